# Optimizing an MI355X kernel written in HIP

```python
import jax, jax.numpy as jnp
from jax import lax
import numpy as np

D_MODEL = 1024
BATCH = 4
SEQ = 4096
DEPTH = 2

HEAD_DIM = 64
ROT_DIM = HEAD_DIM // 4
ROPE_THETA = 500000.0
BLK = 128
A_HEADS = 8
A_PATTERNS = ((128, 1), (512, 4), (2048, 16))
B_Q_HEADS = 8
B_KV_HEADS = 2
B_WINDOW = 128
C_HEADS = 16
C_KV_HEADS = 4
CMP_LEN = 32
CMP_STRIDE = 16
CMP_HIDDEN = 2 * HEAD_DIM
SLC_BLOCK = 64
SLC_TOP_N = 16
NSA_WINDOW = 512
NSA_QBLK = 64
SELECT_FORCE = 1.0e4
N_EXPERTS = 256
TOP_K = 8
N_GROUPS = 8
TOPK_GROUPS = 4
EXPERT_FF = 256
SHARED_FF = 256
ROUTED_SCALE = 2.5
MOE_BLOCK = 128
DEEPNORM_ALPHA = (2 * DEPTH) ** 0.25
DEEPNORM_BETA = (8 * DEPTH) ** -0.25
LN_EPS = 1e-5

EVEN_IN = 3 * A_HEADS * HEAD_DIM + B_Q_HEADS * HEAD_DIM + 2 * B_KV_HEADS * HEAD_DIM
EVEN_OUT = (A_HEADS + B_Q_HEADS) * HEAD_DIM
ODD_IN = C_HEADS * HEAD_DIM + 6 * C_KV_HEADS * HEAD_DIM + 3 * C_HEADS
ODD_OUT = C_HEADS * HEAD_DIM
N_EVEN = (DEPTH + 1) // 2
N_ODD = DEPTH // 2

kernel_name = 'hybrid_dilated_swa_nsa_moe_deepnorm'


def layer_norm(x, g, b):
    xf = x.astype(jnp.float32)
    mu = jnp.mean(xf, -1, keepdims=True)
    var = jnp.mean(jnp.square(xf - mu), -1, keepdims=True)
    y = (xf - mu) * lax.rsqrt(var + LN_EPS) * g.astype(jnp.float32) + b.astype(jnp.float32)
    return y.astype(x.dtype)


def rope_tables(positions, dtype):
    inv_freq = jnp.asarray(ROPE_THETA ** (-np.arange(0, ROT_DIM, 2) / ROT_DIM), jnp.float32)
    ang = positions.astype(jnp.float32)[..., None] * inv_freq
    return jnp.cos(ang)[:, :, None, :].astype(dtype), jnp.sin(ang)[:, :, None, :].astype(dtype)


def apply_rope(x, cos, sin):
    half = ROT_DIM // 2
    x1 = x[..., :half]
    x2 = x[..., half:ROT_DIM]
    return jnp.concatenate([x1 * cos - x2 * sin, x2 * cos + x1 * sin, x[..., ROT_DIM:]], axis=-1)


def banded_attention(q, k, v, max_dist, sinks=None):
    n, g, r, length, hd = q.shape
    nb = -(-length // BLK)
    lp = nb * BLK
    n_prev = -(-max_dist // BLK)
    q = jnp.pad(q, ((0, 0), (0, 0), (0, 0), (0, lp - length), (0, 0)))
    kv_pad = ((0, 0), (0, 0), (n_prev * BLK, lp - length), (0, 0))
    kb = jnp.pad(k, kv_pad).reshape(n, g, nb + n_prev, BLK, hd)
    vb = jnp.pad(v, kv_pad).reshape(n, g, nb + n_prev, BLK, hd)
    kw = jnp.concatenate([kb[:, :, j:j + nb] for j in range(n_prev + 1)], axis=3)
    vw = jnp.concatenate([vb[:, :, j:j + nb] for j in range(n_prev + 1)], axis=3)
    qb = q.reshape(n, g, r, nb, BLK, hd)
    s = jnp.einsum('ngrbqd,ngbkd->ngrbqk', qb, kw).astype(jnp.float32) * (hd ** -0.5)
    qpos = np.arange(nb)[:, None] * BLK + np.arange(BLK)[None, :]
    kpos = (np.arange(nb)[:, None] - n_prev) * BLK + np.arange((n_prev + 1) * BLK)[None, :]
    dist = qpos[:, :, None] - kpos[:, None, :]
    mask = (dist >= 0) & (dist <= max_dist) & (kpos[:, None, :] >= 0)
    s = jnp.where(mask, s, -jnp.inf)
    lse = jax.nn.logsumexp(s, axis=-1)
    if sinks is not None:
        lse = jnp.logaddexp(lse, sinks.astype(jnp.float32)[None, :, :, None, None])
    p = jnp.exp(s - lse[..., None]).astype(v.dtype)
    o = jnp.einsum('ngrbqk,ngbkd->ngrbqd', p, vw)
    return (o.reshape(n, g, r, lp, hd)[:, :, :, :length], lse.reshape(n, g, r, lp)[:, :, :, :length])


def dilated_window_attention(q, k, v, window, dilation):
    b, h, s, hd = q.shape
    length = s // dilation

    def by_residue(t):
        return t.reshape(b, h, length, dilation, hd).transpose(0, 3, 1, 2, 4).reshape(b * dilation, h, length, hd)

    o, lse = banded_attention(by_residue(q)[:, :, None], by_residue(k), by_residue(v), window // dilation)
    o = o.reshape(b, dilation, h, length, hd).transpose(0, 2, 3, 1, 4).reshape(b, h, s, hd)
    lse = lse.reshape(b, dilation, h, length).transpose(0, 2, 3, 1).reshape(b, h, s)
    return o, lse


def even_mixer(x, w_in, sinks, w_out, cos, sin):
    b, s, _ = x.shape
    sizes = [A_HEADS * HEAD_DIM] * 3 + [B_Q_HEADS * HEAD_DIM, B_KV_HEADS * HEAD_DIM, B_KV_HEADS * HEAD_DIM]
    qa, ka, va, qb, kb, vb = jnp.split(x @ w_in, np.cumsum(sizes)[:-1].tolist(), axis=-1)
    heads = lambda t, nh: t.reshape(b, s, nh, HEAD_DIM)
    qa = apply_rope(heads(qa, A_HEADS), cos, sin).transpose(0, 2, 1, 3)
    ka = apply_rope(heads(ka, A_HEADS), cos, sin).transpose(0, 2, 1, 3)
    va = heads(va, A_HEADS).transpose(0, 2, 1, 3)
    outs, lses = [], []
    for window, dilation in A_PATTERNS:
        o, lse = dilated_window_attention(qa, ka, va, window, dilation)
        outs.append(o)
        lses.append(lse)
    wts = jax.nn.softmax(jnp.stack(lses), axis=0).astype(x.dtype)
    oa = jnp.einsum('pbhs,pbhsd->bshd', wts, jnp.stack(outs)).reshape(b, s, A_HEADS * HEAD_DIM)
    rep = B_Q_HEADS // B_KV_HEADS
    qb = apply_rope(heads(qb, B_Q_HEADS), cos, sin).reshape(b, s, B_KV_HEADS, rep, HEAD_DIM).transpose(0, 2, 3, 1, 4)
    kb = apply_rope(heads(kb, B_KV_HEADS), cos, sin).transpose(0, 2, 1, 3)
    vb = heads(vb, B_KV_HEADS).transpose(0, 2, 1, 3)
    ob, _ = banded_attention(qb, kb, vb, B_WINDOW - 1, sinks)
    ob = ob.transpose(0, 3, 1, 2, 4).reshape(b, s, B_Q_HEADS * HEAD_DIM)
    return jnp.concatenate([oa, ob], axis=-1) @ w_out


def compress_blocks(k, pos_emb, w1, w2):
    b, g, s, hd = k.shape
    nc = (s - CMP_LEN) // CMP_STRIDE + 1
    idx = np.arange(nc)[:, None] * CMP_STRIDE + np.arange(CMP_LEN)[None, :]
    blocks = (k[:, :, idx] + pos_emb).reshape(b, g, nc, CMP_LEN * hd)
    return jax.nn.gelu(blocks @ w1) @ w2


def nsa_compressed_and_selected(q, kc, vc, ks, vs):
    b, g, r, s, hd = q.shape
    nc = kc.shape[2]
    nsb = s // SLC_BLOCK
    n_sel = min(SLC_TOP_N, nsb)
    scale = hd ** -0.5
    ksb = ks.reshape(b, g, nsb, SLC_BLOCK, hd)
    vsb = vs.reshape(b, g, nsb, SLC_BLOCK, hd)
    cmp_end = np.arange(nc) * CMP_STRIDE + CMP_LEN - 1
    cs = np.arange(nc)[:, None] * CMP_STRIDE
    js = np.arange(nsb)[None, :] * SLC_BLOCK
    overlap = jnp.asarray(np.clip(np.minimum(cs + CMP_LEN, js + SLC_BLOCK) - np.maximum(cs, js), 0, None) / CMP_LEN, jnp.float32)
    blk_ids = np.arange(nsb)[None, :]
    gather_blocks = jax.vmap(jax.vmap(lambda blocks, ix: blocks[ix]))

    def query_block(i):
        t = i * NSA_QBLK + jnp.arange(NSA_QBLK)
        qb = lax.dynamic_slice_in_dim(q, i * NSA_QBLK, NSA_QBLK, axis=3)
        sc = jnp.einsum('bgrqd,bgcd->bgrqc', qb, kc).astype(jnp.float32) * scale
        cmask = cmp_end[None, :] <= t[:, None]
        sc = jnp.where(cmask, sc, -jnp.inf)
        m = jnp.max(sc, axis=-1, keepdims=True)
        ex = jnp.where(cmask, jnp.exp(sc - jnp.where(jnp.isfinite(m), m, 0.0)), 0.0)
        den = jnp.sum(ex, -1, keepdims=True)
        pc = ex / jnp.where(den > 0, den, 1.0)
        o_cmp = jnp.einsum('bgrqc,bgcd->bgrqd', pc.astype(vc.dtype), vc)
        imp = jnp.einsum('bgrqc,cj->bgqj', pc, overlap)
        cur = (t // SLC_BLOCK)[:, None]
        future = blk_ids > cur
        forced = (blk_ids == 0) | (blk_ids == cur) | (blk_ids == cur - 1)
        score = jnp.where(future, -1.0, jnp.where(forced, SELECT_FORCE, imp))
        _, sel = lax.top_k(score, n_sel)
        k_sel = gather_blocks(ksb, sel).reshape(b, g, NSA_QBLK, n_sel * SLC_BLOCK, hd)
        v_sel = gather_blocks(vsb, sel).reshape(b, g, NSA_QBLK, n_sel * SLC_BLOCK, hd)
        kpos = (sel[..., None] * SLC_BLOCK + jnp.arange(SLC_BLOCK)).reshape(b, g, NSA_QBLK, n_sel * SLC_BLOCK)
        ss = jnp.einsum('bgrqd,bgqkd->bgrqk', qb, k_sel).astype(jnp.float32) * scale
        ss = jnp.where((kpos <= t[:, None])[:, :, None], ss, -jnp.inf)
        ps = jax.nn.softmax(ss, axis=-1).astype(v_sel.dtype)
        o_slc = jnp.einsum('bgrqk,bgqkd->bgrqd', ps, v_sel)
        return o_cmp, o_slc

    o_cmp, o_slc = lax.map(query_block, jnp.arange(s // NSA_QBLK))
    unblock = lambda o: o.transpose(1, 2, 3, 0, 4, 5).reshape(b, g, r, s, hd)
    return unblock(o_cmp), unblock(o_slc)


def odd_mixer(x, w_in, cmpk_pos, cmpk_w1, cmpk_w2, cmpv_pos, cmpv_w1, cmpv_w2, w_out, cos, sin):
    b, s, _ = x.shape
    kvw = C_KV_HEADS * HEAD_DIM
    sizes = [C_HEADS * HEAD_DIM] + [kvw] * 6 + [3 * C_HEADS]
    q, kc, vc, ks, vs, kw, vw, gate = jnp.split(x @ w_in, np.cumsum(sizes)[:-1].tolist(), axis=-1)
    rep = C_HEADS // C_KV_HEADS
    q = apply_rope(q.reshape(b, s, C_HEADS, HEAD_DIM), cos, sin).reshape(b, s, C_KV_HEADS, rep, HEAD_DIM).transpose(0, 2, 3, 1, 4)
    kv_heads = lambda t: t.reshape(b, s, C_KV_HEADS, HEAD_DIM)
    to_bgsd = lambda t: t.transpose(0, 2, 1, 3)
    kc = to_bgsd(apply_rope(kv_heads(kc), cos, sin))
    ks = to_bgsd(apply_rope(kv_heads(ks), cos, sin))
    kw = to_bgsd(apply_rope(kv_heads(kw), cos, sin))
    vc, vs, vw = to_bgsd(kv_heads(vc)), to_bgsd(kv_heads(vs)), to_bgsd(kv_heads(vw))
    kc = compress_blocks(kc, cmpk_pos, cmpk_w1, cmpk_w2)
    vc = compress_blocks(vc, cmpv_pos, cmpv_w1, cmpv_w2)
    o_cmp, o_slc = nsa_compressed_and_selected(q, kc, vc, ks, vs)
    o_win, _ = banded_attention(q, kw, vw, NSA_WINDOW - 1)
    g = jax.nn.sigmoid(gate.astype(jnp.float32)).astype(x.dtype).reshape(b, s, C_HEADS, 3)
    to_bshd = lambda o: o.transpose(0, 3, 1, 2, 4).reshape(b, s, C_HEADS, HEAD_DIM)
    o = g[..., 0:1] * to_bshd(o_cmp) + g[..., 1:2] * to_bshd(o_slc) + g[..., 2:3] * to_bshd(o_win)
    return o.reshape(b, s, C_HEADS * HEAD_DIM) @ w_out


def moe_ffn(x, router_w, router_b, w_gate, w_up, w_down, sh_gate, sh_up, sh_down):
    b, s, d = x.shape
    n_tok = b * s
    xt = x.reshape(n_tok, d)
    affinity = jax.nn.sigmoid((xt @ router_w).astype(jnp.float32))
    biased = affinity + router_b.astype(jnp.float32)
    grouped = biased.reshape(n_tok, N_GROUPS, N_EXPERTS // N_GROUPS)
    group_score = lax.top_k(grouped, 2)[0].sum(-1)
    _, top_groups = lax.top_k(group_score, TOPK_GROUPS)
    group_ok = jnp.any(top_groups[..., None] == jnp.arange(N_GROUPS), axis=-2)
    expert_ok = jnp.repeat(group_ok, N_EXPERTS // N_GROUPS, axis=-1)
    _, eidx = lax.top_k(jnp.where(expert_ok, biased, -jnp.inf), TOP_K)
    gates = jnp.take_along_axis(affinity, eidx, axis=-1)
    gates = gates / jnp.sum(gates, -1, keepdims=True) * ROUTED_SCALE
    n_asg = n_tok * TOP_K
    flat_e = eidx.reshape(n_asg)
    order = jnp.argsort(flat_e)
    se = flat_e[order]
    sg = gates.reshape(n_asg)[order]
    stok = (order // TOP_K).astype(jnp.int32)
    counts = jnp.bincount(flat_e, length=N_EXPERTS)
    starts = jnp.cumsum(counts) - counts
    padded = (counts + MOE_BLOCK - 1) // MOE_BLOCK * MOE_BLOCK
    pad_end = jnp.cumsum(padded)
    dest = (pad_end - padded)[se] + jnp.arange(n_asg) - starts[se]
    n_blocks = -(-n_asg // MOE_BLOCK) + N_EXPERTS
    n_rows = n_blocks * MOE_BLOCK
    row_tok = jnp.full((n_rows,), n_tok, jnp.int32).at[dest].set(stok)
    row_gate = jnp.zeros((n_rows,), jnp.float32).at[dest].set(sg)
    block_expert = jnp.minimum(jnp.searchsorted(pad_end, jnp.arange(n_blocks) * MOE_BLOCK, side='right'), N_EXPERTS - 1)
    x_pad = jnp.concatenate([xt, jnp.zeros((1, d), xt.dtype)], axis=0)

    def expert_block(args):
        tok, gate, e = args
        xb = x_pad[tok]
        h = jax.nn.silu(xb @ w_gate[e]) * (xb @ w_up[e])
        return (h @ w_down[e]) * gate[:, None].astype(xb.dtype)

    y = lax.map(expert_block, (row_tok.reshape(n_blocks, MOE_BLOCK), row_gate.reshape(n_blocks, MOE_BLOCK), block_expert))
    routed = jnp.zeros((n_tok + 1, d), x.dtype).at[row_tok].add(y.reshape(n_rows, d))[:n_tok]
    shared = (jax.nn.silu(xt @ sh_gate) * (xt @ sh_up)) @ sh_down
    return (routed + shared).reshape(b, s, d)


def setup_inputs(seed: int = 0) -> dict:
    key = jax.random.key(seed)
    ks = iter(jax.random.split(key, 32))
    nrm = lambda shape, scale: jax.random.normal(next(ks), shape, jnp.float32) * scale
    x = nrm((BATCH, SEQ, D_MODEL), 1.0)
    positions = (jax.random.randint(next(ks), (BATCH, 1), 0, 2048, dtype=jnp.int32) + jnp.arange(SEQ, dtype=jnp.int32)[None, :])
    return {
        'x': x,
        'positions': positions,
        'even_w_in': nrm((N_EVEN, D_MODEL, EVEN_IN), D_MODEL ** -0.5),
        'even_sinks': nrm((N_EVEN, B_KV_HEADS, B_Q_HEADS // B_KV_HEADS), 0.5),
        'even_w_out': nrm((N_EVEN, EVEN_OUT, D_MODEL), EVEN_OUT ** -0.5 * DEEPNORM_BETA),
        'odd_w_in': nrm((N_ODD, D_MODEL, ODD_IN), D_MODEL ** -0.5),
        'odd_cmpk_pos': nrm((N_ODD, CMP_LEN, HEAD_DIM), 0.1),
        'odd_cmpk_w1': nrm((N_ODD, CMP_LEN * HEAD_DIM, CMP_HIDDEN), (CMP_LEN * HEAD_DIM) ** -0.5),
        'odd_cmpk_w2': nrm((N_ODD, CMP_HIDDEN, HEAD_DIM), CMP_HIDDEN ** -0.5),
        'odd_cmpv_pos': nrm((N_ODD, CMP_LEN, HEAD_DIM), 0.1),
        'odd_cmpv_w1': nrm((N_ODD, CMP_LEN * HEAD_DIM, CMP_HIDDEN), (CMP_LEN * HEAD_DIM) ** -0.5),
        'odd_cmpv_w2': nrm((N_ODD, CMP_HIDDEN, HEAD_DIM), CMP_HIDDEN ** -0.5),
        'odd_w_out': nrm((N_ODD, ODD_OUT, D_MODEL), ODD_OUT ** -0.5 * DEEPNORM_BETA),
        'mix_ln_g': 1.0 + nrm((DEPTH, D_MODEL), 0.01),
        'mix_ln_b': nrm((DEPTH, D_MODEL), 0.01),
        'moe_router_w': nrm((DEPTH, D_MODEL, N_EXPERTS), D_MODEL ** -0.5),
        'moe_router_b': nrm((DEPTH, N_EXPERTS), 0.01),
        'moe_w_gate': nrm((DEPTH, N_EXPERTS, D_MODEL, EXPERT_FF), D_MODEL ** -0.5),
        'moe_w_up': nrm((DEPTH, N_EXPERTS, D_MODEL, EXPERT_FF), D_MODEL ** -0.5),
        'moe_w_down': nrm((DEPTH, N_EXPERTS, EXPERT_FF, D_MODEL), EXPERT_FF ** -0.5 * DEEPNORM_BETA),
        'moe_sh_gate': nrm((DEPTH, D_MODEL, SHARED_FF), D_MODEL ** -0.5),
        'moe_sh_up': nrm((DEPTH, D_MODEL, SHARED_FF), D_MODEL ** -0.5),
        'moe_sh_down': nrm((DEPTH, SHARED_FF, D_MODEL), SHARED_FF ** -0.5 * DEEPNORM_BETA),
        'ffn_ln_g': 1.0 + nrm((DEPTH, D_MODEL), 0.01),
        'ffn_ln_b': nrm((DEPTH, D_MODEL), 0.01),
    }


def reference(x, positions, even_w_in, even_sinks, even_w_out, odd_w_in, odd_cmpk_pos, odd_cmpk_w1, odd_cmpk_w2, odd_cmpv_pos, odd_cmpv_w1, odd_cmpv_w2, odd_w_out, mix_ln_g, mix_ln_b, moe_router_w, moe_router_b, moe_w_gate, moe_w_up, moe_w_down, moe_sh_gate, moe_sh_up, moe_sh_down, ffn_ln_g, ffn_ln_b):
    cos, sin = rope_tables(positions, x.dtype)
    for layer in range(DEPTH):
        j = layer // 2
        if layer % 2 == 0:
            mixed = even_mixer(x, even_w_in[j], even_sinks[j], even_w_out[j], cos, sin)
        else:
            mixed = odd_mixer(x, odd_w_in[j], odd_cmpk_pos[j], odd_cmpk_w1[j], odd_cmpk_w2[j], odd_cmpv_pos[j], odd_cmpv_w1[j], odd_cmpv_w2[j], odd_w_out[j], cos, sin)
        x = layer_norm(DEEPNORM_ALPHA * x + mixed, mix_ln_g[layer], mix_ln_b[layer])
        ffn = moe_ffn(x, moe_router_w[layer], moe_router_b[layer], moe_w_gate[layer], moe_w_up[layer], moe_w_down[layer], moe_sh_gate[layer], moe_sh_up[layer], moe_sh_down[layer])
        x = layer_norm(DEEPNORM_ALPHA * x + ffn, ffn_ln_g[layer], ffn_ln_b[layer])
    return x
```

```cpp
#include <hip/hip_runtime.h>
#include <hip/hip_bf16.h>
#include <stdint.h>
#include <math.h>

typedef unsigned short u16;
using bf16x8 = __attribute__((ext_vector_type(8))) short;
using f32x4  = __attribute__((ext_vector_type(4))) float;

#define DEV __device__ __forceinline__

constexpr int T_ = 16384, S_ = 4096, D_ = 1024;
constexpr int LD0 = 2304, LD1 = 2560, NIN1 = 2608;
constexpr int NE = 256, TOPK = 8, NASG = T_ * TOPK, NROWS = NASG + T_;
constexpr float ALPHA = 1.41421356237309515f;
constexpr float LN_EPS = 1e-5f;

#define FFN_MODE 0
#ifndef STAGE_LIMIT
#define STAGE_LIMIT 99
#endif

struct Params {
  const float* x; const int* pos;
  const float* even_w_in; const float* even_sinks; const float* even_w_out; const float* odd_w_in;
  const float* cmpk_pos; const float* cmpk_w1; const float* cmpk_w2; const float* cmpv_pos; const float* cmpv_w1; const float* cmpv_w2;
  const float* odd_w_out; const float* mix_g; const float* mix_b; const float* router_w; const float* router_b;
  const float* w_gate; const float* w_up; const float* w_down; const float* sh_gate; const float* sh_up; const float* sh_down;
  const float* ffn_g; const float* ffn_b;
  float* out;
  unsigned* bar; int* cnt; float* pb; float* cs; u16* xb; u16* qkv; float* gates; u16* ao; float* hpre;
  float* x1f; u16* x1b; u16* x1lo; float* logits; int* eidx; float* gatev; int* epos; int* slot; int* row_tok;
  u16* hbuf; u16* ybuf; float* x2f; u16* hid; u16* cmpkv;
};

DEV u16 f2bf(float f) { unsigned u = __float_as_uint(f); u += 0x7fffu + ((u >> 16) & 1u); return (u16)(u >> 16); }
DEV float bf2f(u16 h) { return __uint_as_float(((unsigned)h) << 16); }
DEV float bflo(unsigned w) { return __uint_as_float(w << 16); }
DEV float bfhi(unsigned w) { return __uint_as_float(w & 0xffff0000u); }
DEV unsigned pack2(float a, float b) { return (unsigned)f2bf(a) | ((unsigned)f2bf(b) << 16); }
DEV float wave_max(float v) { for (int o = 32; o; o >>= 1) v = fmaxf(v, __shfl_xor(v, o)); return v; }
DEV float wave_sum(float v) { for (int o = 32; o; o >>= 1) v += __shfl_xor(v, o); return v; }
#define WAVE_SYNC() asm volatile("s_waitcnt lgkmcnt(0)" ::: "memory")

struct GemmSmem { u16 A[2][128][40]; u16 B[2][128][40]; };

template <bool SPLIT, class FA, class FB, class FL, class FE>
DEV void gemm_core(GemmSmem& sm, int nk, FA a_addr, FB b_addr, int ldb, FL b_lo, FE epi) {
  const int tid = threadIdx.x, lane = tid & 63, wid = tid >> 6;
  const int wr = wid >> 1, wc = wid & 1, fr = lane & 15, fq = lane >> 4;
  f32x4 acc[4][4];
#pragma unroll
  for (int mi = 0; mi < 4; ++mi)
#pragma unroll
    for (int ni = 0; ni < 4; ++ni) acc[mi][ni] = f32x4{0.f, 0.f, 0.f, 0.f};
  uint4 ra[2]; float rb[2][8];
  auto gload = [&](int kt) {
    ra[0] = *reinterpret_cast<const uint4*>(a_addr(0, kt));
    ra[1] = *reinterpret_cast<const uint4*>(a_addr(1, kt));
#pragma unroll
    for (int cc = 0; cc < 2; ++cc) {
      const float* bp = b_addr(kt, cc);
      if (bp) {
#pragma unroll
        for (int i = 0; i < 8; ++i) rb[cc][i] = bp[(size_t)i * ldb];
      } else {
#pragma unroll
        for (int i = 0; i < 8; ++i) rb[cc][i] = 0.f;
      }
    }
  };
  auto sstore = [&](int buf, int kt) {
    *reinterpret_cast<uint4*>(&sm.A[buf][(tid >> 2)][(tid & 3) * 8]) = ra[0];
    *reinterpret_cast<uint4*>(&sm.A[buf][(tid >> 2) + 64][(tid & 3) * 8]) = ra[1];
    const bool lo = SPLIT ? b_lo(kt) : false;
#pragma unroll
    for (int cc = 0; cc < 2; ++cc) {
      float v[8];
#pragma unroll
      for (int i = 0; i < 8; ++i) { v[i] = rb[cc][i]; if (SPLIT && lo) v[i] = v[i] - bf2f(f2bf(v[i])); }
      uint4 w; w.x = pack2(v[0], v[1]); w.y = pack2(v[2], v[3]); w.z = pack2(v[4], v[5]); w.w = pack2(v[6], v[7]);
      *reinterpret_cast<uint4*>(&sm.B[buf][lane + 64 * cc][wid * 8]) = w;
    }
  };
  gload(0); sstore(0, 0); __syncthreads();
  for (int kt = 0; kt < nk; ++kt) {
    const int cur = kt & 1;
    if (kt + 1 < nk) gload(kt + 1);
    bf16x8 af[4], bf[4];
#pragma unroll
    for (int mi = 0; mi < 4; ++mi) af[mi] = *reinterpret_cast<const bf16x8*>(&sm.A[cur][wr * 64 + mi * 16 + fr][fq * 8]);
#pragma unroll
    for (int ni = 0; ni < 4; ++ni) bf[ni] = *reinterpret_cast<const bf16x8*>(&sm.B[cur][wc * 64 + ni * 16 + fr][fq * 8]);
#pragma unroll
    for (int mi = 0; mi < 4; ++mi)
#pragma unroll
      for (int ni = 0; ni < 4; ++ni) acc[mi][ni] = __builtin_amdgcn_mfma_f32_16x16x32_bf16(af[mi], bf[ni], acc[mi][ni], 0, 0, 0);
    if (kt + 1 < nk) sstore(cur ^ 1, kt + 1);
    __syncthreads();
  }
  epi(acc);
}

__constant__ float INVF[8] = {1.0f, 0.1939227432012558f, 0.03760603070259094f, 0.007292664609849453f, 0.0014142135623842478f,
                              0.00027424818836152554f, 5.3182957344688475e-05f, 1.0313385246263351e-05f};
DEV void ph_prologue(const Params& p) {
  const size_t gtid = (size_t)blockIdx.x * 256 + threadIdx.x, gsz = (size_t)gridDim.x * 256;
  for (size_t i = gtid; i < (size_t)T_ * D_ / 8; i += gsz) {
    const float4 a = reinterpret_cast<const float4*>(p.x)[2 * i], b = reinterpret_cast<const float4*>(p.x)[2 * i + 1];
    uint4 w; w.x = pack2(a.x, a.y); w.y = pack2(a.z, a.w); w.z = pack2(b.x, b.y); w.w = pack2(b.z, b.w);
    reinterpret_cast<uint4*>(p.xb)[i] = w;
  }
  for (size_t i = gtid; i < (size_t)T_ * 8; i += gsz) {
    const int t = (int)(i >> 3), f = (int)(i & 7);
    const float ang = (float)p.pos[t] * INVF[f];
    p.cs[t * 16 + f] = cosf(ang); p.cs[t * 16 + 8 + f] = sinf(ang);
  }
  for (size_t i = gtid; i < 2 * 128 * 16; i += gsz) {
    const int n = (int)(i & 127), kc = (int)((i >> 7) & 15), ts = (int)(i >> 11);
    const float* pe = ts ? p.cmpv_pos : p.cmpk_pos; const float* w1 = ts ? p.cmpv_w1 : p.cmpk_w1;
    float s = 0.f;
    for (int k = kc * 128; k < kc * 128 + 128; ++k) s += pe[k] * w1[(size_t)k * 128 + n];
    atomicAdd(&p.pb[ts * 128 + n], s);
  }
}

DEV void ph_inproj0(const Params& p, GemmSmem& sm) {
  const int tid = threadIdx.x, lane = tid & 63, wid = tid >> 6, wr = wid >> 1, wc = wid & 1, fr = lane & 15, fq = lane >> 4;
  constexpr int NT = LD0 / 128;
  for (int u = blockIdx.x; u < 128 * NT; u += gridDim.x) {
    const int mt = u / NT, nt = u % NT, m0 = mt * 128, n0 = nt * 128;
    const u16* ar0 = p.xb + (size_t)(m0 + (tid >> 2)) * D_ + (tid & 3) * 8;
    const u16* ar1 = ar0 + (size_t)64 * D_;
    auto a_addr = [&](int i, int kt) { return (i ? ar1 : ar0) + kt * 32; };
    const float* bb = p.even_w_in + (size_t)(wid * 8) * LD0 + n0 + lane;
    auto b_addr = [&](int kt, int cc) { return bb + (size_t)kt * 32 * LD0 + cc * 64; };
    auto b_lo = [&](int) { return false; };
    auto epi = [&](f32x4 (&acc)[4][4]) {
#pragma unroll
      for (int mi = 0; mi < 4; ++mi)
#pragma unroll
        for (int ni = 0; ni < 4; ++ni) {
          f32x4 v = acc[mi][ni];
          const int col = n0 + wc * 64 + ni * 16 + fr, rowb = m0 + wr * 64 + mi * 16 + fq * 4;
          const bool rope = (ni == 0) && (col < 1024 || (col >= 1536 && col < 2176));
          if (rope) {
#pragma unroll
            for (int j = 0; j < 4; ++j) {
              const float pv = __shfl_xor(v[j], 8);
              const float c_ = p.cs[(rowb + j) * 16 + (fr & 7)], s_ = p.cs[(rowb + j) * 16 + 8 + (fr & 7)];
              v[j] = (fr < 8) ? v[j] * c_ - pv * s_ : v[j] * c_ + pv * s_;
            }
          }
#pragma unroll
          for (int j = 0; j < 4; ++j) p.qkv[(size_t)(rowb + j) * LD0 + col] = f2bf(v[j]);
        }
    };
    gemm_core<false>(sm, 32, a_addr, b_addr, LD0, b_lo, epi);
  }
}

struct AttnSmem { float qs[4][64]; float sc[4][1040]; int tk[4][1040]; int tw[4][512]; };

DEV float wave_attn(const float* qs, float* sc, const int* tk, int n4, const u16* Kb, const u16* Vb, int ld, float sink, int lane, float (&o)[4]) {
  float mx = -INFINITY;
  for (int i = lane; i < n4; i += 64) {
    const int r = tk[i];
    float s = -INFINITY;
    if (r >= 0) {
      const uint4* kp = reinterpret_cast<const uint4*>(Kb + (size_t)r * ld);
      float a = 0.f;
#pragma unroll
      for (int c = 0; c < 8; ++c) {
        const uint4 kv = kp[c];
        const float4 q0 = reinterpret_cast<const float4*>(qs)[2 * c], q1 = reinterpret_cast<const float4*>(qs)[2 * c + 1];
        a += bflo(kv.x) * q0.x + bfhi(kv.x) * q0.y + bflo(kv.y) * q0.z + bfhi(kv.y) * q0.w
           + bflo(kv.z) * q1.x + bfhi(kv.z) * q1.y + bflo(kv.w) * q1.z + bfhi(kv.w) * q1.w;
      }
      s = a;
    }
    sc[i] = s; mx = fmaxf(mx, s);
  }
  mx = wave_max(mx);
  const float m = fmaxf(mx, sink);
  WAVE_SYNC();
  float sum = 0.f;
  if (m > -INFINITY) {
    for (int i = lane; i < n4; i += 64) { const float pz = __expf(sc[i] - m); sc[i] = pz; sum += pz; }
  } else {
    for (int i = lane; i < n4; i += 64) sc[i] = 0.f;
  }
  sum = wave_sum(sum);
  if (sink > -INFINITY) sum += __expf(sink - m);
  const float inv = sum > 0.f ? 1.f / sum : 0.f;
  WAVE_SYNC();
  const int kk = lane >> 4, dg = lane & 15;
  float a0 = 0.f, a1 = 0.f, a2 = 0.f, a3 = 0.f;
  for (int i = kk; i < n4; i += 4) {
    const float pz = sc[i];
    if (pz != 0.f) {
      const int r = tk[i];
      const uint2 v = *reinterpret_cast<const uint2*>(Vb + (size_t)r * ld + dg * 4);
      a0 += pz * bflo(v.x); a1 += pz * bfhi(v.x); a2 += pz * bflo(v.y); a3 += pz * bfhi(v.y);
    }
  }
  a0 += __shfl_xor(a0, 16); a1 += __shfl_xor(a1, 16); a2 += __shfl_xor(a2, 16); a3 += __shfl_xor(a3, 16);
  a0 += __shfl_xor(a0, 32); a1 += __shfl_xor(a1, 32); a2 += __shfl_xor(a2, 32); a3 += __shfl_xor(a3, 32);
  o[0] = a0 * inv; o[1] = a1 * inv; o[2] = a2 * inv; o[3] = a3 * inv;
  return inv;
}

DEV void ph_attn0(const Params& p, AttnSmem& sm) {
  const int tid = threadIdx.x, lane = tid & 63, wid = tid >> 6;
  float* qs = sm.qs[wid]; float* sc = sm.sc[wid]; int* tk = sm.tk[wid];
  const int gw = blockIdx.x * 4 + wid, nw = gridDim.x * 4;
  for (int u = gw; u < T_ * 16; u += nw) {
    const int tg = u >> 4, h = u & 15, b = tg >> 12, t = tg & 4095;
    const u16* row = p.qkv + (size_t)tg * LD0;
    int qcol, kcol, vcol, n; float sink = -INFINITY;
    if (h < 8) {
      qcol = h * 64; kcol = 512 + h * 64; vcol = 1024 + h * 64;
      for (int i = lane; i < 388; i += 64) {
        int r = -1;
        if (i < 387) { const int pi = i / 129, k = i - pi * 129; const int dil = pi == 0 ? 1 : (pi == 1 ? 4 : 16); const int tok = t - k * dil; if (tok >= 0) r = b * S_ + tok; }
        tk[i] = r;
      }
      n = 388;
    } else {
      const int hb = h - 8, g = hb >> 2;
      qcol = 1536 + hb * 64; kcol = 2048 + g * 64; vcol = 2176 + g * 64; sink = p.even_sinks[hb];
      for (int i = lane; i < 128; i += 64) { const int tok = t - i; tk[i] = tok >= 0 ? b * S_ + tok : -1; }
      n = 128;
    }
    qs[lane] = bf2f(row[qcol + lane]) * 0.125f;
    WAVE_SYNC();
    float o[4];
    wave_attn(qs, sc, tk, n, p.qkv + kcol, p.qkv + vcol, LD0, sink, lane, o);
    if (lane < 16) { uint2 w; w.x = pack2(o[0], o[1]); w.y = pack2(o[2], o[3]); *reinterpret_cast<uint2*>(p.ao + (size_t)tg * D_ + h * 64 + lane * 4) = w; }
    WAVE_SYNC();
  }
}

DEV void ph_outproj(const Params& p, GemmSmem& sm, const float* W, const float* resid) {
  const int tid = threadIdx.x, lane = tid & 63, wid = tid >> 6, wr = wid >> 1, wc = wid & 1, fr = lane & 15, fq = lane >> 4;
  for (int u = blockIdx.x; u < 128 * 8; u += gridDim.x) {
    const int mt = u >> 3, nt = u & 7, m0 = mt * 128, n0 = nt * 128;
    const u16* ar0 = p.ao + (size_t)(m0 + (tid >> 2)) * D_ + (tid & 3) * 8;
    const u16* ar1 = ar0 + (size_t)64 * D_;
    auto a_addr = [&](int i, int kt) { return (i ? ar1 : ar0) + kt * 32; };
    const float* bb = W + (size_t)(wid * 8) * D_ + n0 + lane;
    auto b_addr = [&](int kt, int cc) { return bb + (size_t)kt * 32 * D_ + cc * 64; };
    auto b_lo = [&](int) { return false; };
    auto epi = [&](f32x4 (&acc)[4][4]) {
#pragma unroll
      for (int mi = 0; mi < 4; ++mi)
#pragma unroll
        for (int ni = 0; ni < 4; ++ni)
#pragma unroll
          for (int j = 0; j < 4; ++j) {
            const size_t idx = (size_t)(m0 + wr * 64 + mi * 16 + fq * 4 + j) * D_ + n0 + wc * 64 + ni * 16 + fr;
            p.hpre[idx] = ALPHA * resid[idx] + acc[mi][ni][j];
          }
    };
    gemm_core<false>(sm, 32, a_addr, b_addr, D_, b_lo, epi);
  }
}

DEV void ph_ln_mix(const Params& p, const float* g, const float* bt) {
  const int lane = threadIdx.x & 63, gw = blockIdx.x * 4 + (threadIdx.x >> 6), nw = gridDim.x * 4;
  for (int tok = gw; tok < T_; tok += nw) {
    float4 v[4]; float s = 0.f;
#pragma unroll
    for (int i = 0; i < 4; ++i) { v[i] = reinterpret_cast<const float4*>(p.hpre + (size_t)tok * D_)[i * 64 + lane]; s += v[i].x + v[i].y + v[i].z + v[i].w; }
    const float mu = wave_sum(s) * (1.f / D_);
    float ss = 0.f;
#pragma unroll
    for (int i = 0; i < 4; ++i) { v[i].x -= mu; v[i].y -= mu; v[i].z -= mu; v[i].w -= mu; ss += v[i].x * v[i].x + v[i].y * v[i].y + v[i].z * v[i].z + v[i].w * v[i].w; }
    const float rstd = rsqrtf(wave_sum(ss) * (1.f / D_) + LN_EPS);
#pragma unroll
    for (int i = 0; i < 4; ++i) {
      const float4 gg = reinterpret_cast<const float4*>(g)[i * 64 + lane], bb = reinterpret_cast<const float4*>(bt)[i * 64 + lane];
      float4 y; y.x = v[i].x * rstd * gg.x + bb.x; y.y = v[i].y * rstd * gg.y + bb.y; y.z = v[i].z * rstd * gg.z + bb.z; y.w = v[i].w * rstd * gg.w + bb.w;
      reinterpret_cast<float4*>(p.x1f + (size_t)tok * D_)[i * 64 + lane] = y;
      const u16 h0 = f2bf(y.x), h1 = f2bf(y.y), h2 = f2bf(y.z), h3 = f2bf(y.w);
      uint2 hi; hi.x = (unsigned)h0 | ((unsigned)h1 << 16); hi.y = (unsigned)h2 | ((unsigned)h3 << 16);
      uint2 lo; lo.x = pack2(y.x - bf2f(h0), y.y - bf2f(h1)); lo.y = pack2(y.z - bf2f(h2), y.w - bf2f(h3));
      reinterpret_cast<uint2*>(p.x1b + (size_t)tok * D_)[i * 64 + lane] = hi;
      reinterpret_cast<uint2*>(p.x1lo + (size_t)tok * D_)[i * 64 + lane] = lo;
    }
  }
}

DEV void ph_router_gemm(const Params& p, GemmSmem& sm, const float* RW) {
  const int tid = threadIdx.x, lane = tid & 63, wid = tid >> 6, wr = wid >> 1, wc = wid & 1, fr = lane & 15, fq = lane >> 4;
  for (int u = blockIdx.x; u < 128 * 2; u += gridDim.x) {
    const int mt = u >> 1, nt = u & 1, m0 = mt * 128, n0 = nt * 128;
    const size_t ao0 = (size_t)(m0 + (tid >> 2)) * D_ + (tid & 3) * 8, ao1 = ao0 + (size_t)64 * D_;
    auto a_addr = [&](int i, int kt) { const u16* base = ((kt >> 5) == 1) ? p.x1lo : p.x1b; return base + (i ? ao1 : ao0) + (kt & 31) * 32; };
    const float* bb = RW + (size_t)(wid * 8) * NE + n0 + lane;
    auto b_addr = [&](int kt, int cc) { return bb + (size_t)(kt & 31) * 32 * NE + cc * 64; };
    auto b_lo = [&](int kt) { return kt >= 64; };
    auto epi = [&](f32x4 (&acc)[4][4]) {
#pragma unroll
      for (int mi = 0; mi < 4; ++mi)
#pragma unroll
        for (int ni = 0; ni < 4; ++ni)
#pragma unroll
          for (int j = 0; j < 4; ++j)
            p.logits[(size_t)(m0 + wr * 64 + mi * 16 + fq * 4 + j) * NE + n0 + wc * 64 + ni * 16 + fr] = acc[mi][ni][j];
    };
    gemm_core<true>(sm, 96, a_addr, b_addr, NE, b_lo, epi);
  }
}

template <bool NAIVE_LG> DEV void ph_route(const Params& p, const float* rbias, int* cnt, const float* RW) {
  const int lane = threadIdx.x & 63, gw = blockIdx.x * 4 + (threadIdx.x >> 6), nw = gridDim.x * 4;
  const int half = lane >> 5;
  for (int tok = gw; tok < T_; tok += nw) {
    float aff[4], val[4];
    float lgn[4] = {0.f, 0.f, 0.f, 0.f};
    if (NAIVE_LG) {
      for (int k = 0; k < D_; ++k) {
        const float xv = p.x1f[(size_t)tok * D_ + k];
#pragma unroll
        for (int j = 0; j < 4; ++j) lgn[j] += xv * RW[(size_t)k * NE + lane + 64 * j];
      }
    }
#pragma unroll
    for (int j = 0; j < 4; ++j) {
      const float lg = NAIVE_LG ? lgn[j] : p.logits[(size_t)tok * NE + lane + 64 * j];
      aff[j] = 1.f / (1.f + expf(-lg));
      val[j] = aff[j] + rbias[lane + 64 * j];
    }
    float gs[8];
#pragma unroll
    for (int j = 0; j < 4; ++j) {
      float m1 = val[j];
#pragma unroll
      for (int o = 16; o; o >>= 1) m1 = fmaxf(m1, __shfl_xor(m1, o));
      const unsigned long long eq = __ballot(val[j] == m1);
      const int ceq = __popc((unsigned)(half ? (eq >> 32) : (eq & 0xffffffffull)));
      float m2 = (val[j] == m1) ? -INFINITY : val[j];
#pragma unroll
      for (int o = 16; o; o >>= 1) m2 = fmaxf(m2, __shfl_xor(m2, o));
      if (ceq >= 2) m2 = m1;
      const float mine = m1 + m2, other = __shfl_xor(mine, 32);
      gs[2 * j] = half ? other : mine; gs[2 * j + 1] = half ? mine : other;
    }
    bool gok[8];
#pragma unroll
    for (int g = 0; g < 8; ++g) {
      int rk = 0;
#pragma unroll
      for (int g2 = 0; g2 < 8; ++g2) rk += (gs[g2] > gs[g] || (gs[g2] == gs[g] && g2 < g)) ? 1 : 0;
      gok[g] = rk < 4;
    }
#pragma unroll
    for (int j = 0; j < 4; ++j) { const bool ok = half ? gok[2 * j + 1] : gok[2 * j]; if (!ok) val[j] = -INFINITY; }
    int my_e = 0; float my_a = 0.f, asum = 0.f;
#pragma unroll
    for (int k = 0; k < TOPK; ++k) {
      float bv = val[0]; int bi = lane;
#pragma unroll
      for (int j = 1; j < 4; ++j) if (val[j] > bv) { bv = val[j]; bi = lane + 64 * j; }
#pragma unroll
      for (int o = 32; o; o >>= 1) {
        const float ov = __shfl_xor(bv, o); const int oi = __shfl_xor(bi, o);
        if (ov > bv || (ov == bv && oi < bi)) { bv = ov; bi = oi; }
      }
      float a_sel = 0.f;
#pragma unroll
      for (int j = 0; j < 4; ++j) { const bool hit = (bi == lane + 64 * j); a_sel = hit ? aff[j] : a_sel; val[j] = hit ? -INFINITY : val[j]; }
      a_sel = wave_sum(a_sel);
      asum += a_sel;
      if (lane == k) { my_e = bi; my_a = a_sel; }
    }
    if (lane < TOPK) {
      const int ps = atomicAdd(&cnt[my_e], 1);
      p.eidx[tok * TOPK + lane] = my_e; p.epos[tok * TOPK + lane] = ps; p.gatev[tok * TOPK + lane] = my_a / asum * 2.5f;
    }
  }
}

DEV void ph_scatter(const Params& p, int* si, const int* cnt) {
  const int tid = threadIdx.x;
  si[tid] = cnt[tid];
  __syncthreads();
  if (tid == 0) { int a = 0; for (int e = 0; e < NE; ++e) { const int c = si[e]; si[e] = a; a += c; } }
  __syncthreads();
  const size_t gtid = (size_t)blockIdx.x * 256 + tid, gsz = (size_t)gridDim.x * 256;
  for (size_t i = gtid; i < (size_t)NASG; i += gsz) {
    const int sl = si[p.eidx[i]] + p.epos[i];
    p.slot[i] = sl; p.row_tok[sl] = (int)(i >> 3);
  }
  for (size_t i = gtid; i < (size_t)T_; i += gsz) p.row_tok[NASG + i] = (int)i;
  __syncthreads();
}

struct MoeTab { int cn[260]; int of[260]; int tf[260]; };
DEV void moe_prep(MoeTab& mt, const int* cnt) {
  const int tid = threadIdx.x;
  mt.cn[tid] = cnt[tid];
  __syncthreads();
  if (tid == 0) {
    int a = 0, tl = 0;
    for (int e = 0; e < NE; ++e) { mt.of[e] = a; mt.tf[e] = tl; a += mt.cn[e]; tl += (mt.cn[e] + 127) >> 7; }
    mt.cn[NE] = T_; mt.of[NE] = NASG; mt.tf[NE] = tl; mt.of[NE + 1] = NASG + T_; mt.tf[NE + 1] = tl + T_ / 128;
  }
  __syncthreads();
}
DEV int moe_find(const MoeTab& mt, int mtile) {
  int lo = 0, hi = NE;
  while (lo < hi) { const int mid = (lo + hi + 1) >> 1; if (mt.tf[mid] <= mtile) lo = mid; else hi = mid - 1; }
  return lo;
}

DEV void ph_moe1(const Params& p, GemmSmem& sm, MoeTab& mt, int layer, const int* cnt) {
  const int tid = threadIdx.x, lane = tid & 63, wid = tid >> 6, wr = wid >> 1, wc = wid & 1, fr = lane & 15, fq = lane >> 4;
  moe_prep(mt, cnt);
  const int nunits = mt.tf[NE + 1] * 4;
  for (int u = blockIdx.x; u < nunits; u += gridDim.x) {
    int lo = 0, hi = NE;
    while (lo < hi) { const int mid = (lo + hi + 1) >> 1; if (4 * mt.tf[mid] <= u) lo = mid; else hi = mid - 1; }
    const int e = lo, tiles = mt.tf[e + 1] - mt.tf[e], local = u - 4 * mt.tf[e];
    const int nt = local / tiles, mtl = local % tiles, cn = mt.cn[e], of = mt.of[e];
    int i0 = mtl * 128 + (tid >> 2), i1 = i0 + 64;
    i0 = i0 < cn ? i0 : cn - 1; i1 = i1 < cn ? i1 : cn - 1;
    const u16* ar0 = p.x1b + (size_t)p.row_tok[of + i0] * D_ + (tid & 3) * 8;
    const u16* ar1 = p.x1b + (size_t)p.row_tok[of + i1] * D_ + (tid & 3) * 8;
    auto a_addr = [&](int i, int kt) { return (i ? ar1 : ar0) + kt * 32; };
    const float* wg = e < NE ? p.w_gate + ((size_t)layer * NE + e) * D_ * 256 : p.sh_gate + (size_t)layer * D_ * 256;
    const float* wu = e < NE ? p.w_up + ((size_t)layer * NE + e) * D_ * 256 : p.sh_up + (size_t)layer * D_ * 256;
    const float* bb = (lane >= 32 ? wu : wg) + (size_t)(wid * 8) * 256 + nt * 64 + (lane & 31);
    auto b_addr = [&](int kt, int cc) { return bb + (size_t)kt * 32 * 256 + cc * 32; };
    auto b_lo = [&](int) { return false; };
    auto epi = [&](f32x4 (&acc)[4][4]) {
#pragma unroll
      for (int mi = 0; mi < 4; ++mi)
#pragma unroll
        for (int n2 = 0; n2 < 2; ++n2)
#pragma unroll
          for (int j = 0; j < 4; ++j) {
            const float g = acc[mi][n2][j], uu = acc[mi][n2 + 2][j];
            const float hval = g / (1.f + __expf(-g)) * uu;
            const int idx = mtl * 128 + wr * 64 + mi * 16 + fq * 4 + j;
            if (idx < cn) p.hbuf[(size_t)(of + idx) * 256 + nt * 64 + wc * 32 + n2 * 16 + fr] = f2bf(hval);
          }
    };
    gemm_core<false>(sm, 32, a_addr, b_addr, 256, b_lo, epi);
  }
}

DEV void ph_moe2(const Params& p, GemmSmem& sm, MoeTab& mt, int layer, const int* cnt) {
  const int tid = threadIdx.x, lane = tid & 63, wid = tid >> 6, wr = wid >> 1, wc = wid & 1, fr = lane & 15, fq = lane >> 4;
  moe_prep(mt, cnt);
  const int nunits = mt.tf[NE + 1] * 8;
  for (int u = blockIdx.x; u < nunits; u += gridDim.x) {
    int lo = 0, hi = NE;
    while (lo < hi) { const int mid = (lo + hi + 1) >> 1; if (8 * mt.tf[mid] <= u) lo = mid; else hi = mid - 1; }
    const int e = lo, tiles = mt.tf[e + 1] - mt.tf[e], local = u - 8 * mt.tf[e];
    const int nt = local / tiles, mtl = local % tiles, cn = mt.cn[e], of = mt.of[e];
    int i0 = mtl * 128 + (tid >> 2), i1 = i0 + 64;
    i0 = i0 < cn ? i0 : cn - 1; i1 = i1 < cn ? i1 : cn - 1;
    const u16* ar0 = p.hbuf + (size_t)(of + i0) * 256 + (tid & 3) * 8;
    const u16* ar1 = p.hbuf + (size_t)(of + i1) * 256 + (tid & 3) * 8;
    auto a_addr = [&](int i, int kt) { return (i ? ar1 : ar0) + kt * 32; };
    const float* wd = e < NE ? p.w_down + ((size_t)layer * NE + e) * 256 * D_ : p.sh_down + (size_t)layer * 256 * D_;
    const float* bb = wd + (size_t)(wid * 8) * D_ + nt * 128 + lane;
    auto b_addr = [&](int kt, int cc) { return bb + (size_t)kt * 32 * D_ + cc * 64; };
    auto b_lo = [&](int) { return false; };
    auto epi = [&](f32x4 (&acc)[4][4]) {
#pragma unroll
      for (int mi = 0; mi < 4; ++mi)
#pragma unroll
        for (int ni = 0; ni < 4; ++ni)
#pragma unroll
          for (int j = 0; j < 4; ++j) {
            const int idx = mtl * 128 + wr * 64 + mi * 16 + fq * 4 + j;
            if (idx < cn) p.ybuf[(size_t)(of + idx) * D_ + nt * 128 + wc * 64 + ni * 16 + fr] = f2bf(acc[mi][ni][j]);
          }
    };
    gemm_core<false>(sm, 8, a_addr, b_addr, D_, b_lo, epi);
  }
}

DEV void ph_combine_ln(const Params& p, const float* g, const float* bt, float* outf, u16* outb, bool with_ffn) {
  const int lane = threadIdx.x & 63, gw = blockIdx.x * 4 + (threadIdx.x >> 6), nw = gridDim.x * 4;
  for (int tok = gw; tok < T_; tok += nw) {
    float4 v[4];
#pragma unroll
    for (int i = 0; i < 4; ++i) {
      v[i] = reinterpret_cast<const float4*>(p.x1f + (size_t)tok * D_)[i * 64 + lane];
      v[i].x *= ALPHA; v[i].y *= ALPHA; v[i].z *= ALPHA; v[i].w *= ALPHA;
    }
    if (with_ffn) {
#if FFN_MODE != 2
#pragma unroll
      for (int i = 0; i < 4; ++i) {
        const uint2 y = reinterpret_cast<const uint2*>(p.ybuf + (size_t)(NASG + tok) * D_)[i * 64 + lane];
        v[i].x += bflo(y.x); v[i].y += bfhi(y.x); v[i].z += bflo(y.y); v[i].w += bfhi(y.y);
      }
#endif
#if FFN_MODE != 1
      for (int k = 0; k < TOPK; ++k) {
        const int sl = p.slot[tok * TOPK + k]; const float gk = p.gatev[tok * TOPK + k];
#pragma unroll
        for (int i = 0; i < 4; ++i) {
          const uint2 y = reinterpret_cast<const uint2*>(p.ybuf + (size_t)sl * D_)[i * 64 + lane];
          v[i].x += gk * bflo(y.x); v[i].y += gk * bfhi(y.x); v[i].z += gk * bflo(y.y); v[i].w += gk * bfhi(y.y);
        }
      }
#endif
    }
    float s = 0.f;
#pragma unroll
    for (int i = 0; i < 4; ++i) s += v[i].x + v[i].y + v[i].z + v[i].w;
    const float mu = wave_sum(s) * (1.f / D_);
    float ss = 0.f;
#pragma unroll
    for (int i = 0; i < 4; ++i) { v[i].x -= mu; v[i].y -= mu; v[i].z -= mu; v[i].w -= mu; ss += v[i].x * v[i].x + v[i].y * v[i].y + v[i].z * v[i].z + v[i].w * v[i].w; }
    const float rstd = rsqrtf(wave_sum(ss) * (1.f / D_) + LN_EPS);
#pragma unroll
    for (int i = 0; i < 4; ++i) {
      const float4 gg = reinterpret_cast<const float4*>(g)[i * 64 + lane], bb = reinterpret_cast<const float4*>(bt)[i * 64 + lane];
      float4 y; y.x = v[i].x * rstd * gg.x + bb.x; y.y = v[i].y * rstd * gg.y + bb.y; y.z = v[i].z * rstd * gg.z + bb.z; y.w = v[i].w * rstd * gg.w + bb.w;
      reinterpret_cast<float4*>(outf + (size_t)tok * D_)[i * 64 + lane] = y;
      uint2 hi; hi.x = pack2(y.x, y.y); hi.y = pack2(y.z, y.w);
      reinterpret_cast<uint2*>(outb + (size_t)tok * D_)[i * 64 + lane] = hi;
    }
  }
}

DEV void ph_inproj1(const Params& p, GemmSmem& sm) {
  const int tid = threadIdx.x, lane = tid & 63, wid = tid >> 6, wr = wid >> 1, wc = wid & 1, fr = lane & 15, fq = lane >> 4;
  constexpr int NT = 21;
  for (int u = blockIdx.x; u < 128 * NT; u += gridDim.x) {
    const int mt = u / NT, nt = u % NT, m0 = mt * 128, n0 = nt * 128;
    const u16* ar0 = p.xb + (size_t)(m0 + (tid >> 2)) * D_ + (tid & 3) * 8;
    const u16* ar1 = ar0 + (size_t)64 * D_;
    auto a_addr = [&](int i, int kt) { return (i ? ar1 : ar0) + kt * 32; };
    const float* bb = p.odd_w_in + (size_t)(wid * 8) * NIN1 + n0 + lane;
    auto b_addr = [&](int kt, int cc) -> const float* { return (n0 + lane + cc * 64 < NIN1) ? bb + (size_t)kt * 32 * NIN1 + cc * 64 : nullptr; };
    auto b_lo = [&](int) { return false; };
    auto epi = [&](f32x4 (&acc)[4][4]) {
#pragma unroll
      for (int mi = 0; mi < 4; ++mi)
#pragma unroll
        for (int ni = 0; ni < 4; ++ni) {
          f32x4 v = acc[mi][ni];
          const int col = n0 + wc * 64 + ni * 16 + fr, rowb = m0 + wr * 64 + mi * 16 + fq * 4;
          const bool rope = (ni == 0) && (col < 1280 || (col >= 1536 && col < 1792) || (col >= 2048 && col < 2304));
          if (rope) {
#pragma unroll
            for (int j = 0; j < 4; ++j) {
              const float pv = __shfl_xor(v[j], 8);
              const float c_ = p.cs[(rowb + j) * 16 + (fr & 7)], s_ = p.cs[(rowb + j) * 16 + 8 + (fr & 7)];
              v[j] = (fr < 8) ? v[j] * c_ - pv * s_ : v[j] * c_ + pv * s_;
            }
          }
          if (col < LD1) {
#pragma unroll
            for (int j = 0; j < 4; ++j) p.qkv[(size_t)(rowb + j) * LD1 + col] = f2bf(v[j]);
          } else if (col < NIN1) {
#pragma unroll
            for (int j = 0; j < 4; ++j) p.gates[(size_t)(rowb + j) * 48 + (col - LD1)] = 1.f / (1.f + __expf(-v[j]));
          }
        }
    };
    gemm_core<false>(sm, 32, a_addr, b_addr, NIN1, b_lo, epi);
  }
}

DEV float gelu_tanh(float x) { const float u = 0.7978845608028654f * (x + 0.044715f * x * x * x); return 0.5f * x * (1.f + tanhf(u)); }
DEV void ph_cmp1(const Params& p, GemmSmem& sm) {
  const int tid = threadIdx.x, lane = tid & 63, wid = tid >> 6, wr = wid >> 1, wc = wid & 1, fr = lane & 15, fq = lane >> 4;
  for (int u = blockIdx.x; u < 64; u += gridDim.x) {
    const int ts = u >> 5, mt = u & 31, m0 = mt * 128;
    const u16* ar[2];
#pragma unroll
    for (int i = 0; i < 2; ++i) {
      const int m = m0 + (tid >> 2) + 64 * i, bg = m >> 8; int c = m & 255; c = c < 255 ? c : 254;
      ar[i] = p.qkv + (size_t)((bg >> 2) * S_ + 16 * c) * LD1 + (ts ? 1280 : 1024) + (bg & 3) * 64 + (tid & 3) * 8;
    }
    auto a_addr = [&](int i, int kt) { return (i ? ar[1] : ar[0]) + (size_t)(kt >> 1) * LD1 + (kt & 1) * 32; };
    const float* bb = (ts ? p.cmpv_w1 : p.cmpk_w1) + (size_t)(wid * 8) * 128 + lane;
    auto b_addr = [&](int kt, int cc) { return bb + (size_t)kt * 32 * 128 + cc * 64; };
    auto b_lo = [&](int) { return false; };
    auto epi = [&](f32x4 (&acc)[4][4]) {
#pragma unroll
      for (int mi = 0; mi < 4; ++mi)
#pragma unroll
        for (int ni = 0; ni < 4; ++ni)
#pragma unroll
          for (int j = 0; j < 4; ++j) {
            const int m = m0 + wr * 64 + mi * 16 + fq * 4 + j, col = wc * 64 + ni * 16 + fr;
            p.hid[((size_t)ts * 4096 + m) * 128 + col] = f2bf(gelu_tanh(acc[mi][ni][j] + p.pb[ts * 128 + col]));
          }
    };
    gemm_core<false>(sm, 64, a_addr, b_addr, 128, b_lo, epi);
  }
}
DEV void ph_cmp2(const Params& p, GemmSmem& sm) {
  const int tid = threadIdx.x, lane = tid & 63, wid = tid >> 6, wr = wid >> 1, wc = wid & 1, fr = lane & 15, fq = lane >> 4;
  for (int u = blockIdx.x; u < 64; u += gridDim.x) {
    const int ts = u >> 5, mt = u & 31, m0 = mt * 128;
    const u16* ar0 = p.hid + ((size_t)ts * 4096 + m0 + (tid >> 2)) * 128 + (tid & 3) * 8;
    const u16* ar1 = ar0 + (size_t)64 * 128;
    auto a_addr = [&](int i, int kt) { return (i ? ar1 : ar0) + kt * 32; };
    const float* bb = (ts ? p.cmpv_w2 : p.cmpk_w2) + (size_t)(wid * 8) * 64 + lane;
    auto b_addr = [&](int kt, int cc) -> const float* { return cc == 0 ? bb + (size_t)kt * 32 * 64 : nullptr; };
    auto b_lo = [&](int) { return false; };
    auto epi = [&](f32x4 (&acc)[4][4]) {
      if (wc == 0) {
#pragma unroll
        for (int mi = 0; mi < 4; ++mi)
#pragma unroll
          for (int ni = 0; ni < 4; ++ni)
#pragma unroll
            for (int j = 0; j < 4; ++j) {
              const int m = m0 + wr * 64 + mi * 16 + fq * 4 + j, col = ni * 16 + fr;
              p.cmpkv[((size_t)ts * 4096 + m) * 64 + col] = f2bf(acc[mi][ni][j]);
            }
      }
    };
    gemm_core<false>(sm, 4, a_addr, b_addr, 64, b_lo, epi);
  }
}

DEV void ph_attn1(const Params& p, AttnSmem& sm) {
  const int tid = threadIdx.x, lane = tid & 63, wid = tid >> 6;
  float* qs = sm.qs[wid]; float* sc = sm.sc[wid]; int* tk = sm.tk[wid]; int* tw = sm.tw[wid];
  const int gw = blockIdx.x * 4 + wid, nw = gridDim.x * 4;
  for (int u = gw; u < T_ * 4; u += nw) {
    const int tg = u >> 2, g = u & 3, b = tg >> 12, t = tg & 4095, cur = t >> 6;
    const u16* row = p.qkv + (size_t)tg * LD1;
    const int nvalid = t >= 31 ? (((t - 31) >> 4) + 1 < 255 ? ((t - 31) >> 4) + 1 : 255) : 0;
    const int n4c = (nvalid + 3) & ~3;
    const u16* kc = p.cmpkv + (size_t)((b * 4 + g) * 256) * 64;
    const u16* vc = p.cmpkv + (size_t)(4096 + (b * 4 + g) * 256) * 64;
    float imp = 0.f;
    float ocmp[4][4];
#pragma unroll
    for (int r = 0; r < 4; ++r) {
      ocmp[r][0] = ocmp[r][1] = ocmp[r][2] = ocmp[r][3] = 0.f;
      if (nvalid > 0) {
        qs[lane] = bf2f(row[(g * 4 + r) * 64 + lane]) * 0.125f;
        for (int i = lane; i < n4c; i += 64) tk[i] = i < nvalid ? i : -1;
        WAVE_SYNC();
        const float inv = wave_attn(qs, sc, tk, n4c, kc, vc, 64, -INFINITY, lane, ocmp[r]);
        WAVE_SYNC();
        float a = 0.f;
        const int c0 = 4 * lane;
        if (c0 - 1 >= 0 && c0 - 1 < nvalid) a += 0.5f * sc[c0 - 1];
        if (c0 < nvalid) a += sc[c0];
        if (c0 + 1 < nvalid) a += sc[c0 + 1];
        if (c0 + 2 < nvalid) a += sc[c0 + 2];
        if (c0 + 3 < nvalid) a += 0.5f * sc[c0 + 3];
        imp += a * inv;
        WAVE_SYNC();
      }
    }
    const float score = (lane > cur) ? -1.f : ((lane == 0 || lane == cur || lane == cur - 1) ? 1.0e4f : imp);
    int rk = 0;
    for (int jj = 0; jj < 64; ++jj) { const float sj = __shfl(score, jj); rk += (sj > score || (sj == score && jj < lane)) ? 1 : 0; }
    unsigned long long mask = __ballot(rk < 16 && lane <= cur);
    int nsel = 0;
    while (mask) {
      const int j = __ffsll((long long)mask) - 1; mask &= mask - 1;
      const int tok = j * 64 + lane;
      tk[nsel * 64 + lane] = tok <= t ? b * S_ + tok : -1;
      ++nsel;
    }
    for (int i = lane; i < 512; i += 64) { const int tok = t - i; tw[i] = tok >= 0 ? b * S_ + tok : -1; }
    WAVE_SYNC();
#pragma unroll
    for (int r = 0; r < 4; ++r) {
      const int h = g * 4 + r;
      qs[lane] = bf2f(row[h * 64 + lane]) * 0.125f;
      WAVE_SYNC();
      float os[4], ow[4];
      wave_attn(qs, sc, tk, nsel * 64, p.qkv + 1536 + g * 64, p.qkv + 1792 + g * 64, LD1, -INFINITY, lane, os);
      WAVE_SYNC();
      wave_attn(qs, sc, tw, 512, p.qkv + 2048 + g * 64, p.qkv + 2304 + g * 64, LD1, -INFINITY, lane, ow);
      const float g0 = p.gates[(size_t)tg * 48 + h * 3], g1 = p.gates[(size_t)tg * 48 + h * 3 + 1], g2 = p.gates[(size_t)tg * 48 + h * 3 + 2];
      if (lane < 16) {
        uint2 w;
        w.x = pack2(g0 * ocmp[r][0] + g1 * os[0] + g2 * ow[0], g0 * ocmp[r][1] + g1 * os[1] + g2 * ow[1]);
        w.y = pack2(g0 * ocmp[r][2] + g1 * os[2] + g2 * ow[2], g0 * ocmp[r][3] + g1 * os[3] + g2 * ow[3]);
        *reinterpret_cast<uint2*>(p.ao + (size_t)tg * D_ + h * 64 + lane * 4) = w;
      }
      WAVE_SYNC();
    }
  }
}

enum { PH_PRO = 0, PH_IN0, PH_ATT0, PH_OUT0, PH_LN0, PH_RG0, PH_RT0, PH_SC0, PH_M10, PH_M20, PH_CB0,
       PH_IN1, PH_C1, PH_C2, PH_ATT1, PH_OUT1, PH_LN1, PH_RG1, PH_RT1, PH_SC1, PH_M11, PH_M21, PH_CB1, PH_COUNT };

template <int PH> DEV void run_phase(const Params& p, char* smem) {
  GemmSmem& gs = *reinterpret_cast<GemmSmem*>(smem);
  AttnSmem& as = *reinterpret_cast<AttnSmem*>(smem);
  MoeTab& mt = *reinterpret_cast<MoeTab*>(smem + sizeof(GemmSmem));
  if constexpr (PH == PH_PRO) ph_prologue(p);
  else if constexpr (PH == PH_IN0) ph_inproj0(p, gs);
  else if constexpr (PH == PH_ATT0) ph_attn0(p, as);
  else if constexpr (PH == PH_OUT0) ph_outproj(p, gs, p.even_w_out, p.x);
  else if constexpr (PH == PH_LN0) ph_ln_mix(p, p.mix_g, p.mix_b);
  else if constexpr (PH == PH_RG0) ph_router_gemm(p, gs, p.router_w);
  else if constexpr (PH == PH_RT0) ph_route<false>(p, p.router_b, p.cnt, p.router_w);
  else if constexpr (PH == PH_SC0) ph_scatter(p, reinterpret_cast<int*>(smem), p.cnt);
  else if constexpr (PH == PH_M10) ph_moe1(p, gs, mt, 0, p.cnt);
  else if constexpr (PH == PH_M20) ph_moe2(p, gs, mt, 0, p.cnt);
  else if constexpr (PH == PH_CB0) ph_combine_ln(p, p.ffn_g, p.ffn_b, p.x2f, p.xb, STAGE_LIMIT >= 2);
  else if constexpr (PH == PH_IN1) ph_inproj1(p, gs);
  else if constexpr (PH == PH_C1) ph_cmp1(p, gs);
  else if constexpr (PH == PH_C2) ph_cmp2(p, gs);
  else if constexpr (PH == PH_ATT1) ph_attn1(p, as);
  else if constexpr (PH == PH_OUT1) ph_outproj(p, gs, p.odd_w_out, p.x2f);
  else if constexpr (PH == PH_LN1) ph_ln_mix(p, p.mix_g + D_, p.mix_b + D_);
  else if constexpr (PH == PH_RG1) ph_router_gemm(p, gs, p.router_w + (size_t)D_ * NE);
  else if constexpr (PH == PH_RT1) ph_route<false>(p, p.router_b + NE, p.cnt + 512, p.router_w + (size_t)D_ * NE);
  else if constexpr (PH == PH_SC1) ph_scatter(p, reinterpret_cast<int*>(smem), p.cnt + 512);
  else if constexpr (PH == PH_M11) ph_moe1(p, gs, mt, 1, p.cnt + 512);
  else if constexpr (PH == PH_M21) ph_moe2(p, gs, mt, 1, p.cnt + 512);
  else if constexpr (PH == PH_CB1) ph_combine_ln(p, p.ffn_g + D_, p.ffn_b + D_, p.out, p.xb, STAGE_LIMIT >= 4);
}

template <int PH> __global__ void __launch_bounds__(256, 2) k_phase(Params p) {
  __shared__ __attribute__((aligned(16))) char smem[46080];
  run_phase<PH>(p, smem);
}

__global__ void __launch_bounds__(256, 2) k_resid_only(Params p, const float* resid) {
  const size_t gtid = (size_t)blockIdx.x * 256 + threadIdx.x, gsz = (size_t)gridDim.x * 256;
  for (size_t i = gtid; i < (size_t)T_ * D_; i += gsz) p.hpre[i] = ALPHA * resid[i];
}


template <int PH> static void launch_phase(const Params& p, hipStream_t s) {
  hipLaunchKernelGGL((k_phase<PH>), dim3(512), dim3(256), 0, s, p);
}

extern "C" void kernel_launch(void* const* d_in, const int* in_sizes, int n_in, void* d_out, int out_size, void* d_ws, size_t ws_size, hipStream_t stream) {
  (void)in_sizes; (void)n_in; (void)out_size; (void)ws_size;
  Params p{};
  p.x = (const float*)d_in[0]; p.pos = (const int*)d_in[1];
  p.even_w_in = (const float*)d_in[2]; p.even_sinks = (const float*)d_in[3]; p.even_w_out = (const float*)d_in[4]; p.odd_w_in = (const float*)d_in[5];
  p.cmpk_pos = (const float*)d_in[6]; p.cmpk_w1 = (const float*)d_in[7]; p.cmpk_w2 = (const float*)d_in[8];
  p.cmpv_pos = (const float*)d_in[9]; p.cmpv_w1 = (const float*)d_in[10]; p.cmpv_w2 = (const float*)d_in[11];
  p.odd_w_out = (const float*)d_in[12]; p.mix_g = (const float*)d_in[13]; p.mix_b = (const float*)d_in[14];
  p.router_w = (const float*)d_in[15]; p.router_b = (const float*)d_in[16];
  p.w_gate = (const float*)d_in[17]; p.w_up = (const float*)d_in[18]; p.w_down = (const float*)d_in[19];
  p.sh_gate = (const float*)d_in[20]; p.sh_up = (const float*)d_in[21]; p.sh_down = (const float*)d_in[22];
  p.ffn_g = (const float*)d_in[23]; p.ffn_b = (const float*)d_in[24];
  p.out = (float*)d_out;
  char* w = (char*)d_ws; size_t off = 0;
  auto take = [&](size_t bytes) { char* r = w + off; off += (bytes + 255) & ~(size_t)255; return r; };
  p.bar = (unsigned*)take(16384);
  p.cnt = (int*)take(4096);
  p.pb = (float*)take(1024);
  const size_t zero_bytes = off;
  p.cs = (float*)take((size_t)T_ * 16 * 4);
  p.xb = (u16*)take((size_t)T_ * D_ * 2);
  p.qkv = (u16*)take((size_t)T_ * 2624 * 2);
  p.gates = (float*)take((size_t)T_ * 48 * 4);
  p.ao = (u16*)take((size_t)T_ * D_ * 2);
  p.hpre = (float*)take((size_t)T_ * D_ * 4);
  p.x1f = (float*)take((size_t)T_ * D_ * 4);
  p.x1b = (u16*)take((size_t)T_ * D_ * 2);
  p.x1lo = (u16*)take((size_t)T_ * D_ * 2);
  p.logits = (float*)take((size_t)T_ * NE * 4);
  p.eidx = (int*)take((size_t)NASG * 4);
  p.gatev = (float*)take((size_t)NASG * 4);
  p.epos = (int*)take((size_t)NASG * 4);
  p.slot = (int*)take((size_t)NASG * 4);
  p.row_tok = (int*)take((size_t)NROWS * 4);
  p.hbuf = (u16*)take((size_t)NROWS * 256 * 2);
  p.ybuf = (u16*)take((size_t)NROWS * D_ * 2);
  p.x2f = (float*)take((size_t)T_ * D_ * 4);
  p.hid = (u16*)take((size_t)2 * 4096 * 128 * 2);
  p.cmpkv = (u16*)take((size_t)2 * 4096 * 64 * 2);

  hipMemsetAsync(d_ws, 0, zero_bytes, stream);
  launch_phase<PH_PRO>(p, stream);
#if STAGE_LIMIT >= 1
  launch_phase<PH_IN0>(p, stream);
  launch_phase<PH_ATT0>(p, stream);
  launch_phase<PH_OUT0>(p, stream);
#else
  hipLaunchKernelGGL(k_resid_only, dim3(512), dim3(256), 0, stream, p, p.x);
#endif
  launch_phase<PH_LN0>(p, stream);
#if STAGE_LIMIT >= 2
  launch_phase<PH_RG0>(p, stream);
  launch_phase<PH_RT0>(p, stream);
  launch_phase<PH_SC0>(p, stream);
  launch_phase<PH_M10>(p, stream);
  launch_phase<PH_M20>(p, stream);
#endif
  launch_phase<PH_CB0>(p, stream);
#if STAGE_LIMIT >= 3
  launch_phase<PH_IN1>(p, stream);
  launch_phase<PH_C1>(p, stream);
  launch_phase<PH_C2>(p, stream);
  launch_phase<PH_ATT1>(p, stream);
  launch_phase<PH_OUT1>(p, stream);
#else
  hipLaunchKernelGGL(k_resid_only, dim3(512), dim3(256), 0, stream, p, (const float*)p.x2f);
#endif
  launch_phase<PH_LN1>(p, stream);
#if STAGE_LIMIT >= 4
  launch_phase<PH_RG1>(p, stream);
  launch_phase<PH_RT1>(p, stream);
  launch_phase<PH_SC1>(p, stream);
  launch_phase<PH_M11>(p, stream);
  launch_phase<PH_M21>(p, stream);
#endif
  launch_phase<PH_CB1>(p, stream);
}
```

```cpp
#include <hip/hip_runtime.h>
#include <hip/hip_bf16.h>
#include <stdint.h>
#include <math.h>
#include <utility>

typedef unsigned short u16;
using bf16x8 = __attribute__((ext_vector_type(8))) short;
using f32x4  = __attribute__((ext_vector_type(4))) float;

#define DEV __device__ __forceinline__

constexpr int T_ = 16384, S_ = 4096, D_ = 1024;
constexpr int LD0 = 2304, LD1 = 2560, NIN1 = 2608;
constexpr int NE = 256, TOPK = 8, NASG = T_ * TOPK, NROWS = NASG + T_;
constexpr float ALPHA = 1.41421356237309515f;
constexpr float LN_EPS = 1e-5f;

#define FFN_MODE 0

struct Params {
  const float* x; const int* pos;
  const float* even_w_in; const float* even_sinks; const float* even_w_out; const float* odd_w_in;
  const float* cmpk_pos; const float* cmpk_w1; const float* cmpk_w2; const float* cmpv_pos; const float* cmpv_w1; const float* cmpv_w2;
  const float* odd_w_out; const float* mix_g; const float* mix_b; const float* router_w; const float* router_b;
  const float* w_gate; const float* w_up; const float* w_down; const float* sh_gate; const float* sh_up; const float* sh_down;
  const float* ffn_g; const float* ffn_b;
  float* out;
  unsigned* bar; int* cnt; float* pb; float* cs; u16* xb; u16* qkv; float* gates; u16* ao; float* hpre;
  float* x1f; u16* x1b; u16* x1lo; float* logits; int* eidx; float* gatev; int* epos; int* etok;
  u16* hbuf; u16* ybuf; float* x2f; u16* hid; u16* cmpkv;
};

#define XB_TMO      128
#define XB_XCNT(j)  (256  + 64 * (j))
#define XB_XSUB(j)  (1280 + 64 * (j))
#define XB_XGEN(j)  (2304 + 64 * (j))
#define XB_TOP      3328
#define XB_TOPGEN   3392
#define XCD_BAR_WORDS 3456
#define XB_SPIN_CAP (1u << 18)
#define LAS __attribute__((address_space(3)))

__device__ __forceinline__ unsigned xb_ld(unsigned* p)              { return __hip_atomic_load(p, __ATOMIC_RELAXED, __HIP_MEMORY_SCOPE_AGENT); }
__device__ __forceinline__ unsigned xb_add(unsigned* p, unsigned v) { return __hip_atomic_fetch_add(p, v, __ATOMIC_RELAXED, __HIP_MEMORY_SCOPE_AGENT); }
__device__ __forceinline__ unsigned xb_xcc_id() { return (unsigned)__builtin_amdgcn_s_getreg((3 << 11) | 20) & 0xFu; }
#define XB_SPIN(cond, bar) do { unsigned _sp = 0; while (cond) { __builtin_amdgcn_s_sleep(1); \
    if ((++_sp & 255u) == 0u) { if (xb_ld(&(bar)[XB_TMO])) break; if (_sp > XB_SPIN_CAP) { atomicAdd(&(bar)[XB_TMO], 1u); break; } } } } while (0)

struct XcdBarrier {
    unsigned* bar; unsigned x;
    volatile LAS unsigned* st;
};

__device__ __forceinline__ XcdBarrier xcd_barrier_post(unsigned* bar, volatile LAS unsigned* st) {
    XcdBarrier b; b.bar = bar; b.x = xb_xcc_id(); b.st = st;
    if (threadIdx.x == 0) (void)xb_add(&bar[XB_XCNT(b.x)], 1u);
    return b;
}
__device__ __forceinline__ void xcd_barrier_complete(unsigned* bar, unsigned x, unsigned& nloc, unsigned& nx) {
    const unsigned G = gridDim.x * gridDim.y * gridDim.z;
    unsigned sum, cnt, mine, sp = 0u;
    for (;;) {
        sum = 0u; cnt = 0u; mine = 0u;
#pragma unroll
        for (unsigned j = 0; j < 16; ++j) { const unsigned c = xb_ld(&bar[XB_XCNT(j)]); sum += c; cnt += (c > 0u) ? 1u : 0u; mine = (j == x) ? c : mine; }
        if (sum == G) break;
        __builtin_amdgcn_s_sleep(1);
        if ((++sp & 255u) == 0u) { if (xb_ld(&bar[XB_TMO])) break; if (sp > XB_SPIN_CAP) { atomicAdd(&bar[XB_TMO], 1u); break; } }
    }
    nloc = mine > 0u ? mine : 1u; nx = cnt > 0u ? cnt : 1u;
}

__device__ __forceinline__ void xcd_barrier(const XcdBarrier& b) {
    asm volatile("s_waitcnt vmcnt(0)" ::: "memory");
    __syncthreads();
    if (threadIdx.x == 0) {
        unsigned* bar = b.bar;
        __builtin_amdgcn_s_waitcnt(0);
        unsigned nloc = b.st[0], nx = b.st[1];
        if (nloc == 0u) { xcd_barrier_complete(bar, b.x, nloc, nx); b.st[0] = nloc; b.st[1] = nx; }
        const unsigned old = xb_add(&bar[XB_XSUB(b.x)], 1u);
        const unsigned gen = old / nloc;
        if (old + 1u == (gen + 1u) * nloc) {
            __builtin_amdgcn_fence(__ATOMIC_RELEASE, "agent");
            asm volatile("s_waitcnt vmcnt(0)" ::: "memory");
            const unsigned og = xb_add(&bar[XB_TOP], 1u);
            const unsigned tg = og / nx;
            if (og + 1u == (tg + 1u) * nx) xb_add(&bar[XB_TOPGEN], 1u);
            else XB_SPIN(xb_ld(&bar[XB_TOPGEN]) == tg, bar);
            __builtin_amdgcn_fence(__ATOMIC_ACQUIRE, "agent");
            xb_add(&bar[XB_XGEN(b.x)], 1u);
            asm volatile("s_waitcnt vmcnt(0)" ::: "memory");
        } else {
            XB_SPIN(xb_ld(&bar[XB_XGEN(b.x)]) == gen, bar);
            __builtin_amdgcn_fence(__ATOMIC_ACQUIRE, "agent");
            asm volatile("s_waitcnt vmcnt(0)" ::: "memory");
        }
    }
    __syncthreads();
}


DEV u16 f2bf(float f) { unsigned u = __float_as_uint(f); u += 0x7fffu + ((u >> 16) & 1u); return (u16)(u >> 16); }
DEV float bf2f(u16 h) { return __uint_as_float(((unsigned)h) << 16); }
DEV float bflo(unsigned w) { return __uint_as_float(w << 16); }
DEV float bfhi(unsigned w) { return __uint_as_float(w & 0xffff0000u); }
DEV unsigned pack2(float a, float b) { return (unsigned)f2bf(a) | ((unsigned)f2bf(b) << 16); }
DEV float wave_max(float v) { for (int o = 32; o; o >>= 1) v = fmaxf(v, __shfl_xor(v, o)); return v; }
DEV float wave_sum(float v) { for (int o = 32; o; o >>= 1) v += __shfl_xor(v, o); return v; }
#define WAVE_SYNC() asm volatile("s_waitcnt lgkmcnt(0)" ::: "memory")

struct GemmSmem { u16 A[2][128][40]; u16 B[2][128][40]; };

template <bool SPLIT, class FA, class FB, class FL, class FE>
DEV void gemm_core(GemmSmem& sm, int nk, FA a_addr, FB b_addr, int ldb, FL b_lo, FE epi) {
  const int tid = threadIdx.x, lane = tid & 63, wid = tid >> 6;
  const int wr = wid >> 1, wc = wid & 1, fr = lane & 15, fq = lane >> 4;
  f32x4 acc[4][4];
#pragma unroll
  for (int mi = 0; mi < 4; ++mi)
#pragma unroll
    for (int ni = 0; ni < 4; ++ni) acc[mi][ni] = f32x4{0.f, 0.f, 0.f, 0.f};
  uint4 ra[2]; float rb[2][8];
  auto gload = [&](int kt) {
    ra[0] = *reinterpret_cast<const uint4*>(a_addr(0, kt));
    ra[1] = *reinterpret_cast<const uint4*>(a_addr(1, kt));
#pragma unroll
    for (int cc = 0; cc < 2; ++cc) {
      const float* bp = b_addr(kt, cc);
      if (bp) {
#pragma unroll
        for (int i = 0; i < 8; ++i) rb[cc][i] = bp[(size_t)i * ldb];
      } else {
#pragma unroll
        for (int i = 0; i < 8; ++i) rb[cc][i] = 0.f;
      }
    }
  };
  auto sstore = [&](int buf, int kt) {
    *reinterpret_cast<uint4*>(&sm.A[buf][(tid >> 2)][(tid & 3) * 8]) = ra[0];
    *reinterpret_cast<uint4*>(&sm.A[buf][(tid >> 2) + 64][(tid & 3) * 8]) = ra[1];
    const bool lo = SPLIT ? b_lo(kt) : false;
#pragma unroll
    for (int cc = 0; cc < 2; ++cc) {
      float v[8];
#pragma unroll
      for (int i = 0; i < 8; ++i) { v[i] = rb[cc][i]; if (SPLIT && lo) v[i] = v[i] - bf2f(f2bf(v[i])); }
      uint4 w; w.x = pack2(v[0], v[1]); w.y = pack2(v[2], v[3]); w.z = pack2(v[4], v[5]); w.w = pack2(v[6], v[7]);
      *reinterpret_cast<uint4*>(&sm.B[buf][lane + 64 * cc][wid * 8]) = w;
    }
  };
  gload(0); sstore(0, 0); __syncthreads();
  for (int kt = 0; kt < nk; ++kt) {
    const int cur = kt & 1;
    if (kt + 1 < nk) gload(kt + 1);
    bf16x8 af[4], bf[4];
#pragma unroll
    for (int mi = 0; mi < 4; ++mi) af[mi] = *reinterpret_cast<const bf16x8*>(&sm.A[cur][wr * 64 + mi * 16 + fr][fq * 8]);
#pragma unroll
    for (int ni = 0; ni < 4; ++ni) bf[ni] = *reinterpret_cast<const bf16x8*>(&sm.B[cur][wc * 64 + ni * 16 + fr][fq * 8]);
#pragma unroll
    for (int mi = 0; mi < 4; ++mi)
#pragma unroll
      for (int ni = 0; ni < 4; ++ni) acc[mi][ni] = __builtin_amdgcn_mfma_f32_16x16x32_bf16(af[mi], bf[ni], acc[mi][ni], 0, 0, 0);
    if (kt + 1 < nk) sstore(cur ^ 1, kt + 1);
    __syncthreads();
  }
  epi(acc);
}

__constant__ float INVF[8] = {1.0f, 0.1939227432012558f, 0.03760603070259094f, 0.007292664609849453f, 0.0014142135623842478f,
                              0.00027424818836152554f, 5.3182957344688475e-05f, 1.0313385246263351e-05f};
DEV void ph_prologue(const Params& p) {
  const size_t gtid = (size_t)blockIdx.x * 256 + threadIdx.x, gsz = (size_t)gridDim.x * 256;
  for (size_t i = gtid; i < (size_t)T_ * D_ / 8; i += gsz) {
    const float4 a = reinterpret_cast<const float4*>(p.x)[2 * i], b = reinterpret_cast<const float4*>(p.x)[2 * i + 1];
    uint4 w; w.x = pack2(a.x, a.y); w.y = pack2(a.z, a.w); w.z = pack2(b.x, b.y); w.w = pack2(b.z, b.w);
    reinterpret_cast<uint4*>(p.xb)[i] = w;
  }
  for (size_t i = gtid; i < (size_t)T_ * 8; i += gsz) {
    const int t = (int)(i >> 3), f = (int)(i & 7);
    const float ang = (float)p.pos[t] * INVF[f];
    p.cs[t * 16 + f] = cosf(ang); p.cs[t * 16 + 8 + f] = sinf(ang);
  }
  for (size_t i = gtid; i < 2 * 128 * 16; i += gsz) {
    const int n = (int)(i & 127), kc = (int)((i >> 7) & 15), ts = (int)(i >> 11);
    const float* pe = ts ? p.cmpv_pos : p.cmpk_pos; const float* w1 = ts ? p.cmpv_w1 : p.cmpk_w1;
    float s = 0.f;
    for (int k = kc * 128; k < kc * 128 + 128; ++k) s += pe[k] * w1[(size_t)k * 128 + n];
    atomicAdd(&p.pb[ts * 128 + n], s);
  }
}

DEV void ph_inproj0(const Params& p, GemmSmem& sm) {
  const int tid = threadIdx.x, lane = tid & 63, wid = tid >> 6, wr = wid >> 1, wc = wid & 1, fr = lane & 15, fq = lane >> 4;
  constexpr int NT = LD0 / 128;
  for (int u = blockIdx.x; u < 128 * NT; u += gridDim.x) {
    const int mt = u / NT, nt = u % NT, m0 = mt * 128, n0 = nt * 128;
    const u16* ar0 = p.xb + (size_t)(m0 + (tid >> 2)) * D_ + (tid & 3) * 8;
    const u16* ar1 = ar0 + (size_t)64 * D_;
    auto a_addr = [&](int i, int kt) { return (i ? ar1 : ar0) + kt * 32; };
    const float* bb = p.even_w_in + (size_t)(wid * 8) * LD0 + n0 + lane;
    auto b_addr = [&](int kt, int cc) { return bb + (size_t)kt * 32 * LD0 + cc * 64; };
    auto b_lo = [&](int) { return false; };
    auto epi = [&](f32x4 (&acc)[4][4]) {
#pragma unroll
      for (int mi = 0; mi < 4; ++mi)
#pragma unroll
        for (int ni = 0; ni < 4; ++ni) {
          f32x4 v = acc[mi][ni];
          const int col = n0 + wc * 64 + ni * 16 + fr, rowb = m0 + wr * 64 + mi * 16 + fq * 4;
          const bool rope = (ni == 0) && (col < 1024 || (col >= 1536 && col < 2176));
          if (rope) {
#pragma unroll
            for (int j = 0; j < 4; ++j) {
              const float pv = __shfl_xor(v[j], 8);
              const float c_ = p.cs[(rowb + j) * 16 + (fr & 7)], s_ = p.cs[(rowb + j) * 16 + 8 + (fr & 7)];
              v[j] = (fr < 8) ? v[j] * c_ - pv * s_ : v[j] * c_ + pv * s_;
            }
          }
#pragma unroll
          for (int j = 0; j < 4; ++j) p.qkv[(size_t)(rowb + j) * LD0 + col] = f2bf(v[j]);
        }
    };
    gemm_core<false>(sm, 32, a_addr, b_addr, LD0, b_lo, epi);
  }
}

struct AttnSmem { float qs[4][64]; float sc[4][1040]; int tk[4][1040]; int tw[4][512]; };

DEV float wave_attn(const float* qs, float* sc, const int* tk, int n4, const u16* Kb, const u16* Vb, int ld, float sink, int lane, float (&o)[4]) {
  float mx = -INFINITY;
  for (int i = lane; i < n4; i += 64) {
    const int r = tk[i];
    float s = -INFINITY;
    if (r >= 0) {
      const uint4* kp = reinterpret_cast<const uint4*>(Kb + (size_t)r * ld);
      float a = 0.f;
#pragma unroll
      for (int c = 0; c < 8; ++c) {
        const uint4 kv = kp[c];
        const float4 q0 = reinterpret_cast<const float4*>(qs)[2 * c], q1 = reinterpret_cast<const float4*>(qs)[2 * c + 1];
        a += bflo(kv.x) * q0.x + bfhi(kv.x) * q0.y + bflo(kv.y) * q0.z + bfhi(kv.y) * q0.w
           + bflo(kv.z) * q1.x + bfhi(kv.z) * q1.y + bflo(kv.w) * q1.z + bfhi(kv.w) * q1.w;
      }
      s = a;
    }
    sc[i] = s; mx = fmaxf(mx, s);
  }
  mx = wave_max(mx);
  const float m = fmaxf(mx, sink);
  WAVE_SYNC();
  float sum = 0.f;
  if (m > -INFINITY) {
    for (int i = lane; i < n4; i += 64) { const float pz = __expf(sc[i] - m); sc[i] = pz; sum += pz; }
  } else {
    for (int i = lane; i < n4; i += 64) sc[i] = 0.f;
  }
  sum = wave_sum(sum);
  if (sink > -INFINITY) sum += __expf(sink - m);
  const float inv = sum > 0.f ? 1.f / sum : 0.f;
  WAVE_SYNC();
  const int kk = lane >> 4, dg = lane & 15;
  float a0 = 0.f, a1 = 0.f, a2 = 0.f, a3 = 0.f;
  for (int i = kk; i < n4; i += 4) {
    const float pz = sc[i];
    if (pz != 0.f) {
      const int r = tk[i];
      const uint2 v = *reinterpret_cast<const uint2*>(Vb + (size_t)r * ld + dg * 4);
      a0 += pz * bflo(v.x); a1 += pz * bfhi(v.x); a2 += pz * bflo(v.y); a3 += pz * bfhi(v.y);
    }
  }
  a0 += __shfl_xor(a0, 16); a1 += __shfl_xor(a1, 16); a2 += __shfl_xor(a2, 16); a3 += __shfl_xor(a3, 16);
  a0 += __shfl_xor(a0, 32); a1 += __shfl_xor(a1, 32); a2 += __shfl_xor(a2, 32); a3 += __shfl_xor(a3, 32);
  o[0] = a0 * inv; o[1] = a1 * inv; o[2] = a2 * inv; o[3] = a3 * inv;
  return inv;
}

DEV void ph_attn0(const Params& p, AttnSmem& sm) {
  const int tid = threadIdx.x, lane = tid & 63, wid = tid >> 6;
  float* qs = sm.qs[wid]; float* sc = sm.sc[wid]; int* tk = sm.tk[wid];
  const int gw = blockIdx.x * 4 + wid, nw = gridDim.x * 4;
  for (int u = gw; u < T_ * 16; u += nw) {
    const int tg = u >> 4, h = u & 15, b = tg >> 12, t = tg & 4095;
    const u16* row = p.qkv + (size_t)tg * LD0;
    int qcol, kcol, vcol, n; float sink = -INFINITY;
    if (h < 8) {
      qcol = h * 64; kcol = 512 + h * 64; vcol = 1024 + h * 64;
      for (int i = lane; i < 388; i += 64) {
        int r = -1;
        if (i < 387) { const int pi = i / 129, k = i - pi * 129; const int dil = pi == 0 ? 1 : (pi == 1 ? 4 : 16); const int tok = t - k * dil; if (tok >= 0) r = b * S_ + tok; }
        tk[i] = r;
      }
      n = 388;
    } else {
      const int hb = h - 8, g = hb >> 2;
      qcol = 1536 + hb * 64; kcol = 2048 + g * 64; vcol = 2176 + g * 64; sink = p.even_sinks[hb];
      for (int i = lane; i < 128; i += 64) { const int tok = t - i; tk[i] = tok >= 0 ? b * S_ + tok : -1; }
      n = 128;
    }
    qs[lane] = bf2f(row[qcol + lane]) * 0.125f;
    WAVE_SYNC();
    float o[4];
    wave_attn(qs, sc, tk, n, p.qkv + kcol, p.qkv + vcol, LD0, sink, lane, o);
    if (lane < 16) { uint2 w; w.x = pack2(o[0], o[1]); w.y = pack2(o[2], o[3]); *reinterpret_cast<uint2*>(p.ao + (size_t)tg * D_ + h * 64 + lane * 4) = w; }
    WAVE_SYNC();
  }
}

DEV void ph_outproj(const Params& p, GemmSmem& sm, const float* W, const float* resid) {
  const int tid = threadIdx.x, lane = tid & 63, wid = tid >> 6, wr = wid >> 1, wc = wid & 1, fr = lane & 15, fq = lane >> 4;
  for (int u = blockIdx.x; u < 128 * 8; u += gridDim.x) {
    const int mt = u >> 3, nt = u & 7, m0 = mt * 128, n0 = nt * 128;
    const u16* ar0 = p.ao + (size_t)(m0 + (tid >> 2)) * D_ + (tid & 3) * 8;
    const u16* ar1 = ar0 + (size_t)64 * D_;
    auto a_addr = [&](int i, int kt) { return (i ? ar1 : ar0) + kt * 32; };
    const float* bb = W + (size_t)(wid * 8) * D_ + n0 + lane;
    auto b_addr = [&](int kt, int cc) { return bb + (size_t)kt * 32 * D_ + cc * 64; };
    auto b_lo = [&](int) { return false; };
    auto epi = [&](f32x4 (&acc)[4][4]) {
#pragma unroll
      for (int mi = 0; mi < 4; ++mi)
#pragma unroll
        for (int ni = 0; ni < 4; ++ni)
#pragma unroll
          for (int j = 0; j < 4; ++j) {
            const size_t idx = (size_t)(m0 + wr * 64 + mi * 16 + fq * 4 + j) * D_ + n0 + wc * 64 + ni * 16 + fr;
            p.hpre[idx] = ALPHA * resid[idx] + acc[mi][ni][j];
          }
    };
    gemm_core<false>(sm, 32, a_addr, b_addr, D_, b_lo, epi);
  }
}

DEV void ph_ln_mix(const Params& p, const float* g, const float* bt) {
  const int lane = threadIdx.x & 63, gw = blockIdx.x * 4 + (threadIdx.x >> 6), nw = gridDim.x * 4;
  for (int tok = gw; tok < T_; tok += nw) {
    float4 v[4]; float s = 0.f;
#pragma unroll
    for (int i = 0; i < 4; ++i) { v[i] = reinterpret_cast<const float4*>(p.hpre + (size_t)tok * D_)[i * 64 + lane]; s += v[i].x + v[i].y + v[i].z + v[i].w; }
    const float mu = wave_sum(s) * (1.f / D_);
    float ss = 0.f;
#pragma unroll
    for (int i = 0; i < 4; ++i) { v[i].x -= mu; v[i].y -= mu; v[i].z -= mu; v[i].w -= mu; ss += v[i].x * v[i].x + v[i].y * v[i].y + v[i].z * v[i].z + v[i].w * v[i].w; }
    const float rstd = rsqrtf(wave_sum(ss) * (1.f / D_) + LN_EPS);
#pragma unroll
    for (int i = 0; i < 4; ++i) {
      const float4 gg = reinterpret_cast<const float4*>(g)[i * 64 + lane], bb = reinterpret_cast<const float4*>(bt)[i * 64 + lane];
      float4 y; y.x = v[i].x * rstd * gg.x + bb.x; y.y = v[i].y * rstd * gg.y + bb.y; y.z = v[i].z * rstd * gg.z + bb.z; y.w = v[i].w * rstd * gg.w + bb.w;
      reinterpret_cast<float4*>(p.x1f + (size_t)tok * D_)[i * 64 + lane] = y;
      const u16 h0 = f2bf(y.x), h1 = f2bf(y.y), h2 = f2bf(y.z), h3 = f2bf(y.w);
      uint2 hi; hi.x = (unsigned)h0 | ((unsigned)h1 << 16); hi.y = (unsigned)h2 | ((unsigned)h3 << 16);
      uint2 lo; lo.x = pack2(y.x - bf2f(h0), y.y - bf2f(h1)); lo.y = pack2(y.z - bf2f(h2), y.w - bf2f(h3));
      reinterpret_cast<uint2*>(p.x1b + (size_t)tok * D_)[i * 64 + lane] = hi;
      reinterpret_cast<uint2*>(p.x1lo + (size_t)tok * D_)[i * 64 + lane] = lo;
    }
  }
}

DEV void ph_router_gemm(const Params& p, GemmSmem& sm, const float* RW) {
  const int tid = threadIdx.x, lane = tid & 63, wid = tid >> 6, wr = wid >> 1, wc = wid & 1, fr = lane & 15, fq = lane >> 4;
  for (int u = blockIdx.x; u < 128 * 2; u += gridDim.x) {
    const int mt = u >> 1, nt = u & 1, m0 = mt * 128, n0 = nt * 128;
    const size_t ao0 = (size_t)(m0 + (tid >> 2)) * D_ + (tid & 3) * 8, ao1 = ao0 + (size_t)64 * D_;
    auto a_addr = [&](int i, int kt) { const u16* base = ((kt >> 5) == 1) ? p.x1lo : p.x1b; return base + (i ? ao1 : ao0) + (kt & 31) * 32; };
    const float* bb = RW + (size_t)(wid * 8) * NE + n0 + lane;
    auto b_addr = [&](int kt, int cc) { return bb + (size_t)(kt & 31) * 32 * NE + cc * 64; };
    auto b_lo = [&](int kt) { return kt >= 64; };
    auto epi = [&](f32x4 (&acc)[4][4]) {
#pragma unroll
      for (int mi = 0; mi < 4; ++mi)
#pragma unroll
        for (int ni = 0; ni < 4; ++ni)
#pragma unroll
          for (int j = 0; j < 4; ++j)
            p.logits[(size_t)(m0 + wr * 64 + mi * 16 + fq * 4 + j) * NE + n0 + wc * 64 + ni * 16 + fr] = acc[mi][ni][j];
    };
    gemm_core<true>(sm, 96, a_addr, b_addr, NE, b_lo, epi);
  }
}

template <bool NAIVE_LG> DEV void ph_route(const Params& p, const float* rbias, int* cnt, const float* RW, int* etok) {
  const int lane = threadIdx.x & 63, gw = blockIdx.x * 4 + (threadIdx.x >> 6), nw = gridDim.x * 4;
  const int half = lane >> 5;
  for (int tok = gw; tok < T_; tok += nw) {
    float aff[4], val[4];
    float lgn[4] = {0.f, 0.f, 0.f, 0.f};
    if (NAIVE_LG) {
      for (int k = 0; k < D_; ++k) {
        const float xv = p.x1f[(size_t)tok * D_ + k];
#pragma unroll
        for (int j = 0; j < 4; ++j) lgn[j] += xv * RW[(size_t)k * NE + lane + 64 * j];
      }
    }
#pragma unroll
    for (int j = 0; j < 4; ++j) {
      const float lg = NAIVE_LG ? lgn[j] : p.logits[(size_t)tok * NE + lane + 64 * j];
      aff[j] = 1.f / (1.f + expf(-lg));
      val[j] = aff[j] + rbias[lane + 64 * j];
    }
    float gs[8];
#pragma unroll
    for (int j = 0; j < 4; ++j) {
      float m1 = val[j];
#pragma unroll
      for (int o = 16; o; o >>= 1) m1 = fmaxf(m1, __shfl_xor(m1, o));
      const unsigned long long eq = __ballot(val[j] == m1);
      const int ceq = __popc((unsigned)(half ? (eq >> 32) : (eq & 0xffffffffull)));
      float m2 = (val[j] == m1) ? -INFINITY : val[j];
#pragma unroll
      for (int o = 16; o; o >>= 1) m2 = fmaxf(m2, __shfl_xor(m2, o));
      if (ceq >= 2) m2 = m1;
      const float mine = m1 + m2, other = __shfl_xor(mine, 32);
      gs[2 * j] = half ? other : mine; gs[2 * j + 1] = half ? mine : other;
    }
    bool gok[8];
#pragma unroll
    for (int g = 0; g < 8; ++g) {
      int rk = 0;
#pragma unroll
      for (int g2 = 0; g2 < 8; ++g2) rk += (gs[g2] > gs[g] || (gs[g2] == gs[g] && g2 < g)) ? 1 : 0;
      gok[g] = rk < 4;
    }
#pragma unroll
    for (int j = 0; j < 4; ++j) { const bool ok = half ? gok[2 * j + 1] : gok[2 * j]; if (!ok) val[j] = -INFINITY; }
    int my_e = 0; float my_a = 0.f, asum = 0.f;
#pragma unroll
    for (int k = 0; k < TOPK; ++k) {
      float bv = val[0]; int bi = lane;
#pragma unroll
      for (int j = 1; j < 4; ++j) if (val[j] > bv) { bv = val[j]; bi = lane + 64 * j; }
#pragma unroll
      for (int o = 32; o; o >>= 1) {
        const float ov = __shfl_xor(bv, o); const int oi = __shfl_xor(bi, o);
        if (ov > bv || (ov == bv && oi < bi)) { bv = ov; bi = oi; }
      }
      float a_sel = 0.f;
#pragma unroll
      for (int j = 0; j < 4; ++j) { const bool hit = (bi == lane + 64 * j); a_sel = hit ? aff[j] : a_sel; val[j] = hit ? -INFINITY : val[j]; }
      a_sel = wave_sum(a_sel);
      asum += a_sel;
      if (lane == k) { my_e = bi; my_a = a_sel; }
    }
    if (lane < TOPK) {
      const int ps = atomicAdd(&cnt[my_e], 1);
      p.eidx[tok * TOPK + lane] = my_e; p.epos[tok * TOPK + lane] = ps; p.gatev[tok * TOPK + lane] = my_a / asum * 2.5f;
      etok[(size_t)my_e * T_ + ps] = tok;
    }
  }
}

struct MoeTab { int cn[260]; int of[260]; int tf[260]; };
DEV void moe_prep(MoeTab& mt, const int* cnt) {
  const int tid = threadIdx.x;
  mt.cn[tid] = cnt[tid];
  __syncthreads();
  if (tid == 0) {
    int a = 0, tl = 0;
    for (int e = 0; e < NE; ++e) { mt.of[e] = a; mt.tf[e] = tl; a += mt.cn[e]; tl += (mt.cn[e] + 127) >> 7; }
    mt.cn[NE] = T_; mt.of[NE] = NASG; mt.tf[NE] = tl; mt.of[NE + 1] = NASG + T_; mt.tf[NE + 1] = tl + T_ / 128;
  }
  __syncthreads();
}
DEV int moe_find(const MoeTab& mt, int mtile) {
  int lo = 0, hi = NE;
  while (lo < hi) { const int mid = (lo + hi + 1) >> 1; if (mt.tf[mid] <= mtile) lo = mid; else hi = mid - 1; }
  return lo;
}

DEV void ph_moe1(const Params& p, GemmSmem& sm, MoeTab& mt, int layer, const int* cnt) {
  const int tid = threadIdx.x, lane = tid & 63, wid = tid >> 6, wr = wid >> 1, wc = wid & 1, fr = lane & 15, fq = lane >> 4;
  moe_prep(mt, cnt);
  const int nunits = mt.tf[NE + 1] * 4;
  for (int u = blockIdx.x; u < nunits; u += gridDim.x) {
    int lo = 0, hi = NE;
    while (lo < hi) { const int mid = (lo + hi + 1) >> 1; if (4 * mt.tf[mid] <= u) lo = mid; else hi = mid - 1; }
    const int e = lo, tiles = mt.tf[e + 1] - mt.tf[e], local = u - 4 * mt.tf[e];
    const int nt = local / tiles, mtl = local % tiles, cn = mt.cn[e], of = mt.of[e];
    int i0 = mtl * 128 + (tid >> 2), i1 = i0 + 64;
    i0 = i0 < cn ? i0 : cn - 1; i1 = i1 < cn ? i1 : cn - 1;
    const int tk0 = e < NE ? p.etok[(size_t)e * T_ + i0] : i0, tk1 = e < NE ? p.etok[(size_t)e * T_ + i1] : i1;
    const u16* ar0 = p.x1b + (size_t)tk0 * D_ + (tid & 3) * 8;
    const u16* ar1 = p.x1b + (size_t)tk1 * D_ + (tid & 3) * 8;
    auto a_addr = [&](int i, int kt) { return (i ? ar1 : ar0) + kt * 32; };
    const float* wg = e < NE ? p.w_gate + ((size_t)layer * NE + e) * D_ * 256 : p.sh_gate + (size_t)layer * D_ * 256;
    const float* wu = e < NE ? p.w_up + ((size_t)layer * NE + e) * D_ * 256 : p.sh_up + (size_t)layer * D_ * 256;
    const float* bb = (lane >= 32 ? wu : wg) + (size_t)(wid * 8) * 256 + nt * 64 + (lane & 31);
    auto b_addr = [&](int kt, int cc) { return bb + (size_t)kt * 32 * 256 + cc * 32; };
    auto b_lo = [&](int) { return false; };
    auto epi = [&](f32x4 (&acc)[4][4]) {
#pragma unroll
      for (int mi = 0; mi < 4; ++mi)
#pragma unroll
        for (int n2 = 0; n2 < 2; ++n2)
#pragma unroll
          for (int j = 0; j < 4; ++j) {
            const float g = acc[mi][n2][j], uu = acc[mi][n2 + 2][j];
            const float hval = g / (1.f + __expf(-g)) * uu;
            const int idx = mtl * 128 + wr * 64 + mi * 16 + fq * 4 + j;
            if (idx < cn) p.hbuf[(size_t)(of + idx) * 256 + nt * 64 + wc * 32 + n2 * 16 + fr] = f2bf(hval);
          }
    };
    gemm_core<false>(sm, 32, a_addr, b_addr, 256, b_lo, epi);
  }
}

DEV void ph_moe2(const Params& p, GemmSmem& sm, MoeTab& mt, int layer, const int* cnt) {
  const int tid = threadIdx.x, lane = tid & 63, wid = tid >> 6, wr = wid >> 1, wc = wid & 1, fr = lane & 15, fq = lane >> 4;
  moe_prep(mt, cnt);
  const int nunits = mt.tf[NE + 1] * 8;
  for (int u = blockIdx.x; u < nunits; u += gridDim.x) {
    int lo = 0, hi = NE;
    while (lo < hi) { const int mid = (lo + hi + 1) >> 1; if (8 * mt.tf[mid] <= u) lo = mid; else hi = mid - 1; }
    const int e = lo, tiles = mt.tf[e + 1] - mt.tf[e], local = u - 8 * mt.tf[e];
    const int nt = local / tiles, mtl = local % tiles, cn = mt.cn[e], of = mt.of[e];
    int i0 = mtl * 128 + (tid >> 2), i1 = i0 + 64;
    i0 = i0 < cn ? i0 : cn - 1; i1 = i1 < cn ? i1 : cn - 1;
    const u16* ar0 = p.hbuf + (size_t)(of + i0) * 256 + (tid & 3) * 8;
    const u16* ar1 = p.hbuf + (size_t)(of + i1) * 256 + (tid & 3) * 8;
    auto a_addr = [&](int i, int kt) { return (i ? ar1 : ar0) + kt * 32; };
    const float* wd = e < NE ? p.w_down + ((size_t)layer * NE + e) * 256 * D_ : p.sh_down + (size_t)layer * 256 * D_;
    const float* bb = wd + (size_t)(wid * 8) * D_ + nt * 128 + lane;
    auto b_addr = [&](int kt, int cc) { return bb + (size_t)kt * 32 * D_ + cc * 64; };
    auto b_lo = [&](int) { return false; };
    auto epi = [&](f32x4 (&acc)[4][4]) {
#pragma unroll
      for (int mi = 0; mi < 4; ++mi)
#pragma unroll
        for (int ni = 0; ni < 4; ++ni)
#pragma unroll
          for (int j = 0; j < 4; ++j) {
            const int idx = mtl * 128 + wr * 64 + mi * 16 + fq * 4 + j;
            if (idx < cn) p.ybuf[(size_t)(of + idx) * D_ + nt * 128 + wc * 64 + ni * 16 + fr] = f2bf(acc[mi][ni][j]);
          }
    };
    gemm_core<false>(sm, 8, a_addr, b_addr, D_, b_lo, epi);
  }
}

DEV void ph_combine_ln(const Params& p, MoeTab& mt, const int* cnt, const float* g, const float* bt, float* outf, u16* outb, bool with_ffn) {
  const int lane = threadIdx.x & 63, gw = blockIdx.x * 4 + (threadIdx.x >> 6), nw = gridDim.x * 4;
  moe_prep(mt, cnt);
  for (int tok = gw; tok < T_; tok += nw) {
    float4 v[4];
#pragma unroll
    for (int i = 0; i < 4; ++i) {
      v[i] = reinterpret_cast<const float4*>(p.x1f + (size_t)tok * D_)[i * 64 + lane];
      v[i].x *= ALPHA; v[i].y *= ALPHA; v[i].z *= ALPHA; v[i].w *= ALPHA;
    }
    if (with_ffn) {
#if FFN_MODE != 2
#pragma unroll
      for (int i = 0; i < 4; ++i) {
        const uint2 y = reinterpret_cast<const uint2*>(p.ybuf + (size_t)(NASG + tok) * D_)[i * 64 + lane];
        v[i].x += bflo(y.x); v[i].y += bfhi(y.x); v[i].z += bflo(y.y); v[i].w += bfhi(y.y);
      }
#endif
#if FFN_MODE != 1
      for (int k = 0; k < TOPK; ++k) {
        const int sl = mt.of[p.eidx[tok * TOPK + k]] + p.epos[tok * TOPK + k]; const float gk = p.gatev[tok * TOPK + k];
#pragma unroll
        for (int i = 0; i < 4; ++i) {
          const uint2 y = reinterpret_cast<const uint2*>(p.ybuf + (size_t)sl * D_)[i * 64 + lane];
          v[i].x += gk * bflo(y.x); v[i].y += gk * bfhi(y.x); v[i].z += gk * bflo(y.y); v[i].w += gk * bfhi(y.y);
        }
      }
#endif
    }
    float s = 0.f;
#pragma unroll
    for (int i = 0; i < 4; ++i) s += v[i].x + v[i].y + v[i].z + v[i].w;
    const float mu = wave_sum(s) * (1.f / D_);
    float ss = 0.f;
#pragma unroll
    for (int i = 0; i < 4; ++i) { v[i].x -= mu; v[i].y -= mu; v[i].z -= mu; v[i].w -= mu; ss += v[i].x * v[i].x + v[i].y * v[i].y + v[i].z * v[i].z + v[i].w * v[i].w; }
    const float rstd = rsqrtf(wave_sum(ss) * (1.f / D_) + LN_EPS);
#pragma unroll
    for (int i = 0; i < 4; ++i) {
      const float4 gg = reinterpret_cast<const float4*>(g)[i * 64 + lane], bb = reinterpret_cast<const float4*>(bt)[i * 64 + lane];
      float4 y; y.x = v[i].x * rstd * gg.x + bb.x; y.y = v[i].y * rstd * gg.y + bb.y; y.z = v[i].z * rstd * gg.z + bb.z; y.w = v[i].w * rstd * gg.w + bb.w;
      reinterpret_cast<float4*>(outf + (size_t)tok * D_)[i * 64 + lane] = y;
      uint2 hi; hi.x = pack2(y.x, y.y); hi.y = pack2(y.z, y.w);
      reinterpret_cast<uint2*>(outb + (size_t)tok * D_)[i * 64 + lane] = hi;
    }
  }
}

DEV void ph_inproj1(const Params& p, GemmSmem& sm) {
  const int tid = threadIdx.x, lane = tid & 63, wid = tid >> 6, wr = wid >> 1, wc = wid & 1, fr = lane & 15, fq = lane >> 4;
  constexpr int NT = 21;
  for (int u = blockIdx.x; u < 128 * NT; u += gridDim.x) {
    const int mt = u / NT, nt = u % NT, m0 = mt * 128, n0 = nt * 128;
    const u16* ar0 = p.xb + (size_t)(m0 + (tid >> 2)) * D_ + (tid & 3) * 8;
    const u16* ar1 = ar0 + (size_t)64 * D_;
    auto a_addr = [&](int i, int kt) { return (i ? ar1 : ar0) + kt * 32; };
    const float* bb = p.odd_w_in + (size_t)(wid * 8) * NIN1 + n0 + lane;
    auto b_addr = [&](int kt, int cc) -> const float* { return (n0 + lane + cc * 64 < NIN1) ? bb + (size_t)kt * 32 * NIN1 + cc * 64 : nullptr; };
    auto b_lo = [&](int) { return false; };
    auto epi = [&](f32x4 (&acc)[4][4]) {
#pragma unroll
      for (int mi = 0; mi < 4; ++mi)
#pragma unroll
        for (int ni = 0; ni < 4; ++ni) {
          f32x4 v = acc[mi][ni];
          const int col = n0 + wc * 64 + ni * 16 + fr, rowb = m0 + wr * 64 + mi * 16 + fq * 4;
          const bool rope = (ni == 0) && (col < 1280 || (col >= 1536 && col < 1792) || (col >= 2048 && col < 2304));
          if (rope) {
#pragma unroll
            for (int j = 0; j < 4; ++j) {
              const float pv = __shfl_xor(v[j], 8);
              const float c_ = p.cs[(rowb + j) * 16 + (fr & 7)], s_ = p.cs[(rowb + j) * 16 + 8 + (fr & 7)];
              v[j] = (fr < 8) ? v[j] * c_ - pv * s_ : v[j] * c_ + pv * s_;
            }
          }
          if (col < LD1) {
#pragma unroll
            for (int j = 0; j < 4; ++j) p.qkv[(size_t)(rowb + j) * LD1 + col] = f2bf(v[j]);
          } else if (col < NIN1) {
#pragma unroll
            for (int j = 0; j < 4; ++j) p.gates[(size_t)(rowb + j) * 48 + (col - LD1)] = 1.f / (1.f + __expf(-v[j]));
          }
        }
    };
    gemm_core<false>(sm, 32, a_addr, b_addr, NIN1, b_lo, epi);
  }
}

DEV float gelu_tanh(float x) { const float u = 0.7978845608028654f * (x + 0.044715f * x * x * x); return 0.5f * x * (1.f + tanhf(u)); }
DEV void ph_cmp1(const Params& p, GemmSmem& sm) {
  const int tid = threadIdx.x, lane = tid & 63, wid = tid >> 6, wr = wid >> 1, wc = wid & 1, fr = lane & 15, fq = lane >> 4;
  for (int u = blockIdx.x; u < 64; u += gridDim.x) {
    const int ts = u >> 5, mt = u & 31, m0 = mt * 128;
    const u16* ar[2];
#pragma unroll
    for (int i = 0; i < 2; ++i) {
      const int m = m0 + (tid >> 2) + 64 * i, bg = m >> 8; int c = m & 255; c = c < 255 ? c : 254;
      ar[i] = p.qkv + (size_t)((bg >> 2) * S_ + 16 * c) * LD1 + (ts ? 1280 : 1024) + (bg & 3) * 64 + (tid & 3) * 8;
    }
    auto a_addr = [&](int i, int kt) { return (i ? ar[1] : ar[0]) + (size_t)(kt >> 1) * LD1 + (kt & 1) * 32; };
    const float* bb = (ts ? p.cmpv_w1 : p.cmpk_w1) + (size_t)(wid * 8) * 128 + lane;
    auto b_addr = [&](int kt, int cc) { return bb + (size_t)kt * 32 * 128 + cc * 64; };
    auto b_lo = [&](int) { return false; };
    auto epi = [&](f32x4 (&acc)[4][4]) {
#pragma unroll
      for (int mi = 0; mi < 4; ++mi)
#pragma unroll
        for (int ni = 0; ni < 4; ++ni)
#pragma unroll
          for (int j = 0; j < 4; ++j) {
            const int m = m0 + wr * 64 + mi * 16 + fq * 4 + j, col = wc * 64 + ni * 16 + fr;
            p.hid[((size_t)ts * 4096 + m) * 128 + col] = f2bf(gelu_tanh(acc[mi][ni][j] + p.pb[ts * 128 + col]));
          }
    };
    gemm_core<false>(sm, 64, a_addr, b_addr, 128, b_lo, epi);
  }
}
DEV void ph_cmp2(const Params& p, GemmSmem& sm) {
  const int tid = threadIdx.x, lane = tid & 63, wid = tid >> 6, wr = wid >> 1, wc = wid & 1, fr = lane & 15, fq = lane >> 4;
  for (int u = blockIdx.x; u < 64; u += gridDim.x) {
    const int ts = u >> 5, mt = u & 31, m0 = mt * 128;
    const u16* ar0 = p.hid + ((size_t)ts * 4096 + m0 + (tid >> 2)) * 128 + (tid & 3) * 8;
    const u16* ar1 = ar0 + (size_t)64 * 128;
    auto a_addr = [&](int i, int kt) { return (i ? ar1 : ar0) + kt * 32; };
    const float* bb = (ts ? p.cmpv_w2 : p.cmpk_w2) + (size_t)(wid * 8) * 64 + lane;
    auto b_addr = [&](int kt, int cc) -> const float* { return cc == 0 ? bb + (size_t)kt * 32 * 64 : nullptr; };
    auto b_lo = [&](int) { return false; };
    auto epi = [&](f32x4 (&acc)[4][4]) {
      if (wc == 0) {
#pragma unroll
        for (int mi = 0; mi < 4; ++mi)
#pragma unroll
          for (int ni = 0; ni < 4; ++ni)
#pragma unroll
            for (int j = 0; j < 4; ++j) {
              const int m = m0 + wr * 64 + mi * 16 + fq * 4 + j, col = ni * 16 + fr;
              p.cmpkv[((size_t)ts * 4096 + m) * 64 + col] = f2bf(acc[mi][ni][j]);
            }
      }
    };
    gemm_core<false>(sm, 4, a_addr, b_addr, 64, b_lo, epi);
  }
}

DEV void ph_attn1(const Params& p, AttnSmem& sm) {
  const int tid = threadIdx.x, lane = tid & 63, wid = tid >> 6;
  float* qs = sm.qs[wid]; float* sc = sm.sc[wid]; int* tk = sm.tk[wid]; int* tw = sm.tw[wid];
  const int gw = blockIdx.x * 4 + wid, nw = gridDim.x * 4;
  for (int u = gw; u < T_ * 4; u += nw) {
    const int tg = u >> 2, g = u & 3, b = tg >> 12, t = tg & 4095, cur = t >> 6;
    const u16* row = p.qkv + (size_t)tg * LD1;
    const int nvalid = t >= 31 ? (((t - 31) >> 4) + 1 < 255 ? ((t - 31) >> 4) + 1 : 255) : 0;
    const int n4c = (nvalid + 3) & ~3;
    const u16* kc = p.cmpkv + (size_t)((b * 4 + g) * 256) * 64;
    const u16* vc = p.cmpkv + (size_t)(4096 + (b * 4 + g) * 256) * 64;
    float imp = 0.f;
    float ocmp[4][4];
#pragma unroll
    for (int r = 0; r < 4; ++r) {
      ocmp[r][0] = ocmp[r][1] = ocmp[r][2] = ocmp[r][3] = 0.f;
      if (nvalid > 0) {
        qs[lane] = bf2f(row[(g * 4 + r) * 64 + lane]) * 0.125f;
        for (int i = lane; i < n4c; i += 64) tk[i] = i < nvalid ? i : -1;
        WAVE_SYNC();
        const float inv = wave_attn(qs, sc, tk, n4c, kc, vc, 64, -INFINITY, lane, ocmp[r]);
        WAVE_SYNC();
        float a = 0.f;
        const int c0 = 4 * lane;
        if (c0 - 1 >= 0 && c0 - 1 < nvalid) a += 0.5f * sc[c0 - 1];
        if (c0 < nvalid) a += sc[c0];
        if (c0 + 1 < nvalid) a += sc[c0 + 1];
        if (c0 + 2 < nvalid) a += sc[c0 + 2];
        if (c0 + 3 < nvalid) a += 0.5f * sc[c0 + 3];
        imp += a * inv;
        WAVE_SYNC();
      }
    }
    const float score = (lane > cur) ? -1.f : ((lane == 0 || lane == cur || lane == cur - 1) ? 1.0e4f : imp);
    int rk = 0;
    for (int jj = 0; jj < 64; ++jj) { const float sj = __shfl(score, jj); rk += (sj > score || (sj == score && jj < lane)) ? 1 : 0; }
    unsigned long long mask = __ballot(rk < 16 && lane <= cur);
    int nsel = 0;
    while (mask) {
      const int j = __ffsll((long long)mask) - 1; mask &= mask - 1;
      const int tok = j * 64 + lane;
      tk[nsel * 64 + lane] = tok <= t ? b * S_ + tok : -1;
      ++nsel;
    }
    for (int i = lane; i < 512; i += 64) { const int tok = t - i; tw[i] = tok >= 0 ? b * S_ + tok : -1; }
    WAVE_SYNC();
#pragma unroll
    for (int r = 0; r < 4; ++r) {
      const int h = g * 4 + r;
      qs[lane] = bf2f(row[h * 64 + lane]) * 0.125f;
      WAVE_SYNC();
      float os[4], ow[4];
      wave_attn(qs, sc, tk, nsel * 64, p.qkv + 1536 + g * 64, p.qkv + 1792 + g * 64, LD1, -INFINITY, lane, os);
      WAVE_SYNC();
      wave_attn(qs, sc, tw, 512, p.qkv + 2048 + g * 64, p.qkv + 2304 + g * 64, LD1, -INFINITY, lane, ow);
      const float g0 = p.gates[(size_t)tg * 48 + h * 3], g1 = p.gates[(size_t)tg * 48 + h * 3 + 1], g2 = p.gates[(size_t)tg * 48 + h * 3 + 2];
      if (lane < 16) {
        uint2 w;
        w.x = pack2(g0 * ocmp[r][0] + g1 * os[0] + g2 * ow[0], g0 * ocmp[r][1] + g1 * os[1] + g2 * ow[1]);
        w.y = pack2(g0 * ocmp[r][2] + g1 * os[2] + g2 * ow[2], g0 * ocmp[r][3] + g1 * os[3] + g2 * ow[3]);
        *reinterpret_cast<uint2*>(p.ao + (size_t)tg * D_ + h * 64 + lane * 4) = w;
      }
      WAVE_SYNC();
    }
  }
}

enum { PH_PRO = 0, PH_IN0, PH_ATT0, PH_OUT0, PH_LN0, PH_RG0, PH_RT0, PH_M10, PH_M20, PH_CB0,
       PH_IN1, PH_C1, PH_C2, PH_ATT1, PH_OUT1, PH_LN1, PH_RG1, PH_RT1, PH_M11, PH_M21, PH_CB1, PH_COUNT };

template <int PH> DEV void run_phase(const Params& p, char* smem) {
  GemmSmem& gs = *reinterpret_cast<GemmSmem*>(smem);
  AttnSmem& as = *reinterpret_cast<AttnSmem*>(smem);
  MoeTab& mt = *reinterpret_cast<MoeTab*>(smem + sizeof(GemmSmem));
  if constexpr (PH == PH_PRO) ph_prologue(p);
  else if constexpr (PH == PH_IN0) ph_inproj0(p, gs);
  else if constexpr (PH == PH_ATT0) ph_attn0(p, as);
  else if constexpr (PH == PH_OUT0) ph_outproj(p, gs, p.even_w_out, p.x);
  else if constexpr (PH == PH_LN0) ph_ln_mix(p, p.mix_g, p.mix_b);
  else if constexpr (PH == PH_RG0) ph_router_gemm(p, gs, p.router_w);
  else if constexpr (PH == PH_RT0) ph_route<false>(p, p.router_b, p.cnt, p.router_w, p.etok);
  else if constexpr (PH == PH_M10) ph_moe1(p, gs, mt, 0, p.cnt);
  else if constexpr (PH == PH_M20) ph_moe2(p, gs, mt, 0, p.cnt);
  else if constexpr (PH == PH_CB0) ph_combine_ln(p, mt, p.cnt, p.ffn_g, p.ffn_b, p.x2f, p.xb, true);
  else if constexpr (PH == PH_IN1) ph_inproj1(p, gs);
  else if constexpr (PH == PH_C1) ph_cmp1(p, gs);
  else if constexpr (PH == PH_C2) ph_cmp2(p, gs);
  else if constexpr (PH == PH_ATT1) ph_attn1(p, as);
  else if constexpr (PH == PH_OUT1) ph_outproj(p, gs, p.odd_w_out, p.x2f);
  else if constexpr (PH == PH_LN1) ph_ln_mix(p, p.mix_g + D_, p.mix_b + D_);
  else if constexpr (PH == PH_RG1) ph_router_gemm(p, gs, p.router_w + (size_t)D_ * NE);
  else if constexpr (PH == PH_RT1) ph_route<false>(p, p.router_b + NE, p.cnt + 512, p.router_w + (size_t)D_ * NE, p.etok);
  else if constexpr (PH == PH_M11) ph_moe1(p, gs, mt, 1, p.cnt + 512);
  else if constexpr (PH == PH_M21) ph_moe2(p, gs, mt, 1, p.cnt + 512);
  else if constexpr (PH == PH_CB1) ph_combine_ln(p, mt, p.cnt + 512, p.ffn_g + D_, p.ffn_b + D_, p.out, p.xb, true);
}

constexpr int SMEM_BYTES = 46080, SMEM_BAR_OFF = 46064;
template <int PH> DEV void phase_and_sync(const Params& p, char* smem, const XcdBarrier& bar) {
  run_phase<PH>(p, smem);
  if constexpr (PH + 1 < PH_COUNT) xcd_barrier(bar);
}
template <int... PHS> DEV void run_all(const Params& p, char* smem, const XcdBarrier& bar, std::integer_sequence<int, PHS...>) {
  (phase_and_sync<PHS>(p, smem, bar), ...);
}
__global__ void __launch_bounds__(256, 2) k_fused(Params p) {
  __shared__ __attribute__((aligned(16))) char smem[SMEM_BYTES];
  if (threadIdx.x == 0) *reinterpret_cast<uint4*>(smem + SMEM_BAR_OFF) = make_uint4(0u, 0u, 0u, 0u);
  __syncthreads();
  XcdBarrier bar = xcd_barrier_post(p.bar, (volatile LAS unsigned*)(smem + SMEM_BAR_OFF));
  run_all(p, smem, bar, std::make_integer_sequence<int, PH_COUNT>{});
}

extern "C" void kernel_launch(void* const* d_in, const int* in_sizes, int n_in, void* d_out, int out_size, void* d_ws, size_t ws_size, hipStream_t stream) {
  (void)in_sizes; (void)n_in; (void)out_size; (void)ws_size;
  Params p{};
  p.x = (const float*)d_in[0]; p.pos = (const int*)d_in[1];
  p.even_w_in = (const float*)d_in[2]; p.even_sinks = (const float*)d_in[3]; p.even_w_out = (const float*)d_in[4]; p.odd_w_in = (const float*)d_in[5];
  p.cmpk_pos = (const float*)d_in[6]; p.cmpk_w1 = (const float*)d_in[7]; p.cmpk_w2 = (const float*)d_in[8];
  p.cmpv_pos = (const float*)d_in[9]; p.cmpv_w1 = (const float*)d_in[10]; p.cmpv_w2 = (const float*)d_in[11];
  p.odd_w_out = (const float*)d_in[12]; p.mix_g = (const float*)d_in[13]; p.mix_b = (const float*)d_in[14];
  p.router_w = (const float*)d_in[15]; p.router_b = (const float*)d_in[16];
  p.w_gate = (const float*)d_in[17]; p.w_up = (const float*)d_in[18]; p.w_down = (const float*)d_in[19];
  p.sh_gate = (const float*)d_in[20]; p.sh_up = (const float*)d_in[21]; p.sh_down = (const float*)d_in[22];
  p.ffn_g = (const float*)d_in[23]; p.ffn_b = (const float*)d_in[24];
  p.out = (float*)d_out;
  char* w = (char*)d_ws; size_t off = 0;
  auto take = [&](size_t bytes) { char* r = w + off; off += (bytes + 255) & ~(size_t)255; return r; };
  p.bar = (unsigned*)take(16384);
  p.cnt = (int*)take(4096);
  p.pb = (float*)take(1024);
  const size_t zero_bytes = off;
  p.cs = (float*)take((size_t)T_ * 16 * 4);
  p.xb = (u16*)take((size_t)T_ * D_ * 2);
  p.qkv = (u16*)take((size_t)T_ * 2624 * 2);
  p.gates = (float*)take((size_t)T_ * 48 * 4);
  p.ao = (u16*)take((size_t)T_ * D_ * 2);
  p.hpre = (float*)take((size_t)T_ * D_ * 4);
  p.x1f = (float*)take((size_t)T_ * D_ * 4);
  p.x1b = (u16*)take((size_t)T_ * D_ * 2);
  p.x1lo = (u16*)take((size_t)T_ * D_ * 2);
  p.logits = (float*)take((size_t)T_ * NE * 4);
  p.eidx = (int*)take((size_t)NASG * 4);
  p.gatev = (float*)take((size_t)NASG * 4);
  p.epos = (int*)take((size_t)NASG * 4);
  p.etok = (int*)take((size_t)NE * T_ * 4);
  p.hbuf = (u16*)take((size_t)NROWS * 256 * 2);
  p.ybuf = (u16*)take((size_t)NROWS * D_ * 2);
  p.x2f = (float*)take((size_t)T_ * D_ * 4);
  p.hid = (u16*)take((size_t)2 * 4096 * 128 * 2);
  p.cmpkv = (u16*)take((size_t)2 * 4096 * 64 * 2);

  hipMemsetAsync(d_ws, 0, zero_bytes, stream);
  static int grid = 0;
  if (!grid) {
    int dev = 0, cus = 0, per_cu = 0;
    hipGetDevice(&dev);
    hipDeviceGetAttribute(&cus, hipDeviceAttributeMultiprocessorCount, dev);
    hipOccupancyMaxActiveBlocksPerMultiprocessor(&per_cu, k_fused, 256, 0);
    if (per_cu > 2) per_cu = 2;
    if (per_cu < 1) per_cu = 1;
    grid = cus * per_cu;
  }
  hipLaunchKernelGGL(k_fused, dim3(grid), dim3(256), 0, stream, p);
}
```

```cpp
#include <hip/hip_runtime.h>
#include <hip/hip_bf16.h>
#include <stdint.h>
#include <math.h>
#include <utility>

typedef unsigned short u16;
using bf16x8 = __attribute__((ext_vector_type(8))) short;
using f32x4  = __attribute__((ext_vector_type(4))) float;

#define DEV __device__ __forceinline__

constexpr int T_ = 16384, S_ = 4096, D_ = 1024;
constexpr int LD0 = 2304, LD1 = 2560, NIN1 = 2608;
constexpr int NE = 256, TOPK = 8, NASG = T_ * TOPK, NROWS = NASG + T_;
constexpr float ALPHA = 1.41421356237309515f;
constexpr float LN_EPS = 1e-5f;

#define FFN_MODE 0
#define DEBUG_ATT 0

struct Params {
  const float* x; const int* pos;
  const float* even_w_in; const float* even_sinks; const float* even_w_out; const float* odd_w_in;
  const float* cmpk_pos; const float* cmpk_w1; const float* cmpk_w2; const float* cmpv_pos; const float* cmpv_w1; const float* cmpv_w2;
  const float* odd_w_out; const float* mix_g; const float* mix_b; const float* router_w; const float* router_b;
  const float* w_gate; const float* w_up; const float* w_down; const float* sh_gate; const float* sh_up; const float* sh_down;
  const float* ffn_g; const float* ffn_b;
  float* out;
  unsigned* bar; int* cnt; float* pb; float* dbg; float* cs; u16* xb; u16* qkv; float* gates; u16* ao; float* hpre;
  float* x1f; u16* x1b; u16* x1lo; float* logits; int* eidx; float* gatev; int* epos; int* etok;
  u16* hbuf; u16* ybuf; float* x2f; u16* hid; u16* cmpkv; unsigned long long* selmask;
};

#define XB_TMO      128
#define XB_XCNT(j)  (256  + 64 * (j))
#define XB_XSUB(j)  (1280 + 64 * (j))
#define XB_XGEN(j)  (2304 + 64 * (j))
#define XB_TOP      3328
#define XB_TOPGEN   3392
#define XCD_BAR_WORDS 3456
#define XB_SPIN_CAP (1u << 18)
#define LAS __attribute__((address_space(3)))

__device__ __forceinline__ unsigned xb_ld(unsigned* p)              { return __hip_atomic_load(p, __ATOMIC_RELAXED, __HIP_MEMORY_SCOPE_AGENT); }
__device__ __forceinline__ unsigned xb_add(unsigned* p, unsigned v) { return __hip_atomic_fetch_add(p, v, __ATOMIC_RELAXED, __HIP_MEMORY_SCOPE_AGENT); }
__device__ __forceinline__ unsigned xb_xcc_id() { return (unsigned)__builtin_amdgcn_s_getreg((3 << 11) | 20) & 0xFu; }
#define XB_SPIN(cond, bar) do { unsigned _sp = 0; while (cond) { __builtin_amdgcn_s_sleep(1); \
    if ((++_sp & 255u) == 0u) { if (xb_ld(&(bar)[XB_TMO])) break; if (_sp > XB_SPIN_CAP) { atomicAdd(&(bar)[XB_TMO], 1u); break; } } } } while (0)

struct XcdBarrier {
    unsigned* bar; unsigned x;
    volatile LAS unsigned* st;
};

__device__ __forceinline__ XcdBarrier xcd_barrier_post(unsigned* bar, volatile LAS unsigned* st) {
    XcdBarrier b; b.bar = bar; b.x = xb_xcc_id(); b.st = st;
    if (threadIdx.x == 0) (void)xb_add(&bar[XB_XCNT(b.x)], 1u);
    return b;
}
__device__ __forceinline__ void xcd_barrier_complete(unsigned* bar, unsigned x, unsigned& nloc, unsigned& nx) {
    const unsigned G = gridDim.x * gridDim.y * gridDim.z;
    unsigned sum, cnt, mine, sp = 0u;
    for (;;) {
        sum = 0u; cnt = 0u; mine = 0u;
#pragma unroll
        for (unsigned j = 0; j < 16; ++j) { const unsigned c = xb_ld(&bar[XB_XCNT(j)]); sum += c; cnt += (c > 0u) ? 1u : 0u; mine = (j == x) ? c : mine; }
        if (sum == G) break;
        __builtin_amdgcn_s_sleep(1);
        if ((++sp & 255u) == 0u) { if (xb_ld(&bar[XB_TMO])) break; if (sp > XB_SPIN_CAP) { atomicAdd(&bar[XB_TMO], 1u); break; } }
    }
    nloc = mine > 0u ? mine : 1u; nx = cnt > 0u ? cnt : 1u;
}

__device__ __forceinline__ void xcd_barrier(const XcdBarrier& b) {
    asm volatile("s_waitcnt vmcnt(0)" ::: "memory");
    __syncthreads();
    if (threadIdx.x == 0) {
        unsigned* bar = b.bar;
        __builtin_amdgcn_s_waitcnt(0);
        unsigned nloc = b.st[0], nx = b.st[1];
        if (nloc == 0u) { xcd_barrier_complete(bar, b.x, nloc, nx); b.st[0] = nloc; b.st[1] = nx; }
        const unsigned old = xb_add(&bar[XB_XSUB(b.x)], 1u);
        const unsigned gen = old / nloc;
        if (old + 1u == (gen + 1u) * nloc) {
            __builtin_amdgcn_fence(__ATOMIC_RELEASE, "agent");
            asm volatile("s_waitcnt vmcnt(0)" ::: "memory");
            const unsigned og = xb_add(&bar[XB_TOP], 1u);
            const unsigned tg = og / nx;
            if (og + 1u == (tg + 1u) * nx) xb_add(&bar[XB_TOPGEN], 1u);
            else XB_SPIN(xb_ld(&bar[XB_TOPGEN]) == tg, bar);
            __builtin_amdgcn_fence(__ATOMIC_ACQUIRE, "agent");
            xb_add(&bar[XB_XGEN(b.x)], 1u);
            asm volatile("s_waitcnt vmcnt(0)" ::: "memory");
        } else {
            XB_SPIN(xb_ld(&bar[XB_XGEN(b.x)]) == gen, bar);
            __builtin_amdgcn_fence(__ATOMIC_ACQUIRE, "agent");
            asm volatile("s_waitcnt vmcnt(0)" ::: "memory");
        }
    }
    __syncthreads();
}


DEV u16 f2bf(float f) { unsigned u = __float_as_uint(f); u += 0x7fffu + ((u >> 16) & 1u); return (u16)(u >> 16); }
DEV float bf2f(u16 h) { return __uint_as_float(((unsigned)h) << 16); }
DEV float bflo(unsigned w) { return __uint_as_float(w << 16); }
DEV float bfhi(unsigned w) { return __uint_as_float(w & 0xffff0000u); }
DEV unsigned pack2(float a, float b) { return (unsigned)f2bf(a) | ((unsigned)f2bf(b) << 16); }
DEV float wave_max(float v) { for (int o = 32; o; o >>= 1) v = fmaxf(v, __shfl_xor(v, o)); return v; }
DEV float wave_sum(float v) { for (int o = 32; o; o >>= 1) v += __shfl_xor(v, o); return v; }
#define WAVE_SYNC() asm volatile("s_waitcnt lgkmcnt(0)" ::: "memory")

struct GemmSmem { u16 A[2][128][40]; u16 B[2][128][40]; };

template <bool SPLIT, class FA, class FB, class FL, class FE>
DEV void gemm_core(GemmSmem& sm, int nk, FA a_addr, FB b_addr, int ldb, FL b_lo, FE epi) {
  const int tid = threadIdx.x, lane = tid & 63, wid = tid >> 6;
  const int wr = wid >> 1, wc = wid & 1, fr = lane & 15, fq = lane >> 4;
  f32x4 acc[4][4];
#pragma unroll
  for (int mi = 0; mi < 4; ++mi)
#pragma unroll
    for (int ni = 0; ni < 4; ++ni) acc[mi][ni] = f32x4{0.f, 0.f, 0.f, 0.f};
  uint4 ra[2]; float rb[2][8];
  auto gload = [&](int kt) {
    ra[0] = *reinterpret_cast<const uint4*>(a_addr(0, kt));
    ra[1] = *reinterpret_cast<const uint4*>(a_addr(1, kt));
#pragma unroll
    for (int cc = 0; cc < 2; ++cc) {
      const float* bp = b_addr(kt, cc);
      if (bp) {
#pragma unroll
        for (int i = 0; i < 8; ++i) rb[cc][i] = bp[(size_t)i * ldb];
      } else {
#pragma unroll
        for (int i = 0; i < 8; ++i) rb[cc][i] = 0.f;
      }
    }
  };
  auto sstore = [&](int buf, int kt) {
    *reinterpret_cast<uint4*>(&sm.A[buf][(tid >> 2)][(tid & 3) * 8]) = ra[0];
    *reinterpret_cast<uint4*>(&sm.A[buf][(tid >> 2) + 64][(tid & 3) * 8]) = ra[1];
    const bool lo = SPLIT ? b_lo(kt) : false;
#pragma unroll
    for (int cc = 0; cc < 2; ++cc) {
      float v[8];
#pragma unroll
      for (int i = 0; i < 8; ++i) { v[i] = rb[cc][i]; if (SPLIT && lo) v[i] = v[i] - bf2f(f2bf(v[i])); }
      uint4 w; w.x = pack2(v[0], v[1]); w.y = pack2(v[2], v[3]); w.z = pack2(v[4], v[5]); w.w = pack2(v[6], v[7]);
      *reinterpret_cast<uint4*>(&sm.B[buf][lane + 64 * cc][wid * 8]) = w;
    }
  };
  gload(0); sstore(0, 0); __syncthreads();
  for (int kt = 0; kt < nk; ++kt) {
    const int cur = kt & 1;
    if (kt + 1 < nk) gload(kt + 1);
    bf16x8 af[4], bf[4];
#pragma unroll
    for (int mi = 0; mi < 4; ++mi) af[mi] = *reinterpret_cast<const bf16x8*>(&sm.A[cur][wr * 64 + mi * 16 + fr][fq * 8]);
#pragma unroll
    for (int ni = 0; ni < 4; ++ni) bf[ni] = *reinterpret_cast<const bf16x8*>(&sm.B[cur][wc * 64 + ni * 16 + fr][fq * 8]);
#pragma unroll
    for (int mi = 0; mi < 4; ++mi)
#pragma unroll
      for (int ni = 0; ni < 4; ++ni) acc[mi][ni] = __builtin_amdgcn_mfma_f32_16x16x32_bf16(af[mi], bf[ni], acc[mi][ni], 0, 0, 0);
    if (kt + 1 < nk) sstore(cur ^ 1, kt + 1);
    __syncthreads();
  }
  epi(acc);
}

__constant__ float INVF[8] = {1.0f, 0.1939227432012558f, 0.03760603070259094f, 0.007292664609849453f, 0.0014142135623842478f,
                              0.00027424818836152554f, 5.3182957344688475e-05f, 1.0313385246263351e-05f};
DEV void ph_prologue(const Params& p) {
  const size_t gtid = (size_t)blockIdx.x * 256 + threadIdx.x, gsz = (size_t)gridDim.x * 256;
  for (size_t i = gtid; i < (size_t)T_ * D_ / 8; i += gsz) {
    const float4 a = reinterpret_cast<const float4*>(p.x)[2 * i], b = reinterpret_cast<const float4*>(p.x)[2 * i + 1];
    uint4 w; w.x = pack2(a.x, a.y); w.y = pack2(a.z, a.w); w.z = pack2(b.x, b.y); w.w = pack2(b.z, b.w);
    reinterpret_cast<uint4*>(p.xb)[i] = w;
  }
  for (size_t i = gtid; i < (size_t)T_ * 8; i += gsz) {
    const int t = (int)(i >> 3), f = (int)(i & 7);
    const float ang = (float)p.pos[t] * INVF[f];
    p.cs[t * 16 + f] = cosf(ang); p.cs[t * 16 + 8 + f] = sinf(ang);
  }
  for (size_t i = gtid; i < 2 * 128 * 16; i += gsz) {
    const int n = (int)(i & 127), kc = (int)((i >> 7) & 15), ts = (int)(i >> 11);
    const float* pe = ts ? p.cmpv_pos : p.cmpk_pos; const float* w1 = ts ? p.cmpv_w1 : p.cmpk_w1;
    float s = 0.f;
    for (int k = kc * 128; k < kc * 128 + 128; ++k) s += pe[k] * w1[(size_t)k * 128 + n];
    atomicAdd(&p.pb[ts * 128 + n], s);
  }
}

DEV void ph_inproj0(const Params& p, GemmSmem& sm) {
  const int tid = threadIdx.x, lane = tid & 63, wid = tid >> 6, wr = wid >> 1, wc = wid & 1, fr = lane & 15, fq = lane >> 4;
  constexpr int NT = LD0 / 128;
  for (int u = blockIdx.x; u < 128 * NT; u += gridDim.x) {
    const int mt = u / NT, nt = u % NT, m0 = mt * 128, n0 = nt * 128;
    const u16* ar0 = p.xb + (size_t)(m0 + (tid >> 2)) * D_ + (tid & 3) * 8;
    const u16* ar1 = ar0 + (size_t)64 * D_;
    auto a_addr = [&](int i, int kt) { return (i ? ar1 : ar0) + kt * 32; };
    const float* bb = p.even_w_in + (size_t)(wid * 8) * LD0 + n0 + lane;
    auto b_addr = [&](int kt, int cc) { return bb + (size_t)kt * 32 * LD0 + cc * 64; };
    auto b_lo = [&](int) { return false; };
    auto epi = [&](f32x4 (&acc)[4][4]) {
#pragma unroll
      for (int mi = 0; mi < 4; ++mi)
#pragma unroll
        for (int ni = 0; ni < 4; ++ni) {
          f32x4 v = acc[mi][ni];
          const int col = n0 + wc * 64 + ni * 16 + fr, rowb = m0 + wr * 64 + mi * 16 + fq * 4;
          const bool rope = (ni == 0) && (col < 1024 || (col >= 1536 && col < 2176));
          if (rope) {
#pragma unroll
            for (int j = 0; j < 4; ++j) {
              const float pv = __shfl_xor(v[j], 8);
              const float c_ = p.cs[(rowb + j) * 16 + (fr & 7)], s_ = p.cs[(rowb + j) * 16 + 8 + (fr & 7)];
              v[j] = (fr < 8) ? v[j] * c_ - pv * s_ : v[j] * c_ + pv * s_;
            }
          }
#pragma unroll
          for (int j = 0; j < 4; ++j) p.qkv[(size_t)(rowb + j) * LD0 + col] = f2bf(v[j]);
        }
    };
    gemm_core<false>(sm, 32, a_addr, b_addr, LD0, b_lo, epi);
  }
}

struct AttnSmem { float qs[4][64]; float sc[4][1040]; int tk[4][1040]; int tw[4][512]; };

DEV float wave_attn(const float* qs, float* sc, const int* tk, int n4, const u16* Kb, const u16* Vb, int ld, float sink, int lane, float (&o)[4]) {
  float mx = -INFINITY;
  for (int i = lane; i < n4; i += 64) {
    const int r = tk[i];
    float s = -INFINITY;
    if (r >= 0) {
      const uint4* kp = reinterpret_cast<const uint4*>(Kb + (size_t)r * ld);
      float a = 0.f;
#pragma unroll
      for (int c = 0; c < 8; ++c) {
        const uint4 kv = kp[c];
        const float4 q0 = reinterpret_cast<const float4*>(qs)[2 * c], q1 = reinterpret_cast<const float4*>(qs)[2 * c + 1];
        a += bflo(kv.x) * q0.x + bfhi(kv.x) * q0.y + bflo(kv.y) * q0.z + bfhi(kv.y) * q0.w
           + bflo(kv.z) * q1.x + bfhi(kv.z) * q1.y + bflo(kv.w) * q1.z + bfhi(kv.w) * q1.w;
      }
      s = a;
    }
    sc[i] = s; mx = fmaxf(mx, s);
  }
  mx = wave_max(mx);
  const float m = fmaxf(mx, sink);
  WAVE_SYNC();
  float sum = 0.f;
  if (m > -INFINITY) {
    for (int i = lane; i < n4; i += 64) { const float pz = __expf(sc[i] - m); sc[i] = pz; sum += pz; }
  } else {
    for (int i = lane; i < n4; i += 64) sc[i] = 0.f;
  }
  sum = wave_sum(sum);
  if (sink > -INFINITY) sum += __expf(sink - m);
  const float inv = sum > 0.f ? 1.f / sum : 0.f;
  WAVE_SYNC();
  const int kk = lane >> 4, dg = lane & 15;
  float a0 = 0.f, a1 = 0.f, a2 = 0.f, a3 = 0.f;
  for (int i = kk; i < n4; i += 4) {
    const float pz = sc[i];
    if (pz != 0.f) {
      const int r = tk[i];
      const uint2 v = *reinterpret_cast<const uint2*>(Vb + (size_t)r * ld + dg * 4);
      a0 += pz * bflo(v.x); a1 += pz * bfhi(v.x); a2 += pz * bflo(v.y); a3 += pz * bfhi(v.y);
    }
  }
  a0 += __shfl_xor(a0, 16); a1 += __shfl_xor(a1, 16); a2 += __shfl_xor(a2, 16); a3 += __shfl_xor(a3, 16);
  a0 += __shfl_xor(a0, 32); a1 += __shfl_xor(a1, 32); a2 += __shfl_xor(a2, 32); a3 += __shfl_xor(a3, 32);
  o[0] = a0 * inv; o[1] = a1 * inv; o[2] = a2 * inv; o[3] = a3 * inv;
  return inv;
}

DEV void ph_attn0(const Params& p, AttnSmem& sm) {
  const int tid = threadIdx.x, lane = tid & 63, wid = tid >> 6;
  float* qs = sm.qs[wid]; float* sc = sm.sc[wid]; int* tk = sm.tk[wid];
  const int gw = blockIdx.x * 4 + wid, nw = gridDim.x * 4;
  for (int u = gw; u < T_ * 16; u += nw) {
    const int tg = u >> 4, h = u & 15, b = tg >> 12, t = tg & 4095;
    const u16* row = p.qkv + (size_t)tg * LD0;
    int qcol, kcol, vcol, n; float sink = -INFINITY;
    if (h < 8) {
      qcol = h * 64; kcol = 512 + h * 64; vcol = 1024 + h * 64;
      for (int i = lane; i < 388; i += 64) {
        int r = -1;
        if (i < 387) { const int pi = i / 129, k = i - pi * 129; const int dil = pi == 0 ? 1 : (pi == 1 ? 4 : 16); const int tok = t - k * dil; if (tok >= 0) r = b * S_ + tok; }
        tk[i] = r;
      }
      n = 388;
    } else {
      const int hb = h - 8, g = hb >> 2;
      qcol = 1536 + hb * 64; kcol = 2048 + g * 64; vcol = 2176 + g * 64; sink = p.even_sinks[hb];
      for (int i = lane; i < 128; i += 64) { const int tok = t - i; tk[i] = tok >= 0 ? b * S_ + tok : -1; }
      n = 128;
    }
    qs[lane] = bf2f(row[qcol + lane]) * 0.125f;
    WAVE_SYNC();
    float o[4];
    wave_attn(qs, sc, tk, n, p.qkv + kcol, p.qkv + vcol, LD0, sink, lane, o);
    if (lane < 16) { uint2 w; w.x = pack2(o[0], o[1]); w.y = pack2(o[2], o[3]); *reinterpret_cast<uint2*>(p.ao + (size_t)tg * D_ + h * 64 + lane * 4) = w; }
    WAVE_SYNC();
  }
}

DEV void ph_outproj(const Params& p, GemmSmem& sm, const float* W, const float* resid) {
  const int tid = threadIdx.x, lane = tid & 63, wid = tid >> 6, wr = wid >> 1, wc = wid & 1, fr = lane & 15, fq = lane >> 4;
  for (int u = blockIdx.x; u < 128 * 8; u += gridDim.x) {
    const int mt = u >> 3, nt = u & 7, m0 = mt * 128, n0 = nt * 128;
    const u16* ar0 = p.ao + (size_t)(m0 + (tid >> 2)) * D_ + (tid & 3) * 8;
    const u16* ar1 = ar0 + (size_t)64 * D_;
    auto a_addr = [&](int i, int kt) { return (i ? ar1 : ar0) + kt * 32; };
    const float* bb = W + (size_t)(wid * 8) * D_ + n0 + lane;
    auto b_addr = [&](int kt, int cc) { return bb + (size_t)kt * 32 * D_ + cc * 64; };
    auto b_lo = [&](int) { return false; };
    auto epi = [&](f32x4 (&acc)[4][4]) {
#pragma unroll
      for (int mi = 0; mi < 4; ++mi)
#pragma unroll
        for (int ni = 0; ni < 4; ++ni)
#pragma unroll
          for (int j = 0; j < 4; ++j) {
            const size_t idx = (size_t)(m0 + wr * 64 + mi * 16 + fq * 4 + j) * D_ + n0 + wc * 64 + ni * 16 + fr;
            p.hpre[idx] = ALPHA * resid[idx] + acc[mi][ni][j];
          }
    };
    gemm_core<false>(sm, 32, a_addr, b_addr, D_, b_lo, epi);
  }
}

DEV void ph_ln_mix(const Params& p, const float* g, const float* bt) {
  const int lane = threadIdx.x & 63, gw = blockIdx.x * 4 + (threadIdx.x >> 6), nw = gridDim.x * 4;
  for (int tok = gw; tok < T_; tok += nw) {
    float4 v[4]; float s = 0.f;
#pragma unroll
    for (int i = 0; i < 4; ++i) { v[i] = reinterpret_cast<const float4*>(p.hpre + (size_t)tok * D_)[i * 64 + lane]; s += v[i].x + v[i].y + v[i].z + v[i].w; }
    const float mu = wave_sum(s) * (1.f / D_);
    float ss = 0.f;
#pragma unroll
    for (int i = 0; i < 4; ++i) { v[i].x -= mu; v[i].y -= mu; v[i].z -= mu; v[i].w -= mu; ss += v[i].x * v[i].x + v[i].y * v[i].y + v[i].z * v[i].z + v[i].w * v[i].w; }
    const float rstd = rsqrtf(wave_sum(ss) * (1.f / D_) + LN_EPS);
#pragma unroll
    for (int i = 0; i < 4; ++i) {
      const float4 gg = reinterpret_cast<const float4*>(g)[i * 64 + lane], bb = reinterpret_cast<const float4*>(bt)[i * 64 + lane];
      float4 y; y.x = v[i].x * rstd * gg.x + bb.x; y.y = v[i].y * rstd * gg.y + bb.y; y.z = v[i].z * rstd * gg.z + bb.z; y.w = v[i].w * rstd * gg.w + bb.w;
      reinterpret_cast<float4*>(p.x1f + (size_t)tok * D_)[i * 64 + lane] = y;
      const u16 h0 = f2bf(y.x), h1 = f2bf(y.y), h2 = f2bf(y.z), h3 = f2bf(y.w);
      uint2 hi; hi.x = (unsigned)h0 | ((unsigned)h1 << 16); hi.y = (unsigned)h2 | ((unsigned)h3 << 16);
      uint2 lo; lo.x = pack2(y.x - bf2f(h0), y.y - bf2f(h1)); lo.y = pack2(y.z - bf2f(h2), y.w - bf2f(h3));
      reinterpret_cast<uint2*>(p.x1b + (size_t)tok * D_)[i * 64 + lane] = hi;
      reinterpret_cast<uint2*>(p.x1lo + (size_t)tok * D_)[i * 64 + lane] = lo;
    }
  }
}

DEV void ph_router_gemm(const Params& p, GemmSmem& sm, const float* RW) {
  const int tid = threadIdx.x, lane = tid & 63, wid = tid >> 6, wr = wid >> 1, wc = wid & 1, fr = lane & 15, fq = lane >> 4;
  for (int u = blockIdx.x; u < 128 * 2; u += gridDim.x) {
    const int mt = u >> 1, nt = u & 1, m0 = mt * 128, n0 = nt * 128;
    const size_t ao0 = (size_t)(m0 + (tid >> 2)) * D_ + (tid & 3) * 8, ao1 = ao0 + (size_t)64 * D_;
    auto a_addr = [&](int i, int kt) { const u16* base = ((kt >> 5) == 1) ? p.x1lo : p.x1b; return base + (i ? ao1 : ao0) + (kt & 31) * 32; };
    const float* bb = RW + (size_t)(wid * 8) * NE + n0 + lane;
    auto b_addr = [&](int kt, int cc) { return bb + (size_t)(kt & 31) * 32 * NE + cc * 64; };
    auto b_lo = [&](int kt) { return kt >= 64; };
    auto epi = [&](f32x4 (&acc)[4][4]) {
#pragma unroll
      for (int mi = 0; mi < 4; ++mi)
#pragma unroll
        for (int ni = 0; ni < 4; ++ni)
#pragma unroll
          for (int j = 0; j < 4; ++j)
            p.logits[(size_t)(m0 + wr * 64 + mi * 16 + fq * 4 + j) * NE + n0 + wc * 64 + ni * 16 + fr] = acc[mi][ni][j];
    };
    gemm_core<true>(sm, 96, a_addr, b_addr, NE, b_lo, epi);
  }
}

template <bool NAIVE_LG> DEV void ph_route(const Params& p, const float* rbias, int* cnt, const float* RW, int* etok) {
  const int lane = threadIdx.x & 63, gw = blockIdx.x * 4 + (threadIdx.x >> 6), nw = gridDim.x * 4;
  const int half = lane >> 5;
  for (int tok = gw; tok < T_; tok += nw) {
    float aff[4], val[4];
    float lgn[4] = {0.f, 0.f, 0.f, 0.f};
    if (NAIVE_LG) {
      for (int k = 0; k < D_; ++k) {
        const float xv = p.x1f[(size_t)tok * D_ + k];
#pragma unroll
        for (int j = 0; j < 4; ++j) lgn[j] += xv * RW[(size_t)k * NE + lane + 64 * j];
      }
    }
#pragma unroll
    for (int j = 0; j < 4; ++j) {
      const float lg = NAIVE_LG ? lgn[j] : p.logits[(size_t)tok * NE + lane + 64 * j];
      aff[j] = 1.f / (1.f + expf(-lg));
      val[j] = aff[j] + rbias[lane + 64 * j];
    }
    float gs[8];
#pragma unroll
    for (int j = 0; j < 4; ++j) {
      float m1 = val[j];
#pragma unroll
      for (int o = 16; o; o >>= 1) m1 = fmaxf(m1, __shfl_xor(m1, o));
      const unsigned long long eq = __ballot(val[j] == m1);
      const int ceq = __popc((unsigned)(half ? (eq >> 32) : (eq & 0xffffffffull)));
      float m2 = (val[j] == m1) ? -INFINITY : val[j];
#pragma unroll
      for (int o = 16; o; o >>= 1) m2 = fmaxf(m2, __shfl_xor(m2, o));
      if (ceq >= 2) m2 = m1;
      const float mine = m1 + m2, other = __shfl_xor(mine, 32);
      gs[2 * j] = half ? other : mine; gs[2 * j + 1] = half ? mine : other;
    }
    bool gok[8];
#pragma unroll
    for (int g = 0; g < 8; ++g) {
      int rk = 0;
#pragma unroll
      for (int g2 = 0; g2 < 8; ++g2) rk += (gs[g2] > gs[g] || (gs[g2] == gs[g] && g2 < g)) ? 1 : 0;
      gok[g] = rk < 4;
    }
#pragma unroll
    for (int j = 0; j < 4; ++j) { const bool ok = half ? gok[2 * j + 1] : gok[2 * j]; if (!ok) val[j] = -INFINITY; }
    int my_e = 0; float my_a = 0.f, asum = 0.f;
#pragma unroll
    for (int k = 0; k < TOPK; ++k) {
      float bv = val[0]; int bi = lane;
#pragma unroll
      for (int j = 1; j < 4; ++j) if (val[j] > bv) { bv = val[j]; bi = lane + 64 * j; }
#pragma unroll
      for (int o = 32; o; o >>= 1) {
        const float ov = __shfl_xor(bv, o); const int oi = __shfl_xor(bi, o);
        if (ov > bv || (ov == bv && oi < bi)) { bv = ov; bi = oi; }
      }
      float a_sel = 0.f;
#pragma unroll
      for (int j = 0; j < 4; ++j) { const bool hit = (bi == lane + 64 * j); a_sel = hit ? aff[j] : a_sel; val[j] = hit ? -INFINITY : val[j]; }
      a_sel = wave_sum(a_sel);
      asum += a_sel;
      if (lane == k) { my_e = bi; my_a = a_sel; }
    }
    if (lane < TOPK) {
      const int ps = atomicAdd(&cnt[my_e], 1);
      p.eidx[tok * TOPK + lane] = my_e; p.epos[tok * TOPK + lane] = ps; p.gatev[tok * TOPK + lane] = my_a / asum * 2.5f;
      etok[(size_t)my_e * T_ + ps] = tok;
    }
  }
}

struct MoeTab { int cn[260]; int of[260]; int tf[260]; };
DEV void moe_prep(MoeTab& mt, const int* cnt) {
  const int tid = threadIdx.x;
  mt.cn[tid] = cnt[tid];
  __syncthreads();
  if (tid == 0) {
    int a = 0, tl = 0;
    for (int e = 0; e < NE; ++e) { mt.of[e] = a; mt.tf[e] = tl; a += mt.cn[e]; tl += (mt.cn[e] + 127) >> 7; }
    mt.cn[NE] = T_; mt.of[NE] = NASG; mt.tf[NE] = tl; mt.of[NE + 1] = NASG + T_; mt.tf[NE + 1] = tl + T_ / 128;
  }
  __syncthreads();
}
DEV int moe_find(const MoeTab& mt, int mtile) {
  int lo = 0, hi = NE;
  while (lo < hi) { const int mid = (lo + hi + 1) >> 1; if (mt.tf[mid] <= mtile) lo = mid; else hi = mid - 1; }
  return lo;
}

DEV void ph_moe1(const Params& p, GemmSmem& sm, MoeTab& mt, int layer, const int* cnt) {
  const int tid = threadIdx.x, lane = tid & 63, wid = tid >> 6, wr = wid >> 1, wc = wid & 1, fr = lane & 15, fq = lane >> 4;
  moe_prep(mt, cnt);
  const int nunits = mt.tf[NE + 1] * 4;
  for (int u = blockIdx.x; u < nunits; u += gridDim.x) {
    int lo = 0, hi = NE;
    while (lo < hi) { const int mid = (lo + hi + 1) >> 1; if (4 * mt.tf[mid] <= u) lo = mid; else hi = mid - 1; }
    const int e = lo, tiles = mt.tf[e + 1] - mt.tf[e], local = u - 4 * mt.tf[e];
    const int nt = local / tiles, mtl = local % tiles, cn = mt.cn[e], of = mt.of[e];
    int i0 = mtl * 128 + (tid >> 2), i1 = i0 + 64;
    i0 = i0 < cn ? i0 : cn - 1; i1 = i1 < cn ? i1 : cn - 1;
    const int tk0 = e < NE ? p.etok[(size_t)e * T_ + i0] : i0, tk1 = e < NE ? p.etok[(size_t)e * T_ + i1] : i1;
    const u16* ar0 = p.x1b + (size_t)tk0 * D_ + (tid & 3) * 8;
    const u16* ar1 = p.x1b + (size_t)tk1 * D_ + (tid & 3) * 8;
    auto a_addr = [&](int i, int kt) { return (i ? ar1 : ar0) + kt * 32; };
    const float* wg = e < NE ? p.w_gate + ((size_t)layer * NE + e) * D_ * 256 : p.sh_gate + (size_t)layer * D_ * 256;
    const float* wu = e < NE ? p.w_up + ((size_t)layer * NE + e) * D_ * 256 : p.sh_up + (size_t)layer * D_ * 256;
    const float* bb = (lane >= 32 ? wu : wg) + (size_t)(wid * 8) * 256 + nt * 64 + (lane & 31);
    auto b_addr = [&](int kt, int cc) { return bb + (size_t)kt * 32 * 256 + cc * 32; };
    auto b_lo = [&](int) { return false; };
    auto epi = [&](f32x4 (&acc)[4][4]) {
#pragma unroll
      for (int mi = 0; mi < 4; ++mi)
#pragma unroll
        for (int n2 = 0; n2 < 2; ++n2)
#pragma unroll
          for (int j = 0; j < 4; ++j) {
            const float g = acc[mi][n2][j], uu = acc[mi][n2 + 2][j];
            const float hval = g / (1.f + __expf(-g)) * uu;
            const int idx = mtl * 128 + wr * 64 + mi * 16 + fq * 4 + j;
            if (idx < cn) p.hbuf[(size_t)(of + idx) * 256 + nt * 64 + wc * 32 + n2 * 16 + fr] = f2bf(hval);
          }
    };
    gemm_core<false>(sm, 32, a_addr, b_addr, 256, b_lo, epi);
  }
}

DEV void ph_moe2(const Params& p, GemmSmem& sm, MoeTab& mt, int layer, const int* cnt) {
  const int tid = threadIdx.x, lane = tid & 63, wid = tid >> 6, wr = wid >> 1, wc = wid & 1, fr = lane & 15, fq = lane >> 4;
  moe_prep(mt, cnt);
  const int nunits = mt.tf[NE + 1] * 8;
  for (int u = blockIdx.x; u < nunits; u += gridDim.x) {
    int lo = 0, hi = NE;
    while (lo < hi) { const int mid = (lo + hi + 1) >> 1; if (8 * mt.tf[mid] <= u) lo = mid; else hi = mid - 1; }
    const int e = lo, tiles = mt.tf[e + 1] - mt.tf[e], local = u - 8 * mt.tf[e];
    const int nt = local / tiles, mtl = local % tiles, cn = mt.cn[e], of = mt.of[e];
    int i0 = mtl * 128 + (tid >> 2), i1 = i0 + 64;
    i0 = i0 < cn ? i0 : cn - 1; i1 = i1 < cn ? i1 : cn - 1;
    const u16* ar0 = p.hbuf + (size_t)(of + i0) * 256 + (tid & 3) * 8;
    const u16* ar1 = p.hbuf + (size_t)(of + i1) * 256 + (tid & 3) * 8;
    auto a_addr = [&](int i, int kt) { return (i ? ar1 : ar0) + kt * 32; };
    const float* wd = e < NE ? p.w_down + ((size_t)layer * NE + e) * 256 * D_ : p.sh_down + (size_t)layer * 256 * D_;
    const float* bb = wd + (size_t)(wid * 8) * D_ + nt * 128 + lane;
    auto b_addr = [&](int kt, int cc) { return bb + (size_t)kt * 32 * D_ + cc * 64; };
    auto b_lo = [&](int) { return false; };
    auto epi = [&](f32x4 (&acc)[4][4]) {
#pragma unroll
      for (int mi = 0; mi < 4; ++mi)
#pragma unroll
        for (int ni = 0; ni < 4; ++ni)
#pragma unroll
          for (int j = 0; j < 4; ++j) {
            const int idx = mtl * 128 + wr * 64 + mi * 16 + fq * 4 + j;
            if (idx < cn) p.ybuf[(size_t)(of + idx) * D_ + nt * 128 + wc * 64 + ni * 16 + fr] = f2bf(acc[mi][ni][j]);
          }
    };
    gemm_core<false>(sm, 8, a_addr, b_addr, D_, b_lo, epi);
  }
}

DEV void ph_combine_ln(const Params& p, MoeTab& mt, const int* cnt, const float* g, const float* bt, float* outf, u16* outb, bool with_ffn) {
  const int lane = threadIdx.x & 63, gw = blockIdx.x * 4 + (threadIdx.x >> 6), nw = gridDim.x * 4;
  moe_prep(mt, cnt);
  for (int tok = gw; tok < T_; tok += nw) {
    float4 v[4];
#pragma unroll
    for (int i = 0; i < 4; ++i) {
      v[i] = reinterpret_cast<const float4*>(p.x1f + (size_t)tok * D_)[i * 64 + lane];
      v[i].x *= ALPHA; v[i].y *= ALPHA; v[i].z *= ALPHA; v[i].w *= ALPHA;
    }
    if (with_ffn) {
#if FFN_MODE != 2
#pragma unroll
      for (int i = 0; i < 4; ++i) {
        const uint2 y = reinterpret_cast<const uint2*>(p.ybuf + (size_t)(NASG + tok) * D_)[i * 64 + lane];
        v[i].x += bflo(y.x); v[i].y += bfhi(y.x); v[i].z += bflo(y.y); v[i].w += bfhi(y.y);
      }
#endif
#if FFN_MODE != 1
      for (int k = 0; k < TOPK; ++k) {
        const int sl = mt.of[p.eidx[tok * TOPK + k]] + p.epos[tok * TOPK + k]; const float gk = p.gatev[tok * TOPK + k];
#pragma unroll
        for (int i = 0; i < 4; ++i) {
          const uint2 y = reinterpret_cast<const uint2*>(p.ybuf + (size_t)sl * D_)[i * 64 + lane];
          v[i].x += gk * bflo(y.x); v[i].y += gk * bfhi(y.x); v[i].z += gk * bflo(y.y); v[i].w += gk * bfhi(y.y);
        }
      }
#endif
    }
    float s = 0.f;
#pragma unroll
    for (int i = 0; i < 4; ++i) s += v[i].x + v[i].y + v[i].z + v[i].w;
    const float mu = wave_sum(s) * (1.f / D_);
    float ss = 0.f;
#pragma unroll
    for (int i = 0; i < 4; ++i) { v[i].x -= mu; v[i].y -= mu; v[i].z -= mu; v[i].w -= mu; ss += v[i].x * v[i].x + v[i].y * v[i].y + v[i].z * v[i].z + v[i].w * v[i].w; }
    const float rstd = rsqrtf(wave_sum(ss) * (1.f / D_) + LN_EPS);
#pragma unroll
    for (int i = 0; i < 4; ++i) {
      const float4 gg = reinterpret_cast<const float4*>(g)[i * 64 + lane], bb = reinterpret_cast<const float4*>(bt)[i * 64 + lane];
      float4 y; y.x = v[i].x * rstd * gg.x + bb.x; y.y = v[i].y * rstd * gg.y + bb.y; y.z = v[i].z * rstd * gg.z + bb.z; y.w = v[i].w * rstd * gg.w + bb.w;
      reinterpret_cast<float4*>(outf + (size_t)tok * D_)[i * 64 + lane] = y;
      uint2 hi; hi.x = pack2(y.x, y.y); hi.y = pack2(y.z, y.w);
      reinterpret_cast<uint2*>(outb + (size_t)tok * D_)[i * 64 + lane] = hi;
    }
  }
}

DEV void ph_inproj1(const Params& p, GemmSmem& sm) {
  const int tid = threadIdx.x, lane = tid & 63, wid = tid >> 6, wr = wid >> 1, wc = wid & 1, fr = lane & 15, fq = lane >> 4;
  constexpr int NT = 21;
  for (int u = blockIdx.x; u < 128 * NT; u += gridDim.x) {
    const int mt = u / NT, nt = u % NT, m0 = mt * 128, n0 = nt * 128;
    const u16* ar0 = p.xb + (size_t)(m0 + (tid >> 2)) * D_ + (tid & 3) * 8;
    const u16* ar1 = ar0 + (size_t)64 * D_;
    auto a_addr = [&](int i, int kt) { return (i ? ar1 : ar0) + kt * 32; };
    const float* bb = p.odd_w_in + (size_t)(wid * 8) * NIN1 + n0 + lane;
    auto b_addr = [&](int kt, int cc) -> const float* { return (n0 + lane + cc * 64 < NIN1) ? bb + (size_t)kt * 32 * NIN1 + cc * 64 : nullptr; };
    auto b_lo = [&](int) { return false; };
    auto epi = [&](f32x4 (&acc)[4][4]) {
#pragma unroll
      for (int mi = 0; mi < 4; ++mi)
#pragma unroll
        for (int ni = 0; ni < 4; ++ni) {
          f32x4 v = acc[mi][ni];
          const int col = n0 + wc * 64 + ni * 16 + fr, rowb = m0 + wr * 64 + mi * 16 + fq * 4;
          const bool rope = (ni == 0) && (col < 1280 || (col >= 1536 && col < 1792) || (col >= 2048 && col < 2304));
          if (rope) {
#pragma unroll
            for (int j = 0; j < 4; ++j) {
              const float pv = __shfl_xor(v[j], 8);
              const float c_ = p.cs[(rowb + j) * 16 + (fr & 7)], s_ = p.cs[(rowb + j) * 16 + 8 + (fr & 7)];
              v[j] = (fr < 8) ? v[j] * c_ - pv * s_ : v[j] * c_ + pv * s_;
            }
          }
          if (col < LD1) {
#pragma unroll
            for (int j = 0; j < 4; ++j) p.qkv[(size_t)(rowb + j) * LD1 + col] = f2bf(v[j]);
          } else if (col < NIN1) {
#pragma unroll
            for (int j = 0; j < 4; ++j) p.gates[(size_t)(rowb + j) * 48 + (col - LD1)] = 1.f / (1.f + __expf(-v[j]));
          }
        }
    };
    gemm_core<false>(sm, 32, a_addr, b_addr, NIN1, b_lo, epi);
  }
}

DEV float gelu_tanh(float x) { const float u = 0.7978845608028654f * (x + 0.044715f * x * x * x); return 0.5f * x * (1.f + tanhf(u)); }
DEV void ph_cmp1(const Params& p, GemmSmem& sm) {
  const int tid = threadIdx.x, lane = tid & 63, wid = tid >> 6, wr = wid >> 1, wc = wid & 1, fr = lane & 15, fq = lane >> 4;
  for (int u = blockIdx.x; u < 64; u += gridDim.x) {
    const int ts = u >> 5, mt = u & 31, m0 = mt * 128;
    const u16* ar[2];
#pragma unroll
    for (int i = 0; i < 2; ++i) {
      const int m = m0 + (tid >> 2) + 64 * i, bg = m >> 8; int c = m & 255; c = c < 255 ? c : 254;
      ar[i] = p.qkv + (size_t)((bg >> 2) * S_ + 16 * c) * LD1 + (ts ? 1280 : 1024) + (bg & 3) * 64 + (tid & 3) * 8;
    }
    auto a_addr = [&](int i, int kt) { return (i ? ar[1] : ar[0]) + (size_t)(kt >> 1) * LD1 + (kt & 1) * 32; };
    const float* bb = (ts ? p.cmpv_w1 : p.cmpk_w1) + (size_t)(wid * 8) * 128 + lane;
    auto b_addr = [&](int kt, int cc) { return bb + (size_t)kt * 32 * 128 + cc * 64; };
    auto b_lo = [&](int) { return false; };
    auto epi = [&](f32x4 (&acc)[4][4]) {
#pragma unroll
      for (int mi = 0; mi < 4; ++mi)
#pragma unroll
        for (int ni = 0; ni < 4; ++ni)
#pragma unroll
          for (int j = 0; j < 4; ++j) {
            const int m = m0 + wr * 64 + mi * 16 + fq * 4 + j, col = wc * 64 + ni * 16 + fr;
            p.hid[((size_t)ts * 4096 + m) * 128 + col] = f2bf(gelu_tanh(acc[mi][ni][j] + p.pb[ts * 128 + col]));
          }
    };
    gemm_core<false>(sm, 64, a_addr, b_addr, 128, b_lo, epi);
  }
}
DEV void ph_cmp2(const Params& p, GemmSmem& sm) {
  const int tid = threadIdx.x, lane = tid & 63, wid = tid >> 6, wr = wid >> 1, wc = wid & 1, fr = lane & 15, fq = lane >> 4;
  for (int u = blockIdx.x; u < 64; u += gridDim.x) {
    const int ts = u >> 5, mt = u & 31, m0 = mt * 128;
    const u16* ar0 = p.hid + ((size_t)ts * 4096 + m0 + (tid >> 2)) * 128 + (tid & 3) * 8;
    const u16* ar1 = ar0 + (size_t)64 * 128;
    auto a_addr = [&](int i, int kt) { return (i ? ar1 : ar0) + kt * 32; };
    const float* bb = (ts ? p.cmpv_w2 : p.cmpk_w2) + (size_t)(wid * 8) * 64 + lane;
    auto b_addr = [&](int kt, int cc) -> const float* { return cc == 0 ? bb + (size_t)kt * 32 * 64 : nullptr; };
    auto b_lo = [&](int) { return false; };
    auto epi = [&](f32x4 (&acc)[4][4]) {
      if (wc == 0) {
#pragma unroll
        for (int mi = 0; mi < 4; ++mi)
#pragma unroll
          for (int ni = 0; ni < 4; ++ni)
#pragma unroll
            for (int j = 0; j < 4; ++j) {
              const int m = m0 + wr * 64 + mi * 16 + fq * 4 + j, col = ni * 16 + fr;
              p.cmpkv[((size_t)ts * 4096 + m) * 64 + col] = f2bf(acc[mi][ni][j]);
            }
      }
    };
    gemm_core<false>(sm, 4, a_addr, b_addr, 64, b_lo, epi);
  }
}

DEV void ph_attn1(const Params& p, AttnSmem& sm) {
  const int tid = threadIdx.x, lane = tid & 63, wid = tid >> 6;
  float* qs = sm.qs[wid]; float* sc = sm.sc[wid]; int* tk = sm.tk[wid]; int* tw = sm.tw[wid];
  const int gw = blockIdx.x * 4 + wid, nw = gridDim.x * 4;
  for (int u = gw; u < T_ * 4; u += nw) {
    const int tg = u >> 2, g = u & 3, b = tg >> 12, t = tg & 4095, cur = t >> 6;
    const u16* row = p.qkv + (size_t)tg * LD1;
    const int nvalid = t >= 31 ? (((t - 31) >> 4) + 1 < 255 ? ((t - 31) >> 4) + 1 : 255) : 0;
    const int n4c = (nvalid + 3) & ~3;
    const u16* kc = p.cmpkv + (size_t)((b * 4 + g) * 256) * 64;
    const u16* vc = p.cmpkv + (size_t)(4096 + (b * 4 + g) * 256) * 64;
    float imp = 0.f;
    float ocmp[4][4];
#pragma unroll
    for (int r = 0; r < 4; ++r) {
      ocmp[r][0] = ocmp[r][1] = ocmp[r][2] = ocmp[r][3] = 0.f;
      if (nvalid > 0) {
        qs[lane] = bf2f(row[(g * 4 + r) * 64 + lane]) * 0.125f;
        for (int i = lane; i < n4c; i += 64) tk[i] = i < nvalid ? i : -1;
        WAVE_SYNC();
        const float inv = wave_attn(qs, sc, tk, n4c, kc, vc, 64, -INFINITY, lane, ocmp[r]);
        WAVE_SYNC();
        float a = 0.f;
        const int c0 = 4 * lane;
        if (c0 - 1 >= 0 && c0 - 1 < nvalid) a += 0.5f * sc[c0 - 1];
        if (c0 < nvalid) a += sc[c0];
        if (c0 + 1 < nvalid) a += sc[c0 + 1];
        if (c0 + 2 < nvalid) a += sc[c0 + 2];
        if (c0 + 3 < nvalid) a += 0.5f * sc[c0 + 3];
        imp += a * inv;
        WAVE_SYNC();
      }
    }
    const float score = (lane > cur) ? -1.f : ((lane == 0 || lane == cur || lane == cur - 1) ? 1.0e4f : imp);
    int rk = 0;
    for (int jj = 0; jj < 64; ++jj) { const float sj = __shfl(score, jj); rk += (sj > score || (sj == score && jj < lane)) ? 1 : 0; }
    unsigned long long mask = __ballot(rk < 16 && lane <= cur);
    int nsel = 0;
    while (mask) {
      const int j = __ffsll((long long)mask) - 1; mask &= mask - 1;
      const int tok = j * 64 + lane;
      tk[nsel * 64 + lane] = tok <= t ? b * S_ + tok : -1;
      ++nsel;
    }
    for (int i = lane; i < 512; i += 64) { const int tok = t - i; tw[i] = tok >= 0 ? b * S_ + tok : -1; }
    WAVE_SYNC();
#pragma unroll
    for (int r = 0; r < 4; ++r) {
      const int h = g * 4 + r;
      qs[lane] = bf2f(row[h * 64 + lane]) * 0.125f;
      WAVE_SYNC();
      float os[4], ow[4];
      wave_attn(qs, sc, tk, nsel * 64, p.qkv + 1536 + g * 64, p.qkv + 1792 + g * 64, LD1, -INFINITY, lane, os);
      WAVE_SYNC();
      wave_attn(qs, sc, tw, 512, p.qkv + 2048 + g * 64, p.qkv + 2304 + g * 64, LD1, -INFINITY, lane, ow);
      const float g0 = p.gates[(size_t)tg * 48 + h * 3], g1 = p.gates[(size_t)tg * 48 + h * 3 + 1], g2 = p.gates[(size_t)tg * 48 + h * 3 + 2];
      if (lane < 16) {
        uint2 w;
        w.x = pack2(g0 * ocmp[r][0] + g1 * os[0] + g2 * ow[0], g0 * ocmp[r][1] + g1 * os[1] + g2 * ow[1]);
        w.y = pack2(g0 * ocmp[r][2] + g1 * os[2] + g2 * ow[2], g0 * ocmp[r][3] + g1 * os[3] + g2 * ow[3]);
        *reinterpret_cast<uint2*>(p.ao + (size_t)tg * D_ + h * 64 + lane * 4) = w;
      }
      WAVE_SYNC();
    }
  }
}


using f32x16 = __attribute__((ext_vector_type(16))) float;
typedef short v4i16_t __attribute__((ext_vector_type(4)));
typedef float f32x2_t __attribute__((ext_vector_type(2)));
typedef __bf16 bf16x2_t __attribute__((ext_vector_type(2)));
typedef unsigned u32x4_t __attribute__((ext_vector_type(4)));
DEV unsigned cvtpk(float lo, float hi) { f32x2_t v = {lo, hi}; bf16x2_t b = __builtin_convertvector(v, bf16x2_t); return __builtin_bit_cast(unsigned, b); }
DEV v4i16_t lds_tr(const u16* ptr) { return __builtin_amdgcn_ds_read_tr16_b64_v4i16((LAS v4i16_t*)ptr); }
DEV int crow(int r, int hi) { return (r & 3) + 8 * (r >> 2) + 4 * hi; }
constexpr float LOG2E = 1.4426950408889634f;
constexpr float SCL2 = 0.125f * LOG2E;

struct WaveTile { u16 K[32][72]; u16 V[2][32][32]; float imp[32][64]; unsigned long long msk[32]; };
struct AttnState { float m, l; f32x16 o[2]; };

DEV void stage_load(u32x4_t (&rk)[4], u32x4_t (&rv)[4], const u16* Kb, const u16* Vb, int ld, long rowbase, int rowstep, int kcmax, int k0, int lane) {
#pragma unroll
  for (int it = 0; it < 4; ++it) {
    int kc = k0 + (lane >> 3) + 8 * it; kc = kc > kcmax ? kcmax : kc;
    const long row = rowbase + (long)kc * rowstep;
    rk[it] = *reinterpret_cast<const u32x4_t*>(Kb + row * ld + (lane & 7) * 8);
    rv[it] = *reinterpret_cast<const u32x4_t*>(Vb + row * ld + (lane & 7) * 8);
  }
}
DEV void stage_store(WaveTile& wt, const u32x4_t (&rk)[4], const u32x4_t (&rv)[4], int lane) {
  const int ch = lane & 7;
#pragma unroll
  for (int it = 0; it < 4; ++it) {
    const int j = (lane >> 3) + 8 * it;
    *reinterpret_cast<u32x4_t*>(&wt.K[j][ch * 8]) = rk[it];
    *reinterpret_cast<u32x4_t*>(&wt.V[ch >> 2][j][(ch & 3) * 8]) = rv[it];
  }
}
DEV f32x16 qk_tile(const WaveTile& wt, const bf16x8 (&qf)[4], int r32, int hi) {
  f32x16 acc;
#pragma unroll
  for (int r = 0; r < 16; ++r) acc[r] = 0.f;
#pragma unroll
  for (int s = 0; s < 4; ++s) {
    const bf16x8 kf = *reinterpret_cast<const bf16x8*>(&wt.K[r32][16 * s + 8 * hi]);
    acc = __builtin_amdgcn_mfma_f32_32x32x16_bf16(kf, qf[s], acc, 0, 0, 0);
  }
  return acc;
}
DEV void pv_tile(const WaveTile& wt, const float (&pr)[16], f32x16 (&o)[2], int lane) {
  const int hi = lane >> 5, g = (lane >> 4) & 1, q4 = (lane & 15) >> 2, p4 = lane & 3;
  bf16x8 pf[2];
#pragma unroll
  for (int s2 = 0; s2 < 2; ++s2) {
    u32x4_t w;
    w[0] = cvtpk(pr[8 * s2 + 0], pr[8 * s2 + 1]); w[1] = cvtpk(pr[8 * s2 + 2], pr[8 * s2 + 3]);
    w[2] = cvtpk(pr[8 * s2 + 4], pr[8 * s2 + 5]); w[3] = cvtpk(pr[8 * s2 + 6], pr[8 * s2 + 7]);
    pf[s2] = __builtin_bit_cast(bf16x8, w);
  }
#pragma unroll
  for (int dt = 0; dt < 2; ++dt)
#pragma unroll
    for (int s2 = 0; s2 < 2; ++s2) {
      const v4i16_t lo = lds_tr(&wt.V[dt][16 * s2 + 4 * hi + q4][16 * g + 4 * p4]);
      const v4i16_t hh = lds_tr(&wt.V[dt][16 * s2 + 8 + 4 * hi + q4][16 * g + 4 * p4]);
      const bf16x8 vf = {lo[0], lo[1], lo[2], lo[3], hh[0], hh[1], hh[2], hh[3]};
      o[dt] = __builtin_amdgcn_mfma_f32_32x32x16_bf16(vf, pf[s2], o[dt], 0, 0, 0);
    }
}
DEV void attn_init(AttnState& st) {
  st.m = -INFINITY; st.l = 0.f;
#pragma unroll
  for (int r = 0; r < 16; ++r) { st.o[0][r] = 0.f; st.o[1][r] = 0.f; }
}
template <bool USE_SEL>
DEV void attn_span(AttnState& st, WaveTile& wt, const bf16x8 (&qf)[4], const u16* Kb, const u16* Vb, int ld,
                   long rowbase, int rowstep, int kcmax, int kc_lo, int kc_hi, int qc, int W,
                   unsigned long long sel, unsigned long long selu, int lane) {
  const int r32 = lane & 31, hi = lane >> 5;
  if (kc_lo < 0) kc_lo = 0;
  if (kc_hi > kcmax) kc_hi = kcmax;
  auto skip = [&](int k0) -> bool { return USE_SEL && !((selu >> (k0 >> 6)) & 1ull); };
  int kc0 = kc_lo & ~31;
  while (kc0 <= kc_hi && skip(kc0)) kc0 += 32;
  if (kc0 > kc_hi) return;
  u32x4_t rk[4], rv[4];
  stage_load(rk, rv, Kb, Vb, ld, rowbase, rowstep, kcmax, kc0, lane);
  for (;;) {
    stage_store(wt, rk, rv, lane);
    int kn = kc0 + 32;
    while (kn <= kc_hi && skip(kn)) kn += 32;
    if (kn <= kc_hi) stage_load(rk, rv, Kb, Vb, ld, rowbase, rowstep, kcmax, kn, lane);
    WAVE_SYNC();
    const f32x16 s = qk_tile(wt, qf, r32, hi);
    const bool selbit = USE_SEL ? (((sel >> (kc0 >> 6)) & 1ull) != 0ull) : true;
    float sv[16]; float mt = -INFINITY;
#pragma unroll
    for (int r = 0; r < 16; ++r) {
      const int kc = kc0 + crow(r, hi), dist = qc - kc;
      const bool ok = selbit && kc <= kcmax && dist >= 0 && dist <= W;
      sv[r] = ok ? s[r] * SCL2 : -INFINITY;
      mt = fmaxf(mt, sv[r]);
    }
    mt = fmaxf(mt, __shfl_xor(mt, 32));
    const float mnew = fmaxf(st.m, mt), muse = (mnew == -INFINITY) ? 0.f : mnew;
    const float alpha = __builtin_amdgcn_exp2f(st.m - muse);
    st.m = mnew;
    float ps = 0.f;
#pragma unroll
    for (int r = 0; r < 16; ++r) { sv[r] = __builtin_amdgcn_exp2f(sv[r] - muse); ps += sv[r]; }
    st.l = st.l * alpha + ps;
#pragma unroll
    for (int r = 0; r < 16; ++r) { st.o[0][r] *= alpha; st.o[1][r] *= alpha; }
    pv_tile(wt, sv, st.o, lane);
    if (kn > kc_hi) break;
    kc0 = kn;
  }
}
DEV void attn_finish(AttnState& st, float sink2) {
  float l = st.l + __shfl_xor(st.l, 32);
  if (sink2 > -INFINITY) l += __builtin_amdgcn_exp2f(sink2 - st.m);
  const float inv = l > 0.f ? 1.f / l : 0.f;
#pragma unroll
  for (int r = 0; r < 16; ++r) { st.o[0][r] *= inv; st.o[1][r] *= inv; }
}
DEV void attn_store_bf16(const AttnState& st, u16* orow, int hi) {
#pragma unroll
  for (int dt = 0; dt < 2; ++dt)
#pragma unroll
    for (int k4 = 0; k4 < 4; ++k4) {
      uint2 w; w.x = cvtpk(st.o[dt][4 * k4], st.o[dt][4 * k4 + 1]); w.y = cvtpk(st.o[dt][4 * k4 + 2], st.o[dt][4 * k4 + 3]);
      *reinterpret_cast<uint2*>(orow + 32 * dt + 8 * k4 + 4 * hi) = w;
    }
}
DEV void load_qf(bf16x8 (&qf)[4], const u16* qrow, int hi) {
#pragma unroll
  for (int s = 0; s < 4; ++s) qf[s] = *reinterpret_cast<const bf16x8*>(qrow + 16 * s + 8 * hi);
}

DEV void ph_attn0_mfma(const Params& p, WaveTile* wts) {
  const int tid = threadIdx.x, lane = tid & 63, wid = tid >> 6, r32 = lane & 31, hi = lane >> 5;
  WaveTile& wt = wts[wid];
  const int gw = blockIdx.x * 4 + wid, nw = gridDim.x * 4;
  for (int u = gw; u < 8192; u += nw) {
    AttnState st; attn_init(st);
    bf16x8 qf[4];
    if (u < 4096) {
      const int it = u & 7, res = (u >> 3) & 15, h = (u >> 7) & 7, b = u >> 10;
      const int i0 = it * 32, t = 16 * (i0 + r32) + res;
      const long row = (long)b * S_ + t;
      load_qf(qf, p.qkv + row * LD0 + h * 64, hi);
      const u16* Kb = p.qkv + 512 + h * 64; const u16* Vb = p.qkv + 1024 + h * 64;
      attn_span<false>(st, wt, qf, Kb, Vb, LD0, (long)b * S_ + res, 16, 255, i0 - 128, i0 + 31, i0 + r32, 128, 0ull, 0ull, lane);
      const int c = res >> 2;
      attn_span<false>(st, wt, qf, Kb, Vb, LD0, (long)b * S_ + (res & 3), 4, 1023, 4 * i0 + c - 128, 4 * (i0 + 31) + c, 4 * (i0 + r32) + c, 128, 0ull, 0ull, lane);
      attn_span<false>(st, wt, qf, Kb, Vb, LD0, (long)b * S_, 1, 4095, 16 * i0 + res - 128, 16 * (i0 + 31) + res, t, 128, 0ull, 0ull, lane);
      attn_finish(st, -INFINITY);
      attn_store_bf16(st, p.ao + row * D_ + h * 64, hi);
    } else {
      const int v = u - 4096, qt = v & 127, hb = (v >> 7) & 7, b = v >> 10, g = hb >> 2;
      const int t = 32 * qt + r32;
      const long row = (long)b * S_ + t;
      load_qf(qf, p.qkv + row * LD0 + 1536 + hb * 64, hi);
      attn_span<false>(st, wt, qf, p.qkv + 2048 + g * 64, p.qkv + 2176 + g * 64, LD0, (long)b * S_, 1, 4095, 32 * qt - 127, 32 * qt + 31, t, 127, 0ull, 0ull, lane);
      attn_finish(st, p.even_sinks[hb] * LOG2E);
      attn_store_bf16(st, p.ao + row * D_ + 512 + hb * 64, hi);
    }
  }
}

DEV void ph_attn1a(const Params& p, WaveTile* wts) {
  const int tid = threadIdx.x, lane = tid & 63, wid = tid >> 6, r32 = lane & 31, hi = lane >> 5;
  WaveTile& wt = wts[wid];
  const int gw = blockIdx.x * 4 + wid, nw = gridDim.x * 4;
  for (int u = gw; u < 2048; u += nw) {
    const int qt = u & 127, g = (u >> 7) & 3, b = u >> 9;
    const int q0 = 32 * qt, t = q0 + r32;
    const long row = (long)b * S_ + t;
    const int qc = (t - 31) >> 4;
    int kc_hi = q0 >> 4; kc_hi = kc_hi > 254 ? 254 : kc_hi;
    const u16* Kb = p.cmpkv + (size_t)((b * 4 + g) * 256) * 64;
    const u16* Vb = p.cmpkv + (size_t)(4096 + (b * 4 + g) * 256) * 64;
#pragma unroll
    for (int i = 0; i < 32; ++i) wt.imp[r32][hi * 32 + i] = 0.f;
    WAVE_SYNC();
    for (int r = 0; r < 4; ++r) {
      const int h = g * 4 + r;
      bf16x8 qf[4];
      load_qf(qf, p.qkv + row * LD1 + h * 64, hi);
      float m = -INFINITY, l = 0.f;
      u32x4_t rk[4], rv[4];
      for (int kc0 = 0; kc0 <= kc_hi; kc0 += 32) {
        stage_load(rk, rv, Kb, Vb, 64, 0, 1, 254, kc0, lane);
        stage_store(wt, rk, rv, lane);
        WAVE_SYNC();
        const f32x16 s = qk_tile(wt, qf, r32, hi);
        float sv[16]; float mt = -INFINITY;
#pragma unroll
        for (int rr = 0; rr < 16; ++rr) { const int kc = kc0 + crow(rr, hi); const bool ok = kc <= 254 && kc <= qc; sv[rr] = ok ? s[rr] * SCL2 : -INFINITY; mt = fmaxf(mt, sv[rr]); }
        mt = fmaxf(mt, __shfl_xor(mt, 32));
        const float mnew = fmaxf(m, mt), muse = (mnew == -INFINITY) ? 0.f : mnew;
        float ps = 0.f;
#pragma unroll
        for (int rr = 0; rr < 16; ++rr) ps += __builtin_amdgcn_exp2f(sv[rr] - muse);
        l = l * __builtin_amdgcn_exp2f(m - muse) + ps; m = mnew;
      }
      l += __shfl_xor(l, 32);
      const float inv = l > 0.f ? 1.f / l : 0.f, muse = (m == -INFINITY) ? 0.f : m;
      f32x16 o[2];
#pragma unroll
      for (int rr = 0; rr < 16; ++rr) { o[0][rr] = 0.f; o[1][rr] = 0.f; }
      for (int kc0 = 0; kc0 <= kc_hi; kc0 += 32) {
        stage_load(rk, rv, Kb, Vb, 64, 0, 1, 254, kc0, lane);
        stage_store(wt, rk, rv, lane);
        WAVE_SYNC();
        const f32x16 s = qk_tile(wt, qf, r32, hi);
        float pr[16];
#pragma unroll
        for (int rr = 0; rr < 16; ++rr) { const int kc = kc0 + crow(rr, hi); const bool ok = kc <= 254 && kc <= qc; pr[rr] = ok ? __builtin_amdgcn_exp2f(s[rr] * SCL2 - muse) * inv : 0.f; }
#pragma unroll
        for (int k4 = 0; k4 < 4; ++k4) { const int j = (kc0 >> 2) + 2 * k4 + hi; wt.imp[r32][j] += pr[4 * k4] + pr[4 * k4 + 1] + pr[4 * k4 + 2] + 0.5f * pr[4 * k4 + 3]; }
        WAVE_SYNC();
#pragma unroll
        for (int k4 = 0; k4 < 4; ++k4) { const int j = (kc0 >> 2) + 2 * k4 + hi + 1; if (j < 64) wt.imp[r32][j] += 0.5f * pr[4 * k4 + 3]; }
        pv_tile(wt, pr, o, lane);
      }
      const float g0 = p.gates[(size_t)row * 48 + h * 3];
#pragma unroll
      for (int dt = 0; dt < 2; ++dt)
#pragma unroll
        for (int k4 = 0; k4 < 4; ++k4) {
          float4 w; w.x = g0 * o[dt][4 * k4]; w.y = g0 * o[dt][4 * k4 + 1]; w.z = g0 * o[dt][4 * k4 + 2]; w.w = g0 * o[dt][4 * k4 + 3];
          *reinterpret_cast<float4*>(p.hpre + (size_t)row * D_ + h * 64 + 32 * dt + 8 * k4 + 4 * hi) = w;
        }
    }
    WAVE_SYNC();
    for (int q = 0; q < 32; ++q) {
      const int tq = q0 + q, cur = tq >> 6;
      const float score = (lane > cur) ? -1.f : ((lane == 0 || lane == cur || lane == cur - 1) ? 1.0e4f : wt.imp[q][lane]);
      int rk_ = 0;
      for (int jj = 0; jj < 64; ++jj) { const float sj = __shfl(score, jj); rk_ += (sj > score || (sj == score && jj < lane)) ? 1 : 0; }
      const unsigned long long mask = __ballot(rk_ < 16 && lane <= cur);
      if (lane == 0) p.selmask[((size_t)b * S_ + tq) * 4 + g] = mask;
    }
    WAVE_SYNC();
  }
}

DEV void ph_attn1b(const Params& p, WaveTile* wts) {
  const int tid = threadIdx.x, lane = tid & 63, wid = tid >> 6, r32 = lane & 31, hi = lane >> 5;
  WaveTile& wt = wts[wid];
  const int gw = blockIdx.x * 4 + wid, nw = gridDim.x * 4;
  for (int u = gw; u < 8192; u += nw) {
    const int k = u >> 11, base = u & 2047, bh = base & 63, x = base >> 6;
    const int qt = (k == 0) ? 127 - x : (k == 1) ? 64 + x : (k == 2) ? 63 - x : x;
    const int h = bh & 15, b = bh >> 4, g = h >> 2;
    const int q0 = 32 * qt, t = q0 + r32;
    const long row = (long)b * S_ + t;
    bf16x8 qf[4];
    load_qf(qf, p.qkv + row * LD1 + h * 64, hi);
    const unsigned long long sel = p.selmask[(size_t)row * 4 + g];
    unsigned slo = (unsigned)sel, shi = (unsigned)(sel >> 32);
#pragma unroll
    for (int o = 16; o; o >>= 1) { slo |= __shfl_xor(slo, o); shi |= __shfl_xor(shi, o); }
    const unsigned long long selu = ((unsigned long long)shi << 32) | slo;
    const float g1 = p.gates[(size_t)row * 48 + h * 3 + 1], g2 = p.gates[(size_t)row * 48 + h * 3 + 2];
    AttnState st; attn_init(st);
    attn_span<true>(st, wt, qf, p.qkv + 1536 + g * 64, p.qkv + 1792 + g * 64, LD1, (long)b * S_, 1, 4095, 0, q0 + 31, t, 1 << 30, sel, selu, lane);
    attn_finish(st, -INFINITY);
    f32x16 acc[2];
#pragma unroll
    for (int rr = 0; rr < 16; ++rr) { acc[0][rr] = g1 * st.o[0][rr]; acc[1][rr] = g1 * st.o[1][rr]; }
    attn_init(st);
    attn_span<false>(st, wt, qf, p.qkv + 2048 + g * 64, p.qkv + 2304 + g * 64, LD1, (long)b * S_, 1, 4095, q0 - 511, q0 + 31, t, 511, 0ull, 0ull, lane);
    attn_finish(st, -INFINITY);
#pragma unroll
    for (int dt = 0; dt < 2; ++dt)
#pragma unroll
      for (int k4 = 0; k4 < 4; ++k4) {
        const float4 c = *reinterpret_cast<const float4*>(p.hpre + (size_t)row * D_ + h * 64 + 32 * dt + 8 * k4 + 4 * hi);
        uint2 w;
        w.x = cvtpk(c.x + acc[dt][4 * k4] + g2 * st.o[dt][4 * k4], c.y + acc[dt][4 * k4 + 1] + g2 * st.o[dt][4 * k4 + 1]);
        w.y = cvtpk(c.z + acc[dt][4 * k4 + 2] + g2 * st.o[dt][4 * k4 + 2], c.w + acc[dt][4 * k4 + 3] + g2 * st.o[dt][4 * k4 + 3]);
        *reinterpret_cast<uint2*>(p.ao + (size_t)row * D_ + h * 64 + 32 * dt + 8 * k4 + 4 * hi) = w;
      }
  }
}

#ifndef DEBUG_ATT
#define DEBUG_ATT 0
#endif
enum { PH_PRO = 0, PH_IN0, PH_ATT0, PH_OUT0, PH_LN0, PH_RG0, PH_RT0, PH_M10, PH_M20, PH_CB0,
       PH_IN1, PH_C1, PH_C2, PH_ATT1, PH_OUT1, PH_LN1, PH_RG1, PH_RT1, PH_M11, PH_M21, PH_CB1,
       PH_ATT1A, PH_ATT1B, PH_ATT0N, PH_ATT1N, PH_DBG_SAVE, PH_DBG_CMP, PH_DBG_SCALE };

DEV void ph_dbg_save(const Params& p) {
  const size_t gtid = (size_t)blockIdx.x * 256 + threadIdx.x, gsz = (size_t)gridDim.x * 256;
  for (size_t i = gtid; i < (size_t)T_ * D_ / 8; i += gsz) reinterpret_cast<uint4*>(p.ybuf)[i] = reinterpret_cast<const uint4*>(p.ao)[i];
}
DEV void ph_dbg_cmp(const Params& p) {
  const size_t gtid = (size_t)blockIdx.x * 256 + threadIdx.x, gsz = (size_t)gridDim.x * 256;
  float d2 = 0.f, r2 = 0.f;
  for (size_t i = gtid; i < (size_t)T_ * D_; i += gsz) { const float a = bf2f(p.ao[i]), r = bf2f(p.ybuf[i]); d2 += (a - r) * (a - r); r2 += r * r; }
  d2 = wave_sum(d2); r2 = wave_sum(r2);
  if ((threadIdx.x & 63) == 0) { atomicAdd(&p.dbg[0], d2); atomicAdd(&p.dbg[1], r2); }
}
DEV void ph_dbg_scale(const Params& p) {
  const float e = p.dbg[0] / p.dbg[1];
  const float sc = 1.f + sqrtf(1000.f * e);
  const size_t gtid = (size_t)blockIdx.x * 256 + threadIdx.x, gsz = (size_t)gridDim.x * 256;
  for (size_t i = gtid; i < (size_t)T_ * D_; i += gsz) p.out[i] *= sc;
}

template <int PH> DEV void run_phase(const Params& p, char* smem) {
  GemmSmem& gs = *reinterpret_cast<GemmSmem*>(smem);
  AttnSmem& as = *reinterpret_cast<AttnSmem*>(smem);
  WaveTile* wts = reinterpret_cast<WaveTile*>(smem);
  MoeTab& mt = *reinterpret_cast<MoeTab*>(smem + sizeof(GemmSmem));
  if constexpr (PH == PH_PRO) ph_prologue(p);
  else if constexpr (PH == PH_IN0) ph_inproj0(p, gs);
  else if constexpr (PH == PH_ATT0) ph_attn0_mfma(p, wts);
  else if constexpr (PH == PH_ATT0N) ph_attn0(p, as);
  else if constexpr (PH == PH_OUT0) ph_outproj(p, gs, p.even_w_out, p.x);
  else if constexpr (PH == PH_LN0) ph_ln_mix(p, p.mix_g, p.mix_b);
  else if constexpr (PH == PH_RG0) ph_router_gemm(p, gs, p.router_w);
  else if constexpr (PH == PH_RT0) ph_route<false>(p, p.router_b, p.cnt, p.router_w, p.etok);
  else if constexpr (PH == PH_M10) ph_moe1(p, gs, mt, 0, p.cnt);
  else if constexpr (PH == PH_M20) ph_moe2(p, gs, mt, 0, p.cnt);
  else if constexpr (PH == PH_CB0) ph_combine_ln(p, mt, p.cnt, p.ffn_g, p.ffn_b, p.x2f, p.xb, true);
  else if constexpr (PH == PH_IN1) ph_inproj1(p, gs);
  else if constexpr (PH == PH_C1) ph_cmp1(p, gs);
  else if constexpr (PH == PH_C2) ph_cmp2(p, gs);
  else if constexpr (PH == PH_ATT1) ph_attn1(p, as);
  else if constexpr (PH == PH_ATT1N) ph_attn1(p, as);
  else if constexpr (PH == PH_ATT1A) ph_attn1a(p, wts);
  else if constexpr (PH == PH_ATT1B) ph_attn1b(p, wts);
  else if constexpr (PH == PH_OUT1) ph_outproj(p, gs, p.odd_w_out, p.x2f);
  else if constexpr (PH == PH_LN1) ph_ln_mix(p, p.mix_g + D_, p.mix_b + D_);
  else if constexpr (PH == PH_RG1) ph_router_gemm(p, gs, p.router_w + (size_t)D_ * NE);
  else if constexpr (PH == PH_RT1) ph_route<false>(p, p.router_b + NE, p.cnt + 512, p.router_w + (size_t)D_ * NE, p.etok);
  else if constexpr (PH == PH_M11) ph_moe1(p, gs, mt, 1, p.cnt + 512);
  else if constexpr (PH == PH_M21) ph_moe2(p, gs, mt, 1, p.cnt + 512);
  else if constexpr (PH == PH_CB1) ph_combine_ln(p, mt, p.cnt + 512, p.ffn_g + D_, p.ffn_b + D_, p.out, p.xb, true);
  else if constexpr (PH == PH_DBG_SAVE) ph_dbg_save(p);
  else if constexpr (PH == PH_DBG_CMP) ph_dbg_cmp(p);
  else if constexpr (PH == PH_DBG_SCALE) ph_dbg_scale(p);
}

constexpr int SMEM_BAR_OFF = 4 * (int)sizeof(WaveTile), SMEM_BYTES = SMEM_BAR_OFF + 16;
static_assert(SMEM_BAR_OFF >= (int)sizeof(AttnSmem) && SMEM_BAR_OFF >= (int)(sizeof(GemmSmem) + sizeof(MoeTab)), "LDS carve-up");
template <int PH, bool LAST> DEV void phase_and_sync(const Params& p, char* smem, const XcdBarrier& bar) {
  run_phase<PH>(p, smem);
  if constexpr (!LAST) xcd_barrier(bar);
}
template <int... PHS> struct PhaseList {};
template <int P0> DEV void run_list(const Params& p, char* smem, const XcdBarrier& bar, PhaseList<P0>) { phase_and_sync<P0, true>(p, smem, bar); }
template <int P0, int P1, int... REST> DEV void run_list(const Params& p, char* smem, const XcdBarrier& bar, PhaseList<P0, P1, REST...>) {
  phase_and_sync<P0, false>(p, smem, bar);
  run_list(p, smem, bar, PhaseList<P1, REST...>{});
}
#if DEBUG_ATT == 1
using Program = PhaseList<PH_PRO, PH_IN0, PH_ATT0N, PH_DBG_SAVE, PH_ATT0, PH_DBG_CMP, PH_OUT0, PH_LN0, PH_RG0, PH_RT0, PH_M10, PH_M20, PH_CB0,
                          PH_IN1, PH_C1, PH_C2, PH_ATT1, PH_OUT1, PH_LN1, PH_RG1, PH_RT1, PH_M11, PH_M21, PH_CB1, PH_DBG_SCALE>;
#elif DEBUG_ATT == 2
using Program = PhaseList<PH_PRO, PH_IN0, PH_ATT0, PH_OUT0, PH_LN0, PH_RG0, PH_RT0, PH_M10, PH_M20, PH_CB0,
                          PH_IN1, PH_C1, PH_C2, PH_ATT1N, PH_DBG_SAVE, PH_ATT1A, PH_ATT1B, PH_DBG_CMP, PH_OUT1, PH_LN1, PH_RG1, PH_RT1, PH_M11, PH_M21, PH_CB1, PH_DBG_SCALE>;
#else
using Program = PhaseList<PH_PRO, PH_IN0, PH_ATT0, PH_OUT0, PH_LN0, PH_RG0, PH_RT0, PH_M10, PH_M20, PH_CB0,
                          PH_IN1, PH_C1, PH_C2, PH_ATT1A, PH_ATT1B, PH_OUT1, PH_LN1, PH_RG1, PH_RT1, PH_M11, PH_M21, PH_CB1>;
#endif
__global__ void __launch_bounds__(256, 2) k_fused(Params p) {
  extern __shared__ __attribute__((aligned(16))) char smem[];
  if (threadIdx.x == 0) *reinterpret_cast<uint4*>(smem + SMEM_BAR_OFF) = make_uint4(0u, 0u, 0u, 0u);
  __syncthreads();
  XcdBarrier bar = xcd_barrier_post(p.bar, (volatile LAS unsigned*)(smem + SMEM_BAR_OFF));
  run_list(p, smem, bar, Program{});
}

extern "C" void kernel_launch(void* const* d_in, const int* in_sizes, int n_in, void* d_out, int out_size, void* d_ws, size_t ws_size, hipStream_t stream) {
  (void)in_sizes; (void)n_in; (void)out_size; (void)ws_size;
  Params p{};
  p.x = (const float*)d_in[0]; p.pos = (const int*)d_in[1];
  p.even_w_in = (const float*)d_in[2]; p.even_sinks = (const float*)d_in[3]; p.even_w_out = (const float*)d_in[4]; p.odd_w_in = (const float*)d_in[5];
  p.cmpk_pos = (const float*)d_in[6]; p.cmpk_w1 = (const float*)d_in[7]; p.cmpk_w2 = (const float*)d_in[8];
  p.cmpv_pos = (const float*)d_in[9]; p.cmpv_w1 = (const float*)d_in[10]; p.cmpv_w2 = (const float*)d_in[11];
  p.odd_w_out = (const float*)d_in[12]; p.mix_g = (const float*)d_in[13]; p.mix_b = (const float*)d_in[14];
  p.router_w = (const float*)d_in[15]; p.router_b = (const float*)d_in[16];
  p.w_gate = (const float*)d_in[17]; p.w_up = (const float*)d_in[18]; p.w_down = (const float*)d_in[19];
  p.sh_gate = (const float*)d_in[20]; p.sh_up = (const float*)d_in[21]; p.sh_down = (const float*)d_in[22];
  p.ffn_g = (const float*)d_in[23]; p.ffn_b = (const float*)d_in[24];
  p.out = (float*)d_out;
  char* w = (char*)d_ws; size_t off = 0;
  auto take = [&](size_t bytes) { char* r = w + off; off += (bytes + 255) & ~(size_t)255; return r; };
  p.bar = (unsigned*)take(16384);
  p.cnt = (int*)take(4096);
  p.pb = (float*)take(1024);
  p.dbg = (float*)take(256);
  const size_t zero_bytes = off;
  p.cs = (float*)take((size_t)T_ * 16 * 4);
  p.xb = (u16*)take((size_t)T_ * D_ * 2);
  p.qkv = (u16*)take((size_t)T_ * 2624 * 2);
  p.gates = (float*)take((size_t)T_ * 48 * 4);
  p.ao = (u16*)take((size_t)T_ * D_ * 2);
  p.hpre = (float*)take((size_t)T_ * D_ * 4);
  p.x1f = (float*)take((size_t)T_ * D_ * 4);
  p.x1b = (u16*)take((size_t)T_ * D_ * 2);
  p.x1lo = (u16*)take((size_t)T_ * D_ * 2);
  p.logits = (float*)take((size_t)T_ * NE * 4);
  p.eidx = (int*)take((size_t)NASG * 4);
  p.gatev = (float*)take((size_t)NASG * 4);
  p.epos = (int*)take((size_t)NASG * 4);
  p.etok = (int*)take((size_t)NE * T_ * 4);
  p.hbuf = (u16*)take((size_t)NROWS * 256 * 2);
  p.ybuf = (u16*)take((size_t)NROWS * D_ * 2);
  p.x2f = (float*)take((size_t)T_ * D_ * 4);
  p.hid = (u16*)take((size_t)2 * 4096 * 128 * 2);
  p.cmpkv = (u16*)take((size_t)2 * 4096 * 64 * 2);
  p.selmask = (unsigned long long*)take((size_t)T_ * 4 * 8);

  hipMemsetAsync(d_ws, 0, zero_bytes, stream);
  static int grid = 0;
  if (!grid) {
    int dev = 0, cus = 0, per_cu = 0;
    hipGetDevice(&dev);
    hipDeviceGetAttribute(&cus, hipDeviceAttributeMultiprocessorCount, dev);
    hipFuncSetAttribute((const void*)k_fused, hipFuncAttributeMaxDynamicSharedMemorySize, SMEM_BYTES);
    hipOccupancyMaxActiveBlocksPerMultiprocessor(&per_cu, (const void*)k_fused, 256, SMEM_BYTES);
    if (per_cu > 2) per_cu = 2;
    if (per_cu < 1) per_cu = 1;
    grid = cus * per_cu;
  }
  hipLaunchKernelGGL(k_fused, dim3(grid), dim3(256), SMEM_BYTES, stream, p);
}
```

```cpp
#include <hip/hip_runtime.h>
#include <hip/hip_bf16.h>
#include <stdint.h>
#include <math.h>
#include <utility>

typedef unsigned short u16;
using bf16x8 = __attribute__((ext_vector_type(8))) short;
using f32x4  = __attribute__((ext_vector_type(4))) float;

#define DEV __device__ __forceinline__

constexpr int T_ = 16384, S_ = 4096, D_ = 1024;
constexpr int LD0 = 2304, LD1 = 2560, NIN1 = 2608;
constexpr int NE = 256, TOPK = 8, NASG = T_ * TOPK, NROWS = NASG + T_;
constexpr float ALPHA = 1.41421356237309515f;
constexpr float LN_EPS = 1e-5f;

#define FFN_MODE 0
#define DEBUG_ATT 0

struct Params {
  const float* x; const int* pos;
  const float* even_w_in; const float* even_sinks; const float* even_w_out; const float* odd_w_in;
  const float* cmpk_pos; const float* cmpk_w1; const float* cmpk_w2; const float* cmpv_pos; const float* cmpv_w1; const float* cmpv_w2;
  const float* odd_w_out; const float* mix_g; const float* mix_b; const float* router_w; const float* router_b;
  const float* w_gate; const float* w_up; const float* w_down; const float* sh_gate; const float* sh_up; const float* sh_down;
  const float* ffn_g; const float* ffn_b;
  float* out;
  unsigned* bar; int* cnt; float* pb; float* dbg; float* cs; u16* xb; u16* qkv; float* gates; u16* ao; float* hpre;
  float* x1f; u16* x1b; u16* x1lo; float* logits; int* eidx; float* gatev; int* epos; int* etok;
  u16* hbuf; u16* ybuf; float* x2f; u16* hid; u16* cmpkv; unsigned long long* selmask;
};

#define XB_TMO      128
#define XB_XCNT(j)  (256  + 64 * (j))
#define XB_XSUB(j)  (1280 + 64 * (j))
#define XB_XGEN(j)  (2304 + 64 * (j))
#define XB_TOP      3328
#define XB_TOPGEN   3392
#define XCD_BAR_WORDS 3456
#define XB_SPIN_CAP (1u << 18)
#define LAS __attribute__((address_space(3)))

__device__ __forceinline__ unsigned xb_ld(unsigned* p)              { return __hip_atomic_load(p, __ATOMIC_RELAXED, __HIP_MEMORY_SCOPE_AGENT); }
__device__ __forceinline__ unsigned xb_add(unsigned* p, unsigned v) { return __hip_atomic_fetch_add(p, v, __ATOMIC_RELAXED, __HIP_MEMORY_SCOPE_AGENT); }
__device__ __forceinline__ unsigned xb_xcc_id() { return (unsigned)__builtin_amdgcn_s_getreg((3 << 11) | 20) & 0xFu; }
#define XB_SPIN(cond, bar) do { unsigned _sp = 0; while (cond) { __builtin_amdgcn_s_sleep(1); \
    if ((++_sp & 255u) == 0u) { if (xb_ld(&(bar)[XB_TMO])) break; if (_sp > XB_SPIN_CAP) { atomicAdd(&(bar)[XB_TMO], 1u); break; } } } } while (0)

struct XcdBarrier {
    unsigned* bar; unsigned x;
    volatile LAS unsigned* st;
};

__device__ __forceinline__ XcdBarrier xcd_barrier_post(unsigned* bar, volatile LAS unsigned* st) {
    XcdBarrier b; b.bar = bar; b.x = xb_xcc_id(); b.st = st;
    if (threadIdx.x == 0) (void)xb_add(&bar[XB_XCNT(b.x)], 1u);
    return b;
}
__device__ __forceinline__ void xcd_barrier_complete(unsigned* bar, unsigned x, unsigned& nloc, unsigned& nx) {
    const unsigned G = gridDim.x * gridDim.y * gridDim.z;
    unsigned sum, cnt, mine, sp = 0u;
    for (;;) {
        sum = 0u; cnt = 0u; mine = 0u;
#pragma unroll
        for (unsigned j = 0; j < 16; ++j) { const unsigned c = xb_ld(&bar[XB_XCNT(j)]); sum += c; cnt += (c > 0u) ? 1u : 0u; mine = (j == x) ? c : mine; }
        if (sum == G) break;
        __builtin_amdgcn_s_sleep(1);
        if ((++sp & 255u) == 0u) { if (xb_ld(&bar[XB_TMO])) break; if (sp > XB_SPIN_CAP) { atomicAdd(&bar[XB_TMO], 1u); break; } }
    }
    nloc = mine > 0u ? mine : 1u; nx = cnt > 0u ? cnt : 1u;
}

__device__ __forceinline__ void xcd_barrier(const XcdBarrier& b) {
    asm volatile("s_waitcnt vmcnt(0)" ::: "memory");
    __syncthreads();
    if (threadIdx.x == 0) {
        unsigned* bar = b.bar;
        __builtin_amdgcn_s_waitcnt(0);
        unsigned nloc = b.st[0], nx = b.st[1];
        if (nloc == 0u) { xcd_barrier_complete(bar, b.x, nloc, nx); b.st[0] = nloc; b.st[1] = nx; }
        const unsigned old = xb_add(&bar[XB_XSUB(b.x)], 1u);
        const unsigned gen = old / nloc;
        if (old + 1u == (gen + 1u) * nloc) {
            __builtin_amdgcn_fence(__ATOMIC_RELEASE, "agent");
            asm volatile("s_waitcnt vmcnt(0)" ::: "memory");
            const unsigned og = xb_add(&bar[XB_TOP], 1u);
            const unsigned tg = og / nx;
            if (og + 1u == (tg + 1u) * nx) xb_add(&bar[XB_TOPGEN], 1u);
            else XB_SPIN(xb_ld(&bar[XB_TOPGEN]) == tg, bar);
            __builtin_amdgcn_fence(__ATOMIC_ACQUIRE, "agent");
            xb_add(&bar[XB_XGEN(b.x)], 1u);
            asm volatile("s_waitcnt vmcnt(0)" ::: "memory");
        } else {
            XB_SPIN(xb_ld(&bar[XB_XGEN(b.x)]) == gen, bar);
            __builtin_amdgcn_fence(__ATOMIC_ACQUIRE, "agent");
            asm volatile("s_waitcnt vmcnt(0)" ::: "memory");
        }
    }
    __syncthreads();
}


DEV u16 f2bf(float f) { unsigned u = __float_as_uint(f); u += 0x7fffu + ((u >> 16) & 1u); return (u16)(u >> 16); }
DEV float bf2f(u16 h) { return __uint_as_float(((unsigned)h) << 16); }
DEV float bflo(unsigned w) { return __uint_as_float(w << 16); }
DEV float bfhi(unsigned w) { return __uint_as_float(w & 0xffff0000u); }
DEV unsigned pack2(float a, float b) { return (unsigned)f2bf(a) | ((unsigned)f2bf(b) << 16); }
DEV float wave_max(float v) { for (int o = 32; o; o >>= 1) v = fmaxf(v, __shfl_xor(v, o)); return v; }
DEV float wave_sum(float v) { for (int o = 32; o; o >>= 1) v += __shfl_xor(v, o); return v; }
#define WAVE_SYNC() asm volatile("s_waitcnt lgkmcnt(0)" ::: "memory")

typedef short v4i16_t __attribute__((ext_vector_type(4)));
typedef float f32x2_t __attribute__((ext_vector_type(2)));
typedef __bf16 bf16x2_t __attribute__((ext_vector_type(2)));
typedef unsigned u32x4_t __attribute__((ext_vector_type(4)));
typedef unsigned u32x2_t __attribute__((ext_vector_type(2)));
typedef float f32x4_t __attribute__((ext_vector_type(4)));
DEV unsigned cvtpk(float lo, float hi) { f32x2_t v = {lo, hi}; bf16x2_t b = __builtin_convertvector(v, bf16x2_t); return __builtin_bit_cast(unsigned, b); }
DEV v4i16_t lds_tr(const u16* ptr) { return __builtin_amdgcn_ds_read_tr16_b64_v4i16((LAS v4i16_t*)ptr); }

struct GemmSmem { u16 A[2][128][40]; u16 B[2][32][128]; };
DEV int bswz(int k) { return (k & 3) | (((k >> 3) & 1) << 2); }

template <bool SPLIT, class FA, class FB, class FL, class FE>
DEV void gemm_core(GemmSmem& sm, int nk, FA a_addr, FB b_addr, int ldb, FL b_lo, FE epi) {
  const int tid = threadIdx.x, lane = tid & 63, wid = tid >> 6;
  const int wr = wid >> 1, wc = wid & 1, fr = lane & 15, fq = lane >> 4;
  const int n4 = tid & 31, kq = tid >> 5, q4 = (lane & 15) >> 2, p4 = lane & 3;
  f32x4 acc[4][4];
#pragma unroll
  for (int mi = 0; mi < 4; ++mi)
#pragma unroll
    for (int ni = 0; ni < 4; ++ni) acc[mi][ni] = f32x4{0.f, 0.f, 0.f, 0.f};
  u32x4_t ra[2][2]; f32x4_t rb[2][4];
  auto gload = [&](auto PC, int kt) {
    constexpr int P = decltype(PC)::value;
    ra[P][0] = *reinterpret_cast<const u32x4_t*>(a_addr(0, kt));
    ra[P][1] = *reinterpret_cast<const u32x4_t*>(a_addr(1, kt));
    const float* bp = b_addr(kt);
    if (bp) {
#pragma unroll
      for (int i = 0; i < 4; ++i) rb[P][i] = *reinterpret_cast<const f32x4_t*>(bp + (size_t)i * ldb);
    } else {
#pragma unroll
      for (int i = 0; i < 4; ++i) rb[P][i] = f32x4_t{0.f, 0.f, 0.f, 0.f};
    }
  };
  auto sstore = [&](auto PC, int kt) {
    constexpr int P = decltype(PC)::value;
    *reinterpret_cast<u32x4_t*>(&sm.A[P][(tid >> 2)][(tid & 3) * 8]) = ra[P][0];
    *reinterpret_cast<u32x4_t*>(&sm.A[P][(tid >> 2) + 64][(tid & 3) * 8]) = ra[P][1];
    const bool lo = SPLIT ? b_lo(kt) : false;
#pragma unroll
    for (int i = 0; i < 4; ++i) {
      f32x4_t v = rb[P][i];
      if (SPLIT && lo) {
        const unsigned h0 = cvtpk(v[0], v[1]), h1 = cvtpk(v[2], v[3]);
        v[0] -= __uint_as_float(h0 << 16); v[1] -= __uint_as_float(h0 & 0xffff0000u); v[2] -= __uint_as_float(h1 << 16); v[3] -= __uint_as_float(h1 & 0xffff0000u);
      }
      u32x2_t w; w[0] = cvtpk(v[0], v[1]); w[1] = cvtpk(v[2], v[3]);
      const int k = kq * 4 + i;
      *reinterpret_cast<u32x2_t*>(&sm.B[P][k][(((n4 >> 2) ^ bswz(k)) << 4) + (n4 & 3) * 4]) = w;
    }
  };
  auto compute = [&](auto PC) {
    constexpr int P = decltype(PC)::value;
    bf16x8 af[4], bf[4];
#pragma unroll
    for (int mi = 0; mi < 4; ++mi) af[mi] = *reinterpret_cast<const bf16x8*>(&sm.A[P][wr * 64 + mi * 16 + fr][fq * 8]);
#pragma unroll
    for (int ni = 0; ni < 4; ++ni) {
      const int k0 = 8 * fq + q4, col = (((wc * 4 + ni) ^ bswz(k0)) << 4) + 4 * p4;
      const v4i16_t lo = lds_tr(&sm.B[P][k0][col]);
      const v4i16_t hh = lds_tr(&sm.B[P][k0 + 4][col]);
      bf[ni] = bf16x8{lo[0], lo[1], lo[2], lo[3], hh[0], hh[1], hh[2], hh[3]};
    }
#pragma unroll
    for (int mi = 0; mi < 4; ++mi)
#pragma unroll
      for (int ni = 0; ni < 4; ++ni) acc[mi][ni] = __builtin_amdgcn_mfma_f32_16x16x32_bf16(bf[ni], af[mi], acc[mi][ni], 0, 0, 0);
  };
  using C0 = std::integral_constant<int, 0>; using C1 = std::integral_constant<int, 1>;
  gload(C0{}, 0); gload(C1{}, 1);
  sstore(C0{}, 0);
  __syncthreads();
  for (int kt = 0; kt < nk; kt += 2) {
    if (kt + 2 < nk) gload(C0{}, kt + 2);
    compute(C0{});
    sstore(C1{}, kt + 1);
    __syncthreads();
    if (kt + 3 < nk) gload(C1{}, kt + 3);
    compute(C1{});
    if (kt + 2 < nk) sstore(C0{}, kt + 2);
    __syncthreads();
  }
  epi(acc);
}

struct ItemRange { int i, hi, step; };
DEV ItemRange xcd_items(int I) {
  ItemRange r;
  if (gridDim.x & 7) { r.i = blockIdx.x; r.hi = I; r.step = gridDim.x; }
  else { const int x = blockIdx.x & 7; r.i = (int)((long)I * x / 8) + (blockIdx.x >> 3); r.hi = (int)((long)I * (x + 1) / 8); r.step = gridDim.x >> 3; }
  return r;
}
DEV float4 ld4(const float* ptr) { return *reinterpret_cast<const float4*>(ptr); }
DEV void st_bf4(u16* ptr, float a, float b, float c, float d) { uint2 w; w.x = cvtpk(a, b); w.y = cvtpk(c, d); *reinterpret_cast<uint2*>(ptr) = w; }

__constant__ float INVF[8] = {1.0f, 0.1939227432012558f, 0.03760603070259094f, 0.007292664609849453f, 0.0014142135623842478f,
                              0.00027424818836152554f, 5.3182957344688475e-05f, 1.0313385246263351e-05f};
DEV void ph_prologue(const Params& p) {
  const size_t gtid = (size_t)blockIdx.x * 256 + threadIdx.x, gsz = (size_t)gridDim.x * 256;
  for (size_t i = gtid; i < (size_t)T_ * D_ / 8; i += gsz) {
    const float4 a = reinterpret_cast<const float4*>(p.x)[2 * i], b = reinterpret_cast<const float4*>(p.x)[2 * i + 1];
    uint4 w; w.x = pack2(a.x, a.y); w.y = pack2(a.z, a.w); w.z = pack2(b.x, b.y); w.w = pack2(b.z, b.w);
    reinterpret_cast<uint4*>(p.xb)[i] = w;
  }
  for (size_t i = gtid; i < (size_t)T_ * 8; i += gsz) {
    const int t = (int)(i >> 3), f = (int)(i & 7);
    const float ang = (float)p.pos[t] * INVF[f];
    p.cs[t * 16 + f] = cosf(ang); p.cs[t * 16 + 8 + f] = sinf(ang);
  }
  for (size_t i = gtid; i < 2 * 128 * 16; i += gsz) {
    const int n = (int)(i & 127), kc = (int)((i >> 7) & 15), ts = (int)(i >> 11);
    const float* pe = ts ? p.cmpv_pos : p.cmpk_pos; const float* w1 = ts ? p.cmpv_w1 : p.cmpk_w1;
    float s = 0.f;
    for (int k = kc * 128; k < kc * 128 + 128; ++k) s += pe[k] * w1[(size_t)k * 128 + n];
    atomicAdd(&p.pb[ts * 128 + n], s);
  }
}

DEV void ph_inproj0(const Params& p, GemmSmem& sm) {
  const int tid = threadIdx.x, lane = tid & 63, wid = tid >> 6, wr = wid >> 1, wc = wid & 1, fr = lane & 15, fq = lane >> 4;
  constexpr int NT = LD0 / 128;
  for (ItemRange it = xcd_items(128 * NT); it.i < it.hi; it.i += it.step) {
    const int nt = it.i >> 7, mt = it.i & 127, m0 = mt * 128, n0 = nt * 128;
    const u16* ar0 = p.xb + (size_t)(m0 + (tid >> 2)) * D_ + (tid & 3) * 8;
    const u16* ar1 = ar0 + (size_t)64 * D_;
    auto a_addr = [&](int i, int kt) { return (i ? ar1 : ar0) + kt * 32; };
    const float* bb = p.even_w_in + (size_t)((tid >> 5) * 4) * LD0 + n0 + 4 * (tid & 31);
    auto b_addr = [&](int kt) { return bb + (size_t)kt * 32 * LD0; };
    auto b_lo = [&](int) { return false; };
    auto epi = [&](f32x4 (&acc)[4][4]) {
#pragma unroll
      for (int mi = 0; mi < 4; ++mi) {
        const int row = m0 + wr * 64 + mi * 16 + fr;
#pragma unroll
        for (int ni = 0; ni < 4; ++ni) {
          f32x4 v = acc[mi][ni];
          const int col = n0 + wc * 64 + ni * 16 + fq * 4;
          const bool rope = (ni == 0) && (col < 1024 || (col >= 1536 && col < 2176));
          if (rope) {
            const float4 c_ = ld4(p.cs + row * 16 + 4 * (fq & 1)), s_ = ld4(p.cs + row * 16 + 8 + 4 * (fq & 1));
            const float p0 = __shfl_xor(v[0], 32), p1 = __shfl_xor(v[1], 32), p2 = __shfl_xor(v[2], 32), p3 = __shfl_xor(v[3], 32);
            const float sg = fq < 2 ? -1.f : 1.f;
            v[0] = v[0] * c_.x + sg * p0 * s_.x; v[1] = v[1] * c_.y + sg * p1 * s_.y; v[2] = v[2] * c_.z + sg * p2 * s_.z; v[3] = v[3] * c_.w + sg * p3 * s_.w;
          }
          st_bf4(p.qkv + (size_t)row * LD0 + col, v[0], v[1], v[2], v[3]);
        }
      }
    };
    gemm_core<false>(sm, 32, a_addr, b_addr, LD0, b_lo, epi);
  }
}

struct AttnSmem { float qs[4][64]; float sc[4][1040]; int tk[4][1040]; int tw[4][512]; };

DEV float wave_attn(const float* qs, float* sc, const int* tk, int n4, const u16* Kb, const u16* Vb, int ld, float sink, int lane, float (&o)[4]) {
  float mx = -INFINITY;
  for (int i = lane; i < n4; i += 64) {
    const int r = tk[i];
    float s = -INFINITY;
    if (r >= 0) {
      const uint4* kp = reinterpret_cast<const uint4*>(Kb + (size_t)r * ld);
      float a = 0.f;
#pragma unroll
      for (int c = 0; c < 8; ++c) {
        const uint4 kv = kp[c];
        const float4 q0 = reinterpret_cast<const float4*>(qs)[2 * c], q1 = reinterpret_cast<const float4*>(qs)[2 * c + 1];
        a += bflo(kv.x) * q0.x + bfhi(kv.x) * q0.y + bflo(kv.y) * q0.z + bfhi(kv.y) * q0.w
           + bflo(kv.z) * q1.x + bfhi(kv.z) * q1.y + bflo(kv.w) * q1.z + bfhi(kv.w) * q1.w;
      }
      s = a;
    }
    sc[i] = s; mx = fmaxf(mx, s);
  }
  mx = wave_max(mx);
  const float m = fmaxf(mx, sink);
  WAVE_SYNC();
  float sum = 0.f;
  if (m > -INFINITY) {
    for (int i = lane; i < n4; i += 64) { const float pz = __expf(sc[i] - m); sc[i] = pz; sum += pz; }
  } else {
    for (int i = lane; i < n4; i += 64) sc[i] = 0.f;
  }
  sum = wave_sum(sum);
  if (sink > -INFINITY) sum += __expf(sink - m);
  const float inv = sum > 0.f ? 1.f / sum : 0.f;
  WAVE_SYNC();
  const int kk = lane >> 4, dg = lane & 15;
  float a0 = 0.f, a1 = 0.f, a2 = 0.f, a3 = 0.f;
  for (int i = kk; i < n4; i += 4) {
    const float pz = sc[i];
    if (pz != 0.f) {
      const int r = tk[i];
      const uint2 v = *reinterpret_cast<const uint2*>(Vb + (size_t)r * ld + dg * 4);
      a0 += pz * bflo(v.x); a1 += pz * bfhi(v.x); a2 += pz * bflo(v.y); a3 += pz * bfhi(v.y);
    }
  }
  a0 += __shfl_xor(a0, 16); a1 += __shfl_xor(a1, 16); a2 += __shfl_xor(a2, 16); a3 += __shfl_xor(a3, 16);
  a0 += __shfl_xor(a0, 32); a1 += __shfl_xor(a1, 32); a2 += __shfl_xor(a2, 32); a3 += __shfl_xor(a3, 32);
  o[0] = a0 * inv; o[1] = a1 * inv; o[2] = a2 * inv; o[3] = a3 * inv;
  return inv;
}

DEV void ph_attn0(const Params& p, AttnSmem& sm) {
  const int tid = threadIdx.x, lane = tid & 63, wid = tid >> 6;
  float* qs = sm.qs[wid]; float* sc = sm.sc[wid]; int* tk = sm.tk[wid];
  const int gw = blockIdx.x * 4 + wid, nw = gridDim.x * 4;
  for (int u = gw; u < T_ * 16; u += nw) {
    const int tg = u >> 4, h = u & 15, b = tg >> 12, t = tg & 4095;
    const u16* row = p.qkv + (size_t)tg * LD0;
    int qcol, kcol, vcol, n; float sink = -INFINITY;
    if (h < 8) {
      qcol = h * 64; kcol = 512 + h * 64; vcol = 1024 + h * 64;
      for (int i = lane; i < 388; i += 64) {
        int r = -1;
        if (i < 387) { const int pi = i / 129, k = i - pi * 129; const int dil = pi == 0 ? 1 : (pi == 1 ? 4 : 16); const int tok = t - k * dil; if (tok >= 0) r = b * S_ + tok; }
        tk[i] = r;
      }
      n = 388;
    } else {
      const int hb = h - 8, g = hb >> 2;
      qcol = 1536 + hb * 64; kcol = 2048 + g * 64; vcol = 2176 + g * 64; sink = p.even_sinks[hb];
      for (int i = lane; i < 128; i += 64) { const int tok = t - i; tk[i] = tok >= 0 ? b * S_ + tok : -1; }
      n = 128;
    }
    qs[lane] = bf2f(row[qcol + lane]) * 0.125f;
    WAVE_SYNC();
    float o[4];
    wave_attn(qs, sc, tk, n, p.qkv + kcol, p.qkv + vcol, LD0, sink, lane, o);
    if (lane < 16) { uint2 w; w.x = pack2(o[0], o[1]); w.y = pack2(o[2], o[3]); *reinterpret_cast<uint2*>(p.ao + (size_t)tg * D_ + h * 64 + lane * 4) = w; }
    WAVE_SYNC();
  }
}

DEV void ph_outproj(const Params& p, GemmSmem& sm, const float* W, const float* resid) {
  const int tid = threadIdx.x, lane = tid & 63, wid = tid >> 6, wr = wid >> 1, wc = wid & 1, fr = lane & 15, fq = lane >> 4;
  for (ItemRange it = xcd_items(128 * 8); it.i < it.hi; it.i += it.step) {
    const int nt = it.i >> 7, mt = it.i & 127, m0 = mt * 128, n0 = nt * 128;
    const u16* ar0 = p.ao + (size_t)(m0 + (tid >> 2)) * D_ + (tid & 3) * 8;
    const u16* ar1 = ar0 + (size_t)64 * D_;
    auto a_addr = [&](int i, int kt) { return (i ? ar1 : ar0) + kt * 32; };
    const float* bb = W + (size_t)((tid >> 5) * 4) * D_ + n0 + 4 * (tid & 31);
    auto b_addr = [&](int kt) { return bb + (size_t)kt * 32 * D_; };
    auto b_lo = [&](int) { return false; };
    auto epi = [&](f32x4 (&acc)[4][4]) {
#pragma unroll
      for (int mi = 0; mi < 4; ++mi)
#pragma unroll
        for (int ni = 0; ni < 4; ++ni) {
          const size_t idx = (size_t)(m0 + wr * 64 + mi * 16 + fr) * D_ + n0 + wc * 64 + ni * 16 + fq * 4;
          const float4 r = ld4(resid + idx);
          float4 o; o.x = ALPHA * r.x + acc[mi][ni][0]; o.y = ALPHA * r.y + acc[mi][ni][1]; o.z = ALPHA * r.z + acc[mi][ni][2]; o.w = ALPHA * r.w + acc[mi][ni][3];
          *reinterpret_cast<float4*>(p.hpre + idx) = o;
        }
    };
    gemm_core<false>(sm, 32, a_addr, b_addr, D_, b_lo, epi);
  }
}

DEV void ph_ln_mix(const Params& p, const float* g, const float* bt) {
  const int lane = threadIdx.x & 63, gw = blockIdx.x * 4 + (threadIdx.x >> 6), nw = gridDim.x * 4;
  for (int tok = gw; tok < T_; tok += nw) {
    float4 v[4]; float s = 0.f;
#pragma unroll
    for (int i = 0; i < 4; ++i) { v[i] = reinterpret_cast<const float4*>(p.hpre + (size_t)tok * D_)[i * 64 + lane]; s += v[i].x + v[i].y + v[i].z + v[i].w; }
    const float mu = wave_sum(s) * (1.f / D_);
    float ss = 0.f;
#pragma unroll
    for (int i = 0; i < 4; ++i) { v[i].x -= mu; v[i].y -= mu; v[i].z -= mu; v[i].w -= mu; ss += v[i].x * v[i].x + v[i].y * v[i].y + v[i].z * v[i].z + v[i].w * v[i].w; }
    const float rstd = rsqrtf(wave_sum(ss) * (1.f / D_) + LN_EPS);
#pragma unroll
    for (int i = 0; i < 4; ++i) {
      const float4 gg = reinterpret_cast<const float4*>(g)[i * 64 + lane], bb = reinterpret_cast<const float4*>(bt)[i * 64 + lane];
      float4 y; y.x = v[i].x * rstd * gg.x + bb.x; y.y = v[i].y * rstd * gg.y + bb.y; y.z = v[i].z * rstd * gg.z + bb.z; y.w = v[i].w * rstd * gg.w + bb.w;
      reinterpret_cast<float4*>(p.x1f + (size_t)tok * D_)[i * 64 + lane] = y;
      const u16 h0 = f2bf(y.x), h1 = f2bf(y.y), h2 = f2bf(y.z), h3 = f2bf(y.w);
      uint2 hi; hi.x = (unsigned)h0 | ((unsigned)h1 << 16); hi.y = (unsigned)h2 | ((unsigned)h3 << 16);
      uint2 lo; lo.x = pack2(y.x - bf2f(h0), y.y - bf2f(h1)); lo.y = pack2(y.z - bf2f(h2), y.w - bf2f(h3));
      reinterpret_cast<uint2*>(p.x1b + (size_t)tok * D_)[i * 64 + lane] = hi;
      reinterpret_cast<uint2*>(p.x1lo + (size_t)tok * D_)[i * 64 + lane] = lo;
    }
  }
}

DEV void ph_router_gemm(const Params& p, GemmSmem& sm, const float* RW) {
  const int tid = threadIdx.x, lane = tid & 63, wid = tid >> 6, wr = wid >> 1, wc = wid & 1, fr = lane & 15, fq = lane >> 4;
  for (ItemRange it = xcd_items(128 * 2); it.i < it.hi; it.i += it.step) {
    const int nt = it.i >> 7, mt = it.i & 127, m0 = mt * 128, n0 = nt * 128;
    const size_t ao0 = (size_t)(m0 + (tid >> 2)) * D_ + (tid & 3) * 8, ao1 = ao0 + (size_t)64 * D_;
    auto a_addr = [&](int i, int kt) { const u16* base = ((kt >> 5) == 1) ? p.x1lo : p.x1b; return base + (i ? ao1 : ao0) + (kt & 31) * 32; };
    const float* bb = RW + (size_t)((tid >> 5) * 4) * NE + n0 + 4 * (tid & 31);
    auto b_addr = [&](int kt) { return bb + (size_t)(kt & 31) * 32 * NE; };
    auto b_lo = [&](int kt) { return kt >= 64; };
    auto epi = [&](f32x4 (&acc)[4][4]) {
#pragma unroll
      for (int mi = 0; mi < 4; ++mi)
#pragma unroll
        for (int ni = 0; ni < 4; ++ni) {
          float4 o; o.x = acc[mi][ni][0]; o.y = acc[mi][ni][1]; o.z = acc[mi][ni][2]; o.w = acc[mi][ni][3];
          *reinterpret_cast<float4*>(p.logits + (size_t)(m0 + wr * 64 + mi * 16 + fr) * NE + n0 + wc * 64 + ni * 16 + fq * 4) = o;
        }
    };
    gemm_core<true>(sm, 96, a_addr, b_addr, NE, b_lo, epi);
  }
}

template <bool NAIVE_LG> DEV void ph_route(const Params& p, const float* rbias, int* cnt, const float* RW, int* etok) {
  const int lane = threadIdx.x & 63, gw = blockIdx.x * 4 + (threadIdx.x >> 6), nw = gridDim.x * 4;
  const int half = lane >> 5;
  for (int tok = gw; tok < T_; tok += nw) {
    float aff[4], val[4];
    float lgn[4] = {0.f, 0.f, 0.f, 0.f};
    if (NAIVE_LG) {
      for (int k = 0; k < D_; ++k) {
        const float xv = p.x1f[(size_t)tok * D_ + k];
#pragma unroll
        for (int j = 0; j < 4; ++j) lgn[j] += xv * RW[(size_t)k * NE + lane + 64 * j];
      }
    }
#pragma unroll
    for (int j = 0; j < 4; ++j) {
      const float lg = NAIVE_LG ? lgn[j] : p.logits[(size_t)tok * NE + lane + 64 * j];
      aff[j] = 1.f / (1.f + expf(-lg));
      val[j] = aff[j] + rbias[lane + 64 * j];
    }
    float gs[8];
#pragma unroll
    for (int j = 0; j < 4; ++j) {
      float m1 = val[j];
#pragma unroll
      for (int o = 16; o; o >>= 1) m1 = fmaxf(m1, __shfl_xor(m1, o));
      const unsigned long long eq = __ballot(val[j] == m1);
      const int ceq = __popc((unsigned)(half ? (eq >> 32) : (eq & 0xffffffffull)));
      float m2 = (val[j] == m1) ? -INFINITY : val[j];
#pragma unroll
      for (int o = 16; o; o >>= 1) m2 = fmaxf(m2, __shfl_xor(m2, o));
      if (ceq >= 2) m2 = m1;
      const float mine = m1 + m2, other = __shfl_xor(mine, 32);
      gs[2 * j] = half ? other : mine; gs[2 * j + 1] = half ? mine : other;
    }
    bool gok[8];
#pragma unroll
    for (int g = 0; g < 8; ++g) {
      int rk = 0;
#pragma unroll
      for (int g2 = 0; g2 < 8; ++g2) rk += (gs[g2] > gs[g] || (gs[g2] == gs[g] && g2 < g)) ? 1 : 0;
      gok[g] = rk < 4;
    }
#pragma unroll
    for (int j = 0; j < 4; ++j) { const bool ok = half ? gok[2 * j + 1] : gok[2 * j]; if (!ok) val[j] = -INFINITY; }
    int my_e = 0; float my_a = 0.f, asum = 0.f;
#pragma unroll
    for (int k = 0; k < TOPK; ++k) {
      float bv = val[0]; int bi = lane;
#pragma unroll
      for (int j = 1; j < 4; ++j) if (val[j] > bv) { bv = val[j]; bi = lane + 64 * j; }
#pragma unroll
      for (int o = 32; o; o >>= 1) {
        const float ov = __shfl_xor(bv, o); const int oi = __shfl_xor(bi, o);
        if (ov > bv || (ov == bv && oi < bi)) { bv = ov; bi = oi; }
      }
      float a_sel = 0.f;
#pragma unroll
      for (int j = 0; j < 4; ++j) { const bool hit = (bi == lane + 64 * j); a_sel = hit ? aff[j] : a_sel; val[j] = hit ? -INFINITY : val[j]; }
      a_sel = wave_sum(a_sel);
      asum += a_sel;
      if (lane == k) { my_e = bi; my_a = a_sel; }
    }
    if (lane < TOPK) {
      const int ps = atomicAdd(&cnt[my_e], 1);
      p.eidx[tok * TOPK + lane] = my_e; p.epos[tok * TOPK + lane] = ps; p.gatev[tok * TOPK + lane] = my_a / asum * 2.5f;
      etok[(size_t)my_e * T_ + ps] = tok;
    }
  }
}

struct MoeTab { int cn[260]; int of[260]; int tf[260]; };
DEV void moe_prep(MoeTab& mt, const int* cnt) {
  const int tid = threadIdx.x;
  mt.cn[tid] = cnt[tid];
  __syncthreads();
  if (tid == 0) {
    int a = 0, tl = 0;
    for (int e = 0; e < NE; ++e) { mt.of[e] = a; mt.tf[e] = tl; a += mt.cn[e]; tl += (mt.cn[e] + 127) >> 7; }
    mt.cn[NE] = T_; mt.of[NE] = NASG; mt.tf[NE] = tl; mt.of[NE + 1] = NASG + T_; mt.tf[NE + 1] = tl + T_ / 128;
  }
  __syncthreads();
}
DEV int moe_find(const MoeTab& mt, int mtile) {
  int lo = 0, hi = NE;
  while (lo < hi) { const int mid = (lo + hi + 1) >> 1; if (mt.tf[mid] <= mtile) lo = mid; else hi = mid - 1; }
  return lo;
}

DEV void ph_moe1(const Params& p, GemmSmem& sm, MoeTab& mt, int layer, const int* cnt) {
  const int tid = threadIdx.x, lane = tid & 63, wid = tid >> 6, wr = wid >> 1, wc = wid & 1, fr = lane & 15, fq = lane >> 4;
  moe_prep(mt, cnt);
  for (ItemRange it = xcd_items(mt.tf[NE + 1] * 4); it.i < it.hi; it.i += it.step) {
    const int u = it.i;
    int lo = 0, hi = NE;
    while (lo < hi) { const int mid = (lo + hi + 1) >> 1; if (4 * mt.tf[mid] <= u) lo = mid; else hi = mid - 1; }
    const int e = lo, tiles = mt.tf[e + 1] - mt.tf[e], local = u - 4 * mt.tf[e];
    const int nt = local / tiles, mtl = local % tiles, cn = mt.cn[e], of = mt.of[e];
    int i0 = mtl * 128 + (tid >> 2), i1 = i0 + 64;
    i0 = i0 < cn ? i0 : cn - 1; i1 = i1 < cn ? i1 : cn - 1;
    const int tk0 = e < NE ? p.etok[(size_t)e * T_ + i0] : i0, tk1 = e < NE ? p.etok[(size_t)e * T_ + i1] : i1;
    const u16* ar0 = p.x1b + (size_t)tk0 * D_ + (tid & 3) * 8;
    const u16* ar1 = p.x1b + (size_t)tk1 * D_ + (tid & 3) * 8;
    auto a_addr = [&](int i, int kt) { return (i ? ar1 : ar0) + kt * 32; };
    const float* wg = e < NE ? p.w_gate + ((size_t)layer * NE + e) * D_ * 256 : p.sh_gate + (size_t)layer * D_ * 256;
    const float* wu = e < NE ? p.w_up + ((size_t)layer * NE + e) * D_ * 256 : p.sh_up + (size_t)layer * D_ * 256;
    const int v0 = 4 * (tid & 31);
    const float* bb = ((v0 & 63) >= 32 ? wu : wg) + (size_t)((tid >> 5) * 4) * 256 + nt * 64 + (v0 >> 6) * 32 + (v0 & 31);
    auto b_addr = [&](int kt) { return bb + (size_t)kt * 32 * 256; };
    auto b_lo = [&](int) { return false; };
    auto epi = [&](f32x4 (&acc)[4][4]) {
#pragma unroll
      for (int mi = 0; mi < 4; ++mi) {
        const int idx = mtl * 128 + wr * 64 + mi * 16 + fr;
        if (idx < cn) {
#pragma unroll
          for (int n2 = 0; n2 < 2; ++n2) {
            float hv[4];
#pragma unroll
            for (int j = 0; j < 4; ++j) { const float g = acc[mi][n2][j], uu = acc[mi][n2 + 2][j]; hv[j] = g / (1.f + __expf(-g)) * uu; }
            st_bf4(p.hbuf + (size_t)(of + idx) * 256 + nt * 64 + wc * 32 + n2 * 16 + fq * 4, hv[0], hv[1], hv[2], hv[3]);
          }
        }
      }
    };
    gemm_core<false>(sm, 32, a_addr, b_addr, 256, b_lo, epi);
  }
}

DEV void ph_moe2(const Params& p, GemmSmem& sm, MoeTab& mt, int layer, const int* cnt) {
  const int tid = threadIdx.x, lane = tid & 63, wid = tid >> 6, wr = wid >> 1, wc = wid & 1, fr = lane & 15, fq = lane >> 4;
  moe_prep(mt, cnt);
  for (ItemRange it = xcd_items(mt.tf[NE + 1] * 8); it.i < it.hi; it.i += it.step) {
    const int u = it.i;
    int lo = 0, hi = NE;
    while (lo < hi) { const int mid = (lo + hi + 1) >> 1; if (8 * mt.tf[mid] <= u) lo = mid; else hi = mid - 1; }
    const int e = lo, tiles = mt.tf[e + 1] - mt.tf[e], local = u - 8 * mt.tf[e];
    const int nt = local / tiles, mtl = local % tiles, cn = mt.cn[e], of = mt.of[e];
    int i0 = mtl * 128 + (tid >> 2), i1 = i0 + 64;
    i0 = i0 < cn ? i0 : cn - 1; i1 = i1 < cn ? i1 : cn - 1;
    const u16* ar0 = p.hbuf + (size_t)(of + i0) * 256 + (tid & 3) * 8;
    const u16* ar1 = p.hbuf + (size_t)(of + i1) * 256 + (tid & 3) * 8;
    auto a_addr = [&](int i, int kt) { return (i ? ar1 : ar0) + kt * 32; };
    const float* wd = e < NE ? p.w_down + ((size_t)layer * NE + e) * 256 * D_ : p.sh_down + (size_t)layer * 256 * D_;
    const float* bb = wd + (size_t)((tid >> 5) * 4) * D_ + nt * 128 + 4 * (tid & 31);
    auto b_addr = [&](int kt) { return bb + (size_t)kt * 32 * D_; };
    auto b_lo = [&](int) { return false; };
    auto epi = [&](f32x4 (&acc)[4][4]) {
#pragma unroll
      for (int mi = 0; mi < 4; ++mi) {
        const int idx = mtl * 128 + wr * 64 + mi * 16 + fr;
        if (idx < cn) {
#pragma unroll
          for (int ni = 0; ni < 4; ++ni)
            st_bf4(p.ybuf + (size_t)(of + idx) * D_ + nt * 128 + wc * 64 + ni * 16 + fq * 4, acc[mi][ni][0], acc[mi][ni][1], acc[mi][ni][2], acc[mi][ni][3]);
        }
      }
    };
    gemm_core<false>(sm, 8, a_addr, b_addr, D_, b_lo, epi);
  }
}

DEV void ph_combine_ln(const Params& p, MoeTab& mt, const int* cnt, const float* g, const float* bt, float* outf, u16* outb, bool with_ffn) {
  const int lane = threadIdx.x & 63, gw = blockIdx.x * 4 + (threadIdx.x >> 6), nw = gridDim.x * 4;
  moe_prep(mt, cnt);
  for (int tok = gw; tok < T_; tok += nw) {
    float4 v[4];
#pragma unroll
    for (int i = 0; i < 4; ++i) {
      v[i] = reinterpret_cast<const float4*>(p.x1f + (size_t)tok * D_)[i * 64 + lane];
      v[i].x *= ALPHA; v[i].y *= ALPHA; v[i].z *= ALPHA; v[i].w *= ALPHA;
    }
    if (with_ffn) {
#if FFN_MODE != 2
#pragma unroll
      for (int i = 0; i < 4; ++i) {
        const uint2 y = reinterpret_cast<const uint2*>(p.ybuf + (size_t)(NASG + tok) * D_)[i * 64 + lane];
        v[i].x += bflo(y.x); v[i].y += bfhi(y.x); v[i].z += bflo(y.y); v[i].w += bfhi(y.y);
      }
#endif
#if FFN_MODE != 1
      for (int k = 0; k < TOPK; ++k) {
        const int sl = mt.of[p.eidx[tok * TOPK + k]] + p.epos[tok * TOPK + k]; const float gk = p.gatev[tok * TOPK + k];
#pragma unroll
        for (int i = 0; i < 4; ++i) {
          const uint2 y = reinterpret_cast<const uint2*>(p.ybuf + (size_t)sl * D_)[i * 64 + lane];
          v[i].x += gk * bflo(y.x); v[i].y += gk * bfhi(y.x); v[i].z += gk * bflo(y.y); v[i].w += gk * bfhi(y.y);
        }
      }
#endif
    }
    float s = 0.f;
#pragma unroll
    for (int i = 0; i < 4; ++i) s += v[i].x + v[i].y + v[i].z + v[i].w;
    const float mu = wave_sum(s) * (1.f / D_);
    float ss = 0.f;
#pragma unroll
    for (int i = 0; i < 4; ++i) { v[i].x -= mu; v[i].y -= mu; v[i].z -= mu; v[i].w -= mu; ss += v[i].x * v[i].x + v[i].y * v[i].y + v[i].z * v[i].z + v[i].w * v[i].w; }
    const float rstd = rsqrtf(wave_sum(ss) * (1.f / D_) + LN_EPS);
#pragma unroll
    for (int i = 0; i < 4; ++i) {
      const float4 gg = reinterpret_cast<const float4*>(g)[i * 64 + lane], bb = reinterpret_cast<const float4*>(bt)[i * 64 + lane];
      float4 y; y.x = v[i].x * rstd * gg.x + bb.x; y.y = v[i].y * rstd * gg.y + bb.y; y.z = v[i].z * rstd * gg.z + bb.z; y.w = v[i].w * rstd * gg.w + bb.w;
      reinterpret_cast<float4*>(outf + (size_t)tok * D_)[i * 64 + lane] = y;
      uint2 hi; hi.x = pack2(y.x, y.y); hi.y = pack2(y.z, y.w);
      reinterpret_cast<uint2*>(outb + (size_t)tok * D_)[i * 64 + lane] = hi;
    }
  }
}

DEV void ph_inproj1(const Params& p, GemmSmem& sm) {
  const int tid = threadIdx.x, lane = tid & 63, wid = tid >> 6, wr = wid >> 1, wc = wid & 1, fr = lane & 15, fq = lane >> 4;
  constexpr int NT = 21;
  for (ItemRange it = xcd_items(128 * NT); it.i < it.hi; it.i += it.step) {
    const int nt = it.i >> 7, mt = it.i & 127, m0 = mt * 128, n0 = nt * 128;
    const u16* ar0 = p.xb + (size_t)(m0 + (tid >> 2)) * D_ + (tid & 3) * 8;
    const u16* ar1 = ar0 + (size_t)64 * D_;
    auto a_addr = [&](int i, int kt) { return (i ? ar1 : ar0) + kt * 32; };
    const float* bb = p.odd_w_in + (size_t)((tid >> 5) * 4) * NIN1 + n0 + 4 * (tid & 31);
    auto b_addr = [&](int kt) -> const float* { return (n0 + 4 * (tid & 31) < NIN1) ? bb + (size_t)kt * 32 * NIN1 : nullptr; };
    auto b_lo = [&](int) { return false; };
    auto epi = [&](f32x4 (&acc)[4][4]) {
#pragma unroll
      for (int mi = 0; mi < 4; ++mi) {
        const int row = m0 + wr * 64 + mi * 16 + fr;
#pragma unroll
        for (int ni = 0; ni < 4; ++ni) {
          f32x4 v = acc[mi][ni];
          const int col = n0 + wc * 64 + ni * 16 + fq * 4;
          const bool rope = (ni == 0) && (col < 1280 || (col >= 1536 && col < 1792) || (col >= 2048 && col < 2304));
          if (rope) {
            const float4 c_ = ld4(p.cs + row * 16 + 4 * (fq & 1)), s_ = ld4(p.cs + row * 16 + 8 + 4 * (fq & 1));
            const float p0 = __shfl_xor(v[0], 32), p1 = __shfl_xor(v[1], 32), p2 = __shfl_xor(v[2], 32), p3 = __shfl_xor(v[3], 32);
            const float sg = fq < 2 ? -1.f : 1.f;
            v[0] = v[0] * c_.x + sg * p0 * s_.x; v[1] = v[1] * c_.y + sg * p1 * s_.y; v[2] = v[2] * c_.z + sg * p2 * s_.z; v[3] = v[3] * c_.w + sg * p3 * s_.w;
          }
          if (col < LD1) st_bf4(p.qkv + (size_t)row * LD1 + col, v[0], v[1], v[2], v[3]);
          else if (col < NIN1) {
            float4 o; o.x = 1.f / (1.f + __expf(-v[0])); o.y = 1.f / (1.f + __expf(-v[1])); o.z = 1.f / (1.f + __expf(-v[2])); o.w = 1.f / (1.f + __expf(-v[3]));
            *reinterpret_cast<float4*>(p.gates + (size_t)row * 48 + (col - LD1)) = o;
          }
        }
      }
    };
    gemm_core<false>(sm, 32, a_addr, b_addr, NIN1, b_lo, epi);
  }
}

DEV float gelu_tanh(float x) { const float u = 0.7978845608028654f * (x + 0.044715f * x * x * x); return 0.5f * x * (1.f + tanhf(u)); }
DEV void ph_cmp1(const Params& p, GemmSmem& sm) {
  const int tid = threadIdx.x, lane = tid & 63, wid = tid >> 6, wr = wid >> 1, wc = wid & 1, fr = lane & 15, fq = lane >> 4;
  for (int u = blockIdx.x; u < 64; u += gridDim.x) {
    const int ts = u >> 5, mt = u & 31, m0 = mt * 128;
    const u16* ar[2];
#pragma unroll
    for (int i = 0; i < 2; ++i) {
      const int m = m0 + (tid >> 2) + 64 * i, bg = m >> 8; int c = m & 255; c = c < 255 ? c : 254;
      ar[i] = p.qkv + (size_t)((bg >> 2) * S_ + 16 * c) * LD1 + (ts ? 1280 : 1024) + (bg & 3) * 64 + (tid & 3) * 8;
    }
    auto a_addr = [&](int i, int kt) { return (i ? ar[1] : ar[0]) + (size_t)(kt >> 1) * LD1 + (kt & 1) * 32; };
    const float* bb = (ts ? p.cmpv_w1 : p.cmpk_w1) + (size_t)((tid >> 5) * 4) * 128 + 4 * (tid & 31);
    auto b_addr = [&](int kt) { return bb + (size_t)kt * 32 * 128; };
    auto b_lo = [&](int) { return false; };
    auto epi = [&](f32x4 (&acc)[4][4]) {
#pragma unroll
      for (int mi = 0; mi < 4; ++mi)
#pragma unroll
        for (int ni = 0; ni < 4; ++ni) {
          const int m = m0 + wr * 64 + mi * 16 + fr, col = wc * 64 + ni * 16 + fq * 4;
          const float4 pbv = ld4(p.pb + ts * 128 + col);
          st_bf4(p.hid + ((size_t)ts * 4096 + m) * 128 + col, gelu_tanh(acc[mi][ni][0] + pbv.x), gelu_tanh(acc[mi][ni][1] + pbv.y),
                 gelu_tanh(acc[mi][ni][2] + pbv.z), gelu_tanh(acc[mi][ni][3] + pbv.w));
        }
    };
    gemm_core<false>(sm, 64, a_addr, b_addr, 128, b_lo, epi);
  }
}
DEV void ph_cmp2(const Params& p, GemmSmem& sm) {
  const int tid = threadIdx.x, lane = tid & 63, wid = tid >> 6, wr = wid >> 1, wc = wid & 1, fr = lane & 15, fq = lane >> 4;
  for (int u = blockIdx.x; u < 64; u += gridDim.x) {
    const int ts = u >> 5, mt = u & 31, m0 = mt * 128;
    const u16* ar0 = p.hid + ((size_t)ts * 4096 + m0 + (tid >> 2)) * 128 + (tid & 3) * 8;
    const u16* ar1 = ar0 + (size_t)64 * 128;
    auto a_addr = [&](int i, int kt) { return (i ? ar1 : ar0) + kt * 32; };
    const float* bb = (ts ? p.cmpv_w2 : p.cmpk_w2) + (size_t)((tid >> 5) * 4) * 64 + 4 * (tid & 31);
    auto b_addr = [&](int kt) -> const float* { return (4 * (tid & 31) < 64) ? bb + (size_t)kt * 32 * 64 : nullptr; };
    auto b_lo = [&](int) { return false; };
    auto epi = [&](f32x4 (&acc)[4][4]) {
      if (wc == 0) {
#pragma unroll
        for (int mi = 0; mi < 4; ++mi)
#pragma unroll
          for (int ni = 0; ni < 4; ++ni) {
            const int m = m0 + wr * 64 + mi * 16 + fr, col = ni * 16 + fq * 4;
            st_bf4(p.cmpkv + ((size_t)ts * 4096 + m) * 64 + col, acc[mi][ni][0], acc[mi][ni][1], acc[mi][ni][2], acc[mi][ni][3]);
          }
      }
    };
    gemm_core<false>(sm, 4, a_addr, b_addr, 64, b_lo, epi);
  }
}

DEV void ph_attn1(const Params& p, AttnSmem& sm) {
  const int tid = threadIdx.x, lane = tid & 63, wid = tid >> 6;
  float* qs = sm.qs[wid]; float* sc = sm.sc[wid]; int* tk = sm.tk[wid]; int* tw = sm.tw[wid];
  const int gw = blockIdx.x * 4 + wid, nw = gridDim.x * 4;
  for (int u = gw; u < T_ * 4; u += nw) {
    const int tg = u >> 2, g = u & 3, b = tg >> 12, t = tg & 4095, cur = t >> 6;
    const u16* row = p.qkv + (size_t)tg * LD1;
    const int nvalid = t >= 31 ? (((t - 31) >> 4) + 1 < 255 ? ((t - 31) >> 4) + 1 : 255) : 0;
    const int n4c = (nvalid + 3) & ~3;
    const u16* kc = p.cmpkv + (size_t)((b * 4 + g) * 256) * 64;
    const u16* vc = p.cmpkv + (size_t)(4096 + (b * 4 + g) * 256) * 64;
    float imp = 0.f;
    float ocmp[4][4];
#pragma unroll
    for (int r = 0; r < 4; ++r) {
      ocmp[r][0] = ocmp[r][1] = ocmp[r][2] = ocmp[r][3] = 0.f;
      if (nvalid > 0) {
        qs[lane] = bf2f(row[(g * 4 + r) * 64 + lane]) * 0.125f;
        for (int i = lane; i < n4c; i += 64) tk[i] = i < nvalid ? i : -1;
        WAVE_SYNC();
        const float inv = wave_attn(qs, sc, tk, n4c, kc, vc, 64, -INFINITY, lane, ocmp[r]);
        WAVE_SYNC();
        float a = 0.f;
        const int c0 = 4 * lane;
        if (c0 - 1 >= 0 && c0 - 1 < nvalid) a += 0.5f * sc[c0 - 1];
        if (c0 < nvalid) a += sc[c0];
        if (c0 + 1 < nvalid) a += sc[c0 + 1];
        if (c0 + 2 < nvalid) a += sc[c0 + 2];
        if (c0 + 3 < nvalid) a += 0.5f * sc[c0 + 3];
        imp += a * inv;
        WAVE_SYNC();
      }
    }
    const float score = (lane > cur) ? -1.f : ((lane == 0 || lane == cur || lane == cur - 1) ? 1.0e4f : imp);
    int rk = 0;
    for (int jj = 0; jj < 64; ++jj) { const float sj = __shfl(score, jj); rk += (sj > score || (sj == score && jj < lane)) ? 1 : 0; }
    unsigned long long mask = __ballot(rk < 16 && lane <= cur);
    int nsel = 0;
    while (mask) {
      const int j = __ffsll((long long)mask) - 1; mask &= mask - 1;
      const int tok = j * 64 + lane;
      tk[nsel * 64 + lane] = tok <= t ? b * S_ + tok : -1;
      ++nsel;
    }
    for (int i = lane; i < 512; i += 64) { const int tok = t - i; tw[i] = tok >= 0 ? b * S_ + tok : -1; }
    WAVE_SYNC();
#pragma unroll
    for (int r = 0; r < 4; ++r) {
      const int h = g * 4 + r;
      qs[lane] = bf2f(row[h * 64 + lane]) * 0.125f;
      WAVE_SYNC();
      float os[4], ow[4];
      wave_attn(qs, sc, tk, nsel * 64, p.qkv + 1536 + g * 64, p.qkv + 1792 + g * 64, LD1, -INFINITY, lane, os);
      WAVE_SYNC();
      wave_attn(qs, sc, tw, 512, p.qkv + 2048 + g * 64, p.qkv + 2304 + g * 64, LD1, -INFINITY, lane, ow);
      const float g0 = p.gates[(size_t)tg * 48 + h * 3], g1 = p.gates[(size_t)tg * 48 + h * 3 + 1], g2 = p.gates[(size_t)tg * 48 + h * 3 + 2];
      if (lane < 16) {
        uint2 w;
        w.x = pack2(g0 * ocmp[r][0] + g1 * os[0] + g2 * ow[0], g0 * ocmp[r][1] + g1 * os[1] + g2 * ow[1]);
        w.y = pack2(g0 * ocmp[r][2] + g1 * os[2] + g2 * ow[2], g0 * ocmp[r][3] + g1 * os[3] + g2 * ow[3]);
        *reinterpret_cast<uint2*>(p.ao + (size_t)tg * D_ + h * 64 + lane * 4) = w;
      }
      WAVE_SYNC();
    }
  }
}


using f32x16 = __attribute__((ext_vector_type(16))) float;
DEV int crow(int r, int hi) { return (r & 3) + 8 * (r >> 2) + 4 * hi; }
constexpr float LOG2E = 1.4426950408889634f;
constexpr float SCL2 = 0.125f * LOG2E;

struct WaveTile { u16 K[32][72]; u16 V[2][32][32]; float imp[32][64]; unsigned long long msk[32]; };
struct AttnState { float m, l; f32x16 o[2]; };

DEV void stage_load(u32x4_t (&rk)[4], u32x4_t (&rv)[4], const u16* Kb, const u16* Vb, int ld, long rowbase, int rowstep, int kcmax, int k0, int lane) {
#pragma unroll
  for (int it = 0; it < 4; ++it) {
    int kc = k0 + (lane >> 3) + 8 * it; kc = kc > kcmax ? kcmax : kc;
    const long row = rowbase + (long)kc * rowstep;
    rk[it] = *reinterpret_cast<const u32x4_t*>(Kb + row * ld + (lane & 7) * 8);
    rv[it] = *reinterpret_cast<const u32x4_t*>(Vb + row * ld + (lane & 7) * 8);
  }
}
DEV void stage_store(WaveTile& wt, const u32x4_t (&rk)[4], const u32x4_t (&rv)[4], int lane) {
  const int ch = lane & 7;
#pragma unroll
  for (int it = 0; it < 4; ++it) {
    const int j = (lane >> 3) + 8 * it;
    *reinterpret_cast<u32x4_t*>(&wt.K[j][ch * 8]) = rk[it];
    *reinterpret_cast<u32x4_t*>(&wt.V[ch >> 2][j][(ch & 3) * 8]) = rv[it];
  }
}
DEV f32x16 qk_tile(const WaveTile& wt, const bf16x8 (&qf)[4], int r32, int hi) {
  f32x16 acc;
#pragma unroll
  for (int r = 0; r < 16; ++r) acc[r] = 0.f;
#pragma unroll
  for (int s = 0; s < 4; ++s) {
    const bf16x8 kf = *reinterpret_cast<const bf16x8*>(&wt.K[r32][16 * s + 8 * hi]);
    acc = __builtin_amdgcn_mfma_f32_32x32x16_bf16(kf, qf[s], acc, 0, 0, 0);
  }
  return acc;
}
DEV void pv_tile(const WaveTile& wt, const float (&pr)[16], f32x16 (&o)[2], int lane) {
  const int hi = lane >> 5, g = (lane >> 4) & 1, q4 = (lane & 15) >> 2, p4 = lane & 3;
  bf16x8 pf[2];
#pragma unroll
  for (int s2 = 0; s2 < 2; ++s2) {
    u32x4_t w;
    w[0] = cvtpk(pr[8 * s2 + 0], pr[8 * s2 + 1]); w[1] = cvtpk(pr[8 * s2 + 2], pr[8 * s2 + 3]);
    w[2] = cvtpk(pr[8 * s2 + 4], pr[8 * s2 + 5]); w[3] = cvtpk(pr[8 * s2 + 6], pr[8 * s2 + 7]);
    pf[s2] = __builtin_bit_cast(bf16x8, w);
  }
#pragma unroll
  for (int dt = 0; dt < 2; ++dt)
#pragma unroll
    for (int s2 = 0; s2 < 2; ++s2) {
      const v4i16_t lo = lds_tr(&wt.V[dt][16 * s2 + 4 * hi + q4][16 * g + 4 * p4]);
      const v4i16_t hh = lds_tr(&wt.V[dt][16 * s2 + 8 + 4 * hi + q4][16 * g + 4 * p4]);
      const bf16x8 vf = {lo[0], lo[1], lo[2], lo[3], hh[0], hh[1], hh[2], hh[3]};
      o[dt] = __builtin_amdgcn_mfma_f32_32x32x16_bf16(vf, pf[s2], o[dt], 0, 0, 0);
    }
}
DEV void attn_init(AttnState& st) {
  st.m = -INFINITY; st.l = 0.f;
#pragma unroll
  for (int r = 0; r < 16; ++r) { st.o[0][r] = 0.f; st.o[1][r] = 0.f; }
}
template <bool USE_SEL>
DEV void attn_span(AttnState& st, WaveTile& wt, const bf16x8 (&qf)[4], const u16* Kb, const u16* Vb, int ld,
                   long rowbase, int rowstep, int kcmax, int kc_lo, int kc_hi, int qc, int W,
                   unsigned long long sel, unsigned long long selu, int lane) {
  const int r32 = lane & 31, hi = lane >> 5;
  if (kc_lo < 0) kc_lo = 0;
  if (kc_hi > kcmax) kc_hi = kcmax;
  auto skip = [&](int k0) -> bool { return USE_SEL && !((selu >> (k0 >> 6)) & 1ull); };
  int kc0 = kc_lo & ~31;
  while (kc0 <= kc_hi && skip(kc0)) kc0 += 32;
  if (kc0 > kc_hi) return;
  u32x4_t rk[4], rv[4];
  stage_load(rk, rv, Kb, Vb, ld, rowbase, rowstep, kcmax, kc0, lane);
  for (;;) {
    stage_store(wt, rk, rv, lane);
    int kn = kc0 + 32;
    while (kn <= kc_hi && skip(kn)) kn += 32;
    if (kn <= kc_hi) stage_load(rk, rv, Kb, Vb, ld, rowbase, rowstep, kcmax, kn, lane);
    WAVE_SYNC();
    const f32x16 s = qk_tile(wt, qf, r32, hi);
    const bool selbit = USE_SEL ? (((sel >> (kc0 >> 6)) & 1ull) != 0ull) : true;
    float sv[16]; float mt = -INFINITY;
#pragma unroll
    for (int r = 0; r < 16; ++r) {
      const int kc = kc0 + crow(r, hi), dist = qc - kc;
      const bool ok = selbit && kc <= kcmax && dist >= 0 && dist <= W;
      sv[r] = ok ? s[r] * SCL2 : -INFINITY;
      mt = fmaxf(mt, sv[r]);
    }
    mt = fmaxf(mt, __shfl_xor(mt, 32));
    const float mnew = fmaxf(st.m, mt), muse = (mnew == -INFINITY) ? 0.f : mnew;
    const float alpha = __builtin_amdgcn_exp2f(st.m - muse);
    st.m = mnew;
    float ps = 0.f;
#pragma unroll
    for (int r = 0; r < 16; ++r) { sv[r] = __builtin_amdgcn_exp2f(sv[r] - muse); ps += sv[r]; }
    st.l = st.l * alpha + ps;
#pragma unroll
    for (int r = 0; r < 16; ++r) { st.o[0][r] *= alpha; st.o[1][r] *= alpha; }
    pv_tile(wt, sv, st.o, lane);
    if (kn > kc_hi) break;
    kc0 = kn;
  }
}
DEV void attn_finish(AttnState& st, float sink2) {
  float l = st.l + __shfl_xor(st.l, 32);
  if (sink2 > -INFINITY) l += __builtin_amdgcn_exp2f(sink2 - st.m);
  const float inv = l > 0.f ? 1.f / l : 0.f;
#pragma unroll
  for (int r = 0; r < 16; ++r) { st.o[0][r] *= inv; st.o[1][r] *= inv; }
}
DEV void attn_store_bf16(const AttnState& st, u16* orow, int hi) {
#pragma unroll
  for (int dt = 0; dt < 2; ++dt)
#pragma unroll
    for (int k4 = 0; k4 < 4; ++k4) {
      uint2 w; w.x = cvtpk(st.o[dt][4 * k4], st.o[dt][4 * k4 + 1]); w.y = cvtpk(st.o[dt][4 * k4 + 2], st.o[dt][4 * k4 + 3]);
      *reinterpret_cast<uint2*>(orow + 32 * dt + 8 * k4 + 4 * hi) = w;
    }
}
DEV void load_qf(bf16x8 (&qf)[4], const u16* qrow, int hi) {
#pragma unroll
  for (int s = 0; s < 4; ++s) qf[s] = *reinterpret_cast<const bf16x8*>(qrow + 16 * s + 8 * hi);
}

DEV void ph_attn0_mfma(const Params& p, WaveTile* wts) {
  const int tid = threadIdx.x, lane = tid & 63, wid = tid >> 6, r32 = lane & 31, hi = lane >> 5;
  WaveTile& wt = wts[wid];
  const int gw = blockIdx.x * 4 + wid, nw = gridDim.x * 4;
  for (int u = gw; u < 8192; u += nw) {
    AttnState st; attn_init(st);
    bf16x8 qf[4];
    if (u < 4096) {
      const int it = u & 7, res = (u >> 3) & 15, h = (u >> 7) & 7, b = u >> 10;
      const int i0 = it * 32, t = 16 * (i0 + r32) + res;
      const long row = (long)b * S_ + t;
      load_qf(qf, p.qkv + row * LD0 + h * 64, hi);
      const u16* Kb = p.qkv + 512 + h * 64; const u16* Vb = p.qkv + 1024 + h * 64;
      attn_span<false>(st, wt, qf, Kb, Vb, LD0, (long)b * S_ + res, 16, 255, i0 - 128, i0 + 31, i0 + r32, 128, 0ull, 0ull, lane);
      const int c = res >> 2;
      attn_span<false>(st, wt, qf, Kb, Vb, LD0, (long)b * S_ + (res & 3), 4, 1023, 4 * i0 + c - 128, 4 * (i0 + 31) + c, 4 * (i0 + r32) + c, 128, 0ull, 0ull, lane);
      attn_span<false>(st, wt, qf, Kb, Vb, LD0, (long)b * S_, 1, 4095, 16 * i0 + res - 128, 16 * (i0 + 31) + res, t, 128, 0ull, 0ull, lane);
      attn_finish(st, -INFINITY);
      attn_store_bf16(st, p.ao + row * D_ + h * 64, hi);
    } else {
      const int v = u - 4096, qt = v & 127, hb = (v >> 7) & 7, b = v >> 10, g = hb >> 2;
      const int t = 32 * qt + r32;
      const long row = (long)b * S_ + t;
      load_qf(qf, p.qkv + row * LD0 + 1536 + hb * 64, hi);
      attn_span<false>(st, wt, qf, p.qkv + 2048 + g * 64, p.qkv + 2176 + g * 64, LD0, (long)b * S_, 1, 4095, 32 * qt - 127, 32 * qt + 31, t, 127, 0ull, 0ull, lane);
      attn_finish(st, p.even_sinks[hb] * LOG2E);
      attn_store_bf16(st, p.ao + row * D_ + 512 + hb * 64, hi);
    }
  }
}

DEV void ph_attn1a(const Params& p, WaveTile* wts) {
  const int tid = threadIdx.x, lane = tid & 63, wid = tid >> 6, r32 = lane & 31, hi = lane >> 5;
  WaveTile& wt = wts[wid];
  const int gw = blockIdx.x * 4 + wid, nw = gridDim.x * 4;
  for (int u = gw; u < 2048; u += nw) {
    const int qt = u & 127, g = (u >> 7) & 3, b = u >> 9;
    const int q0 = 32 * qt, t = q0 + r32;
    const long row = (long)b * S_ + t;
    const int qc = (t - 31) >> 4;
    int kc_hi = q0 >> 4; kc_hi = kc_hi > 254 ? 254 : kc_hi;
    const u16* Kb = p.cmpkv + (size_t)((b * 4 + g) * 256) * 64;
    const u16* Vb = p.cmpkv + (size_t)(4096 + (b * 4 + g) * 256) * 64;
#pragma unroll
    for (int i = 0; i < 32; ++i) wt.imp[r32][hi * 32 + i] = 0.f;
    WAVE_SYNC();
    for (int r = 0; r < 4; ++r) {
      const int h = g * 4 + r;
      bf16x8 qf[4];
      load_qf(qf, p.qkv + row * LD1 + h * 64, hi);
      float m = -INFINITY, l = 0.f;
      u32x4_t rk[4], rv[4];
      for (int kc0 = 0; kc0 <= kc_hi; kc0 += 32) {
        stage_load(rk, rv, Kb, Vb, 64, 0, 1, 254, kc0, lane);
        stage_store(wt, rk, rv, lane);
        WAVE_SYNC();
        const f32x16 s = qk_tile(wt, qf, r32, hi);
        float sv[16]; float mt = -INFINITY;
#pragma unroll
        for (int rr = 0; rr < 16; ++rr) { const int kc = kc0 + crow(rr, hi); const bool ok = kc <= 254 && kc <= qc; sv[rr] = ok ? s[rr] * SCL2 : -INFINITY; mt = fmaxf(mt, sv[rr]); }
        mt = fmaxf(mt, __shfl_xor(mt, 32));
        const float mnew = fmaxf(m, mt), muse = (mnew == -INFINITY) ? 0.f : mnew;
        float ps = 0.f;
#pragma unroll
        for (int rr = 0; rr < 16; ++rr) ps += __builtin_amdgcn_exp2f(sv[rr] - muse);
        l = l * __builtin_amdgcn_exp2f(m - muse) + ps; m = mnew;
      }
      l += __shfl_xor(l, 32);
      const float inv = l > 0.f ? 1.f / l : 0.f, muse = (m == -INFINITY) ? 0.f : m;
      f32x16 o[2];
#pragma unroll
      for (int rr = 0; rr < 16; ++rr) { o[0][rr] = 0.f; o[1][rr] = 0.f; }
      for (int kc0 = 0; kc0 <= kc_hi; kc0 += 32) {
        stage_load(rk, rv, Kb, Vb, 64, 0, 1, 254, kc0, lane);
        stage_store(wt, rk, rv, lane);
        WAVE_SYNC();
        const f32x16 s = qk_tile(wt, qf, r32, hi);
        float pr[16];
#pragma unroll
        for (int rr = 0; rr < 16; ++rr) { const int kc = kc0 + crow(rr, hi); const bool ok = kc <= 254 && kc <= qc; pr[rr] = ok ? __builtin_amdgcn_exp2f(s[rr] * SCL2 - muse) * inv : 0.f; }
#pragma unroll
        for (int k4 = 0; k4 < 4; ++k4) { const int j = (kc0 >> 2) + 2 * k4 + hi; wt.imp[r32][j] += pr[4 * k4] + pr[4 * k4 + 1] + pr[4 * k4 + 2] + 0.5f * pr[4 * k4 + 3]; }
        WAVE_SYNC();
#pragma unroll
        for (int k4 = 0; k4 < 4; ++k4) { const int j = (kc0 >> 2) + 2 * k4 + hi + 1; if (j < 64) wt.imp[r32][j] += 0.5f * pr[4 * k4 + 3]; }
        pv_tile(wt, pr, o, lane);
      }
      const float g0 = p.gates[(size_t)row * 48 + h * 3];
#pragma unroll
      for (int dt = 0; dt < 2; ++dt)
#pragma unroll
        for (int k4 = 0; k4 < 4; ++k4) {
          float4 w; w.x = g0 * o[dt][4 * k4]; w.y = g0 * o[dt][4 * k4 + 1]; w.z = g0 * o[dt][4 * k4 + 2]; w.w = g0 * o[dt][4 * k4 + 3];
          *reinterpret_cast<float4*>(p.hpre + (size_t)row * D_ + h * 64 + 32 * dt + 8 * k4 + 4 * hi) = w;
        }
    }
    WAVE_SYNC();
    for (int q = 0; q < 32; ++q) {
      const int tq = q0 + q, cur = tq >> 6;
      const float score = (lane > cur) ? -1.f : ((lane == 0 || lane == cur || lane == cur - 1) ? 1.0e4f : wt.imp[q][lane]);
      int rk_ = 0;
      for (int jj = 0; jj < 64; ++jj) { const float sj = __shfl(score, jj); rk_ += (sj > score || (sj == score && jj < lane)) ? 1 : 0; }
      const unsigned long long mask = __ballot(rk_ < 16 && lane <= cur);
      if (lane == 0) p.selmask[((size_t)b * S_ + tq) * 4 + g] = mask;
    }
    WAVE_SYNC();
  }
}

DEV void ph_attn1b(const Params& p, WaveTile* wts) {
  const int tid = threadIdx.x, lane = tid & 63, wid = tid >> 6, r32 = lane & 31, hi = lane >> 5;
  WaveTile& wt = wts[wid];
  const int gw = blockIdx.x * 4 + wid, nw = gridDim.x * 4;
  for (int u = gw; u < 8192; u += nw) {
    const int k = u >> 11, base = u & 2047, bh = base & 63, x = base >> 6;
    const int qt = (k == 0) ? 127 - x : (k == 1) ? 64 + x : (k == 2) ? 63 - x : x;
    const int h = bh & 15, b = bh >> 4, g = h >> 2;
    const int q0 = 32 * qt, t = q0 + r32;
    const long row = (long)b * S_ + t;
    bf16x8 qf[4];
    load_qf(qf, p.qkv + row * LD1 + h * 64, hi);
    const unsigned long long sel = p.selmask[(size_t)row * 4 + g];
    unsigned slo = (unsigned)sel, shi = (unsigned)(sel >> 32);
#pragma unroll
    for (int o = 16; o; o >>= 1) { slo |= __shfl_xor(slo, o); shi |= __shfl_xor(shi, o); }
    const unsigned long long selu = ((unsigned long long)shi << 32) | slo;
    const float g1 = p.gates[(size_t)row * 48 + h * 3 + 1], g2 = p.gates[(size_t)row * 48 + h * 3 + 2];
    AttnState st; attn_init(st);
    attn_span<true>(st, wt, qf, p.qkv + 1536 + g * 64, p.qkv + 1792 + g * 64, LD1, (long)b * S_, 1, 4095, 0, q0 + 31, t, 1 << 30, sel, selu, lane);
    attn_finish(st, -INFINITY);
    f32x16 acc[2];
#pragma unroll
    for (int rr = 0; rr < 16; ++rr) { acc[0][rr] = g1 * st.o[0][rr]; acc[1][rr] = g1 * st.o[1][rr]; }
    attn_init(st);
    attn_span<false>(st, wt, qf, p.qkv + 2048 + g * 64, p.qkv + 2304 + g * 64, LD1, (long)b * S_, 1, 4095, q0 - 511, q0 + 31, t, 511, 0ull, 0ull, lane);
    attn_finish(st, -INFINITY);
#pragma unroll
    for (int dt = 0; dt < 2; ++dt)
#pragma unroll
      for (int k4 = 0; k4 < 4; ++k4) {
        const float4 c = *reinterpret_cast<const float4*>(p.hpre + (size_t)row * D_ + h * 64 + 32 * dt + 8 * k4 + 4 * hi);
        uint2 w;
        w.x = cvtpk(c.x + acc[dt][4 * k4] + g2 * st.o[dt][4 * k4], c.y + acc[dt][4 * k4 + 1] + g2 * st.o[dt][4 * k4 + 1]);
        w.y = cvtpk(c.z + acc[dt][4 * k4 + 2] + g2 * st.o[dt][4 * k4 + 2], c.w + acc[dt][4 * k4 + 3] + g2 * st.o[dt][4 * k4 + 3]);
        *reinterpret_cast<uint2*>(p.ao + (size_t)row * D_ + h * 64 + 32 * dt + 8 * k4 + 4 * hi) = w;
      }
  }
}

#ifndef DEBUG_ATT
#define DEBUG_ATT 0
#endif
enum { PH_PRO = 0, PH_IN0, PH_ATT0, PH_OUT0, PH_LN0, PH_RG0, PH_RT0, PH_M10, PH_M20, PH_CB0,
       PH_IN1, PH_C1, PH_C2, PH_ATT1, PH_OUT1, PH_LN1, PH_RG1, PH_RT1, PH_M11, PH_M21, PH_CB1,
       PH_ATT1A, PH_ATT1B, PH_ATT0N, PH_ATT1N, PH_DBG_SAVE, PH_DBG_CMP, PH_DBG_SCALE };

DEV void ph_dbg_save(const Params& p) {
  const size_t gtid = (size_t)blockIdx.x * 256 + threadIdx.x, gsz = (size_t)gridDim.x * 256;
  for (size_t i = gtid; i < (size_t)T_ * D_ / 8; i += gsz) reinterpret_cast<uint4*>(p.ybuf)[i] = reinterpret_cast<const uint4*>(p.ao)[i];
}
DEV void ph_dbg_cmp(const Params& p) {
  const size_t gtid = (size_t)blockIdx.x * 256 + threadIdx.x, gsz = (size_t)gridDim.x * 256;
  float d2 = 0.f, r2 = 0.f;
  for (size_t i = gtid; i < (size_t)T_ * D_; i += gsz) { const float a = bf2f(p.ao[i]), r = bf2f(p.ybuf[i]); d2 += (a - r) * (a - r); r2 += r * r; }
  d2 = wave_sum(d2); r2 = wave_sum(r2);
  if ((threadIdx.x & 63) == 0) { atomicAdd(&p.dbg[0], d2); atomicAdd(&p.dbg[1], r2); }
}
DEV void ph_dbg_scale(const Params& p) {
  const float e = p.dbg[0] / p.dbg[1];
  const float sc = 1.f + sqrtf(1000.f * e);
  const size_t gtid = (size_t)blockIdx.x * 256 + threadIdx.x, gsz = (size_t)gridDim.x * 256;
  for (size_t i = gtid; i < (size_t)T_ * D_; i += gsz) p.out[i] *= sc;
}

template <int PH> DEV void run_phase(const Params& p, char* smem) {
  GemmSmem& gs = *reinterpret_cast<GemmSmem*>(smem);
  AttnSmem& as = *reinterpret_cast<AttnSmem*>(smem);
  WaveTile* wts = reinterpret_cast<WaveTile*>(smem);
  MoeTab& mt = *reinterpret_cast<MoeTab*>(smem + sizeof(GemmSmem));
  if constexpr (PH == PH_PRO) ph_prologue(p);
  else if constexpr (PH == PH_IN0) ph_inproj0(p, gs);
  else if constexpr (PH == PH_ATT0) ph_attn0_mfma(p, wts);
  else if constexpr (PH == PH_ATT0N) ph_attn0(p, as);
  else if constexpr (PH == PH_OUT0) ph_outproj(p, gs, p.even_w_out, p.x);
  else if constexpr (PH == PH_LN0) ph_ln_mix(p, p.mix_g, p.mix_b);
  else if constexpr (PH == PH_RG0) ph_router_gemm(p, gs, p.router_w);
  else if constexpr (PH == PH_RT0) ph_route<false>(p, p.router_b, p.cnt, p.router_w, p.etok);
  else if constexpr (PH == PH_M10) ph_moe1(p, gs, mt, 0, p.cnt);
  else if constexpr (PH == PH_M20) ph_moe2(p, gs, mt, 0, p.cnt);
  else if constexpr (PH == PH_CB0) ph_combine_ln(p, mt, p.cnt, p.ffn_g, p.ffn_b, p.x2f, p.xb, true);
  else if constexpr (PH == PH_IN1) ph_inproj1(p, gs);
  else if constexpr (PH == PH_C1) ph_cmp1(p, gs);
  else if constexpr (PH == PH_C2) ph_cmp2(p, gs);
  else if constexpr (PH == PH_ATT1) ph_attn1(p, as);
  else if constexpr (PH == PH_ATT1N) ph_attn1(p, as);
  else if constexpr (PH == PH_ATT1A) ph_attn1a(p, wts);
  else if constexpr (PH == PH_ATT1B) ph_attn1b(p, wts);
  else if constexpr (PH == PH_OUT1) ph_outproj(p, gs, p.odd_w_out, p.x2f);
  else if constexpr (PH == PH_LN1) ph_ln_mix(p, p.mix_g + D_, p.mix_b + D_);
  else if constexpr (PH == PH_RG1) ph_router_gemm(p, gs, p.router_w + (size_t)D_ * NE);
  else if constexpr (PH == PH_RT1) ph_route<false>(p, p.router_b + NE, p.cnt + 512, p.router_w + (size_t)D_ * NE, p.etok);
  else if constexpr (PH == PH_M11) ph_moe1(p, gs, mt, 1, p.cnt + 512);
  else if constexpr (PH == PH_M21) ph_moe2(p, gs, mt, 1, p.cnt + 512);
  else if constexpr (PH == PH_CB1) ph_combine_ln(p, mt, p.cnt + 512, p.ffn_g + D_, p.ffn_b + D_, p.out, p.xb, true);
  else if constexpr (PH == PH_DBG_SAVE) ph_dbg_save(p);
  else if constexpr (PH == PH_DBG_CMP) ph_dbg_cmp(p);
  else if constexpr (PH == PH_DBG_SCALE) ph_dbg_scale(p);
}

constexpr int SMEM_BAR_OFF = 4 * (int)sizeof(WaveTile), SMEM_BYTES = SMEM_BAR_OFF + 16;
static_assert(SMEM_BAR_OFF >= (int)sizeof(AttnSmem) && SMEM_BAR_OFF >= (int)(sizeof(GemmSmem) + sizeof(MoeTab)), "LDS carve-up");
template <int PH, bool LAST> DEV void phase_and_sync(const Params& p, char* smem, const XcdBarrier& bar) {
  run_phase<PH>(p, smem);
  if constexpr (!LAST) xcd_barrier(bar);
}
template <int... PHS> struct PhaseList {};
template <int P0> DEV void run_list(const Params& p, char* smem, const XcdBarrier& bar, PhaseList<P0>) { phase_and_sync<P0, true>(p, smem, bar); }
template <int P0, int P1, int... REST> DEV void run_list(const Params& p, char* smem, const XcdBarrier& bar, PhaseList<P0, P1, REST...>) {
  phase_and_sync<P0, false>(p, smem, bar);
  run_list(p, smem, bar, PhaseList<P1, REST...>{});
}
#if DEBUG_ATT == 1
using Program = PhaseList<PH_PRO, PH_IN0, PH_ATT0N, PH_DBG_SAVE, PH_ATT0, PH_DBG_CMP, PH_OUT0, PH_LN0, PH_RG0, PH_RT0, PH_M10, PH_M20, PH_CB0,
                          PH_IN1, PH_C1, PH_C2, PH_ATT1, PH_OUT1, PH_LN1, PH_RG1, PH_RT1, PH_M11, PH_M21, PH_CB1, PH_DBG_SCALE>;
#elif DEBUG_ATT == 2
using Program = PhaseList<PH_PRO, PH_IN0, PH_ATT0, PH_OUT0, PH_LN0, PH_RG0, PH_RT0, PH_M10, PH_M20, PH_CB0,
                          PH_IN1, PH_C1, PH_C2, PH_ATT1N, PH_DBG_SAVE, PH_ATT1A, PH_ATT1B, PH_DBG_CMP, PH_OUT1, PH_LN1, PH_RG1, PH_RT1, PH_M11, PH_M21, PH_CB1, PH_DBG_SCALE>;
#elif DEBUG_ATT == 11
using Program = PhaseList<PH_PRO, PH_IN0, PH_ATT0, PH_OUT0, PH_LN0, PH_RG0, PH_RT0, PH_M10, PH_M20, PH_CB0,
                          PH_IN1, PH_C1, PH_C2, PH_ATT1A, PH_ATT1B, PH_ATT1B, PH_OUT1, PH_LN1, PH_RG1, PH_RT1, PH_M11, PH_M21, PH_CB1>;
#elif DEBUG_ATT == 12
using Program = PhaseList<PH_PRO, PH_IN0, PH_ATT0, PH_OUT0, PH_LN0, PH_RG0, PH_RT0, PH_M10, PH_M20, PH_M10, PH_M20, PH_CB0,
                          PH_IN1, PH_C1, PH_C2, PH_ATT1A, PH_ATT1B, PH_OUT1, PH_LN1, PH_RG1, PH_RT1, PH_M11, PH_M21, PH_CB1>;
#elif DEBUG_ATT == 13
using Program = PhaseList<PH_PRO, PH_IN0, PH_IN0, PH_ATT0, PH_OUT0, PH_OUT0, PH_LN0, PH_RG0, PH_RT0, PH_M10, PH_M20, PH_CB0,
                          PH_IN1, PH_C1, PH_C2, PH_ATT1A, PH_ATT1B, PH_OUT1, PH_LN1, PH_RG1, PH_RT1, PH_M11, PH_M21, PH_CB1>;
#elif DEBUG_ATT == 14
using Program = PhaseList<PH_PRO, PH_IN0, PH_ATT0, PH_ATT0, PH_OUT0, PH_LN0, PH_RG0, PH_RT0, PH_M10, PH_M20, PH_CB0,
                          PH_IN1, PH_C1, PH_C2, PH_ATT1A, PH_ATT1A, PH_ATT1B, PH_OUT1, PH_LN1, PH_RG1, PH_RT1, PH_M11, PH_M21, PH_CB1>;
#elif DEBUG_ATT == 15
using Program = PhaseList<PH_PRO, PH_IN0, PH_ATT0, PH_OUT0, PH_LN0, PH_LN0, PH_RG0, PH_RG0, PH_RT0, PH_M10, PH_M20, PH_CB0, PH_CB0,
                          PH_IN1, PH_C1, PH_C2, PH_ATT1A, PH_ATT1B, PH_OUT1, PH_LN1, PH_RG1, PH_RT1, PH_M11, PH_M21, PH_CB1>;
#else
using Program = PhaseList<PH_PRO, PH_IN0, PH_ATT0, PH_OUT0, PH_LN0, PH_RG0, PH_RT0, PH_M10, PH_M20, PH_CB0,
                          PH_IN1, PH_C1, PH_C2, PH_ATT1A, PH_ATT1B, PH_OUT1, PH_LN1, PH_RG1, PH_RT1, PH_M11, PH_M21, PH_CB1>;
#endif
__global__ void __launch_bounds__(256, 2) k_fused(Params p) {
  extern __shared__ __attribute__((aligned(16))) char smem[];
  if (threadIdx.x == 0) *reinterpret_cast<uint4*>(smem + SMEM_BAR_OFF) = make_uint4(0u, 0u, 0u, 0u);
  __syncthreads();
  XcdBarrier bar = xcd_barrier_post(p.bar, (volatile LAS unsigned*)(smem + SMEM_BAR_OFF));
  run_list(p, smem, bar, Program{});
}

extern "C" void kernel_launch(void* const* d_in, const int* in_sizes, int n_in, void* d_out, int out_size, void* d_ws, size_t ws_size, hipStream_t stream) {
  (void)in_sizes; (void)n_in; (void)out_size; (void)ws_size;
  Params p{};
  p.x = (const float*)d_in[0]; p.pos = (const int*)d_in[1];
  p.even_w_in = (const float*)d_in[2]; p.even_sinks = (const float*)d_in[3]; p.even_w_out = (const float*)d_in[4]; p.odd_w_in = (const float*)d_in[5];
  p.cmpk_pos = (const float*)d_in[6]; p.cmpk_w1 = (const float*)d_in[7]; p.cmpk_w2 = (const float*)d_in[8];
  p.cmpv_pos = (const float*)d_in[9]; p.cmpv_w1 = (const float*)d_in[10]; p.cmpv_w2 = (const float*)d_in[11];
  p.odd_w_out = (const float*)d_in[12]; p.mix_g = (const float*)d_in[13]; p.mix_b = (const float*)d_in[14];
  p.router_w = (const float*)d_in[15]; p.router_b = (const float*)d_in[16];
  p.w_gate = (const float*)d_in[17]; p.w_up = (const float*)d_in[18]; p.w_down = (const float*)d_in[19];
  p.sh_gate = (const float*)d_in[20]; p.sh_up = (const float*)d_in[21]; p.sh_down = (const float*)d_in[22];
  p.ffn_g = (const float*)d_in[23]; p.ffn_b = (const float*)d_in[24];
  p.out = (float*)d_out;
  char* w = (char*)d_ws; size_t off = 0;
  auto take = [&](size_t bytes) { char* r = w + off; off += (bytes + 255) & ~(size_t)255; return r; };
  p.bar = (unsigned*)take(16384);
  p.cnt = (int*)take(4096);
  p.pb = (float*)take(1024);
  p.dbg = (float*)take(256);
  const size_t zero_bytes = off;
  p.cs = (float*)take((size_t)T_ * 16 * 4);
  p.xb = (u16*)take((size_t)T_ * D_ * 2);
  p.qkv = (u16*)take((size_t)T_ * 2624 * 2);
  p.gates = (float*)take((size_t)T_ * 48 * 4);
  p.ao = (u16*)take((size_t)T_ * D_ * 2);
  p.hpre = (float*)take((size_t)T_ * D_ * 4);
  p.x1f = (float*)take((size_t)T_ * D_ * 4);
  p.x1b = (u16*)take((size_t)T_ * D_ * 2);
  p.x1lo = (u16*)take((size_t)T_ * D_ * 2);
  p.logits = (float*)take((size_t)T_ * NE * 4);
  p.eidx = (int*)take((size_t)NASG * 4);
  p.gatev = (float*)take((size_t)NASG * 4);
  p.epos = (int*)take((size_t)NASG * 4);
  p.etok = (int*)take((size_t)NE * T_ * 4);
  p.hbuf = (u16*)take((size_t)NROWS * 256 * 2);
  p.ybuf = (u16*)take((size_t)NROWS * D_ * 2);
  p.x2f = (float*)take((size_t)T_ * D_ * 4);
  p.hid = (u16*)take((size_t)2 * 4096 * 128 * 2);
  p.cmpkv = (u16*)take((size_t)2 * 4096 * 64 * 2);
  p.selmask = (unsigned long long*)take((size_t)T_ * 4 * 8);

  hipMemsetAsync(d_ws, 0, zero_bytes, stream);
  static int grid = 0;
  if (!grid) {
    int dev = 0, cus = 0, per_cu = 0;
    hipGetDevice(&dev);
    hipDeviceGetAttribute(&cus, hipDeviceAttributeMultiprocessorCount, dev);
    hipFuncSetAttribute((const void*)k_fused, hipFuncAttributeMaxDynamicSharedMemorySize, SMEM_BYTES);
    hipOccupancyMaxActiveBlocksPerMultiprocessor(&per_cu, (const void*)k_fused, 256, SMEM_BYTES);
    if (per_cu > 2) per_cu = 2;
    if (per_cu < 1) per_cu = 1;
    grid = cus * per_cu;
  }
  hipLaunchKernelGGL(k_fused, dim3(grid), dim3(256), SMEM_BYTES, stream, p);
}
```

```cpp
#include <hip/hip_runtime.h>
#include <hip/hip_bf16.h>
#include <stdint.h>
#include <math.h>
#include <utility>

typedef unsigned short u16;
using bf16x8 = __attribute__((ext_vector_type(8))) short;
using f32x4  = __attribute__((ext_vector_type(4))) float;

#define DEV __device__ __forceinline__
__device__ __forceinline__ int tidx() { int t = (int)__builtin_amdgcn_workitem_id_x(); asm volatile("" : "+v"(t)); return t; }

constexpr int T_ = 16384, S_ = 4096, D_ = 1024;
constexpr int LD0 = 2304, LD1 = 2560, NIN1 = 2608;
constexpr int NE = 256, TOPK = 8, NASG = T_ * TOPK, NROWS = NASG + T_;
constexpr float ALPHA = 1.41421356237309515f;
constexpr float LN_EPS = 1e-5f;
constexpr int NTHR = 512, NWAVE = 8;

#define FFN_MODE 0
#define DEBUG_ATT 0

struct Params {
  const float* x; const int* pos;
  const float* even_w_in; const float* even_sinks; const float* even_w_out; const float* odd_w_in;
  const float* cmpk_pos; const float* cmpk_w1; const float* cmpk_w2; const float* cmpv_pos; const float* cmpv_w1; const float* cmpv_w2;
  const float* odd_w_out; const float* mix_g; const float* mix_b; const float* router_w; const float* router_b;
  const float* w_gate; const float* w_up; const float* w_down; const float* sh_gate; const float* sh_up; const float* sh_down;
  const float* ffn_g; const float* ffn_b;
  float* out;
  unsigned* bar; int* cnt; float* pb; float* dbg; float* cs; u16* xb; u16* qkv; float* gates; u16* ao; float* hpre;
  float* x1f; u16* x1b; u16* x1lo; float* logits; int* eidx; float* gatev; int* epos; int* etok;
  u16* hbuf; u16* ybuf; float* x2f; u16* hid; u16* cmpkv; unsigned long long* selmask;
  u16* w16_in0; u16* w16_out0; u16* w16_in1; u16* w16_out1; u16* rw16;
};

#define XB_TMO      128
#define XB_XCNT(j)  (256  + 64 * (j))
#define XB_XSUB(j)  (1280 + 64 * (j))
#define XB_XGEN(j)  (2304 + 64 * (j))
#define XB_TOP      3328
#define XB_TOPGEN   3392
#define XCD_BAR_WORDS 3456
#define XB_SPIN_CAP (1u << 18)
#define LAS __attribute__((address_space(3)))

__device__ __forceinline__ unsigned xb_ld(unsigned* p)              { return __hip_atomic_load(p, __ATOMIC_RELAXED, __HIP_MEMORY_SCOPE_AGENT); }
__device__ __forceinline__ unsigned xb_add(unsigned* p, unsigned v) { return __hip_atomic_fetch_add(p, v, __ATOMIC_RELAXED, __HIP_MEMORY_SCOPE_AGENT); }
__device__ __forceinline__ unsigned xb_xcc_id() { return (unsigned)__builtin_amdgcn_s_getreg((3 << 11) | 20) & 0xFu; }
#define XB_SPIN(cond, bar) do { unsigned _sp = 0; while (cond) { __builtin_amdgcn_s_sleep(1); \
    if ((++_sp & 255u) == 0u) { if (xb_ld(&(bar)[XB_TMO])) break; if (_sp > XB_SPIN_CAP) { atomicAdd(&(bar)[XB_TMO], 1u); break; } } } } while (0)

struct XcdBarrier {
    unsigned* bar; unsigned x;
    volatile LAS unsigned* st;
};

__device__ __forceinline__ XcdBarrier xcd_barrier_post(unsigned* bar, volatile LAS unsigned* st) {
    XcdBarrier b; b.bar = bar; b.x = xb_xcc_id(); b.st = st;
    if (tidx() == 0) (void)xb_add(&bar[XB_XCNT(b.x)], 1u);
    return b;
}
__device__ __forceinline__ void xcd_barrier_complete(unsigned* bar, unsigned x, unsigned& nloc, unsigned& nx) {
    const unsigned G = gridDim.x * gridDim.y * gridDim.z;
    unsigned sum, cnt, mine, sp = 0u;
    for (;;) {
        sum = 0u; cnt = 0u; mine = 0u;
#pragma unroll
        for (unsigned j = 0; j < 16; ++j) { const unsigned c = xb_ld(&bar[XB_XCNT(j)]); sum += c; cnt += (c > 0u) ? 1u : 0u; mine = (j == x) ? c : mine; }
        if (sum == G) break;
        __builtin_amdgcn_s_sleep(1);
        if ((++sp & 255u) == 0u) { if (xb_ld(&bar[XB_TMO])) break; if (sp > XB_SPIN_CAP) { atomicAdd(&bar[XB_TMO], 1u); break; } }
    }
    nloc = mine > 0u ? mine : 1u; nx = cnt > 0u ? cnt : 1u;
}

__device__ __forceinline__ void xcd_barrier(const XcdBarrier& b) {
    asm volatile("s_waitcnt vmcnt(0)" ::: "memory");
    __syncthreads();
    if (tidx() == 0) {
        unsigned* bar = b.bar;
        __builtin_amdgcn_s_waitcnt(0);
        unsigned nloc = b.st[0], nx = b.st[1];
        if (nloc == 0u) { xcd_barrier_complete(bar, b.x, nloc, nx); b.st[0] = nloc; b.st[1] = nx; }
        const unsigned old = xb_add(&bar[XB_XSUB(b.x)], 1u);
        const unsigned gen = old / nloc;
        if (old + 1u == (gen + 1u) * nloc) {
            __builtin_amdgcn_fence(__ATOMIC_RELEASE, "agent");
            asm volatile("s_waitcnt vmcnt(0)" ::: "memory");
            const unsigned og = xb_add(&bar[XB_TOP], 1u);
            const unsigned tg = og / nx;
            if (og + 1u == (tg + 1u) * nx) xb_add(&bar[XB_TOPGEN], 1u);
            else XB_SPIN(xb_ld(&bar[XB_TOPGEN]) == tg, bar);
            __builtin_amdgcn_fence(__ATOMIC_ACQUIRE, "agent");
            xb_add(&bar[XB_XGEN(b.x)], 1u);
            asm volatile("s_waitcnt vmcnt(0)" ::: "memory");
        } else {
            XB_SPIN(xb_ld(&bar[XB_XGEN(b.x)]) == gen, bar);
            __builtin_amdgcn_fence(__ATOMIC_ACQUIRE, "agent");
            asm volatile("s_waitcnt vmcnt(0)" ::: "memory");
        }
    }
    __syncthreads();
}


DEV u16 f2bf(float f) { unsigned u = __float_as_uint(f); u += 0x7fffu + ((u >> 16) & 1u); return (u16)(u >> 16); }
DEV float bf2f(u16 h) { return __uint_as_float(((unsigned)h) << 16); }
DEV float bflo(unsigned w) { return __uint_as_float(w << 16); }
DEV float bfhi(unsigned w) { return __uint_as_float(w & 0xffff0000u); }
DEV unsigned pack2(float a, float b) { return (unsigned)f2bf(a) | ((unsigned)f2bf(b) << 16); }
DEV float wave_max(float v) { for (int o = 32; o; o >>= 1) v = fmaxf(v, __shfl_xor(v, o)); return v; }
DEV float wave_sum(float v) { for (int o = 32; o; o >>= 1) v += __shfl_xor(v, o); return v; }
#define WAVE_SYNC() asm volatile("s_waitcnt lgkmcnt(0)" ::: "memory")

typedef short v4i16_t __attribute__((ext_vector_type(4)));
typedef float f32x2_t __attribute__((ext_vector_type(2)));
typedef __bf16 bf16x2_t __attribute__((ext_vector_type(2)));
typedef unsigned u32x4_t __attribute__((ext_vector_type(4)));
typedef unsigned u32x2_t __attribute__((ext_vector_type(2)));
typedef float f32x4_t __attribute__((ext_vector_type(4)));
DEV unsigned cvtpk(float lo, float hi) { f32x2_t v = {lo, hi}; bf16x2_t b = __builtin_convertvector(v, bf16x2_t); return __builtin_bit_cast(unsigned, b); }
DEV v4i16_t lds_tr(const u16* ptr) { return __builtin_amdgcn_ds_read_tr16_b64_v4i16((LAS v4i16_t*)ptr); }

struct GemmSmem { u16 A[2][320][72]; u16 B[2][64][128]; };
DEV int bswz(int k) { return (k & 3) | (((k >> 3) & 1) << 2); }

template <int MI, bool SPLIT, bool B16 = false, class FA, class FB, class FL, class FE>
DEV void gemm_core(GemmSmem& sm, int nk, FA a_addr, FB b_addr, int ldb, FL b_lo, FE epi, bool b_ok = true) {
  const int tid = tidx(), lane = tid & 63, wid = tid >> 6;
  const int wr = wid >> 1, wc = wid & 1, fr = lane & 15, fq = lane >> 4;
  const int n4 = tid & 31, kq = tid >> 5, q4 = (lane & 15) >> 2, p4 = lane & 3;
  f32x4 acc[MI][4];
#pragma unroll
  for (int mi = 0; mi < MI; ++mi)
#pragma unroll
    for (int ni = 0; ni < 4; ++ni) acc[mi][ni] = f32x4{0.f, 0.f, 0.f, 0.f};
  constexpr int NSET = (MI <= 4) ? 2 : 1;
  u32x4_t ra[NSET][MI]; f32x4_t rb[2][4]; u32x4_t rh[2][2];
  auto gloadA = [&](auto PC, int kt) {
    constexpr int P = decltype(PC)::value;
#pragma unroll
    for (int i = 0; i < MI; ++i) ra[P][i] = *reinterpret_cast<const u32x4_t*>(a_addr(i, kt));
  };
  auto gloadB = [&](auto PC, int kt) {
    constexpr int P = decltype(PC)::value;
    if constexpr (B16) {
      const u16* bp = b_addr(kt);
      rh[P][0] = *reinterpret_cast<const u32x4_t*>(bp);
      rh[P][1] = *reinterpret_cast<const u32x4_t*>(bp + (size_t)32 * ldb);
    } else {
      const float* bp = b_addr(kt);
#pragma unroll
      for (int i = 0; i < 4; ++i) rb[P][i] = *reinterpret_cast<const f32x4_t*>(bp + (size_t)(16 * i) * ldb);
    }
  };
  auto gload = [&](auto PC, int kt) { gloadA(PC, kt); gloadB(PC, kt); };
  auto sstore3 = [&](auto AC, auto PC, auto BC, int kt) {
    constexpr int AS = decltype(AC)::value;
    constexpr int P = decltype(PC)::value;
    constexpr int Bf = decltype(BC)::value;
#pragma unroll
    for (int i = 0; i < MI; ++i) *reinterpret_cast<u32x4_t*>(&sm.A[Bf][(tid >> 3) + 64 * i][(tid & 7) * 8]) = ra[AS][i];
    if constexpr (B16) {
#pragma unroll
      for (int i = 0; i < 2; ++i) {
        u32x4_t w = rh[P][i];
        if (!b_ok) w = u32x4_t{0u, 0u, 0u, 0u};
        const int k = (tid >> 4) + 32 * i, n8 = tid & 15;
        *reinterpret_cast<u32x4_t*>(&sm.B[Bf][k][(((n8 >> 1) ^ bswz(k)) << 4) + (n8 & 1) * 8]) = w;
      }
      return;
    }
    const bool lo = SPLIT ? b_lo(kt) : false;
#pragma unroll
    for (int i = 0; i < 4; ++i) {
      f32x4_t v = rb[P][i];
      if (!b_ok) v = f32x4_t{0.f, 0.f, 0.f, 0.f};
      if (SPLIT && lo) {
        const unsigned h0 = cvtpk(v[0], v[1]), h1 = cvtpk(v[2], v[3]);
        v[0] -= __uint_as_float(h0 << 16); v[1] -= __uint_as_float(h0 & 0xffff0000u); v[2] -= __uint_as_float(h1 << 16); v[3] -= __uint_as_float(h1 & 0xffff0000u);
      }
      u32x2_t w; w[0] = cvtpk(v[0], v[1]); w[1] = cvtpk(v[2], v[3]);
      const int k = kq + 16 * i;
      *reinterpret_cast<u32x2_t*>(&sm.B[Bf][k][(((n4 >> 2) ^ bswz(k)) << 4) + (n4 & 3) * 4]) = w;
    }
  };
  auto sstore = [&](auto PC, auto BC, int kt) { sstore3(PC, PC, BC, kt); };
  auto compute = [&](auto PC) {
    constexpr int P = decltype(PC)::value;
#pragma unroll
    for (int ks = 0; ks < 2; ++ks) {
      bf16x8 bf[4];
#pragma unroll
      for (int ni = 0; ni < 4; ++ni) {
        const int k0 = 32 * ks + 8 * fq + q4, col = (((wc * 4 + ni) ^ bswz(k0)) << 4) + 4 * p4;
        const v4i16_t lo = lds_tr(&sm.B[P][k0][col]);
        const v4i16_t hh = lds_tr(&sm.B[P][k0 + 4][col]);
        bf[ni] = bf16x8{lo[0], lo[1], lo[2], lo[3], hh[0], hh[1], hh[2], hh[3]};
      }
      constexpr int G0 = (MI > 4) ? 3 : MI;
      {
        bf16x8 af[G0];
#pragma unroll
        for (int mi = 0; mi < G0; ++mi) af[mi] = *reinterpret_cast<const bf16x8*>(&sm.A[P][wr * 16 * MI + mi * 16 + fr][32 * ks + fq * 8]);
#pragma unroll
        for (int mi = 0; mi < G0; ++mi)
#pragma unroll
          for (int ni = 0; ni < 4; ++ni) acc[mi][ni] = __builtin_amdgcn_mfma_f32_16x16x32_bf16(bf[ni], af[mi], acc[mi][ni], 0, 0, 0);
      }
      if constexpr (MI > G0) {
        __builtin_amdgcn_sched_barrier(0);
        bf16x8 af[MI - G0];
#pragma unroll
        for (int mi = G0; mi < MI; ++mi) af[mi - G0] = *reinterpret_cast<const bf16x8*>(&sm.A[P][wr * 16 * MI + mi * 16 + fr][32 * ks + fq * 8]);
#pragma unroll
        for (int mi = G0; mi < MI; ++mi)
#pragma unroll
          for (int ni = 0; ni < 4; ++ni) acc[mi][ni] = __builtin_amdgcn_mfma_f32_16x16x32_bf16(bf[ni], af[mi - G0], acc[mi][ni], 0, 0, 0);
      }
      __builtin_amdgcn_sched_barrier(0);
    }
  };
  using C0 = std::integral_constant<int, 0>; using C1 = std::integral_constant<int, 1>;
  int kt = 0;
  if constexpr (MI <= 4) {
    gload(C0{}, 0);
    sstore(C0{}, C0{}, 0);
    gload(C1{}, 1);
    __syncthreads();
    for (; kt + 2 < nk; kt += 2) {
      gload(C0{}, kt + 2); compute(C0{}); sstore(C1{}, C1{}, kt + 1); __syncthreads();
      gload(C1{}, kt + 3); compute(C1{}); sstore(C0{}, C0{}, kt + 2); __syncthreads();
    }
    compute(C0{}); sstore(C1{}, C1{}, kt + 1); __syncthreads();
    compute(C1{}); __syncthreads();
  } else {
    gloadA(C0{}, 0); gloadB(C0{}, 0);
    sstore3(C0{}, C0{}, C0{}, 0);
    gloadB(C1{}, 1);
    __syncthreads();
    for (; kt + 2 < nk; kt += 2) {
      gloadA(C0{}, kt + 1); gloadB(C0{}, kt + 2); compute(C0{}); sstore3(C0{}, C1{}, C1{}, kt + 1); __syncthreads();
      gloadA(C0{}, kt + 2); gloadB(C1{}, kt + 3); compute(C1{}); sstore3(C0{}, C0{}, C0{}, kt + 2); __syncthreads();
    }
    gloadA(C0{}, kt + 1); compute(C0{}); sstore3(C0{}, C1{}, C1{}, kt + 1); __syncthreads();
    compute(C1{}); __syncthreads();
  }
  epi(acc);
}

struct ItemRange { int i, hi, step; };
DEV ItemRange xcd_items(int I) {
  ItemRange r;
  if (gridDim.x & 7) { r.i = blockIdx.x; r.hi = I; r.step = gridDim.x; }
  else { const int x = blockIdx.x & 7; r.i = (int)((long)I * x / 8) + (blockIdx.x >> 3); r.hi = (int)((long)I * (x + 1) / 8); r.step = gridDim.x >> 3; }
  return r;
}
template <int GM, int GN> DEV void dense_item(int i, int MT, int& mt, int& nt) {
  const int g = i / (GM * GN), w = i % (GM * GN), gpm = MT / GM;
  mt = (g % gpm) * GM + w / GN; nt = (g / gpm) * GN + w % GN;
}
DEV float4 ld4(const float* ptr) { return *reinterpret_cast<const float4*>(ptr); }
DEV void st_bf4(u16* ptr, float a, float b, float c, float d) { uint2 w; w.x = cvtpk(a, b); w.y = cvtpk(c, d); *reinterpret_cast<uint2*>(ptr) = w; }

__constant__ float INVF[8] = {1.0f, 0.1939227432012558f, 0.03760603070259094f, 0.007292664609849453f, 0.0014142135623842478f,
                              0.00027424818836152554f, 5.3182957344688475e-05f, 1.0313385246263351e-05f};
DEV void ph_prologue(const Params& p) {
  const size_t gtid = (size_t)blockIdx.x * NTHR + tidx(), gsz = (size_t)gridDim.x * NTHR;
  for (size_t i = gtid; i < (size_t)T_ * D_ / 8; i += gsz) {
    const float4 a = reinterpret_cast<const float4*>(p.x)[2 * i], b = reinterpret_cast<const float4*>(p.x)[2 * i + 1];
    uint4 w; w.x = pack2(a.x, a.y); w.y = pack2(a.z, a.w); w.z = pack2(b.x, b.y); w.w = pack2(b.z, b.w);
    reinterpret_cast<uint4*>(p.xb)[i] = w;
  }
  for (size_t i = gtid; i < (size_t)T_ * 8; i += gsz) {
    const int t = (int)(i >> 3), f = (int)(i & 7);
    const float ang = (float)p.pos[t] * INVF[f];
    p.cs[t * 16 + f] = cosf(ang); p.cs[t * 16 + 8 + f] = sinf(ang);
  }
  auto cvt_w = [&](const float* src, u16* dst, size_t n4) {
    for (size_t i = gtid; i < n4; i += gsz) {
      const float4 a = reinterpret_cast<const float4*>(src)[i];
      uint2 w; w.x = cvtpk(a.x, a.y); w.y = cvtpk(a.z, a.w);
      reinterpret_cast<uint2*>(dst)[i] = w;
    }
  };
  cvt_w(p.even_w_in, p.w16_in0, (size_t)D_ * LD0 / 4);
  cvt_w(p.even_w_out, p.w16_out0, (size_t)D_ * D_ / 4);
  cvt_w(p.odd_w_in, p.w16_in1, (size_t)D_ * NIN1 / 4);
  cvt_w(p.odd_w_out, p.w16_out1, (size_t)D_ * D_ / 4);
  for (size_t i = gtid; i < (size_t)2 * D_ * NE / 4; i += gsz) {
    const size_t L = i / ((size_t)D_ * NE / 4), r = i - L * ((size_t)D_ * NE / 4);
    const float4 a = reinterpret_cast<const float4*>(p.router_w)[i];
    const unsigned h0 = cvtpk(a.x, a.y), h1 = cvtpk(a.z, a.w);
    uint2 hi; hi.x = h0; hi.y = h1;
    uint2 lo; lo.x = cvtpk(a.x - __uint_as_float(h0 << 16), a.y - __uint_as_float(h0 & 0xffff0000u)); lo.y = cvtpk(a.z - __uint_as_float(h1 << 16), a.w - __uint_as_float(h1 & 0xffff0000u));
    reinterpret_cast<uint2*>(p.rw16 + (L * 2 + 0) * (size_t)D_ * NE)[r] = hi;
    reinterpret_cast<uint2*>(p.rw16 + (L * 2 + 1) * (size_t)D_ * NE)[r] = lo;
  }
  for (size_t i = gtid; i < 2 * 128 * 16; i += gsz) {
    const int n = (int)(i & 127), kc = (int)((i >> 7) & 15), ts = (int)(i >> 11);
    const float* pe = ts ? p.cmpv_pos : p.cmpk_pos; const float* w1 = ts ? p.cmpv_w1 : p.cmpk_w1;
    float s = 0.f;
    for (int k = kc * 128; k < kc * 128 + 128; ++k) s += pe[k] * w1[(size_t)k * 128 + n];
    atomicAdd(&p.pb[ts * 128 + n], s);
  }
}

DEV void ph_inproj0(const Params& p, GemmSmem& sm) {
  const int tid = tidx(), lane = tid & 63, wid = tid >> 6, wr = wid >> 1, wc = wid & 1, fr = lane & 15, fq = lane >> 4;
  constexpr int NT = LD0 / 128;
  for (ItemRange it = xcd_items(64 * NT); it.i < it.hi; it.i += it.step) {
    int mt, nt; dense_item<16, 2>(it.i, 64, mt, nt);
    const int m0 = mt * 256, n0 = nt * 128;
    const u16* ar0 = p.xb + (size_t)(m0 + (tid >> 3)) * D_ + (tid & 7) * 8;
    auto a_addr = [&](int i, int kt) { return ar0 + (size_t)i * 64 * D_ + kt * 64; };
    const u16* bb = p.w16_in0 + (size_t)(tid >> 4) * LD0 + n0 + 8 * (tid & 15);
    auto b_addr = [&](int kt) { return bb + (size_t)kt * 64 * LD0; };
    auto b_lo = [&](int) { return false; };
    auto epi = [&](f32x4 (&acc)[4][4]) {
#pragma unroll
      for (int mi = 0; mi < 4; ++mi) {
        const int row = m0 + wr * 64 + mi * 16 + fr;
#pragma unroll
        for (int ni = 0; ni < 4; ++ni) {
          f32x4 v = acc[mi][ni];
          const int col = n0 + wc * 64 + ni * 16 + fq * 4;
          const bool rope = (ni == 0) && (col < 1024 || (col >= 1536 && col < 2176));
          if (rope) {
            const float4 c_ = ld4(p.cs + row * 16 + 4 * (fq & 1)), s_ = ld4(p.cs + row * 16 + 8 + 4 * (fq & 1));
            const float p0 = __shfl_xor(v[0], 32), p1 = __shfl_xor(v[1], 32), p2 = __shfl_xor(v[2], 32), p3 = __shfl_xor(v[3], 32);
            const float sg = fq < 2 ? -1.f : 1.f;
            v[0] = v[0] * c_.x + sg * p0 * s_.x; v[1] = v[1] * c_.y + sg * p1 * s_.y; v[2] = v[2] * c_.z + sg * p2 * s_.z; v[3] = v[3] * c_.w + sg * p3 * s_.w;
          }
          st_bf4(p.qkv + (size_t)row * LD0 + col, v[0], v[1], v[2], v[3]);
        }
      }
    };
    gemm_core<4, false, true>(sm, 16, a_addr, b_addr, LD0, b_lo, epi);
  }
}

struct AttnSmem { float qs[4][64]; float sc[4][1040]; int tk[4][1040]; int tw[4][512]; };

DEV float wave_attn(const float* qs, float* sc, const int* tk, int n4, const u16* Kb, const u16* Vb, int ld, float sink, int lane, float (&o)[4]) {
  float mx = -INFINITY;
  for (int i = lane; i < n4; i += 64) {
    const int r = tk[i];
    float s = -INFINITY;
    if (r >= 0) {
      const uint4* kp = reinterpret_cast<const uint4*>(Kb + (size_t)r * ld);
      float a = 0.f;
#pragma unroll
      for (int c = 0; c < 8; ++c) {
        const uint4 kv = kp[c];
        const float4 q0 = reinterpret_cast<const float4*>(qs)[2 * c], q1 = reinterpret_cast<const float4*>(qs)[2 * c + 1];
        a += bflo(kv.x) * q0.x + bfhi(kv.x) * q0.y + bflo(kv.y) * q0.z + bfhi(kv.y) * q0.w
           + bflo(kv.z) * q1.x + bfhi(kv.z) * q1.y + bflo(kv.w) * q1.z + bfhi(kv.w) * q1.w;
      }
      s = a;
    }
    sc[i] = s; mx = fmaxf(mx, s);
  }
  mx = wave_max(mx);
  const float m = fmaxf(mx, sink);
  WAVE_SYNC();
  float sum = 0.f;
  if (m > -INFINITY) {
    for (int i = lane; i < n4; i += 64) { const float pz = __expf(sc[i] - m); sc[i] = pz; sum += pz; }
  } else {
    for (int i = lane; i < n4; i += 64) sc[i] = 0.f;
  }
  sum = wave_sum(sum);
  if (sink > -INFINITY) sum += __expf(sink - m);
  const float inv = sum > 0.f ? 1.f / sum : 0.f;
  WAVE_SYNC();
  const int kk = lane >> 4, dg = lane & 15;
  float a0 = 0.f, a1 = 0.f, a2 = 0.f, a3 = 0.f;
  for (int i = kk; i < n4; i += 4) {
    const float pz = sc[i];
    if (pz != 0.f) {
      const int r = tk[i];
      const uint2 v = *reinterpret_cast<const uint2*>(Vb + (size_t)r * ld + dg * 4);
      a0 += pz * bflo(v.x); a1 += pz * bfhi(v.x); a2 += pz * bflo(v.y); a3 += pz * bfhi(v.y);
    }
  }
  a0 += __shfl_xor(a0, 16); a1 += __shfl_xor(a1, 16); a2 += __shfl_xor(a2, 16); a3 += __shfl_xor(a3, 16);
  a0 += __shfl_xor(a0, 32); a1 += __shfl_xor(a1, 32); a2 += __shfl_xor(a2, 32); a3 += __shfl_xor(a3, 32);
  o[0] = a0 * inv; o[1] = a1 * inv; o[2] = a2 * inv; o[3] = a3 * inv;
  return inv;
}

DEV void ph_attn0(const Params& p, AttnSmem& sm) {
  const int tid = tidx(), lane = tid & 63, wid = tid >> 6;
  float* qs = sm.qs[wid]; float* sc = sm.sc[wid]; int* tk = sm.tk[wid];
  const int gw = blockIdx.x * NWAVE + wid, nw = gridDim.x * NWAVE;
  for (int u = gw; u < T_ * 16; u += nw) {
    const int tg = u >> 4, h = u & 15, b = tg >> 12, t = tg & 4095;
    const u16* row = p.qkv + (size_t)tg * LD0;
    int qcol, kcol, vcol, n; float sink = -INFINITY;
    if (h < 8) {
      qcol = h * 64; kcol = 512 + h * 64; vcol = 1024 + h * 64;
      for (int i = lane; i < 388; i += 64) {
        int r = -1;
        if (i < 387) { const int pi = i / 129, k = i - pi * 129; const int dil = pi == 0 ? 1 : (pi == 1 ? 4 : 16); const int tok = t - k * dil; if (tok >= 0) r = b * S_ + tok; }
        tk[i] = r;
      }
      n = 388;
    } else {
      const int hb = h - 8, g = hb >> 2;
      qcol = 1536 + hb * 64; kcol = 2048 + g * 64; vcol = 2176 + g * 64; sink = p.even_sinks[hb];
      for (int i = lane; i < 128; i += 64) { const int tok = t - i; tk[i] = tok >= 0 ? b * S_ + tok : -1; }
      n = 128;
    }
    qs[lane] = bf2f(row[qcol + lane]) * 0.125f;
    WAVE_SYNC();
    float o[4];
    wave_attn(qs, sc, tk, n, p.qkv + kcol, p.qkv + vcol, LD0, sink, lane, o);
    if (lane < 16) { uint2 w; w.x = pack2(o[0], o[1]); w.y = pack2(o[2], o[3]); *reinterpret_cast<uint2*>(p.ao + (size_t)tg * D_ + h * 64 + lane * 4) = w; }
    WAVE_SYNC();
  }
}

DEV void ph_outproj(const Params& p, GemmSmem& sm, const u16* W16, const float* resid) {
  const int tid = tidx(), lane = tid & 63, wid = tid >> 6, wr = wid >> 1, wc = wid & 1, fr = lane & 15, fq = lane >> 4;
  for (ItemRange it = xcd_items(64 * 8); it.i < it.hi; it.i += it.step) {
    int mt, nt; dense_item<8, 4>(it.i, 64, mt, nt);
    const int m0 = mt * 256, n0 = nt * 128;
    const u16* ar0 = p.ao + (size_t)(m0 + (tid >> 3)) * D_ + (tid & 7) * 8;
    auto a_addr = [&](int i, int kt) { return ar0 + (size_t)i * 64 * D_ + kt * 64; };
    const u16* bb = W16 + (size_t)(tid >> 4) * D_ + n0 + 8 * (tid & 15);
    auto b_addr = [&](int kt) { return bb + (size_t)kt * 64 * D_; };
    auto b_lo = [&](int) { return false; };
    auto epi = [&](f32x4 (&acc)[4][4]) {
#pragma unroll
      for (int mi = 0; mi < 4; ++mi)
#pragma unroll
        for (int ni = 0; ni < 4; ++ni) {
          const size_t idx = (size_t)(m0 + wr * 64 + mi * 16 + fr) * D_ + n0 + wc * 64 + ni * 16 + fq * 4;
          const float4 r = ld4(resid + idx);
          float4 o; o.x = ALPHA * r.x + acc[mi][ni][0]; o.y = ALPHA * r.y + acc[mi][ni][1]; o.z = ALPHA * r.z + acc[mi][ni][2]; o.w = ALPHA * r.w + acc[mi][ni][3];
          *reinterpret_cast<float4*>(p.hpre + idx) = o;
        }
    };
    gemm_core<4, false, true>(sm, 16, a_addr, b_addr, D_, b_lo, epi);
  }
}

DEV void ph_ln_mix(const Params& p, const float* g, const float* bt) {
  const int lane = tidx() & 63, gw = blockIdx.x * NWAVE + (tidx() >> 6), nw = gridDim.x * NWAVE;
  for (int tok = gw; tok < T_; tok += nw) {
    float4 v[4]; float s = 0.f;
#pragma unroll
    for (int i = 0; i < 4; ++i) { v[i] = reinterpret_cast<const float4*>(p.hpre + (size_t)tok * D_)[i * 64 + lane]; s += v[i].x + v[i].y + v[i].z + v[i].w; }
    const float mu = wave_sum(s) * (1.f / D_);
    float ss = 0.f;
#pragma unroll
    for (int i = 0; i < 4; ++i) { v[i].x -= mu; v[i].y -= mu; v[i].z -= mu; v[i].w -= mu; ss += v[i].x * v[i].x + v[i].y * v[i].y + v[i].z * v[i].z + v[i].w * v[i].w; }
    const float rstd = rsqrtf(wave_sum(ss) * (1.f / D_) + LN_EPS);
#pragma unroll
    for (int i = 0; i < 4; ++i) {
      const float4 gg = reinterpret_cast<const float4*>(g)[i * 64 + lane], bb = reinterpret_cast<const float4*>(bt)[i * 64 + lane];
      float4 y; y.x = v[i].x * rstd * gg.x + bb.x; y.y = v[i].y * rstd * gg.y + bb.y; y.z = v[i].z * rstd * gg.z + bb.z; y.w = v[i].w * rstd * gg.w + bb.w;
      reinterpret_cast<float4*>(p.x1f + (size_t)tok * D_)[i * 64 + lane] = y;
      const u16 h0 = f2bf(y.x), h1 = f2bf(y.y), h2 = f2bf(y.z), h3 = f2bf(y.w);
      uint2 hi; hi.x = (unsigned)h0 | ((unsigned)h1 << 16); hi.y = (unsigned)h2 | ((unsigned)h3 << 16);
      uint2 lo; lo.x = pack2(y.x - bf2f(h0), y.y - bf2f(h1)); lo.y = pack2(y.z - bf2f(h2), y.w - bf2f(h3));
      reinterpret_cast<uint2*>(p.x1b + (size_t)tok * D_)[i * 64 + lane] = hi;
      reinterpret_cast<uint2*>(p.x1lo + (size_t)tok * D_)[i * 64 + lane] = lo;
    }
  }
}

DEV void ph_router_gemm(const Params& p, GemmSmem& sm, const u16* RW16) {
  const int tid = tidx(), lane = tid & 63, wid = tid >> 6, wr = wid >> 1, wc = wid & 1, fr = lane & 15, fq = lane >> 4;
  for (ItemRange it = xcd_items(128 * 2); it.i < it.hi; it.i += it.step) {
    const int nt = it.i & 1, mt = it.i >> 1, m0 = mt * 128, n0 = nt * 128;
    const size_t ao0 = (size_t)(m0 + (tid >> 3)) * D_ + (tid & 7) * 8;
    auto a_addr = [&](int i, int kt) { const u16* base = ((kt >> 4) == 1) ? p.x1lo : p.x1b; return base + ao0 + (size_t)i * 64 * D_ + (kt & 15) * 64; };
    const u16* bb = RW16 + (size_t)(tid >> 4) * NE + n0 + 8 * (tid & 15);
    auto b_addr = [&](int kt) { return bb + (kt >= 32 ? (size_t)D_ * NE : 0) + (size_t)(kt & 15) * 64 * NE; };
    auto b_lo = [&](int) { return false; };
    auto epi = [&](f32x4 (&acc)[2][4]) {
#pragma unroll
      for (int mi = 0; mi < 2; ++mi)
#pragma unroll
        for (int ni = 0; ni < 4; ++ni) {
          float4 o; o.x = acc[mi][ni][0]; o.y = acc[mi][ni][1]; o.z = acc[mi][ni][2]; o.w = acc[mi][ni][3];
          *reinterpret_cast<float4*>(p.logits + (size_t)(m0 + wr * 32 + mi * 16 + fr) * NE + n0 + wc * 64 + ni * 16 + fq * 4) = o;
        }
    };
    gemm_core<2, false, true>(sm, 48, a_addr, b_addr, NE, b_lo, epi);
  }
}

template <bool NAIVE_LG> DEV void ph_route(const Params& p, const float* rbias, int* cnt, const float* RW, int* etok) {
  const int lane = tidx() & 63, gw = blockIdx.x * NWAVE + (tidx() >> 6), nw = gridDim.x * NWAVE;
  const int half = lane >> 5;
  for (int tok = gw; tok < T_; tok += nw) {
    float aff[4], val[4];
    float lgn[4] = {0.f, 0.f, 0.f, 0.f};
    if (NAIVE_LG) {
      for (int k = 0; k < D_; ++k) {
        const float xv = p.x1f[(size_t)tok * D_ + k];
#pragma unroll
        for (int j = 0; j < 4; ++j) lgn[j] += xv * RW[(size_t)k * NE + lane + 64 * j];
      }
    }
#pragma unroll
    for (int j = 0; j < 4; ++j) {
      const float lg = NAIVE_LG ? lgn[j] : p.logits[(size_t)tok * NE + lane + 64 * j];
      aff[j] = 1.f / (1.f + expf(-lg));
      val[j] = aff[j] + rbias[lane + 64 * j];
    }
    float gs[8];
#pragma unroll
    for (int j = 0; j < 4; ++j) {
      float m1 = val[j];
#pragma unroll
      for (int o = 16; o; o >>= 1) m1 = fmaxf(m1, __shfl_xor(m1, o));
      const unsigned long long eq = __ballot(val[j] == m1);
      const int ceq = __popc((unsigned)(half ? (eq >> 32) : (eq & 0xffffffffull)));
      float m2 = (val[j] == m1) ? -INFINITY : val[j];
#pragma unroll
      for (int o = 16; o; o >>= 1) m2 = fmaxf(m2, __shfl_xor(m2, o));
      if (ceq >= 2) m2 = m1;
      const float mine = m1 + m2, other = __shfl_xor(mine, 32);
      gs[2 * j] = half ? other : mine; gs[2 * j + 1] = half ? mine : other;
    }
    bool gok[8];
#pragma unroll
    for (int g = 0; g < 8; ++g) {
      int rk = 0;
#pragma unroll
      for (int g2 = 0; g2 < 8; ++g2) rk += (gs[g2] > gs[g] || (gs[g2] == gs[g] && g2 < g)) ? 1 : 0;
      gok[g] = rk < 4;
    }
#pragma unroll
    for (int j = 0; j < 4; ++j) { const bool ok = half ? gok[2 * j + 1] : gok[2 * j]; if (!ok) val[j] = -INFINITY; }
    int my_e = 0; float my_a = 0.f, asum = 0.f;
#pragma unroll
    for (int k = 0; k < TOPK; ++k) {
      float bv = val[0]; int bi = lane;
#pragma unroll
      for (int j = 1; j < 4; ++j) if (val[j] > bv) { bv = val[j]; bi = lane + 64 * j; }
#pragma unroll
      for (int o = 32; o; o >>= 1) {
        const float ov = __shfl_xor(bv, o); const int oi = __shfl_xor(bi, o);
        if (ov > bv || (ov == bv && oi < bi)) { bv = ov; bi = oi; }
      }
      float a_sel = 0.f;
#pragma unroll
      for (int j = 0; j < 4; ++j) { const bool hit = (bi == lane + 64 * j); a_sel = hit ? aff[j] : a_sel; val[j] = hit ? -INFINITY : val[j]; }
      a_sel = wave_sum(a_sel);
      asum += a_sel;
      if (lane == k) { my_e = bi; my_a = a_sel; }
    }
    if (lane < TOPK) {
      const int ps = atomicAdd(&cnt[my_e], 1);
      p.eidx[tok * TOPK + lane] = my_e; p.epos[tok * TOPK + lane] = ps; p.gatev[tok * TOPK + lane] = my_a / asum * 2.5f;
      etok[(size_t)my_e * T_ + ps] = tok;
    }
  }
}

constexpr int MOE_TM = 320;
struct MoeTab { int cn[260]; int of[260]; int tf[260]; unsigned ao[5][NTHR]; };
DEV void moe_prep(MoeTab& mt, const int* cnt) {
  const int tid = tidx();
  if (tid < NE) mt.cn[tid] = cnt[tid];
  __syncthreads();
  if (tid == 0) {
    int a = 0, tl = 0;
    for (int e = 0; e < NE; ++e) { mt.of[e] = a; mt.tf[e] = tl; a += mt.cn[e]; tl += (mt.cn[e] + MOE_TM - 1) / MOE_TM; }
    mt.cn[NE] = T_; mt.of[NE] = NASG; mt.tf[NE] = tl; mt.of[NE + 1] = NASG + T_; mt.tf[NE + 1] = tl + (T_ + MOE_TM - 1) / MOE_TM;
  }
  __syncthreads();
}
DEV int moe_rows_per_tile(int cn, int tiles) { return (cn + tiles - 1) / tiles; }

DEV void ph_moe1(const Params& p, GemmSmem& sm, MoeTab& mt, int layer, const int* cnt) {
  const int tid = tidx(), lane = tid & 63, wid = tid >> 6, wr = wid >> 1, wc = wid & 1, fr = lane & 15, fq = lane >> 4;
  moe_prep(mt, cnt);
  for (ItemRange it = xcd_items(mt.tf[NE + 1] * 4); it.i < it.hi; it.i += it.step) {
    const int u = it.i;
    int lo = 0, hi = NE;
    while (lo < hi) { const int mid = (lo + hi + 1) >> 1; if (4 * mt.tf[mid] <= u) lo = mid; else hi = mid - 1; }
    const int e = lo, tiles = mt.tf[e + 1] - mt.tf[e], local = u - 4 * mt.tf[e];
    const int nt = local & 3, mtl = local >> 2, cn = mt.cn[e], of = mt.of[e];
    const int per = moe_rows_per_tile(cn, tiles), r0 = mtl * per, r1 = (r0 + per < cn) ? r0 + per : cn;
#pragma unroll
    for (int i = 0; i < 5; ++i) {
      int ri = r0 + (tid >> 3) + 64 * i; ri = ri < r1 ? ri : r1 - 1;
      const int tk = e < NE ? p.etok[(size_t)e * T_ + ri] : ri;
      mt.ao[i][tid] = (unsigned)tk * D_ + (tid & 7) * 8;
    }
    auto a_addr = [&](int i, int kt) { return p.x1b + mt.ao[i][tid] + kt * 64; };
    const float* wg = e < NE ? p.w_gate + ((size_t)layer * NE + e) * D_ * 256 : p.sh_gate + (size_t)layer * D_ * 256;
    const float* wu = e < NE ? p.w_up + ((size_t)layer * NE + e) * D_ * 256 : p.sh_up + (size_t)layer * D_ * 256;
    const int v0 = 4 * (tid & 31);
    const float* bb = ((v0 & 63) >= 32 ? wu : wg) + (size_t)(tid >> 5) * 256 + nt * 64 + (v0 >> 6) * 32 + (v0 & 31);
    auto b_addr = [&](int kt) { return bb + (size_t)kt * 64 * 256; };
    auto b_lo = [&](int) { return false; };
    auto epi = [&](f32x4 (&acc)[5][4]) {
#pragma unroll
      for (int mi = 0; mi < 5; ++mi) {
        const int idx = r0 + wr * 80 + mi * 16 + fr;
        if (idx < r1) {
#pragma unroll
          for (int n2 = 0; n2 < 2; ++n2) {
            float hv[4];
#pragma unroll
            for (int j = 0; j < 4; ++j) { const float g = acc[mi][n2][j], uu = acc[mi][n2 + 2][j]; hv[j] = g * __builtin_amdgcn_rcpf(1.f + __expf(-g)) * uu; }
            st_bf4(p.hbuf + (size_t)(of + idx) * 256 + nt * 64 + wc * 32 + n2 * 16 + fq * 4, hv[0], hv[1], hv[2], hv[3]);
          }
        }
      }
    };
    gemm_core<5, false>(sm, 16, a_addr, b_addr, 256, b_lo, epi);
  }
}

DEV void ph_moe2(const Params& p, GemmSmem& sm, MoeTab& mt, int layer, const int* cnt) {
  const int tid = tidx(), lane = tid & 63, wid = tid >> 6, wr = wid >> 1, wc = wid & 1, fr = lane & 15, fq = lane >> 4;
  moe_prep(mt, cnt);
  for (ItemRange it = xcd_items(mt.tf[NE + 1] * 8); it.i < it.hi; it.i += it.step) {
    const int u = it.i;
    int lo = 0, hi = NE;
    while (lo < hi) { const int mid = (lo + hi + 1) >> 1; if (8 * mt.tf[mid] <= u) lo = mid; else hi = mid - 1; }
    const int e = lo, tiles = mt.tf[e + 1] - mt.tf[e], local = u - 8 * mt.tf[e];
    const int nt = local & 7, mtl = local >> 3, cn = mt.cn[e], of = mt.of[e];
    const int per = moe_rows_per_tile(cn, tiles), r0 = mtl * per, r1 = (r0 + per < cn) ? r0 + per : cn;
    const unsigned ao0 = (unsigned)(of + r0 + (tid >> 3)) * 256 + (tid & 7) * 8;
    const int rmax = r1 - 1 - r0 - (tid >> 3);
    auto a_addr = [&](int i, int kt) { int d = 64 * i; d = d < rmax ? d : rmax; return p.hbuf + ao0 + d * 256 + kt * 64; };
    const float* wd = e < NE ? p.w_down + ((size_t)layer * NE + e) * 256 * D_ : p.sh_down + (size_t)layer * 256 * D_;
    const float* bb = wd + (size_t)(tid >> 5) * D_ + nt * 128 + 4 * (tid & 31);
    auto b_addr = [&](int kt) { return bb + (size_t)kt * 64 * D_; };
    auto b_lo = [&](int) { return false; };
    auto epi = [&](f32x4 (&acc)[5][4]) {
#pragma unroll
      for (int mi = 0; mi < 5; ++mi) {
        const int idx = r0 + wr * 80 + mi * 16 + fr;
        if (idx < r1) {
#pragma unroll
          for (int ni = 0; ni < 4; ++ni)
            st_bf4(p.ybuf + (size_t)(of + idx) * D_ + nt * 128 + wc * 64 + ni * 16 + fq * 4, acc[mi][ni][0], acc[mi][ni][1], acc[mi][ni][2], acc[mi][ni][3]);
        }
      }
    };
    gemm_core<5, false>(sm, 4, a_addr, b_addr, D_, b_lo, epi);
  }
}

DEV void ph_combine_ln(const Params& p, MoeTab& mt, const int* cnt, const float* g, const float* bt, float* outf, u16* outb, bool with_ffn) {
  const int lane = tidx() & 63, gw = blockIdx.x * NWAVE + (tidx() >> 6), nw = gridDim.x * NWAVE;
  moe_prep(mt, cnt);
  for (int tok = gw; tok < T_; tok += nw) {
    float4 v[4];
#pragma unroll
    for (int i = 0; i < 4; ++i) {
      v[i] = reinterpret_cast<const float4*>(p.x1f + (size_t)tok * D_)[i * 64 + lane];
      v[i].x *= ALPHA; v[i].y *= ALPHA; v[i].z *= ALPHA; v[i].w *= ALPHA;
    }
    if (with_ffn) {
#if FFN_MODE != 2
#pragma unroll
      for (int i = 0; i < 4; ++i) {
        const uint2 y = reinterpret_cast<const uint2*>(p.ybuf + (size_t)(NASG + tok) * D_)[i * 64 + lane];
        v[i].x += bflo(y.x); v[i].y += bfhi(y.x); v[i].z += bflo(y.y); v[i].w += bfhi(y.y);
      }
#endif
#if FFN_MODE != 1
      for (int k = 0; k < TOPK; ++k) {
        const int sl = mt.of[p.eidx[tok * TOPK + k]] + p.epos[tok * TOPK + k]; const float gk = p.gatev[tok * TOPK + k];
#pragma unroll
        for (int i = 0; i < 4; ++i) {
          const uint2 y = reinterpret_cast<const uint2*>(p.ybuf + (size_t)sl * D_)[i * 64 + lane];
          v[i].x += gk * bflo(y.x); v[i].y += gk * bfhi(y.x); v[i].z += gk * bflo(y.y); v[i].w += gk * bfhi(y.y);
        }
      }
#endif
    }
    float s = 0.f;
#pragma unroll
    for (int i = 0; i < 4; ++i) s += v[i].x + v[i].y + v[i].z + v[i].w;
    const float mu = wave_sum(s) * (1.f / D_);
    float ss = 0.f;
#pragma unroll
    for (int i = 0; i < 4; ++i) { v[i].x -= mu; v[i].y -= mu; v[i].z -= mu; v[i].w -= mu; ss += v[i].x * v[i].x + v[i].y * v[i].y + v[i].z * v[i].z + v[i].w * v[i].w; }
    const float rstd = rsqrtf(wave_sum(ss) * (1.f / D_) + LN_EPS);
#pragma unroll
    for (int i = 0; i < 4; ++i) {
      const float4 gg = reinterpret_cast<const float4*>(g)[i * 64 + lane], bb = reinterpret_cast<const float4*>(bt)[i * 64 + lane];
      float4 y; y.x = v[i].x * rstd * gg.x + bb.x; y.y = v[i].y * rstd * gg.y + bb.y; y.z = v[i].z * rstd * gg.z + bb.z; y.w = v[i].w * rstd * gg.w + bb.w;
      reinterpret_cast<float4*>(outf + (size_t)tok * D_)[i * 64 + lane] = y;
      uint2 hi; hi.x = pack2(y.x, y.y); hi.y = pack2(y.z, y.w);
      reinterpret_cast<uint2*>(outb + (size_t)tok * D_)[i * 64 + lane] = hi;
    }
  }
}

DEV void ph_inproj1(const Params& p, GemmSmem& sm) {
  const int tid = tidx(), lane = tid & 63, wid = tid >> 6, wr = wid >> 1, wc = wid & 1, fr = lane & 15, fq = lane >> 4;
  constexpr int NT = 21;
  for (ItemRange it = xcd_items(64 * (NT + 1)); it.i < it.hi; it.i += it.step) {
    int mt, nt; dense_item<16, 2>(it.i, 64, mt, nt);
    if (nt >= NT) continue;
    const int m0 = mt * 256, n0 = nt * 128;
    const u16* ar0 = p.xb + (size_t)(m0 + (tid >> 3)) * D_ + (tid & 7) * 8;
    auto a_addr = [&](int i, int kt) { return ar0 + (size_t)i * 64 * D_ + kt * 64; };
    const u16* bb = p.w16_in1 + (size_t)(tid >> 4) * NIN1 + n0 + 8 * (tid & 15);
    const bool bok = n0 + 8 * (tid & 15) < NIN1;
    const u16* bbv = bok ? bb : p.w16_in1 + (size_t)(tid >> 4) * NIN1;
    auto b_addr = [&](int kt) -> const u16* { return bbv + (size_t)kt * 64 * NIN1; };
    auto b_lo = [&](int) { return false; };
    auto epi = [&](f32x4 (&acc)[4][4]) {
#pragma unroll
      for (int mi = 0; mi < 4; ++mi) {
        const int row = m0 + wr * 64 + mi * 16 + fr;
#pragma unroll
        for (int ni = 0; ni < 4; ++ni) {
          f32x4 v = acc[mi][ni];
          const int col = n0 + wc * 64 + ni * 16 + fq * 4;
          const bool rope = (ni == 0) && (col < 1280 || (col >= 1536 && col < 1792) || (col >= 2048 && col < 2304));
          if (rope) {
            const float4 c_ = ld4(p.cs + row * 16 + 4 * (fq & 1)), s_ = ld4(p.cs + row * 16 + 8 + 4 * (fq & 1));
            const float p0 = __shfl_xor(v[0], 32), p1 = __shfl_xor(v[1], 32), p2 = __shfl_xor(v[2], 32), p3 = __shfl_xor(v[3], 32);
            const float sg = fq < 2 ? -1.f : 1.f;
            v[0] = v[0] * c_.x + sg * p0 * s_.x; v[1] = v[1] * c_.y + sg * p1 * s_.y; v[2] = v[2] * c_.z + sg * p2 * s_.z; v[3] = v[3] * c_.w + sg * p3 * s_.w;
          }
          if (col < LD1) st_bf4(p.qkv + (size_t)row * LD1 + col, v[0], v[1], v[2], v[3]);
          else if (col < NIN1) {
            float4 o; o.x = 1.f / (1.f + __expf(-v[0])); o.y = 1.f / (1.f + __expf(-v[1])); o.z = 1.f / (1.f + __expf(-v[2])); o.w = 1.f / (1.f + __expf(-v[3]));
            *reinterpret_cast<float4*>(p.gates + (size_t)row * 48 + (col - LD1)) = o;
          }
        }
      }
    };
    gemm_core<4, false, true>(sm, 16, a_addr, b_addr, NIN1, b_lo, epi, bok);
  }
}

DEV float gelu_tanh(float x) { const float u = 0.7978845608028654f * (x + 0.044715f * x * x * x); return 0.5f * x * (1.f + tanhf(u)); }
DEV void ph_cmp1(const Params& p, GemmSmem& sm) {
  const int tid = tidx(), lane = tid & 63, wid = tid >> 6, wr = wid >> 1, wc = wid & 1, fr = lane & 15, fq = lane >> 4;
  for (int u = blockIdx.x; u < 64; u += gridDim.x) {
    const int ts = u >> 5, mt = u & 31, m0 = mt * 128;
    const u16* ar[2];
#pragma unroll
    for (int i = 0; i < 2; ++i) {
      const int m_ = m0 + (tid >> 3) + 64 * i, bg = m_ >> 8; int c = m_ & 255; c = c < 255 ? c : 254;
      ar[i] = p.qkv + (size_t)((bg >> 2) * S_ + 16 * c) * LD1 + (ts ? 1280 : 1024) + (bg & 3) * 64 + (tid & 7) * 8;
    }
    auto a_addr = [&](int i, int kt) { return ar[i] + (size_t)kt * LD1; };
    const float* bb = (ts ? p.cmpv_w1 : p.cmpk_w1) + (size_t)(tid >> 5) * 128 + 4 * (tid & 31);
    auto b_addr = [&](int kt) { return bb + (size_t)kt * 64 * 128; };
    auto b_lo = [&](int) { return false; };
    auto epi = [&](f32x4 (&acc)[2][4]) {
#pragma unroll
      for (int mi = 0; mi < 2; ++mi)
#pragma unroll
        for (int ni = 0; ni < 4; ++ni) {
          const int m = m0 + wr * 32 + mi * 16 + fr, col = wc * 64 + ni * 16 + fq * 4;
          const float4 pbv = ld4(p.pb + ts * 128 + col);
          st_bf4(p.hid + ((size_t)ts * 4096 + m) * 128 + col, gelu_tanh(acc[mi][ni][0] + pbv.x), gelu_tanh(acc[mi][ni][1] + pbv.y),
                 gelu_tanh(acc[mi][ni][2] + pbv.z), gelu_tanh(acc[mi][ni][3] + pbv.w));
        }
    };
    gemm_core<2, false>(sm, 32, a_addr, b_addr, 128, b_lo, epi);
  }
}
DEV void ph_cmp2(const Params& p, GemmSmem& sm) {
  const int tid = tidx(), lane = tid & 63, wid = tid >> 6, wr = wid >> 1, wc = wid & 1, fr = lane & 15, fq = lane >> 4;
  for (int u = blockIdx.x; u < 64; u += gridDim.x) {
    const int ts = u >> 5, mt = u & 31, m0 = mt * 128;
    const u16* ar0 = p.hid + ((size_t)ts * 4096 + m0 + (tid >> 3)) * 128 + (tid & 7) * 8;
    auto a_addr = [&](int i, int kt) { return ar0 + (size_t)i * 64 * 128 + kt * 64; };
    const float* bb = (ts ? p.cmpv_w2 : p.cmpk_w2) + (size_t)(tid >> 5) * 64 + 4 * (tid & 31);
    const bool bok = 4 * (tid & 31) < 64;
    const float* bbv = bok ? bb : (ts ? p.cmpv_w2 : p.cmpk_w2) + (size_t)(tid >> 5) * 64;
    auto b_addr = [&](int kt) -> const float* { return bbv + (size_t)kt * 64 * 64; };
    auto b_lo = [&](int) { return false; };
    auto epi = [&](f32x4 (&acc)[2][4]) {
      if (wc == 0) {
#pragma unroll
        for (int mi = 0; mi < 2; ++mi)
#pragma unroll
          for (int ni = 0; ni < 4; ++ni) {
            const int m = m0 + wr * 32 + mi * 16 + fr, col = ni * 16 + fq * 4;
            st_bf4(p.cmpkv + ((size_t)ts * 4096 + m) * 64 + col, acc[mi][ni][0], acc[mi][ni][1], acc[mi][ni][2], acc[mi][ni][3]);
          }
      }
    };
    gemm_core<2, false>(sm, 2, a_addr, b_addr, 64, b_lo, epi, bok);
  }
}

DEV void ph_attn1(const Params& p, AttnSmem& sm) {
  const int tid = tidx(), lane = tid & 63, wid = tid >> 6;
  float* qs = sm.qs[wid]; float* sc = sm.sc[wid]; int* tk = sm.tk[wid]; int* tw = sm.tw[wid];
  const int gw = blockIdx.x * NWAVE + wid, nw = gridDim.x * NWAVE;
  for (int u = gw; u < T_ * 4; u += nw) {
    const int tg = u >> 2, g = u & 3, b = tg >> 12, t = tg & 4095, cur = t >> 6;
    const u16* row = p.qkv + (size_t)tg * LD1;
    const int nvalid = t >= 31 ? (((t - 31) >> 4) + 1 < 255 ? ((t - 31) >> 4) + 1 : 255) : 0;
    const int n4c = (nvalid + 3) & ~3;
    const u16* kc = p.cmpkv + (size_t)((b * 4 + g) * 256) * 64;
    const u16* vc = p.cmpkv + (size_t)(4096 + (b * 4 + g) * 256) * 64;
    float imp = 0.f;
    float ocmp[4][4];
#pragma unroll
    for (int r = 0; r < 4; ++r) {
      ocmp[r][0] = ocmp[r][1] = ocmp[r][2] = ocmp[r][3] = 0.f;
      if (nvalid > 0) {
        qs[lane] = bf2f(row[(g * 4 + r) * 64 + lane]) * 0.125f;
        for (int i = lane; i < n4c; i += 64) tk[i] = i < nvalid ? i : -1;
        WAVE_SYNC();
        const float inv = wave_attn(qs, sc, tk, n4c, kc, vc, 64, -INFINITY, lane, ocmp[r]);
        WAVE_SYNC();
        float a = 0.f;
        const int c0 = 4 * lane;
        if (c0 - 1 >= 0 && c0 - 1 < nvalid) a += 0.5f * sc[c0 - 1];
        if (c0 < nvalid) a += sc[c0];
        if (c0 + 1 < nvalid) a += sc[c0 + 1];
        if (c0 + 2 < nvalid) a += sc[c0 + 2];
        if (c0 + 3 < nvalid) a += 0.5f * sc[c0 + 3];
        imp += a * inv;
        WAVE_SYNC();
      }
    }
    const float score = (lane > cur) ? -1.f : ((lane == 0 || lane == cur || lane == cur - 1) ? 1.0e4f : imp);
    int rk = 0;
    for (int jj = 0; jj < 64; ++jj) { const float sj = __shfl(score, jj); rk += (sj > score || (sj == score && jj < lane)) ? 1 : 0; }
    unsigned long long mask = __ballot(rk < 16 && lane <= cur);
    int nsel = 0;
    while (mask) {
      const int j = __ffsll((long long)mask) - 1; mask &= mask - 1;
      const int tok = j * 64 + lane;
      tk[nsel * 64 + lane] = tok <= t ? b * S_ + tok : -1;
      ++nsel;
    }
    for (int i = lane; i < 512; i += 64) { const int tok = t - i; tw[i] = tok >= 0 ? b * S_ + tok : -1; }
    WAVE_SYNC();
#pragma unroll
    for (int r = 0; r < 4; ++r) {
      const int h = g * 4 + r;
      qs[lane] = bf2f(row[h * 64 + lane]) * 0.125f;
      WAVE_SYNC();
      float os[4], ow[4];
      wave_attn(qs, sc, tk, nsel * 64, p.qkv + 1536 + g * 64, p.qkv + 1792 + g * 64, LD1, -INFINITY, lane, os);
      WAVE_SYNC();
      wave_attn(qs, sc, tw, 512, p.qkv + 2048 + g * 64, p.qkv + 2304 + g * 64, LD1, -INFINITY, lane, ow);
      const float g0 = p.gates[(size_t)tg * 48 + h * 3], g1 = p.gates[(size_t)tg * 48 + h * 3 + 1], g2 = p.gates[(size_t)tg * 48 + h * 3 + 2];
      if (lane < 16) {
        uint2 w;
        w.x = pack2(g0 * ocmp[r][0] + g1 * os[0] + g2 * ow[0], g0 * ocmp[r][1] + g1 * os[1] + g2 * ow[1]);
        w.y = pack2(g0 * ocmp[r][2] + g1 * os[2] + g2 * ow[2], g0 * ocmp[r][3] + g1 * os[3] + g2 * ow[3]);
        *reinterpret_cast<uint2*>(p.ao + (size_t)tg * D_ + h * 64 + lane * 4) = w;
      }
      WAVE_SYNC();
    }
  }
}


using f32x16 = __attribute__((ext_vector_type(16))) float;
DEV int crow(int r, int hi) { return (r & 3) + 8 * (r >> 2) + 4 * hi; }
constexpr float LOG2E = 1.4426950408889634f;
constexpr float SCL2 = 0.125f * LOG2E;

struct WaveTile { u16 K[32][72]; u16 V[2][32][32]; float imp[32][64]; unsigned long long msk[32]; };
struct AttnState { float m, l; f32x16 o[2]; };

DEV void stage_load(u32x4_t (&rk)[4], u32x4_t (&rv)[4], const u16* Kb, const u16* Vb, int ld, long rowbase, int rowstep, int kcmax, int k0, int lane) {
#pragma unroll
  for (int it = 0; it < 4; ++it) {
    int kc = k0 + (lane >> 3) + 8 * it; kc = kc > kcmax ? kcmax : kc;
    const long row = rowbase + (long)kc * rowstep;
    rk[it] = *reinterpret_cast<const u32x4_t*>(Kb + row * ld + (lane & 7) * 8);
    rv[it] = *reinterpret_cast<const u32x4_t*>(Vb + row * ld + (lane & 7) * 8);
  }
}
DEV void stage_store(WaveTile& wt, const u32x4_t (&rk)[4], const u32x4_t (&rv)[4], int lane) {
  const int ch = lane & 7;
#pragma unroll
  for (int it = 0; it < 4; ++it) {
    const int j = (lane >> 3) + 8 * it;
    *reinterpret_cast<u32x4_t*>(&wt.K[j][ch * 8]) = rk[it];
    *reinterpret_cast<u32x4_t*>(&wt.V[ch >> 2][j][(ch & 3) * 8]) = rv[it];
  }
}
DEV f32x16 qk_tile(const WaveTile& wt, const bf16x8 (&qf)[4], int r32, int hi) {
  f32x16 acc;
#pragma unroll
  for (int r = 0; r < 16; ++r) acc[r] = 0.f;
#pragma unroll
  for (int s = 0; s < 4; ++s) {
    const bf16x8 kf = *reinterpret_cast<const bf16x8*>(&wt.K[r32][16 * s + 8 * hi]);
    acc = __builtin_amdgcn_mfma_f32_32x32x16_bf16(kf, qf[s], acc, 0, 0, 0);
  }
  return acc;
}
DEV void pv_tile(const WaveTile& wt, const float (&pr)[16], f32x16 (&o)[2], int lane) {
  const int hi = lane >> 5, g = (lane >> 4) & 1, q4 = (lane & 15) >> 2, p4 = lane & 3;
  bf16x8 pf[2];
#pragma unroll
  for (int s2 = 0; s2 < 2; ++s2) {
    u32x4_t w;
    w[0] = cvtpk(pr[8 * s2 + 0], pr[8 * s2 + 1]); w[1] = cvtpk(pr[8 * s2 + 2], pr[8 * s2 + 3]);
    w[2] = cvtpk(pr[8 * s2 + 4], pr[8 * s2 + 5]); w[3] = cvtpk(pr[8 * s2 + 6], pr[8 * s2 + 7]);
    pf[s2] = __builtin_bit_cast(bf16x8, w);
  }
#pragma unroll
  for (int dt = 0; dt < 2; ++dt)
#pragma unroll
    for (int s2 = 0; s2 < 2; ++s2) {
      const v4i16_t lo = lds_tr(&wt.V[dt][16 * s2 + 4 * hi + q4][16 * g + 4 * p4]);
      const v4i16_t hh = lds_tr(&wt.V[dt][16 * s2 + 8 + 4 * hi + q4][16 * g + 4 * p4]);
      const bf16x8 vf = {lo[0], lo[1], lo[2], lo[3], hh[0], hh[1], hh[2], hh[3]};
      o[dt] = __builtin_amdgcn_mfma_f32_32x32x16_bf16(vf, pf[s2], o[dt], 0, 0, 0);
    }
}
DEV void attn_init(AttnState& st) {
  st.m = -INFINITY; st.l = 0.f;
#pragma unroll
  for (int r = 0; r < 16; ++r) { st.o[0][r] = 0.f; st.o[1][r] = 0.f; }
}
template <bool USE_SEL>
DEV void attn_span(AttnState& st, WaveTile& wt, const bf16x8 (&qf)[4], const u16* Kb, const u16* Vb, int ld,
                   long rowbase, int rowstep, int kcmax, int kc_lo, int kc_hi, int qc, int W,
                   unsigned long long sel, unsigned long long selu, int lane, int qc_min, int qc_max) {
  const int r32 = lane & 31, hi = lane >> 5;
  if (kc_lo < 0) kc_lo = 0;
  if (kc_hi > kcmax) kc_hi = kcmax;
  const int full_hi = qc_min < kcmax ? qc_min : kcmax;
  auto skip = [&](int k0) -> bool { return USE_SEL && !((selu >> (k0 >> 6)) & 1ull); };
  int kc0 = kc_lo & ~31;
  while (kc0 <= kc_hi && skip(kc0)) kc0 += 32;
  if (kc0 > kc_hi) return;
  u32x4_t rk[4], rv[4];
  stage_load(rk, rv, Kb, Vb, ld, rowbase, rowstep, kcmax, kc0, lane);
  for (;;) {
    stage_store(wt, rk, rv, lane);
    int kn = kc0 + 32;
    while (kn <= kc_hi && skip(kn)) kn += 32;
    if (kn <= kc_hi) stage_load(rk, rv, Kb, Vb, ld, rowbase, rowstep, kcmax, kn, lane);
    WAVE_SYNC();
    const f32x16 s = qk_tile(wt, qf, r32, hi);
    const bool selbit = USE_SEL ? (((sel >> (kc0 >> 6)) & 1ull) != 0ull) : true;
    const bool full = (qc_min <= qc_max) && (kc0 + 31 <= full_hi) && (kc0 >= qc_max - W);
    float sv[16]; float mt = -INFINITY;
    if (full) {
      float rm = s[0];
#pragma unroll
      for (int r = 1; r < 16; ++r) rm = fmaxf(rm, s[r]);
      mt = selbit ? rm * SCL2 : -INFINITY;
    } else {
#pragma unroll
      for (int r = 0; r < 16; ++r) {
        const int kc = kc0 + crow(r, hi), dist = qc - kc;
        const bool ok = selbit && kc <= kcmax && dist >= 0 && dist <= W;
        sv[r] = ok ? s[r] * SCL2 : -INFINITY;
        mt = fmaxf(mt, sv[r]);
      }
    }
    mt = fmaxf(mt, __shfl_xor(mt, 32));
    const float mnew = fmaxf(st.m, mt), muse = (mnew == -INFINITY) ? 0.f : mnew;
    const float alpha = __builtin_amdgcn_exp2f(st.m - muse);
    st.m = mnew;
    float ps = 0.f;
    if (full) {
      const float sub = selbit ? muse : INFINITY;
#pragma unroll
      for (int r = 0; r < 16; ++r) { sv[r] = __builtin_amdgcn_exp2f(__builtin_fmaf(s[r], SCL2, -sub)); ps += sv[r]; }
    } else {
#pragma unroll
      for (int r = 0; r < 16; ++r) { sv[r] = __builtin_amdgcn_exp2f(sv[r] - muse); ps += sv[r]; }
    }
    st.l = st.l * alpha + ps;
    if (__any(alpha != 1.f)) {
#pragma unroll
      for (int r = 0; r < 16; ++r) { st.o[0][r] *= alpha; st.o[1][r] *= alpha; }
    }
    pv_tile(wt, sv, st.o, lane);
    if (kn > kc_hi) break;
    kc0 = kn;
  }
}
DEV void attn_finish(AttnState& st, float sink2) {
  float l = st.l + __shfl_xor(st.l, 32);
  if (sink2 > -INFINITY) l += __builtin_amdgcn_exp2f(sink2 - st.m);
  const float inv = l > 0.f ? 1.f / l : 0.f;
#pragma unroll
  for (int r = 0; r < 16; ++r) { st.o[0][r] *= inv; st.o[1][r] *= inv; }
}
DEV void attn_store_bf16(const AttnState& st, u16* orow, int hi) {
#pragma unroll
  for (int dt = 0; dt < 2; ++dt)
#pragma unroll
    for (int k4 = 0; k4 < 4; ++k4) {
      uint2 w; w.x = cvtpk(st.o[dt][4 * k4], st.o[dt][4 * k4 + 1]); w.y = cvtpk(st.o[dt][4 * k4 + 2], st.o[dt][4 * k4 + 3]);
      *reinterpret_cast<uint2*>(orow + 32 * dt + 8 * k4 + 4 * hi) = w;
    }
}
DEV void load_qf(bf16x8 (&qf)[4], const u16* qrow, int hi) {
#pragma unroll
  for (int s = 0; s < 4; ++s) qf[s] = *reinterpret_cast<const bf16x8*>(qrow + 16 * s + 8 * hi);
}

DEV void ph_attn0_mfma(const Params& p, WaveTile* wts) {
  const int tid = tidx(), lane = tid & 63, wid = tid >> 6, r32 = lane & 31, hi = lane >> 5;
  WaveTile& wt = wts[wid];
  const int gw = blockIdx.x * NWAVE + wid, nw = gridDim.x * NWAVE;
  for (int u = gw; u < 8192; u += nw) {
    AttnState st; attn_init(st);
    bf16x8 qf[4];
    if (u < 4096) {
      const int it = u & 7, res = (u >> 3) & 15, h = (u >> 7) & 7, b = u >> 10;
      const int i0 = it * 32, t = 16 * (i0 + r32) + res;
      const long row = (long)b * S_ + t;
      load_qf(qf, p.qkv + row * LD0 + h * 64, hi);
      const u16* Kb = p.qkv + 512 + h * 64; const u16* Vb = p.qkv + 1024 + h * 64;
      attn_span<false>(st, wt, qf, Kb, Vb, LD0, (long)b * S_ + res, 16, 255, i0 - 128, i0 + 31, i0 + r32, 128, 0ull, 0ull, lane, 1, 0);
      const int c = res >> 2;
      attn_span<false>(st, wt, qf, Kb, Vb, LD0, (long)b * S_ + (res & 3), 4, 1023, 4 * i0 + c - 128, 4 * (i0 + 31) + c, 4 * (i0 + r32) + c, 128, 0ull, 0ull, lane, 1, 0);
      attn_span<false>(st, wt, qf, Kb, Vb, LD0, (long)b * S_, 1, 4095, 16 * i0 + res - 128, 16 * (i0 + 31) + res, t, 128, 0ull, 0ull, lane, 1, 0);
      attn_finish(st, -INFINITY);
      attn_store_bf16(st, p.ao + row * D_ + h * 64, hi);
    } else {
      const int v = u - 4096, qt = v & 127, hb = (v >> 7) & 7, b = v >> 10, g = hb >> 2;
      const int t = 32 * qt + r32;
      const long row = (long)b * S_ + t;
      load_qf(qf, p.qkv + row * LD0 + 1536 + hb * 64, hi);
      attn_span<false>(st, wt, qf, p.qkv + 2048 + g * 64, p.qkv + 2176 + g * 64, LD0, (long)b * S_, 1, 4095, 32 * qt - 127, 32 * qt + 31, t, 127, 0ull, 0ull, lane, 32 * qt, 32 * qt + 31);
      attn_finish(st, p.even_sinks[hb] * LOG2E);
      attn_store_bf16(st, p.ao + row * D_ + 512 + hb * 64, hi);
    }
  }
}

DEV void ph_attn1a(const Params& p, WaveTile* wts) {
  const int tid = tidx(), lane = tid & 63, wid = tid >> 6, r32 = lane & 31, hi = lane >> 5;
  WaveTile& wt = wts[wid];
  const int gw = blockIdx.x * NWAVE + wid, nw = gridDim.x * NWAVE;
  for (int u = gw; u < 2048; u += nw) {
    const int qt = u & 127, g = (u >> 7) & 3, b = u >> 9;
    const int q0 = 32 * qt, t = q0 + r32;
    const long row = (long)b * S_ + t;
    const int qc = (t - 31) >> 4;
    int kc_hi = q0 >> 4; kc_hi = kc_hi > 254 ? 254 : kc_hi;
    const u16* Kb = p.cmpkv + (size_t)((b * 4 + g) * 256) * 64;
    const u16* Vb = p.cmpkv + (size_t)(4096 + (b * 4 + g) * 256) * 64;
#pragma unroll
    for (int i = 0; i < 32; ++i) wt.imp[r32][hi * 32 + i] = 0.f;
    WAVE_SYNC();
    for (int r = 0; r < 4; ++r) {
      const int h = g * 4 + r;
      bf16x8 qf[4];
      load_qf(qf, p.qkv + row * LD1 + h * 64, hi);
      float m = -INFINITY, l = 0.f;
      u32x4_t rk[4], rv[4];
      for (int kc0 = 0; kc0 <= kc_hi; kc0 += 32) {
        stage_load(rk, rv, Kb, Vb, 64, 0, 1, 254, kc0, lane);
        stage_store(wt, rk, rv, lane);
        WAVE_SYNC();
        const f32x16 s = qk_tile(wt, qf, r32, hi);
        float sv[16]; float mt = -INFINITY;
#pragma unroll
        for (int rr = 0; rr < 16; ++rr) { const int kc = kc0 + crow(rr, hi); const bool ok = kc <= 254 && kc <= qc; sv[rr] = ok ? s[rr] * SCL2 : -INFINITY; mt = fmaxf(mt, sv[rr]); }
        mt = fmaxf(mt, __shfl_xor(mt, 32));
        const float mnew = fmaxf(m, mt), muse = (mnew == -INFINITY) ? 0.f : mnew;
        float ps = 0.f;
#pragma unroll
        for (int rr = 0; rr < 16; ++rr) ps += __builtin_amdgcn_exp2f(sv[rr] - muse);
        l = l * __builtin_amdgcn_exp2f(m - muse) + ps; m = mnew;
      }
      l += __shfl_xor(l, 32);
      const float inv = l > 0.f ? 1.f / l : 0.f, muse = (m == -INFINITY) ? 0.f : m;
      f32x16 o[2];
#pragma unroll
      for (int rr = 0; rr < 16; ++rr) { o[0][rr] = 0.f; o[1][rr] = 0.f; }
      for (int kc0 = 0; kc0 <= kc_hi; kc0 += 32) {
        stage_load(rk, rv, Kb, Vb, 64, 0, 1, 254, kc0, lane);
        stage_store(wt, rk, rv, lane);
        WAVE_SYNC();
        const f32x16 s = qk_tile(wt, qf, r32, hi);
        float pr[16];
#pragma unroll
        for (int rr = 0; rr < 16; ++rr) { const int kc = kc0 + crow(rr, hi); const bool ok = kc <= 254 && kc <= qc; pr[rr] = ok ? __builtin_amdgcn_exp2f(s[rr] * SCL2 - muse) * inv : 0.f; }
#pragma unroll
        for (int k4 = 0; k4 < 4; ++k4) { const int j = (kc0 >> 2) + 2 * k4 + hi; wt.imp[r32][j] += pr[4 * k4] + pr[4 * k4 + 1] + pr[4 * k4 + 2] + 0.5f * pr[4 * k4 + 3]; }
        WAVE_SYNC();
#pragma unroll
        for (int k4 = 0; k4 < 4; ++k4) { const int j = (kc0 >> 2) + 2 * k4 + hi + 1; if (j < 64) wt.imp[r32][j] += 0.5f * pr[4 * k4 + 3]; }
        pv_tile(wt, pr, o, lane);
      }
      const float g0 = p.gates[(size_t)row * 48 + h * 3];
#pragma unroll
      for (int dt = 0; dt < 2; ++dt)
#pragma unroll
        for (int k4 = 0; k4 < 4; ++k4) {
          float4 w; w.x = g0 * o[dt][4 * k4]; w.y = g0 * o[dt][4 * k4 + 1]; w.z = g0 * o[dt][4 * k4 + 2]; w.w = g0 * o[dt][4 * k4 + 3];
          *reinterpret_cast<float4*>(p.hpre + (size_t)row * D_ + h * 64 + 32 * dt + 8 * k4 + 4 * hi) = w;
        }
    }
    WAVE_SYNC();
    for (int q = 0; q < 32; ++q) {
      const int tq = q0 + q, cur = tq >> 6;
      const float score = (lane > cur) ? -1.f : ((lane == 0 || lane == cur || lane == cur - 1) ? 1.0e4f : wt.imp[q][lane]);
      int rk_ = 0;
      for (int jj = 0; jj < 64; ++jj) { const float sj = __shfl(score, jj); rk_ += (sj > score || (sj == score && jj < lane)) ? 1 : 0; }
      const unsigned long long mask = __ballot(rk_ < 16 && lane <= cur);
      if (lane == 0) p.selmask[((size_t)b * S_ + tq) * 4 + g] = mask;
    }
    WAVE_SYNC();
  }
}

DEV void ph_attn1b(const Params& p, WaveTile* wts) {
  const int tid = tidx(), lane = tid & 63, wid = tid >> 6, r32 = lane & 31, hi = lane >> 5;
  WaveTile& wt = wts[wid];
  const int gw = blockIdx.x * NWAVE + wid, nw = gridDim.x * NWAVE;
  for (int u = gw; u < 8192; u += nw) {
    const int k = u >> 11, base = u & 2047, bh = base & 63, x = base >> 6;
    const int qt = (k == 0) ? 127 - x : (k == 1) ? 64 + x : (k == 2) ? 63 - x : x;
    const int h = bh & 15, b = bh >> 4, g = h >> 2;
    const int q0 = 32 * qt, t = q0 + r32;
    const long row = (long)b * S_ + t;
    bf16x8 qf[4];
    load_qf(qf, p.qkv + row * LD1 + h * 64, hi);
    const unsigned long long sel = p.selmask[(size_t)row * 4 + g];
    unsigned slo = (unsigned)sel, shi = (unsigned)(sel >> 32);
#pragma unroll
    for (int o = 16; o; o >>= 1) { slo |= __shfl_xor(slo, o); shi |= __shfl_xor(shi, o); }
    const unsigned long long selu = ((unsigned long long)shi << 32) | slo;
    const float g1 = p.gates[(size_t)row * 48 + h * 3 + 1], g2 = p.gates[(size_t)row * 48 + h * 3 + 2];
    AttnState st; attn_init(st);
    attn_span<true>(st, wt, qf, p.qkv + 1536 + g * 64, p.qkv + 1792 + g * 64, LD1, (long)b * S_, 1, 4095, 0, q0 + 31, t, 1 << 30, sel, selu, lane, q0, q0 + 31);
    attn_finish(st, -INFINITY);
    f32x16 acc[2];
#pragma unroll
    for (int rr = 0; rr < 16; ++rr) { acc[0][rr] = g1 * st.o[0][rr]; acc[1][rr] = g1 * st.o[1][rr]; }
    attn_init(st);
    attn_span<false>(st, wt, qf, p.qkv + 2048 + g * 64, p.qkv + 2304 + g * 64, LD1, (long)b * S_, 1, 4095, q0 - 511, q0 + 31, t, 511, 0ull, 0ull, lane, q0, q0 + 31);
    attn_finish(st, -INFINITY);
#pragma unroll
    for (int dt = 0; dt < 2; ++dt)
#pragma unroll
      for (int k4 = 0; k4 < 4; ++k4) {
        const float4 c = *reinterpret_cast<const float4*>(p.hpre + (size_t)row * D_ + h * 64 + 32 * dt + 8 * k4 + 4 * hi);
        uint2 w;
        w.x = cvtpk(c.x + acc[dt][4 * k4] + g2 * st.o[dt][4 * k4], c.y + acc[dt][4 * k4 + 1] + g2 * st.o[dt][4 * k4 + 1]);
        w.y = cvtpk(c.z + acc[dt][4 * k4 + 2] + g2 * st.o[dt][4 * k4 + 2], c.w + acc[dt][4 * k4 + 3] + g2 * st.o[dt][4 * k4 + 3]);
        *reinterpret_cast<uint2*>(p.ao + (size_t)row * D_ + h * 64 + 32 * dt + 8 * k4 + 4 * hi) = w;
      }
  }
}

#ifndef DEBUG_ATT
#define DEBUG_ATT 0
#endif
enum { PH_PRO = 0, PH_IN0, PH_ATT0, PH_OUT0, PH_LN0, PH_RG0, PH_RT0, PH_M10, PH_M20, PH_CB0,
       PH_IN1, PH_C1, PH_C2, PH_ATT1, PH_OUT1, PH_LN1, PH_RG1, PH_RT1, PH_M11, PH_M21, PH_CB1,
       PH_ATT1A, PH_ATT1B, PH_ATT0N, PH_ATT1N, PH_DBG_SAVE, PH_DBG_CMP, PH_DBG_SCALE };

DEV void ph_dbg_save(const Params& p) {
  const size_t gtid = (size_t)blockIdx.x * NTHR + tidx(), gsz = (size_t)gridDim.x * NTHR;
  for (size_t i = gtid; i < (size_t)T_ * D_ / 8; i += gsz) reinterpret_cast<uint4*>(p.ybuf)[i] = reinterpret_cast<const uint4*>(p.ao)[i];
}
DEV void ph_dbg_cmp(const Params& p) {
  const size_t gtid = (size_t)blockIdx.x * NTHR + tidx(), gsz = (size_t)gridDim.x * NTHR;
  float d2 = 0.f, r2 = 0.f;
  for (size_t i = gtid; i < (size_t)T_ * D_; i += gsz) { const float a = bf2f(p.ao[i]), r = bf2f(p.ybuf[i]); d2 += (a - r) * (a - r); r2 += r * r; }
  d2 = wave_sum(d2); r2 = wave_sum(r2);
  if ((tidx() & 63) == 0) { atomicAdd(&p.dbg[0], d2); atomicAdd(&p.dbg[1], r2); }
}
DEV void ph_dbg_scale(const Params& p) {
  const float e = p.dbg[0] / p.dbg[1];
  const float sc = 1.f + sqrtf(1000.f * e);
  const size_t gtid = (size_t)blockIdx.x * NTHR + tidx(), gsz = (size_t)gridDim.x * NTHR;
  for (size_t i = gtid; i < (size_t)T_ * D_; i += gsz) p.out[i] *= sc;
}

template <int PH> DEV void run_phase(const Params& p, char* smem) {
  GemmSmem& gs = *reinterpret_cast<GemmSmem*>(smem);
  AttnSmem& as = *reinterpret_cast<AttnSmem*>(smem);
  WaveTile* wts = reinterpret_cast<WaveTile*>(smem);
  MoeTab& mt = *reinterpret_cast<MoeTab*>(smem + sizeof(GemmSmem));
  if constexpr (PH == PH_PRO) ph_prologue(p);
  else if constexpr (PH == PH_IN0) ph_inproj0(p, gs);
  else if constexpr (PH == PH_ATT0) ph_attn0_mfma(p, wts);
  else if constexpr (PH == PH_ATT0N) ph_attn0(p, as);
  else if constexpr (PH == PH_OUT0) ph_outproj(p, gs, p.w16_out0, p.x);
  else if constexpr (PH == PH_LN0) ph_ln_mix(p, p.mix_g, p.mix_b);
  else if constexpr (PH == PH_RG0) ph_router_gemm(p, gs, p.rw16);
  else if constexpr (PH == PH_RT0) ph_route<false>(p, p.router_b, p.cnt, p.router_w, p.etok);
  else if constexpr (PH == PH_M10) ph_moe1(p, gs, mt, 0, p.cnt);
  else if constexpr (PH == PH_M20) ph_moe2(p, gs, mt, 0, p.cnt);
  else if constexpr (PH == PH_CB0) ph_combine_ln(p, mt, p.cnt, p.ffn_g, p.ffn_b, p.x2f, p.xb, true);
  else if constexpr (PH == PH_IN1) ph_inproj1(p, gs);
  else if constexpr (PH == PH_C1) ph_cmp1(p, gs);
  else if constexpr (PH == PH_C2) ph_cmp2(p, gs);
  else if constexpr (PH == PH_ATT1) ph_attn1(p, as);
  else if constexpr (PH == PH_ATT1N) ph_attn1(p, as);
  else if constexpr (PH == PH_ATT1A) ph_attn1a(p, wts);
  else if constexpr (PH == PH_ATT1B) ph_attn1b(p, wts);
  else if constexpr (PH == PH_OUT1) ph_outproj(p, gs, p.w16_out1, p.x2f);
  else if constexpr (PH == PH_LN1) ph_ln_mix(p, p.mix_g + D_, p.mix_b + D_);
  else if constexpr (PH == PH_RG1) ph_router_gemm(p, gs, p.rw16 + (size_t)2 * D_ * NE);
  else if constexpr (PH == PH_RT1) ph_route<false>(p, p.router_b + NE, p.cnt + 512, p.router_w + (size_t)D_ * NE, p.etok);
  else if constexpr (PH == PH_M11) ph_moe1(p, gs, mt, 1, p.cnt + 512);
  else if constexpr (PH == PH_M21) ph_moe2(p, gs, mt, 1, p.cnt + 512);
  else if constexpr (PH == PH_CB1) ph_combine_ln(p, mt, p.cnt + 512, p.ffn_g + D_, p.ffn_b + D_, p.out, p.xb, true);
  else if constexpr (PH == PH_DBG_SAVE) ph_dbg_save(p);
  else if constexpr (PH == PH_DBG_CMP) ph_dbg_cmp(p);
  else if constexpr (PH == PH_DBG_SCALE) ph_dbg_scale(p);
}

constexpr int SMEM_NEED = (NWAVE * (int)sizeof(WaveTile) > (int)(sizeof(GemmSmem) + sizeof(MoeTab))) ? NWAVE * (int)sizeof(WaveTile) : (int)(sizeof(GemmSmem) + sizeof(MoeTab));
constexpr int SMEM_BAR_OFF = (SMEM_NEED + 15) & ~15, SMEM_BYTES = SMEM_BAR_OFF + 16;
static_assert(SMEM_BAR_OFF >= (int)sizeof(AttnSmem) && SMEM_BAR_OFF >= (int)(sizeof(GemmSmem) + sizeof(MoeTab)), "LDS carve-up");
template <int PH, bool LAST> DEV void phase_and_sync(const Params& p, char* smem, const XcdBarrier& bar) {
  run_phase<PH>(p, smem);
  if constexpr (!LAST) xcd_barrier(bar);
}
template <int... PHS> struct PhaseList {};
template <int P0> DEV void run_list(const Params& p, char* smem, const XcdBarrier& bar, PhaseList<P0>) { phase_and_sync<P0, true>(p, smem, bar); }
template <int P0, int P1, int... REST> DEV void run_list(const Params& p, char* smem, const XcdBarrier& bar, PhaseList<P0, P1, REST...>) {
  phase_and_sync<P0, false>(p, smem, bar);
  run_list(p, smem, bar, PhaseList<P1, REST...>{});
}
#if DEBUG_ATT == 1
using Program = PhaseList<PH_PRO, PH_IN0, PH_ATT0N, PH_DBG_SAVE, PH_ATT0, PH_DBG_CMP, PH_OUT0, PH_LN0, PH_RG0, PH_RT0, PH_M10, PH_M20, PH_CB0,
                          PH_IN1, PH_C1, PH_C2, PH_ATT1, PH_OUT1, PH_LN1, PH_RG1, PH_RT1, PH_M11, PH_M21, PH_CB1, PH_DBG_SCALE>;
#elif DEBUG_ATT == 2
using Program = PhaseList<PH_PRO, PH_IN0, PH_ATT0, PH_OUT0, PH_LN0, PH_RG0, PH_RT0, PH_M10, PH_M20, PH_CB0,
                          PH_IN1, PH_C1, PH_C2, PH_ATT1N, PH_DBG_SAVE, PH_ATT1A, PH_ATT1B, PH_DBG_CMP, PH_OUT1, PH_LN1, PH_RG1, PH_RT1, PH_M11, PH_M21, PH_CB1, PH_DBG_SCALE>;
#elif DEBUG_ATT == 11
using Program = PhaseList<PH_PRO, PH_IN0, PH_ATT0, PH_OUT0, PH_LN0, PH_RG0, PH_RT0, PH_M10, PH_M20, PH_CB0,
                          PH_IN1, PH_C1, PH_C2, PH_ATT1A, PH_ATT1B, PH_ATT1B, PH_OUT1, PH_LN1, PH_RG1, PH_RT1, PH_M11, PH_M21, PH_CB1>;
#elif DEBUG_ATT == 12
using Program = PhaseList<PH_PRO, PH_IN0, PH_ATT0, PH_OUT0, PH_LN0, PH_RG0, PH_RT0, PH_M10, PH_M20, PH_M10, PH_M20, PH_CB0,
                          PH_IN1, PH_C1, PH_C2, PH_ATT1A, PH_ATT1B, PH_OUT1, PH_LN1, PH_RG1, PH_RT1, PH_M11, PH_M21, PH_CB1>;
#elif DEBUG_ATT == 13
using Program = PhaseList<PH_PRO, PH_IN0, PH_IN0, PH_ATT0, PH_OUT0, PH_OUT0, PH_LN0, PH_RG0, PH_RT0, PH_M10, PH_M20, PH_CB0,
                          PH_IN1, PH_C1, PH_C2, PH_ATT1A, PH_ATT1B, PH_OUT1, PH_LN1, PH_RG1, PH_RT1, PH_M11, PH_M21, PH_CB1>;
#elif DEBUG_ATT == 14
using Program = PhaseList<PH_PRO, PH_IN0, PH_ATT0, PH_ATT0, PH_OUT0, PH_LN0, PH_RG0, PH_RT0, PH_M10, PH_M20, PH_CB0,
                          PH_IN1, PH_C1, PH_C2, PH_ATT1A, PH_ATT1A, PH_ATT1B, PH_OUT1, PH_LN1, PH_RG1, PH_RT1, PH_M11, PH_M21, PH_CB1>;
#elif DEBUG_ATT == 15
using Program = PhaseList<PH_PRO, PH_IN0, PH_ATT0, PH_OUT0, PH_LN0, PH_LN0, PH_RG0, PH_RG0, PH_RT0, PH_M10, PH_M20, PH_CB0, PH_CB0,
                          PH_IN1, PH_C1, PH_C2, PH_ATT1A, PH_ATT1B, PH_OUT1, PH_LN1, PH_RG1, PH_RT1, PH_M11, PH_M21, PH_CB1>;
#else
using Program = PhaseList<PH_PRO, PH_IN0, PH_ATT0, PH_OUT0, PH_LN0, PH_RG0, PH_RT0, PH_M10, PH_M20, PH_CB0,
                          PH_IN1, PH_C1, PH_C2, PH_ATT1A, PH_ATT1B, PH_OUT1, PH_LN1, PH_RG1, PH_RT1, PH_M11, PH_M21, PH_CB1>;
#endif
struct KArgs { const void* in[25]; float* out; char* ws; };
constexpr size_t al256(size_t b) { return (b + 255) & ~(size_t)255; }
constexpr size_t OFF_BAR = 0;
constexpr size_t OFF_CNT = OFF_BAR + al256(16384);
constexpr size_t OFF_PB = OFF_CNT + al256(4096);
constexpr size_t OFF_DBG = OFF_PB + al256(1024);
constexpr size_t OFF_ZERO_END = OFF_DBG + al256(256);
constexpr size_t OFF_CS = OFF_ZERO_END;
constexpr size_t OFF_XB = OFF_CS + al256((size_t)T_ * 16 * 4);
constexpr size_t OFF_QKV = OFF_XB + al256((size_t)T_ * D_ * 2);
constexpr size_t OFF_GATES = OFF_QKV + al256((size_t)T_ * 2624 * 2);
constexpr size_t OFF_AO = OFF_GATES + al256((size_t)T_ * 48 * 4);
constexpr size_t OFF_HPRE = OFF_AO + al256((size_t)T_ * D_ * 2);
constexpr size_t OFF_X1F = OFF_HPRE + al256((size_t)T_ * D_ * 4);
constexpr size_t OFF_X1B = OFF_X1F + al256((size_t)T_ * D_ * 4);
constexpr size_t OFF_X1LO = OFF_X1B + al256((size_t)T_ * D_ * 2);
constexpr size_t OFF_LOGITS = OFF_X1LO + al256((size_t)T_ * D_ * 2);
constexpr size_t OFF_EIDX = OFF_LOGITS + al256((size_t)T_ * NE * 4);
constexpr size_t OFF_GATEV = OFF_EIDX + al256((size_t)NASG * 4);
constexpr size_t OFF_EPOS = OFF_GATEV + al256((size_t)NASG * 4);
constexpr size_t OFF_ETOK = OFF_EPOS + al256((size_t)NASG * 4);
constexpr size_t OFF_HBUF = OFF_ETOK + al256((size_t)NE * T_ * 4);
constexpr size_t OFF_YBUF = OFF_HBUF + al256((size_t)NROWS * 256 * 2);
constexpr size_t OFF_X2F = OFF_YBUF + al256((size_t)NROWS * D_ * 2);
constexpr size_t OFF_HID = OFF_X2F + al256((size_t)T_ * D_ * 4);
constexpr size_t OFF_CMPKV = OFF_HID + al256((size_t)2 * 4096 * 128 * 2);
constexpr size_t OFF_SELMASK = OFF_CMPKV + al256((size_t)2 * 4096 * 64 * 2);
constexpr size_t OFF_W16IN0 = OFF_SELMASK + al256((size_t)T_ * 4 * 8);
constexpr size_t OFF_W16OUT0 = OFF_W16IN0 + al256((size_t)D_ * LD0 * 2);
constexpr size_t OFF_W16IN1 = OFF_W16OUT0 + al256((size_t)D_ * D_ * 2);
constexpr size_t OFF_W16OUT1 = OFF_W16IN1 + al256((size_t)D_ * NIN1 * 2);
constexpr size_t OFF_RW16 = OFF_W16OUT1 + al256((size_t)D_ * D_ * 2);
constexpr size_t WS_NEEDED = OFF_RW16 + al256((size_t)4 * D_ * NE * 2);

DEV Params make_params(const KArgs& k) {
  Params p;
  p.x = (const float*)k.in[0]; p.pos = (const int*)k.in[1];
  p.even_w_in = (const float*)k.in[2]; p.even_sinks = (const float*)k.in[3]; p.even_w_out = (const float*)k.in[4]; p.odd_w_in = (const float*)k.in[5];
  p.cmpk_pos = (const float*)k.in[6]; p.cmpk_w1 = (const float*)k.in[7]; p.cmpk_w2 = (const float*)k.in[8];
  p.cmpv_pos = (const float*)k.in[9]; p.cmpv_w1 = (const float*)k.in[10]; p.cmpv_w2 = (const float*)k.in[11];
  p.odd_w_out = (const float*)k.in[12]; p.mix_g = (const float*)k.in[13]; p.mix_b = (const float*)k.in[14];
  p.router_w = (const float*)k.in[15]; p.router_b = (const float*)k.in[16];
  p.w_gate = (const float*)k.in[17]; p.w_up = (const float*)k.in[18]; p.w_down = (const float*)k.in[19];
  p.sh_gate = (const float*)k.in[20]; p.sh_up = (const float*)k.in[21]; p.sh_down = (const float*)k.in[22];
  p.ffn_g = (const float*)k.in[23]; p.ffn_b = (const float*)k.in[24];
  p.out = k.out;
  char* w = k.ws;
  p.bar = (unsigned*)(w + OFF_BAR); p.cnt = (int*)(w + OFF_CNT); p.pb = (float*)(w + OFF_PB); p.dbg = (float*)(w + OFF_DBG);
  p.cs = (float*)(w + OFF_CS); p.xb = (u16*)(w + OFF_XB); p.qkv = (u16*)(w + OFF_QKV); p.gates = (float*)(w + OFF_GATES);
  p.ao = (u16*)(w + OFF_AO); p.hpre = (float*)(w + OFF_HPRE); p.x1f = (float*)(w + OFF_X1F); p.x1b = (u16*)(w + OFF_X1B); p.x1lo = (u16*)(w + OFF_X1LO);
  p.logits = (float*)(w + OFF_LOGITS); p.eidx = (int*)(w + OFF_EIDX); p.gatev = (float*)(w + OFF_GATEV); p.epos = (int*)(w + OFF_EPOS); p.etok = (int*)(w + OFF_ETOK);
  p.hbuf = (u16*)(w + OFF_HBUF); p.ybuf = (u16*)(w + OFF_YBUF); p.x2f = (float*)(w + OFF_X2F); p.hid = (u16*)(w + OFF_HID); p.cmpkv = (u16*)(w + OFF_CMPKV);
  p.selmask = (unsigned long long*)(w + OFF_SELMASK);
  p.w16_in0 = (u16*)(w + OFF_W16IN0); p.w16_out0 = (u16*)(w + OFF_W16OUT0); p.w16_in1 = (u16*)(w + OFF_W16IN1); p.w16_out1 = (u16*)(w + OFF_W16OUT1); p.rw16 = (u16*)(w + OFF_RW16);
  return p;
}

__global__ void __launch_bounds__(NTHR, 2) k_fused(KArgs ka) {
  extern __shared__ __attribute__((aligned(16))) char smem[];
  const Params p = make_params(ka);
  if (tidx() == 0) *reinterpret_cast<uint4*>(smem + SMEM_BAR_OFF) = make_uint4(0u, 0u, 0u, 0u);
  __syncthreads();
  XcdBarrier bar = xcd_barrier_post(p.bar, (volatile LAS unsigned*)(smem + SMEM_BAR_OFF));
  run_list(p, smem, bar, Program{});
}

extern "C" void kernel_launch(void* const* d_in, const int* in_sizes, int n_in, void* d_out, int out_size, void* d_ws, size_t ws_size, hipStream_t stream) {
  (void)in_sizes; (void)n_in; (void)out_size;
  if (ws_size < WS_NEEDED) return;
  KArgs ka{};
  for (int i = 0; i < 25; ++i) ka.in[i] = d_in[i];
  ka.out = (float*)d_out; ka.ws = (char*)d_ws;
  hipMemsetAsync(d_ws, 0, OFF_ZERO_END, stream);
  static int grid = 0;
  if (!grid) {
    int dev = 0, cus = 0, per_cu = 0;
    hipGetDevice(&dev);
    hipDeviceGetAttribute(&cus, hipDeviceAttributeMultiprocessorCount, dev);
    hipFuncSetAttribute((const void*)k_fused, hipFuncAttributeMaxDynamicSharedMemorySize, SMEM_BYTES);
    hipOccupancyMaxActiveBlocksPerMultiprocessor(&per_cu, (const void*)k_fused, NTHR, SMEM_BYTES);
    if (per_cu > 1) per_cu = 1;
    if (per_cu < 1) per_cu = 1;
    grid = cus * per_cu;
  }
  hipLaunchKernelGGL(k_fused, dim3(grid), dim3(NTHR), SMEM_BYTES, stream, ka);
}
```

```cpp
#include <hip/hip_runtime.h>
#include <hip/hip_bf16.h>
#include <stdint.h>
#include <math.h>
#include <utility>

typedef unsigned short u16;
using bf16x8 = __attribute__((ext_vector_type(8))) short;
using f32x4  = __attribute__((ext_vector_type(4))) float;

#define DEV __device__ __forceinline__
__device__ __forceinline__ int tidx() { int t = (int)__builtin_amdgcn_workitem_id_x(); asm volatile("" : "+v"(t)); return t; }

constexpr int T_ = 16384, S_ = 4096, D_ = 1024;
constexpr int LD0 = 2304, LD1 = 2560, NIN1 = 2608;
constexpr int NE = 256, TOPK = 8, NASG = T_ * TOPK, NROWS = NASG + T_;
constexpr float ALPHA = 1.41421356237309515f;
constexpr float LN_EPS = 1e-5f;
constexpr int NTHR = 512, NWAVE = 8;

#define FFN_MODE 0
#define DEBUG_ATT 0

struct Params {
  const float* x; const int* pos;
  const float* even_w_in; const float* even_sinks; const float* even_w_out; const float* odd_w_in;
  const float* cmpk_pos; const float* cmpk_w1; const float* cmpk_w2; const float* cmpv_pos; const float* cmpv_w1; const float* cmpv_w2;
  const float* odd_w_out; const float* mix_g; const float* mix_b; const float* router_w; const float* router_b;
  const float* w_gate; const float* w_up; const float* w_down; const float* sh_gate; const float* sh_up; const float* sh_down;
  const float* ffn_g; const float* ffn_b;
  float* out;
  unsigned* bar; int* cnt; float* pb; float* dbg; float* cs; u16* xb; u16* qkv; float* gates; u16* ao; float* hpre;
  float* x1f; u16* x1b; u16* x1lo; float* logits; int* eidx; float* gatev; int* epos; int* etok;
  u16* hbuf; u16* ybuf; float* x2f; u16* hid; u16* cmpkv; unsigned long long* selmask;
  u16* w16_in0; u16* w16_out0; u16* w16_in1; u16* w16_out1; u16* rw16;
};

#define XB_TMO      128
#define XB_XCNT(j)  (256  + 64 * (j))
#define XB_XSUB(j)  (1280 + 64 * (j))
#define XB_XGEN(j)  (2304 + 64 * (j))
#define XB_TOP      3328
#define XB_TOPGEN   3392
#define XCD_BAR_WORDS 3456
#define XB_SPIN_CAP (1u << 18)
#define LAS __attribute__((address_space(3)))

__device__ __forceinline__ unsigned xb_ld(unsigned* p)              { return __hip_atomic_load(p, __ATOMIC_RELAXED, __HIP_MEMORY_SCOPE_AGENT); }
__device__ __forceinline__ unsigned xb_add(unsigned* p, unsigned v) { return __hip_atomic_fetch_add(p, v, __ATOMIC_RELAXED, __HIP_MEMORY_SCOPE_AGENT); }
__device__ __forceinline__ unsigned xb_xcc_id() { return (unsigned)__builtin_amdgcn_s_getreg((3 << 11) | 20) & 0xFu; }
#define XB_SPIN(cond, bar) do { unsigned _sp = 0; while (cond) { __builtin_amdgcn_s_sleep(1); \
    if ((++_sp & 255u) == 0u) { if (xb_ld(&(bar)[XB_TMO])) break; if (_sp > XB_SPIN_CAP) { atomicAdd(&(bar)[XB_TMO], 1u); break; } } } } while (0)

struct XcdBarrier {
    unsigned* bar; unsigned x;
    volatile LAS unsigned* st;
};

__device__ __forceinline__ XcdBarrier xcd_barrier_post(unsigned* bar, volatile LAS unsigned* st) {
    XcdBarrier b; b.bar = bar; b.x = xb_xcc_id(); b.st = st;
    if (tidx() == 0) (void)xb_add(&bar[XB_XCNT(b.x)], 1u);
    return b;
}
__device__ __forceinline__ void xcd_barrier_complete(unsigned* bar, unsigned x, unsigned& nloc, unsigned& nx) {
    const unsigned G = gridDim.x * gridDim.y * gridDim.z;
    unsigned sum, cnt, mine, sp = 0u;
    for (;;) {
        sum = 0u; cnt = 0u; mine = 0u;
#pragma unroll
        for (unsigned j = 0; j < 16; ++j) { const unsigned c = xb_ld(&bar[XB_XCNT(j)]); sum += c; cnt += (c > 0u) ? 1u : 0u; mine = (j == x) ? c : mine; }
        if (sum == G) break;
        __builtin_amdgcn_s_sleep(1);
        if ((++sp & 255u) == 0u) { if (xb_ld(&bar[XB_TMO])) break; if (sp > XB_SPIN_CAP) { atomicAdd(&bar[XB_TMO], 1u); break; } }
    }
    nloc = mine > 0u ? mine : 1u; nx = cnt > 0u ? cnt : 1u;
}

__device__ __forceinline__ void xcd_barrier(const XcdBarrier& b) {
    asm volatile("s_waitcnt vmcnt(0)" ::: "memory");
    __syncthreads();
    if (tidx() == 0) {
        unsigned* bar = b.bar;
        __builtin_amdgcn_s_waitcnt(0);
        unsigned nloc = b.st[0], nx = b.st[1];
        if (nloc == 0u) { xcd_barrier_complete(bar, b.x, nloc, nx); b.st[0] = nloc; b.st[1] = nx; }
        const unsigned old = xb_add(&bar[XB_XSUB(b.x)], 1u);
        const unsigned gen = old / nloc;
        if (old + 1u == (gen + 1u) * nloc) {
            __builtin_amdgcn_fence(__ATOMIC_RELEASE, "agent");
            asm volatile("s_waitcnt vmcnt(0)" ::: "memory");
            const unsigned og = xb_add(&bar[XB_TOP], 1u);
            const unsigned tg = og / nx;
            if (og + 1u == (tg + 1u) * nx) xb_add(&bar[XB_TOPGEN], 1u);
            else XB_SPIN(xb_ld(&bar[XB_TOPGEN]) == tg, bar);
            __builtin_amdgcn_fence(__ATOMIC_ACQUIRE, "agent");
            xb_add(&bar[XB_XGEN(b.x)], 1u);
            asm volatile("s_waitcnt vmcnt(0)" ::: "memory");
        } else {
            XB_SPIN(xb_ld(&bar[XB_XGEN(b.x)]) == gen, bar);
            __builtin_amdgcn_fence(__ATOMIC_ACQUIRE, "agent");
            asm volatile("s_waitcnt vmcnt(0)" ::: "memory");
        }
    }
    __syncthreads();
}


DEV u16 f2bf(float f) { unsigned u = __float_as_uint(f); u += 0x7fffu + ((u >> 16) & 1u); return (u16)(u >> 16); }
DEV float bf2f(u16 h) { return __uint_as_float(((unsigned)h) << 16); }
DEV float bflo(unsigned w) { return __uint_as_float(w << 16); }
DEV float bfhi(unsigned w) { return __uint_as_float(w & 0xffff0000u); }
DEV unsigned pack2(float a, float b) { return (unsigned)f2bf(a) | ((unsigned)f2bf(b) << 16); }
DEV float wave_max(float v) { for (int o = 32; o; o >>= 1) v = fmaxf(v, __shfl_xor(v, o)); return v; }
DEV float wave_sum(float v) { for (int o = 32; o; o >>= 1) v += __shfl_xor(v, o); return v; }
#define WAVE_SYNC() asm volatile("s_waitcnt lgkmcnt(0)" ::: "memory")

typedef short v4i16_t __attribute__((ext_vector_type(4)));
typedef float f32x2_t __attribute__((ext_vector_type(2)));
typedef __bf16 bf16x2_t __attribute__((ext_vector_type(2)));
typedef unsigned u32x4_t __attribute__((ext_vector_type(4)));
typedef unsigned u32x2_t __attribute__((ext_vector_type(2)));
typedef float f32x4_t __attribute__((ext_vector_type(4)));
DEV unsigned cvtpk(float lo, float hi) { f32x2_t v = {lo, hi}; bf16x2_t b = __builtin_convertvector(v, bf16x2_t); return __builtin_bit_cast(unsigned, b); }
DEV v4i16_t lds_tr(const u16* ptr) { return __builtin_amdgcn_ds_read_tr16_b64_v4i16((LAS v4i16_t*)ptr); }

struct GemmSmem { u16 A[2][320][72]; u16 B[2][64][128]; };
DEV int bswz(int k) { return (k & 3) | (((k >> 3) & 1) << 2); }

template <int MI, bool SPLIT, bool B16 = false, class FA, class FB, class FL, class FE>
DEV void gemm_core(GemmSmem& sm, int nk, FA a_addr, FB b_addr, int ldb, FL b_lo, FE epi, bool b_ok = true) {
  const int tid = tidx(), lane = tid & 63, wid = tid >> 6;
  const int wr = wid >> 1, wc = wid & 1, fr = lane & 15, fq = lane >> 4;
  const int n4 = tid & 31, kq = tid >> 5, q4 = (lane & 15) >> 2, p4 = lane & 3;
  f32x4 acc[MI][4];
#pragma unroll
  for (int mi = 0; mi < MI; ++mi)
#pragma unroll
    for (int ni = 0; ni < 4; ++ni) acc[mi][ni] = f32x4{0.f, 0.f, 0.f, 0.f};
  constexpr int NSET = (MI <= 4) ? 2 : 1;
  u32x4_t ra[NSET][MI]; f32x4_t rb[2][4]; u32x4_t rh[2][2];
  auto gloadA = [&](auto PC, int kt) {
    constexpr int P = decltype(PC)::value;
#pragma unroll
    for (int i = 0; i < MI; ++i) ra[P][i] = *reinterpret_cast<const u32x4_t*>(a_addr(i, kt));
  };
  auto gloadB = [&](auto PC, int kt) {
    constexpr int P = decltype(PC)::value;
    if constexpr (B16) {
      const u16* bp = b_addr(kt);
      rh[P][0] = *reinterpret_cast<const u32x4_t*>(bp);
      rh[P][1] = *reinterpret_cast<const u32x4_t*>(bp + (size_t)32 * ldb);
    } else {
      const float* bp = b_addr(kt);
#pragma unroll
      for (int i = 0; i < 4; ++i) rb[P][i] = *reinterpret_cast<const f32x4_t*>(bp + (size_t)(16 * i) * ldb);
    }
  };
  auto gload = [&](auto PC, int kt) { gloadA(PC, kt); gloadB(PC, kt); };
  auto sstore3 = [&](auto AC, auto PC, auto BC, int kt) {
    constexpr int AS = decltype(AC)::value;
    constexpr int P = decltype(PC)::value;
    constexpr int Bf = decltype(BC)::value;
#pragma unroll
    for (int i = 0; i < MI; ++i) *reinterpret_cast<u32x4_t*>(&sm.A[Bf][(tid >> 3) + 64 * i][(tid & 7) * 8]) = ra[AS][i];
    if constexpr (B16) {
#pragma unroll
      for (int i = 0; i < 2; ++i) {
        u32x4_t w = rh[P][i];
        if (!b_ok) w = u32x4_t{0u, 0u, 0u, 0u};
        const int k = (tid >> 4) + 32 * i, n8 = tid & 15;
        *reinterpret_cast<u32x4_t*>(&sm.B[Bf][k][(((n8 >> 1) ^ bswz(k)) << 4) + (n8 & 1) * 8]) = w;
      }
      return;
    }
    const bool lo = SPLIT ? b_lo(kt) : false;
#pragma unroll
    for (int i = 0; i < 4; ++i) {
      f32x4_t v = rb[P][i];
      if (!b_ok) v = f32x4_t{0.f, 0.f, 0.f, 0.f};
      if (SPLIT && lo) {
        const unsigned h0 = cvtpk(v[0], v[1]), h1 = cvtpk(v[2], v[3]);
        v[0] -= __uint_as_float(h0 << 16); v[1] -= __uint_as_float(h0 & 0xffff0000u); v[2] -= __uint_as_float(h1 << 16); v[3] -= __uint_as_float(h1 & 0xffff0000u);
      }
      u32x2_t w; w[0] = cvtpk(v[0], v[1]); w[1] = cvtpk(v[2], v[3]);
      const int k = kq + 16 * i;
      *reinterpret_cast<u32x2_t*>(&sm.B[Bf][k][(((n4 >> 2) ^ bswz(k)) << 4) + (n4 & 3) * 4]) = w;
    }
  };
  auto sstore = [&](auto PC, auto BC, int kt) { sstore3(PC, PC, BC, kt); };
  auto compute = [&](auto PC) {
    constexpr int P = decltype(PC)::value;
#pragma unroll
    for (int ks = 0; ks < 2; ++ks) {
      bf16x8 bf[4];
#pragma unroll
      for (int ni = 0; ni < 4; ++ni) {
        const int k0 = 32 * ks + 8 * fq + q4, col = (((wc * 4 + ni) ^ bswz(k0)) << 4) + 4 * p4;
        const v4i16_t lo = lds_tr(&sm.B[P][k0][col]);
        const v4i16_t hh = lds_tr(&sm.B[P][k0 + 4][col]);
        bf[ni] = bf16x8{lo[0], lo[1], lo[2], lo[3], hh[0], hh[1], hh[2], hh[3]};
      }
      constexpr int G0 = (MI > 4) ? 3 : MI;
      {
        bf16x8 af[G0];
#pragma unroll
        for (int mi = 0; mi < G0; ++mi) af[mi] = *reinterpret_cast<const bf16x8*>(&sm.A[P][wr * 16 * MI + mi * 16 + fr][32 * ks + fq * 8]);
#pragma unroll
        for (int mi = 0; mi < G0; ++mi)
#pragma unroll
          for (int ni = 0; ni < 4; ++ni) acc[mi][ni] = __builtin_amdgcn_mfma_f32_16x16x32_bf16(bf[ni], af[mi], acc[mi][ni], 0, 0, 0);
      }
      if constexpr (MI > G0) {
        __builtin_amdgcn_sched_barrier(0);
        bf16x8 af[MI - G0];
#pragma unroll
        for (int mi = G0; mi < MI; ++mi) af[mi - G0] = *reinterpret_cast<const bf16x8*>(&sm.A[P][wr * 16 * MI + mi * 16 + fr][32 * ks + fq * 8]);
#pragma unroll
        for (int mi = G0; mi < MI; ++mi)
#pragma unroll
          for (int ni = 0; ni < 4; ++ni) acc[mi][ni] = __builtin_amdgcn_mfma_f32_16x16x32_bf16(bf[ni], af[mi - G0], acc[mi][ni], 0, 0, 0);
      }
      __builtin_amdgcn_sched_barrier(0);
    }
  };
  using C0 = std::integral_constant<int, 0>; using C1 = std::integral_constant<int, 1>;
  int kt = 0;
  if constexpr (MI <= 4) {
    gload(C0{}, 0);
    sstore(C0{}, C0{}, 0);
    gload(C1{}, 1);
    __syncthreads();
    for (; kt + 2 < nk; kt += 2) {
      gload(C0{}, kt + 2); compute(C0{}); sstore(C1{}, C1{}, kt + 1); __syncthreads();
      gload(C1{}, kt + 3); compute(C1{}); sstore(C0{}, C0{}, kt + 2); __syncthreads();
    }
    compute(C0{}); sstore(C1{}, C1{}, kt + 1); __syncthreads();
    compute(C1{}); __syncthreads();
  } else {
    gloadA(C0{}, 0); gloadB(C0{}, 0);
    sstore3(C0{}, C0{}, C0{}, 0);
    gloadB(C1{}, 1);
    __syncthreads();
    for (; kt + 2 < nk; kt += 2) {
      gloadA(C0{}, kt + 1); gloadB(C0{}, kt + 2); compute(C0{}); sstore3(C0{}, C1{}, C1{}, kt + 1); __syncthreads();
      gloadA(C0{}, kt + 2); gloadB(C1{}, kt + 3); compute(C1{}); sstore3(C0{}, C0{}, C0{}, kt + 2); __syncthreads();
    }
    gloadA(C0{}, kt + 1); compute(C0{}); sstore3(C0{}, C1{}, C1{}, kt + 1); __syncthreads();
    compute(C1{}); __syncthreads();
  }
  epi(acc);
}

struct ItemRange { int i, hi, step; };
DEV ItemRange xcd_items(int I) {
  ItemRange r;
  if (gridDim.x & 7) { r.i = blockIdx.x; r.hi = I; r.step = gridDim.x; }
  else { const int x = blockIdx.x & 7; r.i = (int)((long)I * x / 8) + (blockIdx.x >> 3); r.hi = (int)((long)I * (x + 1) / 8); r.step = gridDim.x >> 3; }
  return r;
}
template <int GM, int GN> DEV void dense_item(int i, int MT, int& mt, int& nt) {
  const int g = i / (GM * GN), w = i % (GM * GN), gpm = MT / GM;
  mt = (g % gpm) * GM + w / GN; nt = (g / gpm) * GN + w % GN;
}
DEV float4 ld4(const float* ptr) { return *reinterpret_cast<const float4*>(ptr); }
DEV void st_bf4(u16* ptr, float a, float b, float c, float d) { uint2 w; w.x = cvtpk(a, b); w.y = cvtpk(c, d); *reinterpret_cast<uint2*>(ptr) = w; }

__constant__ float INVF[8] = {1.0f, 0.1939227432012558f, 0.03760603070259094f, 0.007292664609849453f, 0.0014142135623842478f,
                              0.00027424818836152554f, 5.3182957344688475e-05f, 1.0313385246263351e-05f};
DEV void ph_prologue(const Params& p) {
  const size_t gtid = (size_t)blockIdx.x * NTHR + tidx(), gsz = (size_t)gridDim.x * NTHR;
  for (size_t i = gtid; i < (size_t)T_ * D_ / 8; i += gsz) {
    const float4 a = reinterpret_cast<const float4*>(p.x)[2 * i], b = reinterpret_cast<const float4*>(p.x)[2 * i + 1];
    uint4 w; w.x = pack2(a.x, a.y); w.y = pack2(a.z, a.w); w.z = pack2(b.x, b.y); w.w = pack2(b.z, b.w);
    reinterpret_cast<uint4*>(p.xb)[i] = w;
  }
  for (size_t i = gtid; i < (size_t)T_ * 8; i += gsz) {
    const int t = (int)(i >> 3), f = (int)(i & 7);
    const float ang = (float)p.pos[t] * INVF[f];
    p.cs[t * 16 + f] = cosf(ang); p.cs[t * 16 + 8 + f] = sinf(ang);
  }
  auto cvt_w = [&](const float* src, u16* dst, size_t n4) {
    for (size_t i = gtid; i < n4; i += gsz) {
      const float4 a = reinterpret_cast<const float4*>(src)[i];
      uint2 w; w.x = cvtpk(a.x, a.y); w.y = cvtpk(a.z, a.w);
      reinterpret_cast<uint2*>(dst)[i] = w;
    }
  };
  cvt_w(p.even_w_in, p.w16_in0, (size_t)D_ * LD0 / 4);
  cvt_w(p.even_w_out, p.w16_out0, (size_t)D_ * D_ / 4);
  cvt_w(p.odd_w_in, p.w16_in1, (size_t)D_ * NIN1 / 4);
  cvt_w(p.odd_w_out, p.w16_out1, (size_t)D_ * D_ / 4);
  for (size_t i = gtid; i < (size_t)2 * D_ * NE / 4; i += gsz) {
    const size_t L = i / ((size_t)D_ * NE / 4), r = i - L * ((size_t)D_ * NE / 4);
    const float4 a = reinterpret_cast<const float4*>(p.router_w)[i];
    const unsigned h0 = cvtpk(a.x, a.y), h1 = cvtpk(a.z, a.w);
    uint2 hi; hi.x = h0; hi.y = h1;
    uint2 lo; lo.x = cvtpk(a.x - __uint_as_float(h0 << 16), a.y - __uint_as_float(h0 & 0xffff0000u)); lo.y = cvtpk(a.z - __uint_as_float(h1 << 16), a.w - __uint_as_float(h1 & 0xffff0000u));
    reinterpret_cast<uint2*>(p.rw16 + (L * 2 + 0) * (size_t)D_ * NE)[r] = hi;
    reinterpret_cast<uint2*>(p.rw16 + (L * 2 + 1) * (size_t)D_ * NE)[r] = lo;
  }
  for (size_t i = gtid; i < 2 * 128 * 16; i += gsz) {
    const int n = (int)(i & 127), kc = (int)((i >> 7) & 15), ts = (int)(i >> 11);
    const float* pe = ts ? p.cmpv_pos : p.cmpk_pos; const float* w1 = ts ? p.cmpv_w1 : p.cmpk_w1;
    float s = 0.f;
    for (int k = kc * 128; k < kc * 128 + 128; ++k) s += pe[k] * w1[(size_t)k * 128 + n];
    atomicAdd(&p.pb[ts * 128 + n], s);
  }
}

DEV void ph_inproj0(const Params& p, GemmSmem& sm) {
  const int tid = tidx(), lane = tid & 63, wid = tid >> 6, wr = wid >> 1, wc = wid & 1, fr = lane & 15, fq = lane >> 4;
  constexpr int NT = LD0 / 128;
  for (ItemRange it = xcd_items(64 * NT); it.i < it.hi; it.i += it.step) {
    int mt, nt; dense_item<16, 2>(it.i, 64, mt, nt);
    const int m0 = mt * 256, n0 = nt * 128;
    const u16* ar0 = p.xb + (size_t)(m0 + (tid >> 3)) * D_ + (tid & 7) * 8;
    auto a_addr = [&](int i, int kt) { return ar0 + (size_t)i * 64 * D_ + kt * 64; };
    const u16* bb = p.w16_in0 + (size_t)(tid >> 4) * LD0 + n0 + 8 * (tid & 15);
    auto b_addr = [&](int kt) { return bb + (size_t)kt * 64 * LD0; };
    auto b_lo = [&](int) { return false; };
    auto epi = [&](f32x4 (&acc)[4][4]) {
#pragma unroll
      for (int mi = 0; mi < 4; ++mi) {
        const int row = m0 + wr * 64 + mi * 16 + fr;
#pragma unroll
        for (int ni = 0; ni < 4; ++ni) {
          f32x4 v = acc[mi][ni];
          const int col = n0 + wc * 64 + ni * 16 + fq * 4;
          const bool rope = (ni == 0) && (col < 1024 || (col >= 1536 && col < 2176));
          if (rope) {
            const float4 c_ = ld4(p.cs + row * 16 + 4 * (fq & 1)), s_ = ld4(p.cs + row * 16 + 8 + 4 * (fq & 1));
            const float p0 = __shfl_xor(v[0], 32), p1 = __shfl_xor(v[1], 32), p2 = __shfl_xor(v[2], 32), p3 = __shfl_xor(v[3], 32);
            const float sg = fq < 2 ? -1.f : 1.f;
            v[0] = v[0] * c_.x + sg * p0 * s_.x; v[1] = v[1] * c_.y + sg * p1 * s_.y; v[2] = v[2] * c_.z + sg * p2 * s_.z; v[3] = v[3] * c_.w + sg * p3 * s_.w;
          }
          st_bf4(p.qkv + (size_t)row * LD0 + col, v[0], v[1], v[2], v[3]);
        }
      }
    };
    gemm_core<4, false, true>(sm, 16, a_addr, b_addr, LD0, b_lo, epi);
  }
}

struct AttnSmem { float qs[4][64]; float sc[4][1040]; int tk[4][1040]; int tw[4][512]; };

DEV float wave_attn(const float* qs, float* sc, const int* tk, int n4, const u16* Kb, const u16* Vb, int ld, float sink, int lane, float (&o)[4]) {
  float mx = -INFINITY;
  for (int i = lane; i < n4; i += 64) {
    const int r = tk[i];
    float s = -INFINITY;
    if (r >= 0) {
      const uint4* kp = reinterpret_cast<const uint4*>(Kb + (size_t)r * ld);
      float a = 0.f;
#pragma unroll
      for (int c = 0; c < 8; ++c) {
        const uint4 kv = kp[c];
        const float4 q0 = reinterpret_cast<const float4*>(qs)[2 * c], q1 = reinterpret_cast<const float4*>(qs)[2 * c + 1];
        a += bflo(kv.x) * q0.x + bfhi(kv.x) * q0.y + bflo(kv.y) * q0.z + bfhi(kv.y) * q0.w
           + bflo(kv.z) * q1.x + bfhi(kv.z) * q1.y + bflo(kv.w) * q1.z + bfhi(kv.w) * q1.w;
      }
      s = a;
    }
    sc[i] = s; mx = fmaxf(mx, s);
  }
  mx = wave_max(mx);
  const float m = fmaxf(mx, sink);
  WAVE_SYNC();
  float sum = 0.f;
  if (m > -INFINITY) {
    for (int i = lane; i < n4; i += 64) { const float pz = __expf(sc[i] - m); sc[i] = pz; sum += pz; }
  } else {
    for (int i = lane; i < n4; i += 64) sc[i] = 0.f;
  }
  sum = wave_sum(sum);
  if (sink > -INFINITY) sum += __expf(sink - m);
  const float inv = sum > 0.f ? 1.f / sum : 0.f;
  WAVE_SYNC();
  const int kk = lane >> 4, dg = lane & 15;
  float a0 = 0.f, a1 = 0.f, a2 = 0.f, a3 = 0.f;
  for (int i = kk; i < n4; i += 4) {
    const float pz = sc[i];
    if (pz != 0.f) {
      const int r = tk[i];
      const uint2 v = *reinterpret_cast<const uint2*>(Vb + (size_t)r * ld + dg * 4);
      a0 += pz * bflo(v.x); a1 += pz * bfhi(v.x); a2 += pz * bflo(v.y); a3 += pz * bfhi(v.y);
    }
  }
  a0 += __shfl_xor(a0, 16); a1 += __shfl_xor(a1, 16); a2 += __shfl_xor(a2, 16); a3 += __shfl_xor(a3, 16);
  a0 += __shfl_xor(a0, 32); a1 += __shfl_xor(a1, 32); a2 += __shfl_xor(a2, 32); a3 += __shfl_xor(a3, 32);
  o[0] = a0 * inv; o[1] = a1 * inv; o[2] = a2 * inv; o[3] = a3 * inv;
  return inv;
}

DEV void ph_attn0(const Params& p, AttnSmem& sm) {
  const int tid = tidx(), lane = tid & 63, wid = tid >> 6;
  float* qs = sm.qs[wid]; float* sc = sm.sc[wid]; int* tk = sm.tk[wid];
  const int gw = blockIdx.x * NWAVE + wid, nw = gridDim.x * NWAVE;
  for (int u = gw; u < T_ * 16; u += nw) {
    const int tg = u >> 4, h = u & 15, b = tg >> 12, t = tg & 4095;
    const u16* row = p.qkv + (size_t)tg * LD0;
    int qcol, kcol, vcol, n; float sink = -INFINITY;
    if (h < 8) {
      qcol = h * 64; kcol = 512 + h * 64; vcol = 1024 + h * 64;
      for (int i = lane; i < 388; i += 64) {
        int r = -1;
        if (i < 387) { const int pi = i / 129, k = i - pi * 129; const int dil = pi == 0 ? 1 : (pi == 1 ? 4 : 16); const int tok = t - k * dil; if (tok >= 0) r = b * S_ + tok; }
        tk[i] = r;
      }
      n = 388;
    } else {
      const int hb = h - 8, g = hb >> 2;
      qcol = 1536 + hb * 64; kcol = 2048 + g * 64; vcol = 2176 + g * 64; sink = p.even_sinks[hb];
      for (int i = lane; i < 128; i += 64) { const int tok = t - i; tk[i] = tok >= 0 ? b * S_ + tok : -1; }
      n = 128;
    }
    qs[lane] = bf2f(row[qcol + lane]) * 0.125f;
    WAVE_SYNC();
    float o[4];
    wave_attn(qs, sc, tk, n, p.qkv + kcol, p.qkv + vcol, LD0, sink, lane, o);
    if (lane < 16) { uint2 w; w.x = pack2(o[0], o[1]); w.y = pack2(o[2], o[3]); *reinterpret_cast<uint2*>(p.ao + (size_t)tg * D_ + h * 64 + lane * 4) = w; }
    WAVE_SYNC();
  }
}

DEV void ph_outproj(const Params& p, GemmSmem& sm, const u16* W16, const float* resid) {
  const int tid = tidx(), lane = tid & 63, wid = tid >> 6, wr = wid >> 1, wc = wid & 1, fr = lane & 15, fq = lane >> 4;
  for (ItemRange it = xcd_items(64 * 8); it.i < it.hi; it.i += it.step) {
    int mt, nt; dense_item<8, 4>(it.i, 64, mt, nt);
    const int m0 = mt * 256, n0 = nt * 128;
    const u16* ar0 = p.ao + (size_t)(m0 + (tid >> 3)) * D_ + (tid & 7) * 8;
    auto a_addr = [&](int i, int kt) { return ar0 + (size_t)i * 64 * D_ + kt * 64; };
    const u16* bb = W16 + (size_t)(tid >> 4) * D_ + n0 + 8 * (tid & 15);
    auto b_addr = [&](int kt) { return bb + (size_t)kt * 64 * D_; };
    auto b_lo = [&](int) { return false; };
    auto epi = [&](f32x4 (&acc)[4][4]) {
#pragma unroll
      for (int mi = 0; mi < 4; ++mi)
#pragma unroll
        for (int ni = 0; ni < 4; ++ni) {
          const size_t idx = (size_t)(m0 + wr * 64 + mi * 16 + fr) * D_ + n0 + wc * 64 + ni * 16 + fq * 4;
          const float4 r = ld4(resid + idx);
          float4 o; o.x = ALPHA * r.x + acc[mi][ni][0]; o.y = ALPHA * r.y + acc[mi][ni][1]; o.z = ALPHA * r.z + acc[mi][ni][2]; o.w = ALPHA * r.w + acc[mi][ni][3];
          *reinterpret_cast<float4*>(p.hpre + idx) = o;
        }
    };
    gemm_core<4, false, true>(sm, 16, a_addr, b_addr, D_, b_lo, epi);
  }
}

DEV void ph_ln_mix(const Params& p, const float* g, const float* bt) {
  const int lane = tidx() & 63, gw = blockIdx.x * NWAVE + (tidx() >> 6), nw = gridDim.x * NWAVE;
  for (int tok = gw; tok < T_; tok += nw) {
    float4 v[4]; float s = 0.f;
#pragma unroll
    for (int i = 0; i < 4; ++i) { v[i] = reinterpret_cast<const float4*>(p.hpre + (size_t)tok * D_)[i * 64 + lane]; s += v[i].x + v[i].y + v[i].z + v[i].w; }
    const float mu = wave_sum(s) * (1.f / D_);
    float ss = 0.f;
#pragma unroll
    for (int i = 0; i < 4; ++i) { v[i].x -= mu; v[i].y -= mu; v[i].z -= mu; v[i].w -= mu; ss += v[i].x * v[i].x + v[i].y * v[i].y + v[i].z * v[i].z + v[i].w * v[i].w; }
    const float rstd = rsqrtf(wave_sum(ss) * (1.f / D_) + LN_EPS);
#pragma unroll
    for (int i = 0; i < 4; ++i) {
      const float4 gg = reinterpret_cast<const float4*>(g)[i * 64 + lane], bb = reinterpret_cast<const float4*>(bt)[i * 64 + lane];
      float4 y; y.x = v[i].x * rstd * gg.x + bb.x; y.y = v[i].y * rstd * gg.y + bb.y; y.z = v[i].z * rstd * gg.z + bb.z; y.w = v[i].w * rstd * gg.w + bb.w;
      reinterpret_cast<float4*>(p.x1f + (size_t)tok * D_)[i * 64 + lane] = y;
      const u16 h0 = f2bf(y.x), h1 = f2bf(y.y), h2 = f2bf(y.z), h3 = f2bf(y.w);
      uint2 hi; hi.x = (unsigned)h0 | ((unsigned)h1 << 16); hi.y = (unsigned)h2 | ((unsigned)h3 << 16);
      uint2 lo; lo.x = pack2(y.x - bf2f(h0), y.y - bf2f(h1)); lo.y = pack2(y.z - bf2f(h2), y.w - bf2f(h3));
      reinterpret_cast<uint2*>(p.x1b + (size_t)tok * D_)[i * 64 + lane] = hi;
      reinterpret_cast<uint2*>(p.x1lo + (size_t)tok * D_)[i * 64 + lane] = lo;
    }
  }
}

DEV void ph_router_gemm(const Params& p, GemmSmem& sm, const u16* RW16) {
  const int tid = tidx(), lane = tid & 63, wid = tid >> 6, wr = wid >> 1, wc = wid & 1, fr = lane & 15, fq = lane >> 4;
  for (ItemRange it = xcd_items(128 * 2); it.i < it.hi; it.i += it.step) {
    const int nt = it.i & 1, mt = it.i >> 1, m0 = mt * 128, n0 = nt * 128;
    const size_t ao0 = (size_t)(m0 + (tid >> 3)) * D_ + (tid & 7) * 8;
    auto a_addr = [&](int i, int kt) { const u16* base = ((kt >> 4) == 1) ? p.x1lo : p.x1b; return base + ao0 + (size_t)i * 64 * D_ + (kt & 15) * 64; };
    const u16* bb = RW16 + (size_t)(tid >> 4) * NE + n0 + 8 * (tid & 15);
    auto b_addr = [&](int kt) { return bb + (kt >= 32 ? (size_t)D_ * NE : 0) + (size_t)(kt & 15) * 64 * NE; };
    auto b_lo = [&](int) { return false; };
    auto epi = [&](f32x4 (&acc)[2][4]) {
#pragma unroll
      for (int mi = 0; mi < 2; ++mi)
#pragma unroll
        for (int ni = 0; ni < 4; ++ni) {
          float4 o; o.x = acc[mi][ni][0]; o.y = acc[mi][ni][1]; o.z = acc[mi][ni][2]; o.w = acc[mi][ni][3];
          *reinterpret_cast<float4*>(p.logits + (size_t)(m0 + wr * 32 + mi * 16 + fr) * NE + n0 + wc * 64 + ni * 16 + fq * 4) = o;
        }
    };
    gemm_core<2, false, true>(sm, 48, a_addr, b_addr, NE, b_lo, epi);
  }
}

template <bool NAIVE_LG> DEV void ph_route(const Params& p, const float* rbias, int* cnt, const float* RW, int* etok) {
  const int lane = tidx() & 63, gw = blockIdx.x * NWAVE + (tidx() >> 6), nw = gridDim.x * NWAVE;
  const int half = lane >> 5;
  for (int tok = gw; tok < T_; tok += nw) {
    float aff[4], val[4];
    float lgn[4] = {0.f, 0.f, 0.f, 0.f};
    if (NAIVE_LG) {
      for (int k = 0; k < D_; ++k) {
        const float xv = p.x1f[(size_t)tok * D_ + k];
#pragma unroll
        for (int j = 0; j < 4; ++j) lgn[j] += xv * RW[(size_t)k * NE + lane + 64 * j];
      }
    }
#pragma unroll
    for (int j = 0; j < 4; ++j) {
      const float lg = NAIVE_LG ? lgn[j] : p.logits[(size_t)tok * NE + lane + 64 * j];
      aff[j] = 1.f / (1.f + expf(-lg));
      val[j] = aff[j] + rbias[lane + 64 * j];
    }
    float gs[8];
#pragma unroll
    for (int j = 0; j < 4; ++j) {
      float m1 = val[j];
#pragma unroll
      for (int o = 16; o; o >>= 1) m1 = fmaxf(m1, __shfl_xor(m1, o));
      const unsigned long long eq = __ballot(val[j] == m1);
      const int ceq = __popc((unsigned)(half ? (eq >> 32) : (eq & 0xffffffffull)));
      float m2 = (val[j] == m1) ? -INFINITY : val[j];
#pragma unroll
      for (int o = 16; o; o >>= 1) m2 = fmaxf(m2, __shfl_xor(m2, o));
      if (ceq >= 2) m2 = m1;
      const float mine = m1 + m2, other = __shfl_xor(mine, 32);
      gs[2 * j] = half ? other : mine; gs[2 * j + 1] = half ? mine : other;
    }
    bool gok[8];
#pragma unroll
    for (int g = 0; g < 8; ++g) {
      int rk = 0;
#pragma unroll
      for (int g2 = 0; g2 < 8; ++g2) rk += (gs[g2] > gs[g] || (gs[g2] == gs[g] && g2 < g)) ? 1 : 0;
      gok[g] = rk < 4;
    }
#pragma unroll
    for (int j = 0; j < 4; ++j) { const bool ok = half ? gok[2 * j + 1] : gok[2 * j]; if (!ok) val[j] = -INFINITY; }
    int my_e = 0; float my_a = 0.f, asum = 0.f;
#pragma unroll
    for (int k = 0; k < TOPK; ++k) {
      float bv = val[0]; int bi = lane;
#pragma unroll
      for (int j = 1; j < 4; ++j) if (val[j] > bv) { bv = val[j]; bi = lane + 64 * j; }
#pragma unroll
      for (int o = 32; o; o >>= 1) {
        const float ov = __shfl_xor(bv, o); const int oi = __shfl_xor(bi, o);
        if (ov > bv || (ov == bv && oi < bi)) { bv = ov; bi = oi; }
      }
      float a_sel = 0.f;
#pragma unroll
      for (int j = 0; j < 4; ++j) { const bool hit = (bi == lane + 64 * j); a_sel = hit ? aff[j] : a_sel; val[j] = hit ? -INFINITY : val[j]; }
      a_sel = wave_sum(a_sel);
      asum += a_sel;
      if (lane == k) { my_e = bi; my_a = a_sel; }
    }
    if (lane < TOPK) {
      const int ps = atomicAdd(&cnt[my_e], 1);
      p.eidx[tok * TOPK + lane] = my_e; p.epos[tok * TOPK + lane] = ps; p.gatev[tok * TOPK + lane] = my_a / asum * 2.5f;
      etok[(size_t)my_e * T_ + ps] = tok;
    }
  }
}

constexpr int MOE_TM = 320;
struct MoeTab { int cn[260]; int of[260]; int tf[260]; unsigned ao[5][NTHR]; };
DEV void moe_prep(MoeTab& mt, const int* cnt) {
  const int tid = tidx();
  if (tid < NE) mt.cn[tid] = cnt[tid];
  __syncthreads();
  if (tid == 0) {
    int a = 0, tl = 0;
    for (int e = 0; e < NE; ++e) { mt.of[e] = a; mt.tf[e] = tl; a += mt.cn[e]; tl += (mt.cn[e] + MOE_TM - 1) / MOE_TM; }
    mt.cn[NE] = T_; mt.of[NE] = NASG; mt.tf[NE] = tl; mt.of[NE + 1] = NASG + T_; mt.tf[NE + 1] = tl + (T_ + MOE_TM - 1) / MOE_TM;
  }
  __syncthreads();
}
DEV int moe_rows_per_tile(int cn, int tiles) { return (cn + tiles - 1) / tiles; }

DEV void ph_moe1(const Params& p, GemmSmem& sm, MoeTab& mt, int layer, const int* cnt) {
  const int tid = tidx(), lane = tid & 63, wid = tid >> 6, wr = wid >> 1, wc = wid & 1, fr = lane & 15, fq = lane >> 4;
  moe_prep(mt, cnt);
  for (ItemRange it = xcd_items(mt.tf[NE + 1] * 4); it.i < it.hi; it.i += it.step) {
    const int u = it.i;
    int lo = 0, hi = NE;
    while (lo < hi) { const int mid = (lo + hi + 1) >> 1; if (4 * mt.tf[mid] <= u) lo = mid; else hi = mid - 1; }
    const int e = lo, tiles = mt.tf[e + 1] - mt.tf[e], local = u - 4 * mt.tf[e];
    const int nt = local & 3, mtl = local >> 2, cn = mt.cn[e], of = mt.of[e];
    const int per = moe_rows_per_tile(cn, tiles), r0 = mtl * per, r1 = (r0 + per < cn) ? r0 + per : cn;
#pragma unroll
    for (int i = 0; i < 5; ++i) {
      int ri = r0 + (tid >> 3) + 64 * i; ri = ri < r1 ? ri : r1 - 1;
      const int tk = e < NE ? p.etok[(size_t)e * T_ + ri] : ri;
      mt.ao[i][tid] = (unsigned)tk * D_ + (tid & 7) * 8;
    }
    auto a_addr = [&](int i, int kt) { return p.x1b + mt.ao[i][tid] + kt * 64; };
    const float* wg = e < NE ? p.w_gate + ((size_t)layer * NE + e) * D_ * 256 : p.sh_gate + (size_t)layer * D_ * 256;
    const float* wu = e < NE ? p.w_up + ((size_t)layer * NE + e) * D_ * 256 : p.sh_up + (size_t)layer * D_ * 256;
    const int v0 = 4 * (tid & 31);
    const float* bb = ((v0 & 63) >= 32 ? wu : wg) + (size_t)(tid >> 5) * 256 + nt * 64 + (v0 >> 6) * 32 + (v0 & 31);
    auto b_addr = [&](int kt) { return bb + (size_t)kt * 64 * 256; };
    auto b_lo = [&](int) { return false; };
    auto epi = [&](f32x4 (&acc)[5][4]) {
#pragma unroll
      for (int mi = 0; mi < 5; ++mi) {
        const int idx = r0 + wr * 80 + mi * 16 + fr;
        if (idx < r1) {
#pragma unroll
          for (int n2 = 0; n2 < 2; ++n2) {
            float hv[4];
#pragma unroll
            for (int j = 0; j < 4; ++j) { const float g = acc[mi][n2][j], uu = acc[mi][n2 + 2][j]; hv[j] = g * __builtin_amdgcn_rcpf(1.f + __expf(-g)) * uu; }
            st_bf4(p.hbuf + (size_t)(of + idx) * 256 + nt * 64 + wc * 32 + n2 * 16 + fq * 4, hv[0], hv[1], hv[2], hv[3]);
          }
        }
      }
    };
    gemm_core<5, false>(sm, 16, a_addr, b_addr, 256, b_lo, epi);
  }
}

DEV void ph_moe2(const Params& p, GemmSmem& sm, MoeTab& mt, int layer, const int* cnt) {
  const int tid = tidx(), lane = tid & 63, wid = tid >> 6, wr = wid >> 1, wc = wid & 1, fr = lane & 15, fq = lane >> 4;
  moe_prep(mt, cnt);
  for (ItemRange it = xcd_items(mt.tf[NE + 1] * 8); it.i < it.hi; it.i += it.step) {
    const int u = it.i;
    int lo = 0, hi = NE;
    while (lo < hi) { const int mid = (lo + hi + 1) >> 1; if (8 * mt.tf[mid] <= u) lo = mid; else hi = mid - 1; }
    const int e = lo, tiles = mt.tf[e + 1] - mt.tf[e], local = u - 8 * mt.tf[e];
    const int nt = local & 7, mtl = local >> 3, cn = mt.cn[e], of = mt.of[e];
    const int per = moe_rows_per_tile(cn, tiles), r0 = mtl * per, r1 = (r0 + per < cn) ? r0 + per : cn;
    const unsigned ao0 = (unsigned)(of + r0 + (tid >> 3)) * 256 + (tid & 7) * 8;
    const int rmax = r1 - 1 - r0 - (tid >> 3);
    auto a_addr = [&](int i, int kt) { int d = 64 * i; d = d < rmax ? d : rmax; return p.hbuf + ao0 + d * 256 + kt * 64; };
    const float* wd = e < NE ? p.w_down + ((size_t)layer * NE + e) * 256 * D_ : p.sh_down + (size_t)layer * 256 * D_;
    const float* bb = wd + (size_t)(tid >> 5) * D_ + nt * 128 + 4 * (tid & 31);
    auto b_addr = [&](int kt) { return bb + (size_t)kt * 64 * D_; };
    auto b_lo = [&](int) { return false; };
    auto epi = [&](f32x4 (&acc)[5][4]) {
#pragma unroll
      for (int mi = 0; mi < 5; ++mi) {
        const int idx = r0 + wr * 80 + mi * 16 + fr;
        if (idx < r1) {
#pragma unroll
          for (int ni = 0; ni < 4; ++ni)
            st_bf4(p.ybuf + (size_t)(of + idx) * D_ + nt * 128 + wc * 64 + ni * 16 + fq * 4, acc[mi][ni][0], acc[mi][ni][1], acc[mi][ni][2], acc[mi][ni][3]);
        }
      }
    };
    gemm_core<5, false>(sm, 4, a_addr, b_addr, D_, b_lo, epi);
  }
}

DEV void ph_combine_ln(const Params& p, MoeTab& mt, const int* cnt, const float* g, const float* bt, float* outf, u16* outb, bool with_ffn) {
  const int lane = tidx() & 63, gw = blockIdx.x * NWAVE + (tidx() >> 6), nw = gridDim.x * NWAVE;
  moe_prep(mt, cnt);
  for (int tok = gw; tok < T_; tok += nw) {
    float4 v[4];
#pragma unroll
    for (int i = 0; i < 4; ++i) {
      v[i] = reinterpret_cast<const float4*>(p.x1f + (size_t)tok * D_)[i * 64 + lane];
      v[i].x *= ALPHA; v[i].y *= ALPHA; v[i].z *= ALPHA; v[i].w *= ALPHA;
    }
    if (with_ffn) {
#if FFN_MODE != 2
#pragma unroll
      for (int i = 0; i < 4; ++i) {
        const uint2 y = reinterpret_cast<const uint2*>(p.ybuf + (size_t)(NASG + tok) * D_)[i * 64 + lane];
        v[i].x += bflo(y.x); v[i].y += bfhi(y.x); v[i].z += bflo(y.y); v[i].w += bfhi(y.y);
      }
#endif
#if FFN_MODE != 1
      for (int k = 0; k < TOPK; ++k) {
        const int sl = mt.of[p.eidx[tok * TOPK + k]] + p.epos[tok * TOPK + k]; const float gk = p.gatev[tok * TOPK + k];
#pragma unroll
        for (int i = 0; i < 4; ++i) {
          const uint2 y = reinterpret_cast<const uint2*>(p.ybuf + (size_t)sl * D_)[i * 64 + lane];
          v[i].x += gk * bflo(y.x); v[i].y += gk * bfhi(y.x); v[i].z += gk * bflo(y.y); v[i].w += gk * bfhi(y.y);
        }
      }
#endif
    }
    float s = 0.f;
#pragma unroll
    for (int i = 0; i < 4; ++i) s += v[i].x + v[i].y + v[i].z + v[i].w;
    const float mu = wave_sum(s) * (1.f / D_);
    float ss = 0.f;
#pragma unroll
    for (int i = 0; i < 4; ++i) { v[i].x -= mu; v[i].y -= mu; v[i].z -= mu; v[i].w -= mu; ss += v[i].x * v[i].x + v[i].y * v[i].y + v[i].z * v[i].z + v[i].w * v[i].w; }
    const float rstd = rsqrtf(wave_sum(ss) * (1.f / D_) + LN_EPS);
#pragma unroll
    for (int i = 0; i < 4; ++i) {
      const float4 gg = reinterpret_cast<const float4*>(g)[i * 64 + lane], bb = reinterpret_cast<const float4*>(bt)[i * 64 + lane];
      float4 y; y.x = v[i].x * rstd * gg.x + bb.x; y.y = v[i].y * rstd * gg.y + bb.y; y.z = v[i].z * rstd * gg.z + bb.z; y.w = v[i].w * rstd * gg.w + bb.w;
      reinterpret_cast<float4*>(outf + (size_t)tok * D_)[i * 64 + lane] = y;
      uint2 hi; hi.x = pack2(y.x, y.y); hi.y = pack2(y.z, y.w);
      reinterpret_cast<uint2*>(outb + (size_t)tok * D_)[i * 64 + lane] = hi;
    }
  }
}

DEV void ph_inproj1(const Params& p, GemmSmem& sm) {
  const int tid = tidx(), lane = tid & 63, wid = tid >> 6, wr = wid >> 1, wc = wid & 1, fr = lane & 15, fq = lane >> 4;
  constexpr int NT = 21;
  for (ItemRange it = xcd_items(64 * (NT + 1)); it.i < it.hi; it.i += it.step) {
    int mt, nt; dense_item<16, 2>(it.i, 64, mt, nt);
    if (nt >= NT) continue;
    const int m0 = mt * 256, n0 = nt * 128;
    const u16* ar0 = p.xb + (size_t)(m0 + (tid >> 3)) * D_ + (tid & 7) * 8;
    auto a_addr = [&](int i, int kt) { return ar0 + (size_t)i * 64 * D_ + kt * 64; };
    const u16* bb = p.w16_in1 + (size_t)(tid >> 4) * NIN1 + n0 + 8 * (tid & 15);
    const bool bok = n0 + 8 * (tid & 15) < NIN1;
    const u16* bbv = bok ? bb : p.w16_in1 + (size_t)(tid >> 4) * NIN1;
    auto b_addr = [&](int kt) -> const u16* { return bbv + (size_t)kt * 64 * NIN1; };
    auto b_lo = [&](int) { return false; };
    auto epi = [&](f32x4 (&acc)[4][4]) {
#pragma unroll
      for (int mi = 0; mi < 4; ++mi) {
        const int row = m0 + wr * 64 + mi * 16 + fr;
#pragma unroll
        for (int ni = 0; ni < 4; ++ni) {
          f32x4 v = acc[mi][ni];
          const int col = n0 + wc * 64 + ni * 16 + fq * 4;
          const bool rope = (ni == 0) && (col < 1280 || (col >= 1536 && col < 1792) || (col >= 2048 && col < 2304));
          if (rope) {
            const float4 c_ = ld4(p.cs + row * 16 + 4 * (fq & 1)), s_ = ld4(p.cs + row * 16 + 8 + 4 * (fq & 1));
            const float p0 = __shfl_xor(v[0], 32), p1 = __shfl_xor(v[1], 32), p2 = __shfl_xor(v[2], 32), p3 = __shfl_xor(v[3], 32);
            const float sg = fq < 2 ? -1.f : 1.f;
            v[0] = v[0] * c_.x + sg * p0 * s_.x; v[1] = v[1] * c_.y + sg * p1 * s_.y; v[2] = v[2] * c_.z + sg * p2 * s_.z; v[3] = v[3] * c_.w + sg * p3 * s_.w;
          }
          if (col < LD1) st_bf4(p.qkv + (size_t)row * LD1 + col, v[0], v[1], v[2], v[3]);
          else if (col < NIN1) {
            float4 o; o.x = 1.f / (1.f + __expf(-v[0])); o.y = 1.f / (1.f + __expf(-v[1])); o.z = 1.f / (1.f + __expf(-v[2])); o.w = 1.f / (1.f + __expf(-v[3]));
            *reinterpret_cast<float4*>(p.gates + (size_t)row * 48 + (col - LD1)) = o;
          }
        }
      }
    };
    gemm_core<4, false, true>(sm, 16, a_addr, b_addr, NIN1, b_lo, epi, bok);
  }
}

DEV float gelu_tanh(float x) { const float u = 0.7978845608028654f * (x + 0.044715f * x * x * x); return 0.5f * x * (1.f + tanhf(u)); }
DEV void ph_cmp1(const Params& p, GemmSmem& sm) {
  const int tid = tidx(), lane = tid & 63, wid = tid >> 6, wr = wid >> 1, wc = wid & 1, fr = lane & 15, fq = lane >> 4;
  for (int u = blockIdx.x; u < 64; u += gridDim.x) {
    const int ts = u >> 5, mt = u & 31, m0 = mt * 128;
    const u16* ar[2];
#pragma unroll
    for (int i = 0; i < 2; ++i) {
      const int m_ = m0 + (tid >> 3) + 64 * i, bg = m_ >> 8; int c = m_ & 255; c = c < 255 ? c : 254;
      ar[i] = p.qkv + (size_t)((bg >> 2) * S_ + 16 * c) * LD1 + (ts ? 1280 : 1024) + (bg & 3) * 64 + (tid & 7) * 8;
    }
    auto a_addr = [&](int i, int kt) { return ar[i] + (size_t)kt * LD1; };
    const float* bb = (ts ? p.cmpv_w1 : p.cmpk_w1) + (size_t)(tid >> 5) * 128 + 4 * (tid & 31);
    auto b_addr = [&](int kt) { return bb + (size_t)kt * 64 * 128; };
    auto b_lo = [&](int) { return false; };
    auto epi = [&](f32x4 (&acc)[2][4]) {
#pragma unroll
      for (int mi = 0; mi < 2; ++mi)
#pragma unroll
        for (int ni = 0; ni < 4; ++ni) {
          const int m = m0 + wr * 32 + mi * 16 + fr, col = wc * 64 + ni * 16 + fq * 4;
          const float4 pbv = ld4(p.pb + ts * 128 + col);
          st_bf4(p.hid + ((size_t)ts * 4096 + m) * 128 + col, gelu_tanh(acc[mi][ni][0] + pbv.x), gelu_tanh(acc[mi][ni][1] + pbv.y),
                 gelu_tanh(acc[mi][ni][2] + pbv.z), gelu_tanh(acc[mi][ni][3] + pbv.w));
        }
    };
    gemm_core<2, false>(sm, 32, a_addr, b_addr, 128, b_lo, epi);
  }
}
DEV void ph_cmp2(const Params& p, GemmSmem& sm) {
  const int tid = tidx(), lane = tid & 63, wid = tid >> 6, wr = wid >> 1, wc = wid & 1, fr = lane & 15, fq = lane >> 4;
  for (int u = blockIdx.x; u < 64; u += gridDim.x) {
    const int ts = u >> 5, mt = u & 31, m0 = mt * 128;
    const u16* ar0 = p.hid + ((size_t)ts * 4096 + m0 + (tid >> 3)) * 128 + (tid & 7) * 8;
    auto a_addr = [&](int i, int kt) { return ar0 + (size_t)i * 64 * 128 + kt * 64; };
    const float* bb = (ts ? p.cmpv_w2 : p.cmpk_w2) + (size_t)(tid >> 5) * 64 + 4 * (tid & 31);
    const bool bok = 4 * (tid & 31) < 64;
    const float* bbv = bok ? bb : (ts ? p.cmpv_w2 : p.cmpk_w2) + (size_t)(tid >> 5) * 64;
    auto b_addr = [&](int kt) -> const float* { return bbv + (size_t)kt * 64 * 64; };
    auto b_lo = [&](int) { return false; };
    auto epi = [&](f32x4 (&acc)[2][4]) {
      if (wc == 0) {
#pragma unroll
        for (int mi = 0; mi < 2; ++mi)
#pragma unroll
          for (int ni = 0; ni < 4; ++ni) {
            const int m = m0 + wr * 32 + mi * 16 + fr, col = ni * 16 + fq * 4;
            st_bf4(p.cmpkv + ((size_t)ts * 4096 + m) * 64 + col, acc[mi][ni][0], acc[mi][ni][1], acc[mi][ni][2], acc[mi][ni][3]);
          }
      }
    };
    gemm_core<2, false>(sm, 2, a_addr, b_addr, 64, b_lo, epi, bok);
  }
}

DEV void ph_attn1(const Params& p, AttnSmem& sm) {
  const int tid = tidx(), lane = tid & 63, wid = tid >> 6;
  float* qs = sm.qs[wid]; float* sc = sm.sc[wid]; int* tk = sm.tk[wid]; int* tw = sm.tw[wid];
  const int gw = blockIdx.x * NWAVE + wid, nw = gridDim.x * NWAVE;
  for (int u = gw; u < T_ * 4; u += nw) {
    const int tg = u >> 2, g = u & 3, b = tg >> 12, t = tg & 4095, cur = t >> 6;
    const u16* row = p.qkv + (size_t)tg * LD1;
    const int nvalid = t >= 31 ? (((t - 31) >> 4) + 1 < 255 ? ((t - 31) >> 4) + 1 : 255) : 0;
    const int n4c = (nvalid + 3) & ~3;
    const u16* kc = p.cmpkv + (size_t)((b * 4 + g) * 256) * 64;
    const u16* vc = p.cmpkv + (size_t)(4096 + (b * 4 + g) * 256) * 64;
    float imp = 0.f;
    float ocmp[4][4];
#pragma unroll
    for (int r = 0; r < 4; ++r) {
      ocmp[r][0] = ocmp[r][1] = ocmp[r][2] = ocmp[r][3] = 0.f;
      if (nvalid > 0) {
        qs[lane] = bf2f(row[(g * 4 + r) * 64 + lane]) * 0.125f;
        for (int i = lane; i < n4c; i += 64) tk[i] = i < nvalid ? i : -1;
        WAVE_SYNC();
        const float inv = wave_attn(qs, sc, tk, n4c, kc, vc, 64, -INFINITY, lane, ocmp[r]);
        WAVE_SYNC();
        float a = 0.f;
        const int c0 = 4 * lane;
        if (c0 - 1 >= 0 && c0 - 1 < nvalid) a += 0.5f * sc[c0 - 1];
        if (c0 < nvalid) a += sc[c0];
        if (c0 + 1 < nvalid) a += sc[c0 + 1];
        if (c0 + 2 < nvalid) a += sc[c0 + 2];
        if (c0 + 3 < nvalid) a += 0.5f * sc[c0 + 3];
        imp += a * inv;
        WAVE_SYNC();
      }
    }
    const float score = (lane > cur) ? -1.f : ((lane == 0 || lane == cur || lane == cur - 1) ? 1.0e4f : imp);
    int rk = 0;
    for (int jj = 0; jj < 64; ++jj) { const float sj = __shfl(score, jj); rk += (sj > score || (sj == score && jj < lane)) ? 1 : 0; }
    unsigned long long mask = __ballot(rk < 16 && lane <= cur);
    int nsel = 0;
    while (mask) {
      const int j = __ffsll((long long)mask) - 1; mask &= mask - 1;
      const int tok = j * 64 + lane;
      tk[nsel * 64 + lane] = tok <= t ? b * S_ + tok : -1;
      ++nsel;
    }
    for (int i = lane; i < 512; i += 64) { const int tok = t - i; tw[i] = tok >= 0 ? b * S_ + tok : -1; }
    WAVE_SYNC();
#pragma unroll
    for (int r = 0; r < 4; ++r) {
      const int h = g * 4 + r;
      qs[lane] = bf2f(row[h * 64 + lane]) * 0.125f;
      WAVE_SYNC();
      float os[4], ow[4];
      wave_attn(qs, sc, tk, nsel * 64, p.qkv + 1536 + g * 64, p.qkv + 1792 + g * 64, LD1, -INFINITY, lane, os);
      WAVE_SYNC();
      wave_attn(qs, sc, tw, 512, p.qkv + 2048 + g * 64, p.qkv + 2304 + g * 64, LD1, -INFINITY, lane, ow);
      const float g0 = p.gates[(size_t)tg * 48 + h * 3], g1 = p.gates[(size_t)tg * 48 + h * 3 + 1], g2 = p.gates[(size_t)tg * 48 + h * 3 + 2];
      if (lane < 16) {
        uint2 w;
        w.x = pack2(g0 * ocmp[r][0] + g1 * os[0] + g2 * ow[0], g0 * ocmp[r][1] + g1 * os[1] + g2 * ow[1]);
        w.y = pack2(g0 * ocmp[r][2] + g1 * os[2] + g2 * ow[2], g0 * ocmp[r][3] + g1 * os[3] + g2 * ow[3]);
        *reinterpret_cast<uint2*>(p.ao + (size_t)tg * D_ + h * 64 + lane * 4) = w;
      }
      WAVE_SYNC();
    }
  }
}


using f32x16 = __attribute__((ext_vector_type(16))) float;
DEV int crow(int r, int hi) { return (r & 3) + 8 * (r >> 2) + 4 * hi; }
constexpr float LOG2E = 1.4426950408889634f;
constexpr float SCL2 = 0.125f * LOG2E;

struct WaveTile { u16 K[32][72]; u16 V[2][32][32]; float imp[32][64]; unsigned long long msk[32]; };
struct KVTile { u16 K[32][72]; u16 V[2][32][32]; };
struct AttnState { float m, l; f32x16 o[2]; };

DEV void stage_load(u32x4_t (&rk)[4], u32x4_t (&rv)[4], const u16* Kb, const u16* Vb, int ld, long rowbase, int rowstep, int kcmax, int k0, int lane) {
#pragma unroll
  for (int it = 0; it < 4; ++it) {
    int kc = k0 + (lane >> 3) + 8 * it; kc = kc > kcmax ? kcmax : kc;
    const long row = rowbase + (long)kc * rowstep;
    rk[it] = *reinterpret_cast<const u32x4_t*>(Kb + row * ld + (lane & 7) * 8);
    rv[it] = *reinterpret_cast<const u32x4_t*>(Vb + row * ld + (lane & 7) * 8);
  }
}
DEV void stage_store(WaveTile& wt, const u32x4_t (&rk)[4], const u32x4_t (&rv)[4], int lane) {
  const int ch = lane & 7;
#pragma unroll
  for (int it = 0; it < 4; ++it) {
    const int j = (lane >> 3) + 8 * it;
    *reinterpret_cast<u32x4_t*>(&wt.K[j][ch * 8]) = rk[it];
    *reinterpret_cast<u32x4_t*>(&wt.V[ch >> 2][j][(ch & 3) * 8]) = rv[it];
  }
}
template <class TT> DEV f32x16 qk_tile(const TT& wt, const bf16x8 (&qf)[4], int r32, int hi) {
  f32x16 acc;
#pragma unroll
  for (int r = 0; r < 16; ++r) acc[r] = 0.f;
#pragma unroll
  for (int s = 0; s < 4; ++s) {
    const bf16x8 kf = *reinterpret_cast<const bf16x8*>(&wt.K[r32][16 * s + 8 * hi]);
    acc = __builtin_amdgcn_mfma_f32_32x32x16_bf16(kf, qf[s], acc, 0, 0, 0);
  }
  return acc;
}
template <class TT> DEV void pv_tile(const TT& wt, const float (&pr)[16], f32x16 (&o)[2], int lane) {
  const int hi = lane >> 5, g = (lane >> 4) & 1, q4 = (lane & 15) >> 2, p4 = lane & 3;
  bf16x8 pf[2];
#pragma unroll
  for (int s2 = 0; s2 < 2; ++s2) {
    u32x4_t w;
    w[0] = cvtpk(pr[8 * s2 + 0], pr[8 * s2 + 1]); w[1] = cvtpk(pr[8 * s2 + 2], pr[8 * s2 + 3]);
    w[2] = cvtpk(pr[8 * s2 + 4], pr[8 * s2 + 5]); w[3] = cvtpk(pr[8 * s2 + 6], pr[8 * s2 + 7]);
    pf[s2] = __builtin_bit_cast(bf16x8, w);
  }
#pragma unroll
  for (int dt = 0; dt < 2; ++dt)
#pragma unroll
    for (int s2 = 0; s2 < 2; ++s2) {
      const v4i16_t lo = lds_tr(&wt.V[dt][16 * s2 + 4 * hi + q4][16 * g + 4 * p4]);
      const v4i16_t hh = lds_tr(&wt.V[dt][16 * s2 + 8 + 4 * hi + q4][16 * g + 4 * p4]);
      const bf16x8 vf = {lo[0], lo[1], lo[2], lo[3], hh[0], hh[1], hh[2], hh[3]};
      o[dt] = __builtin_amdgcn_mfma_f32_32x32x16_bf16(vf, pf[s2], o[dt], 0, 0, 0);
    }
}
DEV void attn_init(AttnState& st) {
  st.m = -INFINITY; st.l = 0.f;
#pragma unroll
  for (int r = 0; r < 16; ++r) { st.o[0][r] = 0.f; st.o[1][r] = 0.f; }
}
template <bool USE_SEL>
DEV void attn_span(AttnState& st, WaveTile& wt, const bf16x8 (&qf)[4], const u16* Kb, const u16* Vb, int ld,
                   long rowbase, int rowstep, int kcmax, int kc_lo, int kc_hi, int qc, int W,
                   unsigned long long sel, unsigned long long selu, int lane, int qc_min, int qc_max) {
  const int r32 = lane & 31, hi = lane >> 5;
  if (kc_lo < 0) kc_lo = 0;
  if (kc_hi > kcmax) kc_hi = kcmax;
  const int full_hi = qc_min < kcmax ? qc_min : kcmax;
  auto skip = [&](int k0) -> bool { return USE_SEL && !((selu >> (k0 >> 6)) & 1ull); };
  int kc0 = kc_lo & ~31;
  while (kc0 <= kc_hi && skip(kc0)) kc0 += 32;
  if (kc0 > kc_hi) return;
  u32x4_t rk[4], rv[4];
  stage_load(rk, rv, Kb, Vb, ld, rowbase, rowstep, kcmax, kc0, lane);
  for (;;) {
    stage_store(wt, rk, rv, lane);
    int kn = kc0 + 32;
    while (kn <= kc_hi && skip(kn)) kn += 32;
    if (kn <= kc_hi) stage_load(rk, rv, Kb, Vb, ld, rowbase, rowstep, kcmax, kn, lane);
    WAVE_SYNC();
    const f32x16 s = qk_tile(wt, qf, r32, hi);
    const bool selbit = USE_SEL ? (((sel >> (kc0 >> 6)) & 1ull) != 0ull) : true;
    const bool full = (qc_min <= qc_max) && (kc0 + 31 <= full_hi) && (kc0 >= qc_max - W);
    float sv[16]; float mt = -INFINITY;
    if (full) {
      float rm = s[0];
#pragma unroll
      for (int r = 1; r < 16; ++r) rm = fmaxf(rm, s[r]);
      mt = selbit ? rm * SCL2 : -INFINITY;
    } else {
#pragma unroll
      for (int r = 0; r < 16; ++r) {
        const int kc = kc0 + crow(r, hi), dist = qc - kc;
        const bool ok = selbit && kc <= kcmax && dist >= 0 && dist <= W;
        sv[r] = ok ? s[r] * SCL2 : -INFINITY;
        mt = fmaxf(mt, sv[r]);
      }
    }
    mt = fmaxf(mt, __shfl_xor(mt, 32));
    const float mnew = fmaxf(st.m, mt), muse = (mnew == -INFINITY) ? 0.f : mnew;
    const float alpha = __builtin_amdgcn_exp2f(st.m - muse);
    st.m = mnew;
    float ps = 0.f;
    if (full) {
      const float sub = selbit ? muse : INFINITY;
#pragma unroll
      for (int r = 0; r < 16; ++r) { sv[r] = __builtin_amdgcn_exp2f(__builtin_fmaf(s[r], SCL2, -sub)); ps += sv[r]; }
    } else {
#pragma unroll
      for (int r = 0; r < 16; ++r) { sv[r] = __builtin_amdgcn_exp2f(sv[r] - muse); ps += sv[r]; }
    }
    st.l = st.l * alpha + ps;
    if (__any(alpha != 1.f)) {
#pragma unroll
      for (int r = 0; r < 16; ++r) { st.o[0][r] *= alpha; st.o[1][r] *= alpha; }
    }
    pv_tile(wt, sv, st.o, lane);
    if (kn > kc_hi) break;
    kc0 = kn;
  }
}
DEV void attn_finish(AttnState& st, float sink2) {
  float l = st.l + __shfl_xor(st.l, 32);
  if (sink2 > -INFINITY) l += __builtin_amdgcn_exp2f(sink2 - st.m);
  const float inv = l > 0.f ? 1.f / l : 0.f;
#pragma unroll
  for (int r = 0; r < 16; ++r) { st.o[0][r] *= inv; st.o[1][r] *= inv; }
}
DEV void attn_store_bf16(const AttnState& st, u16* orow, int hi) {
#pragma unroll
  for (int dt = 0; dt < 2; ++dt)
#pragma unroll
    for (int k4 = 0; k4 < 4; ++k4) {
      uint2 w; w.x = cvtpk(st.o[dt][4 * k4], st.o[dt][4 * k4 + 1]); w.y = cvtpk(st.o[dt][4 * k4 + 2], st.o[dt][4 * k4 + 3]);
      *reinterpret_cast<uint2*>(orow + 32 * dt + 8 * k4 + 4 * hi) = w;
    }
}
DEV void load_qf(bf16x8 (&qf)[4], const u16* qrow, int hi) {
#pragma unroll
  for (int s = 0; s < 4; ++s) qf[s] = *reinterpret_cast<const bf16x8*>(qrow + 16 * s + 8 * hi);
}

DEV void ph_attn0_mfma(const Params& p, WaveTile* wts) {
  const int tid = tidx(), lane = tid & 63, wid = tid >> 6, r32 = lane & 31, hi = lane >> 5;
  WaveTile& wt = wts[wid];
  const int gw = blockIdx.x * NWAVE + wid, nw = gridDim.x * NWAVE;
  for (int u = gw; u < 8192; u += nw) {
    AttnState st; attn_init(st);
    bf16x8 qf[4];
    if (u < 4096) {
      const int it = u & 7, res = (u >> 3) & 15, h = (u >> 7) & 7, b = u >> 10;
      const int i0 = it * 32, t = 16 * (i0 + r32) + res;
      const long row = (long)b * S_ + t;
      load_qf(qf, p.qkv + row * LD0 + h * 64, hi);
      const u16* Kb = p.qkv + 512 + h * 64; const u16* Vb = p.qkv + 1024 + h * 64;
      attn_span<false>(st, wt, qf, Kb, Vb, LD0, (long)b * S_ + res, 16, 255, i0 - 128, i0 + 31, i0 + r32, 128, 0ull, 0ull, lane, 1, 0);
      const int c = res >> 2;
      attn_span<false>(st, wt, qf, Kb, Vb, LD0, (long)b * S_ + (res & 3), 4, 1023, 4 * i0 + c - 128, 4 * (i0 + 31) + c, 4 * (i0 + r32) + c, 128, 0ull, 0ull, lane, 1, 0);
      attn_span<false>(st, wt, qf, Kb, Vb, LD0, (long)b * S_, 1, 4095, 16 * i0 + res - 128, 16 * (i0 + 31) + res, t, 128, 0ull, 0ull, lane, 1, 0);
      attn_finish(st, -INFINITY);
      attn_store_bf16(st, p.ao + row * D_ + h * 64, hi);
    } else {
      const int v = u - 4096, qt = v & 127, hb = (v >> 7) & 7, b = v >> 10, g = hb >> 2;
      const int t = 32 * qt + r32;
      const long row = (long)b * S_ + t;
      load_qf(qf, p.qkv + row * LD0 + 1536 + hb * 64, hi);
      attn_span<false>(st, wt, qf, p.qkv + 2048 + g * 64, p.qkv + 2176 + g * 64, LD0, (long)b * S_, 1, 4095, 32 * qt - 127, 32 * qt + 31, t, 127, 0ull, 0ull, lane, 32 * qt, 32 * qt + 31);
      attn_finish(st, p.even_sinks[hb] * LOG2E);
      attn_store_bf16(st, p.ao + row * D_ + 512 + hb * 64, hi);
    }
  }
}

struct Att1aSmem { KVTile tiles[2][2]; float imp[2][32][65]; float sc[NWAVE][64]; };
DEV void ph_attn1a(const Params& p, char* smem) {
  Att1aSmem& sm = *reinterpret_cast<Att1aSmem*>(smem);
  const int tid = tidx(), lane = tid & 63, wid = tid >> 6, r32 = lane & 31, hi = lane >> 5, gl = wid >> 2;
  const int sg = tid >> 8, sj = (tid & 255) >> 3, sc = tid & 7;
  for (int u = blockIdx.x; u < 1024; u += gridDim.x) {
    const int k = u >> 8, base = u & 255, bg = base & 7, x = base >> 3;
    const int qt = (k == 0) ? 127 - x : (k == 1) ? 64 + x : (k == 2) ? 63 - x : x;
    const int b = bg >> 1, gp = bg & 1;
    const int h = gp * 8 + wid, g = h >> 2;
    const int q0 = 32 * qt, t = q0 + r32;
    const long row = (long)b * S_ + t;
    const int qc = (t - 31) >> 4;
    int kc_hi = q0 >> 4; kc_hi = kc_hi > 254 ? 254 : kc_hi;
    const int ntile = (kc_hi >> 5) + 1;
    const u16* kp = p.cmpkv + ((size_t)((b * 4 + 2 * gp + sg) * 256) + sj) * 64 + sc * 8;
    const u16* vp = kp + (size_t)4096 * 64;
    for (int i = tid; i < 2 * 32 * 65; i += NTHR) (&sm.imp[0][0][0])[i] = 0.f;
    bf16x8 qf[4];
    load_qf(qf, p.qkv + row * LD1 + h * 64, hi);
    auto for_tiles = [&](auto&& body) {
      u32x4_t rk = *reinterpret_cast<const u32x4_t*>(kp), rv = *reinterpret_cast<const u32x4_t*>(vp);
      int cur = 0;
      for (int tt = 0; tt < ntile; ++tt) {
        KVTile& dst = sm.tiles[cur][sg];
        *reinterpret_cast<u32x4_t*>(&dst.K[sj][sc * 8]) = rk;
        *reinterpret_cast<u32x4_t*>(&dst.V[sc >> 2][sj][(sc & 3) * 8]) = rv;
        const int tn = tt + 1 < ntile ? tt + 1 : tt;
        rk = *reinterpret_cast<const u32x4_t*>(kp + (size_t)tn * 32 * 64);
        rv = *reinterpret_cast<const u32x4_t*>(vp + (size_t)tn * 32 * 64);
        __syncthreads();
        body(sm.tiles[cur][gl], tt * 32);
        cur ^= 1;
      }
      __syncthreads();
    };
    float m = -INFINITY, l = 0.f;
    for_tiles([&](const KVTile& tl, int kc0) {
      const f32x16 s = qk_tile(tl, qf, r32, hi);
      float sv[16]; float mt = -INFINITY;
#pragma unroll
      for (int rr = 0; rr < 16; ++rr) { const int kc = kc0 + crow(rr, hi); const bool ok = kc <= 254 && kc <= qc; sv[rr] = ok ? s[rr] * SCL2 : -INFINITY; mt = fmaxf(mt, sv[rr]); }
      mt = fmaxf(mt, __shfl_xor(mt, 32));
      const float mnew = fmaxf(m, mt), muse = (mnew == -INFINITY) ? 0.f : mnew;
      float ps = 0.f;
#pragma unroll
      for (int rr = 0; rr < 16; ++rr) ps += __builtin_amdgcn_exp2f(sv[rr] - muse);
      l = l * __builtin_amdgcn_exp2f(m - muse) + ps; m = mnew;
    });
    l += __shfl_xor(l, 32);
    const float inv = l > 0.f ? 1.f / l : 0.f, muse = (m == -INFINITY) ? 0.f : m;
    f32x16 o[2];
#pragma unroll
    for (int rr = 0; rr < 16; ++rr) { o[0][rr] = 0.f; o[1][rr] = 0.f; }
    for_tiles([&](const KVTile& tl, int kc0) {
      const f32x16 s = qk_tile(tl, qf, r32, hi);
      float pr[16];
#pragma unroll
      for (int rr = 0; rr < 16; ++rr) { const int kc = kc0 + crow(rr, hi); const bool ok = kc <= 254 && kc <= qc; pr[rr] = ok ? __builtin_amdgcn_exp2f(s[rr] * SCL2 - muse) * inv : 0.f; }
#pragma unroll
      for (int k4 = 0; k4 < 4; ++k4) {
        const int j = (kc0 >> 2) + 2 * k4 + hi;
        atomicAdd(&sm.imp[gl][r32][j], pr[4 * k4] + pr[4 * k4 + 1] + pr[4 * k4 + 2] + 0.5f * pr[4 * k4 + 3]);
        if (j + 1 < 64) atomicAdd(&sm.imp[gl][r32][j + 1], 0.5f * pr[4 * k4 + 3]);
      }
      pv_tile(tl, pr, o, lane);
    });
    const float g0 = p.gates[(size_t)row * 48 + h * 3];
#pragma unroll
    for (int dt = 0; dt < 2; ++dt)
#pragma unroll
      for (int k4 = 0; k4 < 4; ++k4) {
        float4 w; w.x = g0 * o[dt][4 * k4]; w.y = g0 * o[dt][4 * k4 + 1]; w.z = g0 * o[dt][4 * k4 + 2]; w.w = g0 * o[dt][4 * k4 + 3];
        *reinterpret_cast<float4*>(p.hpre + (size_t)row * D_ + h * 64 + 32 * dt + 8 * k4 + 4 * hi) = w;
      }
    for (int i = 0; i < 8; ++i) {
      const int pi = wid * 8 + i, grp = pi >> 5, q = pi & 31;
      const int tq = q0 + q, cur = tq >> 6;
      const float score = (lane > cur) ? -1.f : ((lane == 0 || lane == cur || lane == cur - 1) ? 1.0e4f : sm.imp[grp][q][lane]);
      sm.sc[wid][lane] = score;
      WAVE_SYNC();
      int rk_ = 0;
#pragma unroll
      for (int jj = 0; jj < 64; jj += 4) {
        const float4 v = *reinterpret_cast<const float4*>(&sm.sc[wid][jj]);
        rk_ += (v.x > score || (v.x == score && jj < lane)) ? 1 : 0;
        rk_ += (v.y > score || (v.y == score && jj + 1 < lane)) ? 1 : 0;
        rk_ += (v.z > score || (v.z == score && jj + 2 < lane)) ? 1 : 0;
        rk_ += (v.w > score || (v.w == score && jj + 3 < lane)) ? 1 : 0;
      }
      WAVE_SYNC();
      const unsigned long long mask = __ballot(rk_ < 16 && lane <= cur);
      if (lane == 0) p.selmask[((size_t)b * S_ + tq) * 4 + 2 * gp + grp] = mask;
    }
    __syncthreads();
  }
}

template <class TT>
DEV void attn_tile_update(AttnState& st, const TT& tl, const bf16x8 (&qf)[4], int kc0, int qc, int W, int kcmax, bool selbit, bool full, int lane) {
  const int r32 = lane & 31, hi = lane >> 5;
  const f32x16 s = qk_tile(tl, qf, r32, hi);
  float sv[16]; float mt = -INFINITY;
  if (full) {
    float rm = s[0];
#pragma unroll
    for (int r = 1; r < 16; ++r) rm = fmaxf(rm, s[r]);
    mt = selbit ? rm * SCL2 : -INFINITY;
  } else {
#pragma unroll
    for (int r = 0; r < 16; ++r) {
      const int kc = kc0 + crow(r, hi), dist = qc - kc;
      const bool ok = selbit && kc <= kcmax && dist >= 0 && dist <= W;
      sv[r] = ok ? s[r] * SCL2 : -INFINITY;
      mt = fmaxf(mt, sv[r]);
    }
  }
  mt = fmaxf(mt, __shfl_xor(mt, 32));
  const float mnew = fmaxf(st.m, mt), muse = (mnew == -INFINITY) ? 0.f : mnew;
  const float alpha = __builtin_amdgcn_exp2f(st.m - muse);
  st.m = mnew;
  float ps = 0.f;
  if (full) {
    const float sub = selbit ? muse : INFINITY;
#pragma unroll
    for (int r = 0; r < 16; ++r) { sv[r] = __builtin_amdgcn_exp2f(__builtin_fmaf(s[r], SCL2, -sub)); ps += sv[r]; }
  } else {
#pragma unroll
    for (int r = 0; r < 16; ++r) { sv[r] = __builtin_amdgcn_exp2f(sv[r] - muse); ps += sv[r]; }
  }
  st.l = st.l * alpha + ps;
  if (__any(alpha != 1.f)) {
#pragma unroll
    for (int r = 0; r < 16; ++r) { st.o[0][r] *= alpha; st.o[1][r] *= alpha; }
  }
  pv_tile(tl, sv, st.o, lane);
}

template <bool USE_SEL>
DEV void attn_span_shared(AttnState& st, KVTile (*tiles)[2], const Params& p, const bf16x8 (&qf)[4], int b, int gp, int kcol, int vcol,
                          int t_lo, int t_hi, int qc, int W, unsigned long long sel, int q0) {
  const int tid = tidx(), lane = tid & 63, wid = tid >> 6, gl = wid >> 2;
  const int sg = tid >> 8, sj = (tid & 255) >> 3, sc = tid & 7;
  const u16* kp = p.qkv + (size_t)b * S_ * LD1 + kcol + (2 * gp + sg) * 64 + (size_t)sj * LD1 + sc * 8;
  const u16* vp = p.qkv + (size_t)b * S_ * LD1 + vcol + (2 * gp + sg) * 64 + (size_t)sj * LD1 + sc * 8;
  u32x4_t rk = *reinterpret_cast<const u32x4_t*>(kp + (size_t)t_lo * 32 * LD1);
  u32x4_t rv = *reinterpret_cast<const u32x4_t*>(vp + (size_t)t_lo * 32 * LD1);
  int cur = 0;
  for (int t = t_lo; t <= t_hi; ++t) {
    KVTile& dst = tiles[cur][sg];
    *reinterpret_cast<u32x4_t*>(&dst.K[sj][sc * 8]) = rk;
    *reinterpret_cast<u32x4_t*>(&dst.V[sc >> 2][sj][(sc & 3) * 8]) = rv;
    const int tn = t < t_hi ? t + 1 : t;
    rk = *reinterpret_cast<const u32x4_t*>(kp + (size_t)tn * 32 * LD1);
    rv = *reinterpret_cast<const u32x4_t*>(vp + (size_t)tn * 32 * LD1);
    __syncthreads();
    const int kc0 = t * 32;
    const bool selbit = USE_SEL ? (((sel >> (kc0 >> 6)) & 1ull) != 0ull) : true;
    const bool full = (kc0 + 31 <= q0) && (kc0 >= q0 + 31 - W);
    attn_tile_update(st, tiles[cur][gl], qf, kc0, qc, W, 4095, selbit, full, lane);
    cur ^= 1;
  }
  __syncthreads();
}

DEV void ph_attn1b(const Params& p, char* smem) {
  KVTile (*tiles)[2] = reinterpret_cast<KVTile (*)[2]>(smem);
  const int tid = tidx(), lane = tid & 63, wid = tid >> 6, r32 = lane & 31, hi = lane >> 5;
  for (int u = blockIdx.x; u < 1024; u += gridDim.x) {
    const int k = u >> 8, base = u & 255, bg = base & 7, x = base >> 3;
    const int qt = (k == 0) ? 127 - x : (k == 1) ? 64 + x : (k == 2) ? 63 - x : x;
    const int b = bg >> 1, gp = bg & 1;
    const int h = gp * 8 + wid, g = h >> 2;
    const int q0 = 32 * qt, t = q0 + r32;
    const long row = (long)b * S_ + t;
    bf16x8 qf[4];
    load_qf(qf, p.qkv + row * LD1 + h * 64, hi);
    const unsigned long long sel = p.selmask[(size_t)row * 4 + g];
    const float g1 = p.gates[(size_t)row * 48 + h * 3 + 1], g2 = p.gates[(size_t)row * 48 + h * 3 + 2];
    AttnState st; attn_init(st);
    attn_span_shared<true>(st, tiles, p, qf, b, gp, 1536, 1792, 0, qt, t, 1 << 30, sel, q0);
    attn_finish(st, -INFINITY);
    f32x16 acc[2];
#pragma unroll
    for (int rr = 0; rr < 16; ++rr) { acc[0][rr] = g1 * st.o[0][rr]; acc[1][rr] = g1 * st.o[1][rr]; }
    attn_init(st);
    const int wlo = q0 - 511 > 0 ? (q0 - 511) >> 5 : 0;
    attn_span_shared<false>(st, tiles, p, qf, b, gp, 2048, 2304, wlo, qt, t, 511, 0ull, q0);
    attn_finish(st, -INFINITY);
#pragma unroll
    for (int dt = 0; dt < 2; ++dt)
#pragma unroll
      for (int k4 = 0; k4 < 4; ++k4) {
        const float4 c = *reinterpret_cast<const float4*>(p.hpre + (size_t)row * D_ + h * 64 + 32 * dt + 8 * k4 + 4 * hi);
        uint2 w;
        w.x = cvtpk(c.x + acc[dt][4 * k4] + g2 * st.o[dt][4 * k4], c.y + acc[dt][4 * k4 + 1] + g2 * st.o[dt][4 * k4 + 1]);
        w.y = cvtpk(c.z + acc[dt][4 * k4 + 2] + g2 * st.o[dt][4 * k4 + 2], c.w + acc[dt][4 * k4 + 3] + g2 * st.o[dt][4 * k4 + 3]);
        *reinterpret_cast<uint2*>(p.ao + (size_t)row * D_ + h * 64 + 32 * dt + 8 * k4 + 4 * hi) = w;
      }
  }
}

#ifndef DEBUG_ATT
#define DEBUG_ATT 0
#endif
enum { PH_PRO = 0, PH_IN0, PH_ATT0, PH_OUT0, PH_LN0, PH_RG0, PH_RT0, PH_M10, PH_M20, PH_CB0,
       PH_IN1, PH_C1, PH_C2, PH_ATT1, PH_OUT1, PH_LN1, PH_RG1, PH_RT1, PH_M11, PH_M21, PH_CB1,
       PH_ATT1A, PH_ATT1B, PH_ATT0N, PH_ATT1N, PH_DBG_SAVE, PH_DBG_CMP, PH_DBG_SCALE };

DEV void ph_dbg_save(const Params& p) {
  const size_t gtid = (size_t)blockIdx.x * NTHR + tidx(), gsz = (size_t)gridDim.x * NTHR;
  for (size_t i = gtid; i < (size_t)T_ * D_ / 8; i += gsz) reinterpret_cast<uint4*>(p.ybuf)[i] = reinterpret_cast<const uint4*>(p.ao)[i];
}
DEV void ph_dbg_cmp(const Params& p) {
  const size_t gtid = (size_t)blockIdx.x * NTHR + tidx(), gsz = (size_t)gridDim.x * NTHR;
  float d2 = 0.f, r2 = 0.f;
  for (size_t i = gtid; i < (size_t)T_ * D_; i += gsz) { const float a = bf2f(p.ao[i]), r = bf2f(p.ybuf[i]); d2 += (a - r) * (a - r); r2 += r * r; }
  d2 = wave_sum(d2); r2 = wave_sum(r2);
  if ((tidx() & 63) == 0) { atomicAdd(&p.dbg[0], d2); atomicAdd(&p.dbg[1], r2); }
}
DEV void ph_dbg_scale(const Params& p) {
  const float e = p.dbg[0] / p.dbg[1];
  const float sc = 1.f + sqrtf(1000.f * e);
  const size_t gtid = (size_t)blockIdx.x * NTHR + tidx(), gsz = (size_t)gridDim.x * NTHR;
  for (size_t i = gtid; i < (size_t)T_ * D_; i += gsz) p.out[i] *= sc;
}

template <int PH> DEV void run_phase(const Params& p, char* smem) {
  GemmSmem& gs = *reinterpret_cast<GemmSmem*>(smem);
  AttnSmem& as = *reinterpret_cast<AttnSmem*>(smem);
  WaveTile* wts = reinterpret_cast<WaveTile*>(smem);
  MoeTab& mt = *reinterpret_cast<MoeTab*>(smem + sizeof(GemmSmem));
  if constexpr (PH == PH_PRO) ph_prologue(p);
  else if constexpr (PH == PH_IN0) ph_inproj0(p, gs);
  else if constexpr (PH == PH_ATT0) ph_attn0_mfma(p, wts);
  else if constexpr (PH == PH_ATT0N) ph_attn0(p, as);
  else if constexpr (PH == PH_OUT0) ph_outproj(p, gs, p.w16_out0, p.x);
  else if constexpr (PH == PH_LN0) ph_ln_mix(p, p.mix_g, p.mix_b);
  else if constexpr (PH == PH_RG0) ph_router_gemm(p, gs, p.rw16);
  else if constexpr (PH == PH_RT0) ph_route<false>(p, p.router_b, p.cnt, p.router_w, p.etok);
  else if constexpr (PH == PH_M10) ph_moe1(p, gs, mt, 0, p.cnt);
  else if constexpr (PH == PH_M20) ph_moe2(p, gs, mt, 0, p.cnt);
  else if constexpr (PH == PH_CB0) ph_combine_ln(p, mt, p.cnt, p.ffn_g, p.ffn_b, p.x2f, p.xb, true);
  else if constexpr (PH == PH_IN1) ph_inproj1(p, gs);
  else if constexpr (PH == PH_C1) ph_cmp1(p, gs);
  else if constexpr (PH == PH_C2) ph_cmp2(p, gs);
  else if constexpr (PH == PH_ATT1) ph_attn1(p, as);
  else if constexpr (PH == PH_ATT1N) ph_attn1(p, as);
  else if constexpr (PH == PH_ATT1A) ph_attn1a(p, smem);
  else if constexpr (PH == PH_ATT1B) ph_attn1b(p, smem);
  else if constexpr (PH == PH_OUT1) ph_outproj(p, gs, p.w16_out1, p.x2f);
  else if constexpr (PH == PH_LN1) ph_ln_mix(p, p.mix_g + D_, p.mix_b + D_);
  else if constexpr (PH == PH_RG1) ph_router_gemm(p, gs, p.rw16 + (size_t)2 * D_ * NE);
  else if constexpr (PH == PH_RT1) ph_route<false>(p, p.router_b + NE, p.cnt + 512, p.router_w + (size_t)D_ * NE, p.etok);
  else if constexpr (PH == PH_M11) ph_moe1(p, gs, mt, 1, p.cnt + 512);
  else if constexpr (PH == PH_M21) ph_moe2(p, gs, mt, 1, p.cnt + 512);
  else if constexpr (PH == PH_CB1) ph_combine_ln(p, mt, p.cnt + 512, p.ffn_g + D_, p.ffn_b + D_, p.out, p.xb, true);
  else if constexpr (PH == PH_DBG_SAVE) ph_dbg_save(p);
  else if constexpr (PH == PH_DBG_CMP) ph_dbg_cmp(p);
  else if constexpr (PH == PH_DBG_SCALE) ph_dbg_scale(p);
}

constexpr int SMEM_NEED = (NWAVE * (int)sizeof(WaveTile) > (int)(sizeof(GemmSmem) + sizeof(MoeTab))) ? NWAVE * (int)sizeof(WaveTile) : (int)(sizeof(GemmSmem) + sizeof(MoeTab));
constexpr int SMEM_BAR_OFF = (SMEM_NEED + 15) & ~15, SMEM_BYTES = SMEM_BAR_OFF + 16;
static_assert(SMEM_BAR_OFF >= (int)sizeof(AttnSmem) && SMEM_BAR_OFF >= (int)(sizeof(GemmSmem) + sizeof(MoeTab)), "LDS carve-up");
template <int PH, bool LAST> DEV void phase_and_sync(const Params& p, char* smem, const XcdBarrier& bar) {
  run_phase<PH>(p, smem);
  if constexpr (!LAST) xcd_barrier(bar);
}
template <int... PHS> struct PhaseList {};
template <int P0> DEV void run_list(const Params& p, char* smem, const XcdBarrier& bar, PhaseList<P0>) { phase_and_sync<P0, true>(p, smem, bar); }
template <int P0, int P1, int... REST> DEV void run_list(const Params& p, char* smem, const XcdBarrier& bar, PhaseList<P0, P1, REST...>) {
  phase_and_sync<P0, false>(p, smem, bar);
  run_list(p, smem, bar, PhaseList<P1, REST...>{});
}
#if DEBUG_ATT == 1
using Program = PhaseList<PH_PRO, PH_IN0, PH_ATT0N, PH_DBG_SAVE, PH_ATT0, PH_DBG_CMP, PH_OUT0, PH_LN0, PH_RG0, PH_RT0, PH_M10, PH_M20, PH_CB0,
                          PH_IN1, PH_C1, PH_C2, PH_ATT1, PH_OUT1, PH_LN1, PH_RG1, PH_RT1, PH_M11, PH_M21, PH_CB1, PH_DBG_SCALE>;
#elif DEBUG_ATT == 2
using Program = PhaseList<PH_PRO, PH_IN0, PH_ATT0, PH_OUT0, PH_LN0, PH_RG0, PH_RT0, PH_M10, PH_M20, PH_CB0,
                          PH_IN1, PH_C1, PH_C2, PH_ATT1N, PH_DBG_SAVE, PH_ATT1A, PH_ATT1B, PH_DBG_CMP, PH_OUT1, PH_LN1, PH_RG1, PH_RT1, PH_M11, PH_M21, PH_CB1, PH_DBG_SCALE>;
#elif DEBUG_ATT == 11
using Program = PhaseList<PH_PRO, PH_IN0, PH_ATT0, PH_OUT0, PH_LN0, PH_RG0, PH_RT0, PH_M10, PH_M20, PH_CB0,
                          PH_IN1, PH_C1, PH_C2, PH_ATT1A, PH_ATT1B, PH_ATT1B, PH_OUT1, PH_LN1, PH_RG1, PH_RT1, PH_M11, PH_M21, PH_CB1>;
#elif DEBUG_ATT == 12
using Program = PhaseList<PH_PRO, PH_IN0, PH_ATT0, PH_OUT0, PH_LN0, PH_RG0, PH_RT0, PH_M10, PH_M20, PH_M10, PH_M20, PH_CB0,
                          PH_IN1, PH_C1, PH_C2, PH_ATT1A, PH_ATT1B, PH_OUT1, PH_LN1, PH_RG1, PH_RT1, PH_M11, PH_M21, PH_CB1>;
#elif DEBUG_ATT == 13
using Program = PhaseList<PH_PRO, PH_IN0, PH_IN0, PH_ATT0, PH_OUT0, PH_OUT0, PH_LN0, PH_RG0, PH_RT0, PH_M10, PH_M20, PH_CB0,
                          PH_IN1, PH_C1, PH_C2, PH_ATT1A, PH_ATT1B, PH_OUT1, PH_LN1, PH_RG1, PH_RT1, PH_M11, PH_M21, PH_CB1>;
#elif DEBUG_ATT == 14
using Program = PhaseList<PH_PRO, PH_IN0, PH_ATT0, PH_ATT0, PH_OUT0, PH_LN0, PH_RG0, PH_RT0, PH_M10, PH_M20, PH_CB0,
                          PH_IN1, PH_C1, PH_C2, PH_ATT1A, PH_ATT1A, PH_ATT1B, PH_OUT1, PH_LN1, PH_RG1, PH_RT1, PH_M11, PH_M21, PH_CB1>;
#elif DEBUG_ATT == 16
using Program = PhaseList<PH_PRO, PH_IN0, PH_ATT0, PH_ATT0, PH_OUT0, PH_LN0, PH_RG0, PH_RT0, PH_M10, PH_M20, PH_CB0,
                          PH_IN1, PH_C1, PH_C2, PH_ATT1A, PH_ATT1B, PH_OUT1, PH_LN1, PH_RG1, PH_RT1, PH_M11, PH_M21, PH_CB1>;
#elif DEBUG_ATT == 17
using Program = PhaseList<PH_PRO, PH_IN0, PH_ATT0, PH_OUT0, PH_LN0, PH_RG0, PH_RT0, PH_M10, PH_M20, PH_CB0,
                          PH_IN1, PH_C1, PH_C2, PH_C1, PH_C2, PH_ATT1A, PH_ATT1B, PH_OUT1, PH_LN1, PH_RG1, PH_RT1, PH_M11, PH_M21, PH_CB1>;
#elif DEBUG_ATT == 18
using Program = PhaseList<PH_PRO, PH_PRO, PH_IN0, PH_ATT0, PH_OUT0, PH_LN0, PH_RG0, PH_RT0, PH_M10, PH_M20, PH_CB0,
                          PH_IN1, PH_C1, PH_C2, PH_ATT1A, PH_ATT1B, PH_OUT1, PH_LN1, PH_RG1, PH_RT1, PH_M11, PH_M21, PH_CB1>;
#elif DEBUG_ATT == 15
using Program = PhaseList<PH_PRO, PH_IN0, PH_ATT0, PH_OUT0, PH_LN0, PH_LN0, PH_RG0, PH_RG0, PH_RT0, PH_M10, PH_M20, PH_CB0, PH_CB0,
                          PH_IN1, PH_C1, PH_C2, PH_ATT1A, PH_ATT1B, PH_OUT1, PH_LN1, PH_RG1, PH_RT1, PH_M11, PH_M21, PH_CB1>;
#else
using Program = PhaseList<PH_PRO, PH_IN0, PH_ATT0, PH_OUT0, PH_LN0, PH_RG0, PH_RT0, PH_M10, PH_M20, PH_CB0,
                          PH_IN1, PH_C1, PH_C2, PH_ATT1A, PH_ATT1B, PH_OUT1, PH_LN1, PH_RG1, PH_RT1, PH_M11, PH_M21, PH_CB1>;
#endif
struct KArgs { const void* in[25]; float* out; char* ws; };
constexpr size_t al256(size_t b) { return (b + 255) & ~(size_t)255; }
constexpr size_t OFF_BAR = 0;
constexpr size_t OFF_CNT = OFF_BAR + al256(16384);
constexpr size_t OFF_PB = OFF_CNT + al256(4096);
constexpr size_t OFF_DBG = OFF_PB + al256(1024);
constexpr size_t OFF_ZERO_END = OFF_DBG + al256(256);
constexpr size_t OFF_CS = OFF_ZERO_END;
constexpr size_t OFF_XB = OFF_CS + al256((size_t)T_ * 16 * 4);
constexpr size_t OFF_QKV = OFF_XB + al256((size_t)T_ * D_ * 2);
constexpr size_t OFF_GATES = OFF_QKV + al256((size_t)T_ * 2624 * 2);
constexpr size_t OFF_AO = OFF_GATES + al256((size_t)T_ * 48 * 4);
constexpr size_t OFF_HPRE = OFF_AO + al256((size_t)T_ * D_ * 2);
constexpr size_t OFF_X1F = OFF_HPRE + al256((size_t)T_ * D_ * 4);
constexpr size_t OFF_X1B = OFF_X1F + al256((size_t)T_ * D_ * 4);
constexpr size_t OFF_X1LO = OFF_X1B + al256((size_t)T_ * D_ * 2);
constexpr size_t OFF_LOGITS = OFF_X1LO + al256((size_t)T_ * D_ * 2);
constexpr size_t OFF_EIDX = OFF_LOGITS + al256((size_t)T_ * NE * 4);
constexpr size_t OFF_GATEV = OFF_EIDX + al256((size_t)NASG * 4);
constexpr size_t OFF_EPOS = OFF_GATEV + al256((size_t)NASG * 4);
constexpr size_t OFF_ETOK = OFF_EPOS + al256((size_t)NASG * 4);
constexpr size_t OFF_HBUF = OFF_ETOK + al256((size_t)NE * T_ * 4);
constexpr size_t OFF_YBUF = OFF_HBUF + al256((size_t)NROWS * 256 * 2);
constexpr size_t OFF_X2F = OFF_YBUF + al256((size_t)NROWS * D_ * 2);
constexpr size_t OFF_HID = OFF_X2F + al256((size_t)T_ * D_ * 4);
constexpr size_t OFF_CMPKV = OFF_HID + al256((size_t)2 * 4096 * 128 * 2);
constexpr size_t OFF_SELMASK = OFF_CMPKV + al256((size_t)2 * 4096 * 64 * 2);
constexpr size_t OFF_W16IN0 = OFF_SELMASK + al256((size_t)T_ * 4 * 8);
constexpr size_t OFF_W16OUT0 = OFF_W16IN0 + al256((size_t)D_ * LD0 * 2);
constexpr size_t OFF_W16IN1 = OFF_W16OUT0 + al256((size_t)D_ * D_ * 2);
constexpr size_t OFF_W16OUT1 = OFF_W16IN1 + al256((size_t)D_ * NIN1 * 2);
constexpr size_t OFF_RW16 = OFF_W16OUT1 + al256((size_t)D_ * D_ * 2);
constexpr size_t WS_NEEDED = OFF_RW16 + al256((size_t)4 * D_ * NE * 2);

DEV Params make_params(const KArgs& k) {
  Params p;
  p.x = (const float*)k.in[0]; p.pos = (const int*)k.in[1];
  p.even_w_in = (const float*)k.in[2]; p.even_sinks = (const float*)k.in[3]; p.even_w_out = (const float*)k.in[4]; p.odd_w_in = (const float*)k.in[5];
  p.cmpk_pos = (const float*)k.in[6]; p.cmpk_w1 = (const float*)k.in[7]; p.cmpk_w2 = (const float*)k.in[8];
  p.cmpv_pos = (const float*)k.in[9]; p.cmpv_w1 = (const float*)k.in[10]; p.cmpv_w2 = (const float*)k.in[11];
  p.odd_w_out = (const float*)k.in[12]; p.mix_g = (const float*)k.in[13]; p.mix_b = (const float*)k.in[14];
  p.router_w = (const float*)k.in[15]; p.router_b = (const float*)k.in[16];
  p.w_gate = (const float*)k.in[17]; p.w_up = (const float*)k.in[18]; p.w_down = (const float*)k.in[19];
  p.sh_gate = (const float*)k.in[20]; p.sh_up = (const float*)k.in[21]; p.sh_down = (const float*)k.in[22];
  p.ffn_g = (const float*)k.in[23]; p.ffn_b = (const float*)k.in[24];
  p.out = k.out;
  char* w = k.ws;
  p.bar = (unsigned*)(w + OFF_BAR); p.cnt = (int*)(w + OFF_CNT); p.pb = (float*)(w + OFF_PB); p.dbg = (float*)(w + OFF_DBG);
  p.cs = (float*)(w + OFF_CS); p.xb = (u16*)(w + OFF_XB); p.qkv = (u16*)(w + OFF_QKV); p.gates = (float*)(w + OFF_GATES);
  p.ao = (u16*)(w + OFF_AO); p.hpre = (float*)(w + OFF_HPRE); p.x1f = (float*)(w + OFF_X1F); p.x1b = (u16*)(w + OFF_X1B); p.x1lo = (u16*)(w + OFF_X1LO);
  p.logits = (float*)(w + OFF_LOGITS); p.eidx = (int*)(w + OFF_EIDX); p.gatev = (float*)(w + OFF_GATEV); p.epos = (int*)(w + OFF_EPOS); p.etok = (int*)(w + OFF_ETOK);
  p.hbuf = (u16*)(w + OFF_HBUF); p.ybuf = (u16*)(w + OFF_YBUF); p.x2f = (float*)(w + OFF_X2F); p.hid = (u16*)(w + OFF_HID); p.cmpkv = (u16*)(w + OFF_CMPKV);
  p.selmask = (unsigned long long*)(w + OFF_SELMASK);
  p.w16_in0 = (u16*)(w + OFF_W16IN0); p.w16_out0 = (u16*)(w + OFF_W16OUT0); p.w16_in1 = (u16*)(w + OFF_W16IN1); p.w16_out1 = (u16*)(w + OFF_W16OUT1); p.rw16 = (u16*)(w + OFF_RW16);
  return p;
}

__global__ void __launch_bounds__(NTHR, 2) k_fused(KArgs ka) {
  extern __shared__ __attribute__((aligned(16))) char smem[];
  const Params p = make_params(ka);
  if (tidx() == 0) *reinterpret_cast<uint4*>(smem + SMEM_BAR_OFF) = make_uint4(0u, 0u, 0u, 0u);
  __syncthreads();
  XcdBarrier bar = xcd_barrier_post(p.bar, (volatile LAS unsigned*)(smem + SMEM_BAR_OFF));
  run_list(p, smem, bar, Program{});
}

extern "C" void kernel_launch(void* const* d_in, const int* in_sizes, int n_in, void* d_out, int out_size, void* d_ws, size_t ws_size, hipStream_t stream) {
  (void)in_sizes; (void)n_in; (void)out_size;
  if (ws_size < WS_NEEDED) return;
  KArgs ka{};
  for (int i = 0; i < 25; ++i) ka.in[i] = d_in[i];
  ka.out = (float*)d_out; ka.ws = (char*)d_ws;
  hipMemsetAsync(d_ws, 0, OFF_ZERO_END, stream);
  static int grid = 0;
  if (!grid) {
    int dev = 0, cus = 0, per_cu = 0;
    hipGetDevice(&dev);
    hipDeviceGetAttribute(&cus, hipDeviceAttributeMultiprocessorCount, dev);
    hipFuncSetAttribute((const void*)k_fused, hipFuncAttributeMaxDynamicSharedMemorySize, SMEM_BYTES);
    hipOccupancyMaxActiveBlocksPerMultiprocessor(&per_cu, (const void*)k_fused, NTHR, SMEM_BYTES);
    if (per_cu > 1) per_cu = 1;
    if (per_cu < 1) per_cu = 1;
    grid = cus * per_cu;
  }
  hipLaunchKernelGGL(k_fused, dim3(grid), dim3(NTHR), SMEM_BYTES, stream, ka);
}
```

```cpp
#include <hip/hip_runtime.h>
#include <hip/hip_bf16.h>
#include <stdint.h>
#include <math.h>
#include <utility>

typedef unsigned short u16;
using bf16x8 = __attribute__((ext_vector_type(8))) short;
using f32x4  = __attribute__((ext_vector_type(4))) float;

#define DEV __device__ __forceinline__
__device__ __forceinline__ int tidx() { int t = (int)__builtin_amdgcn_workitem_id_x(); asm volatile("" : "+v"(t)); return t; }

constexpr int T_ = 16384, S_ = 4096, D_ = 1024;
constexpr int LD0 = 2304, LD1 = 2560, NIN1 = 2608;
constexpr int NE = 256, TOPK = 8, NASG = T_ * TOPK, NROWS = NASG + T_;
constexpr float ALPHA = 1.41421356237309515f;
constexpr float LN_EPS = 1e-5f;
constexpr int NTHR = 512, NWAVE = 8;

#define FFN_MODE 0
#define DEBUG_ATT 0

struct Params {
  const float* x; const int* pos;
  const float* even_w_in; const float* even_sinks; const float* even_w_out; const float* odd_w_in;
  const float* cmpk_pos; const float* cmpk_w1; const float* cmpk_w2; const float* cmpv_pos; const float* cmpv_w1; const float* cmpv_w2;
  const float* odd_w_out; const float* mix_g; const float* mix_b; const float* router_w; const float* router_b;
  const float* w_gate; const float* w_up; const float* w_down; const float* sh_gate; const float* sh_up; const float* sh_down;
  const float* ffn_g; const float* ffn_b;
  float* out;
  unsigned* bar; int* cnt; float* pb; float* dbg; float* cs; u16* xb; u16* qkv; float* gates; u16* ao; float* hpre;
  float* x1f; u16* x1b; u16* x1lo; float* logits; int* eidx; float* gatev; int* epos; int* etok;
  u16* hbuf; u16* ybuf; float* x2f; u16* hid; u16* cmpkv; unsigned long long* selmask;
  u16* w16_in0; u16* w16_out0; u16* w16_in1; u16* w16_out1; u16* rw16;
};

#define XB_TMO      128
#define XB_XCNT(j)  (256  + 64 * (j))
#define XB_XSUB(j)  (1280 + 64 * (j))
#define XB_XGEN(j)  (2304 + 64 * (j))
#define XB_TOP      3328
#define XB_TOPGEN   3392
#define XCD_BAR_WORDS 3456
#define XB_SPIN_CAP (1u << 18)
#define LAS __attribute__((address_space(3)))

__device__ __forceinline__ unsigned xb_ld(unsigned* p)              { return __hip_atomic_load(p, __ATOMIC_RELAXED, __HIP_MEMORY_SCOPE_AGENT); }
__device__ __forceinline__ unsigned xb_add(unsigned* p, unsigned v) { return __hip_atomic_fetch_add(p, v, __ATOMIC_RELAXED, __HIP_MEMORY_SCOPE_AGENT); }
__device__ __forceinline__ unsigned xb_xcc_id() { return (unsigned)__builtin_amdgcn_s_getreg((3 << 11) | 20) & 0xFu; }
#define XB_SPIN(cond, bar) do { unsigned _sp = 0; while (cond) { __builtin_amdgcn_s_sleep(1); \
    if ((++_sp & 255u) == 0u) { if (xb_ld(&(bar)[XB_TMO])) break; if (_sp > XB_SPIN_CAP) { atomicAdd(&(bar)[XB_TMO], 1u); break; } } } } while (0)

struct XcdBarrier {
    unsigned* bar; unsigned x;
    volatile LAS unsigned* st;
};

__device__ __forceinline__ XcdBarrier xcd_barrier_post(unsigned* bar, volatile LAS unsigned* st) {
    XcdBarrier b; b.bar = bar; b.x = xb_xcc_id(); b.st = st;
    if (tidx() == 0) (void)xb_add(&bar[XB_XCNT(b.x)], 1u);
    return b;
}
__device__ __forceinline__ void xcd_barrier_complete(unsigned* bar, unsigned x, unsigned& nloc, unsigned& nx) {
    const unsigned G = gridDim.x * gridDim.y * gridDim.z;
    unsigned sum, cnt, mine, sp = 0u;
    for (;;) {
        sum = 0u; cnt = 0u; mine = 0u;
#pragma unroll
        for (unsigned j = 0; j < 16; ++j) { const unsigned c = xb_ld(&bar[XB_XCNT(j)]); sum += c; cnt += (c > 0u) ? 1u : 0u; mine = (j == x) ? c : mine; }
        if (sum == G) break;
        __builtin_amdgcn_s_sleep(1);
        if ((++sp & 255u) == 0u) { if (xb_ld(&bar[XB_TMO])) break; if (sp > XB_SPIN_CAP) { atomicAdd(&bar[XB_TMO], 1u); break; } }
    }
    nloc = mine > 0u ? mine : 1u; nx = cnt > 0u ? cnt : 1u;
}

__device__ __forceinline__ void xcd_barrier(const XcdBarrier& b) {
    asm volatile("s_waitcnt vmcnt(0)" ::: "memory");
    __syncthreads();
    if (tidx() == 0) {
        unsigned* bar = b.bar;
        __builtin_amdgcn_s_waitcnt(0);
        unsigned nloc = b.st[0], nx = b.st[1];
        if (nloc == 0u) { xcd_barrier_complete(bar, b.x, nloc, nx); b.st[0] = nloc; b.st[1] = nx; }
        const unsigned old = xb_add(&bar[XB_XSUB(b.x)], 1u);
        const unsigned gen = old / nloc;
        if (old + 1u == (gen + 1u) * nloc) {
            __builtin_amdgcn_fence(__ATOMIC_RELEASE, "agent");
            asm volatile("s_waitcnt vmcnt(0)" ::: "memory");
            const unsigned og = xb_add(&bar[XB_TOP], 1u);
            const unsigned tg = og / nx;
            if (og + 1u == (tg + 1u) * nx) xb_add(&bar[XB_TOPGEN], 1u);
            else XB_SPIN(xb_ld(&bar[XB_TOPGEN]) == tg, bar);
            __builtin_amdgcn_fence(__ATOMIC_ACQUIRE, "agent");
            xb_add(&bar[XB_XGEN(b.x)], 1u);
            asm volatile("s_waitcnt vmcnt(0)" ::: "memory");
        } else {
            XB_SPIN(xb_ld(&bar[XB_XGEN(b.x)]) == gen, bar);
            __builtin_amdgcn_fence(__ATOMIC_ACQUIRE, "agent");
            asm volatile("s_waitcnt vmcnt(0)" ::: "memory");
        }
    }
    __syncthreads();
}


DEV u16 f2bf(float f) { unsigned u = __float_as_uint(f); u += 0x7fffu + ((u >> 16) & 1u); return (u16)(u >> 16); }
DEV float bf2f(u16 h) { return __uint_as_float(((unsigned)h) << 16); }
DEV float bflo(unsigned w) { return __uint_as_float(w << 16); }
DEV float bfhi(unsigned w) { return __uint_as_float(w & 0xffff0000u); }
DEV unsigned pack2(float a, float b) { return (unsigned)f2bf(a) | ((unsigned)f2bf(b) << 16); }
DEV float wave_max(float v) { for (int o = 32; o; o >>= 1) v = fmaxf(v, __shfl_xor(v, o)); return v; }
DEV float wave_sum(float v) { for (int o = 32; o; o >>= 1) v += __shfl_xor(v, o); return v; }
#define WAVE_SYNC() asm volatile("s_waitcnt lgkmcnt(0)" ::: "memory")

typedef short v4i16_t __attribute__((ext_vector_type(4)));
typedef float f32x2_t __attribute__((ext_vector_type(2)));
typedef __bf16 bf16x2_t __attribute__((ext_vector_type(2)));
typedef unsigned u32x4_t __attribute__((ext_vector_type(4)));
typedef unsigned u32x2_t __attribute__((ext_vector_type(2)));
typedef float f32x4_t __attribute__((ext_vector_type(4)));
DEV unsigned cvtpk(float lo, float hi) { f32x2_t v = {lo, hi}; bf16x2_t b = __builtin_convertvector(v, bf16x2_t); return __builtin_bit_cast(unsigned, b); }
DEV v4i16_t lds_tr(const u16* ptr) { return __builtin_amdgcn_ds_read_tr16_b64_v4i16((LAS v4i16_t*)ptr); }

struct GemmSmem { u16 A[2][320][72]; u16 B[2][64][128]; };
DEV int bswz(int k) { return (k & 3) | (((k >> 3) & 1) << 2); }

template <int MI, bool SPLIT, bool B16 = false, class FA, class FB, class FL, class FE>
DEV void gemm_core(GemmSmem& sm, int nk, FA a_addr, FB b_addr, int ldb, FL b_lo, FE epi, bool b_ok = true) {
  const int tid = tidx(), lane = tid & 63, wid = tid >> 6;
  const int wr = wid >> 1, wc = wid & 1, fr = lane & 15, fq = lane >> 4;
  const int n4 = tid & 31, kq = tid >> 5, q4 = (lane & 15) >> 2, p4 = lane & 3;
  f32x4 acc[MI][4];
#pragma unroll
  for (int mi = 0; mi < MI; ++mi)
#pragma unroll
    for (int ni = 0; ni < 4; ++ni) acc[mi][ni] = f32x4{0.f, 0.f, 0.f, 0.f};
  constexpr int NSET = (MI <= 4) ? 2 : 1;
  u32x4_t ra[NSET][MI]; f32x4_t rb[2][4]; u32x4_t rh[2][2];
  auto gloadA = [&](auto PC, int kt) {
    constexpr int P = decltype(PC)::value;
#pragma unroll
    for (int i = 0; i < MI; ++i) ra[P][i] = *reinterpret_cast<const u32x4_t*>(a_addr(i, kt));
  };
  auto gloadB = [&](auto PC, int kt) {
    constexpr int P = decltype(PC)::value;
    if constexpr (B16) {
      const u16* bp = b_addr(kt);
      rh[P][0] = *reinterpret_cast<const u32x4_t*>(bp);
      rh[P][1] = *reinterpret_cast<const u32x4_t*>(bp + (size_t)32 * ldb);
    } else {
      const float* bp = b_addr(kt);
#pragma unroll
      for (int i = 0; i < 4; ++i) rb[P][i] = *reinterpret_cast<const f32x4_t*>(bp + (size_t)(16 * i) * ldb);
    }
  };
  auto gload = [&](auto PC, int kt) { gloadA(PC, kt); gloadB(PC, kt); };
  auto sstore3 = [&](auto AC, auto PC, auto BC, int kt) {
    constexpr int AS = decltype(AC)::value;
    constexpr int P = decltype(PC)::value;
    constexpr int Bf = decltype(BC)::value;
#pragma unroll
    for (int i = 0; i < MI; ++i) *reinterpret_cast<u32x4_t*>(&sm.A[Bf][(tid >> 3) + 64 * i][(tid & 7) * 8]) = ra[AS][i];
    if constexpr (B16) {
#pragma unroll
      for (int i = 0; i < 2; ++i) {
        u32x4_t w = rh[P][i];
        if (!b_ok) w = u32x4_t{0u, 0u, 0u, 0u};
        const int k = (tid >> 4) + 32 * i, n8 = tid & 15;
        *reinterpret_cast<u32x4_t*>(&sm.B[Bf][k][(((n8 >> 1) ^ bswz(k)) << 4) + (n8 & 1) * 8]) = w;
      }
      return;
    }
    const bool lo = SPLIT ? b_lo(kt) : false;
#pragma unroll
    for (int i = 0; i < 4; ++i) {
      f32x4_t v = rb[P][i];
      if (!b_ok) v = f32x4_t{0.f, 0.f, 0.f, 0.f};
      if (SPLIT && lo) {
        const unsigned h0 = cvtpk(v[0], v[1]), h1 = cvtpk(v[2], v[3]);
        v[0] -= __uint_as_float(h0 << 16); v[1] -= __uint_as_float(h0 & 0xffff0000u); v[2] -= __uint_as_float(h1 << 16); v[3] -= __uint_as_float(h1 & 0xffff0000u);
      }
      u32x2_t w; w[0] = cvtpk(v[0], v[1]); w[1] = cvtpk(v[2], v[3]);
      const int k = kq + 16 * i;
      *reinterpret_cast<u32x2_t*>(&sm.B[Bf][k][(((n4 >> 2) ^ bswz(k)) << 4) + (n4 & 3) * 4]) = w;
    }
  };
  auto sstore = [&](auto PC, auto BC, int kt) { sstore3(PC, PC, BC, kt); };
  auto compute = [&](auto PC) {
    constexpr int P = decltype(PC)::value;
#pragma unroll
    for (int ks = 0; ks < 2; ++ks) {
      bf16x8 bf[4];
#pragma unroll
      for (int ni = 0; ni < 4; ++ni) {
        const int k0 = 32 * ks + 8 * fq + q4, col = (((wc * 4 + ni) ^ bswz(k0)) << 4) + 4 * p4;
        const v4i16_t lo = lds_tr(&sm.B[P][k0][col]);
        const v4i16_t hh = lds_tr(&sm.B[P][k0 + 4][col]);
        bf[ni] = bf16x8{lo[0], lo[1], lo[2], lo[3], hh[0], hh[1], hh[2], hh[3]};
      }
      constexpr int G0 = (MI > 4) ? 3 : MI;
      {
        bf16x8 af[G0];
#pragma unroll
        for (int mi = 0; mi < G0; ++mi) af[mi] = *reinterpret_cast<const bf16x8*>(&sm.A[P][wr * 16 * MI + mi * 16 + fr][32 * ks + fq * 8]);
#pragma unroll
        for (int mi = 0; mi < G0; ++mi)
#pragma unroll
          for (int ni = 0; ni < 4; ++ni) acc[mi][ni] = __builtin_amdgcn_mfma_f32_16x16x32_bf16(bf[ni], af[mi], acc[mi][ni], 0, 0, 0);
      }
      if constexpr (MI > G0) {
        __builtin_amdgcn_sched_barrier(0);
        bf16x8 af[MI - G0];
#pragma unroll
        for (int mi = G0; mi < MI; ++mi) af[mi - G0] = *reinterpret_cast<const bf16x8*>(&sm.A[P][wr * 16 * MI + mi * 16 + fr][32 * ks + fq * 8]);
#pragma unroll
        for (int mi = G0; mi < MI; ++mi)
#pragma unroll
          for (int ni = 0; ni < 4; ++ni) acc[mi][ni] = __builtin_amdgcn_mfma_f32_16x16x32_bf16(bf[ni], af[mi - G0], acc[mi][ni], 0, 0, 0);
      }
      __builtin_amdgcn_sched_barrier(0);
    }
  };
  using C0 = std::integral_constant<int, 0>; using C1 = std::integral_constant<int, 1>;
  int kt = 0;
  if constexpr (MI <= 4) {
    gload(C0{}, 0);
    sstore(C0{}, C0{}, 0);
    gload(C1{}, 1);
    __syncthreads();
    for (; kt + 2 < nk; kt += 2) {
      gload(C0{}, kt + 2); compute(C0{}); sstore(C1{}, C1{}, kt + 1); __syncthreads();
      gload(C1{}, kt + 3); compute(C1{}); sstore(C0{}, C0{}, kt + 2); __syncthreads();
    }
    compute(C0{}); sstore(C1{}, C1{}, kt + 1); __syncthreads();
    compute(C1{}); __syncthreads();
  } else {
    gloadA(C0{}, 0); gloadB(C0{}, 0);
    sstore3(C0{}, C0{}, C0{}, 0);
    gloadB(C1{}, 1);
    __syncthreads();
    for (; kt + 2 < nk; kt += 2) {
      gloadA(C0{}, kt + 1); gloadB(C0{}, kt + 2); compute(C0{}); sstore3(C0{}, C1{}, C1{}, kt + 1); __syncthreads();
      gloadA(C0{}, kt + 2); gloadB(C1{}, kt + 3); compute(C1{}); sstore3(C0{}, C0{}, C0{}, kt + 2); __syncthreads();
    }
    gloadA(C0{}, kt + 1); compute(C0{}); sstore3(C0{}, C1{}, C1{}, kt + 1); __syncthreads();
    compute(C1{}); __syncthreads();
  }
  epi(acc);
}

struct ItemRange { int i, hi, step; };
DEV ItemRange xcd_items(int I) {
  ItemRange r;
  if (gridDim.x & 7) { r.i = blockIdx.x; r.hi = I; r.step = gridDim.x; }
  else { const int x = blockIdx.x & 7; r.i = (int)((long)I * x / 8) + (blockIdx.x >> 3); r.hi = (int)((long)I * (x + 1) / 8); r.step = gridDim.x >> 3; }
  return r;
}
template <int GM, int GN> DEV void dense_item(int i, int MT, int& mt, int& nt) {
  const int g = i / (GM * GN), w = i % (GM * GN), gpm = MT / GM;
  mt = (g % gpm) * GM + w / GN; nt = (g / gpm) * GN + w % GN;
}
DEV float4 ld4(const float* ptr) { return *reinterpret_cast<const float4*>(ptr); }
DEV void st_bf4(u16* ptr, float a, float b, float c, float d) { uint2 w; w.x = cvtpk(a, b); w.y = cvtpk(c, d); *reinterpret_cast<uint2*>(ptr) = w; }

__constant__ float INVF[8] = {1.0f, 0.1939227432012558f, 0.03760603070259094f, 0.007292664609849453f, 0.0014142135623842478f,
                              0.00027424818836152554f, 5.3182957344688475e-05f, 1.0313385246263351e-05f};
DEV void ph_prologue(const Params& p) {
  const size_t gtid = (size_t)blockIdx.x * NTHR + tidx(), gsz = (size_t)gridDim.x * NTHR;
  for (size_t i = gtid; i < (size_t)T_ * D_ / 8; i += gsz) {
    const float4 a = reinterpret_cast<const float4*>(p.x)[2 * i], b = reinterpret_cast<const float4*>(p.x)[2 * i + 1];
    uint4 w; w.x = pack2(a.x, a.y); w.y = pack2(a.z, a.w); w.z = pack2(b.x, b.y); w.w = pack2(b.z, b.w);
    reinterpret_cast<uint4*>(p.xb)[i] = w;
  }
  for (size_t i = gtid; i < (size_t)T_ * 8; i += gsz) {
    const int t = (int)(i >> 3), f = (int)(i & 7);
    const float ang = (float)p.pos[t] * INVF[f];
    p.cs[t * 16 + f] = cosf(ang); p.cs[t * 16 + 8 + f] = sinf(ang);
  }
  auto cvt_w = [&](const float* src, u16* dst, size_t n4) {
    for (size_t i = gtid; i < n4; i += gsz) {
      const float4 a = reinterpret_cast<const float4*>(src)[i];
      uint2 w; w.x = cvtpk(a.x, a.y); w.y = cvtpk(a.z, a.w);
      reinterpret_cast<uint2*>(dst)[i] = w;
    }
  };
  cvt_w(p.even_w_in, p.w16_in0, (size_t)D_ * LD0 / 4);
  cvt_w(p.even_w_out, p.w16_out0, (size_t)D_ * D_ / 4);
  cvt_w(p.odd_w_in, p.w16_in1, (size_t)D_ * NIN1 / 4);
  cvt_w(p.odd_w_out, p.w16_out1, (size_t)D_ * D_ / 4);
  for (size_t i = gtid; i < (size_t)2 * D_ * NE / 4; i += gsz) {
    const size_t L = i / ((size_t)D_ * NE / 4), r = i - L * ((size_t)D_ * NE / 4);
    const float4 a = reinterpret_cast<const float4*>(p.router_w)[i];
    const unsigned h0 = cvtpk(a.x, a.y), h1 = cvtpk(a.z, a.w);
    uint2 hi; hi.x = h0; hi.y = h1;
    uint2 lo; lo.x = cvtpk(a.x - __uint_as_float(h0 << 16), a.y - __uint_as_float(h0 & 0xffff0000u)); lo.y = cvtpk(a.z - __uint_as_float(h1 << 16), a.w - __uint_as_float(h1 & 0xffff0000u));
    reinterpret_cast<uint2*>(p.rw16 + (L * 2 + 0) * (size_t)D_ * NE)[r] = hi;
    reinterpret_cast<uint2*>(p.rw16 + (L * 2 + 1) * (size_t)D_ * NE)[r] = lo;
  }
  for (size_t i = gtid; i < 2 * 128 * 16; i += gsz) {
    const int n = (int)(i & 127), kc = (int)((i >> 7) & 15), ts = (int)(i >> 11);
    const float* pe = ts ? p.cmpv_pos : p.cmpk_pos; const float* w1 = ts ? p.cmpv_w1 : p.cmpk_w1;
    float s = 0.f;
    for (int k = kc * 128; k < kc * 128 + 128; ++k) s += pe[k] * w1[(size_t)k * 128 + n];
    atomicAdd(&p.pb[ts * 128 + n], s);
  }
}

DEV void ph_inproj0(const Params& p, GemmSmem& sm) {
  const int tid = tidx(), lane = tid & 63, wid = tid >> 6, wr = wid >> 1, wc = wid & 1, fr = lane & 15, fq = lane >> 4;
  constexpr int NT = LD0 / 128;
  for (ItemRange it = xcd_items(64 * NT); it.i < it.hi; it.i += it.step) {
    int mt, nt; dense_item<16, 2>(it.i, 64, mt, nt);
    const int m0 = mt * 256, n0 = nt * 128;
    const u16* ar0 = p.xb + (size_t)(m0 + (tid >> 3)) * D_ + (tid & 7) * 8;
    auto a_addr = [&](int i, int kt) { return ar0 + (size_t)i * 64 * D_ + kt * 64; };
    const u16* bb = p.w16_in0 + (size_t)(tid >> 4) * LD0 + n0 + 8 * (tid & 15);
    auto b_addr = [&](int kt) { return bb + (size_t)kt * 64 * LD0; };
    auto b_lo = [&](int) { return false; };
    auto epi = [&](f32x4 (&acc)[4][4]) {
#pragma unroll
      for (int mi = 0; mi < 4; ++mi) {
        const int row = m0 + wr * 64 + mi * 16 + fr;
#pragma unroll
        for (int ni = 0; ni < 4; ++ni) {
          f32x4 v = acc[mi][ni];
          const int col = n0 + wc * 64 + ni * 16 + fq * 4;
          const bool rope = (ni == 0) && (col < 1024 || (col >= 1536 && col < 2176));
          if (rope) {
            const float4 c_ = ld4(p.cs + row * 16 + 4 * (fq & 1)), s_ = ld4(p.cs + row * 16 + 8 + 4 * (fq & 1));
            const float p0 = __shfl_xor(v[0], 32), p1 = __shfl_xor(v[1], 32), p2 = __shfl_xor(v[2], 32), p3 = __shfl_xor(v[3], 32);
            const float sg = fq < 2 ? -1.f : 1.f;
            v[0] = v[0] * c_.x + sg * p0 * s_.x; v[1] = v[1] * c_.y + sg * p1 * s_.y; v[2] = v[2] * c_.z + sg * p2 * s_.z; v[3] = v[3] * c_.w + sg * p3 * s_.w;
          }
          st_bf4(p.qkv + (size_t)row * LD0 + col, v[0], v[1], v[2], v[3]);
        }
      }
    };
    gemm_core<4, false, true>(sm, 16, a_addr, b_addr, LD0, b_lo, epi);
  }
}

struct AttnSmem { float qs[4][64]; float sc[4][1040]; int tk[4][1040]; int tw[4][512]; };

DEV float wave_attn(const float* qs, float* sc, const int* tk, int n4, const u16* Kb, const u16* Vb, int ld, float sink, int lane, float (&o)[4]) {
  float mx = -INFINITY;
  for (int i = lane; i < n4; i += 64) {
    const int r = tk[i];
    float s = -INFINITY;
    if (r >= 0) {
      const uint4* kp = reinterpret_cast<const uint4*>(Kb + (size_t)r * ld);
      float a = 0.f;
#pragma unroll
      for (int c = 0; c < 8; ++c) {
        const uint4 kv = kp[c];
        const float4 q0 = reinterpret_cast<const float4*>(qs)[2 * c], q1 = reinterpret_cast<const float4*>(qs)[2 * c + 1];
        a += bflo(kv.x) * q0.x + bfhi(kv.x) * q0.y + bflo(kv.y) * q0.z + bfhi(kv.y) * q0.w
           + bflo(kv.z) * q1.x + bfhi(kv.z) * q1.y + bflo(kv.w) * q1.z + bfhi(kv.w) * q1.w;
      }
      s = a;
    }
    sc[i] = s; mx = fmaxf(mx, s);
  }
  mx = wave_max(mx);
  const float m = fmaxf(mx, sink);
  WAVE_SYNC();
  float sum = 0.f;
  if (m > -INFINITY) {
    for (int i = lane; i < n4; i += 64) { const float pz = __expf(sc[i] - m); sc[i] = pz; sum += pz; }
  } else {
    for (int i = lane; i < n4; i += 64) sc[i] = 0.f;
  }
  sum = wave_sum(sum);
  if (sink > -INFINITY) sum += __expf(sink - m);
  const float inv = sum > 0.f ? 1.f / sum : 0.f;
  WAVE_SYNC();
  const int kk = lane >> 4, dg = lane & 15;
  float a0 = 0.f, a1 = 0.f, a2 = 0.f, a3 = 0.f;
  for (int i = kk; i < n4; i += 4) {
    const float pz = sc[i];
    if (pz != 0.f) {
      const int r = tk[i];
      const uint2 v = *reinterpret_cast<const uint2*>(Vb + (size_t)r * ld + dg * 4);
      a0 += pz * bflo(v.x); a1 += pz * bfhi(v.x); a2 += pz * bflo(v.y); a3 += pz * bfhi(v.y);
    }
  }
  a0 += __shfl_xor(a0, 16); a1 += __shfl_xor(a1, 16); a2 += __shfl_xor(a2, 16); a3 += __shfl_xor(a3, 16);
  a0 += __shfl_xor(a0, 32); a1 += __shfl_xor(a1, 32); a2 += __shfl_xor(a2, 32); a3 += __shfl_xor(a3, 32);
  o[0] = a0 * inv; o[1] = a1 * inv; o[2] = a2 * inv; o[3] = a3 * inv;
  return inv;
}

DEV void ph_attn0(const Params& p, AttnSmem& sm) {
  const int tid = tidx(), lane = tid & 63, wid = tid >> 6;
  float* qs = sm.qs[wid]; float* sc = sm.sc[wid]; int* tk = sm.tk[wid];
  const int gw = blockIdx.x * NWAVE + wid, nw = gridDim.x * NWAVE;
  for (int u = gw; u < T_ * 16; u += nw) {
    const int tg = u >> 4, h = u & 15, b = tg >> 12, t = tg & 4095;
    const u16* row = p.qkv + (size_t)tg * LD0;
    int qcol, kcol, vcol, n; float sink = -INFINITY;
    if (h < 8) {
      qcol = h * 64; kcol = 512 + h * 64; vcol = 1024 + h * 64;
      for (int i = lane; i < 388; i += 64) {
        int r = -1;
        if (i < 387) { const int pi = i / 129, k = i - pi * 129; const int dil = pi == 0 ? 1 : (pi == 1 ? 4 : 16); const int tok = t - k * dil; if (tok >= 0) r = b * S_ + tok; }
        tk[i] = r;
      }
      n = 388;
    } else {
      const int hb = h - 8, g = hb >> 2;
      qcol = 1536 + hb * 64; kcol = 2048 + g * 64; vcol = 2176 + g * 64; sink = p.even_sinks[hb];
      for (int i = lane; i < 128; i += 64) { const int tok = t - i; tk[i] = tok >= 0 ? b * S_ + tok : -1; }
      n = 128;
    }
    qs[lane] = bf2f(row[qcol + lane]) * 0.125f;
    WAVE_SYNC();
    float o[4];
    wave_attn(qs, sc, tk, n, p.qkv + kcol, p.qkv + vcol, LD0, sink, lane, o);
    if (lane < 16) { uint2 w; w.x = pack2(o[0], o[1]); w.y = pack2(o[2], o[3]); *reinterpret_cast<uint2*>(p.ao + (size_t)tg * D_ + h * 64 + lane * 4) = w; }
    WAVE_SYNC();
  }
}

DEV void ph_outproj(const Params& p, GemmSmem& sm, const u16* W16, const float* resid) {
  const int tid = tidx(), lane = tid & 63, wid = tid >> 6, wr = wid >> 1, wc = wid & 1, fr = lane & 15, fq = lane >> 4;
  for (ItemRange it = xcd_items(64 * 8); it.i < it.hi; it.i += it.step) {
    int mt, nt; dense_item<8, 4>(it.i, 64, mt, nt);
    const int m0 = mt * 256, n0 = nt * 128;
    const u16* ar0 = p.ao + (size_t)(m0 + (tid >> 3)) * D_ + (tid & 7) * 8;
    auto a_addr = [&](int i, int kt) { return ar0 + (size_t)i * 64 * D_ + kt * 64; };
    const u16* bb = W16 + (size_t)(tid >> 4) * D_ + n0 + 8 * (tid & 15);
    auto b_addr = [&](int kt) { return bb + (size_t)kt * 64 * D_; };
    auto b_lo = [&](int) { return false; };
    auto epi = [&](f32x4 (&acc)[4][4]) {
#pragma unroll
      for (int mi = 0; mi < 4; ++mi)
#pragma unroll
        for (int ni = 0; ni < 4; ++ni) {
          const size_t idx = (size_t)(m0 + wr * 64 + mi * 16 + fr) * D_ + n0 + wc * 64 + ni * 16 + fq * 4;
          const float4 r = ld4(resid + idx);
          float4 o; o.x = ALPHA * r.x + acc[mi][ni][0]; o.y = ALPHA * r.y + acc[mi][ni][1]; o.z = ALPHA * r.z + acc[mi][ni][2]; o.w = ALPHA * r.w + acc[mi][ni][3];
          *reinterpret_cast<float4*>(p.hpre + idx) = o;
        }
    };
    gemm_core<4, false, true>(sm, 16, a_addr, b_addr, D_, b_lo, epi);
  }
}

DEV void ph_ln_mix(const Params& p, const float* g, const float* bt) {
  const int lane = tidx() & 63, gw = blockIdx.x * NWAVE + (tidx() >> 6), nw = gridDim.x * NWAVE;
  for (int tok = gw; tok < T_; tok += nw) {
    float4 v[4]; float s = 0.f;
#pragma unroll
    for (int i = 0; i < 4; ++i) { v[i] = reinterpret_cast<const float4*>(p.hpre + (size_t)tok * D_)[i * 64 + lane]; s += v[i].x + v[i].y + v[i].z + v[i].w; }
    const float mu = wave_sum(s) * (1.f / D_);
    float ss = 0.f;
#pragma unroll
    for (int i = 0; i < 4; ++i) { v[i].x -= mu; v[i].y -= mu; v[i].z -= mu; v[i].w -= mu; ss += v[i].x * v[i].x + v[i].y * v[i].y + v[i].z * v[i].z + v[i].w * v[i].w; }
    const float rstd = rsqrtf(wave_sum(ss) * (1.f / D_) + LN_EPS);
#pragma unroll
    for (int i = 0; i < 4; ++i) {
      const float4 gg = reinterpret_cast<const float4*>(g)[i * 64 + lane], bb = reinterpret_cast<const float4*>(bt)[i * 64 + lane];
      float4 y; y.x = v[i].x * rstd * gg.x + bb.x; y.y = v[i].y * rstd * gg.y + bb.y; y.z = v[i].z * rstd * gg.z + bb.z; y.w = v[i].w * rstd * gg.w + bb.w;
      const u16 h0 = f2bf(y.x), h1 = f2bf(y.y), h2 = f2bf(y.z), h3 = f2bf(y.w);
      uint2 hi; hi.x = (unsigned)h0 | ((unsigned)h1 << 16); hi.y = (unsigned)h2 | ((unsigned)h3 << 16);
      uint2 lo; lo.x = pack2(y.x - bf2f(h0), y.y - bf2f(h1)); lo.y = pack2(y.z - bf2f(h2), y.w - bf2f(h3));
      reinterpret_cast<uint2*>(p.x1b + (size_t)tok * D_)[i * 64 + lane] = hi;
      reinterpret_cast<uint2*>(p.x1lo + (size_t)tok * D_)[i * 64 + lane] = lo;
    }
  }
}

DEV void ph_router_gemm(const Params& p, GemmSmem& sm, const u16* RW16) {
  const int tid = tidx(), lane = tid & 63, wid = tid >> 6, wr = wid >> 1, wc = wid & 1, fr = lane & 15, fq = lane >> 4;
  for (ItemRange it = xcd_items(128 * 2); it.i < it.hi; it.i += it.step) {
    const int nt = it.i & 1, mt = it.i >> 1, m0 = mt * 128, n0 = nt * 128;
    const size_t ao0 = (size_t)(m0 + (tid >> 3)) * D_ + (tid & 7) * 8;
    auto a_addr = [&](int i, int kt) { const u16* base = ((kt >> 4) == 1) ? p.x1lo : p.x1b; return base + ao0 + (size_t)i * 64 * D_ + (kt & 15) * 64; };
    const u16* bb = RW16 + (size_t)(tid >> 4) * NE + n0 + 8 * (tid & 15);
    auto b_addr = [&](int kt) { return bb + (kt >= 32 ? (size_t)D_ * NE : 0) + (size_t)(kt & 15) * 64 * NE; };
    auto b_lo = [&](int) { return false; };
    auto epi = [&](f32x4 (&acc)[2][4]) {
#pragma unroll
      for (int mi = 0; mi < 2; ++mi)
#pragma unroll
        for (int ni = 0; ni < 4; ++ni) {
          float4 o; o.x = acc[mi][ni][0]; o.y = acc[mi][ni][1]; o.z = acc[mi][ni][2]; o.w = acc[mi][ni][3];
          *reinterpret_cast<float4*>(p.logits + (size_t)(m0 + wr * 32 + mi * 16 + fr) * NE + n0 + wc * 64 + ni * 16 + fq * 4) = o;
        }
    };
    gemm_core<2, false, true>(sm, 48, a_addr, b_addr, NE, b_lo, epi);
  }
}

template <bool NAIVE_LG> DEV void ph_route(const Params& p, const float* rbias, int* cnt, const float* RW, int* etok) {
  const int lane = tidx() & 63, gw = blockIdx.x * NWAVE + (tidx() >> 6), nw = gridDim.x * NWAVE;
  const int half = lane >> 5;
  for (int tok = gw; tok < T_; tok += nw) {
    float aff[4], val[4];
    float lgn[4] = {0.f, 0.f, 0.f, 0.f};
    if (NAIVE_LG) {
      for (int k = 0; k < D_; ++k) {
        const float xv = bf2f(p.x1b[(size_t)tok * D_ + k]) + bf2f(p.x1lo[(size_t)tok * D_ + k]);
#pragma unroll
        for (int j = 0; j < 4; ++j) lgn[j] += xv * RW[(size_t)k * NE + lane + 64 * j];
      }
    }
#pragma unroll
    for (int j = 0; j < 4; ++j) {
      const float lg = NAIVE_LG ? lgn[j] : p.logits[(size_t)tok * NE + lane + 64 * j];
      aff[j] = 1.f / (1.f + expf(-lg));
      val[j] = aff[j] + rbias[lane + 64 * j];
    }
    float gs[8];
#pragma unroll
    for (int j = 0; j < 4; ++j) {
      float m1 = val[j];
#pragma unroll
      for (int o = 16; o; o >>= 1) m1 = fmaxf(m1, __shfl_xor(m1, o));
      const unsigned long long eq = __ballot(val[j] == m1);
      const int ceq = __popc((unsigned)(half ? (eq >> 32) : (eq & 0xffffffffull)));
      float m2 = (val[j] == m1) ? -INFINITY : val[j];
#pragma unroll
      for (int o = 16; o; o >>= 1) m2 = fmaxf(m2, __shfl_xor(m2, o));
      if (ceq >= 2) m2 = m1;
      const float mine = m1 + m2, other = __shfl_xor(mine, 32);
      gs[2 * j] = half ? other : mine; gs[2 * j + 1] = half ? mine : other;
    }
    bool gok[8];
#pragma unroll
    for (int g = 0; g < 8; ++g) {
      int rk = 0;
#pragma unroll
      for (int g2 = 0; g2 < 8; ++g2) rk += (gs[g2] > gs[g] || (gs[g2] == gs[g] && g2 < g)) ? 1 : 0;
      gok[g] = rk < 4;
    }
#pragma unroll
    for (int j = 0; j < 4; ++j) { const bool ok = half ? gok[2 * j + 1] : gok[2 * j]; if (!ok) val[j] = -INFINITY; }
    int my_e = 0; float my_a = 0.f, asum = 0.f;
#pragma unroll
    for (int k = 0; k < TOPK; ++k) {
      float bv = val[0]; int bi = lane;
#pragma unroll
      for (int j = 1; j < 4; ++j) if (val[j] > bv) { bv = val[j]; bi = lane + 64 * j; }
#pragma unroll
      for (int o = 32; o; o >>= 1) {
        const float ov = __shfl_xor(bv, o); const int oi = __shfl_xor(bi, o);
        if (ov > bv || (ov == bv && oi < bi)) { bv = ov; bi = oi; }
      }
      float a_sel = 0.f;
#pragma unroll
      for (int j = 0; j < 4; ++j) { const bool hit = (bi == lane + 64 * j); a_sel = hit ? aff[j] : a_sel; val[j] = hit ? -INFINITY : val[j]; }
      a_sel = wave_sum(a_sel);
      asum += a_sel;
      if (lane == k) { my_e = bi; my_a = a_sel; }
    }
    if (lane < TOPK) {
      const int ps = atomicAdd(&cnt[my_e], 1);
      p.eidx[tok * TOPK + lane] = my_e; p.epos[tok * TOPK + lane] = ps; p.gatev[tok * TOPK + lane] = my_a / asum * 2.5f;
      etok[(size_t)my_e * T_ + ps] = tok;
    }
  }
}

constexpr int MOE_TM = 320;
struct MoeTab { int cn[260]; int of[260]; int tf[260]; unsigned ao[2][5][NTHR]; };
DEV void moe_prep(MoeTab& mt, const int* cnt) {
  const int tid = tidx();
  if (tid < NE) mt.cn[tid] = cnt[tid];
  __syncthreads();
  if (tid == 0) {
    int a = 0, tl = 0;
    for (int e = 0; e < NE; ++e) { mt.of[e] = a; mt.tf[e] = tl; a += mt.cn[e]; tl += (mt.cn[e] + MOE_TM - 1) / MOE_TM; }
    mt.cn[NE] = T_; mt.of[NE] = NASG; mt.tf[NE] = tl; mt.of[NE + 1] = NASG + T_; mt.tf[NE + 1] = tl + (T_ + MOE_TM - 1) / MOE_TM;
  }
  __syncthreads();
}
DEV int moe_rows_per_tile(int cn, int tiles) { return (cn + tiles - 1) / tiles; }
struct MoeItem { int e, nt, r0, r1, of; };
template <int NPT> DEV MoeItem moe_item(const MoeTab& mt, int u) {
  int lo = 0, hi = NE;
  while (lo < hi) { const int mid = (lo + hi + 1) >> 1; if (NPT * mt.tf[mid] <= u) lo = mid; else hi = mid - 1; }
  MoeItem it; it.e = lo;
  const int tiles = mt.tf[lo + 1] - mt.tf[lo], local = u - NPT * mt.tf[lo], mtl = local / NPT, cn = mt.cn[lo];
  it.nt = local - mtl * NPT; it.of = mt.of[lo];
  const int per = moe_rows_per_tile(cn, tiles);
  it.r0 = mtl * per; it.r1 = (it.r0 + per < cn) ? it.r0 + per : cn;
  return it;
}

template <int NK, class FA, class FB, class FAN, class FBN, class FM, class FE>
DEV void moe_gemm5(GemmSmem& sm, u32x4_t (&ra)[2][5], f32x4_t (&rb)[4], FA a_addr, FB b_addr, FAN a_next, FBN b_next, int ldb, FM mid, FE epi) {
  constexpr int MI = 5;
  const int tid = tidx(), lane = tid & 63, wid = tid >> 6;
  const int wr = wid >> 1, wc = wid & 1, fr = lane & 15, fq = lane >> 4;
  const int n4 = tid & 31, kq = tid >> 5, q4 = (lane & 15) >> 2, p4 = lane & 3;
  f32x4 acc[MI][4];
#pragma unroll
  for (int mi = 0; mi < MI; ++mi)
#pragma unroll
    for (int ni = 0; ni < 4; ++ni) acc[mi][ni] = f32x4{0.f, 0.f, 0.f, 0.f};
  auto gloadA = [&](auto PC, auto& fa, int kt) {
    constexpr int P = decltype(PC)::value;
#pragma unroll
    for (int i = 0; i < MI; ++i) ra[P][i] = *reinterpret_cast<const u32x4_t*>(fa(i, kt));
  };
  auto gloadB = [&](auto& fb, int kt) {
    const float* bp = fb(kt);
#pragma unroll
    for (int i = 0; i < 4; ++i) rb[i] = *reinterpret_cast<const f32x4_t*>(bp + (size_t)(16 * i) * ldb);
  };
  auto sstore = [&](auto PC, auto BC) {
    constexpr int P = decltype(PC)::value;
    constexpr int Bf = decltype(BC)::value;
#pragma unroll
    for (int i = 0; i < MI; ++i) *reinterpret_cast<u32x4_t*>(&sm.A[Bf][(tid >> 3) + 64 * i][(tid & 7) * 8]) = ra[P][i];
#pragma unroll
    for (int i = 0; i < 4; ++i) {
      const f32x4_t v = rb[i];
      u32x2_t w; w[0] = cvtpk(v[0], v[1]); w[1] = cvtpk(v[2], v[3]);
      const int k = kq + 16 * i;
      *reinterpret_cast<u32x2_t*>(&sm.B[Bf][k][(((n4 >> 2) ^ bswz(k)) << 4) + (n4 & 3) * 4]) = w;
    }
  };
  auto compute = [&](auto BC) {
    constexpr int P = decltype(BC)::value;
#pragma unroll
    for (int ks = 0; ks < 2; ++ks) {
      bf16x8 bf[4];
#pragma unroll
      for (int ni = 0; ni < 4; ++ni) {
        const int k0 = 32 * ks + 8 * fq + q4, col = (((wc * 4 + ni) ^ bswz(k0)) << 4) + 4 * p4;
        const v4i16_t lo = lds_tr(&sm.B[P][k0][col]);
        const v4i16_t hh = lds_tr(&sm.B[P][k0 + 4][col]);
        bf[ni] = bf16x8{lo[0], lo[1], lo[2], lo[3], hh[0], hh[1], hh[2], hh[3]};
      }
      {
        bf16x8 af[3];
#pragma unroll
        for (int mi = 0; mi < 3; ++mi) af[mi] = *reinterpret_cast<const bf16x8*>(&sm.A[P][wr * 80 + mi * 16 + fr][32 * ks + fq * 8]);
#pragma unroll
        for (int mi = 0; mi < 3; ++mi)
#pragma unroll
          for (int ni = 0; ni < 4; ++ni) acc[mi][ni] = __builtin_amdgcn_mfma_f32_16x16x32_bf16(bf[ni], af[mi], acc[mi][ni], 0, 0, 0);
      }
      __builtin_amdgcn_sched_barrier(0);
      {
        bf16x8 af[2];
#pragma unroll
        for (int mi = 3; mi < 5; ++mi) af[mi - 3] = *reinterpret_cast<const bf16x8*>(&sm.A[P][wr * 80 + mi * 16 + fr][32 * ks + fq * 8]);
#pragma unroll
        for (int mi = 3; mi < 5; ++mi)
#pragma unroll
          for (int ni = 0; ni < 4; ++ni) acc[mi][ni] = __builtin_amdgcn_mfma_f32_16x16x32_bf16(bf[ni], af[mi - 3], acc[mi][ni], 0, 0, 0);
      }
      __builtin_amdgcn_sched_barrier(0);
    }
  };
  using C0 = std::integral_constant<int, 0>; using C1 = std::integral_constant<int, 1>;
  gloadA(C1{}, a_addr, 1);
  sstore(C0{}, C0{}); __syncthreads();
#pragma unroll 1
  for (int kt = 0; kt + 2 < NK; kt += 2) {
    gloadA(C0{}, a_addr, kt + 2); gloadB(b_addr, kt + 1); if (kt == 0) mid(); compute(C0{}); sstore(C1{}, C1{}); __syncthreads();
    gloadA(C1{}, a_addr, kt + 3); gloadB(b_addr, kt + 2); compute(C1{}); sstore(C0{}, C0{}); __syncthreads();
  }
  gloadB(b_addr, NK - 1); compute(C0{}); sstore(C1{}, C1{}); __syncthreads();
  gloadA(C0{}, a_next, 0); gloadB(b_next, 0);
  compute(C1{});
  epi(acc);
}

DEV void ph_moe1(const Params& p, GemmSmem& sm, MoeTab& mt, int layer, const int* cnt) {
  const int tid = tidx(), lane = tid & 63, wid = tid >> 6, wr = wid >> 1, wc = wid & 1, fr = lane & 15, fq = lane >> 4;
  moe_prep(mt, cnt);
  ItemRange it = xcd_items(mt.tf[NE + 1] * 4);
  if (it.i >= it.hi) return;
  const int v0 = 4 * (tid & 31);
  auto set_rows = [&](const MoeItem& m, int slot) {
#pragma unroll
    for (int i = 0; i < 5; ++i) {
      int ri = m.r0 + (tid >> 3) + 64 * i; ri = ri < m.r1 ? ri : m.r1 - 1;
      const int tk = m.e < NE ? p.etok[(size_t)m.e * T_ + ri] : ri;
      mt.ao[slot][i][tid] = (unsigned)tk * D_ + (tid & 7) * 8;
    }
  };
  auto b_ptr = [&](const MoeItem& m, int kt) -> const float* {
    const float* wg = m.e < NE ? p.w_gate + ((size_t)layer * NE + m.e) * D_ * 256 : p.sh_gate + (size_t)layer * D_ * 256;
    const float* wu = m.e < NE ? p.w_up + ((size_t)layer * NE + m.e) * D_ * 256 : p.sh_up + (size_t)layer * D_ * 256;
    return ((v0 & 63) >= 32 ? wu : wg) + (size_t)(kt * 64 + (tid >> 5)) * 256 + m.nt * 64 + (v0 >> 6) * 32 + (v0 & 31);
  };
  u32x4_t ra[2][5]; f32x4_t rb[4];
  MoeItem cur = moe_item<4>(mt, it.i);
  int slot = 0;
  set_rows(cur, 0);
  {
#pragma unroll
    for (int i = 0; i < 5; ++i) ra[0][i] = *reinterpret_cast<const u32x4_t*>(p.x1b + mt.ao[0][i][tid]);
#pragma unroll
    for (int i = 0; i < 4; ++i) rb[i] = *reinterpret_cast<const f32x4_t*>(b_ptr(cur, 0) + (size_t)(16 * i) * 256);
  }
  for (;;) {
    const int un = it.i + it.step;
    const bool has_next = un < it.hi;
    const MoeItem nxt = has_next ? moe_item<4>(mt, un) : cur;
    const int nslot = has_next ? slot ^ 1 : slot;
    auto a_addr = [&](int i, int kt) { return p.x1b + mt.ao[slot][i][tid] + kt * 64; };
    auto b_addr = [&](int kt) { return b_ptr(cur, kt); };
    auto a_next = [&](int i, int kt) { return p.x1b + mt.ao[nslot][i][tid] + kt * 64; };
    auto b_next = [&](int kt) { return b_ptr(nxt, kt); };
    auto mid = [&]() { if (has_next) set_rows(nxt, nslot); };
    auto epi = [&](f32x4 (&acc)[5][4]) {
#pragma unroll
      for (int mi = 0; mi < 5; ++mi) {
        const int idx = cur.r0 + wr * 80 + mi * 16 + fr;
        if (idx < cur.r1) {
#pragma unroll
          for (int n2 = 0; n2 < 2; ++n2) {
            float hv[4];
#pragma unroll
            for (int j = 0; j < 4; ++j) { const float g = acc[mi][n2][j], uu = acc[mi][n2 + 2][j]; hv[j] = g * __builtin_amdgcn_rcpf(1.f + __expf(-g)) * uu; }
            st_bf4(p.hbuf + (size_t)(cur.of + idx) * 256 + cur.nt * 64 + wc * 32 + n2 * 16 + fq * 4, hv[0], hv[1], hv[2], hv[3]);
          }
        }
      }
    };
    moe_gemm5<16>(sm, ra, rb, a_addr, b_addr, a_next, b_next, 256, mid, epi);
    if (!has_next) break;
    cur = nxt; it.i = un; slot = nslot;
  }
}

DEV void ph_moe2(const Params& p, GemmSmem& sm, MoeTab& mt, int layer, const int* cnt) {
  const int tid = tidx(), lane = tid & 63, wid = tid >> 6, wr = wid >> 1, wc = wid & 1, fr = lane & 15, fq = lane >> 4;
  moe_prep(mt, cnt);
  ItemRange it = xcd_items(mt.tf[NE + 1] * 8);
  if (it.i >= it.hi) return;
  auto a_ptr = [&](const MoeItem& m, int i, int kt) -> const u16* {
    const int rmax = m.r1 - 1 - m.r0 - (tid >> 3);
    int d = 64 * i; d = d < rmax ? d : rmax;
    return p.hbuf + (size_t)(m.of + m.r0 + (tid >> 3) + d) * 256 + (tid & 7) * 8 + kt * 64;
  };
  auto b_ptr = [&](const MoeItem& m, int kt) -> const float* {
    const float* wd = m.e < NE ? p.w_down + ((size_t)layer * NE + m.e) * 256 * D_ : p.sh_down + (size_t)layer * 256 * D_;
    return wd + (size_t)(kt * 64 + (tid >> 5)) * D_ + m.nt * 128 + 4 * (tid & 31);
  };
  u32x4_t ra[2][5]; f32x4_t rb[4];
  MoeItem cur = moe_item<8>(mt, it.i);
  {
#pragma unroll
    for (int i = 0; i < 5; ++i) ra[0][i] = *reinterpret_cast<const u32x4_t*>(a_ptr(cur, i, 0));
#pragma unroll
    for (int i = 0; i < 4; ++i) rb[i] = *reinterpret_cast<const f32x4_t*>(b_ptr(cur, 0) + (size_t)(16 * i) * D_);
  }
  for (;;) {
    const int un = it.i + it.step;
    const bool has_next = un < it.hi;
    const MoeItem nxt = has_next ? moe_item<8>(mt, un) : cur;
    auto a_addr = [&](int i, int kt) { return a_ptr(cur, i, kt); };
    auto b_addr = [&](int kt) { return b_ptr(cur, kt); };
    auto a_next = [&](int i, int kt) { return a_ptr(nxt, i, kt); };
    auto b_next = [&](int kt) { return b_ptr(nxt, kt); };
    auto mid = [&]() {};
    auto epi = [&](f32x4 (&acc)[5][4]) {
#pragma unroll
      for (int mi = 0; mi < 5; ++mi) {
        const int idx = cur.r0 + wr * 80 + mi * 16 + fr;
        if (idx < cur.r1) {
#pragma unroll
          for (int ni = 0; ni < 4; ++ni)
            st_bf4(p.ybuf + (size_t)(cur.of + idx) * D_ + cur.nt * 128 + wc * 64 + ni * 16 + fq * 4, acc[mi][ni][0], acc[mi][ni][1], acc[mi][ni][2], acc[mi][ni][3]);
        }
      }
    };
    moe_gemm5<4>(sm, ra, rb, a_addr, b_addr, a_next, b_next, D_, mid, epi);
    if (!has_next) break;
    cur = nxt; it.i = un;
  }
}

DEV void ph_combine_ln(const Params& p, MoeTab& mt, const int* cnt, const float* g, const float* bt, float* outf, u16* outb, bool with_ffn, bool write_b = true) {
  const int lane = tidx() & 63, gw = blockIdx.x * NWAVE + (tidx() >> 6), nw = gridDim.x * NWAVE;
  moe_prep(mt, cnt);
  for (int tok = gw; tok < T_; tok += nw) {
    float4 v[4];
#pragma unroll
    for (int i = 0; i < 4; ++i) {
      const uint2 xh = reinterpret_cast<const uint2*>(p.x1b + (size_t)tok * D_)[i * 64 + lane], xl = reinterpret_cast<const uint2*>(p.x1lo + (size_t)tok * D_)[i * 64 + lane];
      v[i].x = ALPHA * (bflo(xh.x) + bflo(xl.x)); v[i].y = ALPHA * (bfhi(xh.x) + bfhi(xl.x));
      v[i].z = ALPHA * (bflo(xh.y) + bflo(xl.y)); v[i].w = ALPHA * (bfhi(xh.y) + bfhi(xl.y));
    }
    if (with_ffn) {
#if FFN_MODE != 2
#pragma unroll
      for (int i = 0; i < 4; ++i) {
        const uint2 y = reinterpret_cast<const uint2*>(p.ybuf + (size_t)(NASG + tok) * D_)[i * 64 + lane];
        v[i].x += bflo(y.x); v[i].y += bfhi(y.x); v[i].z += bflo(y.y); v[i].w += bfhi(y.y);
      }
#endif
#if FFN_MODE != 1
      for (int k = 0; k < TOPK; ++k) {
        const int sl = mt.of[p.eidx[tok * TOPK + k]] + p.epos[tok * TOPK + k]; const float gk = p.gatev[tok * TOPK + k];
#pragma unroll
        for (int i = 0; i < 4; ++i) {
          const uint2 y = reinterpret_cast<const uint2*>(p.ybuf + (size_t)sl * D_)[i * 64 + lane];
          v[i].x += gk * bflo(y.x); v[i].y += gk * bfhi(y.x); v[i].z += gk * bflo(y.y); v[i].w += gk * bfhi(y.y);
        }
      }
#endif
    }
    float s = 0.f;
#pragma unroll
    for (int i = 0; i < 4; ++i) s += v[i].x + v[i].y + v[i].z + v[i].w;
    const float mu = wave_sum(s) * (1.f / D_);
    float ss = 0.f;
#pragma unroll
    for (int i = 0; i < 4; ++i) { v[i].x -= mu; v[i].y -= mu; v[i].z -= mu; v[i].w -= mu; ss += v[i].x * v[i].x + v[i].y * v[i].y + v[i].z * v[i].z + v[i].w * v[i].w; }
    const float rstd = rsqrtf(wave_sum(ss) * (1.f / D_) + LN_EPS);
#pragma unroll
    for (int i = 0; i < 4; ++i) {
      const float4 gg = reinterpret_cast<const float4*>(g)[i * 64 + lane], bb = reinterpret_cast<const float4*>(bt)[i * 64 + lane];
      float4 y; y.x = v[i].x * rstd * gg.x + bb.x; y.y = v[i].y * rstd * gg.y + bb.y; y.z = v[i].z * rstd * gg.z + bb.z; y.w = v[i].w * rstd * gg.w + bb.w;
      reinterpret_cast<float4*>(outf + (size_t)tok * D_)[i * 64 + lane] = y;
      uint2 hi; hi.x = pack2(y.x, y.y); hi.y = pack2(y.z, y.w);
      if (write_b) reinterpret_cast<uint2*>(outb + (size_t)tok * D_)[i * 64 + lane] = hi;
    }
  }
}

DEV void ph_inproj1(const Params& p, GemmSmem& sm) {
  const int tid = tidx(), lane = tid & 63, wid = tid >> 6, wr = wid >> 1, wc = wid & 1, fr = lane & 15, fq = lane >> 4;
  constexpr int NT = 21;
  for (ItemRange it = xcd_items(64 * (NT + 1)); it.i < it.hi; it.i += it.step) {
    int mt, nt; dense_item<16, 2>(it.i, 64, mt, nt);
    if (nt >= NT) continue;
    const int m0 = mt * 256, n0 = nt * 128;
    const u16* ar0 = p.xb + (size_t)(m0 + (tid >> 3)) * D_ + (tid & 7) * 8;
    auto a_addr = [&](int i, int kt) { return ar0 + (size_t)i * 64 * D_ + kt * 64; };
    const u16* bb = p.w16_in1 + (size_t)(tid >> 4) * NIN1 + n0 + 8 * (tid & 15);
    const bool bok = n0 + 8 * (tid & 15) < NIN1;
    const u16* bbv = bok ? bb : p.w16_in1 + (size_t)(tid >> 4) * NIN1;
    auto b_addr = [&](int kt) -> const u16* { return bbv + (size_t)kt * 64 * NIN1; };
    auto b_lo = [&](int) { return false; };
    auto epi = [&](f32x4 (&acc)[4][4]) {
#pragma unroll
      for (int mi = 0; mi < 4; ++mi) {
        const int row = m0 + wr * 64 + mi * 16 + fr;
#pragma unroll
        for (int ni = 0; ni < 4; ++ni) {
          f32x4 v = acc[mi][ni];
          const int col = n0 + wc * 64 + ni * 16 + fq * 4;
          const bool rope = (ni == 0) && (col < 1280 || (col >= 1536 && col < 1792) || (col >= 2048 && col < 2304));
          if (rope) {
            const float4 c_ = ld4(p.cs + row * 16 + 4 * (fq & 1)), s_ = ld4(p.cs + row * 16 + 8 + 4 * (fq & 1));
            const float p0 = __shfl_xor(v[0], 32), p1 = __shfl_xor(v[1], 32), p2 = __shfl_xor(v[2], 32), p3 = __shfl_xor(v[3], 32);
            const float sg = fq < 2 ? -1.f : 1.f;
            v[0] = v[0] * c_.x + sg * p0 * s_.x; v[1] = v[1] * c_.y + sg * p1 * s_.y; v[2] = v[2] * c_.z + sg * p2 * s_.z; v[3] = v[3] * c_.w + sg * p3 * s_.w;
          }
          if (col < LD1) st_bf4(p.qkv + (size_t)row * LD1 + col, v[0], v[1], v[2], v[3]);
          else if (col < NIN1) {
            float4 o; o.x = 1.f / (1.f + __expf(-v[0])); o.y = 1.f / (1.f + __expf(-v[1])); o.z = 1.f / (1.f + __expf(-v[2])); o.w = 1.f / (1.f + __expf(-v[3]));
            *reinterpret_cast<float4*>(p.gates + (size_t)row * 48 + (col - LD1)) = o;
          }
        }
      }
    };
    gemm_core<4, false, true>(sm, 16, a_addr, b_addr, NIN1, b_lo, epi, bok);
  }
}

DEV float gelu_tanh(float x) { const float u = 0.7978845608028654f * (x + 0.044715f * x * x * x); return 0.5f * x * (1.f + tanhf(u)); }
DEV void ph_cmp1(const Params& p, GemmSmem& sm) {
  const int tid = tidx(), lane = tid & 63, wid = tid >> 6, wr = wid >> 1, wc = wid & 1, fr = lane & 15, fq = lane >> 4;
  for (int u = blockIdx.x; u < 64; u += gridDim.x) {
    const int ts = u >> 5, mt = u & 31, m0 = mt * 128;
    const u16* ar[2];
#pragma unroll
    for (int i = 0; i < 2; ++i) {
      const int m_ = m0 + (tid >> 3) + 64 * i, bg = m_ >> 8; int c = m_ & 255; c = c < 255 ? c : 254;
      ar[i] = p.qkv + (size_t)((bg >> 2) * S_ + 16 * c) * LD1 + (ts ? 1280 : 1024) + (bg & 3) * 64 + (tid & 7) * 8;
    }
    auto a_addr = [&](int i, int kt) { return ar[i] + (size_t)kt * LD1; };
    const float* bb = (ts ? p.cmpv_w1 : p.cmpk_w1) + (size_t)(tid >> 5) * 128 + 4 * (tid & 31);
    auto b_addr = [&](int kt) { return bb + (size_t)kt * 64 * 128; };
    auto b_lo = [&](int) { return false; };
    auto epi = [&](f32x4 (&acc)[2][4]) {
#pragma unroll
      for (int mi = 0; mi < 2; ++mi)
#pragma unroll
        for (int ni = 0; ni < 4; ++ni) {
          const int m = m0 + wr * 32 + mi * 16 + fr, col = wc * 64 + ni * 16 + fq * 4;
          const float4 pbv = ld4(p.pb + ts * 128 + col);
          st_bf4(p.hid + ((size_t)ts * 4096 + m) * 128 + col, gelu_tanh(acc[mi][ni][0] + pbv.x), gelu_tanh(acc[mi][ni][1] + pbv.y),
                 gelu_tanh(acc[mi][ni][2] + pbv.z), gelu_tanh(acc[mi][ni][3] + pbv.w));
        }
    };
    gemm_core<2, false>(sm, 32, a_addr, b_addr, 128, b_lo, epi);
  }
}
DEV void ph_cmp2(const Params& p, GemmSmem& sm) {
  const int tid = tidx(), lane = tid & 63, wid = tid >> 6, wr = wid >> 1, wc = wid & 1, fr = lane & 15, fq = lane >> 4;
  for (int u = blockIdx.x; u < 64; u += gridDim.x) {
    const int ts = u >> 5, mt = u & 31, m0 = mt * 128;
    const u16* ar0 = p.hid + ((size_t)ts * 4096 + m0 + (tid >> 3)) * 128 + (tid & 7) * 8;
    auto a_addr = [&](int i, int kt) { return ar0 + (size_t)i * 64 * 128 + kt * 64; };
    const float* bb = (ts ? p.cmpv_w2 : p.cmpk_w2) + (size_t)(tid >> 5) * 64 + 4 * (tid & 31);
    const bool bok = 4 * (tid & 31) < 64;
    const float* bbv = bok ? bb : (ts ? p.cmpv_w2 : p.cmpk_w2) + (size_t)(tid >> 5) * 64;
    auto b_addr = [&](int kt) -> const float* { return bbv + (size_t)kt * 64 * 64; };
    auto b_lo = [&](int) { return false; };
    auto epi = [&](f32x4 (&acc)[2][4]) {
      if (wc == 0) {
#pragma unroll
        for (int mi = 0; mi < 2; ++mi)
#pragma unroll
          for (int ni = 0; ni < 4; ++ni) {
            const int m = m0 + wr * 32 + mi * 16 + fr, col = ni * 16 + fq * 4;
            st_bf4(p.cmpkv + ((size_t)ts * 4096 + m) * 64 + col, acc[mi][ni][0], acc[mi][ni][1], acc[mi][ni][2], acc[mi][ni][3]);
          }
      }
    };
    gemm_core<2, false>(sm, 2, a_addr, b_addr, 64, b_lo, epi, bok);
  }
}

DEV void ph_attn1(const Params& p, AttnSmem& sm) {
  const int tid = tidx(), lane = tid & 63, wid = tid >> 6;
  float* qs = sm.qs[wid]; float* sc = sm.sc[wid]; int* tk = sm.tk[wid]; int* tw = sm.tw[wid];
  const int gw = blockIdx.x * NWAVE + wid, nw = gridDim.x * NWAVE;
  for (int u = gw; u < T_ * 4; u += nw) {
    const int tg = u >> 2, g = u & 3, b = tg >> 12, t = tg & 4095, cur = t >> 6;
    const u16* row = p.qkv + (size_t)tg * LD1;
    const int nvalid = t >= 31 ? (((t - 31) >> 4) + 1 < 255 ? ((t - 31) >> 4) + 1 : 255) : 0;
    const int n4c = (nvalid + 3) & ~3;
    const u16* kc = p.cmpkv + (size_t)((b * 4 + g) * 256) * 64;
    const u16* vc = p.cmpkv + (size_t)(4096 + (b * 4 + g) * 256) * 64;
    float imp = 0.f;
    float ocmp[4][4];
#pragma unroll
    for (int r = 0; r < 4; ++r) {
      ocmp[r][0] = ocmp[r][1] = ocmp[r][2] = ocmp[r][3] = 0.f;
      if (nvalid > 0) {
        qs[lane] = bf2f(row[(g * 4 + r) * 64 + lane]) * 0.125f;
        for (int i = lane; i < n4c; i += 64) tk[i] = i < nvalid ? i : -1;
        WAVE_SYNC();
        const float inv = wave_attn(qs, sc, tk, n4c, kc, vc, 64, -INFINITY, lane, ocmp[r]);
        WAVE_SYNC();
        float a = 0.f;
        const int c0 = 4 * lane;
        if (c0 - 1 >= 0 && c0 - 1 < nvalid) a += 0.5f * sc[c0 - 1];
        if (c0 < nvalid) a += sc[c0];
        if (c0 + 1 < nvalid) a += sc[c0 + 1];
        if (c0 + 2 < nvalid) a += sc[c0 + 2];
        if (c0 + 3 < nvalid) a += 0.5f * sc[c0 + 3];
        imp += a * inv;
        WAVE_SYNC();
      }
    }
    const float score = (lane > cur) ? -1.f : ((lane == 0 || lane == cur || lane == cur - 1) ? 1.0e4f : imp);
    int rk = 0;
    for (int jj = 0; jj < 64; ++jj) { const float sj = __shfl(score, jj); rk += (sj > score || (sj == score && jj < lane)) ? 1 : 0; }
    unsigned long long mask = __ballot(rk < 16 && lane <= cur);
    int nsel = 0;
    while (mask) {
      const int j = __ffsll((long long)mask) - 1; mask &= mask - 1;
      const int tok = j * 64 + lane;
      tk[nsel * 64 + lane] = tok <= t ? b * S_ + tok : -1;
      ++nsel;
    }
    for (int i = lane; i < 512; i += 64) { const int tok = t - i; tw[i] = tok >= 0 ? b * S_ + tok : -1; }
    WAVE_SYNC();
#pragma unroll
    for (int r = 0; r < 4; ++r) {
      const int h = g * 4 + r;
      qs[lane] = bf2f(row[h * 64 + lane]) * 0.125f;
      WAVE_SYNC();
      float os[4], ow[4];
      wave_attn(qs, sc, tk, nsel * 64, p.qkv + 1536 + g * 64, p.qkv + 1792 + g * 64, LD1, -INFINITY, lane, os);
      WAVE_SYNC();
      wave_attn(qs, sc, tw, 512, p.qkv + 2048 + g * 64, p.qkv + 2304 + g * 64, LD1, -INFINITY, lane, ow);
      const float g0 = p.gates[(size_t)tg * 48 + h * 3], g1 = p.gates[(size_t)tg * 48 + h * 3 + 1], g2 = p.gates[(size_t)tg * 48 + h * 3 + 2];
      if (lane < 16) {
        uint2 w;
        w.x = pack2(g0 * ocmp[r][0] + g1 * os[0] + g2 * ow[0], g0 * ocmp[r][1] + g1 * os[1] + g2 * ow[1]);
        w.y = pack2(g0 * ocmp[r][2] + g1 * os[2] + g2 * ow[2], g0 * ocmp[r][3] + g1 * os[3] + g2 * ow[3]);
        *reinterpret_cast<uint2*>(p.ao + (size_t)tg * D_ + h * 64 + lane * 4) = w;
      }
      WAVE_SYNC();
    }
  }
}


using f32x16 = __attribute__((ext_vector_type(16))) float;
DEV int crow(int r, int hi) { return (r & 3) + 8 * (r >> 2) + 4 * hi; }
constexpr float LOG2E = 1.4426950408889634f;
constexpr float SCL2 = 0.125f * LOG2E;

struct WaveTile { u16 K[32][72]; u16 V[2][32][32]; float imp[32][64]; unsigned long long msk[32]; };
struct KVTile { u16 K[32][72]; u16 V[2][32][32]; };
struct AttnState { float m, l; f32x16 o[2]; };

DEV void stage_load(u32x4_t (&rk)[4], u32x4_t (&rv)[4], const u16* Kb, const u16* Vb, int ld, long rowbase, int rowstep, int kcmax, int k0, int lane) {
#pragma unroll
  for (int it = 0; it < 4; ++it) {
    int kc = k0 + (lane >> 3) + 8 * it; kc = kc > kcmax ? kcmax : kc;
    const long row = rowbase + (long)kc * rowstep;
    rk[it] = *reinterpret_cast<const u32x4_t*>(Kb + row * ld + (lane & 7) * 8);
    rv[it] = *reinterpret_cast<const u32x4_t*>(Vb + row * ld + (lane & 7) * 8);
  }
}
DEV void stage_store(WaveTile& wt, const u32x4_t (&rk)[4], const u32x4_t (&rv)[4], int lane) {
  const int ch = lane & 7;
#pragma unroll
  for (int it = 0; it < 4; ++it) {
    const int j = (lane >> 3) + 8 * it;
    *reinterpret_cast<u32x4_t*>(&wt.K[j][ch * 8]) = rk[it];
    *reinterpret_cast<u32x4_t*>(&wt.V[ch >> 2][j][(ch & 3) * 8]) = rv[it];
  }
}
template <class TT> DEV f32x16 qk_tile(const TT& wt, const bf16x8 (&qf)[4], int r32, int hi) {
  f32x16 acc;
#pragma unroll
  for (int r = 0; r < 16; ++r) acc[r] = 0.f;
#pragma unroll
  for (int s = 0; s < 4; ++s) {
    const bf16x8 kf = *reinterpret_cast<const bf16x8*>(&wt.K[r32][16 * s + 8 * hi]);
    acc = __builtin_amdgcn_mfma_f32_32x32x16_bf16(kf, qf[s], acc, 0, 0, 0);
  }
  return acc;
}
template <class TT> DEV void pv_tile(const TT& wt, const float (&pr)[16], f32x16 (&o)[2], int lane) {
  const int hi = lane >> 5, g = (lane >> 4) & 1, q4 = (lane & 15) >> 2, p4 = lane & 3;
  bf16x8 pf[2];
#pragma unroll
  for (int s2 = 0; s2 < 2; ++s2) {
    u32x4_t w;
    w[0] = cvtpk(pr[8 * s2 + 0], pr[8 * s2 + 1]); w[1] = cvtpk(pr[8 * s2 + 2], pr[8 * s2 + 3]);
    w[2] = cvtpk(pr[8 * s2 + 4], pr[8 * s2 + 5]); w[3] = cvtpk(pr[8 * s2 + 6], pr[8 * s2 + 7]);
    pf[s2] = __builtin_bit_cast(bf16x8, w);
  }
#pragma unroll
  for (int dt = 0; dt < 2; ++dt)
#pragma unroll
    for (int s2 = 0; s2 < 2; ++s2) {
      const v4i16_t lo = lds_tr(&wt.V[dt][16 * s2 + 4 * hi + q4][16 * g + 4 * p4]);
      const v4i16_t hh = lds_tr(&wt.V[dt][16 * s2 + 8 + 4 * hi + q4][16 * g + 4 * p4]);
      const bf16x8 vf = {lo[0], lo[1], lo[2], lo[3], hh[0], hh[1], hh[2], hh[3]};
      o[dt] = __builtin_amdgcn_mfma_f32_32x32x16_bf16(vf, pf[s2], o[dt], 0, 0, 0);
    }
}
DEV void attn_init(AttnState& st) {
  st.m = -INFINITY; st.l = 0.f;
#pragma unroll
  for (int r = 0; r < 16; ++r) { st.o[0][r] = 0.f; st.o[1][r] = 0.f; }
}
template <bool USE_SEL>
DEV void attn_span(AttnState& st, WaveTile& wt, const bf16x8 (&qf)[4], const u16* Kb, const u16* Vb, int ld,
                   long rowbase, int rowstep, int kcmax, int kc_lo, int kc_hi, int qc, int W,
                   unsigned long long sel, unsigned long long selu, int lane, int qc_min, int qc_max) {
  const int r32 = lane & 31, hi = lane >> 5;
  if (kc_lo < 0) kc_lo = 0;
  if (kc_hi > kcmax) kc_hi = kcmax;
  const int full_hi = qc_min < kcmax ? qc_min : kcmax;
  auto skip = [&](int k0) -> bool { return USE_SEL && !((selu >> (k0 >> 6)) & 1ull); };
  int kc0 = kc_lo & ~31;
  while (kc0 <= kc_hi && skip(kc0)) kc0 += 32;
  if (kc0 > kc_hi) return;
  u32x4_t rk[4], rv[4];
  stage_load(rk, rv, Kb, Vb, ld, rowbase, rowstep, kcmax, kc0, lane);
  for (;;) {
    stage_store(wt, rk, rv, lane);
    int kn = kc0 + 32;
    while (kn <= kc_hi && skip(kn)) kn += 32;
    if (kn <= kc_hi) stage_load(rk, rv, Kb, Vb, ld, rowbase, rowstep, kcmax, kn, lane);
    WAVE_SYNC();
    const f32x16 s = qk_tile(wt, qf, r32, hi);
    const bool selbit = USE_SEL ? (((sel >> (kc0 >> 6)) & 1ull) != 0ull) : true;
    const bool full = (qc_min <= qc_max) && (kc0 + 31 <= full_hi) && (kc0 >= qc_max - W);
    float sv[16]; float mt = -INFINITY;
    if (full) {
      float rm = s[0];
#pragma unroll
      for (int r = 1; r < 16; ++r) rm = fmaxf(rm, s[r]);
      mt = selbit ? rm * SCL2 : -INFINITY;
    } else {
#pragma unroll
      for (int r = 0; r < 16; ++r) {
        const int kc = kc0 + crow(r, hi), dist = qc - kc;
        const bool ok = selbit && kc <= kcmax && dist >= 0 && dist <= W;
        sv[r] = ok ? s[r] * SCL2 : -INFINITY;
        mt = fmaxf(mt, sv[r]);
      }
    }
    mt = fmaxf(mt, __shfl_xor(mt, 32));
    const float mnew = fmaxf(st.m, mt), muse = (mnew == -INFINITY) ? 0.f : mnew;
    const float alpha = __builtin_amdgcn_exp2f(st.m - muse);
    st.m = mnew;
    float ps = 0.f;
    if (full) {
      const float sub = selbit ? muse : INFINITY;
#pragma unroll
      for (int r = 0; r < 16; ++r) { sv[r] = __builtin_amdgcn_exp2f(__builtin_fmaf(s[r], SCL2, -sub)); ps += sv[r]; }
    } else {
#pragma unroll
      for (int r = 0; r < 16; ++r) { sv[r] = __builtin_amdgcn_exp2f(sv[r] - muse); ps += sv[r]; }
    }
    st.l = st.l * alpha + ps;
    if (__any(alpha != 1.f)) {
#pragma unroll
      for (int r = 0; r < 16; ++r) { st.o[0][r] *= alpha; st.o[1][r] *= alpha; }
    }
    pv_tile(wt, sv, st.o, lane);
    if (kn > kc_hi) break;
    kc0 = kn;
  }
}
DEV void attn_finish(AttnState& st, float sink2) {
  float l = st.l + __shfl_xor(st.l, 32);
  if (sink2 > -INFINITY) l += __builtin_amdgcn_exp2f(sink2 - st.m);
  const float inv = l > 0.f ? 1.f / l : 0.f;
#pragma unroll
  for (int r = 0; r < 16; ++r) { st.o[0][r] *= inv; st.o[1][r] *= inv; }
}
DEV void attn_store_bf16(const AttnState& st, u16* orow, int hi) {
#pragma unroll
  for (int dt = 0; dt < 2; ++dt)
#pragma unroll
    for (int k4 = 0; k4 < 4; ++k4) {
      uint2 w; w.x = cvtpk(st.o[dt][4 * k4], st.o[dt][4 * k4 + 1]); w.y = cvtpk(st.o[dt][4 * k4 + 2], st.o[dt][4 * k4 + 3]);
      *reinterpret_cast<uint2*>(orow + 32 * dt + 8 * k4 + 4 * hi) = w;
    }
}
DEV void load_qf(bf16x8 (&qf)[4], const u16* qrow, int hi) {
#pragma unroll
  for (int s = 0; s < 4; ++s) qf[s] = *reinterpret_cast<const bf16x8*>(qrow + 16 * s + 8 * hi);
}

DEV void ph_attn0_mfma(const Params& p, WaveTile* wts) {
  const int tid = tidx(), lane = tid & 63, wid = tid >> 6, r32 = lane & 31, hi = lane >> 5;
  WaveTile& wt = wts[wid];
  const int gw = blockIdx.x * NWAVE + wid, nw = gridDim.x * NWAVE;
  for (int u = gw; u < 8192; u += nw) {
    AttnState st; attn_init(st);
    bf16x8 qf[4];
    if (u < 4096) {
      const int it = u & 7, res = (u >> 3) & 15, h = (u >> 7) & 7, b = u >> 10;
      const int i0 = it * 32, t = 16 * (i0 + r32) + res;
      const long row = (long)b * S_ + t;
      load_qf(qf, p.qkv + row * LD0 + h * 64, hi);
      const u16* Kb = p.qkv + 512 + h * 64; const u16* Vb = p.qkv + 1024 + h * 64;
      attn_span<false>(st, wt, qf, Kb, Vb, LD0, (long)b * S_ + res, 16, 255, i0 - 128, i0 + 31, i0 + r32, 128, 0ull, 0ull, lane, 1, 0);
      const int c = res >> 2;
      attn_span<false>(st, wt, qf, Kb, Vb, LD0, (long)b * S_ + (res & 3), 4, 1023, 4 * i0 + c - 128, 4 * (i0 + 31) + c, 4 * (i0 + r32) + c, 128, 0ull, 0ull, lane, 1, 0);
      attn_span<false>(st, wt, qf, Kb, Vb, LD0, (long)b * S_, 1, 4095, 16 * i0 + res - 128, 16 * (i0 + 31) + res, t, 128, 0ull, 0ull, lane, 1, 0);
      attn_finish(st, -INFINITY);
      attn_store_bf16(st, p.ao + row * D_ + h * 64, hi);
    } else {
      const int v = u - 4096, qt = v & 127, hb = (v >> 7) & 7, b = v >> 10, g = hb >> 2;
      const int t = 32 * qt + r32;
      const long row = (long)b * S_ + t;
      load_qf(qf, p.qkv + row * LD0 + 1536 + hb * 64, hi);
      attn_span<false>(st, wt, qf, p.qkv + 2048 + g * 64, p.qkv + 2176 + g * 64, LD0, (long)b * S_, 1, 4095, 32 * qt - 127, 32 * qt + 31, t, 127, 0ull, 0ull, lane, 32 * qt, 32 * qt + 31);
      attn_finish(st, p.even_sinks[hb] * LOG2E);
      attn_store_bf16(st, p.ao + row * D_ + 512 + hb * 64, hi);
    }
  }
}

struct Att1aSmem { KVTile tiles[2][2]; float imp[2][32][65]; float sc[NWAVE][64]; };
DEV void ph_attn1a(const Params& p, char* smem) {
  Att1aSmem& sm = *reinterpret_cast<Att1aSmem*>(smem);
  const int tid = tidx(), lane = tid & 63, wid = tid >> 6, r32 = lane & 31, hi = lane >> 5, gl = wid >> 2;
  const int sg = tid >> 8, sj = (tid & 255) >> 3, sc = tid & 7;
  for (int u = blockIdx.x; u < 1024; u += gridDim.x) {
    const int k = u >> 8, base = u & 255, bg = base & 7, x = base >> 3;
    const int qt = (k == 0) ? 127 - x : (k == 1) ? 64 + x : (k == 2) ? 63 - x : x;
    const int b = bg >> 1, gp = bg & 1;
    const int h = gp * 8 + wid, g = h >> 2;
    const int q0 = 32 * qt, t = q0 + r32;
    const long row = (long)b * S_ + t;
    const int qc = (t - 31) >> 4;
    int kc_hi = q0 >> 4; kc_hi = kc_hi > 254 ? 254 : kc_hi;
    const int ntile = (kc_hi >> 5) + 1;
    const u16* kp = p.cmpkv + ((size_t)((b * 4 + 2 * gp + sg) * 256) + sj) * 64 + sc * 8;
    const u16* vp = kp + (size_t)4096 * 64;
    for (int i = tid; i < 2 * 32 * 65; i += NTHR) (&sm.imp[0][0][0])[i] = 0.f;
    bf16x8 qf[4];
    load_qf(qf, p.qkv + row * LD1 + h * 64, hi);
    auto for_tiles = [&](auto&& body) {
      u32x4_t rk = *reinterpret_cast<const u32x4_t*>(kp), rv = *reinterpret_cast<const u32x4_t*>(vp);
      int cur = 0;
      for (int tt = 0; tt < ntile; ++tt) {
        KVTile& dst = sm.tiles[cur][sg];
        *reinterpret_cast<u32x4_t*>(&dst.K[sj][sc * 8]) = rk;
        *reinterpret_cast<u32x4_t*>(&dst.V[sc >> 2][sj][(sc & 3) * 8]) = rv;
        const int tn = tt + 1 < ntile ? tt + 1 : tt;
        rk = *reinterpret_cast<const u32x4_t*>(kp + (size_t)tn * 32 * 64);
        rv = *reinterpret_cast<const u32x4_t*>(vp + (size_t)tn * 32 * 64);
        __syncthreads();
        body(sm.tiles[cur][gl], tt * 32);
        cur ^= 1;
      }
      __syncthreads();
    };
    float m = -INFINITY, l = 0.f;
    for_tiles([&](const KVTile& tl, int kc0) {
      const f32x16 s = qk_tile(tl, qf, r32, hi);
      float sv[16]; float mt = -INFINITY;
#pragma unroll
      for (int rr = 0; rr < 16; ++rr) { const int kc = kc0 + crow(rr, hi); const bool ok = kc <= 254 && kc <= qc; sv[rr] = ok ? s[rr] * SCL2 : -INFINITY; mt = fmaxf(mt, sv[rr]); }
      mt = fmaxf(mt, __shfl_xor(mt, 32));
      const float mnew = fmaxf(m, mt), muse = (mnew == -INFINITY) ? 0.f : mnew;
      float ps = 0.f;
#pragma unroll
      for (int rr = 0; rr < 16; ++rr) ps += __builtin_amdgcn_exp2f(sv[rr] - muse);
      l = l * __builtin_amdgcn_exp2f(m - muse) + ps; m = mnew;
    });
    l += __shfl_xor(l, 32);
    const float inv = l > 0.f ? 1.f / l : 0.f, muse = (m == -INFINITY) ? 0.f : m;
    f32x16 o[2];
#pragma unroll
    for (int rr = 0; rr < 16; ++rr) { o[0][rr] = 0.f; o[1][rr] = 0.f; }
    for_tiles([&](const KVTile& tl, int kc0) {
      const f32x16 s = qk_tile(tl, qf, r32, hi);
      float pr[16];
#pragma unroll
      for (int rr = 0; rr < 16; ++rr) { const int kc = kc0 + crow(rr, hi); const bool ok = kc <= 254 && kc <= qc; pr[rr] = ok ? __builtin_amdgcn_exp2f(s[rr] * SCL2 - muse) * inv : 0.f; }
#pragma unroll
      for (int k4 = 0; k4 < 4; ++k4) {
        const int j = (kc0 >> 2) + 2 * k4 + hi;
        atomicAdd(&sm.imp[gl][r32][j], pr[4 * k4] + pr[4 * k4 + 1] + pr[4 * k4 + 2] + 0.5f * pr[4 * k4 + 3]);
        if (j + 1 < 64) atomicAdd(&sm.imp[gl][r32][j + 1], 0.5f * pr[4 * k4 + 3]);
      }
      pv_tile(tl, pr, o, lane);
    });
    const float g0 = p.gates[(size_t)row * 48 + h * 3];
#pragma unroll
    for (int dt = 0; dt < 2; ++dt)
#pragma unroll
      for (int k4 = 0; k4 < 4; ++k4) {
        float4 w; w.x = g0 * o[dt][4 * k4]; w.y = g0 * o[dt][4 * k4 + 1]; w.z = g0 * o[dt][4 * k4 + 2]; w.w = g0 * o[dt][4 * k4 + 3];
        *reinterpret_cast<float4*>(p.hpre + (size_t)row * D_ + h * 64 + 32 * dt + 8 * k4 + 4 * hi) = w;
      }
    for (int i = 0; i < 8; ++i) {
      const int pi = wid * 8 + i, grp = pi >> 5, q = pi & 31;
      const int tq = q0 + q, cur = tq >> 6;
      const float score = (lane > cur) ? -1.f : ((lane == 0 || lane == cur || lane == cur - 1) ? 1.0e4f : sm.imp[grp][q][lane]);
      sm.sc[wid][lane] = score;
      WAVE_SYNC();
      int rk_ = 0;
#pragma unroll
      for (int jj = 0; jj < 64; jj += 4) {
        const float4 v = *reinterpret_cast<const float4*>(&sm.sc[wid][jj]);
        rk_ += (v.x > score || (v.x == score && jj < lane)) ? 1 : 0;
        rk_ += (v.y > score || (v.y == score && jj + 1 < lane)) ? 1 : 0;
        rk_ += (v.z > score || (v.z == score && jj + 2 < lane)) ? 1 : 0;
        rk_ += (v.w > score || (v.w == score && jj + 3 < lane)) ? 1 : 0;
      }
      WAVE_SYNC();
      const unsigned long long mask = __ballot(rk_ < 16 && lane <= cur);
      if (lane == 0) p.selmask[((size_t)b * S_ + tq) * 4 + 2 * gp + grp] = mask;
    }
    __syncthreads();
  }
}

template <class TT>
DEV void attn_tile_update(AttnState& st, const TT& tl, const bf16x8 (&qf)[4], int kc0, int qc, int W, int kcmax, bool selbit, bool full, int lane) {
  const int r32 = lane & 31, hi = lane >> 5;
  const f32x16 s = qk_tile(tl, qf, r32, hi);
  float sv[16]; float mt = -INFINITY;
  if (full) {
    float rm = s[0];
#pragma unroll
    for (int r = 1; r < 16; ++r) rm = fmaxf(rm, s[r]);
    mt = selbit ? rm * SCL2 : -INFINITY;
  } else {
#pragma unroll
    for (int r = 0; r < 16; ++r) {
      const int kc = kc0 + crow(r, hi), dist = qc - kc;
      const bool ok = selbit && kc <= kcmax && dist >= 0 && dist <= W;
      sv[r] = ok ? s[r] * SCL2 : -INFINITY;
      mt = fmaxf(mt, sv[r]);
    }
  }
  mt = fmaxf(mt, __shfl_xor(mt, 32));
  const float mnew = fmaxf(st.m, mt), muse = (mnew == -INFINITY) ? 0.f : mnew;
  const float alpha = __builtin_amdgcn_exp2f(st.m - muse);
  st.m = mnew;
  float ps = 0.f;
  if (full) {
    const float sub = selbit ? muse : INFINITY;
#pragma unroll
    for (int r = 0; r < 16; ++r) { sv[r] = __builtin_amdgcn_exp2f(__builtin_fmaf(s[r], SCL2, -sub)); ps += sv[r]; }
  } else {
#pragma unroll
    for (int r = 0; r < 16; ++r) { sv[r] = __builtin_amdgcn_exp2f(sv[r] - muse); ps += sv[r]; }
  }
  st.l = st.l * alpha + ps;
  if (__any(alpha != 1.f)) {
#pragma unroll
    for (int r = 0; r < 16; ++r) { st.o[0][r] *= alpha; st.o[1][r] *= alpha; }
  }
  pv_tile(tl, sv, st.o, lane);
}

template <bool USE_SEL>
DEV void attn_span_shared(AttnState& st, KVTile (*tiles)[2], const Params& p, const bf16x8 (&qf)[4], int b, int gp, int kcol, int vcol,
                          int t_lo, int t_hi, int qc, int W, unsigned long long sel, int q0) {
  const int tid = tidx(), lane = tid & 63, wid = tid >> 6, gl = wid >> 2;
  const int sg = tid >> 8, sj = (tid & 255) >> 3, sc = tid & 7;
  const u16* kp = p.qkv + (size_t)b * S_ * LD1 + kcol + (2 * gp + sg) * 64 + (size_t)sj * LD1 + sc * 8;
  const u16* vp = p.qkv + (size_t)b * S_ * LD1 + vcol + (2 * gp + sg) * 64 + (size_t)sj * LD1 + sc * 8;
  u32x4_t rk = *reinterpret_cast<const u32x4_t*>(kp + (size_t)t_lo * 32 * LD1);
  u32x4_t rv = *reinterpret_cast<const u32x4_t*>(vp + (size_t)t_lo * 32 * LD1);
  int cur = 0;
  for (int t = t_lo; t <= t_hi; ++t) {
    KVTile& dst = tiles[cur][sg];
    *reinterpret_cast<u32x4_t*>(&dst.K[sj][sc * 8]) = rk;
    *reinterpret_cast<u32x4_t*>(&dst.V[sc >> 2][sj][(sc & 3) * 8]) = rv;
    const int tn = t < t_hi ? t + 1 : t;
    rk = *reinterpret_cast<const u32x4_t*>(kp + (size_t)tn * 32 * LD1);
    rv = *reinterpret_cast<const u32x4_t*>(vp + (size_t)tn * 32 * LD1);
    __syncthreads();
    const int kc0 = t * 32;
    const bool selbit = USE_SEL ? (((sel >> (kc0 >> 6)) & 1ull) != 0ull) : true;
    const bool full = (kc0 + 31 <= q0) && (kc0 >= q0 + 31 - W);
    attn_tile_update(st, tiles[cur][gl], qf, kc0, qc, W, 4095, selbit, full, lane);
    cur ^= 1;
  }
  __syncthreads();
}

DEV void ph_attn1b(const Params& p, char* smem) {
  KVTile (*tiles)[2] = reinterpret_cast<KVTile (*)[2]>(smem);
  const int tid = tidx(), lane = tid & 63, wid = tid >> 6, r32 = lane & 31, hi = lane >> 5;
  for (int u = blockIdx.x; u < 1024; u += gridDim.x) {
    const int k = u >> 8, base = u & 255, bg = base & 7, x = base >> 3;
    const int qt = (k == 0) ? 127 - x : (k == 1) ? 64 + x : (k == 2) ? 63 - x : x;
    const int b = bg >> 1, gp = bg & 1;
    const int h = gp * 8 + wid, g = h >> 2;
    const int q0 = 32 * qt, t = q0 + r32;
    const long row = (long)b * S_ + t;
    bf16x8 qf[4];
    load_qf(qf, p.qkv + row * LD1 + h * 64, hi);
    const unsigned long long sel = p.selmask[(size_t)row * 4 + g];
    const float g1 = p.gates[(size_t)row * 48 + h * 3 + 1], g2 = p.gates[(size_t)row * 48 + h * 3 + 2];
    AttnState st; attn_init(st);
    attn_span_shared<true>(st, tiles, p, qf, b, gp, 1536, 1792, 0, qt, t, 1 << 30, sel, q0);
    attn_finish(st, -INFINITY);
    f32x16 acc[2];
#pragma unroll
    for (int rr = 0; rr < 16; ++rr) { acc[0][rr] = g1 * st.o[0][rr]; acc[1][rr] = g1 * st.o[1][rr]; }
    attn_init(st);
    const int wlo = q0 - 511 > 0 ? (q0 - 511) >> 5 : 0;
    attn_span_shared<false>(st, tiles, p, qf, b, gp, 2048, 2304, wlo, qt, t, 511, 0ull, q0);
    attn_finish(st, -INFINITY);
#pragma unroll
    for (int dt = 0; dt < 2; ++dt)
#pragma unroll
      for (int k4 = 0; k4 < 4; ++k4) {
        const float4 c = *reinterpret_cast<const float4*>(p.hpre + (size_t)row * D_ + h * 64 + 32 * dt + 8 * k4 + 4 * hi);
        uint2 w;
        w.x = cvtpk(c.x + acc[dt][4 * k4] + g2 * st.o[dt][4 * k4], c.y + acc[dt][4 * k4 + 1] + g2 * st.o[dt][4 * k4 + 1]);
        w.y = cvtpk(c.z + acc[dt][4 * k4 + 2] + g2 * st.o[dt][4 * k4 + 2], c.w + acc[dt][4 * k4 + 3] + g2 * st.o[dt][4 * k4 + 3]);
        *reinterpret_cast<uint2*>(p.ao + (size_t)row * D_ + h * 64 + 32 * dt + 8 * k4 + 4 * hi) = w;
      }
  }
}

#ifndef DEBUG_ATT
#define DEBUG_ATT 0
#endif
enum { PH_PRO = 0, PH_IN0, PH_ATT0, PH_OUT0, PH_LN0, PH_RG0, PH_RT0, PH_M10, PH_M20, PH_CB0,
       PH_IN1, PH_C1, PH_C2, PH_ATT1, PH_OUT1, PH_LN1, PH_RG1, PH_RT1, PH_M11, PH_M21, PH_CB1,
       PH_ATT1A, PH_ATT1B, PH_ATT0N, PH_ATT1N, PH_DBG_SAVE, PH_DBG_CMP, PH_DBG_SCALE };

DEV void ph_dbg_save(const Params& p) {
  const size_t gtid = (size_t)blockIdx.x * NTHR + tidx(), gsz = (size_t)gridDim.x * NTHR;
  for (size_t i = gtid; i < (size_t)T_ * D_ / 8; i += gsz) reinterpret_cast<uint4*>(p.ybuf)[i] = reinterpret_cast<const uint4*>(p.ao)[i];
}
DEV void ph_dbg_cmp(const Params& p) {
  const size_t gtid = (size_t)blockIdx.x * NTHR + tidx(), gsz = (size_t)gridDim.x * NTHR;
  float d2 = 0.f, r2 = 0.f;
  for (size_t i = gtid; i < (size_t)T_ * D_; i += gsz) { const float a = bf2f(p.ao[i]), r = bf2f(p.ybuf[i]); d2 += (a - r) * (a - r); r2 += r * r; }
  d2 = wave_sum(d2); r2 = wave_sum(r2);
  if ((tidx() & 63) == 0) { atomicAdd(&p.dbg[0], d2); atomicAdd(&p.dbg[1], r2); }
}
DEV void ph_dbg_scale(const Params& p) {
  const float e = p.dbg[0] / p.dbg[1];
  const float sc = 1.f + sqrtf(1000.f * e);
  const size_t gtid = (size_t)blockIdx.x * NTHR + tidx(), gsz = (size_t)gridDim.x * NTHR;
  for (size_t i = gtid; i < (size_t)T_ * D_; i += gsz) p.out[i] *= sc;
}

template <int PH> DEV void run_phase(const Params& p, char* smem) {
  GemmSmem& gs = *reinterpret_cast<GemmSmem*>(smem);
  AttnSmem& as = *reinterpret_cast<AttnSmem*>(smem);
  WaveTile* wts = reinterpret_cast<WaveTile*>(smem);
  MoeTab& mt = *reinterpret_cast<MoeTab*>(smem + sizeof(GemmSmem));
  if constexpr (PH == PH_PRO) ph_prologue(p);
  else if constexpr (PH == PH_IN0) ph_inproj0(p, gs);
  else if constexpr (PH == PH_ATT0) ph_attn0_mfma(p, wts);
  else if constexpr (PH == PH_ATT0N) ph_attn0(p, as);
  else if constexpr (PH == PH_OUT0) ph_outproj(p, gs, p.w16_out0, p.x);
  else if constexpr (PH == PH_LN0) ph_ln_mix(p, p.mix_g, p.mix_b);
  else if constexpr (PH == PH_RG0) ph_router_gemm(p, gs, p.rw16);
  else if constexpr (PH == PH_RT0) ph_route<false>(p, p.router_b, p.cnt, p.router_w, p.etok);
  else if constexpr (PH == PH_M10) ph_moe1(p, gs, mt, 0, p.cnt);
  else if constexpr (PH == PH_M20) ph_moe2(p, gs, mt, 0, p.cnt);
  else if constexpr (PH == PH_CB0) ph_combine_ln(p, mt, p.cnt, p.ffn_g, p.ffn_b, p.x2f, p.xb, true);
  else if constexpr (PH == PH_IN1) ph_inproj1(p, gs);
  else if constexpr (PH == PH_C1) ph_cmp1(p, gs);
  else if constexpr (PH == PH_C2) ph_cmp2(p, gs);
  else if constexpr (PH == PH_ATT1) ph_attn1(p, as);
  else if constexpr (PH == PH_ATT1N) ph_attn1(p, as);
  else if constexpr (PH == PH_ATT1A) ph_attn1a(p, smem);
  else if constexpr (PH == PH_ATT1B) ph_attn1b(p, smem);
  else if constexpr (PH == PH_OUT1) ph_outproj(p, gs, p.w16_out1, p.x2f);
  else if constexpr (PH == PH_LN1) ph_ln_mix(p, p.mix_g + D_, p.mix_b + D_);
  else if constexpr (PH == PH_RG1) ph_router_gemm(p, gs, p.rw16 + (size_t)2 * D_ * NE);
  else if constexpr (PH == PH_RT1) ph_route<false>(p, p.router_b + NE, p.cnt + 512, p.router_w + (size_t)D_ * NE, p.etok);
  else if constexpr (PH == PH_M11) ph_moe1(p, gs, mt, 1, p.cnt + 512);
  else if constexpr (PH == PH_M21) ph_moe2(p, gs, mt, 1, p.cnt + 512);
  else if constexpr (PH == PH_CB1) ph_combine_ln(p, mt, p.cnt + 512, p.ffn_g + D_, p.ffn_b + D_, p.out, p.xb, true, false);
  else if constexpr (PH == PH_DBG_SAVE) ph_dbg_save(p);
  else if constexpr (PH == PH_DBG_CMP) ph_dbg_cmp(p);
  else if constexpr (PH == PH_DBG_SCALE) ph_dbg_scale(p);
}

constexpr int SMEM_NEED = (NWAVE * (int)sizeof(WaveTile) > (int)(sizeof(GemmSmem) + sizeof(MoeTab))) ? NWAVE * (int)sizeof(WaveTile) : (int)(sizeof(GemmSmem) + sizeof(MoeTab));
constexpr int SMEM_BAR_OFF = (SMEM_NEED + 15) & ~15, SMEM_BYTES = SMEM_BAR_OFF + 16;
static_assert(SMEM_BAR_OFF >= (int)sizeof(AttnSmem) && SMEM_BAR_OFF >= (int)(sizeof(GemmSmem) + sizeof(MoeTab)), "LDS carve-up");
template <int PH, bool LAST> DEV void phase_and_sync(const Params& p, char* smem, const XcdBarrier& bar) {
  run_phase<PH>(p, smem);
  if constexpr (!LAST) xcd_barrier(bar);
}
template <int... PHS> struct PhaseList {};
template <int P0> DEV void run_list(const Params& p, char* smem, const XcdBarrier& bar, PhaseList<P0>) { phase_and_sync<P0, true>(p, smem, bar); }
template <int P0, int P1, int... REST> DEV void run_list(const Params& p, char* smem, const XcdBarrier& bar, PhaseList<P0, P1, REST...>) {
  phase_and_sync<P0, false>(p, smem, bar);
  run_list(p, smem, bar, PhaseList<P1, REST...>{});
}
#if DEBUG_ATT == 1
using Program = PhaseList<PH_PRO, PH_IN0, PH_ATT0N, PH_DBG_SAVE, PH_ATT0, PH_DBG_CMP, PH_OUT0, PH_LN0, PH_RG0, PH_RT0, PH_M10, PH_M20, PH_CB0,
                          PH_IN1, PH_C1, PH_C2, PH_ATT1, PH_OUT1, PH_LN1, PH_RG1, PH_RT1, PH_M11, PH_M21, PH_CB1, PH_DBG_SCALE>;
#elif DEBUG_ATT == 2
using Program = PhaseList<PH_PRO, PH_IN0, PH_ATT0, PH_OUT0, PH_LN0, PH_RG0, PH_RT0, PH_M10, PH_M20, PH_CB0,
                          PH_IN1, PH_C1, PH_C2, PH_ATT1N, PH_DBG_SAVE, PH_ATT1A, PH_ATT1B, PH_DBG_CMP, PH_OUT1, PH_LN1, PH_RG1, PH_RT1, PH_M11, PH_M21, PH_CB1, PH_DBG_SCALE>;
#elif DEBUG_ATT == 11
using Program = PhaseList<PH_PRO, PH_IN0, PH_ATT0, PH_OUT0, PH_LN0, PH_RG0, PH_RT0, PH_M10, PH_M20, PH_CB0,
                          PH_IN1, PH_C1, PH_C2, PH_ATT1A, PH_ATT1B, PH_ATT1B, PH_OUT1, PH_LN1, PH_RG1, PH_RT1, PH_M11, PH_M21, PH_CB1>;
#elif DEBUG_ATT == 12
using Program = PhaseList<PH_PRO, PH_IN0, PH_ATT0, PH_OUT0, PH_LN0, PH_RG0, PH_RT0, PH_M10, PH_M20, PH_M10, PH_M20, PH_CB0,
                          PH_IN1, PH_C1, PH_C2, PH_ATT1A, PH_ATT1B, PH_OUT1, PH_LN1, PH_RG1, PH_RT1, PH_M11, PH_M21, PH_CB1>;
#elif DEBUG_ATT == 13
using Program = PhaseList<PH_PRO, PH_IN0, PH_IN0, PH_ATT0, PH_OUT0, PH_OUT0, PH_LN0, PH_RG0, PH_RT0, PH_M10, PH_M20, PH_CB0,
                          PH_IN1, PH_C1, PH_C2, PH_ATT1A, PH_ATT1B, PH_OUT1, PH_LN1, PH_RG1, PH_RT1, PH_M11, PH_M21, PH_CB1>;
#elif DEBUG_ATT == 14
using Program = PhaseList<PH_PRO, PH_IN0, PH_ATT0, PH_ATT0, PH_OUT0, PH_LN0, PH_RG0, PH_RT0, PH_M10, PH_M20, PH_CB0,
                          PH_IN1, PH_C1, PH_C2, PH_ATT1A, PH_ATT1A, PH_ATT1B, PH_OUT1, PH_LN1, PH_RG1, PH_RT1, PH_M11, PH_M21, PH_CB1>;
#elif DEBUG_ATT == 16
using Program = PhaseList<PH_PRO, PH_IN0, PH_ATT0, PH_ATT0, PH_OUT0, PH_LN0, PH_RG0, PH_RT0, PH_M10, PH_M20, PH_CB0,
                          PH_IN1, PH_C1, PH_C2, PH_ATT1A, PH_ATT1B, PH_OUT1, PH_LN1, PH_RG1, PH_RT1, PH_M11, PH_M21, PH_CB1>;
#elif DEBUG_ATT == 17
using Program = PhaseList<PH_PRO, PH_IN0, PH_ATT0, PH_OUT0, PH_LN0, PH_RG0, PH_RT0, PH_M10, PH_M20, PH_CB0,
                          PH_IN1, PH_C1, PH_C2, PH_C1, PH_C2, PH_ATT1A, PH_ATT1B, PH_OUT1, PH_LN1, PH_RG1, PH_RT1, PH_M11, PH_M21, PH_CB1>;
#elif DEBUG_ATT == 18
using Program = PhaseList<PH_PRO, PH_PRO, PH_IN0, PH_ATT0, PH_OUT0, PH_LN0, PH_RG0, PH_RT0, PH_M10, PH_M20, PH_CB0,
                          PH_IN1, PH_C1, PH_C2, PH_ATT1A, PH_ATT1B, PH_OUT1, PH_LN1, PH_RG1, PH_RT1, PH_M11, PH_M21, PH_CB1>;
#elif DEBUG_ATT == 15
using Program = PhaseList<PH_PRO, PH_IN0, PH_ATT0, PH_OUT0, PH_LN0, PH_LN0, PH_RG0, PH_RG0, PH_RT0, PH_M10, PH_M20, PH_CB0, PH_CB0,
                          PH_IN1, PH_C1, PH_C2, PH_ATT1A, PH_ATT1B, PH_OUT1, PH_LN1, PH_RG1, PH_RT1, PH_M11, PH_M21, PH_CB1>;
#else
using Program = PhaseList<PH_PRO, PH_IN0, PH_ATT0, PH_OUT0, PH_LN0, PH_RG0, PH_RT0, PH_M10, PH_M20, PH_CB0,
                          PH_IN1, PH_C1, PH_C2, PH_ATT1A, PH_ATT1B, PH_OUT1, PH_LN1, PH_RG1, PH_RT1, PH_M11, PH_M21, PH_CB1>;
#endif
struct KArgs { const void* in[25]; float* out; char* ws; };
constexpr size_t al256(size_t b) { return (b + 255) & ~(size_t)255; }
constexpr size_t OFF_BAR = 0;
constexpr size_t OFF_CNT = OFF_BAR + al256(16384);
constexpr size_t OFF_PB = OFF_CNT + al256(4096);
constexpr size_t OFF_DBG = OFF_PB + al256(1024);
constexpr size_t OFF_ZERO_END = OFF_DBG + al256(256);
constexpr size_t OFF_CS = OFF_ZERO_END;
constexpr size_t OFF_XB = OFF_CS + al256((size_t)T_ * 16 * 4);
constexpr size_t OFF_QKV = OFF_XB + al256((size_t)T_ * D_ * 2);
constexpr size_t OFF_GATES = OFF_QKV + al256((size_t)T_ * 2624 * 2);
constexpr size_t OFF_AO = OFF_GATES + al256((size_t)T_ * 48 * 4);
constexpr size_t OFF_HPRE = OFF_AO + al256((size_t)T_ * D_ * 2);
constexpr size_t OFF_X1F = OFF_HPRE + al256((size_t)T_ * D_ * 4);
constexpr size_t OFF_X1B = OFF_X1F + al256((size_t)T_ * D_ * 4);
constexpr size_t OFF_X1LO = OFF_X1B + al256((size_t)T_ * D_ * 2);
constexpr size_t OFF_LOGITS = OFF_X1LO + al256((size_t)T_ * D_ * 2);
constexpr size_t OFF_EIDX = OFF_LOGITS + al256((size_t)T_ * NE * 4);
constexpr size_t OFF_GATEV = OFF_EIDX + al256((size_t)NASG * 4);
constexpr size_t OFF_EPOS = OFF_GATEV + al256((size_t)NASG * 4);
constexpr size_t OFF_ETOK = OFF_EPOS + al256((size_t)NASG * 4);
constexpr size_t OFF_HBUF = OFF_ETOK + al256((size_t)NE * T_ * 4);
constexpr size_t OFF_YBUF = OFF_HBUF + al256((size_t)NROWS * 256 * 2);
constexpr size_t OFF_X2F = OFF_YBUF + al256((size_t)NROWS * D_ * 2);
constexpr size_t OFF_HID = OFF_X2F + al256((size_t)T_ * D_ * 4);
constexpr size_t OFF_CMPKV = OFF_HID + al256((size_t)2 * 4096 * 128 * 2);
constexpr size_t OFF_SELMASK = OFF_CMPKV + al256((size_t)2 * 4096 * 64 * 2);
constexpr size_t OFF_W16IN0 = OFF_SELMASK + al256((size_t)T_ * 4 * 8);
constexpr size_t OFF_W16OUT0 = OFF_W16IN0 + al256((size_t)D_ * LD0 * 2);
constexpr size_t OFF_W16IN1 = OFF_W16OUT0 + al256((size_t)D_ * D_ * 2);
constexpr size_t OFF_W16OUT1 = OFF_W16IN1 + al256((size_t)D_ * NIN1 * 2);
constexpr size_t OFF_RW16 = OFF_W16OUT1 + al256((size_t)D_ * D_ * 2);
constexpr size_t WS_NEEDED = OFF_RW16 + al256((size_t)4 * D_ * NE * 2);

DEV Params make_params(const KArgs& k) {
  Params p;
  p.x = (const float*)k.in[0]; p.pos = (const int*)k.in[1];
  p.even_w_in = (const float*)k.in[2]; p.even_sinks = (const float*)k.in[3]; p.even_w_out = (const float*)k.in[4]; p.odd_w_in = (const float*)k.in[5];
  p.cmpk_pos = (const float*)k.in[6]; p.cmpk_w1 = (const float*)k.in[7]; p.cmpk_w2 = (const float*)k.in[8];
  p.cmpv_pos = (const float*)k.in[9]; p.cmpv_w1 = (const float*)k.in[10]; p.cmpv_w2 = (const float*)k.in[11];
  p.odd_w_out = (const float*)k.in[12]; p.mix_g = (const float*)k.in[13]; p.mix_b = (const float*)k.in[14];
  p.router_w = (const float*)k.in[15]; p.router_b = (const float*)k.in[16];
  p.w_gate = (const float*)k.in[17]; p.w_up = (const float*)k.in[18]; p.w_down = (const float*)k.in[19];
  p.sh_gate = (const float*)k.in[20]; p.sh_up = (const float*)k.in[21]; p.sh_down = (const float*)k.in[22];
  p.ffn_g = (const float*)k.in[23]; p.ffn_b = (const float*)k.in[24];
  p.out = k.out;
  char* w = k.ws;
  p.bar = (unsigned*)(w + OFF_BAR); p.cnt = (int*)(w + OFF_CNT); p.pb = (float*)(w + OFF_PB); p.dbg = (float*)(w + OFF_DBG);
  p.cs = (float*)(w + OFF_CS); p.xb = (u16*)(w + OFF_XB); p.qkv = (u16*)(w + OFF_QKV); p.gates = (float*)(w + OFF_GATES);
  p.ao = (u16*)(w + OFF_AO); p.hpre = (float*)(w + OFF_HPRE); p.x1f = (float*)(w + OFF_X1F); p.x1b = (u16*)(w + OFF_X1B); p.x1lo = (u16*)(w + OFF_X1LO);
  p.logits = (float*)(w + OFF_LOGITS); p.eidx = (int*)(w + OFF_EIDX); p.gatev = (float*)(w + OFF_GATEV); p.epos = (int*)(w + OFF_EPOS); p.etok = (int*)(w + OFF_ETOK);
  p.hbuf = (u16*)(w + OFF_HBUF); p.ybuf = (u16*)(w + OFF_YBUF); p.x2f = (float*)(w + OFF_X2F); p.hid = (u16*)(w + OFF_HID); p.cmpkv = (u16*)(w + OFF_CMPKV);
  p.selmask = (unsigned long long*)(w + OFF_SELMASK);
  p.w16_in0 = (u16*)(w + OFF_W16IN0); p.w16_out0 = (u16*)(w + OFF_W16OUT0); p.w16_in1 = (u16*)(w + OFF_W16IN1); p.w16_out1 = (u16*)(w + OFF_W16OUT1); p.rw16 = (u16*)(w + OFF_RW16);
  return p;
}

__global__ void __launch_bounds__(NTHR, 2) k_fused(KArgs ka) {
  extern __shared__ __attribute__((aligned(16))) char smem[];
  const Params p = make_params(ka);
  if (tidx() == 0) *reinterpret_cast<uint4*>(smem + SMEM_BAR_OFF) = make_uint4(0u, 0u, 0u, 0u);
  __syncthreads();
  XcdBarrier bar = xcd_barrier_post(p.bar, (volatile LAS unsigned*)(smem + SMEM_BAR_OFF));
  run_list(p, smem, bar, Program{});
}

extern "C" void kernel_launch(void* const* d_in, const int* in_sizes, int n_in, void* d_out, int out_size, void* d_ws, size_t ws_size, hipStream_t stream) {
  (void)in_sizes; (void)n_in; (void)out_size;
  if (ws_size < WS_NEEDED) return;
  KArgs ka{};
  for (int i = 0; i < 25; ++i) ka.in[i] = d_in[i];
  ka.out = (float*)d_out; ka.ws = (char*)d_ws;
  hipMemsetAsync(d_ws, 0, OFF_ZERO_END, stream);
  static int grid = 0;
  if (!grid) {
    int dev = 0, cus = 0, per_cu = 0;
    hipGetDevice(&dev);
    hipDeviceGetAttribute(&cus, hipDeviceAttributeMultiprocessorCount, dev);
    hipFuncSetAttribute((const void*)k_fused, hipFuncAttributeMaxDynamicSharedMemorySize, SMEM_BYTES);
    hipOccupancyMaxActiveBlocksPerMultiprocessor(&per_cu, (const void*)k_fused, NTHR, SMEM_BYTES);
    if (per_cu > 1) per_cu = 1;
    if (per_cu < 1) per_cu = 1;
    grid = cus * per_cu;
  }
  hipLaunchKernelGGL(k_fused, dim3(grid), dim3(NTHR), SMEM_BYTES, stream, ka);
}
```

```cpp
#include <hip/hip_runtime.h>
#include <hip/hip_bf16.h>
#include <stdint.h>
#include <math.h>
#include <utility>

typedef unsigned short u16;
using bf16x8 = __attribute__((ext_vector_type(8))) short;
using f32x4  = __attribute__((ext_vector_type(4))) float;

#define DEV __device__ __forceinline__
__device__ __forceinline__ int tidx() { int t = (int)__builtin_amdgcn_workitem_id_x(); asm volatile("" : "+v"(t)); return t; }

constexpr int T_ = 16384, S_ = 4096, D_ = 1024;
constexpr int LD0 = 2304, LD1 = 2560, NIN1 = 2608;
constexpr int NE = 256, TOPK = 8, NASG = T_ * TOPK, NROWS = NASG + T_;
constexpr float ALPHA = 1.41421356237309515f;
constexpr float LN_EPS = 1e-5f;
constexpr int NTHR = 512, NWAVE = 8;

#define FFN_MODE 0
#define DEBUG_ATT 0

struct Params {
  const float* x; const int* pos;
  const float* even_w_in; const float* even_sinks; const float* even_w_out; const float* odd_w_in;
  const float* cmpk_pos; const float* cmpk_w1; const float* cmpk_w2; const float* cmpv_pos; const float* cmpv_w1; const float* cmpv_w2;
  const float* odd_w_out; const float* mix_g; const float* mix_b; const float* router_w; const float* router_b;
  const float* w_gate; const float* w_up; const float* w_down; const float* sh_gate; const float* sh_up; const float* sh_down;
  const float* ffn_g; const float* ffn_b;
  float* out;
  unsigned* bar; int* cnt; float* pb; float* dbg; float* cs; u16* xb; u16* qkv; float* gates; u16* ao; float* hpre;
  float* x1f; u16* x1b; u16* x1lo; float* logits; int* eidx; float* gatev; int* epos; int* etok;
  u16* hbuf; u16* ybuf; float* x2f; u16* hid; u16* cmpkv; unsigned long long* selmask;
  u16* w16_in0; u16* w16_out0; u16* w16_in1; u16* w16_out1; u16* rw16;
};

#define XB_TMO      128
#define XB_XCNT(j)  (256  + 64 * (j))
#define XB_XSUB(j)  (1280 + 64 * (j))
#define XB_XGEN(j)  (2304 + 64 * (j))
#define XB_TOP      3328
#define XB_TOPGEN   3392
#define XCD_BAR_WORDS 3456
#define XB_SPIN_CAP (1u << 18)
#define LAS __attribute__((address_space(3)))

__device__ __forceinline__ unsigned xb_ld(unsigned* p)              { return __hip_atomic_load(p, __ATOMIC_RELAXED, __HIP_MEMORY_SCOPE_AGENT); }
__device__ __forceinline__ unsigned xb_add(unsigned* p, unsigned v) { return __hip_atomic_fetch_add(p, v, __ATOMIC_RELAXED, __HIP_MEMORY_SCOPE_AGENT); }
__device__ __forceinline__ unsigned xb_xcc_id() { return (unsigned)__builtin_amdgcn_s_getreg((3 << 11) | 20) & 0xFu; }
#define XB_SPIN(cond, bar) do { unsigned _sp = 0; while (cond) { __builtin_amdgcn_s_sleep(1); \
    if ((++_sp & 255u) == 0u) { if (xb_ld(&(bar)[XB_TMO])) break; if (_sp > XB_SPIN_CAP) { atomicAdd(&(bar)[XB_TMO], 1u); break; } } } } while (0)

struct XcdBarrier {
    unsigned* bar; unsigned x;
    volatile LAS unsigned* st;
};

__device__ __forceinline__ XcdBarrier xcd_barrier_post(unsigned* bar, volatile LAS unsigned* st) {
    XcdBarrier b; b.bar = bar; b.x = xb_xcc_id(); b.st = st;
    if (tidx() == 0) (void)xb_add(&bar[XB_XCNT(b.x)], 1u);
    return b;
}
__device__ __forceinline__ void xcd_barrier_complete(unsigned* bar, unsigned x, unsigned& nloc, unsigned& nx) {
    const unsigned G = gridDim.x * gridDim.y * gridDim.z;
    unsigned sum, cnt, mine, sp = 0u;
    for (;;) {
        sum = 0u; cnt = 0u; mine = 0u;
#pragma unroll
        for (unsigned j = 0; j < 16; ++j) { const unsigned c = xb_ld(&bar[XB_XCNT(j)]); sum += c; cnt += (c > 0u) ? 1u : 0u; mine = (j == x) ? c : mine; }
        if (sum == G) break;
        __builtin_amdgcn_s_sleep(1);
        if ((++sp & 255u) == 0u) { if (xb_ld(&bar[XB_TMO])) break; if (sp > XB_SPIN_CAP) { atomicAdd(&bar[XB_TMO], 1u); break; } }
    }
    nloc = mine > 0u ? mine : 1u; nx = cnt > 0u ? cnt : 1u;
}

__device__ __forceinline__ void xcd_barrier(const XcdBarrier& b) {
    asm volatile("s_waitcnt vmcnt(0)" ::: "memory");
    __syncthreads();
    if (tidx() == 0) {
        unsigned* bar = b.bar;
        __builtin_amdgcn_s_waitcnt(0);
        unsigned nloc = b.st[0], nx = b.st[1];
        if (nloc == 0u) { xcd_barrier_complete(bar, b.x, nloc, nx); b.st[0] = nloc; b.st[1] = nx; }
        const unsigned old = xb_add(&bar[XB_XSUB(b.x)], 1u);
        const unsigned gen = old / nloc;
        if (old + 1u == (gen + 1u) * nloc) {
            __builtin_amdgcn_fence(__ATOMIC_RELEASE, "agent");
            asm volatile("s_waitcnt vmcnt(0)" ::: "memory");
            const unsigned og = xb_add(&bar[XB_TOP], 1u);
            const unsigned tg = og / nx;
            if (og + 1u == (tg + 1u) * nx) xb_add(&bar[XB_TOPGEN], 1u);
            else XB_SPIN(xb_ld(&bar[XB_TOPGEN]) == tg, bar);
            __builtin_amdgcn_fence(__ATOMIC_ACQUIRE, "agent");
            xb_add(&bar[XB_XGEN(b.x)], 1u);
            asm volatile("s_waitcnt vmcnt(0)" ::: "memory");
        } else {
            XB_SPIN(xb_ld(&bar[XB_XGEN(b.x)]) == gen, bar);
            __builtin_amdgcn_fence(__ATOMIC_ACQUIRE, "agent");
            asm volatile("s_waitcnt vmcnt(0)" ::: "memory");
        }
    }
    __syncthreads();
}


DEV u16 f2bf(float f) { unsigned u = __float_as_uint(f); u += 0x7fffu + ((u >> 16) & 1u); return (u16)(u >> 16); }
DEV float bf2f(u16 h) { return __uint_as_float(((unsigned)h) << 16); }
DEV float bflo(unsigned w) { return __uint_as_float(w << 16); }
DEV float bfhi(unsigned w) { return __uint_as_float(w & 0xffff0000u); }
DEV unsigned pack2(float a, float b) { return (unsigned)f2bf(a) | ((unsigned)f2bf(b) << 16); }
DEV float wave_max(float v) { for (int o = 32; o; o >>= 1) v = fmaxf(v, __shfl_xor(v, o)); return v; }
DEV float wave_sum(float v) { for (int o = 32; o; o >>= 1) v += __shfl_xor(v, o); return v; }
#define WAVE_SYNC() asm volatile("s_waitcnt lgkmcnt(0)" ::: "memory")

typedef short v4i16_t __attribute__((ext_vector_type(4)));
typedef float f32x2_t __attribute__((ext_vector_type(2)));
typedef __bf16 bf16x2_t __attribute__((ext_vector_type(2)));
typedef unsigned u32x4_t __attribute__((ext_vector_type(4)));
typedef unsigned u32x2_t __attribute__((ext_vector_type(2)));
typedef float f32x4_t __attribute__((ext_vector_type(4)));
DEV unsigned cvtpk(float lo, float hi) { f32x2_t v = {lo, hi}; bf16x2_t b = __builtin_convertvector(v, bf16x2_t); return __builtin_bit_cast(unsigned, b); }
DEV v4i16_t lds_tr(const u16* ptr) { return __builtin_amdgcn_ds_read_tr16_b64_v4i16((LAS v4i16_t*)ptr); }

struct GemmSmem { u16 A[2][320][72]; u16 B[2][64][128]; };
DEV int bswz(int k) { return (k & 3) | (((k >> 3) & 1) << 2); }

template <int MI, bool SPLIT, bool B16 = false, class FA, class FB, class FL, class FE>
DEV void gemm_core(GemmSmem& sm, int nk, FA a_addr, FB b_addr, int ldb, FL b_lo, FE epi, bool b_ok = true) {
  const int tid = tidx(), lane = tid & 63, wid = tid >> 6;
  const int wr = wid >> 1, wc = wid & 1, fr = lane & 15, fq = lane >> 4;
  const int n4 = tid & 31, kq = tid >> 5, q4 = (lane & 15) >> 2, p4 = lane & 3;
  f32x4 acc[MI][4];
#pragma unroll
  for (int mi = 0; mi < MI; ++mi)
#pragma unroll
    for (int ni = 0; ni < 4; ++ni) acc[mi][ni] = f32x4{0.f, 0.f, 0.f, 0.f};
  constexpr int NSET = (MI <= 4) ? 2 : 1;
  u32x4_t ra[NSET][MI]; f32x4_t rb[2][4]; u32x4_t rh[2][2];
  auto gloadA = [&](auto PC, int kt) {
    constexpr int P = decltype(PC)::value;
#pragma unroll
    for (int i = 0; i < MI; ++i) ra[P][i] = *reinterpret_cast<const u32x4_t*>(a_addr(i, kt));
  };
  auto gloadB = [&](auto PC, int kt) {
    constexpr int P = decltype(PC)::value;
    if constexpr (B16) {
      const u16* bp = b_addr(kt);
      rh[P][0] = *reinterpret_cast<const u32x4_t*>(bp);
      rh[P][1] = *reinterpret_cast<const u32x4_t*>(bp + (size_t)32 * ldb);
    } else {
      const float* bp = b_addr(kt);
#pragma unroll
      for (int i = 0; i < 4; ++i) rb[P][i] = *reinterpret_cast<const f32x4_t*>(bp + (size_t)(16 * i) * ldb);
    }
  };
  auto gload = [&](auto PC, int kt) { gloadA(PC, kt); gloadB(PC, kt); };
  auto sstore3 = [&](auto AC, auto PC, auto BC, int kt) {
    constexpr int AS = decltype(AC)::value;
    constexpr int P = decltype(PC)::value;
    constexpr int Bf = decltype(BC)::value;
#pragma unroll
    for (int i = 0; i < MI; ++i) *reinterpret_cast<u32x4_t*>(&sm.A[Bf][(tid >> 3) + 64 * i][(tid & 7) * 8]) = ra[AS][i];
    if constexpr (B16) {
#pragma unroll
      for (int i = 0; i < 2; ++i) {
        u32x4_t w = rh[P][i];
        if (!b_ok) w = u32x4_t{0u, 0u, 0u, 0u};
        const int k = (tid >> 4) + 32 * i, n8 = tid & 15;
        *reinterpret_cast<u32x4_t*>(&sm.B[Bf][k][(((n8 >> 1) ^ bswz(k)) << 4) + (n8 & 1) * 8]) = w;
      }
      return;
    }
    const bool lo = SPLIT ? b_lo(kt) : false;
#pragma unroll
    for (int i = 0; i < 4; ++i) {
      f32x4_t v = rb[P][i];
      if (!b_ok) v = f32x4_t{0.f, 0.f, 0.f, 0.f};
      if (SPLIT && lo) {
        const unsigned h0 = cvtpk(v[0], v[1]), h1 = cvtpk(v[2], v[3]);
        v[0] -= __uint_as_float(h0 << 16); v[1] -= __uint_as_float(h0 & 0xffff0000u); v[2] -= __uint_as_float(h1 << 16); v[3] -= __uint_as_float(h1 & 0xffff0000u);
      }
      u32x2_t w; w[0] = cvtpk(v[0], v[1]); w[1] = cvtpk(v[2], v[3]);
      const int k = kq + 16 * i;
      *reinterpret_cast<u32x2_t*>(&sm.B[Bf][k][(((n4 >> 2) ^ bswz(k)) << 4) + (n4 & 3) * 4]) = w;
    }
  };
  auto sstore = [&](auto PC, auto BC, int kt) { sstore3(PC, PC, BC, kt); };
  auto compute = [&](auto PC) {
    constexpr int P = decltype(PC)::value;
#pragma unroll
    for (int ks = 0; ks < 2; ++ks) {
      bf16x8 bf[4];
#pragma unroll
      for (int ni = 0; ni < 4; ++ni) {
        const int k0 = 32 * ks + 8 * fq + q4, col = (((wc * 4 + ni) ^ bswz(k0)) << 4) + 4 * p4;
        const v4i16_t lo = lds_tr(&sm.B[P][k0][col]);
        const v4i16_t hh = lds_tr(&sm.B[P][k0 + 4][col]);
        bf[ni] = bf16x8{lo[0], lo[1], lo[2], lo[3], hh[0], hh[1], hh[2], hh[3]};
      }
      constexpr int G0 = (MI > 4) ? 3 : MI;
      {
        bf16x8 af[G0];
#pragma unroll
        for (int mi = 0; mi < G0; ++mi) af[mi] = *reinterpret_cast<const bf16x8*>(&sm.A[P][wr * 16 * MI + mi * 16 + fr][32 * ks + fq * 8]);
#pragma unroll
        for (int mi = 0; mi < G0; ++mi)
#pragma unroll
          for (int ni = 0; ni < 4; ++ni) acc[mi][ni] = __builtin_amdgcn_mfma_f32_16x16x32_bf16(bf[ni], af[mi], acc[mi][ni], 0, 0, 0);
      }
      if constexpr (MI > G0) {
        __builtin_amdgcn_sched_barrier(0);
        bf16x8 af[MI - G0];
#pragma unroll
        for (int mi = G0; mi < MI; ++mi) af[mi - G0] = *reinterpret_cast<const bf16x8*>(&sm.A[P][wr * 16 * MI + mi * 16 + fr][32 * ks + fq * 8]);
#pragma unroll
        for (int mi = G0; mi < MI; ++mi)
#pragma unroll
          for (int ni = 0; ni < 4; ++ni) acc[mi][ni] = __builtin_amdgcn_mfma_f32_16x16x32_bf16(bf[ni], af[mi - G0], acc[mi][ni], 0, 0, 0);
      }
      __builtin_amdgcn_sched_barrier(0);
    }
  };
  using C0 = std::integral_constant<int, 0>; using C1 = std::integral_constant<int, 1>;
  int kt = 0;
  if constexpr (MI <= 4) {
    gload(C0{}, 0);
    sstore(C0{}, C0{}, 0);
    gload(C1{}, 1);
    __syncthreads();
    for (; kt + 2 < nk; kt += 2) {
      gload(C0{}, kt + 2); compute(C0{}); sstore(C1{}, C1{}, kt + 1); __syncthreads();
      gload(C1{}, kt + 3); compute(C1{}); sstore(C0{}, C0{}, kt + 2); __syncthreads();
    }
    compute(C0{}); sstore(C1{}, C1{}, kt + 1); __syncthreads();
    compute(C1{}); __syncthreads();
  } else {
    gloadA(C0{}, 0); gloadB(C0{}, 0);
    sstore3(C0{}, C0{}, C0{}, 0);
    gloadB(C1{}, 1);
    __syncthreads();
    for (; kt + 2 < nk; kt += 2) {
      gloadA(C0{}, kt + 1); gloadB(C0{}, kt + 2); compute(C0{}); sstore3(C0{}, C1{}, C1{}, kt + 1); __syncthreads();
      gloadA(C0{}, kt + 2); gloadB(C1{}, kt + 3); compute(C1{}); sstore3(C0{}, C0{}, C0{}, kt + 2); __syncthreads();
    }
    gloadA(C0{}, kt + 1); compute(C0{}); sstore3(C0{}, C1{}, C1{}, kt + 1); __syncthreads();
    compute(C1{}); __syncthreads();
  }
  epi(acc);
}

struct ItemRange { int i, hi, step; };
DEV ItemRange xcd_items(int I) {
  ItemRange r;
  if (gridDim.x & 7) { r.i = blockIdx.x; r.hi = I; r.step = gridDim.x; }
  else { const int x = blockIdx.x & 7; r.i = (int)((long)I * x / 8) + (blockIdx.x >> 3); r.hi = (int)((long)I * (x + 1) / 8); r.step = gridDim.x >> 3; }
  return r;
}
template <int GM, int GN> DEV void dense_item(int i, int MT, int& mt, int& nt) {
  const int g = i / (GM * GN), w = i % (GM * GN), gpm = MT / GM;
  mt = (g % gpm) * GM + w / GN; nt = (g / gpm) * GN + w % GN;
}
DEV float4 ld4(const float* ptr) { return *reinterpret_cast<const float4*>(ptr); }
DEV void st_bf4(u16* ptr, float a, float b, float c, float d) { uint2 w; w.x = cvtpk(a, b); w.y = cvtpk(c, d); *reinterpret_cast<uint2*>(ptr) = w; }

__constant__ float INVF[8] = {1.0f, 0.1939227432012558f, 0.03760603070259094f, 0.007292664609849453f, 0.0014142135623842478f,
                              0.00027424818836152554f, 5.3182957344688475e-05f, 1.0313385246263351e-05f};
DEV void ph_prologue(const Params& p) {
  const size_t gtid = (size_t)blockIdx.x * NTHR + tidx(), gsz = (size_t)gridDim.x * NTHR;
  for (size_t i = gtid; i < (size_t)T_ * D_ / 8; i += gsz) {
    const float4 a = reinterpret_cast<const float4*>(p.x)[2 * i], b = reinterpret_cast<const float4*>(p.x)[2 * i + 1];
    uint4 w; w.x = pack2(a.x, a.y); w.y = pack2(a.z, a.w); w.z = pack2(b.x, b.y); w.w = pack2(b.z, b.w);
    reinterpret_cast<uint4*>(p.xb)[i] = w;
  }
  for (size_t i = gtid; i < (size_t)T_ * 8; i += gsz) {
    const int t = (int)(i >> 3), f = (int)(i & 7);
    const float ang = (float)p.pos[t] * INVF[f];
    p.cs[t * 16 + f] = cosf(ang); p.cs[t * 16 + 8 + f] = sinf(ang);
  }
  auto cvt_w = [&](const float* src, u16* dst, size_t n4) {
    for (size_t i = gtid; i < n4; i += gsz) {
      const float4 a = reinterpret_cast<const float4*>(src)[i];
      uint2 w; w.x = cvtpk(a.x, a.y); w.y = cvtpk(a.z, a.w);
      reinterpret_cast<uint2*>(dst)[i] = w;
    }
  };
  cvt_w(p.even_w_in, p.w16_in0, (size_t)D_ * LD0 / 4);
  cvt_w(p.even_w_out, p.w16_out0, (size_t)D_ * D_ / 4);
  cvt_w(p.odd_w_in, p.w16_in1, (size_t)D_ * NIN1 / 4);
  cvt_w(p.odd_w_out, p.w16_out1, (size_t)D_ * D_ / 4);
  for (size_t i = gtid; i < (size_t)2 * D_ * NE / 4; i += gsz) {
    const size_t L = i / ((size_t)D_ * NE / 4), r = i - L * ((size_t)D_ * NE / 4);
    const float4 a = reinterpret_cast<const float4*>(p.router_w)[i];
    const unsigned h0 = cvtpk(a.x, a.y), h1 = cvtpk(a.z, a.w);
    uint2 hi; hi.x = h0; hi.y = h1;
    uint2 lo; lo.x = cvtpk(a.x - __uint_as_float(h0 << 16), a.y - __uint_as_float(h0 & 0xffff0000u)); lo.y = cvtpk(a.z - __uint_as_float(h1 << 16), a.w - __uint_as_float(h1 & 0xffff0000u));
    reinterpret_cast<uint2*>(p.rw16 + (L * 2 + 0) * (size_t)D_ * NE)[r] = hi;
    reinterpret_cast<uint2*>(p.rw16 + (L * 2 + 1) * (size_t)D_ * NE)[r] = lo;
  }
  for (size_t i = gtid; i < 2 * 128 * 16; i += gsz) {
    const int n = (int)(i & 127), kc = (int)((i >> 7) & 15), ts = (int)(i >> 11);
    const float* pe = ts ? p.cmpv_pos : p.cmpk_pos; const float* w1 = ts ? p.cmpv_w1 : p.cmpk_w1;
    float s = 0.f;
    for (int k = kc * 128; k < kc * 128 + 128; ++k) s += pe[k] * w1[(size_t)k * 128 + n];
    atomicAdd(&p.pb[ts * 128 + n], s);
  }
}

DEV void ph_inproj0(const Params& p, GemmSmem& sm) {
  const int tid = tidx(), lane = tid & 63, wid = tid >> 6, wr = wid >> 1, wc = wid & 1, fr = lane & 15, fq = lane >> 4;
  constexpr int NT = LD0 / 128;
  for (ItemRange it = xcd_items(64 * NT); it.i < it.hi; it.i += it.step) {
    int mt, nt; dense_item<16, 2>(it.i, 64, mt, nt);
    const int m0 = mt * 256, n0 = nt * 128;
    const u16* ar0 = p.xb + (size_t)(m0 + (tid >> 3)) * D_ + (tid & 7) * 8;
    auto a_addr = [&](int i, int kt) { return ar0 + (size_t)i * 64 * D_ + kt * 64; };
    const u16* bb = p.w16_in0 + (size_t)(tid >> 4) * LD0 + n0 + 8 * (tid & 15);
    auto b_addr = [&](int kt) { return bb + (size_t)kt * 64 * LD0; };
    auto b_lo = [&](int) { return false; };
    auto epi = [&](f32x4 (&acc)[4][4]) {
#pragma unroll
      for (int mi = 0; mi < 4; ++mi) {
        const int row = m0 + wr * 64 + mi * 16 + fr;
#pragma unroll
        for (int ni = 0; ni < 4; ++ni) {
          f32x4 v = acc[mi][ni];
          const int col = n0 + wc * 64 + ni * 16 + fq * 4;
          const bool rope = (ni == 0) && (col < 1024 || (col >= 1536 && col < 2176));
          if (rope) {
            const float4 c_ = ld4(p.cs + row * 16 + 4 * (fq & 1)), s_ = ld4(p.cs + row * 16 + 8 + 4 * (fq & 1));
            const float p0 = __shfl_xor(v[0], 32), p1 = __shfl_xor(v[1], 32), p2 = __shfl_xor(v[2], 32), p3 = __shfl_xor(v[3], 32);
            const float sg = fq < 2 ? -1.f : 1.f;
            v[0] = v[0] * c_.x + sg * p0 * s_.x; v[1] = v[1] * c_.y + sg * p1 * s_.y; v[2] = v[2] * c_.z + sg * p2 * s_.z; v[3] = v[3] * c_.w + sg * p3 * s_.w;
          }
          st_bf4(p.qkv + (size_t)row * LD0 + col, v[0], v[1], v[2], v[3]);
        }
      }
    };
    gemm_core<4, false, true>(sm, 16, a_addr, b_addr, LD0, b_lo, epi);
  }
}

struct AttnSmem { float qs[4][64]; float sc[4][1040]; int tk[4][1040]; int tw[4][512]; };

DEV float wave_attn(const float* qs, float* sc, const int* tk, int n4, const u16* Kb, const u16* Vb, int ld, float sink, int lane, float (&o)[4]) {
  float mx = -INFINITY;
  for (int i = lane; i < n4; i += 64) {
    const int r = tk[i];
    float s = -INFINITY;
    if (r >= 0) {
      const uint4* kp = reinterpret_cast<const uint4*>(Kb + (size_t)r * ld);
      float a = 0.f;
#pragma unroll
      for (int c = 0; c < 8; ++c) {
        const uint4 kv = kp[c];
        const float4 q0 = reinterpret_cast<const float4*>(qs)[2 * c], q1 = reinterpret_cast<const float4*>(qs)[2 * c + 1];
        a += bflo(kv.x) * q0.x + bfhi(kv.x) * q0.y + bflo(kv.y) * q0.z + bfhi(kv.y) * q0.w
           + bflo(kv.z) * q1.x + bfhi(kv.z) * q1.y + bflo(kv.w) * q1.z + bfhi(kv.w) * q1.w;
      }
      s = a;
    }
    sc[i] = s; mx = fmaxf(mx, s);
  }
  mx = wave_max(mx);
  const float m = fmaxf(mx, sink);
  WAVE_SYNC();
  float sum = 0.f;
  if (m > -INFINITY) {
    for (int i = lane; i < n4; i += 64) { const float pz = __expf(sc[i] - m); sc[i] = pz; sum += pz; }
  } else {
    for (int i = lane; i < n4; i += 64) sc[i] = 0.f;
  }
  sum = wave_sum(sum);
  if (sink > -INFINITY) sum += __expf(sink - m);
  const float inv = sum > 0.f ? 1.f / sum : 0.f;
  WAVE_SYNC();
  const int kk = lane >> 4, dg = lane & 15;
  float a0 = 0.f, a1 = 0.f, a2 = 0.f, a3 = 0.f;
  for (int i = kk; i < n4; i += 4) {
    const float pz = sc[i];
    if (pz != 0.f) {
      const int r = tk[i];
      const uint2 v = *reinterpret_cast<const uint2*>(Vb + (size_t)r * ld + dg * 4);
      a0 += pz * bflo(v.x); a1 += pz * bfhi(v.x); a2 += pz * bflo(v.y); a3 += pz * bfhi(v.y);
    }
  }
  a0 += __shfl_xor(a0, 16); a1 += __shfl_xor(a1, 16); a2 += __shfl_xor(a2, 16); a3 += __shfl_xor(a3, 16);
  a0 += __shfl_xor(a0, 32); a1 += __shfl_xor(a1, 32); a2 += __shfl_xor(a2, 32); a3 += __shfl_xor(a3, 32);
  o[0] = a0 * inv; o[1] = a1 * inv; o[2] = a2 * inv; o[3] = a3 * inv;
  return inv;
}

DEV void ph_attn0(const Params& p, AttnSmem& sm) {
  const int tid = tidx(), lane = tid & 63, wid = tid >> 6;
  float* qs = sm.qs[wid]; float* sc = sm.sc[wid]; int* tk = sm.tk[wid];
  const int gw = blockIdx.x * NWAVE + wid, nw = gridDim.x * NWAVE;
  for (int u = gw; u < T_ * 16; u += nw) {
    const int tg = u >> 4, h = u & 15, b = tg >> 12, t = tg & 4095;
    const u16* row = p.qkv + (size_t)tg * LD0;
    int qcol, kcol, vcol, n; float sink = -INFINITY;
    if (h < 8) {
      qcol = h * 64; kcol = 512 + h * 64; vcol = 1024 + h * 64;
      for (int i = lane; i < 388; i += 64) {
        int r = -1;
        if (i < 387) { const int pi = i / 129, k = i - pi * 129; const int dil = pi == 0 ? 1 : (pi == 1 ? 4 : 16); const int tok = t - k * dil; if (tok >= 0) r = b * S_ + tok; }
        tk[i] = r;
      }
      n = 388;
    } else {
      const int hb = h - 8, g = hb >> 2;
      qcol = 1536 + hb * 64; kcol = 2048 + g * 64; vcol = 2176 + g * 64; sink = p.even_sinks[hb];
      for (int i = lane; i < 128; i += 64) { const int tok = t - i; tk[i] = tok >= 0 ? b * S_ + tok : -1; }
      n = 128;
    }
    qs[lane] = bf2f(row[qcol + lane]) * 0.125f;
    WAVE_SYNC();
    float o[4];
    wave_attn(qs, sc, tk, n, p.qkv + kcol, p.qkv + vcol, LD0, sink, lane, o);
    if (lane < 16) { uint2 w; w.x = pack2(o[0], o[1]); w.y = pack2(o[2], o[3]); *reinterpret_cast<uint2*>(p.ao + (size_t)tg * D_ + h * 64 + lane * 4) = w; }
    WAVE_SYNC();
  }
}

DEV void ph_outproj(const Params& p, GemmSmem& sm, const u16* W16, const float* resid) {
  const int tid = tidx(), lane = tid & 63, wid = tid >> 6, wr = wid >> 1, wc = wid & 1, fr = lane & 15, fq = lane >> 4;
  for (ItemRange it = xcd_items(64 * 8); it.i < it.hi; it.i += it.step) {
    int mt, nt; dense_item<8, 4>(it.i, 64, mt, nt);
    const int m0 = mt * 256, n0 = nt * 128;
    const u16* ar0 = p.ao + (size_t)(m0 + (tid >> 3)) * D_ + (tid & 7) * 8;
    auto a_addr = [&](int i, int kt) { return ar0 + (size_t)i * 64 * D_ + kt * 64; };
    const u16* bb = W16 + (size_t)(tid >> 4) * D_ + n0 + 8 * (tid & 15);
    auto b_addr = [&](int kt) { return bb + (size_t)kt * 64 * D_; };
    auto b_lo = [&](int) { return false; };
    auto epi = [&](f32x4 (&acc)[4][4]) {
#pragma unroll
      for (int mi = 0; mi < 4; ++mi)
#pragma unroll
        for (int ni = 0; ni < 4; ++ni) {
          const size_t idx = (size_t)(m0 + wr * 64 + mi * 16 + fr) * D_ + n0 + wc * 64 + ni * 16 + fq * 4;
          const float4 r = ld4(resid + idx);
          float4 o; o.x = ALPHA * r.x + acc[mi][ni][0]; o.y = ALPHA * r.y + acc[mi][ni][1]; o.z = ALPHA * r.z + acc[mi][ni][2]; o.w = ALPHA * r.w + acc[mi][ni][3];
          *reinterpret_cast<float4*>(p.hpre + idx) = o;
        }
    };
    gemm_core<4, false, true>(sm, 16, a_addr, b_addr, D_, b_lo, epi);
  }
}

DEV void ph_ln_mix(const Params& p, const float* g, const float* bt) {
  const int lane = tidx() & 63, gw = blockIdx.x * NWAVE + (tidx() >> 6), nw = gridDim.x * NWAVE;
  for (int tok = gw; tok < T_; tok += nw) {
    float4 v[4]; float s = 0.f;
#pragma unroll
    for (int i = 0; i < 4; ++i) { v[i] = reinterpret_cast<const float4*>(p.hpre + (size_t)tok * D_)[i * 64 + lane]; s += v[i].x + v[i].y + v[i].z + v[i].w; }
    const float mu = wave_sum(s) * (1.f / D_);
    float ss = 0.f;
#pragma unroll
    for (int i = 0; i < 4; ++i) { v[i].x -= mu; v[i].y -= mu; v[i].z -= mu; v[i].w -= mu; ss += v[i].x * v[i].x + v[i].y * v[i].y + v[i].z * v[i].z + v[i].w * v[i].w; }
    const float rstd = rsqrtf(wave_sum(ss) * (1.f / D_) + LN_EPS);
#pragma unroll
    for (int i = 0; i < 4; ++i) {
      const float4 gg = reinterpret_cast<const float4*>(g)[i * 64 + lane], bb = reinterpret_cast<const float4*>(bt)[i * 64 + lane];
      float4 y; y.x = v[i].x * rstd * gg.x + bb.x; y.y = v[i].y * rstd * gg.y + bb.y; y.z = v[i].z * rstd * gg.z + bb.z; y.w = v[i].w * rstd * gg.w + bb.w;
      const u16 h0 = f2bf(y.x), h1 = f2bf(y.y), h2 = f2bf(y.z), h3 = f2bf(y.w);
      uint2 hi; hi.x = (unsigned)h0 | ((unsigned)h1 << 16); hi.y = (unsigned)h2 | ((unsigned)h3 << 16);
      uint2 lo; lo.x = pack2(y.x - bf2f(h0), y.y - bf2f(h1)); lo.y = pack2(y.z - bf2f(h2), y.w - bf2f(h3));
      reinterpret_cast<uint2*>(p.x1b + (size_t)tok * D_)[i * 64 + lane] = hi;
      reinterpret_cast<uint2*>(p.x1lo + (size_t)tok * D_)[i * 64 + lane] = lo;
    }
  }
}

struct RouterSmem { u16 A[2][256][72]; u16 B[2][2][64][128]; };
DEV void ph_router_gemm(const Params& p, char* smem, const u16* RW16) {
  RouterSmem& sm = *reinterpret_cast<RouterSmem*>(smem);
  const int tid = tidx(), lane = tid & 63, wid = tid >> 6, wr = wid >> 1, wc = wid & 1, fr = lane & 15, fq = lane >> 4;
  const int q4 = (lane & 15) >> 2, p4 = lane & 3;
  for (ItemRange it = xcd_items(128 * 2); it.i < it.hi; it.i += it.step) {
    const int nt = it.i & 1, mt = it.i >> 1, m0 = mt * 128, n0 = nt * 128;
    const size_t ao0 = (size_t)(m0 + (tid >> 3)) * D_ + (tid & 7) * 8;
    const u16* bb = RW16 + (size_t)(tid >> 4) * NE + n0 + 8 * (tid & 15);
    f32x4 acc[2][4];
#pragma unroll
    for (int mi = 0; mi < 2; ++mi)
#pragma unroll
      for (int ni = 0; ni < 4; ++ni) acc[mi][ni] = f32x4{0.f, 0.f, 0.f, 0.f};
    u32x4_t ra[2][4], rb[2][4];
    auto gload = [&](auto PC, int kt) {
      constexpr int P = decltype(PC)::value;
      ra[P][0] = *reinterpret_cast<const u32x4_t*>(p.x1b + ao0 + kt * 64);
      ra[P][1] = *reinterpret_cast<const u32x4_t*>(p.x1b + ao0 + (size_t)64 * D_ + kt * 64);
      ra[P][2] = *reinterpret_cast<const u32x4_t*>(p.x1lo + ao0 + kt * 64);
      ra[P][3] = *reinterpret_cast<const u32x4_t*>(p.x1lo + ao0 + (size_t)64 * D_ + kt * 64);
      const u16* bp = bb + (size_t)kt * 64 * NE;
      rb[P][0] = *reinterpret_cast<const u32x4_t*>(bp);
      rb[P][1] = *reinterpret_cast<const u32x4_t*>(bp + (size_t)32 * NE);
      rb[P][2] = *reinterpret_cast<const u32x4_t*>(bp + (size_t)D_ * NE);
      rb[P][3] = *reinterpret_cast<const u32x4_t*>(bp + (size_t)D_ * NE + (size_t)32 * NE);
    };
    auto sstore = [&](auto PC) {
      constexpr int P = decltype(PC)::value;
#pragma unroll
      for (int i = 0; i < 4; ++i) *reinterpret_cast<u32x4_t*>(&sm.A[P][(tid >> 3) + 64 * i][(tid & 7) * 8]) = ra[P][i];
#pragma unroll
      for (int i = 0; i < 4; ++i) {
        const int k = (tid >> 4) + 32 * (i & 1), n8 = tid & 15;
        *reinterpret_cast<u32x4_t*>(&sm.B[P][i >> 1][k][(((n8 >> 1) ^ bswz(k)) << 4) + (n8 & 1) * 8]) = rb[P][i];
      }
    };
    auto compute = [&](auto PC) {
      constexpr int P = decltype(PC)::value;
#pragma unroll
      for (int ks = 0; ks < 2; ++ks) {
        bf16x8 ah[2], al[2], bh[4], bl[4];
#pragma unroll
        for (int mi = 0; mi < 2; ++mi) {
          ah[mi] = *reinterpret_cast<const bf16x8*>(&sm.A[P][wr * 32 + mi * 16 + fr][32 * ks + fq * 8]);
          al[mi] = *reinterpret_cast<const bf16x8*>(&sm.A[P][128 + wr * 32 + mi * 16 + fr][32 * ks + fq * 8]);
        }
#pragma unroll
        for (int ni = 0; ni < 4; ++ni) {
          const int k0 = 32 * ks + 8 * fq + q4, col = (((wc * 4 + ni) ^ bswz(k0)) << 4) + 4 * p4;
          { const v4i16_t lo = lds_tr(&sm.B[P][0][k0][col]), hh = lds_tr(&sm.B[P][0][k0 + 4][col]); bh[ni] = bf16x8{lo[0], lo[1], lo[2], lo[3], hh[0], hh[1], hh[2], hh[3]}; }
          { const v4i16_t lo = lds_tr(&sm.B[P][1][k0][col]), hh = lds_tr(&sm.B[P][1][k0 + 4][col]); bl[ni] = bf16x8{lo[0], lo[1], lo[2], lo[3], hh[0], hh[1], hh[2], hh[3]}; }
        }
#pragma unroll
        for (int mi = 0; mi < 2; ++mi)
#pragma unroll
          for (int ni = 0; ni < 4; ++ni) {
            acc[mi][ni] = __builtin_amdgcn_mfma_f32_16x16x32_bf16(bh[ni], ah[mi], acc[mi][ni], 0, 0, 0);
            acc[mi][ni] = __builtin_amdgcn_mfma_f32_16x16x32_bf16(bh[ni], al[mi], acc[mi][ni], 0, 0, 0);
            acc[mi][ni] = __builtin_amdgcn_mfma_f32_16x16x32_bf16(bl[ni], ah[mi], acc[mi][ni], 0, 0, 0);
          }
        __builtin_amdgcn_sched_barrier(0);
      }
    };
    using C0 = std::integral_constant<int, 0>; using C1 = std::integral_constant<int, 1>;
    gload(C0{}, 0); sstore(C0{}); gload(C1{}, 1); __syncthreads();
    int kt = 0;
    for (; kt + 2 < 16; kt += 2) {
      gload(C0{}, kt + 2); compute(C0{}); sstore(C1{}); __syncthreads();
      gload(C1{}, kt + 3); compute(C1{}); sstore(C0{}); __syncthreads();
    }
    compute(C0{}); sstore(C1{}); __syncthreads();
    compute(C1{}); __syncthreads();
#pragma unroll
    for (int mi = 0; mi < 2; ++mi)
#pragma unroll
      for (int ni = 0; ni < 4; ++ni) {
        float4 o; o.x = acc[mi][ni][0]; o.y = acc[mi][ni][1]; o.z = acc[mi][ni][2]; o.w = acc[mi][ni][3];
        *reinterpret_cast<float4*>(p.logits + (size_t)(m0 + wr * 32 + mi * 16 + fr) * NE + n0 + wc * 64 + ni * 16 + fq * 4) = o;
      }
  }
}

template <bool NAIVE_LG> DEV void ph_route(const Params& p, const float* rbias, int* cnt, const float* RW, int* etok) {
  const int lane = tidx() & 63, gw = blockIdx.x * NWAVE + (tidx() >> 6), nw = gridDim.x * NWAVE;
  const int half = lane >> 5;
  for (int tok = gw; tok < T_; tok += nw) {
    float aff[4], val[4];
    float lgn[4] = {0.f, 0.f, 0.f, 0.f};
    if (NAIVE_LG) {
      for (int k = 0; k < D_; ++k) {
        const float xv = bf2f(p.x1b[(size_t)tok * D_ + k]) + bf2f(p.x1lo[(size_t)tok * D_ + k]);
#pragma unroll
        for (int j = 0; j < 4; ++j) lgn[j] += xv * RW[(size_t)k * NE + lane + 64 * j];
      }
    }
#pragma unroll
    for (int j = 0; j < 4; ++j) {
      const float lg = NAIVE_LG ? lgn[j] : p.logits[(size_t)tok * NE + lane + 64 * j];
      aff[j] = 1.f / (1.f + expf(-lg));
      val[j] = aff[j] + rbias[lane + 64 * j];
    }
    float gs[8];
#pragma unroll
    for (int j = 0; j < 4; ++j) {
      float m1 = val[j];
#pragma unroll
      for (int o = 16; o; o >>= 1) m1 = fmaxf(m1, __shfl_xor(m1, o));
      const unsigned long long eq = __ballot(val[j] == m1);
      const int ceq = __popc((unsigned)(half ? (eq >> 32) : (eq & 0xffffffffull)));
      float m2 = (val[j] == m1) ? -INFINITY : val[j];
#pragma unroll
      for (int o = 16; o; o >>= 1) m2 = fmaxf(m2, __shfl_xor(m2, o));
      if (ceq >= 2) m2 = m1;
      const float mine = m1 + m2, other = __shfl_xor(mine, 32);
      gs[2 * j] = half ? other : mine; gs[2 * j + 1] = half ? mine : other;
    }
    bool gok[8];
#pragma unroll
    for (int g = 0; g < 8; ++g) {
      int rk = 0;
#pragma unroll
      for (int g2 = 0; g2 < 8; ++g2) rk += (gs[g2] > gs[g] || (gs[g2] == gs[g] && g2 < g)) ? 1 : 0;
      gok[g] = rk < 4;
    }
#pragma unroll
    for (int j = 0; j < 4; ++j) { const bool ok = half ? gok[2 * j + 1] : gok[2 * j]; if (!ok) val[j] = -INFINITY; }
    int my_e = 0; float my_a = 0.f, asum = 0.f;
#pragma unroll
    for (int k = 0; k < TOPK; ++k) {
      float bv = val[0]; int bi = lane;
#pragma unroll
      for (int j = 1; j < 4; ++j) if (val[j] > bv) { bv = val[j]; bi = lane + 64 * j; }
#pragma unroll
      for (int o = 32; o; o >>= 1) {
        const float ov = __shfl_xor(bv, o); const int oi = __shfl_xor(bi, o);
        if (ov > bv || (ov == bv && oi < bi)) { bv = ov; bi = oi; }
      }
      float a_sel = 0.f;
#pragma unroll
      for (int j = 0; j < 4; ++j) { const bool hit = (bi == lane + 64 * j); a_sel = hit ? aff[j] : a_sel; val[j] = hit ? -INFINITY : val[j]; }
      a_sel = wave_sum(a_sel);
      asum += a_sel;
      if (lane == k) { my_e = bi; my_a = a_sel; }
    }
    if (lane < TOPK) {
      const int ps = atomicAdd(&cnt[my_e], 1);
      p.eidx[tok * TOPK + lane] = my_e; p.epos[tok * TOPK + lane] = ps; p.gatev[tok * TOPK + lane] = my_a / asum * 2.5f;
      etok[(size_t)my_e * T_ + ps] = tok;
    }
  }
}

constexpr int MOE_TM = 320;
struct MoeTab { int cn[260]; int of[260]; int tf[260]; unsigned ao[2][5][NTHR]; };
DEV void moe_prep(MoeTab& mt, const int* cnt) {
  const int tid = tidx();
  if (tid < NE) mt.cn[tid] = cnt[tid];
  __syncthreads();
  if (tid == 0) {
    int a = 0, tl = 0;
    for (int e = 0; e < NE; ++e) { mt.of[e] = a; mt.tf[e] = tl; a += mt.cn[e]; tl += (mt.cn[e] + MOE_TM - 1) / MOE_TM; }
    mt.cn[NE] = T_; mt.of[NE] = NASG; mt.tf[NE] = tl; mt.of[NE + 1] = NASG + T_; mt.tf[NE + 1] = tl + (T_ + MOE_TM - 1) / MOE_TM;
  }
  __syncthreads();
}
DEV int moe_rows_per_tile(int cn, int tiles) { return (cn + tiles - 1) / tiles; }
struct MoeItem { int e, nt, r0, r1, of; };
template <int NPT> DEV MoeItem moe_item(const MoeTab& mt, int u) {
  int lo = 0, hi = NE;
  while (lo < hi) { const int mid = (lo + hi + 1) >> 1; if (NPT * mt.tf[mid] <= u) lo = mid; else hi = mid - 1; }
  MoeItem it; it.e = lo;
  const int tiles = mt.tf[lo + 1] - mt.tf[lo], local = u - NPT * mt.tf[lo], mtl = local / NPT, cn = mt.cn[lo];
  it.nt = local - mtl * NPT; it.of = mt.of[lo];
  const int per = moe_rows_per_tile(cn, tiles);
  it.r0 = mtl * per; it.r1 = (it.r0 + per < cn) ? it.r0 + per : cn;
  return it;
}

template <int NK, class FA, class FB, class FAN, class FBN, class FM, class FE>
DEV void moe_gemm5(GemmSmem& sm, u32x4_t (&ra)[2][5], f32x4_t (&rb)[4], FA a_addr, FB b_addr, FAN a_next, FBN b_next, int ldb, FM mid, FE epi) {
  constexpr int MI = 5;
  const int tid = tidx(), lane = tid & 63, wid = tid >> 6;
  const int wr = wid >> 1, wc = wid & 1, fr = lane & 15, fq = lane >> 4;
  const int n4 = tid & 31, kq = tid >> 5, q4 = (lane & 15) >> 2, p4 = lane & 3;
  f32x4 acc[MI][4];
#pragma unroll
  for (int mi = 0; mi < MI; ++mi)
#pragma unroll
    for (int ni = 0; ni < 4; ++ni) acc[mi][ni] = f32x4{0.f, 0.f, 0.f, 0.f};
  auto gloadA = [&](auto PC, auto& fa, int kt) {
    constexpr int P = decltype(PC)::value;
#pragma unroll
    for (int i = 0; i < MI; ++i) ra[P][i] = *reinterpret_cast<const u32x4_t*>(fa(i, kt));
  };
  auto gloadB = [&](auto& fb, int kt) {
    const float* bp = fb(kt);
#pragma unroll
    for (int i = 0; i < 4; ++i) rb[i] = *reinterpret_cast<const f32x4_t*>(bp + (size_t)(16 * i) * ldb);
  };
  auto sstore = [&](auto PC, auto BC) {
    constexpr int P = decltype(PC)::value;
    constexpr int Bf = decltype(BC)::value;
#pragma unroll
    for (int i = 0; i < MI; ++i) *reinterpret_cast<u32x4_t*>(&sm.A[Bf][(tid >> 3) + 64 * i][(tid & 7) * 8]) = ra[P][i];
#pragma unroll
    for (int i = 0; i < 4; ++i) {
      const f32x4_t v = rb[i];
      u32x2_t w; w[0] = cvtpk(v[0], v[1]); w[1] = cvtpk(v[2], v[3]);
      const int k = kq + 16 * i;
      *reinterpret_cast<u32x2_t*>(&sm.B[Bf][k][(((n4 >> 2) ^ bswz(k)) << 4) + (n4 & 3) * 4]) = w;
    }
  };
  auto compute = [&](auto BC) {
    constexpr int P = decltype(BC)::value;
#pragma unroll
    for (int ks = 0; ks < 2; ++ks) {
      bf16x8 bf[4];
#pragma unroll
      for (int ni = 0; ni < 4; ++ni) {
        const int k0 = 32 * ks + 8 * fq + q4, col = (((wc * 4 + ni) ^ bswz(k0)) << 4) + 4 * p4;
        const v4i16_t lo = lds_tr(&sm.B[P][k0][col]);
        const v4i16_t hh = lds_tr(&sm.B[P][k0 + 4][col]);
        bf[ni] = bf16x8{lo[0], lo[1], lo[2], lo[3], hh[0], hh[1], hh[2], hh[3]};
      }
      {
        bf16x8 af[3];
#pragma unroll
        for (int mi = 0; mi < 3; ++mi) af[mi] = *reinterpret_cast<const bf16x8*>(&sm.A[P][wr * 80 + mi * 16 + fr][32 * ks + fq * 8]);
#pragma unroll
        for (int mi = 0; mi < 3; ++mi)
#pragma unroll
          for (int ni = 0; ni < 4; ++ni) acc[mi][ni] = __builtin_amdgcn_mfma_f32_16x16x32_bf16(bf[ni], af[mi], acc[mi][ni], 0, 0, 0);
      }
      __builtin_amdgcn_sched_barrier(0);
      {
        bf16x8 af[2];
#pragma unroll
        for (int mi = 3; mi < 5; ++mi) af[mi - 3] = *reinterpret_cast<const bf16x8*>(&sm.A[P][wr * 80 + mi * 16 + fr][32 * ks + fq * 8]);
#pragma unroll
        for (int mi = 3; mi < 5; ++mi)
#pragma unroll
          for (int ni = 0; ni < 4; ++ni) acc[mi][ni] = __builtin_amdgcn_mfma_f32_16x16x32_bf16(bf[ni], af[mi - 3], acc[mi][ni], 0, 0, 0);
      }
      __builtin_amdgcn_sched_barrier(0);
    }
  };
  using C0 = std::integral_constant<int, 0>; using C1 = std::integral_constant<int, 1>;
  gloadA(C1{}, a_addr, 1);
  sstore(C0{}, C0{}); __syncthreads();
#pragma unroll 1
  for (int kt = 0; kt + 2 < NK; kt += 2) {
    gloadA(C0{}, a_addr, kt + 2); gloadB(b_addr, kt + 1); if (kt == 0) mid(); compute(C0{}); sstore(C1{}, C1{}); __syncthreads();
    gloadA(C1{}, a_addr, kt + 3); gloadB(b_addr, kt + 2); compute(C1{}); sstore(C0{}, C0{}); __syncthreads();
  }
  gloadB(b_addr, NK - 1); compute(C0{}); sstore(C1{}, C1{}); __syncthreads();
  gloadA(C0{}, a_next, 0); gloadB(b_next, 0);
  compute(C1{});
  epi(acc);
}


constexpr int TS_LD = 136;
DEV void ts_put(u16* T, int row, int col, float a, float b, float c, float d) { uint2 w; w.x = cvtpk(a, b); w.y = cvtpk(c, d); *reinterpret_cast<uint2*>(T + row * TS_LD + col) = w; }
template <int NCH, class FD> DEV void ts_flush(const u16* T, int rows, FD dst) {
  __syncthreads();
  for (int c = tidx(); c < rows * NCH; c += NTHR) {
    const int row = c / NCH, ch = c - row * NCH;
    u16* d = dst(row);
    if (d) *reinterpret_cast<u32x4_t*>(d + ch * 8) = *reinterpret_cast<const u32x4_t*>(T + row * TS_LD + ch * 8);
  }
  __syncthreads();
}

DEV void ph_moe1(const Params& p, GemmSmem& sm, MoeTab& mt, int layer, const int* cnt) {
  const int tid = tidx(), lane = tid & 63, wid = tid >> 6, wr = wid >> 1, wc = wid & 1, fr = lane & 15, fq = lane >> 4;
  moe_prep(mt, cnt);
  ItemRange it = xcd_items(mt.tf[NE + 1] * 4);
  if (it.i >= it.hi) return;
  const int v0 = 4 * (tid & 31);
  auto set_rows = [&](const MoeItem& m, int slot) {
#pragma unroll
    for (int i = 0; i < 5; ++i) {
      int ri = m.r0 + (tid >> 3) + 64 * i; ri = ri < m.r1 ? ri : m.r1 - 1;
      const int tk = m.e < NE ? p.etok[(size_t)m.e * T_ + ri] : ri;
      mt.ao[slot][i][tid] = (unsigned)tk * D_ + (tid & 7) * 8;
    }
  };
  auto b_ptr = [&](const MoeItem& m, int kt) -> const float* {
    const float* wg = m.e < NE ? p.w_gate + ((size_t)layer * NE + m.e) * D_ * 256 : p.sh_gate + (size_t)layer * D_ * 256;
    const float* wu = m.e < NE ? p.w_up + ((size_t)layer * NE + m.e) * D_ * 256 : p.sh_up + (size_t)layer * D_ * 256;
    return ((v0 & 63) >= 32 ? wu : wg) + (size_t)(kt * 64 + (tid >> 5)) * 256 + m.nt * 64 + (v0 >> 6) * 32 + (v0 & 31);
  };
  u32x4_t ra[2][5]; f32x4_t rb[4];
  MoeItem cur = moe_item<4>(mt, it.i);
  int slot = 0;
  set_rows(cur, 0);
  {
#pragma unroll
    for (int i = 0; i < 5; ++i) ra[0][i] = *reinterpret_cast<const u32x4_t*>(p.x1b + mt.ao[0][i][tid]);
#pragma unroll
    for (int i = 0; i < 4; ++i) rb[i] = *reinterpret_cast<const f32x4_t*>(b_ptr(cur, 0) + (size_t)(16 * i) * 256);
  }
  for (;;) {
    const int un = it.i + it.step;
    const bool has_next = un < it.hi;
    const MoeItem nxt = has_next ? moe_item<4>(mt, un) : cur;
    const int nslot = has_next ? slot ^ 1 : slot;
    auto a_addr = [&](int i, int kt) { return p.x1b + mt.ao[slot][i][tid] + kt * 64; };
    auto b_addr = [&](int kt) { return b_ptr(cur, kt); };
    auto a_next = [&](int i, int kt) { return p.x1b + mt.ao[nslot][i][tid] + kt * 64; };
    auto b_next = [&](int kt) { return b_ptr(nxt, kt); };
    auto mid = [&]() { if (has_next) set_rows(nxt, nslot); };
    auto epi = [&](f32x4 (&acc)[5][4]) {
#pragma unroll
      for (int mi = 0; mi < 5; ++mi) {
        const int idx = cur.r0 + wr * 80 + mi * 16 + fr;
        if (idx < cur.r1) {
#pragma unroll
          for (int n2 = 0; n2 < 2; ++n2) {
            float hv[4];
#pragma unroll
            for (int j = 0; j < 4; ++j) { const float g = acc[mi][n2][j], uu = acc[mi][n2 + 2][j]; hv[j] = g * __builtin_amdgcn_rcpf(1.f + __expf(-g)) * uu; }
            st_bf4(p.hbuf + (size_t)(cur.of + idx) * 256 + cur.nt * 64 + wc * 32 + n2 * 16 + fq * 4, hv[0], hv[1], hv[2], hv[3]);
          }
        }
      }
    };
    moe_gemm5<16>(sm, ra, rb, a_addr, b_addr, a_next, b_next, 256, mid, epi);
    if (!has_next) break;
    cur = nxt; it.i = un; slot = nslot;
  }
}

DEV void ph_moe2(const Params& p, GemmSmem& sm, MoeTab& mt, int layer, const int* cnt) {
  const int tid = tidx(), lane = tid & 63, wid = tid >> 6, wr = wid >> 1, wc = wid & 1, fr = lane & 15, fq = lane >> 4;
  moe_prep(mt, cnt);
  ItemRange it = xcd_items(mt.tf[NE + 1] * 8);
  if (it.i >= it.hi) return;
  auto a_ptr = [&](const MoeItem& m, int i, int kt) -> const u16* {
    const int rmax = m.r1 - 1 - m.r0 - (tid >> 3);
    int d = 64 * i; d = d < rmax ? d : rmax;
    return p.hbuf + (size_t)(m.of + m.r0 + (tid >> 3) + d) * 256 + (tid & 7) * 8 + kt * 64;
  };
  auto b_ptr = [&](const MoeItem& m, int kt) -> const float* {
    const float* wd = m.e < NE ? p.w_down + ((size_t)layer * NE + m.e) * 256 * D_ : p.sh_down + (size_t)layer * 256 * D_;
    return wd + (size_t)(kt * 64 + (tid >> 5)) * D_ + m.nt * 128 + 4 * (tid & 31);
  };
  u32x4_t ra[2][5]; f32x4_t rb[4];
  MoeItem cur = moe_item<8>(mt, it.i);
  {
#pragma unroll
    for (int i = 0; i < 5; ++i) ra[0][i] = *reinterpret_cast<const u32x4_t*>(a_ptr(cur, i, 0));
#pragma unroll
    for (int i = 0; i < 4; ++i) rb[i] = *reinterpret_cast<const f32x4_t*>(b_ptr(cur, 0) + (size_t)(16 * i) * D_);
  }
  for (;;) {
    const int un = it.i + it.step;
    const bool has_next = un < it.hi;
    const MoeItem nxt = has_next ? moe_item<8>(mt, un) : cur;
    auto a_addr = [&](int i, int kt) { return a_ptr(cur, i, kt); };
    auto b_addr = [&](int kt) { return b_ptr(cur, kt); };
    auto a_next = [&](int i, int kt) { return a_ptr(nxt, i, kt); };
    auto b_next = [&](int kt) { return b_ptr(nxt, kt); };
    auto mid = [&]() {};
    auto epi = [&](f32x4 (&acc)[5][4]) {
      u16* T = reinterpret_cast<u16*>(&sm);
      __syncthreads();
#pragma unroll
      for (int mi = 0; mi < 5; ++mi)
#pragma unroll
        for (int ni = 0; ni < 4; ++ni) ts_put(T, wr * 80 + mi * 16 + fr, wc * 64 + ni * 16 + fq * 4, acc[mi][ni][0], acc[mi][ni][1], acc[mi][ni][2], acc[mi][ni][3]);
      ts_flush<16>(T, cur.r1 - cur.r0, [&](int row) -> u16* { return p.ybuf + (size_t)(cur.of + cur.r0 + row) * D_ + cur.nt * 128; });
    };
    moe_gemm5<4>(sm, ra, rb, a_addr, b_addr, a_next, b_next, D_, mid, epi);
    if (!has_next) break;
    cur = nxt; it.i = un;
  }
}

DEV void ph_combine_ln(const Params& p, MoeTab& mt, const int* cnt, const float* g, const float* bt, float* outf, u16* outb, bool with_ffn, bool write_b = true) {
  const int lane = tidx() & 63, gw = blockIdx.x * NWAVE + (tidx() >> 6), nw = gridDim.x * NWAVE;
  moe_prep(mt, cnt);
  for (int tok = gw; tok < T_; tok += nw) {
    int sl = 0; float gk = 0.f;
    if (lane < TOPK) { sl = mt.of[p.eidx[tok * TOPK + lane]] + p.epos[tok * TOPK + lane]; gk = p.gatev[tok * TOPK + lane]; }
    u32x4_t y[9][2], xh[2], xl[2];
#pragma unroll
    for (int i = 0; i < 2; ++i) {
      xh[i] = reinterpret_cast<const u32x4_t*>(p.x1b + (size_t)tok * D_)[i * 64 + lane];
      xl[i] = reinterpret_cast<const u32x4_t*>(p.x1lo + (size_t)tok * D_)[i * 64 + lane];
      y[8][i] = reinterpret_cast<const u32x4_t*>(p.ybuf + (size_t)(NASG + tok) * D_)[i * 64 + lane];
    }
    float gks[8];
#pragma unroll
    for (int k = 0; k < TOPK; ++k) {
      const int slk = __builtin_amdgcn_readlane(sl, k);
      gks[k] = __builtin_bit_cast(float, __builtin_amdgcn_readlane(__builtin_bit_cast(int, gk), k));
#pragma unroll
      for (int i = 0; i < 2; ++i) y[k][i] = reinterpret_cast<const u32x4_t*>(p.ybuf + (size_t)slk * D_)[i * 64 + lane];
    }
    float v[2][8];
#pragma unroll
    for (int i = 0; i < 2; ++i)
#pragma unroll
      for (int c = 0; c < 4; ++c) {
        float a0 = ALPHA * (bflo(xh[i][c]) + bflo(xl[i][c])), a1 = ALPHA * (bfhi(xh[i][c]) + bfhi(xl[i][c]));
        if (with_ffn) {
          a0 += bflo(y[8][i][c]); a1 += bfhi(y[8][i][c]);
#pragma unroll
          for (int k = 0; k < TOPK; ++k) { a0 += gks[k] * bflo(y[k][i][c]); a1 += gks[k] * bfhi(y[k][i][c]); }
        }
        v[i][2 * c] = a0; v[i][2 * c + 1] = a1;
      }
    float s = 0.f;
#pragma unroll
    for (int i = 0; i < 2; ++i)
#pragma unroll
      for (int c = 0; c < 8; ++c) s += v[i][c];
    const float mu = wave_sum(s) * (1.f / D_);
    float ss = 0.f;
#pragma unroll
    for (int i = 0; i < 2; ++i)
#pragma unroll
      for (int c = 0; c < 8; ++c) { v[i][c] -= mu; ss += v[i][c] * v[i][c]; }
    const float rstd = rsqrtf(wave_sum(ss) * (1.f / D_) + LN_EPS);
#pragma unroll
    for (int i = 0; i < 2; ++i) {
      const int c0 = (i * 64 + lane) * 8;
      float o[8];
#pragma unroll
      for (int h = 0; h < 2; ++h) {
        const float4 gg = ld4(g + c0 + 4 * h), bb = ld4(bt + c0 + 4 * h);
        o[4 * h] = v[i][4 * h] * rstd * gg.x + bb.x; o[4 * h + 1] = v[i][4 * h + 1] * rstd * gg.y + bb.y;
        o[4 * h + 2] = v[i][4 * h + 2] * rstd * gg.z + bb.z; o[4 * h + 3] = v[i][4 * h + 3] * rstd * gg.w + bb.w;
        float4 w; w.x = o[4 * h]; w.y = o[4 * h + 1]; w.z = o[4 * h + 2]; w.w = o[4 * h + 3];
        *reinterpret_cast<float4*>(outf + (size_t)tok * D_ + c0 + 4 * h) = w;
      }
      if (write_b) {
        u32x4_t w; w[0] = cvtpk(o[0], o[1]); w[1] = cvtpk(o[2], o[3]); w[2] = cvtpk(o[4], o[5]); w[3] = cvtpk(o[6], o[7]);
        *reinterpret_cast<u32x4_t*>(outb + (size_t)tok * D_ + c0) = w;
      }
    }
  }
}

DEV void ph_inproj1(const Params& p, GemmSmem& sm) {
  const int tid = tidx(), lane = tid & 63, wid = tid >> 6, wr = wid >> 1, wc = wid & 1, fr = lane & 15, fq = lane >> 4;
  constexpr int NT = 21;
  for (ItemRange it = xcd_items(64 * (NT + 1)); it.i < it.hi; it.i += it.step) {
    int mt, nt; dense_item<16, 2>(it.i, 64, mt, nt);
    if (nt >= NT) continue;
    const int m0 = mt * 256, n0 = nt * 128;
    const u16* ar0 = p.xb + (size_t)(m0 + (tid >> 3)) * D_ + (tid & 7) * 8;
    auto a_addr = [&](int i, int kt) { return ar0 + (size_t)i * 64 * D_ + kt * 64; };
    const u16* bb = p.w16_in1 + (size_t)(tid >> 4) * NIN1 + n0 + 8 * (tid & 15);
    const bool bok = n0 + 8 * (tid & 15) < NIN1;
    const u16* bbv = bok ? bb : p.w16_in1 + (size_t)(tid >> 4) * NIN1;
    auto b_addr = [&](int kt) -> const u16* { return bbv + (size_t)kt * 64 * NIN1; };
    auto b_lo = [&](int) { return false; };
    auto epi = [&](f32x4 (&acc)[4][4]) {
#pragma unroll
      for (int mi = 0; mi < 4; ++mi) {
        const int row = m0 + wr * 64 + mi * 16 + fr;
#pragma unroll
        for (int ni = 0; ni < 4; ++ni) {
          f32x4 v = acc[mi][ni];
          const int col = n0 + wc * 64 + ni * 16 + fq * 4;
          const bool rope = (ni == 0) && (col < 1280 || (col >= 1536 && col < 1792) || (col >= 2048 && col < 2304));
          if (rope) {
            const float4 c_ = ld4(p.cs + row * 16 + 4 * (fq & 1)), s_ = ld4(p.cs + row * 16 + 8 + 4 * (fq & 1));
            const float p0 = __shfl_xor(v[0], 32), p1 = __shfl_xor(v[1], 32), p2 = __shfl_xor(v[2], 32), p3 = __shfl_xor(v[3], 32);
            const float sg = fq < 2 ? -1.f : 1.f;
            v[0] = v[0] * c_.x + sg * p0 * s_.x; v[1] = v[1] * c_.y + sg * p1 * s_.y; v[2] = v[2] * c_.z + sg * p2 * s_.z; v[3] = v[3] * c_.w + sg * p3 * s_.w;
          }
          if (col < LD1) st_bf4(p.qkv + (size_t)row * LD1 + col, v[0], v[1], v[2], v[3]);
          else if (col < NIN1) {
            float4 o; o.x = 1.f / (1.f + __expf(-v[0])); o.y = 1.f / (1.f + __expf(-v[1])); o.z = 1.f / (1.f + __expf(-v[2])); o.w = 1.f / (1.f + __expf(-v[3]));
            *reinterpret_cast<float4*>(p.gates + (size_t)row * 48 + (col - LD1)) = o;
          }
        }
      }
    };
    gemm_core<4, false, true>(sm, 16, a_addr, b_addr, NIN1, b_lo, epi, bok);
  }
}

DEV float gelu_tanh(float x) { const float u = 0.7978845608028654f * (x + 0.044715f * x * x * x); return 0.5f * x * (1.f + tanhf(u)); }
DEV void ph_cmp1(const Params& p, GemmSmem& sm) {
  const int tid = tidx(), lane = tid & 63, wid = tid >> 6, wr = wid >> 1, wc = wid & 1, fr = lane & 15, fq = lane >> 4;
  for (int u = blockIdx.x; u < 64; u += gridDim.x) {
    const int ts = u >> 5, mt = u & 31, m0 = mt * 128;
    const u16* ar[2];
#pragma unroll
    for (int i = 0; i < 2; ++i) {
      const int m_ = m0 + (tid >> 3) + 64 * i, bg = m_ >> 8; int c = m_ & 255; c = c < 255 ? c : 254;
      ar[i] = p.qkv + (size_t)((bg >> 2) * S_ + 16 * c) * LD1 + (ts ? 1280 : 1024) + (bg & 3) * 64 + (tid & 7) * 8;
    }
    auto a_addr = [&](int i, int kt) { return ar[i] + (size_t)kt * LD1; };
    const float* bb = (ts ? p.cmpv_w1 : p.cmpk_w1) + (size_t)(tid >> 5) * 128 + 4 * (tid & 31);
    auto b_addr = [&](int kt) { return bb + (size_t)kt * 64 * 128; };
    auto b_lo = [&](int) { return false; };
    auto epi = [&](f32x4 (&acc)[2][4]) {
#pragma unroll
      for (int mi = 0; mi < 2; ++mi)
#pragma unroll
        for (int ni = 0; ni < 4; ++ni) {
          const int m = m0 + wr * 32 + mi * 16 + fr, col = wc * 64 + ni * 16 + fq * 4;
          const float4 pbv = ld4(p.pb + ts * 128 + col);
          st_bf4(p.hid + ((size_t)ts * 4096 + m) * 128 + col, gelu_tanh(acc[mi][ni][0] + pbv.x), gelu_tanh(acc[mi][ni][1] + pbv.y),
                 gelu_tanh(acc[mi][ni][2] + pbv.z), gelu_tanh(acc[mi][ni][3] + pbv.w));
        }
    };
    gemm_core<2, false>(sm, 32, a_addr, b_addr, 128, b_lo, epi);
  }
}
DEV void ph_cmp2(const Params& p, GemmSmem& sm) {
  const int tid = tidx(), lane = tid & 63, wid = tid >> 6, wr = wid >> 1, wc = wid & 1, fr = lane & 15, fq = lane >> 4;
  for (int u = blockIdx.x; u < 64; u += gridDim.x) {
    const int ts = u >> 5, mt = u & 31, m0 = mt * 128;
    const u16* ar0 = p.hid + ((size_t)ts * 4096 + m0 + (tid >> 3)) * 128 + (tid & 7) * 8;
    auto a_addr = [&](int i, int kt) { return ar0 + (size_t)i * 64 * 128 + kt * 64; };
    const float* bb = (ts ? p.cmpv_w2 : p.cmpk_w2) + (size_t)(tid >> 5) * 64 + 4 * (tid & 31);
    const bool bok = 4 * (tid & 31) < 64;
    const float* bbv = bok ? bb : (ts ? p.cmpv_w2 : p.cmpk_w2) + (size_t)(tid >> 5) * 64;
    auto b_addr = [&](int kt) -> const float* { return bbv + (size_t)kt * 64 * 64; };
    auto b_lo = [&](int) { return false; };
    auto epi = [&](f32x4 (&acc)[2][4]) {
      if (wc == 0) {
#pragma unroll
        for (int mi = 0; mi < 2; ++mi)
#pragma unroll
          for (int ni = 0; ni < 4; ++ni) {
            const int m = m0 + wr * 32 + mi * 16 + fr, col = ni * 16 + fq * 4;
            st_bf4(p.cmpkv + ((size_t)ts * 4096 + m) * 64 + col, acc[mi][ni][0], acc[mi][ni][1], acc[mi][ni][2], acc[mi][ni][3]);
          }
      }
    };
    gemm_core<2, false>(sm, 2, a_addr, b_addr, 64, b_lo, epi, bok);
  }
}

DEV void ph_attn1(const Params& p, AttnSmem& sm) {
  const int tid = tidx(), lane = tid & 63, wid = tid >> 6;
  float* qs = sm.qs[wid]; float* sc = sm.sc[wid]; int* tk = sm.tk[wid]; int* tw = sm.tw[wid];
  const int gw = blockIdx.x * NWAVE + wid, nw = gridDim.x * NWAVE;
  for (int u = gw; u < T_ * 4; u += nw) {
    const int tg = u >> 2, g = u & 3, b = tg >> 12, t = tg & 4095, cur = t >> 6;
    const u16* row = p.qkv + (size_t)tg * LD1;
    const int nvalid = t >= 31 ? (((t - 31) >> 4) + 1 < 255 ? ((t - 31) >> 4) + 1 : 255) : 0;
    const int n4c = (nvalid + 3) & ~3;
    const u16* kc = p.cmpkv + (size_t)((b * 4 + g) * 256) * 64;
    const u16* vc = p.cmpkv + (size_t)(4096 + (b * 4 + g) * 256) * 64;
    float imp = 0.f;
    float ocmp[4][4];
#pragma unroll
    for (int r = 0; r < 4; ++r) {
      ocmp[r][0] = ocmp[r][1] = ocmp[r][2] = ocmp[r][3] = 0.f;
      if (nvalid > 0) {
        qs[lane] = bf2f(row[(g * 4 + r) * 64 + lane]) * 0.125f;
        for (int i = lane; i < n4c; i += 64) tk[i] = i < nvalid ? i : -1;
        WAVE_SYNC();
        const float inv = wave_attn(qs, sc, tk, n4c, kc, vc, 64, -INFINITY, lane, ocmp[r]);
        WAVE_SYNC();
        float a = 0.f;
        const int c0 = 4 * lane;
        if (c0 - 1 >= 0 && c0 - 1 < nvalid) a += 0.5f * sc[c0 - 1];
        if (c0 < nvalid) a += sc[c0];
        if (c0 + 1 < nvalid) a += sc[c0 + 1];
        if (c0 + 2 < nvalid) a += sc[c0 + 2];
        if (c0 + 3 < nvalid) a += 0.5f * sc[c0 + 3];
        imp += a * inv;
        WAVE_SYNC();
      }
    }
    const float score = (lane > cur) ? -1.f : ((lane == 0 || lane == cur || lane == cur - 1) ? 1.0e4f : imp);
    int rk = 0;
    for (int jj = 0; jj < 64; ++jj) { const float sj = __shfl(score, jj); rk += (sj > score || (sj == score && jj < lane)) ? 1 : 0; }
    unsigned long long mask = __ballot(rk < 16 && lane <= cur);
    int nsel = 0;
    while (mask) {
      const int j = __ffsll((long long)mask) - 1; mask &= mask - 1;
      const int tok = j * 64 + lane;
      tk[nsel * 64 + lane] = tok <= t ? b * S_ + tok : -1;
      ++nsel;
    }
    for (int i = lane; i < 512; i += 64) { const int tok = t - i; tw[i] = tok >= 0 ? b * S_ + tok : -1; }
    WAVE_SYNC();
#pragma unroll
    for (int r = 0; r < 4; ++r) {
      const int h = g * 4 + r;
      qs[lane] = bf2f(row[h * 64 + lane]) * 0.125f;
      WAVE_SYNC();
      float os[4], ow[4];
      wave_attn(qs, sc, tk, nsel * 64, p.qkv + 1536 + g * 64, p.qkv + 1792 + g * 64, LD1, -INFINITY, lane, os);
      WAVE_SYNC();
      wave_attn(qs, sc, tw, 512, p.qkv + 2048 + g * 64, p.qkv + 2304 + g * 64, LD1, -INFINITY, lane, ow);
      const float g0 = p.gates[(size_t)tg * 48 + h * 3], g1 = p.gates[(size_t)tg * 48 + h * 3 + 1], g2 = p.gates[(size_t)tg * 48 + h * 3 + 2];
      if (lane < 16) {
        uint2 w;
        w.x = pack2(g0 * ocmp[r][0] + g1 * os[0] + g2 * ow[0], g0 * ocmp[r][1] + g1 * os[1] + g2 * ow[1]);
        w.y = pack2(g0 * ocmp[r][2] + g1 * os[2] + g2 * ow[2], g0 * ocmp[r][3] + g1 * os[3] + g2 * ow[3]);
        *reinterpret_cast<uint2*>(p.ao + (size_t)tg * D_ + h * 64 + lane * 4) = w;
      }
      WAVE_SYNC();
    }
  }
}


using f32x16 = __attribute__((ext_vector_type(16))) float;
DEV int crow(int r, int hi) { return (r & 3) + 8 * (r >> 2) + 4 * hi; }
constexpr float LOG2E = 1.4426950408889634f;
constexpr float SCL2 = 0.125f * LOG2E;

struct WaveTile { u16 K[32][72]; u16 V[2][32][32]; float imp[32][64]; unsigned long long msk[32]; };
struct KVTile { u16 K[32][72]; u16 V[2][32][32]; };
struct AttnState { float m, l; f32x16 o[2]; };

DEV void stage_load(u32x4_t (&rk)[4], u32x4_t (&rv)[4], const u16* Kb, const u16* Vb, int ld, long rowbase, int rowstep, int kcmax, int k0, int lane) {
#pragma unroll
  for (int it = 0; it < 4; ++it) {
    int kc = k0 + (lane >> 3) + 8 * it; kc = kc > kcmax ? kcmax : kc;
    const long row = rowbase + (long)kc * rowstep;
    rk[it] = *reinterpret_cast<const u32x4_t*>(Kb + row * ld + (lane & 7) * 8);
    rv[it] = *reinterpret_cast<const u32x4_t*>(Vb + row * ld + (lane & 7) * 8);
  }
}
DEV void stage_store(WaveTile& wt, const u32x4_t (&rk)[4], const u32x4_t (&rv)[4], int lane) {
  const int ch = lane & 7;
#pragma unroll
  for (int it = 0; it < 4; ++it) {
    const int j = (lane >> 3) + 8 * it;
    *reinterpret_cast<u32x4_t*>(&wt.K[j][ch * 8]) = rk[it];
    *reinterpret_cast<u32x4_t*>(&wt.V[ch >> 2][j][(ch & 3) * 8]) = rv[it];
  }
}
template <class TT> DEV f32x16 qk_tile(const TT& wt, const bf16x8 (&qf)[4], int r32, int hi) {
  f32x16 acc;
#pragma unroll
  for (int r = 0; r < 16; ++r) acc[r] = 0.f;
#pragma unroll
  for (int s = 0; s < 4; ++s) {
    const bf16x8 kf = *reinterpret_cast<const bf16x8*>(&wt.K[r32][16 * s + 8 * hi]);
    acc = __builtin_amdgcn_mfma_f32_32x32x16_bf16(kf, qf[s], acc, 0, 0, 0);
  }
  return acc;
}
template <class TT> DEV void pv_tile(const TT& wt, const float (&pr)[16], f32x16 (&o)[2], int lane) {
  const int hi = lane >> 5, g = (lane >> 4) & 1, q4 = (lane & 15) >> 2, p4 = lane & 3;
  bf16x8 pf[2];
#pragma unroll
  for (int s2 = 0; s2 < 2; ++s2) {
    u32x4_t w;
    w[0] = cvtpk(pr[8 * s2 + 0], pr[8 * s2 + 1]); w[1] = cvtpk(pr[8 * s2 + 2], pr[8 * s2 + 3]);
    w[2] = cvtpk(pr[8 * s2 + 4], pr[8 * s2 + 5]); w[3] = cvtpk(pr[8 * s2 + 6], pr[8 * s2 + 7]);
    pf[s2] = __builtin_bit_cast(bf16x8, w);
  }
#pragma unroll
  for (int dt = 0; dt < 2; ++dt)
#pragma unroll
    for (int s2 = 0; s2 < 2; ++s2) {
      const v4i16_t lo = lds_tr(&wt.V[dt][16 * s2 + 4 * hi + q4][16 * g + 4 * p4]);
      const v4i16_t hh = lds_tr(&wt.V[dt][16 * s2 + 8 + 4 * hi + q4][16 * g + 4 * p4]);
      const bf16x8 vf = {lo[0], lo[1], lo[2], lo[3], hh[0], hh[1], hh[2], hh[3]};
      o[dt] = __builtin_amdgcn_mfma_f32_32x32x16_bf16(vf, pf[s2], o[dt], 0, 0, 0);
    }
}
DEV void attn_init(AttnState& st) {
  st.m = -INFINITY; st.l = 0.f;
#pragma unroll
  for (int r = 0; r < 16; ++r) { st.o[0][r] = 0.f; st.o[1][r] = 0.f; }
}
template <bool USE_SEL>
DEV void attn_span(AttnState& st, WaveTile& wt, const bf16x8 (&qf)[4], const u16* Kb, const u16* Vb, int ld,
                   long rowbase, int rowstep, int kcmax, int kc_lo, int kc_hi, int qc, int W,
                   unsigned long long sel, unsigned long long selu, int lane, int qc_min, int qc_max) {
  const int r32 = lane & 31, hi = lane >> 5;
  if (kc_lo < 0) kc_lo = 0;
  if (kc_hi > kcmax) kc_hi = kcmax;
  const int full_hi = qc_min < kcmax ? qc_min : kcmax;
  auto skip = [&](int k0) -> bool { return USE_SEL && !((selu >> (k0 >> 6)) & 1ull); };
  int kc0 = kc_lo & ~31;
  while (kc0 <= kc_hi && skip(kc0)) kc0 += 32;
  if (kc0 > kc_hi) return;
  u32x4_t rk[4], rv[4];
  stage_load(rk, rv, Kb, Vb, ld, rowbase, rowstep, kcmax, kc0, lane);
  for (;;) {
    stage_store(wt, rk, rv, lane);
    int kn = kc0 + 32;
    while (kn <= kc_hi && skip(kn)) kn += 32;
    if (kn <= kc_hi) stage_load(rk, rv, Kb, Vb, ld, rowbase, rowstep, kcmax, kn, lane);
    WAVE_SYNC();
    const f32x16 s = qk_tile(wt, qf, r32, hi);
    const bool selbit = USE_SEL ? (((sel >> (kc0 >> 6)) & 1ull) != 0ull) : true;
    const bool full = (qc_min <= qc_max) && (kc0 + 31 <= full_hi) && (kc0 >= qc_max - W);
    float sv[16]; float mt = -INFINITY;
    if (full) {
      float rm = s[0];
#pragma unroll
      for (int r = 1; r < 16; ++r) rm = fmaxf(rm, s[r]);
      mt = selbit ? rm * SCL2 : -INFINITY;
    } else {
#pragma unroll
      for (int r = 0; r < 16; ++r) {
        const int kc = kc0 + crow(r, hi), dist = qc - kc;
        const bool ok = selbit && kc <= kcmax && dist >= 0 && dist <= W;
        sv[r] = ok ? s[r] * SCL2 : -INFINITY;
        mt = fmaxf(mt, sv[r]);
      }
    }
    mt = fmaxf(mt, __shfl_xor(mt, 32));
    const float mnew = fmaxf(st.m, mt), muse = (mnew == -INFINITY) ? 0.f : mnew;
    const float alpha = __builtin_amdgcn_exp2f(st.m - muse);
    st.m = mnew;
    float ps = 0.f;
    if (full) {
      const float sub = selbit ? muse : INFINITY;
#pragma unroll
      for (int r = 0; r < 16; ++r) { sv[r] = __builtin_amdgcn_exp2f(__builtin_fmaf(s[r], SCL2, -sub)); ps += sv[r]; }
    } else {
#pragma unroll
      for (int r = 0; r < 16; ++r) { sv[r] = __builtin_amdgcn_exp2f(sv[r] - muse); ps += sv[r]; }
    }
    st.l = st.l * alpha + ps;
    if (__any(alpha != 1.f)) {
#pragma unroll
      for (int r = 0; r < 16; ++r) { st.o[0][r] *= alpha; st.o[1][r] *= alpha; }
    }
    pv_tile(wt, sv, st.o, lane);
    if (kn > kc_hi) break;
    kc0 = kn;
  }
}
DEV void attn_finish(AttnState& st, float sink2) {
  float l = st.l + __shfl_xor(st.l, 32);
  if (sink2 > -INFINITY) l += __builtin_amdgcn_exp2f(sink2 - st.m);
  const float inv = l > 0.f ? 1.f / l : 0.f;
#pragma unroll
  for (int r = 0; r < 16; ++r) { st.o[0][r] *= inv; st.o[1][r] *= inv; }
}
DEV void attn_store_bf16(const AttnState& st, u16* orow, int hi) {
#pragma unroll
  for (int dt = 0; dt < 2; ++dt)
#pragma unroll
    for (int k4 = 0; k4 < 4; ++k4) {
      uint2 w; w.x = cvtpk(st.o[dt][4 * k4], st.o[dt][4 * k4 + 1]); w.y = cvtpk(st.o[dt][4 * k4 + 2], st.o[dt][4 * k4 + 3]);
      *reinterpret_cast<uint2*>(orow + 32 * dt + 8 * k4 + 4 * hi) = w;
    }
}
DEV void load_qf(bf16x8 (&qf)[4], const u16* qrow, int hi) {
#pragma unroll
  for (int s = 0; s < 4; ++s) qf[s] = *reinterpret_cast<const bf16x8*>(qrow + 16 * s + 8 * hi);
}

DEV void ph_attn0_mfma(const Params& p, WaveTile* wts) {
  const int tid = tidx(), lane = tid & 63, wid = tid >> 6, r32 = lane & 31, hi = lane >> 5;
  WaveTile& wt = wts[wid];
  const int gw = blockIdx.x * NWAVE + wid, nw = gridDim.x * NWAVE;
  for (int u = gw; u < 8192; u += nw) {
    AttnState st; attn_init(st);
    bf16x8 qf[4];
    if (u < 4096) {
      const int it = u & 7, res = (u >> 3) & 15, h = (u >> 7) & 7, b = u >> 10;
      const int i0 = it * 32, t = 16 * (i0 + r32) + res;
      const long row = (long)b * S_ + t;
      load_qf(qf, p.qkv + row * LD0 + h * 64, hi);
      const u16* Kb = p.qkv + 512 + h * 64; const u16* Vb = p.qkv + 1024 + h * 64;
      attn_span<false>(st, wt, qf, Kb, Vb, LD0, (long)b * S_ + res, 16, 255, i0 - 128, i0 + 31, i0 + r32, 128, 0ull, 0ull, lane, 1, 0);
      const int c = res >> 2;
      attn_span<false>(st, wt, qf, Kb, Vb, LD0, (long)b * S_ + (res & 3), 4, 1023, 4 * i0 + c - 128, 4 * (i0 + 31) + c, 4 * (i0 + r32) + c, 128, 0ull, 0ull, lane, 1, 0);
      attn_span<false>(st, wt, qf, Kb, Vb, LD0, (long)b * S_, 1, 4095, 16 * i0 + res - 128, 16 * (i0 + 31) + res, t, 128, 0ull, 0ull, lane, 1, 0);
      attn_finish(st, -INFINITY);
      attn_store_bf16(st, p.ao + row * D_ + h * 64, hi);
    } else {
      const int v = u - 4096, qt = v & 127, hb = (v >> 7) & 7, b = v >> 10, g = hb >> 2;
      const int t = 32 * qt + r32;
      const long row = (long)b * S_ + t;
      load_qf(qf, p.qkv + row * LD0 + 1536 + hb * 64, hi);
      attn_span<false>(st, wt, qf, p.qkv + 2048 + g * 64, p.qkv + 2176 + g * 64, LD0, (long)b * S_, 1, 4095, 32 * qt - 127, 32 * qt + 31, t, 127, 0ull, 0ull, lane, 32 * qt, 32 * qt + 31);
      attn_finish(st, p.even_sinks[hb] * LOG2E);
      attn_store_bf16(st, p.ao + row * D_ + 512 + hb * 64, hi);
    }
  }
}

struct Att1aSmem { KVTile tiles[2][2]; float imp[2][32][65]; float sc[NWAVE][64]; };
DEV void ph_attn1a(const Params& p, char* smem) {
  Att1aSmem& sm = *reinterpret_cast<Att1aSmem*>(smem);
  const int tid = tidx(), lane = tid & 63, wid = tid >> 6, r32 = lane & 31, hi = lane >> 5, gl = wid >> 2;
  const int sg = tid >> 8, sj = (tid & 255) >> 3, sc = tid & 7;
  for (int u = blockIdx.x; u < 1024; u += gridDim.x) {
    const int k = u >> 8, base = u & 255, bg = base & 7, x = base >> 3;
    const int qt = (k == 0) ? 127 - x : (k == 1) ? 64 + x : (k == 2) ? 63 - x : x;
    const int b = bg >> 1, gp = bg & 1;
    const int h = gp * 8 + wid, g = h >> 2;
    const int q0 = 32 * qt, t = q0 + r32;
    const long row = (long)b * S_ + t;
    const int qc = (t - 31) >> 4;
    int kc_hi = q0 >> 4; kc_hi = kc_hi > 254 ? 254 : kc_hi;
    const int ntile = (kc_hi >> 5) + 1;
    const u16* kp = p.cmpkv + ((size_t)((b * 4 + 2 * gp + sg) * 256) + sj) * 64 + sc * 8;
    const u16* vp = kp + (size_t)4096 * 64;
    for (int i = tid; i < 2 * 32 * 65; i += NTHR) (&sm.imp[0][0][0])[i] = 0.f;
    bf16x8 qf[4];
    load_qf(qf, p.qkv + row * LD1 + h * 64, hi);
    auto for_tiles = [&](auto&& body) {
      u32x4_t rk = *reinterpret_cast<const u32x4_t*>(kp), rv = *reinterpret_cast<const u32x4_t*>(vp);
      int cur = 0;
      for (int tt = 0; tt < ntile; ++tt) {
        KVTile& dst = sm.tiles[cur][sg];
        *reinterpret_cast<u32x4_t*>(&dst.K[sj][sc * 8]) = rk;
        *reinterpret_cast<u32x4_t*>(&dst.V[sc >> 2][sj][(sc & 3) * 8]) = rv;
        const int tn = tt + 1 < ntile ? tt + 1 : tt;
        rk = *reinterpret_cast<const u32x4_t*>(kp + (size_t)tn * 32 * 64);
        rv = *reinterpret_cast<const u32x4_t*>(vp + (size_t)tn * 32 * 64);
        __syncthreads();
        body(sm.tiles[cur][gl], tt * 32);
        cur ^= 1;
      }
      __syncthreads();
    };
    float m = -INFINITY, l = 0.f;
    for_tiles([&](const KVTile& tl, int kc0) {
      const f32x16 s = qk_tile(tl, qf, r32, hi);
      float sv[16]; float mt = -INFINITY;
#pragma unroll
      for (int rr = 0; rr < 16; ++rr) { const int kc = kc0 + crow(rr, hi); const bool ok = kc <= 254 && kc <= qc; sv[rr] = ok ? s[rr] * SCL2 : -INFINITY; mt = fmaxf(mt, sv[rr]); }
      mt = fmaxf(mt, __shfl_xor(mt, 32));
      const float mnew = fmaxf(m, mt), muse = (mnew == -INFINITY) ? 0.f : mnew;
      float ps = 0.f;
#pragma unroll
      for (int rr = 0; rr < 16; ++rr) ps += __builtin_amdgcn_exp2f(sv[rr] - muse);
      l = l * __builtin_amdgcn_exp2f(m - muse) + ps; m = mnew;
    });
    l += __shfl_xor(l, 32);
    const float inv = l > 0.f ? 1.f / l : 0.f, muse = (m == -INFINITY) ? 0.f : m;
    f32x16 o[2];
#pragma unroll
    for (int rr = 0; rr < 16; ++rr) { o[0][rr] = 0.f; o[1][rr] = 0.f; }
    for_tiles([&](const KVTile& tl, int kc0) {
      const f32x16 s = qk_tile(tl, qf, r32, hi);
      float pr[16];
#pragma unroll
      for (int rr = 0; rr < 16; ++rr) { const int kc = kc0 + crow(rr, hi); const bool ok = kc <= 254 && kc <= qc; pr[rr] = ok ? __builtin_amdgcn_exp2f(s[rr] * SCL2 - muse) * inv : 0.f; }
#pragma unroll
      for (int k4 = 0; k4 < 4; ++k4) {
        const int j = (kc0 >> 2) + 2 * k4 + hi;
        atomicAdd(&sm.imp[gl][r32][j], pr[4 * k4] + pr[4 * k4 + 1] + pr[4 * k4 + 2] + 0.5f * pr[4 * k4 + 3]);
        if (j + 1 < 64) atomicAdd(&sm.imp[gl][r32][j + 1], 0.5f * pr[4 * k4 + 3]);
      }
      pv_tile(tl, pr, o, lane);
    });
    const float g0 = p.gates[(size_t)row * 48 + h * 3];
#pragma unroll
    for (int dt = 0; dt < 2; ++dt)
#pragma unroll
      for (int k4 = 0; k4 < 4; ++k4) {
        float4 w; w.x = g0 * o[dt][4 * k4]; w.y = g0 * o[dt][4 * k4 + 1]; w.z = g0 * o[dt][4 * k4 + 2]; w.w = g0 * o[dt][4 * k4 + 3];
        *reinterpret_cast<float4*>(p.hpre + (size_t)row * D_ + h * 64 + 32 * dt + 8 * k4 + 4 * hi) = w;
      }
    for (int i = 0; i < 8; ++i) {
      const int pi = wid * 8 + i, grp = pi >> 5, q = pi & 31;
      const int tq = q0 + q, cur = tq >> 6;
      const float score = (lane > cur) ? -1.f : ((lane == 0 || lane == cur || lane == cur - 1) ? 1.0e4f : sm.imp[grp][q][lane]);
      sm.sc[wid][lane] = score;
      WAVE_SYNC();
      int rk_ = 0;
#pragma unroll
      for (int jj = 0; jj < 64; jj += 4) {
        const float4 v = *reinterpret_cast<const float4*>(&sm.sc[wid][jj]);
        rk_ += (v.x > score || (v.x == score && jj < lane)) ? 1 : 0;
        rk_ += (v.y > score || (v.y == score && jj + 1 < lane)) ? 1 : 0;
        rk_ += (v.z > score || (v.z == score && jj + 2 < lane)) ? 1 : 0;
        rk_ += (v.w > score || (v.w == score && jj + 3 < lane)) ? 1 : 0;
      }
      WAVE_SYNC();
      const unsigned long long mask = __ballot(rk_ < 16 && lane <= cur);
      if (lane == 0) p.selmask[((size_t)b * S_ + tq) * 4 + 2 * gp + grp] = mask;
    }
    __syncthreads();
  }
}

template <class TT>
DEV void attn_tile_update(AttnState& st, const TT& tl, const bf16x8 (&qf)[4], int kc0, int qc, int W, int kcmax, bool selbit, bool full, int lane) {
  const int r32 = lane & 31, hi = lane >> 5;
  const f32x16 s = qk_tile(tl, qf, r32, hi);
  float sv[16]; float mt = -INFINITY;
  if (full) {
    float rm = s[0];
#pragma unroll
    for (int r = 1; r < 16; ++r) rm = fmaxf(rm, s[r]);
    mt = selbit ? rm * SCL2 : -INFINITY;
  } else {
#pragma unroll
    for (int r = 0; r < 16; ++r) {
      const int kc = kc0 + crow(r, hi), dist = qc - kc;
      const bool ok = selbit && kc <= kcmax && dist >= 0 && dist <= W;
      sv[r] = ok ? s[r] * SCL2 : -INFINITY;
      mt = fmaxf(mt, sv[r]);
    }
  }
  mt = fmaxf(mt, __shfl_xor(mt, 32));
  const float mnew = fmaxf(st.m, mt), muse = (mnew == -INFINITY) ? 0.f : mnew;
  const float alpha = __builtin_amdgcn_exp2f(st.m - muse);
  st.m = mnew;
  float ps = 0.f;
  if (full) {
    const float sub = selbit ? muse : INFINITY;
#pragma unroll
    for (int r = 0; r < 16; ++r) { sv[r] = __builtin_amdgcn_exp2f(__builtin_fmaf(s[r], SCL2, -sub)); ps += sv[r]; }
  } else {
#pragma unroll
    for (int r = 0; r < 16; ++r) { sv[r] = __builtin_amdgcn_exp2f(sv[r] - muse); ps += sv[r]; }
  }
  st.l = st.l * alpha + ps;
  if (__any(alpha != 1.f)) {
#pragma unroll
    for (int r = 0; r < 16; ++r) { st.o[0][r] *= alpha; st.o[1][r] *= alpha; }
  }
  pv_tile(tl, sv, st.o, lane);
}

template <bool USE_SEL>
DEV void attn_span_shared(AttnState& st, KVTile (*tiles)[2], const Params& p, const bf16x8 (&qf)[4], int b, int gp, int kcol, int vcol,
                          int t_lo, int t_hi, int qc, int W, unsigned long long sel, int q0) {
  const int tid = tidx(), lane = tid & 63, wid = tid >> 6, gl = wid >> 2;
  const int sg = tid >> 8, sj = (tid & 255) >> 3, sc = tid & 7;
  const u16* kp = p.qkv + (size_t)b * S_ * LD1 + kcol + (2 * gp + sg) * 64 + (size_t)sj * LD1 + sc * 8;
  const u16* vp = p.qkv + (size_t)b * S_ * LD1 + vcol + (2 * gp + sg) * 64 + (size_t)sj * LD1 + sc * 8;
  u32x4_t rk = *reinterpret_cast<const u32x4_t*>(kp + (size_t)t_lo * 32 * LD1);
  u32x4_t rv = *reinterpret_cast<const u32x4_t*>(vp + (size_t)t_lo * 32 * LD1);
  int cur = 0;
  for (int t = t_lo; t <= t_hi; ++t) {
    KVTile& dst = tiles[cur][sg];
    *reinterpret_cast<u32x4_t*>(&dst.K[sj][sc * 8]) = rk;
    *reinterpret_cast<u32x4_t*>(&dst.V[sc >> 2][sj][(sc & 3) * 8]) = rv;
    const int tn = t < t_hi ? t + 1 : t;
    rk = *reinterpret_cast<const u32x4_t*>(kp + (size_t)tn * 32 * LD1);
    rv = *reinterpret_cast<const u32x4_t*>(vp + (size_t)tn * 32 * LD1);
    __syncthreads();
    const int kc0 = t * 32;
    const bool selbit = USE_SEL ? (((sel >> (kc0 >> 6)) & 1ull) != 0ull) : true;
    const bool full = (kc0 + 31 <= q0) && (kc0 >= q0 + 31 - W);
    attn_tile_update(st, tiles[cur][gl], qf, kc0, qc, W, 4095, selbit, full, lane);
    cur ^= 1;
  }
  __syncthreads();
}

DEV void ph_attn1b(const Params& p, char* smem) {
  KVTile (*tiles)[2] = reinterpret_cast<KVTile (*)[2]>(smem);
  const int tid = tidx(), lane = tid & 63, wid = tid >> 6, r32 = lane & 31, hi = lane >> 5;
  for (int u = blockIdx.x; u < 1024; u += gridDim.x) {
    const int k = u >> 8, base = u & 255, bg = base & 7, x = base >> 3;
    const int qt = (k == 0) ? 127 - x : (k == 1) ? 64 + x : (k == 2) ? 63 - x : x;
    const int b = bg >> 1, gp = bg & 1;
    const int h = gp * 8 + wid, g = h >> 2;
    const int q0 = 32 * qt, t = q0 + r32;
    const long row = (long)b * S_ + t;
    bf16x8 qf[4];
    load_qf(qf, p.qkv + row * LD1 + h * 64, hi);
    const unsigned long long sel = p.selmask[(size_t)row * 4 + g];
    const float g1 = p.gates[(size_t)row * 48 + h * 3 + 1], g2 = p.gates[(size_t)row * 48 + h * 3 + 2];
    AttnState st; attn_init(st);
    attn_span_shared<true>(st, tiles, p, qf, b, gp, 1536, 1792, 0, qt, t, 1 << 30, sel, q0);
    attn_finish(st, -INFINITY);
    f32x16 acc[2];
#pragma unroll
    for (int rr = 0; rr < 16; ++rr) { acc[0][rr] = g1 * st.o[0][rr]; acc[1][rr] = g1 * st.o[1][rr]; }
    attn_init(st);
    const int wlo = q0 - 511 > 0 ? (q0 - 511) >> 5 : 0;
    attn_span_shared<false>(st, tiles, p, qf, b, gp, 2048, 2304, wlo, qt, t, 511, 0ull, q0);
    attn_finish(st, -INFINITY);
#pragma unroll
    for (int dt = 0; dt < 2; ++dt)
#pragma unroll
      for (int k4 = 0; k4 < 4; ++k4) {
        const float4 c = *reinterpret_cast<const float4*>(p.hpre + (size_t)row * D_ + h * 64 + 32 * dt + 8 * k4 + 4 * hi);
        uint2 w;
        w.x = cvtpk(c.x + acc[dt][4 * k4] + g2 * st.o[dt][4 * k4], c.y + acc[dt][4 * k4 + 1] + g2 * st.o[dt][4 * k4 + 1]);
        w.y = cvtpk(c.z + acc[dt][4 * k4 + 2] + g2 * st.o[dt][4 * k4 + 2], c.w + acc[dt][4 * k4 + 3] + g2 * st.o[dt][4 * k4 + 3]);
        *reinterpret_cast<uint2*>(p.ao + (size_t)row * D_ + h * 64 + 32 * dt + 8 * k4 + 4 * hi) = w;
      }
  }
}

#ifndef DEBUG_ATT
#define DEBUG_ATT 0
#endif
enum { PH_PRO = 0, PH_IN0, PH_ATT0, PH_OUT0, PH_LN0, PH_RG0, PH_RT0, PH_M10, PH_M20, PH_CB0,
       PH_IN1, PH_C1, PH_C2, PH_ATT1, PH_OUT1, PH_LN1, PH_RG1, PH_RT1, PH_M11, PH_M21, PH_CB1,
       PH_ATT1A, PH_ATT1B, PH_ATT0N, PH_ATT1N, PH_DBG_SAVE, PH_DBG_CMP, PH_DBG_SCALE };

DEV void ph_dbg_save(const Params& p) {
  const size_t gtid = (size_t)blockIdx.x * NTHR + tidx(), gsz = (size_t)gridDim.x * NTHR;
  for (size_t i = gtid; i < (size_t)T_ * D_ / 8; i += gsz) reinterpret_cast<uint4*>(p.ybuf)[i] = reinterpret_cast<const uint4*>(p.ao)[i];
}
DEV void ph_dbg_cmp(const Params& p) {
  const size_t gtid = (size_t)blockIdx.x * NTHR + tidx(), gsz = (size_t)gridDim.x * NTHR;
  float d2 = 0.f, r2 = 0.f;
  for (size_t i = gtid; i < (size_t)T_ * D_; i += gsz) { const float a = bf2f(p.ao[i]), r = bf2f(p.ybuf[i]); d2 += (a - r) * (a - r); r2 += r * r; }
  d2 = wave_sum(d2); r2 = wave_sum(r2);
  if ((tidx() & 63) == 0) { atomicAdd(&p.dbg[0], d2); atomicAdd(&p.dbg[1], r2); }
}
DEV void ph_dbg_scale(const Params& p) {
  const float e = p.dbg[0] / p.dbg[1];
  const float sc = 1.f + sqrtf(1000.f * e);
  const size_t gtid = (size_t)blockIdx.x * NTHR + tidx(), gsz = (size_t)gridDim.x * NTHR;
  for (size_t i = gtid; i < (size_t)T_ * D_; i += gsz) p.out[i] *= sc;
}

template <int PH> DEV void run_phase(const Params& p, char* smem) {
  GemmSmem& gs = *reinterpret_cast<GemmSmem*>(smem);
  AttnSmem& as = *reinterpret_cast<AttnSmem*>(smem);
  WaveTile* wts = reinterpret_cast<WaveTile*>(smem);
  MoeTab& mt = *reinterpret_cast<MoeTab*>(smem + sizeof(GemmSmem));
  if constexpr (PH == PH_PRO) ph_prologue(p);
  else if constexpr (PH == PH_IN0) ph_inproj0(p, gs);
  else if constexpr (PH == PH_ATT0) ph_attn0_mfma(p, wts);
  else if constexpr (PH == PH_ATT0N) ph_attn0(p, as);
  else if constexpr (PH == PH_OUT0) ph_outproj(p, gs, p.w16_out0, p.x);
  else if constexpr (PH == PH_LN0) ph_ln_mix(p, p.mix_g, p.mix_b);
  else if constexpr (PH == PH_RG0) ph_router_gemm(p, smem, p.rw16);
  else if constexpr (PH == PH_RT0) ph_route<false>(p, p.router_b, p.cnt, p.router_w, p.etok);
  else if constexpr (PH == PH_M10) ph_moe1(p, gs, mt, 0, p.cnt);
  else if constexpr (PH == PH_M20) ph_moe2(p, gs, mt, 0, p.cnt);
  else if constexpr (PH == PH_CB0) ph_combine_ln(p, mt, p.cnt, p.ffn_g, p.ffn_b, p.x2f, p.xb, true);
  else if constexpr (PH == PH_IN1) ph_inproj1(p, gs);
  else if constexpr (PH == PH_C1) ph_cmp1(p, gs);
  else if constexpr (PH == PH_C2) ph_cmp2(p, gs);
  else if constexpr (PH == PH_ATT1) ph_attn1(p, as);
  else if constexpr (PH == PH_ATT1N) ph_attn1(p, as);
  else if constexpr (PH == PH_ATT1A) ph_attn1a(p, smem);
  else if constexpr (PH == PH_ATT1B) ph_attn1b(p, smem);
  else if constexpr (PH == PH_OUT1) ph_outproj(p, gs, p.w16_out1, p.x2f);
  else if constexpr (PH == PH_LN1) ph_ln_mix(p, p.mix_g + D_, p.mix_b + D_);
  else if constexpr (PH == PH_RG1) ph_router_gemm(p, smem, p.rw16 + (size_t)2 * D_ * NE);
  else if constexpr (PH == PH_RT1) ph_route<false>(p, p.router_b + NE, p.cnt + 512, p.router_w + (size_t)D_ * NE, p.etok);
  else if constexpr (PH == PH_M11) ph_moe1(p, gs, mt, 1, p.cnt + 512);
  else if constexpr (PH == PH_M21) ph_moe2(p, gs, mt, 1, p.cnt + 512);
  else if constexpr (PH == PH_CB1) ph_combine_ln(p, mt, p.cnt + 512, p.ffn_g + D_, p.ffn_b + D_, p.out, p.xb, true, false);
  else if constexpr (PH == PH_DBG_SAVE) ph_dbg_save(p);
  else if constexpr (PH == PH_DBG_CMP) ph_dbg_cmp(p);
  else if constexpr (PH == PH_DBG_SCALE) ph_dbg_scale(p);
}

constexpr int SMEM_NEED0 = (NWAVE * (int)sizeof(WaveTile) > (int)(sizeof(GemmSmem) + sizeof(MoeTab))) ? NWAVE * (int)sizeof(WaveTile) : (int)(sizeof(GemmSmem) + sizeof(MoeTab));
constexpr int SMEM_NEED = SMEM_NEED0 > (int)sizeof(RouterSmem) ? SMEM_NEED0 : (int)sizeof(RouterSmem);
constexpr int SMEM_BAR_OFF = (SMEM_NEED + 15) & ~15, SMEM_BYTES = SMEM_BAR_OFF + 16;
static_assert(SMEM_BAR_OFF >= (int)sizeof(AttnSmem) && SMEM_BAR_OFF >= (int)(sizeof(GemmSmem) + sizeof(MoeTab)), "LDS carve-up");
template <int PH, bool LAST> DEV void phase_and_sync(const Params& p, char* smem, const XcdBarrier& bar) {
  run_phase<PH>(p, smem);
  if constexpr (!LAST) xcd_barrier(bar);
}
template <int... PHS> struct PhaseList {};
template <int P0> DEV void run_list(const Params& p, char* smem, const XcdBarrier& bar, PhaseList<P0>) { phase_and_sync<P0, true>(p, smem, bar); }
template <int P0, int P1, int... REST> DEV void run_list(const Params& p, char* smem, const XcdBarrier& bar, PhaseList<P0, P1, REST...>) {
  phase_and_sync<P0, false>(p, smem, bar);
  run_list(p, smem, bar, PhaseList<P1, REST...>{});
}
#if DEBUG_ATT == 1
using Program = PhaseList<PH_PRO, PH_IN0, PH_ATT0N, PH_DBG_SAVE, PH_ATT0, PH_DBG_CMP, PH_OUT0, PH_LN0, PH_RG0, PH_RT0, PH_M10, PH_M20, PH_CB0,
                          PH_IN1, PH_C1, PH_C2, PH_ATT1, PH_OUT1, PH_LN1, PH_RG1, PH_RT1, PH_M11, PH_M21, PH_CB1, PH_DBG_SCALE>;
#elif DEBUG_ATT == 2
using Program = PhaseList<PH_PRO, PH_IN0, PH_ATT0, PH_OUT0, PH_LN0, PH_RG0, PH_RT0, PH_M10, PH_M20, PH_CB0,
                          PH_IN1, PH_C1, PH_C2, PH_ATT1N, PH_DBG_SAVE, PH_ATT1A, PH_ATT1B, PH_DBG_CMP, PH_OUT1, PH_LN1, PH_RG1, PH_RT1, PH_M11, PH_M21, PH_CB1, PH_DBG_SCALE>;
#elif DEBUG_ATT == 11
using Program = PhaseList<PH_PRO, PH_IN0, PH_ATT0, PH_OUT0, PH_LN0, PH_RG0, PH_RT0, PH_M10, PH_M20, PH_CB0,
                          PH_IN1, PH_C1, PH_C2, PH_ATT1A, PH_ATT1B, PH_ATT1B, PH_OUT1, PH_LN1, PH_RG1, PH_RT1, PH_M11, PH_M21, PH_CB1>;
#elif DEBUG_ATT == 12
using Program = PhaseList<PH_PRO, PH_IN0, PH_ATT0, PH_OUT0, PH_LN0, PH_RG0, PH_RT0, PH_M10, PH_M20, PH_M10, PH_M20, PH_CB0,
                          PH_IN1, PH_C1, PH_C2, PH_ATT1A, PH_ATT1B, PH_OUT1, PH_LN1, PH_RG1, PH_RT1, PH_M11, PH_M21, PH_CB1>;
#elif DEBUG_ATT == 13
using Program = PhaseList<PH_PRO, PH_IN0, PH_IN0, PH_ATT0, PH_OUT0, PH_OUT0, PH_LN0, PH_RG0, PH_RT0, PH_M10, PH_M20, PH_CB0,
                          PH_IN1, PH_C1, PH_C2, PH_ATT1A, PH_ATT1B, PH_OUT1, PH_LN1, PH_RG1, PH_RT1, PH_M11, PH_M21, PH_CB1>;
#elif DEBUG_ATT == 14
using Program = PhaseList<PH_PRO, PH_IN0, PH_ATT0, PH_ATT0, PH_OUT0, PH_LN0, PH_RG0, PH_RT0, PH_M10, PH_M20, PH_CB0,
                          PH_IN1, PH_C1, PH_C2, PH_ATT1A, PH_ATT1A, PH_ATT1B, PH_OUT1, PH_LN1, PH_RG1, PH_RT1, PH_M11, PH_M21, PH_CB1>;
#elif DEBUG_ATT == 16
using Program = PhaseList<PH_PRO, PH_IN0, PH_ATT0, PH_ATT0, PH_OUT0, PH_LN0, PH_RG0, PH_RT0, PH_M10, PH_M20, PH_CB0,
                          PH_IN1, PH_C1, PH_C2, PH_ATT1A, PH_ATT1B, PH_OUT1, PH_LN1, PH_RG1, PH_RT1, PH_M11, PH_M21, PH_CB1>;
#elif DEBUG_ATT == 17
using Program = PhaseList<PH_PRO, PH_IN0, PH_ATT0, PH_OUT0, PH_LN0, PH_RG0, PH_RT0, PH_M10, PH_M20, PH_CB0,
                          PH_IN1, PH_C1, PH_C2, PH_C1, PH_C2, PH_ATT1A, PH_ATT1B, PH_OUT1, PH_LN1, PH_RG1, PH_RT1, PH_M11, PH_M21, PH_CB1>;
#elif DEBUG_ATT == 18
using Program = PhaseList<PH_PRO, PH_PRO, PH_IN0, PH_ATT0, PH_OUT0, PH_LN0, PH_RG0, PH_RT0, PH_M10, PH_M20, PH_CB0,
                          PH_IN1, PH_C1, PH_C2, PH_ATT1A, PH_ATT1B, PH_OUT1, PH_LN1, PH_RG1, PH_RT1, PH_M11, PH_M21, PH_CB1>;
#elif DEBUG_ATT == 31
using Program = PhaseList<PH_PRO, PH_IN0, PH_ATT0, PH_OUT0, PH_LN0, PH_LN0, PH_RG0, PH_RT0, PH_M10, PH_M20, PH_CB0,
                          PH_IN1, PH_C1, PH_C2, PH_ATT1A, PH_ATT1B, PH_OUT1, PH_LN1, PH_RG1, PH_RT1, PH_M11, PH_M21, PH_CB1>;
#elif DEBUG_ATT == 32
using Program = PhaseList<PH_PRO, PH_IN0, PH_ATT0, PH_OUT0, PH_LN0, PH_RG0, PH_RG0, PH_RT0, PH_M10, PH_M20, PH_CB0,
                          PH_IN1, PH_C1, PH_C2, PH_ATT1A, PH_ATT1B, PH_OUT1, PH_LN1, PH_RG1, PH_RT1, PH_M11, PH_M21, PH_CB1>;
#elif DEBUG_ATT == 33
using Program = PhaseList<PH_PRO, PH_IN0, PH_ATT0, PH_OUT0, PH_LN0, PH_RG0, PH_RT0, PH_M10, PH_M20, PH_CB0, PH_CB0,
                          PH_IN1, PH_C1, PH_C2, PH_ATT1A, PH_ATT1B, PH_OUT1, PH_LN1, PH_RG1, PH_RT1, PH_M11, PH_M21, PH_CB1>;
#elif DEBUG_ATT == 34
using Program = PhaseList<PH_PRO, PH_IN0, PH_ATT0, PH_OUT0, PH_LN0, PH_RG0, PH_RT0, PH_M10, PH_M20, PH_M20, PH_CB0,
                          PH_IN1, PH_C1, PH_C2, PH_ATT1A, PH_ATT1B, PH_OUT1, PH_LN1, PH_RG1, PH_RT1, PH_M11, PH_M21, PH_CB1>;
#elif DEBUG_ATT == 15
using Program = PhaseList<PH_PRO, PH_IN0, PH_ATT0, PH_OUT0, PH_LN0, PH_LN0, PH_RG0, PH_RG0, PH_RT0, PH_M10, PH_M20, PH_CB0, PH_CB0,
                          PH_IN1, PH_C1, PH_C2, PH_ATT1A, PH_ATT1B, PH_OUT1, PH_LN1, PH_RG1, PH_RT1, PH_M11, PH_M21, PH_CB1>;
#else
using Program = PhaseList<PH_PRO, PH_IN0, PH_ATT0, PH_OUT0, PH_LN0, PH_RG0, PH_RT0, PH_M10, PH_M20, PH_CB0,
                          PH_IN1, PH_C1, PH_C2, PH_ATT1A, PH_ATT1B, PH_OUT1, PH_LN1, PH_RG1, PH_RT1, PH_M11, PH_M21, PH_CB1>;
#endif
struct KArgs { const void* in[25]; float* out; char* ws; };
constexpr size_t al256(size_t b) { return (b + 255) & ~(size_t)255; }
constexpr size_t OFF_BAR = 0;
constexpr size_t OFF_CNT = OFF_BAR + al256(16384);
constexpr size_t OFF_PB = OFF_CNT + al256(4096);
constexpr size_t OFF_DBG = OFF_PB + al256(1024);
constexpr size_t OFF_ZERO_END = OFF_DBG + al256(256);
constexpr size_t OFF_CS = OFF_ZERO_END;
constexpr size_t OFF_XB = OFF_CS + al256((size_t)T_ * 16 * 4);
constexpr size_t OFF_QKV = OFF_XB + al256((size_t)T_ * D_ * 2);
constexpr size_t OFF_GATES = OFF_QKV + al256((size_t)T_ * 2624 * 2);
constexpr size_t OFF_AO = OFF_GATES + al256((size_t)T_ * 48 * 4);
constexpr size_t OFF_HPRE = OFF_AO + al256((size_t)T_ * D_ * 2);
constexpr size_t OFF_X1F = OFF_HPRE + al256((size_t)T_ * D_ * 4);
constexpr size_t OFF_X1B = OFF_X1F + al256((size_t)T_ * D_ * 4);
constexpr size_t OFF_X1LO = OFF_X1B + al256((size_t)T_ * D_ * 2);
constexpr size_t OFF_LOGITS = OFF_X1LO + al256((size_t)T_ * D_ * 2);
constexpr size_t OFF_EIDX = OFF_LOGITS + al256((size_t)T_ * NE * 4);
constexpr size_t OFF_GATEV = OFF_EIDX + al256((size_t)NASG * 4);
constexpr size_t OFF_EPOS = OFF_GATEV + al256((size_t)NASG * 4);
constexpr size_t OFF_ETOK = OFF_EPOS + al256((size_t)NASG * 4);
constexpr size_t OFF_HBUF = OFF_ETOK + al256((size_t)NE * T_ * 4);
constexpr size_t OFF_YBUF = OFF_HBUF + al256((size_t)NROWS * 256 * 2);
constexpr size_t OFF_X2F = OFF_YBUF + al256((size_t)NROWS * D_ * 2);
constexpr size_t OFF_HID = OFF_X2F + al256((size_t)T_ * D_ * 4);
constexpr size_t OFF_CMPKV = OFF_HID + al256((size_t)2 * 4096 * 128 * 2);
constexpr size_t OFF_SELMASK = OFF_CMPKV + al256((size_t)2 * 4096 * 64 * 2);
constexpr size_t OFF_W16IN0 = OFF_SELMASK + al256((size_t)T_ * 4 * 8);
constexpr size_t OFF_W16OUT0 = OFF_W16IN0 + al256((size_t)D_ * LD0 * 2);
constexpr size_t OFF_W16IN1 = OFF_W16OUT0 + al256((size_t)D_ * D_ * 2);
constexpr size_t OFF_W16OUT1 = OFF_W16IN1 + al256((size_t)D_ * NIN1 * 2);
constexpr size_t OFF_RW16 = OFF_W16OUT1 + al256((size_t)D_ * D_ * 2);
constexpr size_t WS_NEEDED = OFF_RW16 + al256((size_t)4 * D_ * NE * 2);

DEV Params make_params(const KArgs& k) {
  Params p;
  p.x = (const float*)k.in[0]; p.pos = (const int*)k.in[1];
  p.even_w_in = (const float*)k.in[2]; p.even_sinks = (const float*)k.in[3]; p.even_w_out = (const float*)k.in[4]; p.odd_w_in = (const float*)k.in[5];
  p.cmpk_pos = (const float*)k.in[6]; p.cmpk_w1 = (const float*)k.in[7]; p.cmpk_w2 = (const float*)k.in[8];
  p.cmpv_pos = (const float*)k.in[9]; p.cmpv_w1 = (const float*)k.in[10]; p.cmpv_w2 = (const float*)k.in[11];
  p.odd_w_out = (const float*)k.in[12]; p.mix_g = (const float*)k.in[13]; p.mix_b = (const float*)k.in[14];
  p.router_w = (const float*)k.in[15]; p.router_b = (const float*)k.in[16];
  p.w_gate = (const float*)k.in[17]; p.w_up = (const float*)k.in[18]; p.w_down = (const float*)k.in[19];
  p.sh_gate = (const float*)k.in[20]; p.sh_up = (const float*)k.in[21]; p.sh_down = (const float*)k.in[22];
  p.ffn_g = (const float*)k.in[23]; p.ffn_b = (const float*)k.in[24];
  p.out = k.out;
  char* w = k.ws;
  p.bar = (unsigned*)(w + OFF_BAR); p.cnt = (int*)(w + OFF_CNT); p.pb = (float*)(w + OFF_PB); p.dbg = (float*)(w + OFF_DBG);
  p.cs = (float*)(w + OFF_CS); p.xb = (u16*)(w + OFF_XB); p.qkv = (u16*)(w + OFF_QKV); p.gates = (float*)(w + OFF_GATES);
  p.ao = (u16*)(w + OFF_AO); p.hpre = (float*)(w + OFF_HPRE); p.x1f = (float*)(w + OFF_X1F); p.x1b = (u16*)(w + OFF_X1B); p.x1lo = (u16*)(w + OFF_X1LO);
  p.logits = (float*)(w + OFF_LOGITS); p.eidx = (int*)(w + OFF_EIDX); p.gatev = (float*)(w + OFF_GATEV); p.epos = (int*)(w + OFF_EPOS); p.etok = (int*)(w + OFF_ETOK);
  p.hbuf = (u16*)(w + OFF_HBUF); p.ybuf = (u16*)(w + OFF_YBUF); p.x2f = (float*)(w + OFF_X2F); p.hid = (u16*)(w + OFF_HID); p.cmpkv = (u16*)(w + OFF_CMPKV);
  p.selmask = (unsigned long long*)(w + OFF_SELMASK);
  p.w16_in0 = (u16*)(w + OFF_W16IN0); p.w16_out0 = (u16*)(w + OFF_W16OUT0); p.w16_in1 = (u16*)(w + OFF_W16IN1); p.w16_out1 = (u16*)(w + OFF_W16OUT1); p.rw16 = (u16*)(w + OFF_RW16);
  return p;
}

__global__ void __launch_bounds__(NTHR, 2) k_fused(KArgs ka) {
  extern __shared__ __attribute__((aligned(16))) char smem[];
  const Params p = make_params(ka);
  if (tidx() == 0) *reinterpret_cast<uint4*>(smem + SMEM_BAR_OFF) = make_uint4(0u, 0u, 0u, 0u);
  __syncthreads();
  XcdBarrier bar = xcd_barrier_post(p.bar, (volatile LAS unsigned*)(smem + SMEM_BAR_OFF));
  run_list(p, smem, bar, Program{});
}

extern "C" void kernel_launch(void* const* d_in, const int* in_sizes, int n_in, void* d_out, int out_size, void* d_ws, size_t ws_size, hipStream_t stream) {
  (void)in_sizes; (void)n_in; (void)out_size;
  if (ws_size < WS_NEEDED) return;
  KArgs ka{};
  for (int i = 0; i < 25; ++i) ka.in[i] = d_in[i];
  ka.out = (float*)d_out; ka.ws = (char*)d_ws;
  hipMemsetAsync(d_ws, 0, OFF_ZERO_END, stream);
  static int grid = 0;
  if (!grid) {
    int dev = 0, cus = 0, per_cu = 0;
    hipGetDevice(&dev);
    hipDeviceGetAttribute(&cus, hipDeviceAttributeMultiprocessorCount, dev);
    hipFuncSetAttribute((const void*)k_fused, hipFuncAttributeMaxDynamicSharedMemorySize, SMEM_BYTES);
    hipOccupancyMaxActiveBlocksPerMultiprocessor(&per_cu, (const void*)k_fused, NTHR, SMEM_BYTES);
    if (per_cu > 1) per_cu = 1;
    if (per_cu < 1) per_cu = 1;
    grid = cus * per_cu;
  }
  hipLaunchKernelGGL(k_fused, dim3(grid), dim3(NTHR), SMEM_BYTES, stream, ka);
}
```

```cpp
#include <hip/hip_runtime.h>
#include <hip/hip_bf16.h>
#include <stdint.h>
#include <math.h>
#include <utility>

typedef unsigned short u16;
using bf16x8 = __attribute__((ext_vector_type(8))) short;
using f32x4  = __attribute__((ext_vector_type(4))) float;

#define DEV __device__ __forceinline__
__device__ __forceinline__ int tidx() { int t = (int)__builtin_amdgcn_workitem_id_x(); asm volatile("" : "+v"(t)); return t; }

constexpr int T_ = 16384, S_ = 4096, D_ = 1024;
constexpr int LD0 = 2304, LD1 = 2560, NIN1 = 2608;
constexpr int NE = 256, TOPK = 8, NASG = T_ * TOPK, NROWS = NASG + T_;
constexpr float ALPHA = 1.41421356237309515f;
constexpr float LN_EPS = 1e-5f;
constexpr int NTHR = 512, NWAVE = 8;


struct Params {
  const float* x; const int* pos;
  const float* even_w_in; const float* even_sinks; const float* even_w_out; const float* odd_w_in;
  const float* cmpk_pos; const float* cmpk_w1; const float* cmpk_w2; const float* cmpv_pos; const float* cmpv_w1; const float* cmpv_w2;
  const float* odd_w_out; const float* mix_g; const float* mix_b; const float* router_w; const float* router_b;
  const float* w_gate; const float* w_up; const float* w_down; const float* sh_gate; const float* sh_up; const float* sh_down;
  const float* ffn_g; const float* ffn_b;
  float* out;
  unsigned* bar; int* cnt; float* pb; float* cs; u16* xb; u16* qkv; float* gates; u16* ao; float* hpre;
  u16* x1b; u16* x1lo; float* logits; int* eidx; float* gatev; int* epos; int* etok;
  u16* hbuf; u16* ybuf; float* x2f; u16* hid; u16* cmpkv; unsigned long long* selmask;
  u16* w16_in0; u16* w16_out0; u16* w16_in1; u16* w16_out1; u16* rw16;
};

#define XB_TMO      128
#define XB_XCNT(j)  (256  + 64 * (j))
#define XB_XSUB(j)  (1280 + 64 * (j))
#define XB_XGEN(j)  (2304 + 64 * (j))
#define XB_TOP      3328
#define XB_TOPGEN   3392
#define XCD_BAR_WORDS 3456
#define XB_SPIN_CAP (1u << 18)
#define LAS __attribute__((address_space(3)))

__device__ __forceinline__ unsigned xb_ld(unsigned* p)              { return __hip_atomic_load(p, __ATOMIC_RELAXED, __HIP_MEMORY_SCOPE_AGENT); }
__device__ __forceinline__ unsigned xb_add(unsigned* p, unsigned v) { return __hip_atomic_fetch_add(p, v, __ATOMIC_RELAXED, __HIP_MEMORY_SCOPE_AGENT); }
__device__ __forceinline__ unsigned xb_xcc_id() { return (unsigned)__builtin_amdgcn_s_getreg((3 << 11) | 20) & 0xFu; }
#define XB_SPIN(cond, bar) do { unsigned _sp = 0; while (cond) { __builtin_amdgcn_s_sleep(1); \
    if ((++_sp & 255u) == 0u) { if (xb_ld(&(bar)[XB_TMO])) break; if (_sp > XB_SPIN_CAP) { atomicAdd(&(bar)[XB_TMO], 1u); break; } } } } while (0)

struct XcdBarrier {
    unsigned* bar; unsigned x;
    volatile LAS unsigned* st;
};

__device__ __forceinline__ XcdBarrier xcd_barrier_post(unsigned* bar, volatile LAS unsigned* st) {
    XcdBarrier b; b.bar = bar; b.x = xb_xcc_id(); b.st = st;
    if (tidx() == 0) (void)xb_add(&bar[XB_XCNT(b.x)], 1u);
    return b;
}
__device__ __forceinline__ void xcd_barrier_complete(unsigned* bar, unsigned x, unsigned& nloc, unsigned& nx) {
    const unsigned G = gridDim.x * gridDim.y * gridDim.z;
    unsigned sum, cnt, mine, sp = 0u;
    for (;;) {
        sum = 0u; cnt = 0u; mine = 0u;
#pragma unroll
        for (unsigned j = 0; j < 16; ++j) { const unsigned c = xb_ld(&bar[XB_XCNT(j)]); sum += c; cnt += (c > 0u) ? 1u : 0u; mine = (j == x) ? c : mine; }
        if (sum == G) break;
        __builtin_amdgcn_s_sleep(1);
        if ((++sp & 255u) == 0u) { if (xb_ld(&bar[XB_TMO])) break; if (sp > XB_SPIN_CAP) { atomicAdd(&bar[XB_TMO], 1u); break; } }
    }
    nloc = mine > 0u ? mine : 1u; nx = cnt > 0u ? cnt : 1u;
}

__device__ __forceinline__ void xcd_barrier(const XcdBarrier& b) {
    asm volatile("s_waitcnt vmcnt(0)" ::: "memory");
    __syncthreads();
    if (tidx() == 0) {
        unsigned* bar = b.bar;
        __builtin_amdgcn_s_waitcnt(0);
        unsigned nloc = b.st[0], nx = b.st[1];
        if (nloc == 0u) { xcd_barrier_complete(bar, b.x, nloc, nx); b.st[0] = nloc; b.st[1] = nx; }
        const unsigned old = xb_add(&bar[XB_XSUB(b.x)], 1u);
        const unsigned gen = old / nloc;
        if (old + 1u == (gen + 1u) * nloc) {
            __builtin_amdgcn_fence(__ATOMIC_RELEASE, "agent");
            asm volatile("s_waitcnt vmcnt(0)" ::: "memory");
            const unsigned og = xb_add(&bar[XB_TOP], 1u);
            const unsigned tg = og / nx;
            if (og + 1u == (tg + 1u) * nx) xb_add(&bar[XB_TOPGEN], 1u);
            else XB_SPIN(xb_ld(&bar[XB_TOPGEN]) == tg, bar);
            __builtin_amdgcn_fence(__ATOMIC_ACQUIRE, "agent");
            xb_add(&bar[XB_XGEN(b.x)], 1u);
            asm volatile("s_waitcnt vmcnt(0)" ::: "memory");
        } else {
            XB_SPIN(xb_ld(&bar[XB_XGEN(b.x)]) == gen, bar);
            __builtin_amdgcn_fence(__ATOMIC_ACQUIRE, "agent");
            asm volatile("s_waitcnt vmcnt(0)" ::: "memory");
        }
    }
    __syncthreads();
}


DEV float bf2f(u16 h) { return __uint_as_float(((unsigned)h) << 16); }
DEV float bflo(unsigned w) { return __uint_as_float(w << 16); }
DEV float bfhi(unsigned w) { return __uint_as_float(w & 0xffff0000u); }
DEV float wave_max(float v) { for (int o = 32; o; o >>= 1) v = fmaxf(v, __shfl_xor(v, o)); return v; }
DEV float wave_sum(float v) { for (int o = 32; o; o >>= 1) v += __shfl_xor(v, o); return v; }
#define WAVE_SYNC() asm volatile("s_waitcnt lgkmcnt(0)" ::: "memory")

typedef short v4i16_t __attribute__((ext_vector_type(4)));
typedef float f32x2_t __attribute__((ext_vector_type(2)));
typedef __bf16 bf16x2_t __attribute__((ext_vector_type(2)));
typedef unsigned u32x4_t __attribute__((ext_vector_type(4)));
typedef unsigned u32x2_t __attribute__((ext_vector_type(2)));
typedef float f32x4_t __attribute__((ext_vector_type(4)));
DEV unsigned cvtpk(float lo, float hi) { f32x2_t v = {lo, hi}; bf16x2_t b = __builtin_convertvector(v, bf16x2_t); return __builtin_bit_cast(unsigned, b); }
DEV v4i16_t lds_tr(const u16* ptr) { return __builtin_amdgcn_ds_read_tr16_b64_v4i16((LAS v4i16_t*)ptr); }

struct GemmSmem { u16 A[2][320][72]; u16 B[2][64][128]; };
DEV int bswz(int k) { return (k & 3) | (((k >> 3) & 1) << 2); }

template <int MI, bool SPLIT, bool B16 = false, class FA, class FB, class FL, class FE>
DEV void gemm_core(GemmSmem& sm, int nk, FA a_addr, FB b_addr, int ldb, FL b_lo, FE epi, bool b_ok = true) {
  const int tid = tidx(), lane = tid & 63, wid = tid >> 6;
  const int wr = wid >> 1, wc = wid & 1, fr = lane & 15, fq = lane >> 4;
  const int n4 = tid & 31, kq = tid >> 5, q4 = (lane & 15) >> 2, p4 = lane & 3;
  f32x4 acc[MI][4];
#pragma unroll
  for (int mi = 0; mi < MI; ++mi)
#pragma unroll
    for (int ni = 0; ni < 4; ++ni) acc[mi][ni] = f32x4{0.f, 0.f, 0.f, 0.f};
  constexpr int NSET = (MI <= 4) ? 2 : 1;
  u32x4_t ra[NSET][MI]; f32x4_t rb[2][4]; u32x4_t rh[2][2];
  auto gloadA = [&](auto PC, int kt) {
    constexpr int P = decltype(PC)::value;
#pragma unroll
    for (int i = 0; i < MI; ++i) ra[P][i] = *reinterpret_cast<const u32x4_t*>(a_addr(i, kt));
  };
  auto gloadB = [&](auto PC, int kt) {
    constexpr int P = decltype(PC)::value;
    if constexpr (B16) {
      const u16* bp = b_addr(kt);
      rh[P][0] = *reinterpret_cast<const u32x4_t*>(bp);
      rh[P][1] = *reinterpret_cast<const u32x4_t*>(bp + (size_t)32 * ldb);
    } else {
      const float* bp = b_addr(kt);
#pragma unroll
      for (int i = 0; i < 4; ++i) rb[P][i] = *reinterpret_cast<const f32x4_t*>(bp + (size_t)(16 * i) * ldb);
    }
  };
  auto gload = [&](auto PC, int kt) { gloadA(PC, kt); gloadB(PC, kt); };
  auto sstore3 = [&](auto AC, auto PC, auto BC, int kt) {
    constexpr int AS = decltype(AC)::value;
    constexpr int P = decltype(PC)::value;
    constexpr int Bf = decltype(BC)::value;
#pragma unroll
    for (int i = 0; i < MI; ++i) *reinterpret_cast<u32x4_t*>(&sm.A[Bf][(tid >> 3) + 64 * i][(tid & 7) * 8]) = ra[AS][i];
    if constexpr (B16) {
#pragma unroll
      for (int i = 0; i < 2; ++i) {
        u32x4_t w = rh[P][i];
        if (!b_ok) w = u32x4_t{0u, 0u, 0u, 0u};
        const int k = (tid >> 4) + 32 * i, n8 = tid & 15;
        *reinterpret_cast<u32x4_t*>(&sm.B[Bf][k][(((n8 >> 1) ^ bswz(k)) << 4) + (n8 & 1) * 8]) = w;
      }
      return;
    }
    const bool lo = SPLIT ? b_lo(kt) : false;
#pragma unroll
    for (int i = 0; i < 4; ++i) {
      f32x4_t v = rb[P][i];
      if (!b_ok) v = f32x4_t{0.f, 0.f, 0.f, 0.f};
      if (SPLIT && lo) {
        const unsigned h0 = cvtpk(v[0], v[1]), h1 = cvtpk(v[2], v[3]);
        v[0] -= __uint_as_float(h0 << 16); v[1] -= __uint_as_float(h0 & 0xffff0000u); v[2] -= __uint_as_float(h1 << 16); v[3] -= __uint_as_float(h1 & 0xffff0000u);
      }
      u32x2_t w; w[0] = cvtpk(v[0], v[1]); w[1] = cvtpk(v[2], v[3]);
      const int k = kq + 16 * i;
      *reinterpret_cast<u32x2_t*>(&sm.B[Bf][k][(((n4 >> 2) ^ bswz(k)) << 4) + (n4 & 3) * 4]) = w;
    }
  };
  auto sstore = [&](auto PC, auto BC, int kt) { sstore3(PC, PC, BC, kt); };
  auto compute = [&](auto PC) {
    constexpr int P = decltype(PC)::value;
#pragma unroll
    for (int ks = 0; ks < 2; ++ks) {
      bf16x8 bf[4];
#pragma unroll
      for (int ni = 0; ni < 4; ++ni) {
        const int k0 = 32 * ks + 8 * fq + q4, col = (((wc * 4 + ni) ^ bswz(k0)) << 4) + 4 * p4;
        const v4i16_t lo = lds_tr(&sm.B[P][k0][col]);
        const v4i16_t hh = lds_tr(&sm.B[P][k0 + 4][col]);
        bf[ni] = bf16x8{lo[0], lo[1], lo[2], lo[3], hh[0], hh[1], hh[2], hh[3]};
      }
      constexpr int G0 = (MI > 4) ? 3 : MI;
      {
        bf16x8 af[G0];
#pragma unroll
        for (int mi = 0; mi < G0; ++mi) af[mi] = *reinterpret_cast<const bf16x8*>(&sm.A[P][wr * 16 * MI + mi * 16 + fr][32 * ks + fq * 8]);
#pragma unroll
        for (int mi = 0; mi < G0; ++mi)
#pragma unroll
          for (int ni = 0; ni < 4; ++ni) acc[mi][ni] = __builtin_amdgcn_mfma_f32_16x16x32_bf16(bf[ni], af[mi], acc[mi][ni], 0, 0, 0);
      }
      if constexpr (MI > G0) {
        __builtin_amdgcn_sched_barrier(0);
        bf16x8 af[MI - G0];
#pragma unroll
        for (int mi = G0; mi < MI; ++mi) af[mi - G0] = *reinterpret_cast<const bf16x8*>(&sm.A[P][wr * 16 * MI + mi * 16 + fr][32 * ks + fq * 8]);
#pragma unroll
        for (int mi = G0; mi < MI; ++mi)
#pragma unroll
          for (int ni = 0; ni < 4; ++ni) acc[mi][ni] = __builtin_amdgcn_mfma_f32_16x16x32_bf16(bf[ni], af[mi - G0], acc[mi][ni], 0, 0, 0);
      }
      __builtin_amdgcn_sched_barrier(0);
    }
  };
  using C0 = std::integral_constant<int, 0>; using C1 = std::integral_constant<int, 1>;
  int kt = 0;
  if constexpr (MI <= 4) {
    gload(C0{}, 0);
    sstore(C0{}, C0{}, 0);
    gload(C1{}, 1);
    __syncthreads();
    for (; kt + 2 < nk; kt += 2) {
      gload(C0{}, kt + 2); compute(C0{}); sstore(C1{}, C1{}, kt + 1); __syncthreads();
      gload(C1{}, kt + 3); compute(C1{}); sstore(C0{}, C0{}, kt + 2); __syncthreads();
    }
    compute(C0{}); sstore(C1{}, C1{}, kt + 1); __syncthreads();
    compute(C1{}); __syncthreads();
  } else {
    gloadA(C0{}, 0); gloadB(C0{}, 0);
    sstore3(C0{}, C0{}, C0{}, 0);
    gloadB(C1{}, 1);
    __syncthreads();
    for (; kt + 2 < nk; kt += 2) {
      gloadA(C0{}, kt + 1); gloadB(C0{}, kt + 2); compute(C0{}); sstore3(C0{}, C1{}, C1{}, kt + 1); __syncthreads();
      gloadA(C0{}, kt + 2); gloadB(C1{}, kt + 3); compute(C1{}); sstore3(C0{}, C0{}, C0{}, kt + 2); __syncthreads();
    }
    gloadA(C0{}, kt + 1); compute(C0{}); sstore3(C0{}, C1{}, C1{}, kt + 1); __syncthreads();
    compute(C1{}); __syncthreads();
  }
  epi(acc);
}

struct ItemRange { int i, hi, step; };
DEV ItemRange xcd_items(int I) {
  ItemRange r;
  if (gridDim.x & 7) { r.i = blockIdx.x; r.hi = I; r.step = gridDim.x; }
  else { const int x = blockIdx.x & 7; r.i = (int)((long)I * x / 8) + (blockIdx.x >> 3); r.hi = (int)((long)I * (x + 1) / 8); r.step = gridDim.x >> 3; }
  return r;
}
template <int GM, int GN> DEV void dense_item(int i, int MT, int& mt, int& nt) {
  const int g = i / (GM * GN), w = i % (GM * GN), gpm = MT / GM;
  mt = (g % gpm) * GM + w / GN; nt = (g / gpm) * GN + w % GN;
}
DEV float4 ld4(const float* ptr) { return *reinterpret_cast<const float4*>(ptr); }
DEV void st_bf4(u16* ptr, float a, float b, float c, float d) { uint2 w; w.x = cvtpk(a, b); w.y = cvtpk(c, d); *reinterpret_cast<uint2*>(ptr) = w; }

__constant__ float INVF[8] = {1.0f, 0.1939227432012558f, 0.03760603070259094f, 0.007292664609849453f, 0.0014142135623842478f,
                              0.00027424818836152554f, 5.3182957344688475e-05f, 1.0313385246263351e-05f};
DEV void ph_prologue(const Params& p) {
  const size_t gtid = (size_t)blockIdx.x * NTHR + tidx(), gsz = (size_t)gridDim.x * NTHR;
  for (size_t i = gtid; i < (size_t)T_ * D_ / 8; i += gsz) {
    const float4 a = reinterpret_cast<const float4*>(p.x)[2 * i], b = reinterpret_cast<const float4*>(p.x)[2 * i + 1];
    uint4 w; w.x = cvtpk(a.x, a.y); w.y = cvtpk(a.z, a.w); w.z = cvtpk(b.x, b.y); w.w = cvtpk(b.z, b.w);
    reinterpret_cast<uint4*>(p.xb)[i] = w;
  }
  for (size_t i = gtid; i < (size_t)T_ * 8; i += gsz) {
    const int t = (int)(i >> 3), f = (int)(i & 7);
    const float ang = (float)p.pos[t] * INVF[f];
    p.cs[t * 16 + f] = cosf(ang); p.cs[t * 16 + 8 + f] = sinf(ang);
  }
  auto cvt_w = [&](const float* src, u16* dst, size_t n4) {
    for (size_t i = gtid; i < n4; i += gsz) {
      const float4 a = reinterpret_cast<const float4*>(src)[i];
      uint2 w; w.x = cvtpk(a.x, a.y); w.y = cvtpk(a.z, a.w);
      reinterpret_cast<uint2*>(dst)[i] = w;
    }
  };
  cvt_w(p.even_w_in, p.w16_in0, (size_t)D_ * LD0 / 4);
  cvt_w(p.even_w_out, p.w16_out0, (size_t)D_ * D_ / 4);
  cvt_w(p.odd_w_in, p.w16_in1, (size_t)D_ * NIN1 / 4);
  cvt_w(p.odd_w_out, p.w16_out1, (size_t)D_ * D_ / 4);
  for (size_t i = gtid; i < (size_t)2 * D_ * NE / 4; i += gsz) {
    const size_t L = i / ((size_t)D_ * NE / 4), r = i - L * ((size_t)D_ * NE / 4);
    const float4 a = reinterpret_cast<const float4*>(p.router_w)[i];
    const unsigned h0 = cvtpk(a.x, a.y), h1 = cvtpk(a.z, a.w);
    uint2 hi; hi.x = h0; hi.y = h1;
    uint2 lo; lo.x = cvtpk(a.x - __uint_as_float(h0 << 16), a.y - __uint_as_float(h0 & 0xffff0000u)); lo.y = cvtpk(a.z - __uint_as_float(h1 << 16), a.w - __uint_as_float(h1 & 0xffff0000u));
    reinterpret_cast<uint2*>(p.rw16 + (L * 2 + 0) * (size_t)D_ * NE)[r] = hi;
    reinterpret_cast<uint2*>(p.rw16 + (L * 2 + 1) * (size_t)D_ * NE)[r] = lo;
  }
  for (size_t i = gtid; i < 2 * 128 * 16; i += gsz) {
    const int n = (int)(i & 127), kc = (int)((i >> 7) & 15), ts = (int)(i >> 11);
    const float* pe = ts ? p.cmpv_pos : p.cmpk_pos; const float* w1 = ts ? p.cmpv_w1 : p.cmpk_w1;
    float s = 0.f;
    for (int k = kc * 128; k < kc * 128 + 128; ++k) s += pe[k] * w1[(size_t)k * 128 + n];
    atomicAdd(&p.pb[ts * 128 + n], s);
  }
}

DEV void ph_inproj0(const Params& p, GemmSmem& sm) {
  const int tid = tidx(), lane = tid & 63, wid = tid >> 6, wr = wid >> 1, wc = wid & 1, fr = lane & 15, fq = lane >> 4;
  constexpr int NT = LD0 / 128;
  for (ItemRange it = xcd_items(64 * NT); it.i < it.hi; it.i += it.step) {
    int mt, nt; dense_item<16, 2>(it.i, 64, mt, nt);
    const int m0 = mt * 256, n0 = nt * 128;
    const u16* ar0 = p.xb + (size_t)(m0 + (tid >> 3)) * D_ + (tid & 7) * 8;
    auto a_addr = [&](int i, int kt) { return ar0 + (size_t)i * 64 * D_ + kt * 64; };
    const u16* bb = p.w16_in0 + (size_t)(tid >> 4) * LD0 + n0 + 8 * (tid & 15);
    auto b_addr = [&](int kt) { return bb + (size_t)kt * 64 * LD0; };
    auto b_lo = [&](int) { return false; };
    auto epi = [&](f32x4 (&acc)[4][4]) {
#pragma unroll
      for (int mi = 0; mi < 4; ++mi) {
        const int row = m0 + wr * 64 + mi * 16 + fr;
#pragma unroll
        for (int ni = 0; ni < 4; ++ni) {
          f32x4 v = acc[mi][ni];
          const int col = n0 + wc * 64 + ni * 16 + fq * 4;
          const bool rope = (ni == 0) && (col < 1024 || (col >= 1536 && col < 2176));
          if (rope) {
            const float4 c_ = ld4(p.cs + row * 16 + 4 * (fq & 1)), s_ = ld4(p.cs + row * 16 + 8 + 4 * (fq & 1));
            const float p0 = __shfl_xor(v[0], 32), p1 = __shfl_xor(v[1], 32), p2 = __shfl_xor(v[2], 32), p3 = __shfl_xor(v[3], 32);
            const float sg = fq < 2 ? -1.f : 1.f;
            v[0] = v[0] * c_.x + sg * p0 * s_.x; v[1] = v[1] * c_.y + sg * p1 * s_.y; v[2] = v[2] * c_.z + sg * p2 * s_.z; v[3] = v[3] * c_.w + sg * p3 * s_.w;
          }
          st_bf4(p.qkv + (size_t)row * LD0 + col, v[0], v[1], v[2], v[3]);
        }
      }
    };
    gemm_core<4, false, true>(sm, 16, a_addr, b_addr, LD0, b_lo, epi);
  }
}

DEV void ph_outproj(const Params& p, GemmSmem& sm, const u16* W16, const float* resid) {
  const int tid = tidx(), lane = tid & 63, wid = tid >> 6, wr = wid >> 1, wc = wid & 1, fr = lane & 15, fq = lane >> 4;
  for (ItemRange it = xcd_items(64 * 8); it.i < it.hi; it.i += it.step) {
    int mt, nt; dense_item<8, 4>(it.i, 64, mt, nt);
    const int m0 = mt * 256, n0 = nt * 128;
    const u16* ar0 = p.ao + (size_t)(m0 + (tid >> 3)) * D_ + (tid & 7) * 8;
    auto a_addr = [&](int i, int kt) { return ar0 + (size_t)i * 64 * D_ + kt * 64; };
    const u16* bb = W16 + (size_t)(tid >> 4) * D_ + n0 + 8 * (tid & 15);
    auto b_addr = [&](int kt) { return bb + (size_t)kt * 64 * D_; };
    auto b_lo = [&](int) { return false; };
    auto epi = [&](f32x4 (&acc)[4][4]) {
#pragma unroll
      for (int mi = 0; mi < 4; ++mi)
#pragma unroll
        for (int ni = 0; ni < 4; ++ni) {
          const size_t idx = (size_t)(m0 + wr * 64 + mi * 16 + fr) * D_ + n0 + wc * 64 + ni * 16 + fq * 4;
          const float4 r = ld4(resid + idx);
          float4 o; o.x = ALPHA * r.x + acc[mi][ni][0]; o.y = ALPHA * r.y + acc[mi][ni][1]; o.z = ALPHA * r.z + acc[mi][ni][2]; o.w = ALPHA * r.w + acc[mi][ni][3];
          *reinterpret_cast<float4*>(p.hpre + idx) = o;
        }
    };
    gemm_core<4, false, true>(sm, 16, a_addr, b_addr, D_, b_lo, epi);
  }
}

DEV void ph_ln_mix(const Params& p, const float* g, const float* bt) {
  const int lane = tidx() & 63, gw = blockIdx.x * NWAVE + (tidx() >> 6), nw = gridDim.x * NWAVE;
  for (int tok = gw; tok < T_; tok += nw) {
    float v[2][8]; float s = 0.f;
#pragma unroll
    for (int i = 0; i < 2; ++i)
#pragma unroll
      for (int h = 0; h < 2; ++h) {
        const float4 a = ld4(p.hpre + (size_t)tok * D_ + (i * 64 + lane) * 8 + 4 * h);
        v[i][4 * h] = a.x; v[i][4 * h + 1] = a.y; v[i][4 * h + 2] = a.z; v[i][4 * h + 3] = a.w;
        s += a.x + a.y + a.z + a.w;
      }
    const float mu = wave_sum(s) * (1.f / D_);
    float ss = 0.f;
#pragma unroll
    for (int i = 0; i < 2; ++i)
#pragma unroll
      for (int c = 0; c < 8; ++c) { v[i][c] -= mu; ss += v[i][c] * v[i][c]; }
    const float rstd = rsqrtf(wave_sum(ss) * (1.f / D_) + LN_EPS);
#pragma unroll
    for (int i = 0; i < 2; ++i) {
      const int c0 = (i * 64 + lane) * 8;
      float y[8];
#pragma unroll
      for (int h = 0; h < 2; ++h) {
        const float4 gg = ld4(g + c0 + 4 * h), bb = ld4(bt + c0 + 4 * h);
        y[4 * h] = v[i][4 * h] * rstd * gg.x + bb.x; y[4 * h + 1] = v[i][4 * h + 1] * rstd * gg.y + bb.y;
        y[4 * h + 2] = v[i][4 * h + 2] * rstd * gg.z + bb.z; y[4 * h + 3] = v[i][4 * h + 3] * rstd * gg.w + bb.w;
      }
      u32x4_t hi, lo;
#pragma unroll
      for (int c = 0; c < 4; ++c) {
        const unsigned hw = cvtpk(y[2 * c], y[2 * c + 1]);
        hi[c] = hw;
        lo[c] = cvtpk(y[2 * c] - __uint_as_float(hw << 16), y[2 * c + 1] - __uint_as_float(hw & 0xffff0000u));
      }
      *reinterpret_cast<u32x4_t*>(p.x1b + (size_t)tok * D_ + c0) = hi;
      *reinterpret_cast<u32x4_t*>(p.x1lo + (size_t)tok * D_ + c0) = lo;
    }
  }
}

struct RouterSmem { u16 A[2][256][72]; u16 B[2][2][64][128]; };
DEV void ph_router_gemm(const Params& p, char* smem, const u16* RW16) {
  RouterSmem& sm = *reinterpret_cast<RouterSmem*>(smem);
  const int tid = tidx(), lane = tid & 63, wid = tid >> 6, wr = wid >> 1, wc = wid & 1, fr = lane & 15, fq = lane >> 4;
  const int q4 = (lane & 15) >> 2, p4 = lane & 3;
  for (ItemRange it = xcd_items(128 * 2); it.i < it.hi; it.i += it.step) {
    const int nt = it.i & 1, mt = it.i >> 1, m0 = mt * 128, n0 = nt * 128;
    const size_t ao0 = (size_t)(m0 + (tid >> 3)) * D_ + (tid & 7) * 8;
    const u16* bb = RW16 + (size_t)(tid >> 4) * NE + n0 + 8 * (tid & 15);
    f32x4 acc[2][4];
#pragma unroll
    for (int mi = 0; mi < 2; ++mi)
#pragma unroll
      for (int ni = 0; ni < 4; ++ni) acc[mi][ni] = f32x4{0.f, 0.f, 0.f, 0.f};
    u32x4_t ra[2][4], rb[2][4];
    auto gload = [&](auto PC, int kt) {
      constexpr int P = decltype(PC)::value;
      ra[P][0] = *reinterpret_cast<const u32x4_t*>(p.x1b + ao0 + kt * 64);
      ra[P][1] = *reinterpret_cast<const u32x4_t*>(p.x1b + ao0 + (size_t)64 * D_ + kt * 64);
      ra[P][2] = *reinterpret_cast<const u32x4_t*>(p.x1lo + ao0 + kt * 64);
      ra[P][3] = *reinterpret_cast<const u32x4_t*>(p.x1lo + ao0 + (size_t)64 * D_ + kt * 64);
      const u16* bp = bb + (size_t)kt * 64 * NE;
      rb[P][0] = *reinterpret_cast<const u32x4_t*>(bp);
      rb[P][1] = *reinterpret_cast<const u32x4_t*>(bp + (size_t)32 * NE);
      rb[P][2] = *reinterpret_cast<const u32x4_t*>(bp + (size_t)D_ * NE);
      rb[P][3] = *reinterpret_cast<const u32x4_t*>(bp + (size_t)D_ * NE + (size_t)32 * NE);
    };
    auto sstore = [&](auto PC) {
      constexpr int P = decltype(PC)::value;
#pragma unroll
      for (int i = 0; i < 4; ++i) *reinterpret_cast<u32x4_t*>(&sm.A[P][(tid >> 3) + 64 * i][(tid & 7) * 8]) = ra[P][i];
#pragma unroll
      for (int i = 0; i < 4; ++i) {
        const int k = (tid >> 4) + 32 * (i & 1), n8 = tid & 15;
        *reinterpret_cast<u32x4_t*>(&sm.B[P][i >> 1][k][(((n8 >> 1) ^ bswz(k)) << 4) + (n8 & 1) * 8]) = rb[P][i];
      }
    };
    auto compute = [&](auto PC) {
      constexpr int P = decltype(PC)::value;
#pragma unroll
      for (int ks = 0; ks < 2; ++ks) {
        bf16x8 ah[2], al[2], bh[4], bl[4];
#pragma unroll
        for (int mi = 0; mi < 2; ++mi) {
          ah[mi] = *reinterpret_cast<const bf16x8*>(&sm.A[P][wr * 32 + mi * 16 + fr][32 * ks + fq * 8]);
          al[mi] = *reinterpret_cast<const bf16x8*>(&sm.A[P][128 + wr * 32 + mi * 16 + fr][32 * ks + fq * 8]);
        }
#pragma unroll
        for (int ni = 0; ni < 4; ++ni) {
          const int k0 = 32 * ks + 8 * fq + q4, col = (((wc * 4 + ni) ^ bswz(k0)) << 4) + 4 * p4;
          { const v4i16_t lo = lds_tr(&sm.B[P][0][k0][col]), hh = lds_tr(&sm.B[P][0][k0 + 4][col]); bh[ni] = bf16x8{lo[0], lo[1], lo[2], lo[3], hh[0], hh[1], hh[2], hh[3]}; }
          { const v4i16_t lo = lds_tr(&sm.B[P][1][k0][col]), hh = lds_tr(&sm.B[P][1][k0 + 4][col]); bl[ni] = bf16x8{lo[0], lo[1], lo[2], lo[3], hh[0], hh[1], hh[2], hh[3]}; }
        }
#pragma unroll
        for (int mi = 0; mi < 2; ++mi)
#pragma unroll
          for (int ni = 0; ni < 4; ++ni) {
            acc[mi][ni] = __builtin_amdgcn_mfma_f32_16x16x32_bf16(bh[ni], ah[mi], acc[mi][ni], 0, 0, 0);
            acc[mi][ni] = __builtin_amdgcn_mfma_f32_16x16x32_bf16(bh[ni], al[mi], acc[mi][ni], 0, 0, 0);
            acc[mi][ni] = __builtin_amdgcn_mfma_f32_16x16x32_bf16(bl[ni], ah[mi], acc[mi][ni], 0, 0, 0);
          }
        __builtin_amdgcn_sched_barrier(0);
      }
    };
    using C0 = std::integral_constant<int, 0>; using C1 = std::integral_constant<int, 1>;
    gload(C0{}, 0); sstore(C0{}); gload(C1{}, 1); __syncthreads();
    int kt = 0;
    for (; kt + 2 < 16; kt += 2) {
      gload(C0{}, kt + 2); compute(C0{}); sstore(C1{}); __syncthreads();
      gload(C1{}, kt + 3); compute(C1{}); sstore(C0{}); __syncthreads();
    }
    compute(C0{}); sstore(C1{}); __syncthreads();
    compute(C1{}); __syncthreads();
#pragma unroll
    for (int mi = 0; mi < 2; ++mi)
#pragma unroll
      for (int ni = 0; ni < 4; ++ni) {
        float4 o; o.x = acc[mi][ni][0]; o.y = acc[mi][ni][1]; o.z = acc[mi][ni][2]; o.w = acc[mi][ni][3];
        *reinterpret_cast<float4*>(p.logits + (size_t)(m0 + wr * 32 + mi * 16 + fr) * NE + n0 + wc * 64 + ni * 16 + fq * 4) = o;
      }
  }
}

DEV void ph_route(const Params& p, const float* rbias, int* cnt, int* etok) {
  const int lane = tidx() & 63, gw = blockIdx.x * NWAVE + (tidx() >> 6), nw = gridDim.x * NWAVE;
  const int half = lane >> 5;
  for (int tok = gw; tok < T_; tok += nw) {
    float aff[4], val[4];
#pragma unroll
    for (int j = 0; j < 4; ++j) {
      const float lg = p.logits[(size_t)tok * NE + lane + 64 * j];
      aff[j] = 1.f / (1.f + expf(-lg));
      val[j] = aff[j] + rbias[lane + 64 * j];
    }
    float gs[8];
#pragma unroll
    for (int j = 0; j < 4; ++j) {
      float m1 = val[j];
#pragma unroll
      for (int o = 16; o; o >>= 1) m1 = fmaxf(m1, __shfl_xor(m1, o));
      const unsigned long long eq = __ballot(val[j] == m1);
      const int ceq = __popc((unsigned)(half ? (eq >> 32) : (eq & 0xffffffffull)));
      float m2 = (val[j] == m1) ? -INFINITY : val[j];
#pragma unroll
      for (int o = 16; o; o >>= 1) m2 = fmaxf(m2, __shfl_xor(m2, o));
      if (ceq >= 2) m2 = m1;
      const float mine = m1 + m2, other = __shfl_xor(mine, 32);
      gs[2 * j] = half ? other : mine; gs[2 * j + 1] = half ? mine : other;
    }
    bool gok[8];
#pragma unroll
    for (int g = 0; g < 8; ++g) {
      int rk = 0;
#pragma unroll
      for (int g2 = 0; g2 < 8; ++g2) rk += (gs[g2] > gs[g] || (gs[g2] == gs[g] && g2 < g)) ? 1 : 0;
      gok[g] = rk < 4;
    }
#pragma unroll
    for (int j = 0; j < 4; ++j) { const bool ok = half ? gok[2 * j + 1] : gok[2 * j]; if (!ok) val[j] = -INFINITY; }
    int my_e = 0; float my_a = 0.f, asum = 0.f;
#pragma unroll
    for (int k = 0; k < TOPK; ++k) {
      float bv = val[0]; int bi = lane;
#pragma unroll
      for (int j = 1; j < 4; ++j) if (val[j] > bv) { bv = val[j]; bi = lane + 64 * j; }
#pragma unroll
      for (int o = 32; o; o >>= 1) {
        const float ov = __shfl_xor(bv, o); const int oi = __shfl_xor(bi, o);
        if (ov > bv || (ov == bv && oi < bi)) { bv = ov; bi = oi; }
      }
      float a_sel = 0.f;
#pragma unroll
      for (int j = 0; j < 4; ++j) { const bool hit = (bi == lane + 64 * j); a_sel = hit ? aff[j] : a_sel; val[j] = hit ? -INFINITY : val[j]; }
      a_sel = wave_sum(a_sel);
      asum += a_sel;
      if (lane == k) { my_e = bi; my_a = a_sel; }
    }
    if (lane < TOPK) {
      const int ps = atomicAdd(&cnt[my_e], 1);
      p.eidx[tok * TOPK + lane] = my_e; p.epos[tok * TOPK + lane] = ps; p.gatev[tok * TOPK + lane] = my_a / asum * 2.5f;
      etok[(size_t)my_e * T_ + ps] = tok;
    }
  }
}

constexpr int MOE_TM = 320;
struct MoeTab { int cn[260]; int of[260]; int tf[260]; unsigned ao[2][5][NTHR]; };
DEV void moe_prep(MoeTab& mt, const int* cnt) {
  const int tid = tidx();
  if (tid < NE) mt.cn[tid] = cnt[tid];
  __syncthreads();
  if (tid == 0) {
    int a = 0, tl = 0;
    for (int e = 0; e < NE; ++e) { mt.of[e] = a; mt.tf[e] = tl; a += mt.cn[e]; tl += (mt.cn[e] + MOE_TM - 1) / MOE_TM; }
    mt.cn[NE] = T_; mt.of[NE] = NASG; mt.tf[NE] = tl; mt.of[NE + 1] = NASG + T_; mt.tf[NE + 1] = tl + (T_ + MOE_TM - 1) / MOE_TM;
  }
  __syncthreads();
}
DEV int moe_rows_per_tile(int cn, int tiles) { return (cn + tiles - 1) / tiles; }
struct MoeItem { int e, nt, r0, r1, of; };
template <int NPT> DEV MoeItem moe_item(const MoeTab& mt, int u) {
  int lo = 0, hi = NE;
  while (lo < hi) { const int mid = (lo + hi + 1) >> 1; if (NPT * mt.tf[mid] <= u) lo = mid; else hi = mid - 1; }
  MoeItem it; it.e = lo;
  const int tiles = mt.tf[lo + 1] - mt.tf[lo], local = u - NPT * mt.tf[lo], mtl = local / NPT, cn = mt.cn[lo];
  it.nt = local - mtl * NPT; it.of = mt.of[lo];
  const int per = moe_rows_per_tile(cn, tiles);
  it.r0 = mtl * per; it.r1 = (it.r0 + per < cn) ? it.r0 + per : cn;
  return it;
}

template <int NK, class FA, class FB, class FAN, class FBN, class FM, class FE>
DEV void moe_gemm5(GemmSmem& sm, u32x4_t (&ra)[2][5], f32x4_t (&rb)[4], FA a_addr, FB b_addr, FAN a_next, FBN b_next, int ldb, FM mid, FE epi) {
  constexpr int MI = 5;
  const int tid = tidx(), lane = tid & 63, wid = tid >> 6;
  const int wr = wid >> 1, wc = wid & 1, fr = lane & 15, fq = lane >> 4;
  const int n4 = tid & 31, kq = tid >> 5, q4 = (lane & 15) >> 2, p4 = lane & 3;
  f32x4 acc[MI][4];
#pragma unroll
  for (int mi = 0; mi < MI; ++mi)
#pragma unroll
    for (int ni = 0; ni < 4; ++ni) acc[mi][ni] = f32x4{0.f, 0.f, 0.f, 0.f};
  auto gloadA = [&](auto PC, auto& fa, int kt) {
    constexpr int P = decltype(PC)::value;
#pragma unroll
    for (int i = 0; i < MI; ++i) ra[P][i] = *reinterpret_cast<const u32x4_t*>(fa(i, kt));
  };
  auto gloadB = [&](auto& fb, int kt) {
    const float* bp = fb(kt);
#pragma unroll
    for (int i = 0; i < 4; ++i) rb[i] = *reinterpret_cast<const f32x4_t*>(bp + (size_t)(16 * i) * ldb);
  };
  auto sstore = [&](auto PC, auto BC) {
    constexpr int P = decltype(PC)::value;
    constexpr int Bf = decltype(BC)::value;
#pragma unroll
    for (int i = 0; i < MI; ++i) *reinterpret_cast<u32x4_t*>(&sm.A[Bf][(tid >> 3) + 64 * i][(tid & 7) * 8]) = ra[P][i];
#pragma unroll
    for (int i = 0; i < 4; ++i) {
      const f32x4_t v = rb[i];
      u32x2_t w; w[0] = cvtpk(v[0], v[1]); w[1] = cvtpk(v[2], v[3]);
      const int k = kq + 16 * i;
      *reinterpret_cast<u32x2_t*>(&sm.B[Bf][k][(((n4 >> 2) ^ bswz(k)) << 4) + (n4 & 3) * 4]) = w;
    }
  };
  auto compute = [&](auto BC) {
    constexpr int P = decltype(BC)::value;
#pragma unroll
    for (int ks = 0; ks < 2; ++ks) {
      bf16x8 bf[4];
#pragma unroll
      for (int ni = 0; ni < 4; ++ni) {
        const int k0 = 32 * ks + 8 * fq + q4, col = (((wc * 4 + ni) ^ bswz(k0)) << 4) + 4 * p4;
        const v4i16_t lo = lds_tr(&sm.B[P][k0][col]);
        const v4i16_t hh = lds_tr(&sm.B[P][k0 + 4][col]);
        bf[ni] = bf16x8{lo[0], lo[1], lo[2], lo[3], hh[0], hh[1], hh[2], hh[3]};
      }
      {
        bf16x8 af[3];
#pragma unroll
        for (int mi = 0; mi < 3; ++mi) af[mi] = *reinterpret_cast<const bf16x8*>(&sm.A[P][wr * 80 + mi * 16 + fr][32 * ks + fq * 8]);
#pragma unroll
        for (int mi = 0; mi < 3; ++mi)
#pragma unroll
          for (int ni = 0; ni < 4; ++ni) acc[mi][ni] = __builtin_amdgcn_mfma_f32_16x16x32_bf16(bf[ni], af[mi], acc[mi][ni], 0, 0, 0);
      }
      __builtin_amdgcn_sched_barrier(0);
      {
        bf16x8 af[2];
#pragma unroll
        for (int mi = 3; mi < 5; ++mi) af[mi - 3] = *reinterpret_cast<const bf16x8*>(&sm.A[P][wr * 80 + mi * 16 + fr][32 * ks + fq * 8]);
#pragma unroll
        for (int mi = 3; mi < 5; ++mi)
#pragma unroll
          for (int ni = 0; ni < 4; ++ni) acc[mi][ni] = __builtin_amdgcn_mfma_f32_16x16x32_bf16(bf[ni], af[mi - 3], acc[mi][ni], 0, 0, 0);
      }
      __builtin_amdgcn_sched_barrier(0);
    }
  };
  using C0 = std::integral_constant<int, 0>; using C1 = std::integral_constant<int, 1>;
  gloadA(C1{}, a_addr, 1);
  sstore(C0{}, C0{}); __syncthreads();
#pragma unroll 1
  for (int kt = 0; kt + 2 < NK; kt += 2) {
    gloadA(C0{}, a_addr, kt + 2); gloadB(b_addr, kt + 1); if (kt == 0) mid(); compute(C0{}); sstore(C1{}, C1{}); __syncthreads();
    gloadA(C1{}, a_addr, kt + 3); gloadB(b_addr, kt + 2); compute(C1{}); sstore(C0{}, C0{}); __syncthreads();
  }
  gloadB(b_addr, NK - 1); compute(C0{}); sstore(C1{}, C1{}); __syncthreads();
  gloadA(C0{}, a_next, 0); gloadB(b_next, 0);
  compute(C1{});
  epi(acc);
}


constexpr int TS_LD = 136;
DEV void ts_put(u16* T, int row, int col, float a, float b, float c, float d) { uint2 w; w.x = cvtpk(a, b); w.y = cvtpk(c, d); *reinterpret_cast<uint2*>(T + row * TS_LD + col) = w; }
template <int NCH, class FD> DEV void ts_flush(const u16* T, int rows, FD dst) {
  __syncthreads();
  for (int c = tidx(); c < rows * NCH; c += NTHR) {
    const int row = c / NCH, ch = c - row * NCH;
    u16* d = dst(row);
    if (d) *reinterpret_cast<u32x4_t*>(d + ch * 8) = *reinterpret_cast<const u32x4_t*>(T + row * TS_LD + ch * 8);
  }
  __syncthreads();
}

DEV void ph_moe1(const Params& p, GemmSmem& sm, MoeTab& mt, int layer, const int* cnt) {
  const int tid = tidx(), lane = tid & 63, wid = tid >> 6, wr = wid >> 1, wc = wid & 1, fr = lane & 15, fq = lane >> 4;
  moe_prep(mt, cnt);
  ItemRange it = xcd_items(mt.tf[NE + 1] * 4);
  if (it.i >= it.hi) return;
  const int v0 = 4 * (tid & 31);
  auto set_rows = [&](const MoeItem& m, int slot) {
#pragma unroll
    for (int i = 0; i < 5; ++i) {
      int ri = m.r0 + (tid >> 3) + 64 * i; ri = ri < m.r1 ? ri : m.r1 - 1;
      const int tk = m.e < NE ? p.etok[(size_t)m.e * T_ + ri] : ri;
      mt.ao[slot][i][tid] = (unsigned)tk * D_ + (tid & 7) * 8;
    }
  };
  auto b_ptr = [&](const MoeItem& m, int kt) -> const float* {
    const float* wg = m.e < NE ? p.w_gate + ((size_t)layer * NE + m.e) * D_ * 256 : p.sh_gate + (size_t)layer * D_ * 256;
    const float* wu = m.e < NE ? p.w_up + ((size_t)layer * NE + m.e) * D_ * 256 : p.sh_up + (size_t)layer * D_ * 256;
    return ((v0 & 63) >= 32 ? wu : wg) + (size_t)(kt * 64 + (tid >> 5)) * 256 + m.nt * 64 + (v0 >> 6) * 32 + (v0 & 31);
  };
  u32x4_t ra[2][5]; f32x4_t rb[4];
  MoeItem cur = moe_item<4>(mt, it.i);
  int slot = 0;
  set_rows(cur, 0);
  {
#pragma unroll
    for (int i = 0; i < 5; ++i) ra[0][i] = *reinterpret_cast<const u32x4_t*>(p.x1b + mt.ao[0][i][tid]);
#pragma unroll
    for (int i = 0; i < 4; ++i) rb[i] = *reinterpret_cast<const f32x4_t*>(b_ptr(cur, 0) + (size_t)(16 * i) * 256);
  }
  for (;;) {
    const int un = it.i + it.step;
    const bool has_next = un < it.hi;
    const MoeItem nxt = has_next ? moe_item<4>(mt, un) : cur;
    const int nslot = has_next ? slot ^ 1 : slot;
    auto a_addr = [&](int i, int kt) { return p.x1b + mt.ao[slot][i][tid] + kt * 64; };
    auto b_addr = [&](int kt) { return b_ptr(cur, kt); };
    auto a_next = [&](int i, int kt) { return p.x1b + mt.ao[nslot][i][tid] + kt * 64; };
    auto b_next = [&](int kt) { return b_ptr(nxt, kt); };
    auto mid = [&]() { if (has_next) set_rows(nxt, nslot); };
    auto epi = [&](f32x4 (&acc)[5][4]) {
#pragma unroll
      for (int mi = 0; mi < 5; ++mi) {
        const int idx = cur.r0 + wr * 80 + mi * 16 + fr;
        if (idx < cur.r1) {
#pragma unroll
          for (int n2 = 0; n2 < 2; ++n2) {
            float hv[4];
#pragma unroll
            for (int j = 0; j < 4; ++j) { const float g = acc[mi][n2][j], uu = acc[mi][n2 + 2][j]; hv[j] = g * __builtin_amdgcn_rcpf(1.f + __expf(-g)) * uu; }
            st_bf4(p.hbuf + (size_t)(cur.of + idx) * 256 + cur.nt * 64 + wc * 32 + n2 * 16 + fq * 4, hv[0], hv[1], hv[2], hv[3]);
          }
        }
      }
    };
    moe_gemm5<16>(sm, ra, rb, a_addr, b_addr, a_next, b_next, 256, mid, epi);
    if (!has_next) break;
    cur = nxt; it.i = un; slot = nslot;
  }
}

DEV void ph_moe2(const Params& p, GemmSmem& sm, MoeTab& mt, int layer, const int* cnt) {
  const int tid = tidx(), lane = tid & 63, wid = tid >> 6, wr = wid >> 1, wc = wid & 1, fr = lane & 15, fq = lane >> 4;
  moe_prep(mt, cnt);
  ItemRange it = xcd_items(mt.tf[NE + 1] * 8);
  if (it.i >= it.hi) return;
  auto a_ptr = [&](const MoeItem& m, int i, int kt) -> const u16* {
    const int rmax = m.r1 - 1 - m.r0 - (tid >> 3);
    int d = 64 * i; d = d < rmax ? d : rmax;
    return p.hbuf + (size_t)(m.of + m.r0 + (tid >> 3) + d) * 256 + (tid & 7) * 8 + kt * 64;
  };
  auto b_ptr = [&](const MoeItem& m, int kt) -> const float* {
    const float* wd = m.e < NE ? p.w_down + ((size_t)layer * NE + m.e) * 256 * D_ : p.sh_down + (size_t)layer * 256 * D_;
    return wd + (size_t)(kt * 64 + (tid >> 5)) * D_ + m.nt * 128 + 4 * (tid & 31);
  };
  u32x4_t ra[2][5]; f32x4_t rb[4];
  MoeItem cur = moe_item<8>(mt, it.i);
  {
#pragma unroll
    for (int i = 0; i < 5; ++i) ra[0][i] = *reinterpret_cast<const u32x4_t*>(a_ptr(cur, i, 0));
#pragma unroll
    for (int i = 0; i < 4; ++i) rb[i] = *reinterpret_cast<const f32x4_t*>(b_ptr(cur, 0) + (size_t)(16 * i) * D_);
  }
  for (;;) {
    const int un = it.i + it.step;
    const bool has_next = un < it.hi;
    const MoeItem nxt = has_next ? moe_item<8>(mt, un) : cur;
    auto a_addr = [&](int i, int kt) { return a_ptr(cur, i, kt); };
    auto b_addr = [&](int kt) { return b_ptr(cur, kt); };
    auto a_next = [&](int i, int kt) { return a_ptr(nxt, i, kt); };
    auto b_next = [&](int kt) { return b_ptr(nxt, kt); };
    auto mid = [&]() {};
    auto epi = [&](f32x4 (&acc)[5][4]) {
      u16* T = reinterpret_cast<u16*>(&sm);
      __syncthreads();
#pragma unroll
      for (int mi = 0; mi < 5; ++mi)
#pragma unroll
        for (int ni = 0; ni < 4; ++ni) ts_put(T, wr * 80 + mi * 16 + fr, wc * 64 + ni * 16 + fq * 4, acc[mi][ni][0], acc[mi][ni][1], acc[mi][ni][2], acc[mi][ni][3]);
      ts_flush<16>(T, cur.r1 - cur.r0, [&](int row) -> u16* { return p.ybuf + (size_t)(cur.of + cur.r0 + row) * D_ + cur.nt * 128; });
    };
    moe_gemm5<4>(sm, ra, rb, a_addr, b_addr, a_next, b_next, D_, mid, epi);
    if (!has_next) break;
    cur = nxt; it.i = un;
  }
}

DEV void ph_combine_ln(const Params& p, MoeTab& mt, const int* cnt, const float* g, const float* bt, float* outf, u16* outb, bool with_ffn, bool write_b = true) {
  const int lane = tidx() & 63, gw = blockIdx.x * NWAVE + (tidx() >> 6), nw = gridDim.x * NWAVE;
  moe_prep(mt, cnt);
  for (int tok = gw; tok < T_; tok += nw) {
    int sl = 0; float gk = 0.f;
    if (lane < TOPK) { sl = mt.of[p.eidx[tok * TOPK + lane]] + p.epos[tok * TOPK + lane]; gk = p.gatev[tok * TOPK + lane]; }
    u32x4_t y[9][2], xh[2], xl[2];
#pragma unroll
    for (int i = 0; i < 2; ++i) {
      xh[i] = reinterpret_cast<const u32x4_t*>(p.x1b + (size_t)tok * D_)[i * 64 + lane];
      xl[i] = reinterpret_cast<const u32x4_t*>(p.x1lo + (size_t)tok * D_)[i * 64 + lane];
      y[8][i] = reinterpret_cast<const u32x4_t*>(p.ybuf + (size_t)(NASG + tok) * D_)[i * 64 + lane];
    }
    float gks[8];
#pragma unroll
    for (int k = 0; k < TOPK; ++k) {
      const int slk = __builtin_amdgcn_readlane(sl, k);
      gks[k] = __builtin_bit_cast(float, __builtin_amdgcn_readlane(__builtin_bit_cast(int, gk), k));
#pragma unroll
      for (int i = 0; i < 2; ++i) y[k][i] = reinterpret_cast<const u32x4_t*>(p.ybuf + (size_t)slk * D_)[i * 64 + lane];
    }
    float v[2][8];
#pragma unroll
    for (int i = 0; i < 2; ++i)
#pragma unroll
      for (int c = 0; c < 4; ++c) {
        float a0 = ALPHA * (bflo(xh[i][c]) + bflo(xl[i][c])), a1 = ALPHA * (bfhi(xh[i][c]) + bfhi(xl[i][c]));
        if (with_ffn) {
          a0 += bflo(y[8][i][c]); a1 += bfhi(y[8][i][c]);
#pragma unroll
          for (int k = 0; k < TOPK; ++k) { a0 += gks[k] * bflo(y[k][i][c]); a1 += gks[k] * bfhi(y[k][i][c]); }
        }
        v[i][2 * c] = a0; v[i][2 * c + 1] = a1;
      }
    float s = 0.f;
#pragma unroll
    for (int i = 0; i < 2; ++i)
#pragma unroll
      for (int c = 0; c < 8; ++c) s += v[i][c];
    const float mu = wave_sum(s) * (1.f / D_);
    float ss = 0.f;
#pragma unroll
    for (int i = 0; i < 2; ++i)
#pragma unroll
      for (int c = 0; c < 8; ++c) { v[i][c] -= mu; ss += v[i][c] * v[i][c]; }
    const float rstd = rsqrtf(wave_sum(ss) * (1.f / D_) + LN_EPS);
#pragma unroll
    for (int i = 0; i < 2; ++i) {
      const int c0 = (i * 64 + lane) * 8;
      float o[8];
#pragma unroll
      for (int h = 0; h < 2; ++h) {
        const float4 gg = ld4(g + c0 + 4 * h), bb = ld4(bt + c0 + 4 * h);
        o[4 * h] = v[i][4 * h] * rstd * gg.x + bb.x; o[4 * h + 1] = v[i][4 * h + 1] * rstd * gg.y + bb.y;
        o[4 * h + 2] = v[i][4 * h + 2] * rstd * gg.z + bb.z; o[4 * h + 3] = v[i][4 * h + 3] * rstd * gg.w + bb.w;
        float4 w; w.x = o[4 * h]; w.y = o[4 * h + 1]; w.z = o[4 * h + 2]; w.w = o[4 * h + 3];
        *reinterpret_cast<float4*>(outf + (size_t)tok * D_ + c0 + 4 * h) = w;
      }
      if (write_b) {
        u32x4_t w; w[0] = cvtpk(o[0], o[1]); w[1] = cvtpk(o[2], o[3]); w[2] = cvtpk(o[4], o[5]); w[3] = cvtpk(o[6], o[7]);
        *reinterpret_cast<u32x4_t*>(outb + (size_t)tok * D_ + c0) = w;
      }
    }
  }
}

DEV void ph_inproj1(const Params& p, GemmSmem& sm) {
  const int tid = tidx(), lane = tid & 63, wid = tid >> 6, wr = wid >> 1, wc = wid & 1, fr = lane & 15, fq = lane >> 4;
  constexpr int NT = 21;
  for (ItemRange it = xcd_items(64 * (NT + 1)); it.i < it.hi; it.i += it.step) {
    int mt, nt; dense_item<16, 2>(it.i, 64, mt, nt);
    if (nt >= NT) continue;
    const int m0 = mt * 256, n0 = nt * 128;
    const u16* ar0 = p.xb + (size_t)(m0 + (tid >> 3)) * D_ + (tid & 7) * 8;
    auto a_addr = [&](int i, int kt) { return ar0 + (size_t)i * 64 * D_ + kt * 64; };
    const u16* bb = p.w16_in1 + (size_t)(tid >> 4) * NIN1 + n0 + 8 * (tid & 15);
    const bool bok = n0 + 8 * (tid & 15) < NIN1;
    const u16* bbv = bok ? bb : p.w16_in1 + (size_t)(tid >> 4) * NIN1;
    auto b_addr = [&](int kt) -> const u16* { return bbv + (size_t)kt * 64 * NIN1; };
    auto b_lo = [&](int) { return false; };
    auto epi = [&](f32x4 (&acc)[4][4]) {
#pragma unroll
      for (int mi = 0; mi < 4; ++mi) {
        const int row = m0 + wr * 64 + mi * 16 + fr;
#pragma unroll
        for (int ni = 0; ni < 4; ++ni) {
          f32x4 v = acc[mi][ni];
          const int col = n0 + wc * 64 + ni * 16 + fq * 4;
          const bool rope = (ni == 0) && (col < 1280 || (col >= 1536 && col < 1792) || (col >= 2048 && col < 2304));
          if (rope) {
            const float4 c_ = ld4(p.cs + row * 16 + 4 * (fq & 1)), s_ = ld4(p.cs + row * 16 + 8 + 4 * (fq & 1));
            const float p0 = __shfl_xor(v[0], 32), p1 = __shfl_xor(v[1], 32), p2 = __shfl_xor(v[2], 32), p3 = __shfl_xor(v[3], 32);
            const float sg = fq < 2 ? -1.f : 1.f;
            v[0] = v[0] * c_.x + sg * p0 * s_.x; v[1] = v[1] * c_.y + sg * p1 * s_.y; v[2] = v[2] * c_.z + sg * p2 * s_.z; v[3] = v[3] * c_.w + sg * p3 * s_.w;
          }
          if (col < LD1) st_bf4(p.qkv + (size_t)row * LD1 + col, v[0], v[1], v[2], v[3]);
          else if (col < NIN1) {
            float4 o; o.x = 1.f / (1.f + __expf(-v[0])); o.y = 1.f / (1.f + __expf(-v[1])); o.z = 1.f / (1.f + __expf(-v[2])); o.w = 1.f / (1.f + __expf(-v[3]));
            *reinterpret_cast<float4*>(p.gates + (size_t)row * 48 + (col - LD1)) = o;
          }
        }
      }
    };
    gemm_core<4, false, true>(sm, 16, a_addr, b_addr, NIN1, b_lo, epi, bok);
  }
}

DEV float gelu_tanh(float x) { const float u = 0.7978845608028654f * (x + 0.044715f * x * x * x); return 0.5f * x * (1.f + tanhf(u)); }
DEV void ph_cmp1(const Params& p, GemmSmem& sm) {
  const int tid = tidx(), lane = tid & 63, wid = tid >> 6, wr = wid >> 1, wc = wid & 1, fr = lane & 15, fq = lane >> 4;
  for (int u = blockIdx.x; u < 64; u += gridDim.x) {
    const int ts = u >> 5, mt = u & 31, m0 = mt * 128;
    const u16* ar[2];
#pragma unroll
    for (int i = 0; i < 2; ++i) {
      const int m_ = m0 + (tid >> 3) + 64 * i, bg = m_ >> 8; int c = m_ & 255; c = c < 255 ? c : 254;
      ar[i] = p.qkv + (size_t)((bg >> 2) * S_ + 16 * c) * LD1 + (ts ? 1280 : 1024) + (bg & 3) * 64 + (tid & 7) * 8;
    }
    auto a_addr = [&](int i, int kt) { return ar[i] + (size_t)kt * LD1; };
    const float* bb = (ts ? p.cmpv_w1 : p.cmpk_w1) + (size_t)(tid >> 5) * 128 + 4 * (tid & 31);
    auto b_addr = [&](int kt) { return bb + (size_t)kt * 64 * 128; };
    auto b_lo = [&](int) { return false; };
    auto epi = [&](f32x4 (&acc)[2][4]) {
#pragma unroll
      for (int mi = 0; mi < 2; ++mi)
#pragma unroll
        for (int ni = 0; ni < 4; ++ni) {
          const int m = m0 + wr * 32 + mi * 16 + fr, col = wc * 64 + ni * 16 + fq * 4;
          const float4 pbv = ld4(p.pb + ts * 128 + col);
          st_bf4(p.hid + ((size_t)ts * 4096 + m) * 128 + col, gelu_tanh(acc[mi][ni][0] + pbv.x), gelu_tanh(acc[mi][ni][1] + pbv.y),
                 gelu_tanh(acc[mi][ni][2] + pbv.z), gelu_tanh(acc[mi][ni][3] + pbv.w));
        }
    };
    gemm_core<2, false>(sm, 32, a_addr, b_addr, 128, b_lo, epi);
  }
}
DEV void ph_cmp2(const Params& p, GemmSmem& sm) {
  const int tid = tidx(), lane = tid & 63, wid = tid >> 6, wr = wid >> 1, wc = wid & 1, fr = lane & 15, fq = lane >> 4;
  for (int u = blockIdx.x; u < 64; u += gridDim.x) {
    const int ts = u >> 5, mt = u & 31, m0 = mt * 128;
    const u16* ar0 = p.hid + ((size_t)ts * 4096 + m0 + (tid >> 3)) * 128 + (tid & 7) * 8;
    auto a_addr = [&](int i, int kt) { return ar0 + (size_t)i * 64 * 128 + kt * 64; };
    const float* bb = (ts ? p.cmpv_w2 : p.cmpk_w2) + (size_t)(tid >> 5) * 64 + 4 * (tid & 31);
    const bool bok = 4 * (tid & 31) < 64;
    const float* bbv = bok ? bb : (ts ? p.cmpv_w2 : p.cmpk_w2) + (size_t)(tid >> 5) * 64;
    auto b_addr = [&](int kt) -> const float* { return bbv + (size_t)kt * 64 * 64; };
    auto b_lo = [&](int) { return false; };
    auto epi = [&](f32x4 (&acc)[2][4]) {
      if (wc == 0) {
#pragma unroll
        for (int mi = 0; mi < 2; ++mi)
#pragma unroll
          for (int ni = 0; ni < 4; ++ni) {
            const int m = m0 + wr * 32 + mi * 16 + fr, col = ni * 16 + fq * 4;
            st_bf4(p.cmpkv + ((size_t)ts * 4096 + m) * 64 + col, acc[mi][ni][0], acc[mi][ni][1], acc[mi][ni][2], acc[mi][ni][3]);
          }
      }
    };
    gemm_core<2, false>(sm, 2, a_addr, b_addr, 64, b_lo, epi, bok);
  }
}

using f32x16 = __attribute__((ext_vector_type(16))) float;
DEV int crow(int r, int hi) { return (r & 3) + 8 * (r >> 2) + 4 * hi; }
constexpr float LOG2E = 1.4426950408889634f;
constexpr float SCL2 = 0.125f * LOG2E;

struct WaveTile { u16 K[32][72]; u16 V[2][32][32]; };
struct KVTile { u16 K[32][72]; u16 V[2][32][32]; };
struct AttnState { float m, l; f32x16 o[2]; };

DEV void stage_load(u32x4_t (&rk)[4], u32x4_t (&rv)[4], const u16* Kb, const u16* Vb, int ld, long rowbase, int rowstep, int kcmax, int k0, int lane) {
#pragma unroll
  for (int it = 0; it < 4; ++it) {
    int kc = k0 + (lane >> 3) + 8 * it; kc = kc > kcmax ? kcmax : kc;
    const long row = rowbase + (long)kc * rowstep;
    rk[it] = *reinterpret_cast<const u32x4_t*>(Kb + row * ld + (lane & 7) * 8);
    rv[it] = *reinterpret_cast<const u32x4_t*>(Vb + row * ld + (lane & 7) * 8);
  }
}
DEV void stage_store(WaveTile& wt, const u32x4_t (&rk)[4], const u32x4_t (&rv)[4], int lane) {
  const int ch = lane & 7;
#pragma unroll
  for (int it = 0; it < 4; ++it) {
    const int j = (lane >> 3) + 8 * it;
    *reinterpret_cast<u32x4_t*>(&wt.K[j][ch * 8]) = rk[it];
    *reinterpret_cast<u32x4_t*>(&wt.V[ch >> 2][j][(ch & 3) * 8]) = rv[it];
  }
}
template <class TT> DEV f32x16 qk_tile(const TT& wt, const bf16x8 (&qf)[4], int r32, int hi) {
  f32x16 acc;
#pragma unroll
  for (int r = 0; r < 16; ++r) acc[r] = 0.f;
#pragma unroll
  for (int s = 0; s < 4; ++s) {
    const bf16x8 kf = *reinterpret_cast<const bf16x8*>(&wt.K[r32][16 * s + 8 * hi]);
    acc = __builtin_amdgcn_mfma_f32_32x32x16_bf16(kf, qf[s], acc, 0, 0, 0);
  }
  return acc;
}
template <class TT> DEV void pv_tile(const TT& wt, const float (&pr)[16], f32x16 (&o)[2], int lane) {
  const int hi = lane >> 5, g = (lane >> 4) & 1, q4 = (lane & 15) >> 2, p4 = lane & 3;
  bf16x8 pf[2];
#pragma unroll
  for (int s2 = 0; s2 < 2; ++s2) {
    u32x4_t w;
    w[0] = cvtpk(pr[8 * s2 + 0], pr[8 * s2 + 1]); w[1] = cvtpk(pr[8 * s2 + 2], pr[8 * s2 + 3]);
    w[2] = cvtpk(pr[8 * s2 + 4], pr[8 * s2 + 5]); w[3] = cvtpk(pr[8 * s2 + 6], pr[8 * s2 + 7]);
    pf[s2] = __builtin_bit_cast(bf16x8, w);
  }
#pragma unroll
  for (int dt = 0; dt < 2; ++dt)
#pragma unroll
    for (int s2 = 0; s2 < 2; ++s2) {
      const v4i16_t lo = lds_tr(&wt.V[dt][16 * s2 + 4 * hi + q4][16 * g + 4 * p4]);
      const v4i16_t hh = lds_tr(&wt.V[dt][16 * s2 + 8 + 4 * hi + q4][16 * g + 4 * p4]);
      const bf16x8 vf = {lo[0], lo[1], lo[2], lo[3], hh[0], hh[1], hh[2], hh[3]};
      o[dt] = __builtin_amdgcn_mfma_f32_32x32x16_bf16(vf, pf[s2], o[dt], 0, 0, 0);
    }
}
DEV void attn_init(AttnState& st) {
  st.m = -INFINITY; st.l = 0.f;
#pragma unroll
  for (int r = 0; r < 16; ++r) { st.o[0][r] = 0.f; st.o[1][r] = 0.f; }
}
template <bool USE_SEL>
DEV void attn_span(AttnState& st, WaveTile& wt, const bf16x8 (&qf)[4], const u16* Kb, const u16* Vb, int ld,
                   long rowbase, int rowstep, int kcmax, int kc_lo, int kc_hi, int qc, int W,
                   unsigned long long sel, unsigned long long selu, int lane, int qc_min, int qc_max) {
  const int r32 = lane & 31, hi = lane >> 5;
  if (kc_lo < 0) kc_lo = 0;
  if (kc_hi > kcmax) kc_hi = kcmax;
  const int full_hi = qc_min < kcmax ? qc_min : kcmax;
  auto skip = [&](int k0) -> bool { return USE_SEL && !((selu >> (k0 >> 6)) & 1ull); };
  int kc0 = kc_lo & ~31;
  while (kc0 <= kc_hi && skip(kc0)) kc0 += 32;
  if (kc0 > kc_hi) return;
  u32x4_t rk[4], rv[4];
  stage_load(rk, rv, Kb, Vb, ld, rowbase, rowstep, kcmax, kc0, lane);
  for (;;) {
    stage_store(wt, rk, rv, lane);
    int kn = kc0 + 32;
    while (kn <= kc_hi && skip(kn)) kn += 32;
    if (kn <= kc_hi) stage_load(rk, rv, Kb, Vb, ld, rowbase, rowstep, kcmax, kn, lane);
    WAVE_SYNC();
    const f32x16 s = qk_tile(wt, qf, r32, hi);
    const bool selbit = USE_SEL ? (((sel >> (kc0 >> 6)) & 1ull) != 0ull) : true;
    const bool full = (qc_min <= qc_max) && (kc0 + 31 <= full_hi) && (kc0 >= qc_max - W);
    float sv[16]; float mt = -INFINITY;
    if (full) {
      float rm = s[0];
#pragma unroll
      for (int r = 1; r < 16; ++r) rm = fmaxf(rm, s[r]);
      mt = selbit ? rm * SCL2 : -INFINITY;
    } else {
#pragma unroll
      for (int r = 0; r < 16; ++r) {
        const int kc = kc0 + crow(r, hi), dist = qc - kc;
        const bool ok = selbit && kc <= kcmax && dist >= 0 && dist <= W;
        sv[r] = ok ? s[r] * SCL2 : -INFINITY;
        mt = fmaxf(mt, sv[r]);
      }
    }
    mt = fmaxf(mt, __shfl_xor(mt, 32));
    const float mnew = fmaxf(st.m, mt), muse = (mnew == -INFINITY) ? 0.f : mnew;
    const float alpha = __builtin_amdgcn_exp2f(st.m - muse);
    st.m = mnew;
    float ps = 0.f;
    if (full) {
      const float sub = selbit ? muse : INFINITY;
#pragma unroll
      for (int r = 0; r < 16; ++r) { sv[r] = __builtin_amdgcn_exp2f(__builtin_fmaf(s[r], SCL2, -sub)); ps += sv[r]; }
    } else {
#pragma unroll
      for (int r = 0; r < 16; ++r) { sv[r] = __builtin_amdgcn_exp2f(sv[r] - muse); ps += sv[r]; }
    }
    st.l = st.l * alpha + ps;
    if (__any(alpha != 1.f)) {
#pragma unroll
      for (int r = 0; r < 16; ++r) { st.o[0][r] *= alpha; st.o[1][r] *= alpha; }
    }
    pv_tile(wt, sv, st.o, lane);
    if (kn > kc_hi) break;
    kc0 = kn;
  }
}
DEV void attn_finish(AttnState& st, float sink2) {
  float l = st.l + __shfl_xor(st.l, 32);
  if (sink2 > -INFINITY) l += __builtin_amdgcn_exp2f(sink2 - st.m);
  const float inv = l > 0.f ? 1.f / l : 0.f;
#pragma unroll
  for (int r = 0; r < 16; ++r) { st.o[0][r] *= inv; st.o[1][r] *= inv; }
}
DEV void attn_store_bf16(const AttnState& st, u16* orow, int hi) {
#pragma unroll
  for (int dt = 0; dt < 2; ++dt)
#pragma unroll
    for (int k4 = 0; k4 < 4; ++k4) {
      uint2 w; w.x = cvtpk(st.o[dt][4 * k4], st.o[dt][4 * k4 + 1]); w.y = cvtpk(st.o[dt][4 * k4 + 2], st.o[dt][4 * k4 + 3]);
      *reinterpret_cast<uint2*>(orow + 32 * dt + 8 * k4 + 4 * hi) = w;
    }
}
DEV void load_qf(bf16x8 (&qf)[4], const u16* qrow, int hi) {
#pragma unroll
  for (int s = 0; s < 4; ++s) qf[s] = *reinterpret_cast<const bf16x8*>(qrow + 16 * s + 8 * hi);
}

DEV void ph_attn0_mfma(const Params& p, WaveTile* wts) {
  const int tid = tidx(), lane = tid & 63, wid = tid >> 6, r32 = lane & 31, hi = lane >> 5;
  WaveTile& wt = wts[wid];
  const int gw = blockIdx.x * NWAVE + wid, nw = gridDim.x * NWAVE;
  for (int u = gw; u < 8192; u += nw) {
    AttnState st; attn_init(st);
    bf16x8 qf[4];
    if (u < 4096) {
      const int it = u & 7, res = (u >> 3) & 15, h = (u >> 7) & 7, b = u >> 10;
      const int i0 = it * 32, t = 16 * (i0 + r32) + res;
      const long row = (long)b * S_ + t;
      load_qf(qf, p.qkv + row * LD0 + h * 64, hi);
      const u16* Kb = p.qkv + 512 + h * 64; const u16* Vb = p.qkv + 1024 + h * 64;
      attn_span<false>(st, wt, qf, Kb, Vb, LD0, (long)b * S_ + res, 16, 255, i0 - 128, i0 + 31, i0 + r32, 128, 0ull, 0ull, lane, 1, 0);
      const int c = res >> 2;
      attn_span<false>(st, wt, qf, Kb, Vb, LD0, (long)b * S_ + (res & 3), 4, 1023, 4 * i0 + c - 128, 4 * (i0 + 31) + c, 4 * (i0 + r32) + c, 128, 0ull, 0ull, lane, 1, 0);
      attn_span<false>(st, wt, qf, Kb, Vb, LD0, (long)b * S_, 1, 4095, 16 * i0 + res - 128, 16 * (i0 + 31) + res, t, 128, 0ull, 0ull, lane, 1, 0);
      attn_finish(st, -INFINITY);
      attn_store_bf16(st, p.ao + row * D_ + h * 64, hi);
    } else {
      const int v = u - 4096, qt = v & 127, hb = (v >> 7) & 7, b = v >> 10, g = hb >> 2;
      const int t = 32 * qt + r32;
      const long row = (long)b * S_ + t;
      load_qf(qf, p.qkv + row * LD0 + 1536 + hb * 64, hi);
      attn_span<false>(st, wt, qf, p.qkv + 2048 + g * 64, p.qkv + 2176 + g * 64, LD0, (long)b * S_, 1, 4095, 32 * qt - 127, 32 * qt + 31, t, 127, 0ull, 0ull, lane, 32 * qt, 32 * qt + 31);
      attn_finish(st, p.even_sinks[hb] * LOG2E);
      attn_store_bf16(st, p.ao + row * D_ + 512 + hb * 64, hi);
    }
  }
}

struct Att1aSmem { KVTile tiles[2][2]; float imp[NWAVE][32][65]; float sc[NWAVE][64]; };
DEV void ph_attn1a(const Params& p, char* smem) {
  Att1aSmem& sm = *reinterpret_cast<Att1aSmem*>(smem);
  const int tid = tidx(), lane = tid & 63, wid = tid >> 6, r32 = lane & 31, hi = lane >> 5, gl = wid >> 2;
  const int sg = tid >> 8, sj = (tid & 255) >> 3, sc = tid & 7;
  for (int u = blockIdx.x; u < 1024; u += gridDim.x) {
    const int k = u >> 8, base = u & 255, bg = base & 7, x = base >> 3;
    const int qt = (k == 0) ? 127 - x : (k == 1) ? 64 + x : (k == 2) ? 63 - x : x;
    const int b = bg >> 1, gp = bg & 1;
    const int h = gp * 8 + wid, g = h >> 2;
    const int q0 = 32 * qt, t = q0 + r32;
    const long row = (long)b * S_ + t;
    const int qc = (t - 31) >> 4;
    int kc_hi = q0 >> 4; kc_hi = kc_hi > 254 ? 254 : kc_hi;
    const int ntile = (kc_hi >> 5) + 1;
    const u16* kp = p.cmpkv + ((size_t)((b * 4 + 2 * gp + sg) * 256) + sj) * 64 + sc * 8;
    const u16* vp = kp + (size_t)4096 * 64;
    for (int i = tid; i < NWAVE * 32 * 65; i += NTHR) (&sm.imp[0][0][0])[i] = 0.f;
    bf16x8 qf[4];
    load_qf(qf, p.qkv + row * LD1 + h * 64, hi);
    auto for_tiles = [&](auto&& body) {
      u32x4_t rk = *reinterpret_cast<const u32x4_t*>(kp), rv = *reinterpret_cast<const u32x4_t*>(vp);
      int cur = 0;
      for (int tt = 0; tt < ntile; ++tt) {
        KVTile& dst = sm.tiles[cur][sg];
        *reinterpret_cast<u32x4_t*>(&dst.K[sj][sc * 8]) = rk;
        *reinterpret_cast<u32x4_t*>(&dst.V[sc >> 2][sj][(sc & 3) * 8]) = rv;
        const int tn = tt + 1 < ntile ? tt + 1 : tt;
        rk = *reinterpret_cast<const u32x4_t*>(kp + (size_t)tn * 32 * 64);
        rv = *reinterpret_cast<const u32x4_t*>(vp + (size_t)tn * 32 * 64);
        __syncthreads();
        body(sm.tiles[cur][gl], tt * 32);
        cur ^= 1;
      }
      __syncthreads();
    };
    float m = -INFINITY, l = 0.f;
    for_tiles([&](const KVTile& tl, int kc0) {
      const f32x16 s = qk_tile(tl, qf, r32, hi);
      float sv[16]; float mt = -INFINITY;
#pragma unroll
      for (int rr = 0; rr < 16; ++rr) { const int kc = kc0 + crow(rr, hi); const bool ok = kc <= 254 && kc <= qc; sv[rr] = ok ? s[rr] * SCL2 : -INFINITY; mt = fmaxf(mt, sv[rr]); }
      mt = fmaxf(mt, __shfl_xor(mt, 32));
      const float mnew = fmaxf(m, mt), muse = (mnew == -INFINITY) ? 0.f : mnew;
      float ps = 0.f;
#pragma unroll
      for (int rr = 0; rr < 16; ++rr) ps += __builtin_amdgcn_exp2f(sv[rr] - muse);
      l = l * __builtin_amdgcn_exp2f(m - muse) + ps; m = mnew;
    });
    l += __shfl_xor(l, 32);
    const float inv = l > 0.f ? 1.f / l : 0.f, muse = (m == -INFINITY) ? 0.f : m;
    f32x16 o[2];
#pragma unroll
    for (int rr = 0; rr < 16; ++rr) { o[0][rr] = 0.f; o[1][rr] = 0.f; }
    for_tiles([&](const KVTile& tl, int kc0) {
      const f32x16 s = qk_tile(tl, qf, r32, hi);
      float pr[16];
#pragma unroll
      for (int rr = 0; rr < 16; ++rr) { const int kc = kc0 + crow(rr, hi); const bool ok = kc <= 254 && kc <= qc; pr[rr] = ok ? __builtin_amdgcn_exp2f(s[rr] * SCL2 - muse) * inv : 0.f; }
#pragma unroll
      for (int k4 = 0; k4 < 4; ++k4) {
        const int j = (kc0 >> 2) + 2 * k4 + hi;
        sm.imp[wid][r32][j] += pr[4 * k4] + pr[4 * k4 + 1] + pr[4 * k4 + 2] + 0.5f * pr[4 * k4 + 3];
        WAVE_SYNC();
        if (j + 1 < 64) sm.imp[wid][r32][j + 1] += 0.5f * pr[4 * k4 + 3];
        WAVE_SYNC();
      }
      pv_tile(tl, pr, o, lane);
    });
    const float g0 = p.gates[(size_t)row * 48 + h * 3];
#pragma unroll
    for (int dt = 0; dt < 2; ++dt)
#pragma unroll
      for (int k4 = 0; k4 < 4; ++k4) {
        float4 w; w.x = g0 * o[dt][4 * k4]; w.y = g0 * o[dt][4 * k4 + 1]; w.z = g0 * o[dt][4 * k4 + 2]; w.w = g0 * o[dt][4 * k4 + 3];
        *reinterpret_cast<float4*>(p.hpre + (size_t)row * D_ + h * 64 + 32 * dt + 8 * k4 + 4 * hi) = w;
      }
    for (int i = 0; i < 8; ++i) {
      const int pi = wid * 8 + i, grp = pi >> 5, q = pi & 31;
      const int tq = q0 + q, cur = tq >> 6;
      const float impq = (sm.imp[4 * grp][q][lane] + sm.imp[4 * grp + 1][q][lane]) + (sm.imp[4 * grp + 2][q][lane] + sm.imp[4 * grp + 3][q][lane]);
      const float score = (lane > cur) ? -1.f : ((lane == 0 || lane == cur || lane == cur - 1) ? 1.0e4f : impq);
      sm.sc[wid][lane] = score;
      WAVE_SYNC();
      int rk_ = 0;
#pragma unroll
      for (int jj = 0; jj < 64; jj += 4) {
        const float4 v = *reinterpret_cast<const float4*>(&sm.sc[wid][jj]);
        rk_ += (v.x > score || (v.x == score && jj < lane)) ? 1 : 0;
        rk_ += (v.y > score || (v.y == score && jj + 1 < lane)) ? 1 : 0;
        rk_ += (v.z > score || (v.z == score && jj + 2 < lane)) ? 1 : 0;
        rk_ += (v.w > score || (v.w == score && jj + 3 < lane)) ? 1 : 0;
      }
      WAVE_SYNC();
      const unsigned long long mask = __ballot(rk_ < 16 && lane <= cur);
      if (lane == 0) p.selmask[((size_t)b * S_ + tq) * 4 + 2 * gp + grp] = mask;
    }
    __syncthreads();
  }
}

template <class TT>
DEV void attn_tile_update(AttnState& st, const TT& tl, const bf16x8 (&qf)[4], int kc0, int qc, int W, int kcmax, bool selbit, bool full, int lane) {
  const int r32 = lane & 31, hi = lane >> 5;
  const f32x16 s = qk_tile(tl, qf, r32, hi);
  float sv[16]; float mt = -INFINITY;
  if (full) {
    float rm = s[0];
#pragma unroll
    for (int r = 1; r < 16; ++r) rm = fmaxf(rm, s[r]);
    mt = selbit ? rm * SCL2 : -INFINITY;
  } else {
#pragma unroll
    for (int r = 0; r < 16; ++r) {
      const int kc = kc0 + crow(r, hi), dist = qc - kc;
      const bool ok = selbit && kc <= kcmax && dist >= 0 && dist <= W;
      sv[r] = ok ? s[r] * SCL2 : -INFINITY;
      mt = fmaxf(mt, sv[r]);
    }
  }
  mt = fmaxf(mt, __shfl_xor(mt, 32));
  const float mnew = fmaxf(st.m, mt), muse = (mnew == -INFINITY) ? 0.f : mnew;
  const float alpha = __builtin_amdgcn_exp2f(st.m - muse);
  st.m = mnew;
  float ps = 0.f;
  if (full) {
    const float sub = selbit ? muse : INFINITY;
#pragma unroll
    for (int r = 0; r < 16; ++r) { sv[r] = __builtin_amdgcn_exp2f(__builtin_fmaf(s[r], SCL2, -sub)); ps += sv[r]; }
  } else {
#pragma unroll
    for (int r = 0; r < 16; ++r) { sv[r] = __builtin_amdgcn_exp2f(sv[r] - muse); ps += sv[r]; }
  }
  st.l = st.l * alpha + ps;
  if (__any(alpha != 1.f)) {
#pragma unroll
    for (int r = 0; r < 16; ++r) { st.o[0][r] *= alpha; st.o[1][r] *= alpha; }
  }
  pv_tile(tl, sv, st.o, lane);
}

template <bool USE_SEL>
DEV void attn_span_shared(AttnState& st, KVTile (*tiles)[2][2], const Params& p, const bf16x8 (&qf)[4], int b, int gp, int kcol, int vcol,
                          int t_lo, int t_hi, int qc, int W, unsigned long long sel, int q0) {
  const int tid = tidx(), lane = tid & 63, wid = tid >> 6, gl = wid >> 2;
  const int sg = tid >> 8, sj = (tid & 255) >> 3, sc = tid & 7;
  const u16* kp = p.qkv + (size_t)b * S_ * LD1 + kcol + (2 * gp + sg) * 64 + (size_t)sj * LD1 + sc * 8;
  const u16* vp = p.qkv + (size_t)b * S_ * LD1 + vcol + (2 * gp + sg) * 64 + (size_t)sj * LD1 + sc * 8;
  const int s_lo = t_lo >> 1, s_hi = t_hi >> 1;
  u32x4_t rk[2], rv[2];
#pragma unroll
  for (int h = 0; h < 2; ++h) {
    rk[h] = *reinterpret_cast<const u32x4_t*>(kp + (size_t)(2 * s_lo + h) * 32 * LD1);
    rv[h] = *reinterpret_cast<const u32x4_t*>(vp + (size_t)(2 * s_lo + h) * 32 * LD1);
  }
  int cur = 0;
  for (int sidx = s_lo; sidx <= s_hi; ++sidx) {
#pragma unroll
    for (int h = 0; h < 2; ++h) {
      KVTile& dst = tiles[cur][sg][h];
      *reinterpret_cast<u32x4_t*>(&dst.K[sj][sc * 8]) = rk[h];
      *reinterpret_cast<u32x4_t*>(&dst.V[sc >> 2][sj][(sc & 3) * 8]) = rv[h];
    }
    const int sn = sidx < s_hi ? sidx + 1 : sidx;
#pragma unroll
    for (int h = 0; h < 2; ++h) {
      rk[h] = *reinterpret_cast<const u32x4_t*>(kp + (size_t)(2 * sn + h) * 32 * LD1);
      rv[h] = *reinterpret_cast<const u32x4_t*>(vp + (size_t)(2 * sn + h) * 32 * LD1);
    }
    __syncthreads();
#pragma unroll
    for (int h = 0; h < 2; ++h) {
      const int t = 2 * sidx + h;
      if (t >= t_lo && t <= t_hi) {
        const int kc0 = t * 32;
        const bool selbit = USE_SEL ? (((sel >> (kc0 >> 6)) & 1ull) != 0ull) : true;
        const bool full = (kc0 + 31 <= q0) && (kc0 >= q0 + 31 - W);
        attn_tile_update(st, tiles[cur][gl][h], qf, kc0, qc, W, 4095, selbit, full, lane);
      }
    }
    cur ^= 1;
  }
  __syncthreads();
}

DEV void ph_attn1b(const Params& p, char* smem) {
  KVTile (*tiles)[2][2] = reinterpret_cast<KVTile (*)[2][2]>(smem);
  const int tid = tidx(), lane = tid & 63, wid = tid >> 6, r32 = lane & 31, hi = lane >> 5;
  for (int u = blockIdx.x; u < 1024; u += gridDim.x) {
    const int k = u >> 8, base = u & 255, bg = base & 7, x = base >> 3;
    const int qt = (k == 0) ? 127 - x : (k == 1) ? 64 + x : (k == 2) ? 63 - x : x;
    const int b = bg >> 1, gp = bg & 1;
    const int h = gp * 8 + wid, g = h >> 2;
    const int q0 = 32 * qt, t = q0 + r32;
    const long row = (long)b * S_ + t;
    bf16x8 qf[4];
    load_qf(qf, p.qkv + row * LD1 + h * 64, hi);
    const unsigned long long sel = p.selmask[(size_t)row * 4 + g];
    const float g1 = p.gates[(size_t)row * 48 + h * 3 + 1], g2 = p.gates[(size_t)row * 48 + h * 3 + 2];
    AttnState st; attn_init(st);
    attn_span_shared<true>(st, tiles, p, qf, b, gp, 1536, 1792, 0, qt, t, 1 << 30, sel, q0);
    attn_finish(st, -INFINITY);
    f32x16 acc[2];
#pragma unroll
    for (int rr = 0; rr < 16; ++rr) { acc[0][rr] = g1 * st.o[0][rr]; acc[1][rr] = g1 * st.o[1][rr]; }
    attn_init(st);
    const int wlo = q0 - 511 > 0 ? (q0 - 511) >> 5 : 0;
    attn_span_shared<false>(st, tiles, p, qf, b, gp, 2048, 2304, wlo, qt, t, 511, 0ull, q0);
    attn_finish(st, -INFINITY);
#pragma unroll
    for (int dt = 0; dt < 2; ++dt)
#pragma unroll
      for (int k4 = 0; k4 < 4; ++k4) {
        const float4 c = *reinterpret_cast<const float4*>(p.hpre + (size_t)row * D_ + h * 64 + 32 * dt + 8 * k4 + 4 * hi);
        uint2 w;
        w.x = cvtpk(c.x + acc[dt][4 * k4] + g2 * st.o[dt][4 * k4], c.y + acc[dt][4 * k4 + 1] + g2 * st.o[dt][4 * k4 + 1]);
        w.y = cvtpk(c.z + acc[dt][4 * k4 + 2] + g2 * st.o[dt][4 * k4 + 2], c.w + acc[dt][4 * k4 + 3] + g2 * st.o[dt][4 * k4 + 3]);
        *reinterpret_cast<uint2*>(p.ao + (size_t)row * D_ + h * 64 + 32 * dt + 8 * k4 + 4 * hi) = w;
      }
  }
}

enum { PH_PRO = 0, PH_IN0, PH_ATT0, PH_OUT0, PH_LN0, PH_RG0, PH_RT0, PH_M10, PH_M20, PH_CB0,
       PH_IN1, PH_C1, PH_C2, PH_ATT1A, PH_ATT1B, PH_OUT1, PH_LN1, PH_RG1, PH_RT1, PH_M11, PH_M21, PH_CB1 };

template <int PH> DEV void run_phase(const Params& p, char* smem) {
  GemmSmem& gs = *reinterpret_cast<GemmSmem*>(smem);
  WaveTile* wts = reinterpret_cast<WaveTile*>(smem);
  MoeTab& mt = *reinterpret_cast<MoeTab*>(smem + sizeof(GemmSmem));
  if constexpr (PH == PH_PRO) ph_prologue(p);
  else if constexpr (PH == PH_IN0) ph_inproj0(p, gs);
  else if constexpr (PH == PH_ATT0) ph_attn0_mfma(p, wts);
  else if constexpr (PH == PH_OUT0) ph_outproj(p, gs, p.w16_out0, p.x);
  else if constexpr (PH == PH_LN0) ph_ln_mix(p, p.mix_g, p.mix_b);
  else if constexpr (PH == PH_RG0) ph_router_gemm(p, smem, p.rw16);
  else if constexpr (PH == PH_RT0) ph_route(p, p.router_b, p.cnt, p.etok);
  else if constexpr (PH == PH_M10) ph_moe1(p, gs, mt, 0, p.cnt);
  else if constexpr (PH == PH_M20) ph_moe2(p, gs, mt, 0, p.cnt);
  else if constexpr (PH == PH_CB0) ph_combine_ln(p, mt, p.cnt, p.ffn_g, p.ffn_b, p.x2f, p.xb, true);
  else if constexpr (PH == PH_IN1) ph_inproj1(p, gs);
  else if constexpr (PH == PH_C1) ph_cmp1(p, gs);
  else if constexpr (PH == PH_C2) ph_cmp2(p, gs);
  else if constexpr (PH == PH_ATT1A) ph_attn1a(p, smem);
  else if constexpr (PH == PH_ATT1B) ph_attn1b(p, smem);
  else if constexpr (PH == PH_OUT1) ph_outproj(p, gs, p.w16_out1, p.x2f);
  else if constexpr (PH == PH_LN1) ph_ln_mix(p, p.mix_g + D_, p.mix_b + D_);
  else if constexpr (PH == PH_RG1) ph_router_gemm(p, smem, p.rw16 + (size_t)2 * D_ * NE);
  else if constexpr (PH == PH_RT1) ph_route(p, p.router_b + NE, p.cnt + 512, p.etok);
  else if constexpr (PH == PH_M11) ph_moe1(p, gs, mt, 1, p.cnt + 512);
  else if constexpr (PH == PH_M21) ph_moe2(p, gs, mt, 1, p.cnt + 512);
  else if constexpr (PH == PH_CB1) ph_combine_ln(p, mt, p.cnt + 512, p.ffn_g + D_, p.ffn_b + D_, p.out, p.xb, true, false);
}

constexpr int SMEM_NEED0 = (NWAVE * (int)sizeof(WaveTile) > (int)(sizeof(GemmSmem) + sizeof(MoeTab))) ? NWAVE * (int)sizeof(WaveTile) : (int)(sizeof(GemmSmem) + sizeof(MoeTab));
constexpr int SMEM_NEED1 = SMEM_NEED0 > (int)sizeof(RouterSmem) ? SMEM_NEED0 : (int)sizeof(RouterSmem);
constexpr int SMEM_NEED2 = SMEM_NEED1 > (int)sizeof(Att1aSmem) ? SMEM_NEED1 : (int)sizeof(Att1aSmem);
constexpr int SMEM_NEED = SMEM_NEED2 > 8 * (int)sizeof(KVTile) ? SMEM_NEED2 : 8 * (int)sizeof(KVTile);
constexpr int SMEM_BAR_OFF = (SMEM_NEED + 15) & ~15, SMEM_BYTES = SMEM_BAR_OFF + 16;
template <int PH, bool LAST> DEV void phase_and_sync(const Params& p, char* smem, const XcdBarrier& bar) {
  run_phase<PH>(p, smem);
  if constexpr (!LAST) xcd_barrier(bar);
}
template <int... PHS> struct PhaseList {};
template <int P0> DEV void run_list(const Params& p, char* smem, const XcdBarrier& bar, PhaseList<P0>) { phase_and_sync<P0, true>(p, smem, bar); }
template <int P0, int P1, int... REST> DEV void run_list(const Params& p, char* smem, const XcdBarrier& bar, PhaseList<P0, P1, REST...>) {
  phase_and_sync<P0, false>(p, smem, bar);
  run_list(p, smem, bar, PhaseList<P1, REST...>{});
}
using Program = PhaseList<PH_PRO, PH_IN0, PH_ATT0, PH_OUT0, PH_LN0, PH_RG0, PH_RT0, PH_M10, PH_M20, PH_CB0,
                          PH_IN1, PH_C1, PH_C2, PH_ATT1A, PH_ATT1B, PH_OUT1, PH_LN1, PH_RG1, PH_RT1, PH_M11, PH_M21, PH_CB1>;
struct KArgs { const void* in[25]; float* out; char* ws; };
constexpr size_t al256(size_t b) { return (b + 255) & ~(size_t)255; }
constexpr size_t OFF_BAR = 0;
constexpr size_t OFF_CNT = OFF_BAR + al256(16384);
constexpr size_t OFF_PB = OFF_CNT + al256(4096);
constexpr size_t OFF_ZERO_END = OFF_PB + al256(1024);
constexpr size_t OFF_CS = OFF_ZERO_END;
constexpr size_t OFF_XB = OFF_CS + al256((size_t)T_ * 16 * 4);
constexpr size_t OFF_QKV = OFF_XB + al256((size_t)T_ * D_ * 2);
constexpr size_t OFF_GATES = OFF_QKV + al256((size_t)T_ * 2624 * 2);
constexpr size_t OFF_AO = OFF_GATES + al256((size_t)T_ * 48 * 4);
constexpr size_t OFF_HPRE = OFF_AO + al256((size_t)T_ * D_ * 2);
constexpr size_t OFF_X1B = OFF_HPRE + al256((size_t)T_ * D_ * 4);
constexpr size_t OFF_X1LO = OFF_X1B + al256((size_t)T_ * D_ * 2);
constexpr size_t OFF_LOGITS = OFF_X1LO + al256((size_t)T_ * D_ * 2);
constexpr size_t OFF_EIDX = OFF_LOGITS + al256((size_t)T_ * NE * 4);
constexpr size_t OFF_GATEV = OFF_EIDX + al256((size_t)NASG * 4);
constexpr size_t OFF_EPOS = OFF_GATEV + al256((size_t)NASG * 4);
constexpr size_t OFF_ETOK = OFF_EPOS + al256((size_t)NASG * 4);
constexpr size_t OFF_HBUF = OFF_ETOK + al256((size_t)NE * T_ * 4);
constexpr size_t OFF_YBUF = OFF_HBUF + al256((size_t)NROWS * 256 * 2);
constexpr size_t OFF_X2F = OFF_YBUF + al256((size_t)NROWS * D_ * 2);
constexpr size_t OFF_HID = OFF_X2F + al256((size_t)T_ * D_ * 4);
constexpr size_t OFF_CMPKV = OFF_HID + al256((size_t)2 * 4096 * 128 * 2);
constexpr size_t OFF_SELMASK = OFF_CMPKV + al256((size_t)2 * 4096 * 64 * 2);
constexpr size_t OFF_W16IN0 = OFF_SELMASK + al256((size_t)T_ * 4 * 8);
constexpr size_t OFF_W16OUT0 = OFF_W16IN0 + al256((size_t)D_ * LD0 * 2);
constexpr size_t OFF_W16IN1 = OFF_W16OUT0 + al256((size_t)D_ * D_ * 2);
constexpr size_t OFF_W16OUT1 = OFF_W16IN1 + al256((size_t)D_ * NIN1 * 2);
constexpr size_t OFF_RW16 = OFF_W16OUT1 + al256((size_t)D_ * D_ * 2);
constexpr size_t WS_NEEDED = OFF_RW16 + al256((size_t)4 * D_ * NE * 2);

DEV Params make_params(const KArgs& k) {
  Params p;
  p.x = (const float*)k.in[0]; p.pos = (const int*)k.in[1];
  p.even_w_in = (const float*)k.in[2]; p.even_sinks = (const float*)k.in[3]; p.even_w_out = (const float*)k.in[4]; p.odd_w_in = (const float*)k.in[5];
  p.cmpk_pos = (const float*)k.in[6]; p.cmpk_w1 = (const float*)k.in[7]; p.cmpk_w2 = (const float*)k.in[8];
  p.cmpv_pos = (const float*)k.in[9]; p.cmpv_w1 = (const float*)k.in[10]; p.cmpv_w2 = (const float*)k.in[11];
  p.odd_w_out = (const float*)k.in[12]; p.mix_g = (const float*)k.in[13]; p.mix_b = (const float*)k.in[14];
  p.router_w = (const float*)k.in[15]; p.router_b = (const float*)k.in[16];
  p.w_gate = (const float*)k.in[17]; p.w_up = (const float*)k.in[18]; p.w_down = (const float*)k.in[19];
  p.sh_gate = (const float*)k.in[20]; p.sh_up = (const float*)k.in[21]; p.sh_down = (const float*)k.in[22];
  p.ffn_g = (const float*)k.in[23]; p.ffn_b = (const float*)k.in[24];
  p.out = k.out;
  char* w = k.ws;
  p.bar = (unsigned*)(w + OFF_BAR); p.cnt = (int*)(w + OFF_CNT); p.pb = (float*)(w + OFF_PB);
  p.cs = (float*)(w + OFF_CS); p.xb = (u16*)(w + OFF_XB); p.qkv = (u16*)(w + OFF_QKV); p.gates = (float*)(w + OFF_GATES);
  p.ao = (u16*)(w + OFF_AO); p.hpre = (float*)(w + OFF_HPRE); p.x1b = (u16*)(w + OFF_X1B); p.x1lo = (u16*)(w + OFF_X1LO);
  p.logits = (float*)(w + OFF_LOGITS); p.eidx = (int*)(w + OFF_EIDX); p.gatev = (float*)(w + OFF_GATEV); p.epos = (int*)(w + OFF_EPOS); p.etok = (int*)(w + OFF_ETOK);
  p.hbuf = (u16*)(w + OFF_HBUF); p.ybuf = (u16*)(w + OFF_YBUF); p.x2f = (float*)(w + OFF_X2F); p.hid = (u16*)(w + OFF_HID); p.cmpkv = (u16*)(w + OFF_CMPKV);
  p.selmask = (unsigned long long*)(w + OFF_SELMASK);
  p.w16_in0 = (u16*)(w + OFF_W16IN0); p.w16_out0 = (u16*)(w + OFF_W16OUT0); p.w16_in1 = (u16*)(w + OFF_W16IN1); p.w16_out1 = (u16*)(w + OFF_W16OUT1); p.rw16 = (u16*)(w + OFF_RW16);
  return p;
}

__global__ void __launch_bounds__(NTHR, 2) k_fused(KArgs ka) {
  extern __shared__ __attribute__((aligned(16))) char smem[];
  const Params p = make_params(ka);
  if (tidx() == 0) *reinterpret_cast<uint4*>(smem + SMEM_BAR_OFF) = make_uint4(0u, 0u, 0u, 0u);
  __syncthreads();
  XcdBarrier bar = xcd_barrier_post(p.bar, (volatile LAS unsigned*)(smem + SMEM_BAR_OFF));
  run_list(p, smem, bar, Program{});
}

extern "C" void kernel_launch(void* const* d_in, const int* in_sizes, int n_in, void* d_out, int out_size, void* d_ws, size_t ws_size, hipStream_t stream) {
  (void)in_sizes; (void)n_in; (void)out_size;
  if (ws_size < WS_NEEDED) return;
  KArgs ka{};
  for (int i = 0; i < 25; ++i) ka.in[i] = d_in[i];
  ka.out = (float*)d_out; ka.ws = (char*)d_ws;
  hipMemsetAsync(d_ws, 0, OFF_ZERO_END, stream);
  static int grid = 0;
  if (!grid) {
    int dev = 0, cus = 0, per_cu = 0;
    hipGetDevice(&dev);
    hipDeviceGetAttribute(&cus, hipDeviceAttributeMultiprocessorCount, dev);
    hipFuncSetAttribute((const void*)k_fused, hipFuncAttributeMaxDynamicSharedMemorySize, SMEM_BYTES);
    hipOccupancyMaxActiveBlocksPerMultiprocessor(&per_cu, (const void*)k_fused, NTHR, SMEM_BYTES);
    if (per_cu > 1) per_cu = 1;
    if (per_cu < 1) per_cu = 1;
    grid = cus * per_cu;
  }
  hipLaunchKernelGGL(k_fused, dim3(grid), dim3(NTHR), SMEM_BYTES, stream, ka);
}
```

```cpp
#include <hip/hip_runtime.h>
#include <hip/hip_bf16.h>
#include <stdint.h>
#include <math.h>
#include <utility>

typedef unsigned short u16;
using bf16x8 = __attribute__((ext_vector_type(8))) short;
using f32x4  = __attribute__((ext_vector_type(4))) float;

#define DEV __device__ __forceinline__
__device__ __forceinline__ int tidx() { int t = (int)__builtin_amdgcn_workitem_id_x(); asm volatile("" : "+v"(t)); return t; }

constexpr int T_ = 16384, S_ = 4096, D_ = 1024;
constexpr int LD0 = 2304, LD1 = 2560, NIN1 = 2608;
constexpr int NE = 256, TOPK = 8, NASG = T_ * TOPK, NROWS = NASG + T_;
constexpr float ALPHA = 1.41421356237309515f;
constexpr float LN_EPS = 1e-5f;
constexpr int NTHR = 512, NWAVE = 8;


struct Params {
  const float* x; const int* pos;
  const float* even_w_in; const float* even_sinks; const float* even_w_out; const float* odd_w_in;
  const float* cmpk_pos; const float* cmpk_w1; const float* cmpk_w2; const float* cmpv_pos; const float* cmpv_w1; const float* cmpv_w2;
  const float* odd_w_out; const float* mix_g; const float* mix_b; const float* router_w; const float* router_b;
  const float* w_gate; const float* w_up; const float* w_down; const float* sh_gate; const float* sh_up; const float* sh_down;
  const float* ffn_g; const float* ffn_b;
  float* out;
  unsigned* bar; int* cnt; float* pb; float* cs; u16* xb; u16* qkv; float* gates; u16* ao; float* hpre;
  u16* x1b; u16* x1lo; float* logits; int* eidx; float* gatev; int* epos; int* etok;
  u16* hbuf; u16* ybuf; float* x2f; u16* hid; u16* cmpkv; unsigned long long* selmask;
  u16* w16_in0; u16* w16_out0; u16* w16_in1; u16* w16_out1; u16* rw16;
};

#define XB_TMO      128
#define XB_XCNT(j)  (256  + 64 * (j))
#define XB_XSUB(j)  (1280 + 64 * (j))
#define XB_XGEN(j)  (2304 + 64 * (j))
#define XB_TOP      3328
#define XB_TOPGEN   3392
#define XCD_BAR_WORDS 3456
#define XB_SPIN_CAP (1u << 18)
#define LAS __attribute__((address_space(3)))

__device__ __forceinline__ unsigned xb_ld(unsigned* p)              { return __hip_atomic_load(p, __ATOMIC_RELAXED, __HIP_MEMORY_SCOPE_AGENT); }
__device__ __forceinline__ unsigned xb_add(unsigned* p, unsigned v) { return __hip_atomic_fetch_add(p, v, __ATOMIC_RELAXED, __HIP_MEMORY_SCOPE_AGENT); }
__device__ __forceinline__ unsigned xb_xcc_id() { return (unsigned)__builtin_amdgcn_s_getreg((3 << 11) | 20) & 0xFu; }
#define XB_SPIN(cond, bar) do { unsigned _sp = 0; while (cond) { __builtin_amdgcn_s_sleep(1); \
    if ((++_sp & 255u) == 0u) { if (xb_ld(&(bar)[XB_TMO])) break; if (_sp > XB_SPIN_CAP) { atomicAdd(&(bar)[XB_TMO], 1u); break; } } } } while (0)

struct XcdBarrier {
    unsigned* bar; unsigned x;
    volatile LAS unsigned* st;
};

__device__ __forceinline__ XcdBarrier xcd_barrier_post(unsigned* bar, volatile LAS unsigned* st) {
    XcdBarrier b; b.bar = bar; b.x = xb_xcc_id(); b.st = st;
    if (tidx() == 0) (void)xb_add(&bar[XB_XCNT(b.x)], 1u);
    return b;
}
__device__ __forceinline__ void xcd_barrier_complete(unsigned* bar, unsigned x, unsigned& nloc, unsigned& nx) {
    const unsigned G = gridDim.x * gridDim.y * gridDim.z;
    unsigned sum, cnt, mine, sp = 0u;
    for (;;) {
        sum = 0u; cnt = 0u; mine = 0u;
#pragma unroll
        for (unsigned j = 0; j < 16; ++j) { const unsigned c = xb_ld(&bar[XB_XCNT(j)]); sum += c; cnt += (c > 0u) ? 1u : 0u; mine = (j == x) ? c : mine; }
        if (sum == G) break;
        __builtin_amdgcn_s_sleep(1);
        if ((++sp & 255u) == 0u) { if (xb_ld(&bar[XB_TMO])) break; if (sp > XB_SPIN_CAP) { atomicAdd(&bar[XB_TMO], 1u); break; } }
    }
    nloc = mine > 0u ? mine : 1u; nx = cnt > 0u ? cnt : 1u;
}

__device__ __forceinline__ void xcd_barrier(const XcdBarrier& b) {
    asm volatile("s_waitcnt vmcnt(0)" ::: "memory");
    __syncthreads();
    if (tidx() == 0) {
        unsigned* bar = b.bar;
        __builtin_amdgcn_s_waitcnt(0);
        unsigned nloc = b.st[0], nx = b.st[1];
        if (nloc == 0u) { xcd_barrier_complete(bar, b.x, nloc, nx); b.st[0] = nloc; b.st[1] = nx; }
        const unsigned old = xb_add(&bar[XB_XSUB(b.x)], 1u);
        const unsigned gen = old / nloc;
        if (old + 1u == (gen + 1u) * nloc) {
            __builtin_amdgcn_fence(__ATOMIC_RELEASE, "agent");
            asm volatile("s_waitcnt vmcnt(0)" ::: "memory");
            const unsigned og = xb_add(&bar[XB_TOP], 1u);
            const unsigned tg = og / nx;
            if (og + 1u == (tg + 1u) * nx) xb_add(&bar[XB_TOPGEN], 1u);
            else XB_SPIN(xb_ld(&bar[XB_TOPGEN]) == tg, bar);
            __builtin_amdgcn_fence(__ATOMIC_ACQUIRE, "agent");
            xb_add(&bar[XB_XGEN(b.x)], 1u);
            asm volatile("s_waitcnt vmcnt(0)" ::: "memory");
        } else {
            XB_SPIN(xb_ld(&bar[XB_XGEN(b.x)]) == gen, bar);
            __builtin_amdgcn_fence(__ATOMIC_ACQUIRE, "agent");
            asm volatile("s_waitcnt vmcnt(0)" ::: "memory");
        }
    }
    __syncthreads();
}


DEV float bf2f(u16 h) { return __uint_as_float(((unsigned)h) << 16); }
DEV float bflo(unsigned w) { return __uint_as_float(w << 16); }
DEV float bfhi(unsigned w) { return __uint_as_float(w & 0xffff0000u); }
DEV float wave_max(float v) { for (int o = 32; o; o >>= 1) v = fmaxf(v, __shfl_xor(v, o)); return v; }
DEV float wave_sum(float v) { for (int o = 32; o; o >>= 1) v += __shfl_xor(v, o); return v; }
#define WAVE_SYNC() asm volatile("s_waitcnt lgkmcnt(0)" ::: "memory")

typedef short v4i16_t __attribute__((ext_vector_type(4)));
typedef float f32x2_t __attribute__((ext_vector_type(2)));
typedef __bf16 bf16x2_t __attribute__((ext_vector_type(2)));
typedef unsigned u32x4_t __attribute__((ext_vector_type(4)));
typedef unsigned u32x2_t __attribute__((ext_vector_type(2)));
typedef float f32x4_t __attribute__((ext_vector_type(4)));
DEV unsigned cvtpk(float lo, float hi) { f32x2_t v = {lo, hi}; bf16x2_t b = __builtin_convertvector(v, bf16x2_t); return __builtin_bit_cast(unsigned, b); }
DEV v4i16_t lds_tr(const u16* ptr) { return __builtin_amdgcn_ds_read_tr16_b64_v4i16((LAS v4i16_t*)ptr); }

struct GemmSmem { u16 A[2][320][72]; u16 B[2][64][128]; };
DEV int bswz(int k) { return (k & 3) | (((k >> 3) & 1) << 2); }

template <int MI, bool SPLIT, bool B16 = false, class FA, class FB, class FL, class FE>
DEV void gemm_core(GemmSmem& sm, int nk, FA a_addr, FB b_addr, int ldb, FL b_lo, FE epi, bool b_ok = true) {
  const int tid = tidx(), lane = tid & 63, wid = tid >> 6;
  const int wr = wid >> 1, wc = wid & 1, fr = lane & 15, fq = lane >> 4;
  const int n4 = tid & 31, kq = tid >> 5, q4 = (lane & 15) >> 2, p4 = lane & 3;
  f32x4 acc[MI][4];
#pragma unroll
  for (int mi = 0; mi < MI; ++mi)
#pragma unroll
    for (int ni = 0; ni < 4; ++ni) acc[mi][ni] = f32x4{0.f, 0.f, 0.f, 0.f};
  constexpr int NSET = (MI <= 4) ? 2 : 1;
  u32x4_t ra[NSET][MI]; f32x4_t rb[2][4]; u32x4_t rh[2][2];
  auto gloadA = [&](auto PC, int kt) {
    constexpr int P = decltype(PC)::value;
#pragma unroll
    for (int i = 0; i < MI; ++i) ra[P][i] = *reinterpret_cast<const u32x4_t*>(a_addr(i, kt));
  };
  auto gloadB = [&](auto PC, int kt) {
    constexpr int P = decltype(PC)::value;
    if constexpr (B16) {
      const u16* bp = b_addr(kt);
      rh[P][0] = *reinterpret_cast<const u32x4_t*>(bp);
      rh[P][1] = *reinterpret_cast<const u32x4_t*>(bp + (size_t)32 * ldb);
    } else {
      const float* bp = b_addr(kt);
#pragma unroll
      for (int i = 0; i < 4; ++i) rb[P][i] = *reinterpret_cast<const f32x4_t*>(bp + (size_t)(16 * i) * ldb);
    }
  };
  auto gload = [&](auto PC, int kt) { gloadA(PC, kt); gloadB(PC, kt); };
  auto sstore3 = [&](auto AC, auto PC, auto BC, int kt) {
    constexpr int AS = decltype(AC)::value;
    constexpr int P = decltype(PC)::value;
    constexpr int Bf = decltype(BC)::value;
#pragma unroll
    for (int i = 0; i < MI; ++i) *reinterpret_cast<u32x4_t*>(&sm.A[Bf][(tid >> 3) + 64 * i][(tid & 7) * 8]) = ra[AS][i];
    if constexpr (B16) {
#pragma unroll
      for (int i = 0; i < 2; ++i) {
        u32x4_t w = rh[P][i];
        if (!b_ok) w = u32x4_t{0u, 0u, 0u, 0u};
        const int k = (tid >> 4) + 32 * i, n8 = tid & 15;
        *reinterpret_cast<u32x4_t*>(&sm.B[Bf][k][(((n8 >> 1) ^ bswz(k)) << 4) + (n8 & 1) * 8]) = w;
      }
      return;
    }
    const bool lo = SPLIT ? b_lo(kt) : false;
#pragma unroll
    for (int i = 0; i < 4; ++i) {
      f32x4_t v = rb[P][i];
      if (!b_ok) v = f32x4_t{0.f, 0.f, 0.f, 0.f};
      if (SPLIT && lo) {
        const unsigned h0 = cvtpk(v[0], v[1]), h1 = cvtpk(v[2], v[3]);
        v[0] -= __uint_as_float(h0 << 16); v[1] -= __uint_as_float(h0 & 0xffff0000u); v[2] -= __uint_as_float(h1 << 16); v[3] -= __uint_as_float(h1 & 0xffff0000u);
      }
      u32x2_t w; w[0] = cvtpk(v[0], v[1]); w[1] = cvtpk(v[2], v[3]);
      const int k = kq + 16 * i;
      *reinterpret_cast<u32x2_t*>(&sm.B[Bf][k][(((n4 >> 2) ^ bswz(k)) << 4) + (n4 & 3) * 4]) = w;
    }
  };
  auto sstore = [&](auto PC, auto BC, int kt) { sstore3(PC, PC, BC, kt); };
  auto compute = [&](auto PC) {
    constexpr int P = decltype(PC)::value;
#pragma unroll
    for (int ks = 0; ks < 2; ++ks) {
      bf16x8 bf[4];
#pragma unroll
      for (int ni = 0; ni < 4; ++ni) {
        const int k0 = 32 * ks + 8 * fq + q4, col = (((wc * 4 + ni) ^ bswz(k0)) << 4) + 4 * p4;
        const v4i16_t lo = lds_tr(&sm.B[P][k0][col]);
        const v4i16_t hh = lds_tr(&sm.B[P][k0 + 4][col]);
        bf[ni] = bf16x8{lo[0], lo[1], lo[2], lo[3], hh[0], hh[1], hh[2], hh[3]};
      }
      constexpr int G0 = (MI > 4) ? 3 : MI;
      {
        bf16x8 af[G0];
#pragma unroll
        for (int mi = 0; mi < G0; ++mi) af[mi] = *reinterpret_cast<const bf16x8*>(&sm.A[P][wr * 16 * MI + mi * 16 + fr][32 * ks + fq * 8]);
#pragma unroll
        for (int mi = 0; mi < G0; ++mi)
#pragma unroll
          for (int ni = 0; ni < 4; ++ni) acc[mi][ni] = __builtin_amdgcn_mfma_f32_16x16x32_bf16(bf[ni], af[mi], acc[mi][ni], 0, 0, 0);
      }
      if constexpr (MI > G0) {
        __builtin_amdgcn_sched_barrier(0);
        bf16x8 af[MI - G0];
#pragma unroll
        for (int mi = G0; mi < MI; ++mi) af[mi - G0] = *reinterpret_cast<const bf16x8*>(&sm.A[P][wr * 16 * MI + mi * 16 + fr][32 * ks + fq * 8]);
#pragma unroll
        for (int mi = G0; mi < MI; ++mi)
#pragma unroll
          for (int ni = 0; ni < 4; ++ni) acc[mi][ni] = __builtin_amdgcn_mfma_f32_16x16x32_bf16(bf[ni], af[mi - G0], acc[mi][ni], 0, 0, 0);
      }
      __builtin_amdgcn_sched_barrier(0);
    }
  };
  using C0 = std::integral_constant<int, 0>; using C1 = std::integral_constant<int, 1>;
  int kt = 0;
  if constexpr (MI <= 4) {
    gload(C0{}, 0);
    sstore(C0{}, C0{}, 0);
    gload(C1{}, 1);
    __syncthreads();
    for (; kt + 2 < nk; kt += 2) {
      gload(C0{}, kt + 2); compute(C0{}); sstore(C1{}, C1{}, kt + 1); __syncthreads();
      gload(C1{}, kt + 3); compute(C1{}); sstore(C0{}, C0{}, kt + 2); __syncthreads();
    }
    compute(C0{}); sstore(C1{}, C1{}, kt + 1); __syncthreads();
    compute(C1{}); __syncthreads();
  } else {
    gloadA(C0{}, 0); gloadB(C0{}, 0);
    sstore3(C0{}, C0{}, C0{}, 0);
    gloadB(C1{}, 1);
    __syncthreads();
    for (; kt + 2 < nk; kt += 2) {
      gloadA(C0{}, kt + 1); gloadB(C0{}, kt + 2); compute(C0{}); sstore3(C0{}, C1{}, C1{}, kt + 1); __syncthreads();
      gloadA(C0{}, kt + 2); gloadB(C1{}, kt + 3); compute(C1{}); sstore3(C0{}, C0{}, C0{}, kt + 2); __syncthreads();
    }
    gloadA(C0{}, kt + 1); compute(C0{}); sstore3(C0{}, C1{}, C1{}, kt + 1); __syncthreads();
    compute(C1{}); __syncthreads();
  }
  epi(acc);
}

struct ItemRange { int i, hi, step; };
DEV ItemRange xcd_items(int I) {
  ItemRange r;
  if (gridDim.x & 7) { r.i = blockIdx.x; r.hi = I; r.step = gridDim.x; }
  else { const int x = blockIdx.x & 7; r.i = (int)((long)I * x / 8) + (blockIdx.x >> 3); r.hi = (int)((long)I * (x + 1) / 8); r.step = gridDim.x >> 3; }
  return r;
}
template <int GM, int GN> DEV void dense_item(int i, int MT, int& mt, int& nt) {
  const int g = i / (GM * GN), w = i % (GM * GN), gpm = MT / GM;
  mt = (g % gpm) * GM + w / GN; nt = (g / gpm) * GN + w % GN;
}
DEV float4 ld4(const float* ptr) { return *reinterpret_cast<const float4*>(ptr); }
DEV void st_bf4(u16* ptr, float a, float b, float c, float d) { uint2 w; w.x = cvtpk(a, b); w.y = cvtpk(c, d); *reinterpret_cast<uint2*>(ptr) = w; }

__constant__ float INVF[8] = {1.0f, 0.1939227432012558f, 0.03760603070259094f, 0.007292664609849453f, 0.0014142135623842478f,
                              0.00027424818836152554f, 5.3182957344688475e-05f, 1.0313385246263351e-05f};
DEV void ph_prologue(const Params& p) {
  const size_t gtid = (size_t)blockIdx.x * NTHR + tidx(), gsz = (size_t)gridDim.x * NTHR;
  for (size_t i = gtid; i < (size_t)T_ * D_ / 8; i += gsz) {
    const float4 a = reinterpret_cast<const float4*>(p.x)[2 * i], b = reinterpret_cast<const float4*>(p.x)[2 * i + 1];
    uint4 w; w.x = cvtpk(a.x, a.y); w.y = cvtpk(a.z, a.w); w.z = cvtpk(b.x, b.y); w.w = cvtpk(b.z, b.w);
    reinterpret_cast<uint4*>(p.xb)[i] = w;
  }
  for (size_t i = gtid; i < (size_t)T_ * 8; i += gsz) {
    const int t = (int)(i >> 3), f = (int)(i & 7);
    const float ang = (float)p.pos[t] * INVF[f];
    p.cs[t * 16 + f] = cosf(ang); p.cs[t * 16 + 8 + f] = sinf(ang);
  }
  auto cvt_w = [&](const float* src, u16* dst, size_t n4) {
    for (size_t i = gtid; i < n4; i += gsz) {
      const float4 a = reinterpret_cast<const float4*>(src)[i];
      uint2 w; w.x = cvtpk(a.x, a.y); w.y = cvtpk(a.z, a.w);
      reinterpret_cast<uint2*>(dst)[i] = w;
    }
  };
  cvt_w(p.even_w_in, p.w16_in0, (size_t)D_ * LD0 / 4);
  cvt_w(p.even_w_out, p.w16_out0, (size_t)D_ * D_ / 4);
  cvt_w(p.odd_w_in, p.w16_in1, (size_t)D_ * NIN1 / 4);
  cvt_w(p.odd_w_out, p.w16_out1, (size_t)D_ * D_ / 4);
  for (size_t i = gtid; i < (size_t)2 * D_ * NE / 4; i += gsz) {
    const size_t L = i / ((size_t)D_ * NE / 4), r = i - L * ((size_t)D_ * NE / 4);
    const float4 a = reinterpret_cast<const float4*>(p.router_w)[i];
    const unsigned h0 = cvtpk(a.x, a.y), h1 = cvtpk(a.z, a.w);
    uint2 hi; hi.x = h0; hi.y = h1;
    uint2 lo; lo.x = cvtpk(a.x - __uint_as_float(h0 << 16), a.y - __uint_as_float(h0 & 0xffff0000u)); lo.y = cvtpk(a.z - __uint_as_float(h1 << 16), a.w - __uint_as_float(h1 & 0xffff0000u));
    reinterpret_cast<uint2*>(p.rw16 + (L * 2 + 0) * (size_t)D_ * NE)[r] = hi;
    reinterpret_cast<uint2*>(p.rw16 + (L * 2 + 1) * (size_t)D_ * NE)[r] = lo;
  }
  for (size_t i = gtid; i < 2 * 128 * 16; i += gsz) {
    const int n = (int)(i & 127), kc = (int)((i >> 7) & 15), ts = (int)(i >> 11);
    const float* pe = ts ? p.cmpv_pos : p.cmpk_pos; const float* w1 = ts ? p.cmpv_w1 : p.cmpk_w1;
    float s = 0.f;
    for (int k = kc * 128; k < kc * 128 + 128; ++k) s += pe[k] * w1[(size_t)k * 128 + n];
    atomicAdd(&p.pb[ts * 128 + n], s);
  }
}

DEV void ph_inproj0(const Params& p, GemmSmem& sm) {
  const int tid = tidx(), lane = tid & 63, wid = tid >> 6, wr = wid >> 1, wc = wid & 1, fr = lane & 15, fq = lane >> 4;
  constexpr int NT = LD0 / 128;
  for (ItemRange it = xcd_items(64 * NT); it.i < it.hi; it.i += it.step) {
    int mt, nt; dense_item<16, 2>(it.i, 64, mt, nt);
    const int m0 = mt * 256, n0 = nt * 128;
    const u16* ar0 = p.xb + (size_t)(m0 + (tid >> 3)) * D_ + (tid & 7) * 8;
    auto a_addr = [&](int i, int kt) { return ar0 + (size_t)i * 64 * D_ + kt * 64; };
    const u16* bb = p.w16_in0 + (size_t)(tid >> 4) * LD0 + n0 + 8 * (tid & 15);
    auto b_addr = [&](int kt) { return bb + (size_t)kt * 64 * LD0; };
    auto b_lo = [&](int) { return false; };
    auto epi = [&](f32x4 (&acc)[4][4]) {
#pragma unroll
      for (int mi = 0; mi < 4; ++mi) {
        const int row = m0 + wr * 64 + mi * 16 + fr;
#pragma unroll
        for (int ni = 0; ni < 4; ++ni) {
          f32x4 v = acc[mi][ni];
          const int col = n0 + wc * 64 + ni * 16 + fq * 4;
          const bool rope = (ni == 0) && (col < 1024 || (col >= 1536 && col < 2176));
          if (rope) {
            const float4 c_ = ld4(p.cs + row * 16 + 4 * (fq & 1)), s_ = ld4(p.cs + row * 16 + 8 + 4 * (fq & 1));
            const float p0 = __shfl_xor(v[0], 32), p1 = __shfl_xor(v[1], 32), p2 = __shfl_xor(v[2], 32), p3 = __shfl_xor(v[3], 32);
            const float sg = fq < 2 ? -1.f : 1.f;
            v[0] = v[0] * c_.x + sg * p0 * s_.x; v[1] = v[1] * c_.y + sg * p1 * s_.y; v[2] = v[2] * c_.z + sg * p2 * s_.z; v[3] = v[3] * c_.w + sg * p3 * s_.w;
          }
          st_bf4(p.qkv + (size_t)row * LD0 + col, v[0], v[1], v[2], v[3]);
        }
      }
    };
    gemm_core<4, false, true>(sm, 16, a_addr, b_addr, LD0, b_lo, epi);
  }
}

DEV void ph_outproj(const Params& p, GemmSmem& sm, const u16* W16, const float* resid) {
  const int tid = tidx(), lane = tid & 63, wid = tid >> 6, wr = wid >> 1, wc = wid & 1, fr = lane & 15, fq = lane >> 4;
  for (ItemRange it = xcd_items(64 * 8); it.i < it.hi; it.i += it.step) {
    int mt, nt; dense_item<8, 4>(it.i, 64, mt, nt);
    const int m0 = mt * 256, n0 = nt * 128;
    const u16* ar0 = p.ao + (size_t)(m0 + (tid >> 3)) * D_ + (tid & 7) * 8;
    auto a_addr = [&](int i, int kt) { return ar0 + (size_t)i * 64 * D_ + kt * 64; };
    const u16* bb = W16 + (size_t)(tid >> 4) * D_ + n0 + 8 * (tid & 15);
    auto b_addr = [&](int kt) { return bb + (size_t)kt * 64 * D_; };
    auto b_lo = [&](int) { return false; };
    auto epi = [&](f32x4 (&acc)[4][4]) {
#pragma unroll
      for (int mi = 0; mi < 4; ++mi)
#pragma unroll
        for (int ni = 0; ni < 4; ++ni) {
          const size_t idx = (size_t)(m0 + wr * 64 + mi * 16 + fr) * D_ + n0 + wc * 64 + ni * 16 + fq * 4;
          const float4 r = ld4(resid + idx);
          float4 o; o.x = ALPHA * r.x + acc[mi][ni][0]; o.y = ALPHA * r.y + acc[mi][ni][1]; o.z = ALPHA * r.z + acc[mi][ni][2]; o.w = ALPHA * r.w + acc[mi][ni][3];
          *reinterpret_cast<float4*>(p.hpre + idx) = o;
        }
    };
    gemm_core<4, false, true>(sm, 16, a_addr, b_addr, D_, b_lo, epi);
  }
}

DEV void ph_ln_mix(const Params& p, const float* g, const float* bt) {
  const int lane = tidx() & 63, gw = blockIdx.x * NWAVE + (tidx() >> 6), nw = gridDim.x * NWAVE;
  for (int tok = gw; tok < T_; tok += nw) {
    float v[2][8]; float s = 0.f;
#pragma unroll
    for (int i = 0; i < 2; ++i)
#pragma unroll
      for (int h = 0; h < 2; ++h) {
        const float4 a = ld4(p.hpre + (size_t)tok * D_ + (i * 64 + lane) * 8 + 4 * h);
        v[i][4 * h] = a.x; v[i][4 * h + 1] = a.y; v[i][4 * h + 2] = a.z; v[i][4 * h + 3] = a.w;
        s += a.x + a.y + a.z + a.w;
      }
    const float mu = wave_sum(s) * (1.f / D_);
    float ss = 0.f;
#pragma unroll
    for (int i = 0; i < 2; ++i)
#pragma unroll
      for (int c = 0; c < 8; ++c) { v[i][c] -= mu; ss += v[i][c] * v[i][c]; }
    const float rstd = rsqrtf(wave_sum(ss) * (1.f / D_) + LN_EPS);
#pragma unroll
    for (int i = 0; i < 2; ++i) {
      const int c0 = (i * 64 + lane) * 8;
      float y[8];
#pragma unroll
      for (int h = 0; h < 2; ++h) {
        const float4 gg = ld4(g + c0 + 4 * h), bb = ld4(bt + c0 + 4 * h);
        y[4 * h] = v[i][4 * h] * rstd * gg.x + bb.x; y[4 * h + 1] = v[i][4 * h + 1] * rstd * gg.y + bb.y;
        y[4 * h + 2] = v[i][4 * h + 2] * rstd * gg.z + bb.z; y[4 * h + 3] = v[i][4 * h + 3] * rstd * gg.w + bb.w;
      }
      u32x4_t hi, lo;
#pragma unroll
      for (int c = 0; c < 4; ++c) {
        const unsigned hw = cvtpk(y[2 * c], y[2 * c + 1]);
        hi[c] = hw;
        lo[c] = cvtpk(y[2 * c] - __uint_as_float(hw << 16), y[2 * c + 1] - __uint_as_float(hw & 0xffff0000u));
      }
      *reinterpret_cast<u32x4_t*>(p.x1b + (size_t)tok * D_ + c0) = hi;
      *reinterpret_cast<u32x4_t*>(p.x1lo + (size_t)tok * D_ + c0) = lo;
    }
  }
}

struct RouterSmem { u16 A[2][256][72]; u16 B[2][2][64][128]; };
DEV void ph_router_gemm(const Params& p, char* smem, const u16* RW16) {
  RouterSmem& sm = *reinterpret_cast<RouterSmem*>(smem);
  const int tid = tidx(), lane = tid & 63, wid = tid >> 6, wr = wid >> 1, wc = wid & 1, fr = lane & 15, fq = lane >> 4;
  const int q4 = (lane & 15) >> 2, p4 = lane & 3;
  for (ItemRange it = xcd_items(128 * 2); it.i < it.hi; it.i += it.step) {
    const int nt = it.i & 1, mt = it.i >> 1, m0 = mt * 128, n0 = nt * 128;
    const size_t ao0 = (size_t)(m0 + (tid >> 3)) * D_ + (tid & 7) * 8;
    const u16* bb = RW16 + (size_t)(tid >> 4) * NE + n0 + 8 * (tid & 15);
    f32x4 acc[2][4];
#pragma unroll
    for (int mi = 0; mi < 2; ++mi)
#pragma unroll
      for (int ni = 0; ni < 4; ++ni) acc[mi][ni] = f32x4{0.f, 0.f, 0.f, 0.f};
    u32x4_t ra[2][4], rb[2][4];
    auto gload = [&](auto PC, int kt) {
      constexpr int P = decltype(PC)::value;
      ra[P][0] = *reinterpret_cast<const u32x4_t*>(p.x1b + ao0 + kt * 64);
      ra[P][1] = *reinterpret_cast<const u32x4_t*>(p.x1b + ao0 + (size_t)64 * D_ + kt * 64);
      ra[P][2] = *reinterpret_cast<const u32x4_t*>(p.x1lo + ao0 + kt * 64);
      ra[P][3] = *reinterpret_cast<const u32x4_t*>(p.x1lo + ao0 + (size_t)64 * D_ + kt * 64);
      const u16* bp = bb + (size_t)kt * 64 * NE;
      rb[P][0] = *reinterpret_cast<const u32x4_t*>(bp);
      rb[P][1] = *reinterpret_cast<const u32x4_t*>(bp + (size_t)32 * NE);
      rb[P][2] = *reinterpret_cast<const u32x4_t*>(bp + (size_t)D_ * NE);
      rb[P][3] = *reinterpret_cast<const u32x4_t*>(bp + (size_t)D_ * NE + (size_t)32 * NE);
    };
    auto sstore = [&](auto PC) {
      constexpr int P = decltype(PC)::value;
#pragma unroll
      for (int i = 0; i < 4; ++i) *reinterpret_cast<u32x4_t*>(&sm.A[P][(tid >> 3) + 64 * i][(tid & 7) * 8]) = ra[P][i];
#pragma unroll
      for (int i = 0; i < 4; ++i) {
        const int k = (tid >> 4) + 32 * (i & 1), n8 = tid & 15;
        *reinterpret_cast<u32x4_t*>(&sm.B[P][i >> 1][k][(((n8 >> 1) ^ bswz(k)) << 4) + (n8 & 1) * 8]) = rb[P][i];
      }
    };
    auto compute = [&](auto PC) {
      constexpr int P = decltype(PC)::value;
#pragma unroll
      for (int ks = 0; ks < 2; ++ks) {
        bf16x8 ah[2], al[2], bh[4], bl[4];
#pragma unroll
        for (int mi = 0; mi < 2; ++mi) {
          ah[mi] = *reinterpret_cast<const bf16x8*>(&sm.A[P][wr * 32 + mi * 16 + fr][32 * ks + fq * 8]);
          al[mi] = *reinterpret_cast<const bf16x8*>(&sm.A[P][128 + wr * 32 + mi * 16 + fr][32 * ks + fq * 8]);
        }
#pragma unroll
        for (int ni = 0; ni < 4; ++ni) {
          const int k0 = 32 * ks + 8 * fq + q4, col = (((wc * 4 + ni) ^ bswz(k0)) << 4) + 4 * p4;
          { const v4i16_t lo = lds_tr(&sm.B[P][0][k0][col]), hh = lds_tr(&sm.B[P][0][k0 + 4][col]); bh[ni] = bf16x8{lo[0], lo[1], lo[2], lo[3], hh[0], hh[1], hh[2], hh[3]}; }
          { const v4i16_t lo = lds_tr(&sm.B[P][1][k0][col]), hh = lds_tr(&sm.B[P][1][k0 + 4][col]); bl[ni] = bf16x8{lo[0], lo[1], lo[2], lo[3], hh[0], hh[1], hh[2], hh[3]}; }
        }
#pragma unroll
        for (int mi = 0; mi < 2; ++mi)
#pragma unroll
          for (int ni = 0; ni < 4; ++ni) {
            acc[mi][ni] = __builtin_amdgcn_mfma_f32_16x16x32_bf16(bh[ni], ah[mi], acc[mi][ni], 0, 0, 0);
            acc[mi][ni] = __builtin_amdgcn_mfma_f32_16x16x32_bf16(bh[ni], al[mi], acc[mi][ni], 0, 0, 0);
            acc[mi][ni] = __builtin_amdgcn_mfma_f32_16x16x32_bf16(bl[ni], ah[mi], acc[mi][ni], 0, 0, 0);
          }
        __builtin_amdgcn_sched_barrier(0);
      }
    };
    using C0 = std::integral_constant<int, 0>; using C1 = std::integral_constant<int, 1>;
    gload(C0{}, 0); sstore(C0{}); gload(C1{}, 1); __syncthreads();
    int kt = 0;
    for (; kt + 2 < 16; kt += 2) {
      gload(C0{}, kt + 2); compute(C0{}); sstore(C1{}); __syncthreads();
      gload(C1{}, kt + 3); compute(C1{}); sstore(C0{}); __syncthreads();
    }
    compute(C0{}); sstore(C1{}); __syncthreads();
    compute(C1{}); __syncthreads();
#pragma unroll
    for (int mi = 0; mi < 2; ++mi)
#pragma unroll
      for (int ni = 0; ni < 4; ++ni) {
        float4 o; o.x = acc[mi][ni][0]; o.y = acc[mi][ni][1]; o.z = acc[mi][ni][2]; o.w = acc[mi][ni][3];
        *reinterpret_cast<float4*>(p.logits + (size_t)(m0 + wr * 32 + mi * 16 + fr) * NE + n0 + wc * 64 + ni * 16 + fq * 4) = o;
      }
  }
}

DEV void ph_route(const Params& p, const float* rbias, int* cnt, int* etok) {
  const int lane = tidx() & 63, gw = blockIdx.x * NWAVE + (tidx() >> 6), nw = gridDim.x * NWAVE;
  const int half = lane >> 5;
  for (int tok = gw; tok < T_; tok += nw) {
    float aff[4], val[4];
#pragma unroll
    for (int j = 0; j < 4; ++j) {
      const float lg = p.logits[(size_t)tok * NE + lane + 64 * j];
      aff[j] = 1.f / (1.f + expf(-lg));
      val[j] = aff[j] + rbias[lane + 64 * j];
    }
    float gs[8];
#pragma unroll
    for (int j = 0; j < 4; ++j) {
      float m1 = val[j];
#pragma unroll
      for (int o = 16; o; o >>= 1) m1 = fmaxf(m1, __shfl_xor(m1, o));
      const unsigned long long eq = __ballot(val[j] == m1);
      const int ceq = __popc((unsigned)(half ? (eq >> 32) : (eq & 0xffffffffull)));
      float m2 = (val[j] == m1) ? -INFINITY : val[j];
#pragma unroll
      for (int o = 16; o; o >>= 1) m2 = fmaxf(m2, __shfl_xor(m2, o));
      if (ceq >= 2) m2 = m1;
      const float mine = m1 + m2, other = __shfl_xor(mine, 32);
      gs[2 * j] = half ? other : mine; gs[2 * j + 1] = half ? mine : other;
    }
    bool gok[8];
#pragma unroll
    for (int g = 0; g < 8; ++g) {
      int rk = 0;
#pragma unroll
      for (int g2 = 0; g2 < 8; ++g2) rk += (gs[g2] > gs[g] || (gs[g2] == gs[g] && g2 < g)) ? 1 : 0;
      gok[g] = rk < 4;
    }
#pragma unroll
    for (int j = 0; j < 4; ++j) { const bool ok = half ? gok[2 * j + 1] : gok[2 * j]; if (!ok) val[j] = -INFINITY; }
    int my_e = 0; float my_a = 0.f, asum = 0.f;
#pragma unroll
    for (int k = 0; k < TOPK; ++k) {
      float bv = val[0]; int bi = lane;
#pragma unroll
      for (int j = 1; j < 4; ++j) if (val[j] > bv) { bv = val[j]; bi = lane + 64 * j; }
#pragma unroll
      for (int o = 32; o; o >>= 1) {
        const float ov = __shfl_xor(bv, o); const int oi = __shfl_xor(bi, o);
        if (ov > bv || (ov == bv && oi < bi)) { bv = ov; bi = oi; }
      }
      float a_sel = 0.f;
#pragma unroll
      for (int j = 0; j < 4; ++j) { const bool hit = (bi == lane + 64 * j); a_sel = hit ? aff[j] : a_sel; val[j] = hit ? -INFINITY : val[j]; }
      a_sel = wave_sum(a_sel);
      asum += a_sel;
      if (lane == k) { my_e = bi; my_a = a_sel; }
    }
    if (lane < TOPK) {
      const int ps = atomicAdd(&cnt[my_e], 1);
      p.eidx[tok * TOPK + lane] = my_e; p.epos[tok * TOPK + lane] = ps; p.gatev[tok * TOPK + lane] = my_a / asum * 2.5f;
      etok[(size_t)my_e * T_ + ps] = tok;
    }
  }
}

constexpr int MOE_TM = 320;
struct MoeTab { int cn[260]; int of[260]; int tf[260]; unsigned ao[2][5][NTHR]; };
DEV void moe_prep(MoeTab& mt, const int* cnt) {
  const int tid = tidx();
  if (tid < NE) mt.cn[tid] = cnt[tid];
  __syncthreads();
  if (tid == 0) {
    int a = 0, tl = 0;
    for (int e = 0; e < NE; ++e) { mt.of[e] = a; mt.tf[e] = tl; a += mt.cn[e]; tl += (mt.cn[e] + MOE_TM - 1) / MOE_TM; }
    mt.cn[NE] = T_; mt.of[NE] = NASG; mt.tf[NE] = tl; mt.of[NE + 1] = NASG + T_; mt.tf[NE + 1] = tl + (T_ + MOE_TM - 1) / MOE_TM;
  }
  __syncthreads();
}
DEV int moe_rows_per_tile(int cn, int tiles) { return (cn + tiles - 1) / tiles; }
struct MoeItem { int e, nt, r0, r1, of; };
template <int NPT> DEV MoeItem moe_item(const MoeTab& mt, int u) {
  int lo = 0, hi = NE;
  while (lo < hi) { const int mid = (lo + hi + 1) >> 1; if (NPT * mt.tf[mid] <= u) lo = mid; else hi = mid - 1; }
  MoeItem it; it.e = lo;
  const int tiles = mt.tf[lo + 1] - mt.tf[lo], local = u - NPT * mt.tf[lo], mtl = local / NPT, cn = mt.cn[lo];
  it.nt = local - mtl * NPT; it.of = mt.of[lo];
  const int per = moe_rows_per_tile(cn, tiles);
  it.r0 = mtl * per; it.r1 = (it.r0 + per < cn) ? it.r0 + per : cn;
  return it;
}

template <int NK, class FA, class FB, class FAN, class FBN, class FM, class FE>
DEV void moe_gemm5(GemmSmem& sm, u32x4_t (&ra)[5], f32x4_t (&rb)[2][4], FA a_addr, FB b_addr, FAN a_next, FBN b_next, int ldb, FM mid, FE epi) {
  constexpr int MI = 5;
  const int tid = tidx(), lane = tid & 63, wid = tid >> 6;
  const int wr = wid >> 1, wc = wid & 1, fr = lane & 15, fq = lane >> 4;
  const int n4 = tid & 31, kq = tid >> 5, q4 = (lane & 15) >> 2, p4 = lane & 3;
  f32x4 acc[MI][4];
#pragma unroll
  for (int mi = 0; mi < MI; ++mi)
#pragma unroll
    for (int ni = 0; ni < 4; ++ni) acc[mi][ni] = f32x4{0.f, 0.f, 0.f, 0.f};
  auto gloadA = [&](auto& fa, int kt) {
#pragma unroll
    for (int i = 0; i < MI; ++i) ra[i] = *reinterpret_cast<const u32x4_t*>(fa(i, kt));
  };
  auto gloadB = [&](auto PC, auto& fb, int kt) {
    constexpr int P = decltype(PC)::value;
    const float* bp = fb(kt);
#pragma unroll
    for (int i = 0; i < 4; ++i) rb[P][i] = *reinterpret_cast<const f32x4_t*>(bp + (size_t)(16 * i) * ldb);
  };
  auto sstore = [&](auto PC, auto BC) {
    constexpr int P = decltype(PC)::value;
    constexpr int Bf = decltype(BC)::value;
#pragma unroll
    for (int i = 0; i < MI; ++i) *reinterpret_cast<u32x4_t*>(&sm.A[Bf][(tid >> 3) + 64 * i][(tid & 7) * 8]) = ra[i];
#pragma unroll
    for (int i = 0; i < 4; ++i) {
      const f32x4_t v = rb[P][i];
      u32x2_t w; w[0] = cvtpk(v[0], v[1]); w[1] = cvtpk(v[2], v[3]);
      const int k = kq + 16 * i;
      *reinterpret_cast<u32x2_t*>(&sm.B[Bf][k][(((n4 >> 2) ^ bswz(k)) << 4) + (n4 & 3) * 4]) = w;
    }
  };
  auto compute = [&](auto BC) {
    constexpr int P = decltype(BC)::value;
#pragma unroll
    for (int ks = 0; ks < 2; ++ks) {
      bf16x8 bf[4];
#pragma unroll
      for (int ni = 0; ni < 4; ++ni) {
        const int k0 = 32 * ks + 8 * fq + q4, col = (((wc * 4 + ni) ^ bswz(k0)) << 4) + 4 * p4;
        const v4i16_t lo = lds_tr(&sm.B[P][k0][col]);
        const v4i16_t hh = lds_tr(&sm.B[P][k0 + 4][col]);
        bf[ni] = bf16x8{lo[0], lo[1], lo[2], lo[3], hh[0], hh[1], hh[2], hh[3]};
      }
      {
        bf16x8 af[3];
#pragma unroll
        for (int mi = 0; mi < 3; ++mi) af[mi] = *reinterpret_cast<const bf16x8*>(&sm.A[P][wr * 80 + mi * 16 + fr][32 * ks + fq * 8]);
#pragma unroll
        for (int mi = 0; mi < 3; ++mi)
#pragma unroll
          for (int ni = 0; ni < 4; ++ni) acc[mi][ni] = __builtin_amdgcn_mfma_f32_16x16x32_bf16(bf[ni], af[mi], acc[mi][ni], 0, 0, 0);
      }
      __builtin_amdgcn_sched_barrier(0);
      {
        bf16x8 af[2];
#pragma unroll
        for (int mi = 3; mi < 5; ++mi) af[mi - 3] = *reinterpret_cast<const bf16x8*>(&sm.A[P][wr * 80 + mi * 16 + fr][32 * ks + fq * 8]);
#pragma unroll
        for (int mi = 3; mi < 5; ++mi)
#pragma unroll
          for (int ni = 0; ni < 4; ++ni) acc[mi][ni] = __builtin_amdgcn_mfma_f32_16x16x32_bf16(bf[ni], af[mi - 3], acc[mi][ni], 0, 0, 0);
      }
      __builtin_amdgcn_sched_barrier(0);
    }
  };
  using C0 = std::integral_constant<int, 0>; using C1 = std::integral_constant<int, 1>;
  sstore(C0{}, C0{}); __syncthreads();
#pragma unroll 1
  for (int kt = 0; kt + 2 < NK; kt += 2) {
    gloadA(a_addr, kt + 1); gloadB(C0{}, b_addr, kt + 2); if (kt == 0) mid(); compute(C0{}); sstore(C1{}, C1{}); __syncthreads();
    gloadA(a_addr, kt + 2); gloadB(C1{}, b_addr, kt + 3); compute(C1{}); sstore(C0{}, C0{}); __syncthreads();
  }
  gloadA(a_addr, NK - 1); gloadB(C0{}, b_next, 0); compute(C0{}); sstore(C1{}, C1{}); __syncthreads();
  gloadA(a_next, 0); gloadB(C1{}, b_next, 1);
  compute(C1{});
  epi(acc);
}


constexpr int TS_LD = 136;
DEV void ts_put(u16* T, int row, int col, float a, float b, float c, float d) { uint2 w; w.x = cvtpk(a, b); w.y = cvtpk(c, d); *reinterpret_cast<uint2*>(T + row * TS_LD + col) = w; }
template <int NCH, class FD> DEV void ts_flush(const u16* T, int rows, FD dst) {
  __syncthreads();
  for (int c = tidx(); c < rows * NCH; c += NTHR) {
    const int row = c / NCH, ch = c - row * NCH;
    u16* d = dst(row);
    if (d) *reinterpret_cast<u32x4_t*>(d + ch * 8) = *reinterpret_cast<const u32x4_t*>(T + row * TS_LD + ch * 8);
  }
  __syncthreads();
}

DEV void ph_moe1(const Params& p, GemmSmem& sm, MoeTab& mt, int layer, const int* cnt) {
  const int tid = tidx(), lane = tid & 63, wid = tid >> 6, wr = wid >> 1, wc = wid & 1, fr = lane & 15, fq = lane >> 4;
  moe_prep(mt, cnt);
  ItemRange it = xcd_items(mt.tf[NE + 1] * 4);
  if (it.i >= it.hi) return;
  const int v0 = 4 * (tid & 31);
  auto set_rows = [&](const MoeItem& m, int slot) {
#pragma unroll
    for (int i = 0; i < 5; ++i) {
      int ri = m.r0 + (tid >> 3) + 64 * i; ri = ri < m.r1 ? ri : m.r1 - 1;
      const int tk = m.e < NE ? p.etok[(size_t)m.e * T_ + ri] : ri;
      mt.ao[slot][i][tid] = (unsigned)tk * D_ + (tid & 7) * 8;
    }
  };
  auto b_ptr = [&](const MoeItem& m, int kt) -> const float* {
    const float* wg = m.e < NE ? p.w_gate + ((size_t)layer * NE + m.e) * D_ * 256 : p.sh_gate + (size_t)layer * D_ * 256;
    const float* wu = m.e < NE ? p.w_up + ((size_t)layer * NE + m.e) * D_ * 256 : p.sh_up + (size_t)layer * D_ * 256;
    return ((v0 & 63) >= 32 ? wu : wg) + (size_t)(kt * 64 + (tid >> 5)) * 256 + m.nt * 64 + (v0 >> 6) * 32 + (v0 & 31);
  };
  u32x4_t ra[5]; f32x4_t rb[2][4];
  MoeItem cur = moe_item<4>(mt, it.i);
  int slot = 0;
  set_rows(cur, 0);
  {
#pragma unroll
    for (int i = 0; i < 5; ++i) ra[i] = *reinterpret_cast<const u32x4_t*>(p.x1b + mt.ao[0][i][tid]);
#pragma unroll
    for (int j = 0; j < 2; ++j)
#pragma unroll
      for (int i = 0; i < 4; ++i) rb[j][i] = *reinterpret_cast<const f32x4_t*>(b_ptr(cur, j) + (size_t)(16 * i) * 256);
  }
  for (;;) {
    const int un = it.i + it.step;
    const bool has_next = un < it.hi;
    const MoeItem nxt = has_next ? moe_item<4>(mt, un) : cur;
    const int nslot = has_next ? slot ^ 1 : slot;
    auto a_addr = [&](int i, int kt) { return p.x1b + mt.ao[slot][i][tid] + kt * 64; };
    auto b_addr = [&](int kt) { return b_ptr(cur, kt); };
    auto a_next = [&](int i, int kt) { return p.x1b + mt.ao[nslot][i][tid] + kt * 64; };
    auto b_next = [&](int kt) { return b_ptr(nxt, kt); };
    auto mid = [&]() { if (has_next) set_rows(nxt, nslot); };
    auto epi = [&](f32x4 (&acc)[5][4]) {
#pragma unroll
      for (int mi = 0; mi < 5; ++mi) {
        const int idx = cur.r0 + wr * 80 + mi * 16 + fr;
        if (idx < cur.r1) {
#pragma unroll
          for (int n2 = 0; n2 < 2; ++n2) {
            float hv[4];
#pragma unroll
            for (int j = 0; j < 4; ++j) { const float g = acc[mi][n2][j], uu = acc[mi][n2 + 2][j]; hv[j] = g * __builtin_amdgcn_rcpf(1.f + __expf(-g)) * uu; }
            st_bf4(p.hbuf + (size_t)(cur.of + idx) * 256 + cur.nt * 64 + wc * 32 + n2 * 16 + fq * 4, hv[0], hv[1], hv[2], hv[3]);
          }
        }
      }
    };
    moe_gemm5<16>(sm, ra, rb, a_addr, b_addr, a_next, b_next, 256, mid, epi);
    if (!has_next) break;
    cur = nxt; it.i = un; slot = nslot;
  }
}

DEV void ph_moe2(const Params& p, GemmSmem& sm, MoeTab& mt, int layer, const int* cnt) {
  const int tid = tidx(), lane = tid & 63, wid = tid >> 6, wr = wid >> 1, wc = wid & 1, fr = lane & 15, fq = lane >> 4;
  moe_prep(mt, cnt);
  ItemRange it = xcd_items(mt.tf[NE + 1] * 8);
  if (it.i >= it.hi) return;
  auto a_ptr = [&](const MoeItem& m, int i, int kt) -> const u16* {
    const int rmax = m.r1 - 1 - m.r0 - (tid >> 3);
    int d = 64 * i; d = d < rmax ? d : rmax;
    return p.hbuf + (size_t)(m.of + m.r0 + (tid >> 3) + d) * 256 + (tid & 7) * 8 + kt * 64;
  };
  auto b_ptr = [&](const MoeItem& m, int kt) -> const float* {
    const float* wd = m.e < NE ? p.w_down + ((size_t)layer * NE + m.e) * 256 * D_ : p.sh_down + (size_t)layer * 256 * D_;
    return wd + (size_t)(kt * 64 + (tid >> 5)) * D_ + m.nt * 128 + 4 * (tid & 31);
  };
  u32x4_t ra[5]; f32x4_t rb[2][4];
  MoeItem cur = moe_item<8>(mt, it.i);
  {
#pragma unroll
    for (int i = 0; i < 5; ++i) ra[i] = *reinterpret_cast<const u32x4_t*>(a_ptr(cur, i, 0));
#pragma unroll
    for (int j = 0; j < 2; ++j)
#pragma unroll
      for (int i = 0; i < 4; ++i) rb[j][i] = *reinterpret_cast<const f32x4_t*>(b_ptr(cur, j) + (size_t)(16 * i) * D_);
  }
  for (;;) {
    const int un = it.i + it.step;
    const bool has_next = un < it.hi;
    const MoeItem nxt = has_next ? moe_item<8>(mt, un) : cur;
    auto a_addr = [&](int i, int kt) { return a_ptr(cur, i, kt); };
    auto b_addr = [&](int kt) { return b_ptr(cur, kt); };
    auto a_next = [&](int i, int kt) { return a_ptr(nxt, i, kt); };
    auto b_next = [&](int kt) { return b_ptr(nxt, kt); };
    auto mid = [&]() {};
    auto epi = [&](f32x4 (&acc)[5][4]) {
      u16* T = reinterpret_cast<u16*>(&sm);
      __syncthreads();
#pragma unroll
      for (int mi = 0; mi < 5; ++mi)
#pragma unroll
        for (int ni = 0; ni < 4; ++ni) ts_put(T, wr * 80 + mi * 16 + fr, wc * 64 + ni * 16 + fq * 4, acc[mi][ni][0], acc[mi][ni][1], acc[mi][ni][2], acc[mi][ni][3]);
      ts_flush<16>(T, cur.r1 - cur.r0, [&](int row) -> u16* { return p.ybuf + (size_t)(cur.of + cur.r0 + row) * D_ + cur.nt * 128; });
    };
    moe_gemm5<4>(sm, ra, rb, a_addr, b_addr, a_next, b_next, D_, mid, epi);
    if (!has_next) break;
    cur = nxt; it.i = un;
  }
}

DEV void ph_combine_ln(const Params& p, MoeTab& mt, const int* cnt, const float* g, const float* bt, float* outf, u16* outb, bool with_ffn, bool write_b = true) {
  const int lane = tidx() & 63, gw = blockIdx.x * NWAVE + (tidx() >> 6), nw = gridDim.x * NWAVE;
  moe_prep(mt, cnt);
  for (int tok = gw; tok < T_; tok += nw) {
    int sl = 0; float gk = 0.f;
    if (lane < TOPK) { sl = mt.of[p.eidx[tok * TOPK + lane]] + p.epos[tok * TOPK + lane]; gk = p.gatev[tok * TOPK + lane]; }
    u32x4_t y[9][2], xh[2], xl[2];
#pragma unroll
    for (int i = 0; i < 2; ++i) {
      xh[i] = reinterpret_cast<const u32x4_t*>(p.x1b + (size_t)tok * D_)[i * 64 + lane];
      xl[i] = reinterpret_cast<const u32x4_t*>(p.x1lo + (size_t)tok * D_)[i * 64 + lane];
      y[8][i] = reinterpret_cast<const u32x4_t*>(p.ybuf + (size_t)(NASG + tok) * D_)[i * 64 + lane];
    }
    float gks[8];
#pragma unroll
    for (int k = 0; k < TOPK; ++k) {
      const int slk = __builtin_amdgcn_readlane(sl, k);
      gks[k] = __builtin_bit_cast(float, __builtin_amdgcn_readlane(__builtin_bit_cast(int, gk), k));
#pragma unroll
      for (int i = 0; i < 2; ++i) y[k][i] = reinterpret_cast<const u32x4_t*>(p.ybuf + (size_t)slk * D_)[i * 64 + lane];
    }
    float v[2][8];
#pragma unroll
    for (int i = 0; i < 2; ++i)
#pragma unroll
      for (int c = 0; c < 4; ++c) {
        float a0 = ALPHA * (bflo(xh[i][c]) + bflo(xl[i][c])), a1 = ALPHA * (bfhi(xh[i][c]) + bfhi(xl[i][c]));
        if (with_ffn) {
          a0 += bflo(y[8][i][c]); a1 += bfhi(y[8][i][c]);
#pragma unroll
          for (int k = 0; k < TOPK; ++k) { a0 += gks[k] * bflo(y[k][i][c]); a1 += gks[k] * bfhi(y[k][i][c]); }
        }
        v[i][2 * c] = a0; v[i][2 * c + 1] = a1;
      }
    float s = 0.f;
#pragma unroll
    for (int i = 0; i < 2; ++i)
#pragma unroll
      for (int c = 0; c < 8; ++c) s += v[i][c];
    const float mu = wave_sum(s) * (1.f / D_);
    float ss = 0.f;
#pragma unroll
    for (int i = 0; i < 2; ++i)
#pragma unroll
      for (int c = 0; c < 8; ++c) { v[i][c] -= mu; ss += v[i][c] * v[i][c]; }
    const float rstd = rsqrtf(wave_sum(ss) * (1.f / D_) + LN_EPS);
#pragma unroll
    for (int i = 0; i < 2; ++i) {
      const int c0 = (i * 64 + lane) * 8;
      float o[8];
#pragma unroll
      for (int h = 0; h < 2; ++h) {
        const float4 gg = ld4(g + c0 + 4 * h), bb = ld4(bt + c0 + 4 * h);
        o[4 * h] = v[i][4 * h] * rstd * gg.x + bb.x; o[4 * h + 1] = v[i][4 * h + 1] * rstd * gg.y + bb.y;
        o[4 * h + 2] = v[i][4 * h + 2] * rstd * gg.z + bb.z; o[4 * h + 3] = v[i][4 * h + 3] * rstd * gg.w + bb.w;
        float4 w; w.x = o[4 * h]; w.y = o[4 * h + 1]; w.z = o[4 * h + 2]; w.w = o[4 * h + 3];
        *reinterpret_cast<float4*>(outf + (size_t)tok * D_ + c0 + 4 * h) = w;
      }
      if (write_b) {
        u32x4_t w; w[0] = cvtpk(o[0], o[1]); w[1] = cvtpk(o[2], o[3]); w[2] = cvtpk(o[4], o[5]); w[3] = cvtpk(o[6], o[7]);
        *reinterpret_cast<u32x4_t*>(outb + (size_t)tok * D_ + c0) = w;
      }
    }
  }
}

DEV void ph_inproj1(const Params& p, GemmSmem& sm) {
  const int tid = tidx(), lane = tid & 63, wid = tid >> 6, wr = wid >> 1, wc = wid & 1, fr = lane & 15, fq = lane >> 4;
  constexpr int NT = 21;
  for (ItemRange it = xcd_items(64 * (NT + 1)); it.i < it.hi; it.i += it.step) {
    int mt, nt; dense_item<16, 2>(it.i, 64, mt, nt);
    if (nt >= NT) continue;
    const int m0 = mt * 256, n0 = nt * 128;
    const u16* ar0 = p.xb + (size_t)(m0 + (tid >> 3)) * D_ + (tid & 7) * 8;
    auto a_addr = [&](int i, int kt) { return ar0 + (size_t)i * 64 * D_ + kt * 64; };
    const u16* bb = p.w16_in1 + (size_t)(tid >> 4) * NIN1 + n0 + 8 * (tid & 15);
    const bool bok = n0 + 8 * (tid & 15) < NIN1;
    const u16* bbv = bok ? bb : p.w16_in1 + (size_t)(tid >> 4) * NIN1;
    auto b_addr = [&](int kt) -> const u16* { return bbv + (size_t)kt * 64 * NIN1; };
    auto b_lo = [&](int) { return false; };
    auto epi = [&](f32x4 (&acc)[4][4]) {
#pragma unroll
      for (int mi = 0; mi < 4; ++mi) {
        const int row = m0 + wr * 64 + mi * 16 + fr;
#pragma unroll
        for (int ni = 0; ni < 4; ++ni) {
          f32x4 v = acc[mi][ni];
          const int col = n0 + wc * 64 + ni * 16 + fq * 4;
          const bool rope = (ni == 0) && (col < 1280 || (col >= 1536 && col < 1792) || (col >= 2048 && col < 2304));
          if (rope) {
            const float4 c_ = ld4(p.cs + row * 16 + 4 * (fq & 1)), s_ = ld4(p.cs + row * 16 + 8 + 4 * (fq & 1));
            const float p0 = __shfl_xor(v[0], 32), p1 = __shfl_xor(v[1], 32), p2 = __shfl_xor(v[2], 32), p3 = __shfl_xor(v[3], 32);
            const float sg = fq < 2 ? -1.f : 1.f;
            v[0] = v[0] * c_.x + sg * p0 * s_.x; v[1] = v[1] * c_.y + sg * p1 * s_.y; v[2] = v[2] * c_.z + sg * p2 * s_.z; v[3] = v[3] * c_.w + sg * p3 * s_.w;
          }
          if (col < LD1) st_bf4(p.qkv + (size_t)row * LD1 + col, v[0], v[1], v[2], v[3]);
          else if (col < NIN1) {
            float4 o; o.x = 1.f / (1.f + __expf(-v[0])); o.y = 1.f / (1.f + __expf(-v[1])); o.z = 1.f / (1.f + __expf(-v[2])); o.w = 1.f / (1.f + __expf(-v[3]));
            *reinterpret_cast<float4*>(p.gates + (size_t)row * 48 + (col - LD1)) = o;
          }
        }
      }
    };
    gemm_core<4, false, true>(sm, 16, a_addr, b_addr, NIN1, b_lo, epi, bok);
  }
}

DEV float gelu_tanh(float x) { const float u = 0.7978845608028654f * (x + 0.044715f * x * x * x); return 0.5f * x * (1.f + tanhf(u)); }
DEV void ph_cmp1(const Params& p, GemmSmem& sm) {
  const int tid = tidx(), lane = tid & 63, wid = tid >> 6, wr = wid >> 1, wc = wid & 1, fr = lane & 15, fq = lane >> 4;
  for (int u = blockIdx.x; u < 64; u += gridDim.x) {
    const int ts = u >> 5, mt = u & 31, m0 = mt * 128;
    const u16* ar[2];
#pragma unroll
    for (int i = 0; i < 2; ++i) {
      const int m_ = m0 + (tid >> 3) + 64 * i, bg = m_ >> 8; int c = m_ & 255; c = c < 255 ? c : 254;
      ar[i] = p.qkv + (size_t)((bg >> 2) * S_ + 16 * c) * LD1 + (ts ? 1280 : 1024) + (bg & 3) * 64 + (tid & 7) * 8;
    }
    auto a_addr = [&](int i, int kt) { return ar[i] + (size_t)kt * LD1; };
    const float* bb = (ts ? p.cmpv_w1 : p.cmpk_w1) + (size_t)(tid >> 5) * 128 + 4 * (tid & 31);
    auto b_addr = [&](int kt) { return bb + (size_t)kt * 64 * 128; };
    auto b_lo = [&](int) { return false; };
    auto epi = [&](f32x4 (&acc)[2][4]) {
#pragma unroll
      for (int mi = 0; mi < 2; ++mi)
#pragma unroll
        for (int ni = 0; ni < 4; ++ni) {
          const int m = m0 + wr * 32 + mi * 16 + fr, col = wc * 64 + ni * 16 + fq * 4;
          const float4 pbv = ld4(p.pb + ts * 128 + col);
          st_bf4(p.hid + ((size_t)ts * 4096 + m) * 128 + col, gelu_tanh(acc[mi][ni][0] + pbv.x), gelu_tanh(acc[mi][ni][1] + pbv.y),
                 gelu_tanh(acc[mi][ni][2] + pbv.z), gelu_tanh(acc[mi][ni][3] + pbv.w));
        }
    };
    gemm_core<2, false>(sm, 32, a_addr, b_addr, 128, b_lo, epi);
  }
}
DEV void ph_cmp2(const Params& p, GemmSmem& sm) {
  const int tid = tidx(), lane = tid & 63, wid = tid >> 6, wr = wid >> 1, wc = wid & 1, fr = lane & 15, fq = lane >> 4;
  for (int u = blockIdx.x; u < 64; u += gridDim.x) {
    const int ts = u >> 5, mt = u & 31, m0 = mt * 128;
    const u16* ar0 = p.hid + ((size_t)ts * 4096 + m0 + (tid >> 3)) * 128 + (tid & 7) * 8;
    auto a_addr = [&](int i, int kt) { return ar0 + (size_t)i * 64 * 128 + kt * 64; };
    const float* bb = (ts ? p.cmpv_w2 : p.cmpk_w2) + (size_t)(tid >> 5) * 64 + 4 * (tid & 31);
    const bool bok = 4 * (tid & 31) < 64;
    const float* bbv = bok ? bb : (ts ? p.cmpv_w2 : p.cmpk_w2) + (size_t)(tid >> 5) * 64;
    auto b_addr = [&](int kt) -> const float* { return bbv + (size_t)kt * 64 * 64; };
    auto b_lo = [&](int) { return false; };
    auto epi = [&](f32x4 (&acc)[2][4]) {
      if (wc == 0) {
#pragma unroll
        for (int mi = 0; mi < 2; ++mi)
#pragma unroll
          for (int ni = 0; ni < 4; ++ni) {
            const int m = m0 + wr * 32 + mi * 16 + fr, col = ni * 16 + fq * 4;
            st_bf4(p.cmpkv + ((size_t)ts * 4096 + m) * 64 + col, acc[mi][ni][0], acc[mi][ni][1], acc[mi][ni][2], acc[mi][ni][3]);
          }
      }
    };
    gemm_core<2, false>(sm, 2, a_addr, b_addr, 64, b_lo, epi, bok);
  }
}

using f32x16 = __attribute__((ext_vector_type(16))) float;
DEV int crow(int r, int hi) { return (r & 3) + 8 * (r >> 2) + 4 * hi; }
constexpr float LOG2E = 1.4426950408889634f;
constexpr float SCL2 = 0.125f * LOG2E;

struct WaveTile { u16 K[32][72]; u16 V[2][32][32]; };
struct KVTile { u16 K[32][72]; u16 V[2][32][32]; };
struct AttnState { float m, l; f32x16 o[2]; };

DEV void stage_load(u32x4_t (&rk)[4], u32x4_t (&rv)[4], const u16* Kb, const u16* Vb, int ld, long rowbase, int rowstep, int kcmax, int k0, int lane) {
#pragma unroll
  for (int it = 0; it < 4; ++it) {
    int kc = k0 + (lane >> 3) + 8 * it; kc = kc > kcmax ? kcmax : kc;
    const long row = rowbase + (long)kc * rowstep;
    rk[it] = *reinterpret_cast<const u32x4_t*>(Kb + row * ld + (lane & 7) * 8);
    rv[it] = *reinterpret_cast<const u32x4_t*>(Vb + row * ld + (lane & 7) * 8);
  }
}
DEV void stage_store(WaveTile& wt, const u32x4_t (&rk)[4], const u32x4_t (&rv)[4], int lane) {
  const int ch = lane & 7;
#pragma unroll
  for (int it = 0; it < 4; ++it) {
    const int j = (lane >> 3) + 8 * it;
    *reinterpret_cast<u32x4_t*>(&wt.K[j][ch * 8]) = rk[it];
    *reinterpret_cast<u32x4_t*>(&wt.V[ch >> 2][j][(ch & 3) * 8]) = rv[it];
  }
}
template <class TT> DEV f32x16 qk_tile(const TT& wt, const bf16x8 (&qf)[4], int r32, int hi) {
  f32x16 acc;
#pragma unroll
  for (int r = 0; r < 16; ++r) acc[r] = 0.f;
#pragma unroll
  for (int s = 0; s < 4; ++s) {
    const bf16x8 kf = *reinterpret_cast<const bf16x8*>(&wt.K[r32][16 * s + 8 * hi]);
    acc = __builtin_amdgcn_mfma_f32_32x32x16_bf16(kf, qf[s], acc, 0, 0, 0);
  }
  return acc;
}
template <class TT> DEV void pv_tile(const TT& wt, const float (&pr)[16], f32x16 (&o)[2], int lane) {
  const int hi = lane >> 5, g = (lane >> 4) & 1, q4 = (lane & 15) >> 2, p4 = lane & 3;
  bf16x8 pf[2];
#pragma unroll
  for (int s2 = 0; s2 < 2; ++s2) {
    u32x4_t w;
    w[0] = cvtpk(pr[8 * s2 + 0], pr[8 * s2 + 1]); w[1] = cvtpk(pr[8 * s2 + 2], pr[8 * s2 + 3]);
    w[2] = cvtpk(pr[8 * s2 + 4], pr[8 * s2 + 5]); w[3] = cvtpk(pr[8 * s2 + 6], pr[8 * s2 + 7]);
    pf[s2] = __builtin_bit_cast(bf16x8, w);
  }
#pragma unroll
  for (int dt = 0; dt < 2; ++dt)
#pragma unroll
    for (int s2 = 0; s2 < 2; ++s2) {
      const v4i16_t lo = lds_tr(&wt.V[dt][16 * s2 + 4 * hi + q4][16 * g + 4 * p4]);
      const v4i16_t hh = lds_tr(&wt.V[dt][16 * s2 + 8 + 4 * hi + q4][16 * g + 4 * p4]);
      const bf16x8 vf = {lo[0], lo[1], lo[2], lo[3], hh[0], hh[1], hh[2], hh[3]};
      o[dt] = __builtin_amdgcn_mfma_f32_32x32x16_bf16(vf, pf[s2], o[dt], 0, 0, 0);
    }
}
DEV void attn_init(AttnState& st) {
  st.m = -INFINITY; st.l = 0.f;
#pragma unroll
  for (int r = 0; r < 16; ++r) { st.o[0][r] = 0.f; st.o[1][r] = 0.f; }
}
template <bool USE_SEL>
DEV void attn_span(AttnState& st, WaveTile& wt, const bf16x8 (&qf)[4], const u16* Kb, const u16* Vb, int ld,
                   long rowbase, int rowstep, int kcmax, int kc_lo, int kc_hi, int qc, int W,
                   unsigned long long sel, unsigned long long selu, int lane, int qc_min, int qc_max) {
  const int r32 = lane & 31, hi = lane >> 5;
  if (kc_lo < 0) kc_lo = 0;
  if (kc_hi > kcmax) kc_hi = kcmax;
  const int full_hi = qc_min < kcmax ? qc_min : kcmax;
  auto skip = [&](int k0) -> bool { return USE_SEL && !((selu >> (k0 >> 6)) & 1ull); };
  int kc0 = kc_lo & ~31;
  while (kc0 <= kc_hi && skip(kc0)) kc0 += 32;
  if (kc0 > kc_hi) return;
  u32x4_t rk[4], rv[4];
  stage_load(rk, rv, Kb, Vb, ld, rowbase, rowstep, kcmax, kc0, lane);
  for (;;) {
    stage_store(wt, rk, rv, lane);
    int kn = kc0 + 32;
    while (kn <= kc_hi && skip(kn)) kn += 32;
    if (kn <= kc_hi) stage_load(rk, rv, Kb, Vb, ld, rowbase, rowstep, kcmax, kn, lane);
    WAVE_SYNC();
    const f32x16 s = qk_tile(wt, qf, r32, hi);
    const bool selbit = USE_SEL ? (((sel >> (kc0 >> 6)) & 1ull) != 0ull) : true;
    const bool full = (qc_min <= qc_max) && (kc0 + 31 <= full_hi) && (kc0 >= qc_max - W);
    float sv[16]; float mt = -INFINITY;
    if (full) {
      float rm = s[0];
#pragma unroll
      for (int r = 1; r < 16; ++r) rm = fmaxf(rm, s[r]);
      mt = selbit ? rm * SCL2 : -INFINITY;
    } else {
#pragma unroll
      for (int r = 0; r < 16; ++r) {
        const int kc = kc0 + crow(r, hi), dist = qc - kc;
        const bool ok = selbit && kc <= kcmax && dist >= 0 && dist <= W;
        sv[r] = ok ? s[r] * SCL2 : -INFINITY;
        mt = fmaxf(mt, sv[r]);
      }
    }
    mt = fmaxf(mt, __shfl_xor(mt, 32));
    const float mnew = fmaxf(st.m, mt), muse = (mnew == -INFINITY) ? 0.f : mnew;
    const float alpha = __builtin_amdgcn_exp2f(st.m - muse);
    st.m = mnew;
    float ps = 0.f;
    if (full) {
      const float sub = selbit ? muse : INFINITY;
#pragma unroll
      for (int r = 0; r < 16; ++r) { sv[r] = __builtin_amdgcn_exp2f(__builtin_fmaf(s[r], SCL2, -sub)); ps += sv[r]; }
    } else {
#pragma unroll
      for (int r = 0; r < 16; ++r) { sv[r] = __builtin_amdgcn_exp2f(sv[r] - muse); ps += sv[r]; }
    }
    st.l = st.l * alpha + ps;
    if (__any(alpha != 1.f)) {
#pragma unroll
      for (int r = 0; r < 16; ++r) { st.o[0][r] *= alpha; st.o[1][r] *= alpha; }
    }
    pv_tile(wt, sv, st.o, lane);
    if (kn > kc_hi) break;
    kc0 = kn;
  }
}
DEV void attn_finish(AttnState& st, float sink2) {
  float l = st.l + __shfl_xor(st.l, 32);
  if (sink2 > -INFINITY) l += __builtin_amdgcn_exp2f(sink2 - st.m);
  const float inv = l > 0.f ? 1.f / l : 0.f;
#pragma unroll
  for (int r = 0; r < 16; ++r) { st.o[0][r] *= inv; st.o[1][r] *= inv; }
}
DEV void attn_store_bf16(const AttnState& st, u16* orow, int hi) {
#pragma unroll
  for (int dt = 0; dt < 2; ++dt)
#pragma unroll
    for (int k4 = 0; k4 < 4; ++k4) {
      uint2 w; w.x = cvtpk(st.o[dt][4 * k4], st.o[dt][4 * k4 + 1]); w.y = cvtpk(st.o[dt][4 * k4 + 2], st.o[dt][4 * k4 + 3]);
      *reinterpret_cast<uint2*>(orow + 32 * dt + 8 * k4 + 4 * hi) = w;
    }
}
DEV void load_qf(bf16x8 (&qf)[4], const u16* qrow, int hi) {
#pragma unroll
  for (int s = 0; s < 4; ++s) qf[s] = *reinterpret_cast<const bf16x8*>(qrow + 16 * s + 8 * hi);
}

DEV void ph_attn0_mfma(const Params& p, WaveTile* wts) {
  const int tid = tidx(), lane = tid & 63, wid = tid >> 6, r32 = lane & 31, hi = lane >> 5;
  WaveTile& wt = wts[wid];
  const int gw = blockIdx.x * NWAVE + wid, nw = gridDim.x * NWAVE;
  for (int u = gw; u < 8192; u += nw) {
    AttnState st; attn_init(st);
    bf16x8 qf[4];
    if (u < 4096) {
      const int it = u & 7, res = (u >> 3) & 15, h = (u >> 7) & 7, b = u >> 10;
      const int i0 = it * 32, t = 16 * (i0 + r32) + res;
      const long row = (long)b * S_ + t;
      load_qf(qf, p.qkv + row * LD0 + h * 64, hi);
      const u16* Kb = p.qkv + 512 + h * 64; const u16* Vb = p.qkv + 1024 + h * 64;
      attn_span<false>(st, wt, qf, Kb, Vb, LD0, (long)b * S_ + res, 16, 255, i0 - 128, i0 + 31, i0 + r32, 128, 0ull, 0ull, lane, 1, 0);
      const int c = res >> 2;
      attn_span<false>(st, wt, qf, Kb, Vb, LD0, (long)b * S_ + (res & 3), 4, 1023, 4 * i0 + c - 128, 4 * (i0 + 31) + c, 4 * (i0 + r32) + c, 128, 0ull, 0ull, lane, 1, 0);
      attn_span<false>(st, wt, qf, Kb, Vb, LD0, (long)b * S_, 1, 4095, 16 * i0 + res - 128, 16 * (i0 + 31) + res, t, 128, 0ull, 0ull, lane, 1, 0);
      attn_finish(st, -INFINITY);
      attn_store_bf16(st, p.ao + row * D_ + h * 64, hi);
    } else {
      const int v = u - 4096, qt = v & 127, hb = (v >> 7) & 7, b = v >> 10, g = hb >> 2;
      const int t = 32 * qt + r32;
      const long row = (long)b * S_ + t;
      load_qf(qf, p.qkv + row * LD0 + 1536 + hb * 64, hi);
      attn_span<false>(st, wt, qf, p.qkv + 2048 + g * 64, p.qkv + 2176 + g * 64, LD0, (long)b * S_, 1, 4095, 32 * qt - 127, 32 * qt + 31, t, 127, 0ull, 0ull, lane, 32 * qt, 32 * qt + 31);
      attn_finish(st, p.even_sinks[hb] * LOG2E);
      attn_store_bf16(st, p.ao + row * D_ + 512 + hb * 64, hi);
    }
  }
}

struct Att1aSmem { KVTile tiles[2][2]; float imp[NWAVE][32][65]; float sc[NWAVE][64]; };
DEV void ph_attn1a(const Params& p, char* smem) {
  Att1aSmem& sm = *reinterpret_cast<Att1aSmem*>(smem);
  const int tid = tidx(), lane = tid & 63, wid = tid >> 6, r32 = lane & 31, hi = lane >> 5, gl = wid >> 2;
  const int sg = tid >> 8, sj = (tid & 255) >> 3, sc = tid & 7;
  for (int u = blockIdx.x; u < 1024; u += gridDim.x) {
    const int k = u >> 8, base = u & 255, bg = base & 7, x = base >> 3;
    const int qt = (k == 0) ? 127 - x : (k == 1) ? 64 + x : (k == 2) ? 63 - x : x;
    const int b = bg >> 1, gp = bg & 1;
    const int h = gp * 8 + wid, g = h >> 2;
    const int q0 = 32 * qt, t = q0 + r32;
    const long row = (long)b * S_ + t;
    const int qc = (t - 31) >> 4;
    int kc_hi = q0 >> 4; kc_hi = kc_hi > 254 ? 254 : kc_hi;
    const int ntile = (kc_hi >> 5) + 1;
    const u16* kp = p.cmpkv + ((size_t)((b * 4 + 2 * gp + sg) * 256) + sj) * 64 + sc * 8;
    const u16* vp = kp + (size_t)4096 * 64;
    for (int i = tid; i < NWAVE * 32 * 65; i += NTHR) (&sm.imp[0][0][0])[i] = 0.f;
    bf16x8 qf[4];
    load_qf(qf, p.qkv + row * LD1 + h * 64, hi);
    auto for_tiles = [&](auto&& body) {
      u32x4_t rk = *reinterpret_cast<const u32x4_t*>(kp), rv = *reinterpret_cast<const u32x4_t*>(vp);
      int cur = 0;
      for (int tt = 0; tt < ntile; ++tt) {
        KVTile& dst = sm.tiles[cur][sg];
        *reinterpret_cast<u32x4_t*>(&dst.K[sj][sc * 8]) = rk;
        *reinterpret_cast<u32x4_t*>(&dst.V[sc >> 2][sj][(sc & 3) * 8]) = rv;
        const int tn = tt + 1 < ntile ? tt + 1 : tt;
        rk = *reinterpret_cast<const u32x4_t*>(kp + (size_t)tn * 32 * 64);
        rv = *reinterpret_cast<const u32x4_t*>(vp + (size_t)tn * 32 * 64);
        __syncthreads();
        body(sm.tiles[cur][gl], tt * 32);
        cur ^= 1;
      }
      __syncthreads();
    };
    float m = -INFINITY, l = 0.f;
    for_tiles([&](const KVTile& tl, int kc0) {
      const f32x16 s = qk_tile(tl, qf, r32, hi);
      float sv[16]; float mt = -INFINITY;
#pragma unroll
      for (int rr = 0; rr < 16; ++rr) { const int kc = kc0 + crow(rr, hi); const bool ok = kc <= 254 && kc <= qc; sv[rr] = ok ? s[rr] * SCL2 : -INFINITY; mt = fmaxf(mt, sv[rr]); }
      mt = fmaxf(mt, __shfl_xor(mt, 32));
      const float mnew = fmaxf(m, mt), muse = (mnew == -INFINITY) ? 0.f : mnew;
      float ps = 0.f;
#pragma unroll
      for (int rr = 0; rr < 16; ++rr) ps += __builtin_amdgcn_exp2f(sv[rr] - muse);
      l = l * __builtin_amdgcn_exp2f(m - muse) + ps; m = mnew;
    });
    l += __shfl_xor(l, 32);
    const float inv = l > 0.f ? 1.f / l : 0.f, muse = (m == -INFINITY) ? 0.f : m;
    f32x16 o[2];
#pragma unroll
    for (int rr = 0; rr < 16; ++rr) { o[0][rr] = 0.f; o[1][rr] = 0.f; }
    for_tiles([&](const KVTile& tl, int kc0) {
      const f32x16 s = qk_tile(tl, qf, r32, hi);
      float pr[16];
#pragma unroll
      for (int rr = 0; rr < 16; ++rr) { const int kc = kc0 + crow(rr, hi); const bool ok = kc <= 254 && kc <= qc; pr[rr] = ok ? __builtin_amdgcn_exp2f(s[rr] * SCL2 - muse) * inv : 0.f; }
#pragma unroll
      for (int k4 = 0; k4 < 4; ++k4) {
        const int j = (kc0 >> 2) + 2 * k4 + hi;
        sm.imp[wid][r32][j] += pr[4 * k4] + pr[4 * k4 + 1] + pr[4 * k4 + 2] + 0.5f * pr[4 * k4 + 3];
        WAVE_SYNC();
        if (j + 1 < 64) sm.imp[wid][r32][j + 1] += 0.5f * pr[4 * k4 + 3];
        WAVE_SYNC();
      }
      pv_tile(tl, pr, o, lane);
    });
    const float g0 = p.gates[(size_t)row * 48 + h * 3];
#pragma unroll
    for (int dt = 0; dt < 2; ++dt)
#pragma unroll
      for (int k4 = 0; k4 < 4; ++k4) {
        float4 w; w.x = g0 * o[dt][4 * k4]; w.y = g0 * o[dt][4 * k4 + 1]; w.z = g0 * o[dt][4 * k4 + 2]; w.w = g0 * o[dt][4 * k4 + 3];
        *reinterpret_cast<float4*>(p.hpre + (size_t)row * D_ + h * 64 + 32 * dt + 8 * k4 + 4 * hi) = w;
      }
    for (int i = 0; i < 8; ++i) {
      const int pi = wid * 8 + i, grp = pi >> 5, q = pi & 31;
      const int tq = q0 + q, cur = tq >> 6;
      const float impq = (sm.imp[4 * grp][q][lane] + sm.imp[4 * grp + 1][q][lane]) + (sm.imp[4 * grp + 2][q][lane] + sm.imp[4 * grp + 3][q][lane]);
      const float score = (lane > cur) ? -1.f : ((lane == 0 || lane == cur || lane == cur - 1) ? 1.0e4f : impq);
      sm.sc[wid][lane] = score;
      WAVE_SYNC();
      int rk_ = 0;
#pragma unroll
      for (int jj = 0; jj < 64; jj += 4) {
        const float4 v = *reinterpret_cast<const float4*>(&sm.sc[wid][jj]);
        rk_ += (v.x > score || (v.x == score && jj < lane)) ? 1 : 0;
        rk_ += (v.y > score || (v.y == score && jj + 1 < lane)) ? 1 : 0;
        rk_ += (v.z > score || (v.z == score && jj + 2 < lane)) ? 1 : 0;
        rk_ += (v.w > score || (v.w == score && jj + 3 < lane)) ? 1 : 0;
      }
      WAVE_SYNC();
      const unsigned long long mask = __ballot(rk_ < 16 && lane <= cur);
      if (lane == 0) p.selmask[((size_t)b * S_ + tq) * 4 + 2 * gp + grp] = mask;
    }
    __syncthreads();
  }
}

template <class TT>
DEV void attn_tile_update(AttnState& st, const TT& tl, const bf16x8 (&qf)[4], int kc0, int qc, int W, int kcmax, bool selbit, bool full, int lane) {
  const int r32 = lane & 31, hi = lane >> 5;
  const f32x16 s = qk_tile(tl, qf, r32, hi);
  float sv[16]; float mt = -INFINITY;
  if (full) {
    float rm = s[0];
#pragma unroll
    for (int r = 1; r < 16; ++r) rm = fmaxf(rm, s[r]);
    mt = selbit ? rm * SCL2 : -INFINITY;
  } else {
#pragma unroll
    for (int r = 0; r < 16; ++r) {
      const int kc = kc0 + crow(r, hi), dist = qc - kc;
      const bool ok = selbit && kc <= kcmax && dist >= 0 && dist <= W;
      sv[r] = ok ? s[r] * SCL2 : -INFINITY;
      mt = fmaxf(mt, sv[r]);
    }
  }
  mt = fmaxf(mt, __shfl_xor(mt, 32));
  const float mnew = fmaxf(st.m, mt), muse = (mnew == -INFINITY) ? 0.f : mnew;
  const float alpha = __builtin_amdgcn_exp2f(st.m - muse);
  st.m = mnew;
  float ps = 0.f;
  if (full) {
    const float sub = selbit ? muse : INFINITY;
#pragma unroll
    for (int r = 0; r < 16; ++r) { sv[r] = __builtin_amdgcn_exp2f(__builtin_fmaf(s[r], SCL2, -sub)); ps += sv[r]; }
  } else {
#pragma unroll
    for (int r = 0; r < 16; ++r) { sv[r] = __builtin_amdgcn_exp2f(sv[r] - muse); ps += sv[r]; }
  }
  st.l = st.l * alpha + ps;
  if (__any(alpha != 1.f)) {
#pragma unroll
    for (int r = 0; r < 16; ++r) { st.o[0][r] *= alpha; st.o[1][r] *= alpha; }
  }
  pv_tile(tl, sv, st.o, lane);
}

template <bool USE_SEL>
DEV void attn_span_shared(AttnState& st, KVTile (*tiles)[2][2], const Params& p, const bf16x8 (&qf)[4], int b, int gp, int kcol, int vcol,
                          int t_lo, int t_hi, int qc, int W, unsigned long long sel, int q0) {
  const int tid = tidx(), lane = tid & 63, wid = tid >> 6, gl = wid >> 2;
  const int sg = tid >> 8, sj = (tid & 255) >> 3, sc = tid & 7;
  const u16* kp = p.qkv + (size_t)b * S_ * LD1 + kcol + (2 * gp + sg) * 64 + (size_t)sj * LD1 + sc * 8;
  const u16* vp = p.qkv + (size_t)b * S_ * LD1 + vcol + (2 * gp + sg) * 64 + (size_t)sj * LD1 + sc * 8;
  const int s_lo = t_lo >> 1, s_hi = t_hi >> 1;
  u32x4_t rk[2], rv[2];
#pragma unroll
  for (int h = 0; h < 2; ++h) {
    rk[h] = *reinterpret_cast<const u32x4_t*>(kp + (size_t)(2 * s_lo + h) * 32 * LD1);
    rv[h] = *reinterpret_cast<const u32x4_t*>(vp + (size_t)(2 * s_lo + h) * 32 * LD1);
  }
  int cur = 0;
  for (int sidx = s_lo; sidx <= s_hi; ++sidx) {
#pragma unroll
    for (int h = 0; h < 2; ++h) {
      KVTile& dst = tiles[cur][sg][h];
      *reinterpret_cast<u32x4_t*>(&dst.K[sj][sc * 8]) = rk[h];
      *reinterpret_cast<u32x4_t*>(&dst.V[sc >> 2][sj][(sc & 3) * 8]) = rv[h];
    }
    const int sn = sidx < s_hi ? sidx + 1 : sidx;
#pragma unroll
    for (int h = 0; h < 2; ++h) {
      rk[h] = *reinterpret_cast<const u32x4_t*>(kp + (size_t)(2 * sn + h) * 32 * LD1);
      rv[h] = *reinterpret_cast<const u32x4_t*>(vp + (size_t)(2 * sn + h) * 32 * LD1);
    }
    __syncthreads();
#pragma unroll
    for (int h = 0; h < 2; ++h) {
      const int t = 2 * sidx + h;
      if (t >= t_lo && t <= t_hi) {
        const int kc0 = t * 32;
        const bool selbit = USE_SEL ? (((sel >> (kc0 >> 6)) & 1ull) != 0ull) : true;
        const bool full = (kc0 + 31 <= q0) && (kc0 >= q0 + 31 - W);
        attn_tile_update(st, tiles[cur][gl][h], qf, kc0, qc, W, 4095, selbit, full, lane);
      }
    }
    cur ^= 1;
  }
  __syncthreads();
}

DEV void ph_attn1b(const Params& p, char* smem) {
  KVTile (*tiles)[2][2] = reinterpret_cast<KVTile (*)[2][2]>(smem);
  const int tid = tidx(), lane = tid & 63, wid = tid >> 6, r32 = lane & 31, hi = lane >> 5;
  for (int u = blockIdx.x; u < 1024; u += gridDim.x) {
    const int k = u >> 8, base = u & 255, bg = base & 7, x = base >> 3;
    const int qt = (k == 0) ? 127 - x : (k == 1) ? 64 + x : (k == 2) ? 63 - x : x;
    const int b = bg >> 1, gp = bg & 1;
    const int h = gp * 8 + wid, g = h >> 2;
    const int q0 = 32 * qt, t = q0 + r32;
    const long row = (long)b * S_ + t;
    bf16x8 qf[4];
    load_qf(qf, p.qkv + row * LD1 + h * 64, hi);
    const unsigned long long sel = p.selmask[(size_t)row * 4 + g];
    const float g1 = p.gates[(size_t)row * 48 + h * 3 + 1], g2 = p.gates[(size_t)row * 48 + h * 3 + 2];
    AttnState st; attn_init(st);
    attn_span_shared<true>(st, tiles, p, qf, b, gp, 1536, 1792, 0, qt, t, 1 << 30, sel, q0);
    attn_finish(st, -INFINITY);
    f32x16 acc[2];
#pragma unroll
    for (int rr = 0; rr < 16; ++rr) { acc[0][rr] = g1 * st.o[0][rr]; acc[1][rr] = g1 * st.o[1][rr]; }
    attn_init(st);
    const int wlo = q0 - 511 > 0 ? (q0 - 511) >> 5 : 0;
    attn_span_shared<false>(st, tiles, p, qf, b, gp, 2048, 2304, wlo, qt, t, 511, 0ull, q0);
    attn_finish(st, -INFINITY);
#pragma unroll
    for (int dt = 0; dt < 2; ++dt)
#pragma unroll
      for (int k4 = 0; k4 < 4; ++k4) {
        const float4 c = *reinterpret_cast<const float4*>(p.hpre + (size_t)row * D_ + h * 64 + 32 * dt + 8 * k4 + 4 * hi);
        uint2 w;
        w.x = cvtpk(c.x + acc[dt][4 * k4] + g2 * st.o[dt][4 * k4], c.y + acc[dt][4 * k4 + 1] + g2 * st.o[dt][4 * k4 + 1]);
        w.y = cvtpk(c.z + acc[dt][4 * k4 + 2] + g2 * st.o[dt][4 * k4 + 2], c.w + acc[dt][4 * k4 + 3] + g2 * st.o[dt][4 * k4 + 3]);
        *reinterpret_cast<uint2*>(p.ao + (size_t)row * D_ + h * 64 + 32 * dt + 8 * k4 + 4 * hi) = w;
      }
  }
}

enum { PH_PRO = 0, PH_IN0, PH_ATT0, PH_OUT0, PH_LN0, PH_RG0, PH_RT0, PH_M10, PH_M20, PH_CB0,
       PH_IN1, PH_C1, PH_C2, PH_ATT1A, PH_ATT1B, PH_OUT1, PH_LN1, PH_RG1, PH_RT1, PH_M11, PH_M21, PH_CB1 };

template <int PH> DEV void run_phase(const Params& p, char* smem) {
  GemmSmem& gs = *reinterpret_cast<GemmSmem*>(smem);
  WaveTile* wts = reinterpret_cast<WaveTile*>(smem);
  MoeTab& mt = *reinterpret_cast<MoeTab*>(smem + sizeof(GemmSmem));
  if constexpr (PH == PH_PRO) ph_prologue(p);
  else if constexpr (PH == PH_IN0) ph_inproj0(p, gs);
  else if constexpr (PH == PH_ATT0) ph_attn0_mfma(p, wts);
  else if constexpr (PH == PH_OUT0) ph_outproj(p, gs, p.w16_out0, p.x);
  else if constexpr (PH == PH_LN0) ph_ln_mix(p, p.mix_g, p.mix_b);
  else if constexpr (PH == PH_RG0) ph_router_gemm(p, smem, p.rw16);
  else if constexpr (PH == PH_RT0) ph_route(p, p.router_b, p.cnt, p.etok);
  else if constexpr (PH == PH_M10) ph_moe1(p, gs, mt, 0, p.cnt);
  else if constexpr (PH == PH_M20) ph_moe2(p, gs, mt, 0, p.cnt);
  else if constexpr (PH == PH_CB0) ph_combine_ln(p, mt, p.cnt, p.ffn_g, p.ffn_b, p.x2f, p.xb, true);
  else if constexpr (PH == PH_IN1) ph_inproj1(p, gs);
  else if constexpr (PH == PH_C1) ph_cmp1(p, gs);
  else if constexpr (PH == PH_C2) ph_cmp2(p, gs);
  else if constexpr (PH == PH_ATT1A) ph_attn1a(p, smem);
  else if constexpr (PH == PH_ATT1B) ph_attn1b(p, smem);
  else if constexpr (PH == PH_OUT1) ph_outproj(p, gs, p.w16_out1, p.x2f);
  else if constexpr (PH == PH_LN1) ph_ln_mix(p, p.mix_g + D_, p.mix_b + D_);
  else if constexpr (PH == PH_RG1) ph_router_gemm(p, smem, p.rw16 + (size_t)2 * D_ * NE);
  else if constexpr (PH == PH_RT1) ph_route(p, p.router_b + NE, p.cnt + 512, p.etok);
  else if constexpr (PH == PH_M11) ph_moe1(p, gs, mt, 1, p.cnt + 512);
  else if constexpr (PH == PH_M21) ph_moe2(p, gs, mt, 1, p.cnt + 512);
  else if constexpr (PH == PH_CB1) ph_combine_ln(p, mt, p.cnt + 512, p.ffn_g + D_, p.ffn_b + D_, p.out, p.xb, true, false);
}

constexpr int SMEM_NEED0 = (NWAVE * (int)sizeof(WaveTile) > (int)(sizeof(GemmSmem) + sizeof(MoeTab))) ? NWAVE * (int)sizeof(WaveTile) : (int)(sizeof(GemmSmem) + sizeof(MoeTab));
constexpr int SMEM_NEED1 = SMEM_NEED0 > (int)sizeof(RouterSmem) ? SMEM_NEED0 : (int)sizeof(RouterSmem);
constexpr int SMEM_NEED2 = SMEM_NEED1 > (int)sizeof(Att1aSmem) ? SMEM_NEED1 : (int)sizeof(Att1aSmem);
constexpr int SMEM_NEED = SMEM_NEED2 > 8 * (int)sizeof(KVTile) ? SMEM_NEED2 : 8 * (int)sizeof(KVTile);
constexpr int SMEM_BAR_OFF = (SMEM_NEED + 15) & ~15, SMEM_BYTES = SMEM_BAR_OFF + 16;
template <int PH, bool LAST> DEV void phase_and_sync(const Params& p, char* smem, const XcdBarrier& bar) {
  run_phase<PH>(p, smem);
  if constexpr (!LAST) xcd_barrier(bar);
}
template <int... PHS> struct PhaseList {};
template <int P0> DEV void run_list(const Params& p, char* smem, const XcdBarrier& bar, PhaseList<P0>) { phase_and_sync<P0, true>(p, smem, bar); }
template <int P0, int P1, int... REST> DEV void run_list(const Params& p, char* smem, const XcdBarrier& bar, PhaseList<P0, P1, REST...>) {
  phase_and_sync<P0, false>(p, smem, bar);
  run_list(p, smem, bar, PhaseList<P1, REST...>{});
}
using Program = PhaseList<PH_PRO, PH_IN0, PH_ATT0, PH_OUT0, PH_LN0, PH_RG0, PH_RT0, PH_M10, PH_M20, PH_CB0,
                          PH_IN1, PH_C1, PH_C2, PH_ATT1A, PH_ATT1B, PH_OUT1, PH_LN1, PH_RG1, PH_RT1, PH_M11, PH_M21, PH_CB1>;
struct KArgs { const void* in[25]; float* out; char* ws; };
constexpr size_t al256(size_t b) { return (b + 255) & ~(size_t)255; }
constexpr size_t OFF_BAR = 0;
constexpr size_t OFF_CNT = OFF_BAR + al256(16384);
constexpr size_t OFF_PB = OFF_CNT + al256(4096);
constexpr size_t OFF_ZERO_END = OFF_PB + al256(1024);
constexpr size_t OFF_CS = OFF_ZERO_END;
constexpr size_t OFF_XB = OFF_CS + al256((size_t)T_ * 16 * 4);
constexpr size_t OFF_QKV = OFF_XB + al256((size_t)T_ * D_ * 2);
constexpr size_t OFF_GATES = OFF_QKV + al256((size_t)T_ * 2624 * 2);
constexpr size_t OFF_AO = OFF_GATES + al256((size_t)T_ * 48 * 4);
constexpr size_t OFF_HPRE = OFF_AO + al256((size_t)T_ * D_ * 2);
constexpr size_t OFF_X1B = OFF_HPRE + al256((size_t)T_ * D_ * 4);
constexpr size_t OFF_X1LO = OFF_X1B + al256((size_t)T_ * D_ * 2);
constexpr size_t OFF_LOGITS = OFF_X1LO + al256((size_t)T_ * D_ * 2);
constexpr size_t OFF_EIDX = OFF_LOGITS + al256((size_t)T_ * NE * 4);
constexpr size_t OFF_GATEV = OFF_EIDX + al256((size_t)NASG * 4);
constexpr size_t OFF_EPOS = OFF_GATEV + al256((size_t)NASG * 4);
constexpr size_t OFF_ETOK = OFF_EPOS + al256((size_t)NASG * 4);
constexpr size_t OFF_HBUF = OFF_ETOK + al256((size_t)NE * T_ * 4);
constexpr size_t OFF_YBUF = OFF_HBUF + al256((size_t)NROWS * 256 * 2);
constexpr size_t OFF_X2F = OFF_YBUF + al256((size_t)NROWS * D_ * 2);
constexpr size_t OFF_HID = OFF_X2F + al256((size_t)T_ * D_ * 4);
constexpr size_t OFF_CMPKV = OFF_HID + al256((size_t)2 * 4096 * 128 * 2);
constexpr size_t OFF_SELMASK = OFF_CMPKV + al256((size_t)2 * 4096 * 64 * 2);
constexpr size_t OFF_W16IN0 = OFF_SELMASK + al256((size_t)T_ * 4 * 8);
constexpr size_t OFF_W16OUT0 = OFF_W16IN0 + al256((size_t)D_ * LD0 * 2);
constexpr size_t OFF_W16IN1 = OFF_W16OUT0 + al256((size_t)D_ * D_ * 2);
constexpr size_t OFF_W16OUT1 = OFF_W16IN1 + al256((size_t)D_ * NIN1 * 2);
constexpr size_t OFF_RW16 = OFF_W16OUT1 + al256((size_t)D_ * D_ * 2);
constexpr size_t WS_NEEDED = OFF_RW16 + al256((size_t)4 * D_ * NE * 2);

DEV Params make_params(const KArgs& k) {
  Params p;
  p.x = (const float*)k.in[0]; p.pos = (const int*)k.in[1];
  p.even_w_in = (const float*)k.in[2]; p.even_sinks = (const float*)k.in[3]; p.even_w_out = (const float*)k.in[4]; p.odd_w_in = (const float*)k.in[5];
  p.cmpk_pos = (const float*)k.in[6]; p.cmpk_w1 = (const float*)k.in[7]; p.cmpk_w2 = (const float*)k.in[8];
  p.cmpv_pos = (const float*)k.in[9]; p.cmpv_w1 = (const float*)k.in[10]; p.cmpv_w2 = (const float*)k.in[11];
  p.odd_w_out = (const float*)k.in[12]; p.mix_g = (const float*)k.in[13]; p.mix_b = (const float*)k.in[14];
  p.router_w = (const float*)k.in[15]; p.router_b = (const float*)k.in[16];
  p.w_gate = (const float*)k.in[17]; p.w_up = (const float*)k.in[18]; p.w_down = (const float*)k.in[19];
  p.sh_gate = (const float*)k.in[20]; p.sh_up = (const float*)k.in[21]; p.sh_down = (const float*)k.in[22];
  p.ffn_g = (const float*)k.in[23]; p.ffn_b = (const float*)k.in[24];
  p.out = k.out;
  char* w = k.ws;
  p.bar = (unsigned*)(w + OFF_BAR); p.cnt = (int*)(w + OFF_CNT); p.pb = (float*)(w + OFF_PB);
  p.cs = (float*)(w + OFF_CS); p.xb = (u16*)(w + OFF_XB); p.qkv = (u16*)(w + OFF_QKV); p.gates = (float*)(w + OFF_GATES);
  p.ao = (u16*)(w + OFF_AO); p.hpre = (float*)(w + OFF_HPRE); p.x1b = (u16*)(w + OFF_X1B); p.x1lo = (u16*)(w + OFF_X1LO);
  p.logits = (float*)(w + OFF_LOGITS); p.eidx = (int*)(w + OFF_EIDX); p.gatev = (float*)(w + OFF_GATEV); p.epos = (int*)(w + OFF_EPOS); p.etok = (int*)(w + OFF_ETOK);
  p.hbuf = (u16*)(w + OFF_HBUF); p.ybuf = (u16*)(w + OFF_YBUF); p.x2f = (float*)(w + OFF_X2F); p.hid = (u16*)(w + OFF_HID); p.cmpkv = (u16*)(w + OFF_CMPKV);
  p.selmask = (unsigned long long*)(w + OFF_SELMASK);
  p.w16_in0 = (u16*)(w + OFF_W16IN0); p.w16_out0 = (u16*)(w + OFF_W16OUT0); p.w16_in1 = (u16*)(w + OFF_W16IN1); p.w16_out1 = (u16*)(w + OFF_W16OUT1); p.rw16 = (u16*)(w + OFF_RW16);
  return p;
}

__global__ void __launch_bounds__(NTHR, 2) k_fused(KArgs ka) {
  extern __shared__ __attribute__((aligned(16))) char smem[];
  const Params p = make_params(ka);
  if (tidx() == 0) *reinterpret_cast<uint4*>(smem + SMEM_BAR_OFF) = make_uint4(0u, 0u, 0u, 0u);
  __syncthreads();
  XcdBarrier bar = xcd_barrier_post(p.bar, (volatile LAS unsigned*)(smem + SMEM_BAR_OFF));
  run_list(p, smem, bar, Program{});
}

extern "C" void kernel_launch(void* const* d_in, const int* in_sizes, int n_in, void* d_out, int out_size, void* d_ws, size_t ws_size, hipStream_t stream) {
  (void)in_sizes; (void)n_in; (void)out_size;
  if (ws_size < WS_NEEDED) return;
  KArgs ka{};
  for (int i = 0; i < 25; ++i) ka.in[i] = d_in[i];
  ka.out = (float*)d_out; ka.ws = (char*)d_ws;
  hipMemsetAsync(d_ws, 0, OFF_ZERO_END, stream);
  static int grid = 0;
  if (!grid) {
    int dev = 0, cus = 0, per_cu = 0;
    hipGetDevice(&dev);
    hipDeviceGetAttribute(&cus, hipDeviceAttributeMultiprocessorCount, dev);
    hipFuncSetAttribute((const void*)k_fused, hipFuncAttributeMaxDynamicSharedMemorySize, SMEM_BYTES);
    hipOccupancyMaxActiveBlocksPerMultiprocessor(&per_cu, (const void*)k_fused, NTHR, SMEM_BYTES);
    if (per_cu > 1) per_cu = 1;
    if (per_cu < 1) per_cu = 1;
    grid = cus * per_cu;
  }
  hipLaunchKernelGGL(k_fused, dim3(grid), dim3(NTHR), SMEM_BYTES, stream, ka);
}
```

```cpp
#include <hip/hip_runtime.h>
#include <hip/hip_bf16.h>
#include <stdint.h>
#include <math.h>
#include <utility>

typedef unsigned short u16;
using bf16x8 = __attribute__((ext_vector_type(8))) short;
using f32x4  = __attribute__((ext_vector_type(4))) float;

#define DEV __device__ __forceinline__
__device__ __forceinline__ int tidx() { int t = (int)__builtin_amdgcn_workitem_id_x(); asm volatile("" : "+v"(t)); return t; }

constexpr int T_ = 16384, S_ = 4096, D_ = 1024;
constexpr int LD0 = 2304, LD1 = 2560, NIN1 = 2608;
constexpr int NE = 256, TOPK = 8, NASG = T_ * TOPK, NROWS = NASG + T_;
constexpr float ALPHA = 1.41421356237309515f;
constexpr float LN_EPS = 1e-5f;
constexpr int NTHR = 512, NWAVE = 8;


struct Params {
  const float* x; const int* pos;
  const float* even_w_in; const float* even_sinks; const float* even_w_out; const float* odd_w_in;
  const float* cmpk_pos; const float* cmpk_w1; const float* cmpk_w2; const float* cmpv_pos; const float* cmpv_w1; const float* cmpv_w2;
  const float* odd_w_out; const float* mix_g; const float* mix_b; const float* router_w; const float* router_b;
  const float* w_gate; const float* w_up; const float* w_down; const float* sh_gate; const float* sh_up; const float* sh_down;
  const float* ffn_g; const float* ffn_b;
  float* out;
  unsigned* bar; int* cnt; float* pb; float* cs; u16* xb; u16* qkv; float* gates; u16* ao; float* hpre;
  u16* x1b; u16* x1lo; float* logits; int* eidx; float* gatev; int* epos; int* etok;
  u16* hbuf; u16* ybuf; float* x2f; u16* hid; u16* cmpkv; unsigned long long* selmask;
  u16* w16_in0; u16* w16_out0; u16* w16_in1; u16* w16_out1; u16* rw16;
};

#define XB_TMO      128
#define XB_XCNT(j)  (256  + 64 * (j))
#define XB_XSUB(j)  (1280 + 64 * (j))
#define XB_XGEN(j)  (2304 + 64 * (j))
#define XB_TOP      3328
#define XB_TOPGEN   3392
#define XCD_BAR_WORDS 3456
#define XB_SPIN_CAP (1u << 18)
#define LAS __attribute__((address_space(3)))

__device__ __forceinline__ unsigned xb_ld(unsigned* p)              { return __hip_atomic_load(p, __ATOMIC_RELAXED, __HIP_MEMORY_SCOPE_AGENT); }
__device__ __forceinline__ unsigned xb_add(unsigned* p, unsigned v) { return __hip_atomic_fetch_add(p, v, __ATOMIC_RELAXED, __HIP_MEMORY_SCOPE_AGENT); }
__device__ __forceinline__ unsigned xb_xcc_id() { return (unsigned)__builtin_amdgcn_s_getreg((3 << 11) | 20) & 0xFu; }
#define XB_SPIN(cond, bar) do { unsigned _sp = 0; while (cond) { __builtin_amdgcn_s_sleep(1); \
    if ((++_sp & 255u) == 0u) { if (xb_ld(&(bar)[XB_TMO])) break; if (_sp > XB_SPIN_CAP) { atomicAdd(&(bar)[XB_TMO], 1u); break; } } } } while (0)

struct XcdBarrier {
    unsigned* bar; unsigned x;
    volatile LAS unsigned* st;
};

__device__ __forceinline__ XcdBarrier xcd_barrier_post(unsigned* bar, volatile LAS unsigned* st) {
    XcdBarrier b; b.bar = bar; b.x = xb_xcc_id(); b.st = st;
    if (tidx() == 0) (void)xb_add(&bar[XB_XCNT(b.x)], 1u);
    return b;
}
__device__ __forceinline__ void xcd_barrier_complete(unsigned* bar, unsigned x, unsigned& nloc, unsigned& nx) {
    const unsigned G = gridDim.x * gridDim.y * gridDim.z;
    unsigned sum, cnt, mine, sp = 0u;
    for (;;) {
        sum = 0u; cnt = 0u; mine = 0u;
#pragma unroll
        for (unsigned j = 0; j < 16; ++j) { const unsigned c = xb_ld(&bar[XB_XCNT(j)]); sum += c; cnt += (c > 0u) ? 1u : 0u; mine = (j == x) ? c : mine; }
        if (sum == G) break;
        __builtin_amdgcn_s_sleep(1);
        if ((++sp & 255u) == 0u) { if (xb_ld(&bar[XB_TMO])) break; if (sp > XB_SPIN_CAP) { atomicAdd(&bar[XB_TMO], 1u); break; } }
    }
    nloc = mine > 0u ? mine : 1u; nx = cnt > 0u ? cnt : 1u;
}

__device__ __forceinline__ void xcd_barrier(const XcdBarrier& b) {
    asm volatile("s_waitcnt vmcnt(0)" ::: "memory");
    __syncthreads();
    if (tidx() == 0) {
        unsigned* bar = b.bar;
        __builtin_amdgcn_s_waitcnt(0);
        unsigned nloc = b.st[0], nx = b.st[1];
        if (nloc == 0u) { xcd_barrier_complete(bar, b.x, nloc, nx); b.st[0] = nloc; b.st[1] = nx; }
        const unsigned old = xb_add(&bar[XB_XSUB(b.x)], 1u);
        const unsigned gen = old / nloc;
        if (old + 1u == (gen + 1u) * nloc) {
            __builtin_amdgcn_fence(__ATOMIC_RELEASE, "agent");
            asm volatile("s_waitcnt vmcnt(0)" ::: "memory");
            const unsigned og = xb_add(&bar[XB_TOP], 1u);
            const unsigned tg = og / nx;
            if (og + 1u == (tg + 1u) * nx) xb_add(&bar[XB_TOPGEN], 1u);
            else XB_SPIN(xb_ld(&bar[XB_TOPGEN]) == tg, bar);
            __builtin_amdgcn_fence(__ATOMIC_ACQUIRE, "agent");
            xb_add(&bar[XB_XGEN(b.x)], 1u);
            asm volatile("s_waitcnt vmcnt(0)" ::: "memory");
        } else {
            XB_SPIN(xb_ld(&bar[XB_XGEN(b.x)]) == gen, bar);
            __builtin_amdgcn_fence(__ATOMIC_ACQUIRE, "agent");
            asm volatile("s_waitcnt vmcnt(0)" ::: "memory");
        }
    }
    __syncthreads();
}


DEV float bf2f(u16 h) { return __uint_as_float(((unsigned)h) << 16); }
DEV float bflo(unsigned w) { return __uint_as_float(w << 16); }
DEV float bfhi(unsigned w) { return __uint_as_float(w & 0xffff0000u); }
DEV float wave_max(float v) { for (int o = 32; o; o >>= 1) v = fmaxf(v, __shfl_xor(v, o)); return v; }
DEV float wave_sum(float v) { for (int o = 32; o; o >>= 1) v += __shfl_xor(v, o); return v; }
#define WAVE_SYNC() asm volatile("s_waitcnt lgkmcnt(0)" ::: "memory")

typedef short v4i16_t __attribute__((ext_vector_type(4)));
typedef float f32x2_t __attribute__((ext_vector_type(2)));
typedef __bf16 bf16x2_t __attribute__((ext_vector_type(2)));
typedef unsigned u32x4_t __attribute__((ext_vector_type(4)));
typedef unsigned u32x2_t __attribute__((ext_vector_type(2)));
typedef float f32x4_t __attribute__((ext_vector_type(4)));
DEV unsigned cvtpk(float lo, float hi) { f32x2_t v = {lo, hi}; bf16x2_t b = __builtin_convertvector(v, bf16x2_t); return __builtin_bit_cast(unsigned, b); }
DEV v4i16_t lds_tr(const u16* ptr) { return __builtin_amdgcn_ds_read_tr16_b64_v4i16((LAS v4i16_t*)ptr); }

struct GemmSmem { u16 A[2][320][72]; u16 B[2][64][128]; };
DEV int bswz(int k) { return (k & 3) | (((k >> 3) & 1) << 2); }

template <int MI, bool SPLIT, bool B16 = false, class FA, class FB, class FL, class FE>
DEV void gemm_core(GemmSmem& sm, int nk, FA a_addr, FB b_addr, int ldb, FL b_lo, FE epi, bool b_ok = true) {
  const int tid = tidx(), lane = tid & 63, wid = tid >> 6;
  const int wr = wid >> 1, wc = wid & 1, fr = lane & 15, fq = lane >> 4;
  const int n4 = tid & 31, kq = tid >> 5, q4 = (lane & 15) >> 2, p4 = lane & 3;
  f32x4 acc[MI][4];
#pragma unroll
  for (int mi = 0; mi < MI; ++mi)
#pragma unroll
    for (int ni = 0; ni < 4; ++ni) acc[mi][ni] = f32x4{0.f, 0.f, 0.f, 0.f};
  constexpr int NSET = (MI <= 4) ? 2 : 1;
  u32x4_t ra[NSET][MI]; f32x4_t rb[2][4]; u32x4_t rh[2][2];
  auto gloadA = [&](auto PC, int kt) {
    constexpr int P = decltype(PC)::value;
#pragma unroll
    for (int i = 0; i < MI; ++i) ra[P][i] = *reinterpret_cast<const u32x4_t*>(a_addr(i, kt));
  };
  auto gloadB = [&](auto PC, int kt) {
    constexpr int P = decltype(PC)::value;
    if constexpr (B16) {
      const u16* bp = b_addr(kt);
      rh[P][0] = *reinterpret_cast<const u32x4_t*>(bp);
      rh[P][1] = *reinterpret_cast<const u32x4_t*>(bp + (size_t)32 * ldb);
    } else {
      const float* bp = b_addr(kt);
#pragma unroll
      for (int i = 0; i < 4; ++i) rb[P][i] = *reinterpret_cast<const f32x4_t*>(bp + (size_t)(16 * i) * ldb);
    }
  };
  auto gload = [&](auto PC, int kt) { gloadA(PC, kt); gloadB(PC, kt); };
  auto sstore3 = [&](auto AC, auto PC, auto BC, int kt) {
    constexpr int AS = decltype(AC)::value;
    constexpr int P = decltype(PC)::value;
    constexpr int Bf = decltype(BC)::value;
#pragma unroll
    for (int i = 0; i < MI; ++i) *reinterpret_cast<u32x4_t*>(&sm.A[Bf][(tid >> 3) + 64 * i][(tid & 7) * 8]) = ra[AS][i];
    if constexpr (B16) {
#pragma unroll
      for (int i = 0; i < 2; ++i) {
        u32x4_t w = rh[P][i];
        if (!b_ok) w = u32x4_t{0u, 0u, 0u, 0u};
        const int k = (tid >> 4) + 32 * i, n8 = tid & 15;
        *reinterpret_cast<u32x4_t*>(&sm.B[Bf][k][(((n8 >> 1) ^ bswz(k)) << 4) + (n8 & 1) * 8]) = w;
      }
      return;
    }
    const bool lo = SPLIT ? b_lo(kt) : false;
#pragma unroll
    for (int i = 0; i < 4; ++i) {
      f32x4_t v = rb[P][i];
      if (!b_ok) v = f32x4_t{0.f, 0.f, 0.f, 0.f};
      if (SPLIT && lo) {
        const unsigned h0 = cvtpk(v[0], v[1]), h1 = cvtpk(v[2], v[3]);
        v[0] -= __uint_as_float(h0 << 16); v[1] -= __uint_as_float(h0 & 0xffff0000u); v[2] -= __uint_as_float(h1 << 16); v[3] -= __uint_as_float(h1 & 0xffff0000u);
      }
      u32x2_t w; w[0] = cvtpk(v[0], v[1]); w[1] = cvtpk(v[2], v[3]);
      const int k = kq + 16 * i;
      *reinterpret_cast<u32x2_t*>(&sm.B[Bf][k][(((n4 >> 2) ^ bswz(k)) << 4) + (n4 & 3) * 4]) = w;
    }
  };
  auto sstore = [&](auto PC, auto BC, int kt) { sstore3(PC, PC, BC, kt); };
  auto compute = [&](auto PC) {
    constexpr int P = decltype(PC)::value;
#pragma unroll
    for (int ks = 0; ks < 2; ++ks) {
      bf16x8 bf[4];
#pragma unroll
      for (int ni = 0; ni < 4; ++ni) {
        const int k0 = 32 * ks + 8 * fq + q4, col = (((wc * 4 + ni) ^ bswz(k0)) << 4) + 4 * p4;
        const v4i16_t lo = lds_tr(&sm.B[P][k0][col]);
        const v4i16_t hh = lds_tr(&sm.B[P][k0 + 4][col]);
        bf[ni] = bf16x8{lo[0], lo[1], lo[2], lo[3], hh[0], hh[1], hh[2], hh[3]};
      }
      constexpr int G0 = (MI > 4) ? 3 : MI;
      {
        bf16x8 af[G0];
#pragma unroll
        for (int mi = 0; mi < G0; ++mi) af[mi] = *reinterpret_cast<const bf16x8*>(&sm.A[P][wr * 16 * MI + mi * 16 + fr][32 * ks + fq * 8]);
#pragma unroll
        for (int mi = 0; mi < G0; ++mi)
#pragma unroll
          for (int ni = 0; ni < 4; ++ni) acc[mi][ni] = __builtin_amdgcn_mfma_f32_16x16x32_bf16(bf[ni], af[mi], acc[mi][ni], 0, 0, 0);
      }
      if constexpr (MI > G0) {
        __builtin_amdgcn_sched_barrier(0);
        bf16x8 af[MI - G0];
#pragma unroll
        for (int mi = G0; mi < MI; ++mi) af[mi - G0] = *reinterpret_cast<const bf16x8*>(&sm.A[P][wr * 16 * MI + mi * 16 + fr][32 * ks + fq * 8]);
#pragma unroll
        for (int mi = G0; mi < MI; ++mi)
#pragma unroll
          for (int ni = 0; ni < 4; ++ni) acc[mi][ni] = __builtin_amdgcn_mfma_f32_16x16x32_bf16(bf[ni], af[mi - G0], acc[mi][ni], 0, 0, 0);
      }
      __builtin_amdgcn_sched_barrier(0);
    }
  };
  using C0 = std::integral_constant<int, 0>; using C1 = std::integral_constant<int, 1>;
  int kt = 0;
  if constexpr (MI <= 4) {
    gload(C0{}, 0);
    sstore(C0{}, C0{}, 0);
    gload(C1{}, 1);
    __syncthreads();
    for (; kt + 2 < nk; kt += 2) {
      gload(C0{}, kt + 2); compute(C0{}); sstore(C1{}, C1{}, kt + 1); __syncthreads();
      gload(C1{}, kt + 3); compute(C1{}); sstore(C0{}, C0{}, kt + 2); __syncthreads();
    }
    compute(C0{}); sstore(C1{}, C1{}, kt + 1); __syncthreads();
    compute(C1{}); __syncthreads();
  } else {
    gloadA(C0{}, 0); gloadB(C0{}, 0);
    sstore3(C0{}, C0{}, C0{}, 0);
    gloadB(C1{}, 1);
    __syncthreads();
    for (; kt + 2 < nk; kt += 2) {
      gloadA(C0{}, kt + 1); gloadB(C0{}, kt + 2); compute(C0{}); sstore3(C0{}, C1{}, C1{}, kt + 1); __syncthreads();
      gloadA(C0{}, kt + 2); gloadB(C1{}, kt + 3); compute(C1{}); sstore3(C0{}, C0{}, C0{}, kt + 2); __syncthreads();
    }
    gloadA(C0{}, kt + 1); compute(C0{}); sstore3(C0{}, C1{}, C1{}, kt + 1); __syncthreads();
    compute(C1{}); __syncthreads();
  }
  epi(acc);
}

struct ItemRange { int i, hi, step; };
DEV ItemRange xcd_items(int I) {
  ItemRange r;
  if (gridDim.x & 7) { r.i = blockIdx.x; r.hi = I; r.step = gridDim.x; }
  else { const int x = blockIdx.x & 7; r.i = (int)((long)I * x / 8) + (blockIdx.x >> 3); r.hi = (int)((long)I * (x + 1) / 8); r.step = gridDim.x >> 3; }
  return r;
}
template <int GM, int GN> DEV void dense_item(int i, int MT, int& mt, int& nt) {
  const int g = i / (GM * GN), w = i % (GM * GN), gpm = MT / GM;
  mt = (g % gpm) * GM + w / GN; nt = (g / gpm) * GN + w % GN;
}
DEV float4 ld4(const float* ptr) { return *reinterpret_cast<const float4*>(ptr); }
DEV void st_bf4(u16* ptr, float a, float b, float c, float d) { uint2 w; w.x = cvtpk(a, b); w.y = cvtpk(c, d); *reinterpret_cast<uint2*>(ptr) = w; }

__constant__ float INVF[8] = {1.0f, 0.1939227432012558f, 0.03760603070259094f, 0.007292664609849453f, 0.0014142135623842478f,
                              0.00027424818836152554f, 5.3182957344688475e-05f, 1.0313385246263351e-05f};
DEV void ph_prologue(const Params& p) {
  const size_t gtid = (size_t)blockIdx.x * NTHR + tidx(), gsz = (size_t)gridDim.x * NTHR;
  for (size_t i = gtid; i < (size_t)T_ * D_ / 8; i += gsz) {
    const float4 a = reinterpret_cast<const float4*>(p.x)[2 * i], b = reinterpret_cast<const float4*>(p.x)[2 * i + 1];
    uint4 w; w.x = cvtpk(a.x, a.y); w.y = cvtpk(a.z, a.w); w.z = cvtpk(b.x, b.y); w.w = cvtpk(b.z, b.w);
    reinterpret_cast<uint4*>(p.xb)[i] = w;
  }
  for (size_t i = gtid; i < (size_t)T_ * 8; i += gsz) {
    const int t = (int)(i >> 3), f = (int)(i & 7);
    const float ang = (float)p.pos[t] * INVF[f];
    p.cs[t * 16 + f] = cosf(ang); p.cs[t * 16 + 8 + f] = sinf(ang);
  }
  auto cvt_w = [&](const float* src, u16* dst, size_t n4) {
    for (size_t i = gtid; i < n4; i += gsz) {
      const float4 a = reinterpret_cast<const float4*>(src)[i];
      uint2 w; w.x = cvtpk(a.x, a.y); w.y = cvtpk(a.z, a.w);
      reinterpret_cast<uint2*>(dst)[i] = w;
    }
  };
  cvt_w(p.even_w_in, p.w16_in0, (size_t)D_ * LD0 / 4);
  cvt_w(p.even_w_out, p.w16_out0, (size_t)D_ * D_ / 4);
  cvt_w(p.odd_w_in, p.w16_in1, (size_t)D_ * NIN1 / 4);
  cvt_w(p.odd_w_out, p.w16_out1, (size_t)D_ * D_ / 4);
  for (size_t i = gtid; i < (size_t)2 * D_ * NE / 4; i += gsz) {
    const size_t L = i / ((size_t)D_ * NE / 4), r = i - L * ((size_t)D_ * NE / 4);
    const float4 a = reinterpret_cast<const float4*>(p.router_w)[i];
    const unsigned h0 = cvtpk(a.x, a.y), h1 = cvtpk(a.z, a.w);
    uint2 hi; hi.x = h0; hi.y = h1;
    uint2 lo; lo.x = cvtpk(a.x - __uint_as_float(h0 << 16), a.y - __uint_as_float(h0 & 0xffff0000u)); lo.y = cvtpk(a.z - __uint_as_float(h1 << 16), a.w - __uint_as_float(h1 & 0xffff0000u));
    reinterpret_cast<uint2*>(p.rw16 + (L * 2 + 0) * (size_t)D_ * NE)[r] = hi;
    reinterpret_cast<uint2*>(p.rw16 + (L * 2 + 1) * (size_t)D_ * NE)[r] = lo;
  }
  for (size_t i = gtid; i < 2 * 128 * 16; i += gsz) {
    const int n = (int)(i & 127), kc = (int)((i >> 7) & 15), ts = (int)(i >> 11);
    const float* pe = ts ? p.cmpv_pos : p.cmpk_pos; const float* w1 = ts ? p.cmpv_w1 : p.cmpk_w1;
    float s = 0.f;
    for (int k = kc * 128; k < kc * 128 + 128; ++k) s += pe[k] * w1[(size_t)k * 128 + n];
    atomicAdd(&p.pb[ts * 128 + n], s);
  }
}

DEV void ph_inproj0(const Params& p, GemmSmem& sm) {
  const int tid = tidx(), lane = tid & 63, wid = tid >> 6, wr = wid >> 1, wc = wid & 1, fr = lane & 15, fq = lane >> 4;
  constexpr int NT = LD0 / 128;
  for (ItemRange it = xcd_items(64 * NT); it.i < it.hi; it.i += it.step) {
    int mt, nt; dense_item<16, 2>(it.i, 64, mt, nt);
    const int m0 = mt * 256, n0 = nt * 128;
    const u16* ar0 = p.xb + (size_t)(m0 + (tid >> 3)) * D_ + (tid & 7) * 8;
    auto a_addr = [&](int i, int kt) { return ar0 + (size_t)i * 64 * D_ + kt * 64; };
    const u16* bb = p.w16_in0 + (size_t)(tid >> 4) * LD0 + n0 + 8 * (tid & 15);
    auto b_addr = [&](int kt) { return bb + (size_t)kt * 64 * LD0; };
    auto b_lo = [&](int) { return false; };
    auto epi = [&](f32x4 (&acc)[4][4]) {
#pragma unroll
      for (int mi = 0; mi < 4; ++mi) {
        const int row = m0 + wr * 64 + mi * 16 + fr;
#pragma unroll
        for (int ni = 0; ni < 4; ++ni) {
          f32x4 v = acc[mi][ni];
          const int col = n0 + wc * 64 + ni * 16 + fq * 4;
          const bool rope = (ni == 0) && (col < 1024 || (col >= 1536 && col < 2176));
          if (rope) {
            const float4 c_ = ld4(p.cs + row * 16 + 4 * (fq & 1)), s_ = ld4(p.cs + row * 16 + 8 + 4 * (fq & 1));
            const float p0 = __shfl_xor(v[0], 32), p1 = __shfl_xor(v[1], 32), p2 = __shfl_xor(v[2], 32), p3 = __shfl_xor(v[3], 32);
            const float sg = fq < 2 ? -1.f : 1.f;
            v[0] = v[0] * c_.x + sg * p0 * s_.x; v[1] = v[1] * c_.y + sg * p1 * s_.y; v[2] = v[2] * c_.z + sg * p2 * s_.z; v[3] = v[3] * c_.w + sg * p3 * s_.w;
          }
          st_bf4(p.qkv + (size_t)row * LD0 + col, v[0], v[1], v[2], v[3]);
        }
      }
    };
    gemm_core<4, false, true>(sm, 16, a_addr, b_addr, LD0, b_lo, epi);
  }
}

DEV void ph_outproj(const Params& p, GemmSmem& sm, const u16* W16, const float* resid) {
  const int tid = tidx(), lane = tid & 63, wid = tid >> 6, wr = wid >> 1, wc = wid & 1, fr = lane & 15, fq = lane >> 4;
  for (ItemRange it = xcd_items(64 * 8); it.i < it.hi; it.i += it.step) {
    int mt, nt; dense_item<8, 4>(it.i, 64, mt, nt);
    const int m0 = mt * 256, n0 = nt * 128;
    const u16* ar0 = p.ao + (size_t)(m0 + (tid >> 3)) * D_ + (tid & 7) * 8;
    auto a_addr = [&](int i, int kt) { return ar0 + (size_t)i * 64 * D_ + kt * 64; };
    const u16* bb = W16 + (size_t)(tid >> 4) * D_ + n0 + 8 * (tid & 15);
    auto b_addr = [&](int kt) { return bb + (size_t)kt * 64 * D_; };
    auto b_lo = [&](int) { return false; };
    auto epi = [&](f32x4 (&acc)[4][4]) {
#pragma unroll
      for (int mi = 0; mi < 4; ++mi)
#pragma unroll
        for (int ni = 0; ni < 4; ++ni) {
          const size_t idx = (size_t)(m0 + wr * 64 + mi * 16 + fr) * D_ + n0 + wc * 64 + ni * 16 + fq * 4;
          const float4 r = ld4(resid + idx);
          float4 o; o.x = ALPHA * r.x + acc[mi][ni][0]; o.y = ALPHA * r.y + acc[mi][ni][1]; o.z = ALPHA * r.z + acc[mi][ni][2]; o.w = ALPHA * r.w + acc[mi][ni][3];
          *reinterpret_cast<float4*>(p.hpre + idx) = o;
        }
    };
    gemm_core<4, false, true>(sm, 16, a_addr, b_addr, D_, b_lo, epi);
  }
}

DEV void ph_ln_mix(const Params& p, const float* g, const float* bt) {
  const int lane = tidx() & 63, gw = blockIdx.x * NWAVE + (tidx() >> 6), nw = gridDim.x * NWAVE;
  for (int tok = gw; tok < T_; tok += nw) {
    float v[2][8]; float s = 0.f;
#pragma unroll
    for (int i = 0; i < 2; ++i)
#pragma unroll
      for (int h = 0; h < 2; ++h) {
        const float4 a = ld4(p.hpre + (size_t)tok * D_ + (i * 64 + lane) * 8 + 4 * h);
        v[i][4 * h] = a.x; v[i][4 * h + 1] = a.y; v[i][4 * h + 2] = a.z; v[i][4 * h + 3] = a.w;
        s += a.x + a.y + a.z + a.w;
      }
    const float mu = wave_sum(s) * (1.f / D_);
    float ss = 0.f;
#pragma unroll
    for (int i = 0; i < 2; ++i)
#pragma unroll
      for (int c = 0; c < 8; ++c) { v[i][c] -= mu; ss += v[i][c] * v[i][c]; }
    const float rstd = rsqrtf(wave_sum(ss) * (1.f / D_) + LN_EPS);
#pragma unroll
    for (int i = 0; i < 2; ++i) {
      const int c0 = (i * 64 + lane) * 8;
      float y[8];
#pragma unroll
      for (int h = 0; h < 2; ++h) {
        const float4 gg = ld4(g + c0 + 4 * h), bb = ld4(bt + c0 + 4 * h);
        y[4 * h] = v[i][4 * h] * rstd * gg.x + bb.x; y[4 * h + 1] = v[i][4 * h + 1] * rstd * gg.y + bb.y;
        y[4 * h + 2] = v[i][4 * h + 2] * rstd * gg.z + bb.z; y[4 * h + 3] = v[i][4 * h + 3] * rstd * gg.w + bb.w;
      }
      u32x4_t hi, lo;
#pragma unroll
      for (int c = 0; c < 4; ++c) {
        const unsigned hw = cvtpk(y[2 * c], y[2 * c + 1]);
        hi[c] = hw;
        lo[c] = cvtpk(y[2 * c] - __uint_as_float(hw << 16), y[2 * c + 1] - __uint_as_float(hw & 0xffff0000u));
      }
      *reinterpret_cast<u32x4_t*>(p.x1b + (size_t)tok * D_ + c0) = hi;
      *reinterpret_cast<u32x4_t*>(p.x1lo + (size_t)tok * D_ + c0) = lo;
    }
  }
}

struct RouterSmem { u16 A[2][256][72]; u16 B[2][2][64][128]; };
DEV void ph_router_gemm(const Params& p, char* smem, const u16* RW16) {
  RouterSmem& sm = *reinterpret_cast<RouterSmem*>(smem);
  const int tid = tidx(), lane = tid & 63, wid = tid >> 6, wr = wid >> 1, wc = wid & 1, fr = lane & 15, fq = lane >> 4;
  const int q4 = (lane & 15) >> 2, p4 = lane & 3;
  for (ItemRange it = xcd_items(128 * 2); it.i < it.hi; it.i += it.step) {
    const int nt = it.i & 1, mt = it.i >> 1, m0 = mt * 128, n0 = nt * 128;
    const size_t ao0 = (size_t)(m0 + (tid >> 3)) * D_ + (tid & 7) * 8;
    const u16* bb = RW16 + (size_t)(tid >> 4) * NE + n0 + 8 * (tid & 15);
    f32x4 acc[2][4];
#pragma unroll
    for (int mi = 0; mi < 2; ++mi)
#pragma unroll
      for (int ni = 0; ni < 4; ++ni) acc[mi][ni] = f32x4{0.f, 0.f, 0.f, 0.f};
    u32x4_t ra[2][4], rb[2][4];
    auto gload = [&](auto PC, int kt) {
      constexpr int P = decltype(PC)::value;
      ra[P][0] = *reinterpret_cast<const u32x4_t*>(p.x1b + ao0 + kt * 64);
      ra[P][1] = *reinterpret_cast<const u32x4_t*>(p.x1b + ao0 + (size_t)64 * D_ + kt * 64);
      ra[P][2] = *reinterpret_cast<const u32x4_t*>(p.x1lo + ao0 + kt * 64);
      ra[P][3] = *reinterpret_cast<const u32x4_t*>(p.x1lo + ao0 + (size_t)64 * D_ + kt * 64);
      const u16* bp = bb + (size_t)kt * 64 * NE;
      rb[P][0] = *reinterpret_cast<const u32x4_t*>(bp);
      rb[P][1] = *reinterpret_cast<const u32x4_t*>(bp + (size_t)32 * NE);
      rb[P][2] = *reinterpret_cast<const u32x4_t*>(bp + (size_t)D_ * NE);
      rb[P][3] = *reinterpret_cast<const u32x4_t*>(bp + (size_t)D_ * NE + (size_t)32 * NE);
    };
    auto sstore = [&](auto PC) {
      constexpr int P = decltype(PC)::value;
#pragma unroll
      for (int i = 0; i < 4; ++i) *reinterpret_cast<u32x4_t*>(&sm.A[P][(tid >> 3) + 64 * i][(tid & 7) * 8]) = ra[P][i];
#pragma unroll
      for (int i = 0; i < 4; ++i) {
        const int k = (tid >> 4) + 32 * (i & 1), n8 = tid & 15;
        *reinterpret_cast<u32x4_t*>(&sm.B[P][i >> 1][k][(((n8 >> 1) ^ bswz(k)) << 4) + (n8 & 1) * 8]) = rb[P][i];
      }
    };
    auto compute = [&](auto PC) {
      constexpr int P = decltype(PC)::value;
#pragma unroll
      for (int ks = 0; ks < 2; ++ks) {
        bf16x8 ah[2], al[2], bh[4], bl[4];
#pragma unroll
        for (int mi = 0; mi < 2; ++mi) {
          ah[mi] = *reinterpret_cast<const bf16x8*>(&sm.A[P][wr * 32 + mi * 16 + fr][32 * ks + fq * 8]);
          al[mi] = *reinterpret_cast<const bf16x8*>(&sm.A[P][128 + wr * 32 + mi * 16 + fr][32 * ks + fq * 8]);
        }
#pragma unroll
        for (int ni = 0; ni < 4; ++ni) {
          const int k0 = 32 * ks + 8 * fq + q4, col = (((wc * 4 + ni) ^ bswz(k0)) << 4) + 4 * p4;
          { const v4i16_t lo = lds_tr(&sm.B[P][0][k0][col]), hh = lds_tr(&sm.B[P][0][k0 + 4][col]); bh[ni] = bf16x8{lo[0], lo[1], lo[2], lo[3], hh[0], hh[1], hh[2], hh[3]}; }
          { const v4i16_t lo = lds_tr(&sm.B[P][1][k0][col]), hh = lds_tr(&sm.B[P][1][k0 + 4][col]); bl[ni] = bf16x8{lo[0], lo[1], lo[2], lo[3], hh[0], hh[1], hh[2], hh[3]}; }
        }
#pragma unroll
        for (int mi = 0; mi < 2; ++mi)
#pragma unroll
          for (int ni = 0; ni < 4; ++ni) {
            acc[mi][ni] = __builtin_amdgcn_mfma_f32_16x16x32_bf16(bh[ni], ah[mi], acc[mi][ni], 0, 0, 0);
            acc[mi][ni] = __builtin_amdgcn_mfma_f32_16x16x32_bf16(bh[ni], al[mi], acc[mi][ni], 0, 0, 0);
            acc[mi][ni] = __builtin_amdgcn_mfma_f32_16x16x32_bf16(bl[ni], ah[mi], acc[mi][ni], 0, 0, 0);
          }
        __builtin_amdgcn_sched_barrier(0);
      }
    };
    using C0 = std::integral_constant<int, 0>; using C1 = std::integral_constant<int, 1>;
    gload(C0{}, 0); sstore(C0{}); gload(C1{}, 1); __syncthreads();
    int kt = 0;
    for (; kt + 2 < 16; kt += 2) {
      gload(C0{}, kt + 2); compute(C0{}); sstore(C1{}); __syncthreads();
      gload(C1{}, kt + 3); compute(C1{}); sstore(C0{}); __syncthreads();
    }
    compute(C0{}); sstore(C1{}); __syncthreads();
    compute(C1{}); __syncthreads();
#pragma unroll
    for (int mi = 0; mi < 2; ++mi)
#pragma unroll
      for (int ni = 0; ni < 4; ++ni) {
        float4 o; o.x = acc[mi][ni][0]; o.y = acc[mi][ni][1]; o.z = acc[mi][ni][2]; o.w = acc[mi][ni][3];
        *reinterpret_cast<float4*>(p.logits + (size_t)(m0 + wr * 32 + mi * 16 + fr) * NE + n0 + wc * 64 + ni * 16 + fq * 4) = o;
      }
  }
}

DEV void ph_route(const Params& p, const float* rbias, int* cnt, int* etok) {
  const int lane = tidx() & 63, gw = blockIdx.x * NWAVE + (tidx() >> 6), nw = gridDim.x * NWAVE;
  const int half = lane >> 5;
  for (int tok = gw; tok < T_; tok += nw) {
    float aff[4], val[4];
#pragma unroll
    for (int j = 0; j < 4; ++j) {
      const float lg = p.logits[(size_t)tok * NE + lane + 64 * j];
      aff[j] = 1.f / (1.f + expf(-lg));
      val[j] = aff[j] + rbias[lane + 64 * j];
    }
    float gs[8];
#pragma unroll
    for (int j = 0; j < 4; ++j) {
      float m1 = val[j];
#pragma unroll
      for (int o = 16; o; o >>= 1) m1 = fmaxf(m1, __shfl_xor(m1, o));
      const unsigned long long eq = __ballot(val[j] == m1);
      const int ceq = __popc((unsigned)(half ? (eq >> 32) : (eq & 0xffffffffull)));
      float m2 = (val[j] == m1) ? -INFINITY : val[j];
#pragma unroll
      for (int o = 16; o; o >>= 1) m2 = fmaxf(m2, __shfl_xor(m2, o));
      if (ceq >= 2) m2 = m1;
      const float mine = m1 + m2, other = __shfl_xor(mine, 32);
      gs[2 * j] = half ? other : mine; gs[2 * j + 1] = half ? mine : other;
    }
    bool gok[8];
#pragma unroll
    for (int g = 0; g < 8; ++g) {
      int rk = 0;
#pragma unroll
      for (int g2 = 0; g2 < 8; ++g2) rk += (gs[g2] > gs[g] || (gs[g2] == gs[g] && g2 < g)) ? 1 : 0;
      gok[g] = rk < 4;
    }
#pragma unroll
    for (int j = 0; j < 4; ++j) { const bool ok = half ? gok[2 * j + 1] : gok[2 * j]; if (!ok) val[j] = -INFINITY; }
    int my_e = 0; float my_a = 0.f, asum = 0.f;
#pragma unroll
    for (int k = 0; k < TOPK; ++k) {
      float bv = val[0]; int bi = lane;
#pragma unroll
      for (int j = 1; j < 4; ++j) if (val[j] > bv) { bv = val[j]; bi = lane + 64 * j; }
#pragma unroll
      for (int o = 32; o; o >>= 1) {
        const float ov = __shfl_xor(bv, o); const int oi = __shfl_xor(bi, o);
        if (ov > bv || (ov == bv && oi < bi)) { bv = ov; bi = oi; }
      }
      float a_sel = 0.f;
#pragma unroll
      for (int j = 0; j < 4; ++j) { const bool hit = (bi == lane + 64 * j); a_sel = hit ? aff[j] : a_sel; val[j] = hit ? -INFINITY : val[j]; }
      a_sel = wave_sum(a_sel);
      asum += a_sel;
      if (lane == k) { my_e = bi; my_a = a_sel; }
    }
    if (lane < TOPK) {
      const int ps = atomicAdd(&cnt[my_e], 1);
      p.eidx[tok * TOPK + lane] = my_e; p.epos[tok * TOPK + lane] = ps; p.gatev[tok * TOPK + lane] = my_a / asum * 2.5f;
      etok[(size_t)my_e * T_ + ps] = tok;
    }
  }
}

constexpr int MOE_TM = 320;
struct MoeTab { int cn[260]; int of[260]; int tf[260]; unsigned ao[2][5][NTHR]; };
DEV void moe_prep(MoeTab& mt, const int* cnt) {
  const int tid = tidx();
  if (tid < NE) mt.cn[tid] = cnt[tid];
  __syncthreads();
  if (tid == 0) {
    int a = 0, tl = 0;
    for (int e = 0; e < NE; ++e) { mt.of[e] = a; mt.tf[e] = tl; a += mt.cn[e]; tl += (mt.cn[e] + MOE_TM - 1) / MOE_TM; }
    mt.cn[NE] = T_; mt.of[NE] = NASG; mt.tf[NE] = tl; mt.of[NE + 1] = NASG + T_; mt.tf[NE + 1] = tl + (T_ + MOE_TM - 1) / MOE_TM;
  }
  __syncthreads();
}
DEV int moe_rows_per_tile(int cn, int tiles) { return (cn + tiles - 1) / tiles; }
struct MoeItem { int e, nt, r0, r1, of; };
template <int NPT> DEV MoeItem moe_item(const MoeTab& mt, int u) {
  int lo = 0, hi = NE;
  while (lo < hi) { const int mid = (lo + hi + 1) >> 1; if (NPT * mt.tf[mid] <= u) lo = mid; else hi = mid - 1; }
  MoeItem it; it.e = lo;
  const int tiles = mt.tf[lo + 1] - mt.tf[lo], local = u - NPT * mt.tf[lo], mtl = local / NPT, cn = mt.cn[lo];
  it.nt = local - mtl * NPT; it.of = mt.of[lo];
  const int per = moe_rows_per_tile(cn, tiles);
  it.r0 = mtl * per; it.r1 = (it.r0 + per < cn) ? it.r0 + per : cn;
  return it;
}

template <int NK, class FA, class FB, class FAN, class FBN, class FM, class FE>
DEV void moe_gemm5(GemmSmem& sm, u32x4_t (&ra)[5], f32x4_t (&rb)[2][4], FA a_addr, FB b_addr, FAN a_next, FBN b_next, int ldb, FM mid, FE epi) {
  constexpr int MI = 5;
  const int tid = tidx(), lane = tid & 63, wid = tid >> 6;
  const int wr = wid >> 1, wc = wid & 1, fr = lane & 15, fq = lane >> 4;
  const int n4 = tid & 31, kq = tid >> 5, q4 = (lane & 15) >> 2, p4 = lane & 3;
  f32x4 acc[MI][4];
#pragma unroll
  for (int mi = 0; mi < MI; ++mi)
#pragma unroll
    for (int ni = 0; ni < 4; ++ni) acc[mi][ni] = f32x4{0.f, 0.f, 0.f, 0.f};
  auto gloadA = [&](auto& fa, int kt) {
#pragma unroll
    for (int i = 0; i < MI; ++i) ra[i] = *reinterpret_cast<const u32x4_t*>(fa(i, kt));
  };
  auto gloadB = [&](auto PC, auto& fb, int kt) {
    constexpr int P = decltype(PC)::value;
    const float* bp = fb(kt);
#pragma unroll
    for (int i = 0; i < 4; ++i) rb[P][i] = *reinterpret_cast<const f32x4_t*>(bp + (size_t)(16 * i) * ldb);
  };
  auto storeA = [&](auto PC, int i) {
    constexpr int P = decltype(PC)::value;
    *reinterpret_cast<u32x4_t*>(&sm.A[P][(tid >> 3) + 64 * i][(tid & 7) * 8]) = ra[i];
  };
  auto storeB = [&](auto PC, int i) {
    constexpr int P = decltype(PC)::value;
    const f32x4_t v = rb[P][i];
    u32x2_t w; w[0] = cvtpk(v[0], v[1]); w[1] = cvtpk(v[2], v[3]);
    const int k = kq + 16 * i;
    *reinterpret_cast<u32x2_t*>(&sm.B[P][k][(((n4 >> 2) ^ bswz(k)) << 4) + (n4 & 3) * 4]) = w;
  };
  auto compute = [&](auto BC, auto STC, auto& fa, int kta) {
    constexpr int P = decltype(BC)::value;
    constexpr bool ST = decltype(STC)::value;
    using CQ = std::integral_constant<int, 1 - P>;
#pragma unroll
    for (int ks = 0; ks < 2; ++ks) {
      bf16x8 bf[4];
#pragma unroll
      for (int ni = 0; ni < 4; ++ni) {
        const int k0 = 32 * ks + 8 * fq + q4, col = (((wc * 4 + ni) ^ bswz(k0)) << 4) + 4 * p4;
        const v4i16_t lo = lds_tr(&sm.B[P][k0][col]);
        const v4i16_t hh = lds_tr(&sm.B[P][k0 + 4][col]);
        bf[ni] = bf16x8{lo[0], lo[1], lo[2], lo[3], hh[0], hh[1], hh[2], hh[3]};
      }
      {
        bf16x8 af[3];
#pragma unroll
        for (int mi = 0; mi < 3; ++mi) af[mi] = *reinterpret_cast<const bf16x8*>(&sm.A[P][wr * 80 + mi * 16 + fr][32 * ks + fq * 8]);
#pragma unroll
        for (int mi = 0; mi < 3; ++mi)
#pragma unroll
          for (int ni = 0; ni < 4; ++ni) acc[mi][ni] = __builtin_amdgcn_mfma_f32_16x16x32_bf16(bf[ni], af[mi], acc[mi][ni], 0, 0, 0);
        if constexpr (ST) { if (ks == 0) { storeB(CQ{}, 0); storeB(CQ{}, 1); } else { storeA(CQ{}, 0); storeA(CQ{}, 1); } }
      }
      __builtin_amdgcn_sched_barrier(0);
      {
        bf16x8 af[2];
#pragma unroll
        for (int mi = 3; mi < 5; ++mi) af[mi - 3] = *reinterpret_cast<const bf16x8*>(&sm.A[P][wr * 80 + mi * 16 + fr][32 * ks + fq * 8]);
#pragma unroll
        for (int mi = 3; mi < 5; ++mi)
#pragma unroll
          for (int ni = 0; ni < 4; ++ni) acc[mi][ni] = __builtin_amdgcn_mfma_f32_16x16x32_bf16(bf[ni], af[mi - 3], acc[mi][ni], 0, 0, 0);
        if constexpr (ST) { if (ks == 0) { storeB(CQ{}, 2); storeB(CQ{}, 3); } else { storeA(CQ{}, 2); storeA(CQ{}, 3); storeA(CQ{}, 4); gloadA(fa, kta); } }
      }
      __builtin_amdgcn_sched_barrier(0);
    }
  };
  using C0 = std::integral_constant<int, 0>; using C1 = std::integral_constant<int, 1>;
  using YES = std::true_type; using NO = std::false_type;
#pragma unroll
  for (int i = 0; i < MI; ++i) storeA(C0{}, i);
#pragma unroll
  for (int i = 0; i < 4; ++i) storeB(C0{}, i);
  gloadA(a_addr, 1);
  __syncthreads();
#pragma unroll 1
  for (int kt = 0; kt + 2 < NK; kt += 2) {
    gloadB(C0{}, b_addr, kt + 2); if (kt == 0) mid(); compute(C0{}, YES{}, a_addr, kt + 2); __syncthreads();
    gloadB(C1{}, b_addr, kt + 3); compute(C1{}, YES{}, a_addr, kt + 3); __syncthreads();
  }
  gloadB(C0{}, b_next, 0); compute(C0{}, YES{}, a_next, 0); __syncthreads();
  gloadB(C1{}, b_next, 1);
  compute(C1{}, NO{}, a_next, 0);
  epi(acc);
}


constexpr int TS_LD = 136;
DEV void ts_put(u16* T, int row, int col, float a, float b, float c, float d) { uint2 w; w.x = cvtpk(a, b); w.y = cvtpk(c, d); *reinterpret_cast<uint2*>(T + row * TS_LD + col) = w; }
template <int NCH, class FD> DEV void ts_flush(const u16* T, int rows, FD dst) {
  __syncthreads();
  for (int c = tidx(); c < rows * NCH; c += NTHR) {
    const int row = c / NCH, ch = c - row * NCH;
    u16* d = dst(row);
    if (d) *reinterpret_cast<u32x4_t*>(d + ch * 8) = *reinterpret_cast<const u32x4_t*>(T + row * TS_LD + ch * 8);
  }
  __syncthreads();
}

DEV void ph_moe1(const Params& p, GemmSmem& sm, MoeTab& mt, int layer, const int* cnt) {
  const int tid = tidx(), lane = tid & 63, wid = tid >> 6, wr = wid >> 1, wc = wid & 1, fr = lane & 15, fq = lane >> 4;
  moe_prep(mt, cnt);
  ItemRange it = xcd_items(mt.tf[NE + 1] * 4);
  if (it.i >= it.hi) return;
  const int v0 = 4 * (tid & 31);
  auto set_rows = [&](const MoeItem& m, int slot) {
#pragma unroll
    for (int i = 0; i < 5; ++i) {
      int ri = m.r0 + (tid >> 3) + 64 * i; ri = ri < m.r1 ? ri : m.r1 - 1;
      const int tk = m.e < NE ? p.etok[(size_t)m.e * T_ + ri] : ri;
      mt.ao[slot][i][tid] = (unsigned)tk * D_ + (tid & 7) * 8;
    }
  };
  auto b_ptr = [&](const MoeItem& m, int kt) -> const float* {
    const float* wg = m.e < NE ? p.w_gate + ((size_t)layer * NE + m.e) * D_ * 256 : p.sh_gate + (size_t)layer * D_ * 256;
    const float* wu = m.e < NE ? p.w_up + ((size_t)layer * NE + m.e) * D_ * 256 : p.sh_up + (size_t)layer * D_ * 256;
    return ((v0 & 63) >= 32 ? wu : wg) + (size_t)(kt * 64 + (tid >> 5)) * 256 + m.nt * 64 + (v0 >> 6) * 32 + (v0 & 31);
  };
  u32x4_t ra[5]; f32x4_t rb[2][4];
  MoeItem cur = moe_item<4>(mt, it.i);
  int slot = 0;
  set_rows(cur, 0);
  {
#pragma unroll
    for (int i = 0; i < 5; ++i) ra[i] = *reinterpret_cast<const u32x4_t*>(p.x1b + mt.ao[0][i][tid]);
#pragma unroll
    for (int j = 0; j < 2; ++j)
#pragma unroll
      for (int i = 0; i < 4; ++i) rb[j][i] = *reinterpret_cast<const f32x4_t*>(b_ptr(cur, j) + (size_t)(16 * i) * 256);
  }
  for (;;) {
    const int un = it.i + it.step;
    const bool has_next = un < it.hi;
    const MoeItem nxt = has_next ? moe_item<4>(mt, un) : cur;
    const int nslot = has_next ? slot ^ 1 : slot;
    auto a_addr = [&](int i, int kt) { return p.x1b + mt.ao[slot][i][tid] + kt * 64; };
    auto b_addr = [&](int kt) { return b_ptr(cur, kt); };
    auto a_next = [&](int i, int kt) { return p.x1b + mt.ao[nslot][i][tid] + kt * 64; };
    auto b_next = [&](int kt) { return b_ptr(nxt, kt); };
    auto mid = [&]() { if (has_next) set_rows(nxt, nslot); };
    auto epi = [&](f32x4 (&acc)[5][4]) {
#pragma unroll
      for (int mi = 0; mi < 5; ++mi) {
        const int idx = cur.r0 + wr * 80 + mi * 16 + fr;
        if (idx < cur.r1) {
#pragma unroll
          for (int n2 = 0; n2 < 2; ++n2) {
            float hv[4];
#pragma unroll
            for (int j = 0; j < 4; ++j) { const float g = acc[mi][n2][j], uu = acc[mi][n2 + 2][j]; hv[j] = g * __builtin_amdgcn_rcpf(1.f + __expf(-g)) * uu; }
            st_bf4(p.hbuf + (size_t)(cur.of + idx) * 256 + cur.nt * 64 + wc * 32 + n2 * 16 + fq * 4, hv[0], hv[1], hv[2], hv[3]);
          }
        }
      }
    };
    moe_gemm5<16>(sm, ra, rb, a_addr, b_addr, a_next, b_next, 256, mid, epi);
    if (!has_next) break;
    cur = nxt; it.i = un; slot = nslot;
  }
}

DEV void ph_moe2(const Params& p, GemmSmem& sm, MoeTab& mt, int layer, const int* cnt) {
  const int tid = tidx(), lane = tid & 63, wid = tid >> 6, wr = wid >> 1, wc = wid & 1, fr = lane & 15, fq = lane >> 4;
  moe_prep(mt, cnt);
  ItemRange it = xcd_items(mt.tf[NE + 1] * 8);
  if (it.i >= it.hi) return;
  auto a_ptr = [&](const MoeItem& m, int i, int kt) -> const u16* {
    const int rmax = m.r1 - 1 - m.r0 - (tid >> 3);
    int d = 64 * i; d = d < rmax ? d : rmax;
    return p.hbuf + (size_t)(m.of + m.r0 + (tid >> 3) + d) * 256 + (tid & 7) * 8 + kt * 64;
  };
  auto b_ptr = [&](const MoeItem& m, int kt) -> const float* {
    const float* wd = m.e < NE ? p.w_down + ((size_t)layer * NE + m.e) * 256 * D_ : p.sh_down + (size_t)layer * 256 * D_;
    return wd + (size_t)(kt * 64 + (tid >> 5)) * D_ + m.nt * 128 + 4 * (tid & 31);
  };
  u32x4_t ra[5]; f32x4_t rb[2][4];
  MoeItem cur = moe_item<8>(mt, it.i);
  {
#pragma unroll
    for (int i = 0; i < 5; ++i) ra[i] = *reinterpret_cast<const u32x4_t*>(a_ptr(cur, i, 0));
#pragma unroll
    for (int j = 0; j < 2; ++j)
#pragma unroll
      for (int i = 0; i < 4; ++i) rb[j][i] = *reinterpret_cast<const f32x4_t*>(b_ptr(cur, j) + (size_t)(16 * i) * D_);
  }
  for (;;) {
    const int un = it.i + it.step;
    const bool has_next = un < it.hi;
    const MoeItem nxt = has_next ? moe_item<8>(mt, un) : cur;
    auto a_addr = [&](int i, int kt) { return a_ptr(cur, i, kt); };
    auto b_addr = [&](int kt) { return b_ptr(cur, kt); };
    auto a_next = [&](int i, int kt) { return a_ptr(nxt, i, kt); };
    auto b_next = [&](int kt) { return b_ptr(nxt, kt); };
    auto mid = [&]() {};
    auto epi = [&](f32x4 (&acc)[5][4]) {
      u16* T = reinterpret_cast<u16*>(&sm);
      __syncthreads();
#pragma unroll
      for (int mi = 0; mi < 5; ++mi)
#pragma unroll
        for (int ni = 0; ni < 4; ++ni) ts_put(T, wr * 80 + mi * 16 + fr, wc * 64 + ni * 16 + fq * 4, acc[mi][ni][0], acc[mi][ni][1], acc[mi][ni][2], acc[mi][ni][3]);
      ts_flush<16>(T, cur.r1 - cur.r0, [&](int row) -> u16* { return p.ybuf + (size_t)(cur.of + cur.r0 + row) * D_ + cur.nt * 128; });
    };
    moe_gemm5<4>(sm, ra, rb, a_addr, b_addr, a_next, b_next, D_, mid, epi);
    if (!has_next) break;
    cur = nxt; it.i = un;
  }
}

DEV void ph_combine_ln(const Params& p, MoeTab& mt, const int* cnt, const float* g, const float* bt, float* outf, u16* outb, bool with_ffn, bool write_b = true) {
  const int lane = tidx() & 63, gw = blockIdx.x * NWAVE + (tidx() >> 6), nw = gridDim.x * NWAVE;
  moe_prep(mt, cnt);
  for (int tok = gw; tok < T_; tok += nw) {
    int sl = 0; float gk = 0.f;
    if (lane < TOPK) { sl = mt.of[p.eidx[tok * TOPK + lane]] + p.epos[tok * TOPK + lane]; gk = p.gatev[tok * TOPK + lane]; }
    u32x4_t y[9][2], xh[2], xl[2];
#pragma unroll
    for (int i = 0; i < 2; ++i) {
      xh[i] = reinterpret_cast<const u32x4_t*>(p.x1b + (size_t)tok * D_)[i * 64 + lane];
      xl[i] = reinterpret_cast<const u32x4_t*>(p.x1lo + (size_t)tok * D_)[i * 64 + lane];
      y[8][i] = reinterpret_cast<const u32x4_t*>(p.ybuf + (size_t)(NASG + tok) * D_)[i * 64 + lane];
    }
    float gks[8];
#pragma unroll
    for (int k = 0; k < TOPK; ++k) {
      const int slk = __builtin_amdgcn_readlane(sl, k);
      gks[k] = __builtin_bit_cast(float, __builtin_amdgcn_readlane(__builtin_bit_cast(int, gk), k));
#pragma unroll
      for (int i = 0; i < 2; ++i) y[k][i] = reinterpret_cast<const u32x4_t*>(p.ybuf + (size_t)slk * D_)[i * 64 + lane];
    }
    float v[2][8];
#pragma unroll
    for (int i = 0; i < 2; ++i)
#pragma unroll
      for (int c = 0; c < 4; ++c) {
        float a0 = ALPHA * (bflo(xh[i][c]) + bflo(xl[i][c])), a1 = ALPHA * (bfhi(xh[i][c]) + bfhi(xl[i][c]));
        if (with_ffn) {
          a0 += bflo(y[8][i][c]); a1 += bfhi(y[8][i][c]);
#pragma unroll
          for (int k = 0; k < TOPK; ++k) { a0 += gks[k] * bflo(y[k][i][c]); a1 += gks[k] * bfhi(y[k][i][c]); }
        }
        v[i][2 * c] = a0; v[i][2 * c + 1] = a1;
      }
    float s = 0.f;
#pragma unroll
    for (int i = 0; i < 2; ++i)
#pragma unroll
      for (int c = 0; c < 8; ++c) s += v[i][c];
    const float mu = wave_sum(s) * (1.f / D_);
    float ss = 0.f;
#pragma unroll
    for (int i = 0; i < 2; ++i)
#pragma unroll
      for (int c = 0; c < 8; ++c) { v[i][c] -= mu; ss += v[i][c] * v[i][c]; }
    const float rstd = rsqrtf(wave_sum(ss) * (1.f / D_) + LN_EPS);
#pragma unroll
    for (int i = 0; i < 2; ++i) {
      const int c0 = (i * 64 + lane) * 8;
      float o[8];
#pragma unroll
      for (int h = 0; h < 2; ++h) {
        const float4 gg = ld4(g + c0 + 4 * h), bb = ld4(bt + c0 + 4 * h);
        o[4 * h] = v[i][4 * h] * rstd * gg.x + bb.x; o[4 * h + 1] = v[i][4 * h + 1] * rstd * gg.y + bb.y;
        o[4 * h + 2] = v[i][4 * h + 2] * rstd * gg.z + bb.z; o[4 * h + 3] = v[i][4 * h + 3] * rstd * gg.w + bb.w;
        float4 w; w.x = o[4 * h]; w.y = o[4 * h + 1]; w.z = o[4 * h + 2]; w.w = o[4 * h + 3];
        *reinterpret_cast<float4*>(outf + (size_t)tok * D_ + c0 + 4 * h) = w;
      }
      if (write_b) {
        u32x4_t w; w[0] = cvtpk(o[0], o[1]); w[1] = cvtpk(o[2], o[3]); w[2] = cvtpk(o[4], o[5]); w[3] = cvtpk(o[6], o[7]);
        *reinterpret_cast<u32x4_t*>(outb + (size_t)tok * D_ + c0) = w;
      }
    }
  }
}

DEV void ph_inproj1(const Params& p, GemmSmem& sm) {
  const int tid = tidx(), lane = tid & 63, wid = tid >> 6, wr = wid >> 1, wc = wid & 1, fr = lane & 15, fq = lane >> 4;
  constexpr int NT = 21;
  for (ItemRange it = xcd_items(64 * (NT + 1)); it.i < it.hi; it.i += it.step) {
    int mt, nt; dense_item<16, 2>(it.i, 64, mt, nt);
    if (nt >= NT) continue;
    const int m0 = mt * 256, n0 = nt * 128;
    const u16* ar0 = p.xb + (size_t)(m0 + (tid >> 3)) * D_ + (tid & 7) * 8;
    auto a_addr = [&](int i, int kt) { return ar0 + (size_t)i * 64 * D_ + kt * 64; };
    const u16* bb = p.w16_in1 + (size_t)(tid >> 4) * NIN1 + n0 + 8 * (tid & 15);
    const bool bok = n0 + 8 * (tid & 15) < NIN1;
    const u16* bbv = bok ? bb : p.w16_in1 + (size_t)(tid >> 4) * NIN1;
    auto b_addr = [&](int kt) -> const u16* { return bbv + (size_t)kt * 64 * NIN1; };
    auto b_lo = [&](int) { return false; };
    auto epi = [&](f32x4 (&acc)[4][4]) {
#pragma unroll
      for (int mi = 0; mi < 4; ++mi) {
        const int row = m0 + wr * 64 + mi * 16 + fr;
#pragma unroll
        for (int ni = 0; ni < 4; ++ni) {
          f32x4 v = acc[mi][ni];
          const int col = n0 + wc * 64 + ni * 16 + fq * 4;
          const bool rope = (ni == 0) && (col < 1280 || (col >= 1536 && col < 1792) || (col >= 2048 && col < 2304));
          if (rope) {
            const float4 c_ = ld4(p.cs + row * 16 + 4 * (fq & 1)), s_ = ld4(p.cs + row * 16 + 8 + 4 * (fq & 1));
            const float p0 = __shfl_xor(v[0], 32), p1 = __shfl_xor(v[1], 32), p2 = __shfl_xor(v[2], 32), p3 = __shfl_xor(v[3], 32);
            const float sg = fq < 2 ? -1.f : 1.f;
            v[0] = v[0] * c_.x + sg * p0 * s_.x; v[1] = v[1] * c_.y + sg * p1 * s_.y; v[2] = v[2] * c_.z + sg * p2 * s_.z; v[3] = v[3] * c_.w + sg * p3 * s_.w;
          }
          if (col < LD1) st_bf4(p.qkv + (size_t)row * LD1 + col, v[0], v[1], v[2], v[3]);
          else if (col < NIN1) {
            float4 o; o.x = 1.f / (1.f + __expf(-v[0])); o.y = 1.f / (1.f + __expf(-v[1])); o.z = 1.f / (1.f + __expf(-v[2])); o.w = 1.f / (1.f + __expf(-v[3]));
            *reinterpret_cast<float4*>(p.gates + (size_t)row * 48 + (col - LD1)) = o;
          }
        }
      }
    };
    gemm_core<4, false, true>(sm, 16, a_addr, b_addr, NIN1, b_lo, epi, bok);
  }
}

DEV float gelu_tanh(float x) { const float u = 0.7978845608028654f * (x + 0.044715f * x * x * x); return 0.5f * x * (1.f + tanhf(u)); }
DEV void ph_cmp1(const Params& p, GemmSmem& sm) {
  const int tid = tidx(), lane = tid & 63, wid = tid >> 6, wr = wid >> 1, wc = wid & 1, fr = lane & 15, fq = lane >> 4;
  for (int u = blockIdx.x; u < 64; u += gridDim.x) {
    const int ts = u >> 5, mt = u & 31, m0 = mt * 128;
    const u16* ar[2];
#pragma unroll
    for (int i = 0; i < 2; ++i) {
      const int m_ = m0 + (tid >> 3) + 64 * i, bg = m_ >> 8; int c = m_ & 255; c = c < 255 ? c : 254;
      ar[i] = p.qkv + (size_t)((bg >> 2) * S_ + 16 * c) * LD1 + (ts ? 1280 : 1024) + (bg & 3) * 64 + (tid & 7) * 8;
    }
    auto a_addr = [&](int i, int kt) { return ar[i] + (size_t)kt * LD1; };
    const float* bb = (ts ? p.cmpv_w1 : p.cmpk_w1) + (size_t)(tid >> 5) * 128 + 4 * (tid & 31);
    auto b_addr = [&](int kt) { return bb + (size_t)kt * 64 * 128; };
    auto b_lo = [&](int) { return false; };
    auto epi = [&](f32x4 (&acc)[2][4]) {
#pragma unroll
      for (int mi = 0; mi < 2; ++mi)
#pragma unroll
        for (int ni = 0; ni < 4; ++ni) {
          const int m = m0 + wr * 32 + mi * 16 + fr, col = wc * 64 + ni * 16 + fq * 4;
          const float4 pbv = ld4(p.pb + ts * 128 + col);
          st_bf4(p.hid + ((size_t)ts * 4096 + m) * 128 + col, gelu_tanh(acc[mi][ni][0] + pbv.x), gelu_tanh(acc[mi][ni][1] + pbv.y),
                 gelu_tanh(acc[mi][ni][2] + pbv.z), gelu_tanh(acc[mi][ni][3] + pbv.w));
        }
    };
    gemm_core<2, false>(sm, 32, a_addr, b_addr, 128, b_lo, epi);
  }
}
DEV void ph_cmp2(const Params& p, GemmSmem& sm) {
  const int tid = tidx(), lane = tid & 63, wid = tid >> 6, wr = wid >> 1, wc = wid & 1, fr = lane & 15, fq = lane >> 4;
  for (int u = blockIdx.x; u < 64; u += gridDim.x) {
    const int ts = u >> 5, mt = u & 31, m0 = mt * 128;
    const u16* ar0 = p.hid + ((size_t)ts * 4096 + m0 + (tid >> 3)) * 128 + (tid & 7) * 8;
    auto a_addr = [&](int i, int kt) { return ar0 + (size_t)i * 64 * 128 + kt * 64; };
    const float* bb = (ts ? p.cmpv_w2 : p.cmpk_w2) + (size_t)(tid >> 5) * 64 + 4 * (tid & 31);
    const bool bok = 4 * (tid & 31) < 64;
    const float* bbv = bok ? bb : (ts ? p.cmpv_w2 : p.cmpk_w2) + (size_t)(tid >> 5) * 64;
    auto b_addr = [&](int kt) -> const float* { return bbv + (size_t)kt * 64 * 64; };
    auto b_lo = [&](int) { return false; };
    auto epi = [&](f32x4 (&acc)[2][4]) {
      if (wc == 0) {
#pragma unroll
        for (int mi = 0; mi < 2; ++mi)
#pragma unroll
          for (int ni = 0; ni < 4; ++ni) {
            const int m = m0 + wr * 32 + mi * 16 + fr, col = ni * 16 + fq * 4;
            st_bf4(p.cmpkv + ((size_t)ts * 4096 + m) * 64 + col, acc[mi][ni][0], acc[mi][ni][1], acc[mi][ni][2], acc[mi][ni][3]);
          }
      }
    };
    gemm_core<2, false>(sm, 2, a_addr, b_addr, 64, b_lo, epi, bok);
  }
}

using f32x16 = __attribute__((ext_vector_type(16))) float;
DEV int crow(int r, int hi) { return (r & 3) + 8 * (r >> 2) + 4 * hi; }
constexpr float LOG2E = 1.4426950408889634f;
constexpr float SCL2 = 0.125f * LOG2E;

struct WaveTile { u16 K[32][72]; u16 V[2][32][32]; };
struct KVTile { u16 K[32][72]; u16 V[2][32][32]; };
struct AttnState { float m, l; f32x16 o[2]; };

DEV void stage_load(u32x4_t (&rk)[4], u32x4_t (&rv)[4], const u16* Kb, const u16* Vb, int ld, long rowbase, int rowstep, int kcmax, int k0, int lane) {
#pragma unroll
  for (int it = 0; it < 4; ++it) {
    int kc = k0 + (lane >> 3) + 8 * it; kc = kc > kcmax ? kcmax : kc;
    const long row = rowbase + (long)kc * rowstep;
    rk[it] = *reinterpret_cast<const u32x4_t*>(Kb + row * ld + (lane & 7) * 8);
    rv[it] = *reinterpret_cast<const u32x4_t*>(Vb + row * ld + (lane & 7) * 8);
  }
}
DEV void stage_store(WaveTile& wt, const u32x4_t (&rk)[4], const u32x4_t (&rv)[4], int lane) {
  const int ch = lane & 7;
#pragma unroll
  for (int it = 0; it < 4; ++it) {
    const int j = (lane >> 3) + 8 * it;
    *reinterpret_cast<u32x4_t*>(&wt.K[j][ch * 8]) = rk[it];
    *reinterpret_cast<u32x4_t*>(&wt.V[ch >> 2][j][(ch & 3) * 8]) = rv[it];
  }
}
template <class TT> DEV f32x16 qk_tile(const TT& wt, const bf16x8 (&qf)[4], int r32, int hi) {
  f32x16 acc;
#pragma unroll
  for (int r = 0; r < 16; ++r) acc[r] = 0.f;
#pragma unroll
  for (int s = 0; s < 4; ++s) {
    const bf16x8 kf = *reinterpret_cast<const bf16x8*>(&wt.K[r32][16 * s + 8 * hi]);
    acc = __builtin_amdgcn_mfma_f32_32x32x16_bf16(kf, qf[s], acc, 0, 0, 0);
  }
  return acc;
}
template <class TT> DEV void pv_tile(const TT& wt, const float (&pr)[16], f32x16 (&o)[2], int lane) {
  const int hi = lane >> 5, g = (lane >> 4) & 1, q4 = (lane & 15) >> 2, p4 = lane & 3;
  bf16x8 pf[2];
#pragma unroll
  for (int s2 = 0; s2 < 2; ++s2) {
    u32x4_t w;
    w[0] = cvtpk(pr[8 * s2 + 0], pr[8 * s2 + 1]); w[1] = cvtpk(pr[8 * s2 + 2], pr[8 * s2 + 3]);
    w[2] = cvtpk(pr[8 * s2 + 4], pr[8 * s2 + 5]); w[3] = cvtpk(pr[8 * s2 + 6], pr[8 * s2 + 7]);
    pf[s2] = __builtin_bit_cast(bf16x8, w);
  }
#pragma unroll
  for (int dt = 0; dt < 2; ++dt)
#pragma unroll
    for (int s2 = 0; s2 < 2; ++s2) {
      const v4i16_t lo = lds_tr(&wt.V[dt][16 * s2 + 4 * hi + q4][16 * g + 4 * p4]);
      const v4i16_t hh = lds_tr(&wt.V[dt][16 * s2 + 8 + 4 * hi + q4][16 * g + 4 * p4]);
      const bf16x8 vf = {lo[0], lo[1], lo[2], lo[3], hh[0], hh[1], hh[2], hh[3]};
      o[dt] = __builtin_amdgcn_mfma_f32_32x32x16_bf16(vf, pf[s2], o[dt], 0, 0, 0);
    }
}
DEV void attn_init(AttnState& st) {
  st.m = -INFINITY; st.l = 0.f;
#pragma unroll
  for (int r = 0; r < 16; ++r) { st.o[0][r] = 0.f; st.o[1][r] = 0.f; }
}
template <bool USE_SEL>
DEV void attn_span(AttnState& st, WaveTile& wt, const bf16x8 (&qf)[4], const u16* Kb, const u16* Vb, int ld,
                   long rowbase, int rowstep, int kcmax, int kc_lo, int kc_hi, int qc, int W,
                   unsigned long long sel, unsigned long long selu, int lane, int qc_min, int qc_max) {
  const int r32 = lane & 31, hi = lane >> 5;
  if (kc_lo < 0) kc_lo = 0;
  if (kc_hi > kcmax) kc_hi = kcmax;
  const int full_hi = qc_min < kcmax ? qc_min : kcmax;
  auto skip = [&](int k0) -> bool { return USE_SEL && !((selu >> (k0 >> 6)) & 1ull); };
  int kc0 = kc_lo & ~31;
  while (kc0 <= kc_hi && skip(kc0)) kc0 += 32;
  if (kc0 > kc_hi) return;
  u32x4_t rk[4], rv[4];
  stage_load(rk, rv, Kb, Vb, ld, rowbase, rowstep, kcmax, kc0, lane);
  for (;;) {
    stage_store(wt, rk, rv, lane);
    int kn = kc0 + 32;
    while (kn <= kc_hi && skip(kn)) kn += 32;
    if (kn <= kc_hi) stage_load(rk, rv, Kb, Vb, ld, rowbase, rowstep, kcmax, kn, lane);
    WAVE_SYNC();
    const f32x16 s = qk_tile(wt, qf, r32, hi);
    const bool selbit = USE_SEL ? (((sel >> (kc0 >> 6)) & 1ull) != 0ull) : true;
    const bool full = (qc_min <= qc_max) && (kc0 + 31 <= full_hi) && (kc0 >= qc_max - W);
    float sv[16]; float mt = -INFINITY;
    if (full) {
      float rm = s[0];
#pragma unroll
      for (int r = 1; r < 16; ++r) rm = fmaxf(rm, s[r]);
      mt = selbit ? rm * SCL2 : -INFINITY;
    } else {
#pragma unroll
      for (int r = 0; r < 16; ++r) {
        const int kc = kc0 + crow(r, hi), dist = qc - kc;
        const bool ok = selbit && kc <= kcmax && dist >= 0 && dist <= W;
        sv[r] = ok ? s[r] * SCL2 : -INFINITY;
        mt = fmaxf(mt, sv[r]);
      }
    }
    mt = fmaxf(mt, __shfl_xor(mt, 32));
    const float mnew = fmaxf(st.m, mt), muse = (mnew == -INFINITY) ? 0.f : mnew;
    const float alpha = __builtin_amdgcn_exp2f(st.m - muse);
    st.m = mnew;
    float ps = 0.f;
    if (full) {
      const float sub = selbit ? muse : INFINITY;
#pragma unroll
      for (int r = 0; r < 16; ++r) { sv[r] = __builtin_amdgcn_exp2f(__builtin_fmaf(s[r], SCL2, -sub)); ps += sv[r]; }
    } else {
#pragma unroll
      for (int r = 0; r < 16; ++r) { sv[r] = __builtin_amdgcn_exp2f(sv[r] - muse); ps += sv[r]; }
    }
    st.l = st.l * alpha + ps;
    if (__any(alpha != 1.f)) {
#pragma unroll
      for (int r = 0; r < 16; ++r) { st.o[0][r] *= alpha; st.o[1][r] *= alpha; }
    }
    pv_tile(wt, sv, st.o, lane);
    if (kn > kc_hi) break;
    kc0 = kn;
  }
}
DEV void attn_finish(AttnState& st, float sink2) {
  float l = st.l + __shfl_xor(st.l, 32);
  if (sink2 > -INFINITY) l += __builtin_amdgcn_exp2f(sink2 - st.m);
  const float inv = l > 0.f ? 1.f / l : 0.f;
#pragma unroll
  for (int r = 0; r < 16; ++r) { st.o[0][r] *= inv; st.o[1][r] *= inv; }
}
DEV void attn_store_bf16(const AttnState& st, u16* orow, int hi) {
#pragma unroll
  for (int dt = 0; dt < 2; ++dt)
#pragma unroll
    for (int k4 = 0; k4 < 4; ++k4) {
      uint2 w; w.x = cvtpk(st.o[dt][4 * k4], st.o[dt][4 * k4 + 1]); w.y = cvtpk(st.o[dt][4 * k4 + 2], st.o[dt][4 * k4 + 3]);
      *reinterpret_cast<uint2*>(orow + 32 * dt + 8 * k4 + 4 * hi) = w;
    }
}
DEV void load_qf(bf16x8 (&qf)[4], const u16* qrow, int hi) {
#pragma unroll
  for (int s = 0; s < 4; ++s) qf[s] = *reinterpret_cast<const bf16x8*>(qrow + 16 * s + 8 * hi);
}

DEV void ph_attn0_mfma(const Params& p, WaveTile* wts) {
  const int tid = tidx(), lane = tid & 63, wid = tid >> 6, r32 = lane & 31, hi = lane >> 5;
  WaveTile& wt = wts[wid];
  const int gw = blockIdx.x * NWAVE + wid, nw = gridDim.x * NWAVE;
  for (int u = gw; u < 8192; u += nw) {
    AttnState st; attn_init(st);
    bf16x8 qf[4];
    if (u < 4096) {
      const int it = u & 7, res = (u >> 3) & 15, h = (u >> 7) & 7, b = u >> 10;
      const int i0 = it * 32, t = 16 * (i0 + r32) + res;
      const long row = (long)b * S_ + t;
      load_qf(qf, p.qkv + row * LD0 + h * 64, hi);
      const u16* Kb = p.qkv + 512 + h * 64; const u16* Vb = p.qkv + 1024 + h * 64;
      attn_span<false>(st, wt, qf, Kb, Vb, LD0, (long)b * S_ + res, 16, 255, i0 - 128, i0 + 31, i0 + r32, 128, 0ull, 0ull, lane, 1, 0);
      const int c = res >> 2;
      attn_span<false>(st, wt, qf, Kb, Vb, LD0, (long)b * S_ + (res & 3), 4, 1023, 4 * i0 + c - 128, 4 * (i0 + 31) + c, 4 * (i0 + r32) + c, 128, 0ull, 0ull, lane, 1, 0);
      attn_span<false>(st, wt, qf, Kb, Vb, LD0, (long)b * S_, 1, 4095, 16 * i0 + res - 128, 16 * (i0 + 31) + res, t, 128, 0ull, 0ull, lane, 1, 0);
      attn_finish(st, -INFINITY);
      attn_store_bf16(st, p.ao + row * D_ + h * 64, hi);
    } else {
      const int v = u - 4096, qt = v & 127, hb = (v >> 7) & 7, b = v >> 10, g = hb >> 2;
      const int t = 32 * qt + r32;
      const long row = (long)b * S_ + t;
      load_qf(qf, p.qkv + row * LD0 + 1536 + hb * 64, hi);
      attn_span<false>(st, wt, qf, p.qkv + 2048 + g * 64, p.qkv + 2176 + g * 64, LD0, (long)b * S_, 1, 4095, 32 * qt - 127, 32 * qt + 31, t, 127, 0ull, 0ull, lane, 32 * qt, 32 * qt + 31);
      attn_finish(st, p.even_sinks[hb] * LOG2E);
      attn_store_bf16(st, p.ao + row * D_ + 512 + hb * 64, hi);
    }
  }
}

struct Att1aSmem { KVTile tiles[2][2]; float imp[NWAVE][32][65]; float sc[NWAVE][64]; };
DEV void ph_attn1a(const Params& p, char* smem) {
  Att1aSmem& sm = *reinterpret_cast<Att1aSmem*>(smem);
  const int tid = tidx(), lane = tid & 63, wid = tid >> 6, r32 = lane & 31, hi = lane >> 5, gl = wid >> 2;
  const int sg = tid >> 8, sj = (tid & 255) >> 3, sc = tid & 7;
  for (int u = blockIdx.x; u < 1024; u += gridDim.x) {
    const int k = u >> 8, base = u & 255, bg = base & 7, x = base >> 3;
    const int qt = (k == 0) ? 127 - x : (k == 1) ? 64 + x : (k == 2) ? 63 - x : x;
    const int b = bg >> 1, gp = bg & 1;
    const int h = gp * 8 + wid, g = h >> 2;
    const int q0 = 32 * qt, t = q0 + r32;
    const long row = (long)b * S_ + t;
    const int qc = (t - 31) >> 4;
    int kc_hi = q0 >> 4; kc_hi = kc_hi > 254 ? 254 : kc_hi;
    const int ntile = (kc_hi >> 5) + 1;
    const u16* kp = p.cmpkv + ((size_t)((b * 4 + 2 * gp + sg) * 256) + sj) * 64 + sc * 8;
    const u16* vp = kp + (size_t)4096 * 64;
    for (int i = tid; i < NWAVE * 32 * 65; i += NTHR) (&sm.imp[0][0][0])[i] = 0.f;
    bf16x8 qf[4];
    load_qf(qf, p.qkv + row * LD1 + h * 64, hi);
    auto for_tiles = [&](auto&& body) {
      u32x4_t rk = *reinterpret_cast<const u32x4_t*>(kp), rv = *reinterpret_cast<const u32x4_t*>(vp);
      int cur = 0;
      for (int tt = 0; tt < ntile; ++tt) {
        KVTile& dst = sm.tiles[cur][sg];
        *reinterpret_cast<u32x4_t*>(&dst.K[sj][sc * 8]) = rk;
        *reinterpret_cast<u32x4_t*>(&dst.V[sc >> 2][sj][(sc & 3) * 8]) = rv;
        const int tn = tt + 1 < ntile ? tt + 1 : tt;
        rk = *reinterpret_cast<const u32x4_t*>(kp + (size_t)tn * 32 * 64);
        rv = *reinterpret_cast<const u32x4_t*>(vp + (size_t)tn * 32 * 64);
        __syncthreads();
        body(sm.tiles[cur][gl], tt * 32);
        cur ^= 1;
      }
      __syncthreads();
    };
    float m = -INFINITY, l = 0.f;
    for_tiles([&](const KVTile& tl, int kc0) {
      const f32x16 s = qk_tile(tl, qf, r32, hi);
      float sv[16]; float mt = -INFINITY;
#pragma unroll
      for (int rr = 0; rr < 16; ++rr) { const int kc = kc0 + crow(rr, hi); const bool ok = kc <= 254 && kc <= qc; sv[rr] = ok ? s[rr] * SCL2 : -INFINITY; mt = fmaxf(mt, sv[rr]); }
      mt = fmaxf(mt, __shfl_xor(mt, 32));
      const float mnew = fmaxf(m, mt), muse = (mnew == -INFINITY) ? 0.f : mnew;
      float ps = 0.f;
#pragma unroll
      for (int rr = 0; rr < 16; ++rr) ps += __builtin_amdgcn_exp2f(sv[rr] - muse);
      l = l * __builtin_amdgcn_exp2f(m - muse) + ps; m = mnew;
    });
    l += __shfl_xor(l, 32);
    const float inv = l > 0.f ? 1.f / l : 0.f, muse = (m == -INFINITY) ? 0.f : m;
    f32x16 o[2];
#pragma unroll
    for (int rr = 0; rr < 16; ++rr) { o[0][rr] = 0.f; o[1][rr] = 0.f; }
    for_tiles([&](const KVTile& tl, int kc0) {
      const f32x16 s = qk_tile(tl, qf, r32, hi);
      float pr[16];
#pragma unroll
      for (int rr = 0; rr < 16; ++rr) { const int kc = kc0 + crow(rr, hi); const bool ok = kc <= 254 && kc <= qc; pr[rr] = ok ? __builtin_amdgcn_exp2f(s[rr] * SCL2 - muse) * inv : 0.f; }
#pragma unroll
      for (int k4 = 0; k4 < 4; ++k4) {
        const int j = (kc0 >> 2) + 2 * k4 + hi;
        sm.imp[wid][r32][j] += pr[4 * k4] + pr[4 * k4 + 1] + pr[4 * k4 + 2] + 0.5f * pr[4 * k4 + 3];
        WAVE_SYNC();
        if (j + 1 < 64) sm.imp[wid][r32][j + 1] += 0.5f * pr[4 * k4 + 3];
        WAVE_SYNC();
      }
      pv_tile(tl, pr, o, lane);
    });
    const float g0 = p.gates[(size_t)row * 48 + h * 3];
#pragma unroll
    for (int dt = 0; dt < 2; ++dt)
#pragma unroll
      for (int k4 = 0; k4 < 4; ++k4) {
        float4 w; w.x = g0 * o[dt][4 * k4]; w.y = g0 * o[dt][4 * k4 + 1]; w.z = g0 * o[dt][4 * k4 + 2]; w.w = g0 * o[dt][4 * k4 + 3];
        *reinterpret_cast<float4*>(p.hpre + (size_t)row * D_ + h * 64 + 32 * dt + 8 * k4 + 4 * hi) = w;
      }
    for (int i = 0; i < 8; ++i) {
      const int pi = wid * 8 + i, grp = pi >> 5, q = pi & 31;
      const int tq = q0 + q, cur = tq >> 6;
      const float impq = (sm.imp[4 * grp][q][lane] + sm.imp[4 * grp + 1][q][lane]) + (sm.imp[4 * grp + 2][q][lane] + sm.imp[4 * grp + 3][q][lane]);
      const float score = (lane > cur) ? -1.f : ((lane == 0 || lane == cur || lane == cur - 1) ? 1.0e4f : impq);
      sm.sc[wid][lane] = score;
      WAVE_SYNC();
      int rk_ = 0;
#pragma unroll
      for (int jj = 0; jj < 64; jj += 4) {
        const float4 v = *reinterpret_cast<const float4*>(&sm.sc[wid][jj]);
        rk_ += (v.x > score || (v.x == score && jj < lane)) ? 1 : 0;
        rk_ += (v.y > score || (v.y == score && jj + 1 < lane)) ? 1 : 0;
        rk_ += (v.z > score || (v.z == score && jj + 2 < lane)) ? 1 : 0;
        rk_ += (v.w > score || (v.w == score && jj + 3 < lane)) ? 1 : 0;
      }
      WAVE_SYNC();
      const unsigned long long mask = __ballot(rk_ < 16 && lane <= cur);
      if (lane == 0) p.selmask[((size_t)b * S_ + tq) * 4 + 2 * gp + grp] = mask;
    }
    __syncthreads();
  }
}

template <class TT>
DEV void attn_tile_update(AttnState& st, const TT& tl, const bf16x8 (&qf)[4], int kc0, int qc, int W, int kcmax, bool selbit, bool full, int lane) {
  const int r32 = lane & 31, hi = lane >> 5;
  const f32x16 s = qk_tile(tl, qf, r32, hi);
  float sv[16]; float mt = -INFINITY;
  if (full) {
    float rm = s[0];
#pragma unroll
    for (int r = 1; r < 16; ++r) rm = fmaxf(rm, s[r]);
    mt = selbit ? rm * SCL2 : -INFINITY;
  } else {
#pragma unroll
    for (int r = 0; r < 16; ++r) {
      const int kc = kc0 + crow(r, hi), dist = qc - kc;
      const bool ok = selbit && kc <= kcmax && dist >= 0 && dist <= W;
      sv[r] = ok ? s[r] * SCL2 : -INFINITY;
      mt = fmaxf(mt, sv[r]);
    }
  }
  mt = fmaxf(mt, __shfl_xor(mt, 32));
  const float mnew = fmaxf(st.m, mt), muse = (mnew == -INFINITY) ? 0.f : mnew;
  const float alpha = __builtin_amdgcn_exp2f(st.m - muse);
  st.m = mnew;
  float ps = 0.f;
  if (full) {
    const float sub = selbit ? muse : INFINITY;
#pragma unroll
    for (int r = 0; r < 16; ++r) { sv[r] = __builtin_amdgcn_exp2f(__builtin_fmaf(s[r], SCL2, -sub)); ps += sv[r]; }
  } else {
#pragma unroll
    for (int r = 0; r < 16; ++r) { sv[r] = __builtin_amdgcn_exp2f(sv[r] - muse); ps += sv[r]; }
  }
  st.l = st.l * alpha + ps;
  if (__any(alpha != 1.f)) {
#pragma unroll
    for (int r = 0; r < 16; ++r) { st.o[0][r] *= alpha; st.o[1][r] *= alpha; }
  }
  pv_tile(tl, sv, st.o, lane);
}

template <bool USE_SEL>
DEV void attn_span_shared(AttnState& st, KVTile (*tiles)[2][2], const Params& p, const bf16x8 (&qf)[4], int b, int gp, int kcol, int vcol,
                          int t_lo, int t_hi, int qc, int W, unsigned long long sel, int q0) {
  const int tid = tidx(), lane = tid & 63, wid = tid >> 6, gl = wid >> 2;
  const int sg = tid >> 8, sj = (tid & 255) >> 3, sc = tid & 7;
  const u16* kp = p.qkv + (size_t)b * S_ * LD1 + kcol + (2 * gp + sg) * 64 + (size_t)sj * LD1 + sc * 8;
  const u16* vp = p.qkv + (size_t)b * S_ * LD1 + vcol + (2 * gp + sg) * 64 + (size_t)sj * LD1 + sc * 8;
  const int s_lo = t_lo >> 1, s_hi = t_hi >> 1;
  u32x4_t rk[2], rv[2];
#pragma unroll
  for (int h = 0; h < 2; ++h) {
    rk[h] = *reinterpret_cast<const u32x4_t*>(kp + (size_t)(2 * s_lo + h) * 32 * LD1);
    rv[h] = *reinterpret_cast<const u32x4_t*>(vp + (size_t)(2 * s_lo + h) * 32 * LD1);
  }
  int cur = 0;
  for (int sidx = s_lo; sidx <= s_hi; ++sidx) {
#pragma unroll
    for (int h = 0; h < 2; ++h) {
      KVTile& dst = tiles[cur][sg][h];
      *reinterpret_cast<u32x4_t*>(&dst.K[sj][sc * 8]) = rk[h];
      *reinterpret_cast<u32x4_t*>(&dst.V[sc >> 2][sj][(sc & 3) * 8]) = rv[h];
    }
    const int sn = sidx < s_hi ? sidx + 1 : sidx;
#pragma unroll
    for (int h = 0; h < 2; ++h) {
      rk[h] = *reinterpret_cast<const u32x4_t*>(kp + (size_t)(2 * sn + h) * 32 * LD1);
      rv[h] = *reinterpret_cast<const u32x4_t*>(vp + (size_t)(2 * sn + h) * 32 * LD1);
    }
    __syncthreads();
#pragma unroll
    for (int h = 0; h < 2; ++h) {
      const int t = 2 * sidx + h;
      if (t >= t_lo && t <= t_hi) {
        const int kc0 = t * 32;
        const bool selbit = USE_SEL ? (((sel >> (kc0 >> 6)) & 1ull) != 0ull) : true;
        const bool full = (kc0 + 31 <= q0) && (kc0 >= q0 + 31 - W);
        attn_tile_update(st, tiles[cur][gl][h], qf, kc0, qc, W, 4095, selbit, full, lane);
      }
    }
    cur ^= 1;
  }
  __syncthreads();
}

DEV void ph_attn1b(const Params& p, char* smem) {
  KVTile (*tiles)[2][2] = reinterpret_cast<KVTile (*)[2][2]>(smem);
  const int tid = tidx(), lane = tid & 63, wid = tid >> 6, r32 = lane & 31, hi = lane >> 5;
  for (int u = blockIdx.x; u < 1024; u += gridDim.x) {
    const int k = u >> 8, base = u & 255, bg = base & 7, x = base >> 3;
    const int qt = (k == 0) ? 127 - x : (k == 1) ? 64 + x : (k == 2) ? 63 - x : x;
    const int b = bg >> 1, gp = bg & 1;
    const int h = gp * 8 + wid, g = h >> 2;
    const int q0 = 32 * qt, t = q0 + r32;
    const long row = (long)b * S_ + t;
    bf16x8 qf[4];
    load_qf(qf, p.qkv + row * LD1 + h * 64, hi);
    const unsigned long long sel = p.selmask[(size_t)row * 4 + g];
    const float g1 = p.gates[(size_t)row * 48 + h * 3 + 1], g2 = p.gates[(size_t)row * 48 + h * 3 + 2];
    AttnState st; attn_init(st);
    attn_span_shared<true>(st, tiles, p, qf, b, gp, 1536, 1792, 0, qt, t, 1 << 30, sel, q0);
    attn_finish(st, -INFINITY);
    f32x16 acc[2];
#pragma unroll
    for (int rr = 0; rr < 16; ++rr) { acc[0][rr] = g1 * st.o[0][rr]; acc[1][rr] = g1 * st.o[1][rr]; }
    attn_init(st);
    const int wlo = q0 - 511 > 0 ? (q0 - 511) >> 5 : 0;
    attn_span_shared<false>(st, tiles, p, qf, b, gp, 2048, 2304, wlo, qt, t, 511, 0ull, q0);
    attn_finish(st, -INFINITY);
#pragma unroll
    for (int dt = 0; dt < 2; ++dt)
#pragma unroll
      for (int k4 = 0; k4 < 4; ++k4) {
        const float4 c = *reinterpret_cast<const float4*>(p.hpre + (size_t)row * D_ + h * 64 + 32 * dt + 8 * k4 + 4 * hi);
        uint2 w;
        w.x = cvtpk(c.x + acc[dt][4 * k4] + g2 * st.o[dt][4 * k4], c.y + acc[dt][4 * k4 + 1] + g2 * st.o[dt][4 * k4 + 1]);
        w.y = cvtpk(c.z + acc[dt][4 * k4 + 2] + g2 * st.o[dt][4 * k4 + 2], c.w + acc[dt][4 * k4 + 3] + g2 * st.o[dt][4 * k4 + 3]);
        *reinterpret_cast<uint2*>(p.ao + (size_t)row * D_ + h * 64 + 32 * dt + 8 * k4 + 4 * hi) = w;
      }
  }
}

enum { PH_PRO = 0, PH_IN0, PH_ATT0, PH_OUT0, PH_LN0, PH_RG0, PH_RT0, PH_M10, PH_M20, PH_CB0,
       PH_IN1, PH_C1, PH_C2, PH_ATT1A, PH_ATT1B, PH_OUT1, PH_LN1, PH_RG1, PH_RT1, PH_M11, PH_M21, PH_CB1 };

template <int PH> DEV void run_phase(const Params& p, char* smem) {
  GemmSmem& gs = *reinterpret_cast<GemmSmem*>(smem);
  WaveTile* wts = reinterpret_cast<WaveTile*>(smem);
  MoeTab& mt = *reinterpret_cast<MoeTab*>(smem + sizeof(GemmSmem));
  if constexpr (PH == PH_PRO) ph_prologue(p);
  else if constexpr (PH == PH_IN0) ph_inproj0(p, gs);
  else if constexpr (PH == PH_ATT0) ph_attn0_mfma(p, wts);
  else if constexpr (PH == PH_OUT0) ph_outproj(p, gs, p.w16_out0, p.x);
  else if constexpr (PH == PH_LN0) ph_ln_mix(p, p.mix_g, p.mix_b);
  else if constexpr (PH == PH_RG0) ph_router_gemm(p, smem, p.rw16);
  else if constexpr (PH == PH_RT0) ph_route(p, p.router_b, p.cnt, p.etok);
  else if constexpr (PH == PH_M10) ph_moe1(p, gs, mt, 0, p.cnt);
  else if constexpr (PH == PH_M20) ph_moe2(p, gs, mt, 0, p.cnt);
  else if constexpr (PH == PH_CB0) ph_combine_ln(p, mt, p.cnt, p.ffn_g, p.ffn_b, p.x2f, p.xb, true);
  else if constexpr (PH == PH_IN1) ph_inproj1(p, gs);
  else if constexpr (PH == PH_C1) ph_cmp1(p, gs);
  else if constexpr (PH == PH_C2) ph_cmp2(p, gs);
  else if constexpr (PH == PH_ATT1A) ph_attn1a(p, smem);
  else if constexpr (PH == PH_ATT1B) ph_attn1b(p, smem);
  else if constexpr (PH == PH_OUT1) ph_outproj(p, gs, p.w16_out1, p.x2f);
  else if constexpr (PH == PH_LN1) ph_ln_mix(p, p.mix_g + D_, p.mix_b + D_);
  else if constexpr (PH == PH_RG1) ph_router_gemm(p, smem, p.rw16 + (size_t)2 * D_ * NE);
  else if constexpr (PH == PH_RT1) ph_route(p, p.router_b + NE, p.cnt + 512, p.etok);
  else if constexpr (PH == PH_M11) ph_moe1(p, gs, mt, 1, p.cnt + 512);
  else if constexpr (PH == PH_M21) ph_moe2(p, gs, mt, 1, p.cnt + 512);
  else if constexpr (PH == PH_CB1) ph_combine_ln(p, mt, p.cnt + 512, p.ffn_g + D_, p.ffn_b + D_, p.out, p.xb, true, false);
}

constexpr int SMEM_NEED0 = (NWAVE * (int)sizeof(WaveTile) > (int)(sizeof(GemmSmem) + sizeof(MoeTab))) ? NWAVE * (int)sizeof(WaveTile) : (int)(sizeof(GemmSmem) + sizeof(MoeTab));
constexpr int SMEM_NEED1 = SMEM_NEED0 > (int)sizeof(RouterSmem) ? SMEM_NEED0 : (int)sizeof(RouterSmem);
constexpr int SMEM_NEED2 = SMEM_NEED1 > (int)sizeof(Att1aSmem) ? SMEM_NEED1 : (int)sizeof(Att1aSmem);
constexpr int SMEM_NEED = SMEM_NEED2 > 8 * (int)sizeof(KVTile) ? SMEM_NEED2 : 8 * (int)sizeof(KVTile);
constexpr int SMEM_BAR_OFF = (SMEM_NEED + 15) & ~15, SMEM_BYTES = SMEM_BAR_OFF + 16;
template <int PH, bool LAST> DEV void phase_and_sync(const Params& p, char* smem, const XcdBarrier& bar) {
  run_phase<PH>(p, smem);
  if constexpr (!LAST) xcd_barrier(bar);
}
template <int... PHS> struct PhaseList {};
template <int P0> DEV void run_list(const Params& p, char* smem, const XcdBarrier& bar, PhaseList<P0>) { phase_and_sync<P0, true>(p, smem, bar); }
template <int P0, int P1, int... REST> DEV void run_list(const Params& p, char* smem, const XcdBarrier& bar, PhaseList<P0, P1, REST...>) {
  phase_and_sync<P0, false>(p, smem, bar);
  run_list(p, smem, bar, PhaseList<P1, REST...>{});
}
using Program = PhaseList<PH_PRO, PH_IN0, PH_ATT0, PH_OUT0, PH_LN0, PH_RG0, PH_RT0, PH_M10, PH_M20, PH_CB0,
                          PH_IN1, PH_C1, PH_C2, PH_ATT1A, PH_ATT1B, PH_OUT1, PH_LN1, PH_RG1, PH_RT1, PH_M11, PH_M21, PH_CB1>;
struct KArgs { const void* in[25]; float* out; char* ws; };
constexpr size_t al256(size_t b) { return (b + 255) & ~(size_t)255; }
constexpr size_t OFF_BAR = 0;
constexpr size_t OFF_CNT = OFF_BAR + al256(16384);
constexpr size_t OFF_PB = OFF_CNT + al256(4096);
constexpr size_t OFF_ZERO_END = OFF_PB + al256(1024);
constexpr size_t OFF_CS = OFF_ZERO_END;
constexpr size_t OFF_XB = OFF_CS + al256((size_t)T_ * 16 * 4);
constexpr size_t OFF_QKV = OFF_XB + al256((size_t)T_ * D_ * 2);
constexpr size_t OFF_GATES = OFF_QKV + al256((size_t)T_ * 2624 * 2);
constexpr size_t OFF_AO = OFF_GATES + al256((size_t)T_ * 48 * 4);
constexpr size_t OFF_HPRE = OFF_AO + al256((size_t)T_ * D_ * 2);
constexpr size_t OFF_X1B = OFF_HPRE + al256((size_t)T_ * D_ * 4);
constexpr size_t OFF_X1LO = OFF_X1B + al256((size_t)T_ * D_ * 2);
constexpr size_t OFF_LOGITS = OFF_X1LO + al256((size_t)T_ * D_ * 2);
constexpr size_t OFF_EIDX = OFF_LOGITS + al256((size_t)T_ * NE * 4);
constexpr size_t OFF_GATEV = OFF_EIDX + al256((size_t)NASG * 4);
constexpr size_t OFF_EPOS = OFF_GATEV + al256((size_t)NASG * 4);
constexpr size_t OFF_ETOK = OFF_EPOS + al256((size_t)NASG * 4);
constexpr size_t OFF_HBUF = OFF_ETOK + al256((size_t)NE * T_ * 4);
constexpr size_t OFF_YBUF = OFF_HBUF + al256((size_t)NROWS * 256 * 2);
constexpr size_t OFF_X2F = OFF_YBUF + al256((size_t)NROWS * D_ * 2);
constexpr size_t OFF_HID = OFF_X2F + al256((size_t)T_ * D_ * 4);
constexpr size_t OFF_CMPKV = OFF_HID + al256((size_t)2 * 4096 * 128 * 2);
constexpr size_t OFF_SELMASK = OFF_CMPKV + al256((size_t)2 * 4096 * 64 * 2);
constexpr size_t OFF_W16IN0 = OFF_SELMASK + al256((size_t)T_ * 4 * 8);
constexpr size_t OFF_W16OUT0 = OFF_W16IN0 + al256((size_t)D_ * LD0 * 2);
constexpr size_t OFF_W16IN1 = OFF_W16OUT0 + al256((size_t)D_ * D_ * 2);
constexpr size_t OFF_W16OUT1 = OFF_W16IN1 + al256((size_t)D_ * NIN1 * 2);
constexpr size_t OFF_RW16 = OFF_W16OUT1 + al256((size_t)D_ * D_ * 2);
constexpr size_t WS_NEEDED = OFF_RW16 + al256((size_t)4 * D_ * NE * 2);

DEV Params make_params(const KArgs& k) {
  Params p;
  p.x = (const float*)k.in[0]; p.pos = (const int*)k.in[1];
  p.even_w_in = (const float*)k.in[2]; p.even_sinks = (const float*)k.in[3]; p.even_w_out = (const float*)k.in[4]; p.odd_w_in = (const float*)k.in[5];
  p.cmpk_pos = (const float*)k.in[6]; p.cmpk_w1 = (const float*)k.in[7]; p.cmpk_w2 = (const float*)k.in[8];
  p.cmpv_pos = (const float*)k.in[9]; p.cmpv_w1 = (const float*)k.in[10]; p.cmpv_w2 = (const float*)k.in[11];
  p.odd_w_out = (const float*)k.in[12]; p.mix_g = (const float*)k.in[13]; p.mix_b = (const float*)k.in[14];
  p.router_w = (const float*)k.in[15]; p.router_b = (const float*)k.in[16];
  p.w_gate = (const float*)k.in[17]; p.w_up = (const float*)k.in[18]; p.w_down = (const float*)k.in[19];
  p.sh_gate = (const float*)k.in[20]; p.sh_up = (const float*)k.in[21]; p.sh_down = (const float*)k.in[22];
  p.ffn_g = (const float*)k.in[23]; p.ffn_b = (const float*)k.in[24];
  p.out = k.out;
  char* w = k.ws;
  p.bar = (unsigned*)(w + OFF_BAR); p.cnt = (int*)(w + OFF_CNT); p.pb = (float*)(w + OFF_PB);
  p.cs = (float*)(w + OFF_CS); p.xb = (u16*)(w + OFF_XB); p.qkv = (u16*)(w + OFF_QKV); p.gates = (float*)(w + OFF_GATES);
  p.ao = (u16*)(w + OFF_AO); p.hpre = (float*)(w + OFF_HPRE); p.x1b = (u16*)(w + OFF_X1B); p.x1lo = (u16*)(w + OFF_X1LO);
  p.logits = (float*)(w + OFF_LOGITS); p.eidx = (int*)(w + OFF_EIDX); p.gatev = (float*)(w + OFF_GATEV); p.epos = (int*)(w + OFF_EPOS); p.etok = (int*)(w + OFF_ETOK);
  p.hbuf = (u16*)(w + OFF_HBUF); p.ybuf = (u16*)(w + OFF_YBUF); p.x2f = (float*)(w + OFF_X2F); p.hid = (u16*)(w + OFF_HID); p.cmpkv = (u16*)(w + OFF_CMPKV);
  p.selmask = (unsigned long long*)(w + OFF_SELMASK);
  p.w16_in0 = (u16*)(w + OFF_W16IN0); p.w16_out0 = (u16*)(w + OFF_W16OUT0); p.w16_in1 = (u16*)(w + OFF_W16IN1); p.w16_out1 = (u16*)(w + OFF_W16OUT1); p.rw16 = (u16*)(w + OFF_RW16);
  return p;
}

__global__ void __launch_bounds__(NTHR, 2) k_fused(KArgs ka) {
  extern __shared__ __attribute__((aligned(16))) char smem[];
  const Params p = make_params(ka);
  if (tidx() == 0) *reinterpret_cast<uint4*>(smem + SMEM_BAR_OFF) = make_uint4(0u, 0u, 0u, 0u);
  __syncthreads();
  XcdBarrier bar = xcd_barrier_post(p.bar, (volatile LAS unsigned*)(smem + SMEM_BAR_OFF));
  run_list(p, smem, bar, Program{});
}

extern "C" void kernel_launch(void* const* d_in, const int* in_sizes, int n_in, void* d_out, int out_size, void* d_ws, size_t ws_size, hipStream_t stream) {
  (void)in_sizes; (void)n_in; (void)out_size;
  if (ws_size < WS_NEEDED) return;
  KArgs ka{};
  for (int i = 0; i < 25; ++i) ka.in[i] = d_in[i];
  ka.out = (float*)d_out; ka.ws = (char*)d_ws;
  hipMemsetAsync(d_ws, 0, OFF_ZERO_END, stream);
  static int grid = 0;
  if (!grid) {
    int dev = 0, cus = 0, per_cu = 0;
    hipGetDevice(&dev);
    hipDeviceGetAttribute(&cus, hipDeviceAttributeMultiprocessorCount, dev);
    hipFuncSetAttribute((const void*)k_fused, hipFuncAttributeMaxDynamicSharedMemorySize, SMEM_BYTES);
    hipOccupancyMaxActiveBlocksPerMultiprocessor(&per_cu, (const void*)k_fused, NTHR, SMEM_BYTES);
    if (per_cu > 1) per_cu = 1;
    if (per_cu < 1) per_cu = 1;
    grid = cus * per_cu;
  }
  hipLaunchKernelGGL(k_fused, dim3(grid), dim3(NTHR), SMEM_BYTES, stream, ka);
}
```

```cpp
#include <hip/hip_runtime.h>
#include <hip/hip_bf16.h>
#include <stdint.h>
#include <math.h>
#include <utility>

typedef unsigned short u16;
using bf16x8 = __attribute__((ext_vector_type(8))) short;
using f32x4  = __attribute__((ext_vector_type(4))) float;

#define DEV __device__ __forceinline__
__device__ __forceinline__ int tidx() { int t = (int)__builtin_amdgcn_workitem_id_x(); asm volatile("" : "+v"(t)); return t; }

constexpr int T_ = 16384, S_ = 4096, D_ = 1024;
constexpr int LD0 = 2304, LD1 = 2560, NIN1 = 2608;
constexpr int NE = 256, TOPK = 8, NASG = T_ * TOPK, NROWS = NASG + T_;
constexpr float ALPHA = 1.41421356237309515f;
constexpr float LN_EPS = 1e-5f;
constexpr int NTHR = 512, NWAVE = 8;


struct Params {
  const float* x; const int* pos;
  const float* even_w_in; const float* even_sinks; const float* even_w_out; const float* odd_w_in;
  const float* cmpk_pos; const float* cmpk_w1; const float* cmpk_w2; const float* cmpv_pos; const float* cmpv_w1; const float* cmpv_w2;
  const float* odd_w_out; const float* mix_g; const float* mix_b; const float* router_w; const float* router_b;
  const float* w_gate; const float* w_up; const float* w_down; const float* sh_gate; const float* sh_up; const float* sh_down;
  const float* ffn_g; const float* ffn_b;
  float* out;
  unsigned* bar; int* cnt; float* pb; float* cs; u16* xb; u16* qkv; float* gates; u16* ao; float* hpre;
  u16* x1b; u16* x1lo; float* logits; int* eidx; float* gatev; int* epos; int* etok;
  u16* hbuf; u16* ybuf; float* x2f; u16* hid; u16* cmpkv; unsigned long long* selmask;
  u16* w16_in0; u16* w16_out0; u16* w16_in1; u16* w16_out1; u16* rw16;
};

#define XB_TMO      128
#define XB_XCNT(j)  (256  + 64 * (j))
#define XB_XSUB(j)  (1280 + 64 * (j))
#define XB_XGEN(j)  (2304 + 64 * (j))
#define XB_TOP      3328
#define XB_TOPGEN   3392
#define XCD_BAR_WORDS 3456
#define XB_SPIN_CAP (1u << 18)
#define LAS __attribute__((address_space(3)))

__device__ __forceinline__ unsigned xb_ld(unsigned* p)              { return __hip_atomic_load(p, __ATOMIC_RELAXED, __HIP_MEMORY_SCOPE_AGENT); }
__device__ __forceinline__ unsigned xb_add(unsigned* p, unsigned v) { return __hip_atomic_fetch_add(p, v, __ATOMIC_RELAXED, __HIP_MEMORY_SCOPE_AGENT); }
__device__ __forceinline__ unsigned xb_xcc_id() { return (unsigned)__builtin_amdgcn_s_getreg((3 << 11) | 20) & 0xFu; }
#define XB_SPIN(cond, bar) do { unsigned _sp = 0; while (cond) { __builtin_amdgcn_s_sleep(1); \
    if ((++_sp & 255u) == 0u) { if (xb_ld(&(bar)[XB_TMO])) break; if (_sp > XB_SPIN_CAP) { atomicAdd(&(bar)[XB_TMO], 1u); break; } } } } while (0)

struct XcdBarrier {
    unsigned* bar; unsigned x;
    volatile LAS unsigned* st;
};

__device__ __forceinline__ XcdBarrier xcd_barrier_post(unsigned* bar, volatile LAS unsigned* st) {
    XcdBarrier b; b.bar = bar; b.x = xb_xcc_id(); b.st = st;
    if (tidx() == 0) (void)xb_add(&bar[XB_XCNT(b.x)], 1u);
    return b;
}
__device__ __forceinline__ void xcd_barrier_complete(unsigned* bar, unsigned x, unsigned& nloc, unsigned& nx) {
    const unsigned G = gridDim.x * gridDim.y * gridDim.z;
    unsigned sum, cnt, mine, sp = 0u;
    for (;;) {
        sum = 0u; cnt = 0u; mine = 0u;
#pragma unroll
        for (unsigned j = 0; j < 16; ++j) { const unsigned c = xb_ld(&bar[XB_XCNT(j)]); sum += c; cnt += (c > 0u) ? 1u : 0u; mine = (j == x) ? c : mine; }
        if (sum == G) break;
        __builtin_amdgcn_s_sleep(1);
        if ((++sp & 255u) == 0u) { if (xb_ld(&bar[XB_TMO])) break; if (sp > XB_SPIN_CAP) { atomicAdd(&bar[XB_TMO], 1u); break; } }
    }
    nloc = mine > 0u ? mine : 1u; nx = cnt > 0u ? cnt : 1u;
}

__device__ __forceinline__ void xcd_barrier(const XcdBarrier& b) {
    asm volatile("s_waitcnt vmcnt(0)" ::: "memory");
    __syncthreads();
    if (tidx() == 0) {
        unsigned* bar = b.bar;
        __builtin_amdgcn_s_waitcnt(0);
        unsigned nloc = b.st[0], nx = b.st[1];
        if (nloc == 0u) { xcd_barrier_complete(bar, b.x, nloc, nx); b.st[0] = nloc; b.st[1] = nx; }
        const unsigned old = xb_add(&bar[XB_XSUB(b.x)], 1u);
        const unsigned gen = old / nloc;
        if (old + 1u == (gen + 1u) * nloc) {
            __builtin_amdgcn_fence(__ATOMIC_RELEASE, "agent");
            asm volatile("s_waitcnt vmcnt(0)" ::: "memory");
            const unsigned og = xb_add(&bar[XB_TOP], 1u);
            const unsigned tg = og / nx;
            if (og + 1u == (tg + 1u) * nx) xb_add(&bar[XB_TOPGEN], 1u);
            else XB_SPIN(xb_ld(&bar[XB_TOPGEN]) == tg, bar);
            __builtin_amdgcn_fence(__ATOMIC_ACQUIRE, "agent");
            xb_add(&bar[XB_XGEN(b.x)], 1u);
            asm volatile("s_waitcnt vmcnt(0)" ::: "memory");
        } else {
            XB_SPIN(xb_ld(&bar[XB_XGEN(b.x)]) == gen, bar);
            __builtin_amdgcn_fence(__ATOMIC_ACQUIRE, "agent");
            asm volatile("s_waitcnt vmcnt(0)" ::: "memory");
        }
    }
    __syncthreads();
}


DEV float bf2f(u16 h) { return __uint_as_float(((unsigned)h) << 16); }
DEV float bflo(unsigned w) { return __uint_as_float(w << 16); }
DEV float bfhi(unsigned w) { return __uint_as_float(w & 0xffff0000u); }
DEV float wave_max(float v) { for (int o = 32; o; o >>= 1) v = fmaxf(v, __shfl_xor(v, o)); return v; }
DEV float wave_sum(float v) { for (int o = 32; o; o >>= 1) v += __shfl_xor(v, o); return v; }
#define WAVE_SYNC() asm volatile("s_waitcnt lgkmcnt(0)" ::: "memory")

typedef short v4i16_t __attribute__((ext_vector_type(4)));
typedef float f32x2_t __attribute__((ext_vector_type(2)));
typedef __bf16 bf16x2_t __attribute__((ext_vector_type(2)));
typedef unsigned u32x4_t __attribute__((ext_vector_type(4)));
typedef unsigned u32x2_t __attribute__((ext_vector_type(2)));
typedef float f32x4_t __attribute__((ext_vector_type(4)));
DEV unsigned cvtpk(float lo, float hi) { f32x2_t v = {lo, hi}; bf16x2_t b = __builtin_convertvector(v, bf16x2_t); return __builtin_bit_cast(unsigned, b); }
DEV v4i16_t lds_tr(const u16* ptr) { return __builtin_amdgcn_ds_read_tr16_b64_v4i16((LAS v4i16_t*)ptr); }

struct GemmSmem { u16 A[2][320][72]; u16 B[2][64][128]; };
DEV int bswz(int k) { return (k & 3) | (((k >> 3) & 1) << 2); }

template <int MI, bool SPLIT, bool B16 = false, class FA, class FB, class FL, class FE>
DEV void gemm_core(GemmSmem& sm, int nk, FA a_addr, FB b_addr, int ldb, FL b_lo, FE epi, bool b_ok = true) {
  const int tid = tidx(), lane = tid & 63, wid = tid >> 6;
  const int wr = wid >> 1, wc = wid & 1, fr = lane & 15, fq = lane >> 4;
  const int n4 = tid & 31, kq = tid >> 5, q4 = (lane & 15) >> 2, p4 = lane & 3;
  f32x4 acc[MI][4];
#pragma unroll
  for (int mi = 0; mi < MI; ++mi)
#pragma unroll
    for (int ni = 0; ni < 4; ++ni) acc[mi][ni] = f32x4{0.f, 0.f, 0.f, 0.f};
  static_assert(MI == 2 || MI == 4, "two register sets");
  u32x4_t ra[2][MI]; f32x4_t rb[2][4]; u32x4_t rh[2][2];
  auto gload = [&](auto PC, int kt) {
    constexpr int P = decltype(PC)::value;
#pragma unroll
    for (int i = 0; i < MI; ++i) ra[P][i] = *reinterpret_cast<const u32x4_t*>(a_addr(i, kt));
    if constexpr (B16) {
      const u16* bp = b_addr(kt);
      rh[P][0] = *reinterpret_cast<const u32x4_t*>(bp);
      rh[P][1] = *reinterpret_cast<const u32x4_t*>(bp + (size_t)32 * ldb);
    } else {
      const float* bp = b_addr(kt);
#pragma unroll
      for (int i = 0; i < 4; ++i) rb[P][i] = *reinterpret_cast<const f32x4_t*>(bp + (size_t)(16 * i) * ldb);
    }
  };
  constexpr int NB = B16 ? 2 : 4;
  auto storeA = [&](auto PC, int i) {
    constexpr int P = decltype(PC)::value;
    *reinterpret_cast<u32x4_t*>(&sm.A[P][(tid >> 3) + 64 * i][(tid & 7) * 8]) = ra[P][i];
  };
  auto storeB = [&](auto PC, int i, int kt) {
    constexpr int P = decltype(PC)::value;
    if constexpr (B16) {
      u32x4_t w = rh[P][i];
      if (!b_ok) w = u32x4_t{0u, 0u, 0u, 0u};
      const int k = (tid >> 4) + 32 * i, n8 = tid & 15;
      *reinterpret_cast<u32x4_t*>(&sm.B[P][k][(((n8 >> 1) ^ bswz(k)) << 4) + (n8 & 1) * 8]) = w;
    } else {
      const bool lo = SPLIT ? b_lo(kt) : false;
      f32x4_t v = rb[P][i];
      if (!b_ok) v = f32x4_t{0.f, 0.f, 0.f, 0.f};
      if (SPLIT && lo) {
        const unsigned h0 = cvtpk(v[0], v[1]), h1 = cvtpk(v[2], v[3]);
        v[0] -= __uint_as_float(h0 << 16); v[1] -= __uint_as_float(h0 & 0xffff0000u); v[2] -= __uint_as_float(h1 << 16); v[3] -= __uint_as_float(h1 & 0xffff0000u);
      }
      u32x2_t w; w[0] = cvtpk(v[0], v[1]); w[1] = cvtpk(v[2], v[3]);
      const int k = kq + 16 * i;
      *reinterpret_cast<u32x2_t*>(&sm.B[P][k][(((n4 >> 2) ^ bswz(k)) << 4) + (n4 & 3) * 4]) = w;
    }
  };
  auto sstore = [&](auto PC, int kt) {
#pragma unroll
    for (int i = 0; i < MI; ++i) storeA(PC, i);
#pragma unroll
    for (int i = 0; i < NB; ++i) storeB(PC, i, kt);
  };
  auto compute = [&](auto PC, auto STC, int kts) {
    constexpr int P = decltype(PC)::value;
    constexpr bool ST = decltype(STC)::value;
    using CQ = std::integral_constant<int, 1 - P>;
#pragma unroll
    for (int ks = 0; ks < 2; ++ks) {
      bf16x8 bf[4];
#pragma unroll
      for (int ni = 0; ni < 4; ++ni) {
        const int k0 = 32 * ks + 8 * fq + q4, col = (((wc * 4 + ni) ^ bswz(k0)) << 4) + 4 * p4;
        const v4i16_t lo = lds_tr(&sm.B[P][k0][col]);
        const v4i16_t hh = lds_tr(&sm.B[P][k0 + 4][col]);
        bf[ni] = bf16x8{lo[0], lo[1], lo[2], lo[3], hh[0], hh[1], hh[2], hh[3]};
      }
      bf16x8 af[MI];
#pragma unroll
      for (int mi = 0; mi < MI; ++mi) af[mi] = *reinterpret_cast<const bf16x8*>(&sm.A[P][wr * 16 * MI + mi * 16 + fr][32 * ks + fq * 8]);
#pragma unroll
      for (int mi = 0; mi < MI; ++mi)
#pragma unroll
        for (int ni = 0; ni < 4; ++ni) acc[mi][ni] = __builtin_amdgcn_mfma_f32_16x16x32_bf16(bf[ni], af[mi], acc[mi][ni], 0, 0, 0);
      if constexpr (ST) {
#pragma unroll
        for (int i = ks * (MI / 2); i < (ks + 1) * (MI / 2); ++i) storeA(CQ{}, i);
#pragma unroll
        for (int i = ks * (NB / 2); i < (ks + 1) * (NB / 2); ++i) storeB(CQ{}, i, kts);
      }
      __builtin_amdgcn_sched_barrier(0);
    }
  };
  using C0 = std::integral_constant<int, 0>; using C1 = std::integral_constant<int, 1>;
  using YES = std::true_type; using NO = std::false_type;
  int kt = 0;
  gload(C0{}, 0);
  sstore(C0{}, 0);
  gload(C1{}, 1);
  __syncthreads();
  for (; kt + 2 < nk; kt += 2) {
    gload(C0{}, kt + 2); compute(C0{}, YES{}, kt + 1); __syncthreads();
    gload(C1{}, kt + 3); compute(C1{}, YES{}, kt + 2); __syncthreads();
  }
  compute(C0{}, YES{}, kt + 1); __syncthreads();
  compute(C1{}, NO{}, 0); __syncthreads();
  epi(acc);
}

struct ItemRange { int i, hi, step; };
DEV ItemRange xcd_items(int I) {
  ItemRange r;
  if (gridDim.x & 7) { r.i = blockIdx.x; r.hi = I; r.step = gridDim.x; }
  else { const int x = blockIdx.x & 7; r.i = (int)((long)I * x / 8) + (blockIdx.x >> 3); r.hi = (int)((long)I * (x + 1) / 8); r.step = gridDim.x >> 3; }
  return r;
}
template <int GM, int GN> DEV void dense_item(int i, int MT, int& mt, int& nt) {
  const int g = i / (GM * GN), w = i % (GM * GN), gpm = MT / GM;
  mt = (g % gpm) * GM + w / GN; nt = (g / gpm) * GN + w % GN;
}
DEV float4 ld4(const float* ptr) { return *reinterpret_cast<const float4*>(ptr); }
DEV void st_bf4(u16* ptr, float a, float b, float c, float d) { uint2 w; w.x = cvtpk(a, b); w.y = cvtpk(c, d); *reinterpret_cast<uint2*>(ptr) = w; }

__constant__ float INVF[8] = {1.0f, 0.1939227432012558f, 0.03760603070259094f, 0.007292664609849453f, 0.0014142135623842478f,
                              0.00027424818836152554f, 5.3182957344688475e-05f, 1.0313385246263351e-05f};
DEV void ph_prologue(const Params& p) {
  const size_t gtid = (size_t)blockIdx.x * NTHR + tidx(), gsz = (size_t)gridDim.x * NTHR;
  for (size_t i = gtid; i < (size_t)T_ * D_ / 8; i += gsz) {
    const float4 a = reinterpret_cast<const float4*>(p.x)[2 * i], b = reinterpret_cast<const float4*>(p.x)[2 * i + 1];
    uint4 w; w.x = cvtpk(a.x, a.y); w.y = cvtpk(a.z, a.w); w.z = cvtpk(b.x, b.y); w.w = cvtpk(b.z, b.w);
    reinterpret_cast<uint4*>(p.xb)[i] = w;
  }
  for (size_t i = gtid; i < (size_t)T_ * 8; i += gsz) {
    const int t = (int)(i >> 3), f = (int)(i & 7);
    const float ang = (float)p.pos[t] * INVF[f];
    p.cs[t * 16 + f] = cosf(ang); p.cs[t * 16 + 8 + f] = sinf(ang);
  }
  auto cvt_w = [&](const float* src, u16* dst, size_t n4) {
    for (size_t i = gtid; i < n4; i += gsz) {
      const float4 a = reinterpret_cast<const float4*>(src)[i];
      uint2 w; w.x = cvtpk(a.x, a.y); w.y = cvtpk(a.z, a.w);
      reinterpret_cast<uint2*>(dst)[i] = w;
    }
  };
  cvt_w(p.even_w_in, p.w16_in0, (size_t)D_ * LD0 / 4);
  cvt_w(p.even_w_out, p.w16_out0, (size_t)D_ * D_ / 4);
  cvt_w(p.odd_w_in, p.w16_in1, (size_t)D_ * NIN1 / 4);
  cvt_w(p.odd_w_out, p.w16_out1, (size_t)D_ * D_ / 4);
  for (size_t i = gtid; i < (size_t)2 * D_ * NE / 4; i += gsz) {
    const size_t L = i / ((size_t)D_ * NE / 4), r = i - L * ((size_t)D_ * NE / 4);
    const float4 a = reinterpret_cast<const float4*>(p.router_w)[i];
    const unsigned h0 = cvtpk(a.x, a.y), h1 = cvtpk(a.z, a.w);
    uint2 hi; hi.x = h0; hi.y = h1;
    uint2 lo; lo.x = cvtpk(a.x - __uint_as_float(h0 << 16), a.y - __uint_as_float(h0 & 0xffff0000u)); lo.y = cvtpk(a.z - __uint_as_float(h1 << 16), a.w - __uint_as_float(h1 & 0xffff0000u));
    reinterpret_cast<uint2*>(p.rw16 + (L * 2 + 0) * (size_t)D_ * NE)[r] = hi;
    reinterpret_cast<uint2*>(p.rw16 + (L * 2 + 1) * (size_t)D_ * NE)[r] = lo;
  }
  for (size_t i = gtid; i < 2 * 128 * 16; i += gsz) {
    const int n = (int)(i & 127), kc = (int)((i >> 7) & 15), ts = (int)(i >> 11);
    const float* pe = ts ? p.cmpv_pos : p.cmpk_pos; const float* w1 = ts ? p.cmpv_w1 : p.cmpk_w1;
    float s = 0.f;
    for (int k = kc * 128; k < kc * 128 + 128; ++k) s += pe[k] * w1[(size_t)k * 128 + n];
    atomicAdd(&p.pb[ts * 128 + n], s);
  }
}

DEV void ph_inproj0(const Params& p, GemmSmem& sm) {
  const int tid = tidx(), lane = tid & 63, wid = tid >> 6, wr = wid >> 1, wc = wid & 1, fr = lane & 15, fq = lane >> 4;
  constexpr int NT = LD0 / 128;
  for (ItemRange it = xcd_items(64 * NT); it.i < it.hi; it.i += it.step) {
    int mt, nt; dense_item<16, 2>(it.i, 64, mt, nt);
    const int m0 = mt * 256, n0 = nt * 128;
    const u16* ar0 = p.xb + (size_t)(m0 + (tid >> 3)) * D_ + (tid & 7) * 8;
    auto a_addr = [&](int i, int kt) { return ar0 + (size_t)i * 64 * D_ + kt * 64; };
    const u16* bb = p.w16_in0 + (size_t)(tid >> 4) * LD0 + n0 + 8 * (tid & 15);
    auto b_addr = [&](int kt) { return bb + (size_t)kt * 64 * LD0; };
    auto b_lo = [&](int) { return false; };
    auto epi = [&](f32x4 (&acc)[4][4]) {
#pragma unroll
      for (int mi = 0; mi < 4; ++mi) {
        const int row = m0 + wr * 64 + mi * 16 + fr;
#pragma unroll
        for (int ni = 0; ni < 4; ++ni) {
          f32x4 v = acc[mi][ni];
          const int col = n0 + wc * 64 + ni * 16 + fq * 4;
          const bool rope = (ni == 0) && (col < 1024 || (col >= 1536 && col < 2176));
          if (rope) {
            const float4 c_ = ld4(p.cs + row * 16 + 4 * (fq & 1)), s_ = ld4(p.cs + row * 16 + 8 + 4 * (fq & 1));
            const float p0 = __shfl_xor(v[0], 32), p1 = __shfl_xor(v[1], 32), p2 = __shfl_xor(v[2], 32), p3 = __shfl_xor(v[3], 32);
            const float sg = fq < 2 ? -1.f : 1.f;
            v[0] = v[0] * c_.x + sg * p0 * s_.x; v[1] = v[1] * c_.y + sg * p1 * s_.y; v[2] = v[2] * c_.z + sg * p2 * s_.z; v[3] = v[3] * c_.w + sg * p3 * s_.w;
          }
          st_bf4(p.qkv + (size_t)row * LD0 + col, v[0], v[1], v[2], v[3]);
        }
      }
    };
    gemm_core<4, false, true>(sm, 16, a_addr, b_addr, LD0, b_lo, epi);
  }
}

DEV void ph_outproj(const Params& p, GemmSmem& sm, const u16* W16, const float* resid) {
  const int tid = tidx(), lane = tid & 63, wid = tid >> 6, wr = wid >> 1, wc = wid & 1, fr = lane & 15, fq = lane >> 4;
  for (ItemRange it = xcd_items(64 * 8); it.i < it.hi; it.i += it.step) {
    int mt, nt; dense_item<8, 4>(it.i, 64, mt, nt);
    const int m0 = mt * 256, n0 = nt * 128;
    const u16* ar0 = p.ao + (size_t)(m0 + (tid >> 3)) * D_ + (tid & 7) * 8;
    auto a_addr = [&](int i, int kt) { return ar0 + (size_t)i * 64 * D_ + kt * 64; };
    const u16* bb = W16 + (size_t)(tid >> 4) * D_ + n0 + 8 * (tid & 15);
    auto b_addr = [&](int kt) { return bb + (size_t)kt * 64 * D_; };
    auto b_lo = [&](int) { return false; };
    auto epi = [&](f32x4 (&acc)[4][4]) {
#pragma unroll
      for (int mi = 0; mi < 4; ++mi)
#pragma unroll
        for (int ni = 0; ni < 4; ++ni) {
          const size_t idx = (size_t)(m0 + wr * 64 + mi * 16 + fr) * D_ + n0 + wc * 64 + ni * 16 + fq * 4;
          const float4 r = ld4(resid + idx);
          float4 o; o.x = ALPHA * r.x + acc[mi][ni][0]; o.y = ALPHA * r.y + acc[mi][ni][1]; o.z = ALPHA * r.z + acc[mi][ni][2]; o.w = ALPHA * r.w + acc[mi][ni][3];
          *reinterpret_cast<float4*>(p.hpre + idx) = o;
        }
    };
    gemm_core<4, false, true>(sm, 16, a_addr, b_addr, D_, b_lo, epi);
  }
}

DEV void ph_ln_mix(const Params& p, const float* g, const float* bt) {
  const int lane = tidx() & 63, gw = blockIdx.x * NWAVE + (tidx() >> 6), nw = gridDim.x * NWAVE;
  for (int tok = gw; tok < T_; tok += nw) {
    float v[2][8]; float s = 0.f;
#pragma unroll
    for (int i = 0; i < 2; ++i)
#pragma unroll
      for (int h = 0; h < 2; ++h) {
        const float4 a = ld4(p.hpre + (size_t)tok * D_ + (i * 64 + lane) * 8 + 4 * h);
        v[i][4 * h] = a.x; v[i][4 * h + 1] = a.y; v[i][4 * h + 2] = a.z; v[i][4 * h + 3] = a.w;
        s += a.x + a.y + a.z + a.w;
      }
    const float mu = wave_sum(s) * (1.f / D_);
    float ss = 0.f;
#pragma unroll
    for (int i = 0; i < 2; ++i)
#pragma unroll
      for (int c = 0; c < 8; ++c) { v[i][c] -= mu; ss += v[i][c] * v[i][c]; }
    const float rstd = rsqrtf(wave_sum(ss) * (1.f / D_) + LN_EPS);
#pragma unroll
    for (int i = 0; i < 2; ++i) {
      const int c0 = (i * 64 + lane) * 8;
      float y[8];
#pragma unroll
      for (int h = 0; h < 2; ++h) {
        const float4 gg = ld4(g + c0 + 4 * h), bb = ld4(bt + c0 + 4 * h);
        y[4 * h] = v[i][4 * h] * rstd * gg.x + bb.x; y[4 * h + 1] = v[i][4 * h + 1] * rstd * gg.y + bb.y;
        y[4 * h + 2] = v[i][4 * h + 2] * rstd * gg.z + bb.z; y[4 * h + 3] = v[i][4 * h + 3] * rstd * gg.w + bb.w;
      }
      u32x4_t hi, lo;
#pragma unroll
      for (int c = 0; c < 4; ++c) {
        const unsigned hw = cvtpk(y[2 * c], y[2 * c + 1]);
        hi[c] = hw;
        lo[c] = cvtpk(y[2 * c] - __uint_as_float(hw << 16), y[2 * c + 1] - __uint_as_float(hw & 0xffff0000u));
      }
      *reinterpret_cast<u32x4_t*>(p.x1b + (size_t)tok * D_ + c0) = hi;
      *reinterpret_cast<u32x4_t*>(p.x1lo + (size_t)tok * D_ + c0) = lo;
    }
  }
}

struct RouterSmem { u16 A[2][256][72]; u16 B[2][2][64][128]; };
DEV void ph_router_gemm(const Params& p, char* smem, const u16* RW16) {
  RouterSmem& sm = *reinterpret_cast<RouterSmem*>(smem);
  const int tid = tidx(), lane = tid & 63, wid = tid >> 6, wr = wid >> 1, wc = wid & 1, fr = lane & 15, fq = lane >> 4;
  const int q4 = (lane & 15) >> 2, p4 = lane & 3;
  for (ItemRange it = xcd_items(128 * 2); it.i < it.hi; it.i += it.step) {
    const int nt = it.i & 1, mt = it.i >> 1, m0 = mt * 128, n0 = nt * 128;
    const size_t ao0 = (size_t)(m0 + (tid >> 3)) * D_ + (tid & 7) * 8;
    const u16* bb = RW16 + (size_t)(tid >> 4) * NE + n0 + 8 * (tid & 15);
    f32x4 acc[2][4];
#pragma unroll
    for (int mi = 0; mi < 2; ++mi)
#pragma unroll
      for (int ni = 0; ni < 4; ++ni) acc[mi][ni] = f32x4{0.f, 0.f, 0.f, 0.f};
    u32x4_t ra[2][4], rb[2][4];
    auto gload = [&](auto PC, int kt) {
      constexpr int P = decltype(PC)::value;
      ra[P][0] = *reinterpret_cast<const u32x4_t*>(p.x1b + ao0 + kt * 64);
      ra[P][1] = *reinterpret_cast<const u32x4_t*>(p.x1b + ao0 + (size_t)64 * D_ + kt * 64);
      ra[P][2] = *reinterpret_cast<const u32x4_t*>(p.x1lo + ao0 + kt * 64);
      ra[P][3] = *reinterpret_cast<const u32x4_t*>(p.x1lo + ao0 + (size_t)64 * D_ + kt * 64);
      const u16* bp = bb + (size_t)kt * 64 * NE;
      rb[P][0] = *reinterpret_cast<const u32x4_t*>(bp);
      rb[P][1] = *reinterpret_cast<const u32x4_t*>(bp + (size_t)32 * NE);
      rb[P][2] = *reinterpret_cast<const u32x4_t*>(bp + (size_t)D_ * NE);
      rb[P][3] = *reinterpret_cast<const u32x4_t*>(bp + (size_t)D_ * NE + (size_t)32 * NE);
    };
    auto sstore = [&](auto PC) {
      constexpr int P = decltype(PC)::value;
#pragma unroll
      for (int i = 0; i < 4; ++i) *reinterpret_cast<u32x4_t*>(&sm.A[P][(tid >> 3) + 64 * i][(tid & 7) * 8]) = ra[P][i];
#pragma unroll
      for (int i = 0; i < 4; ++i) {
        const int k = (tid >> 4) + 32 * (i & 1), n8 = tid & 15;
        *reinterpret_cast<u32x4_t*>(&sm.B[P][i >> 1][k][(((n8 >> 1) ^ bswz(k)) << 4) + (n8 & 1) * 8]) = rb[P][i];
      }
    };
    auto compute = [&](auto PC) {
      constexpr int P = decltype(PC)::value;
#pragma unroll
      for (int ks = 0; ks < 2; ++ks) {
        bf16x8 ah[2], al[2], bh[4], bl[4];
#pragma unroll
        for (int mi = 0; mi < 2; ++mi) {
          ah[mi] = *reinterpret_cast<const bf16x8*>(&sm.A[P][wr * 32 + mi * 16 + fr][32 * ks + fq * 8]);
          al[mi] = *reinterpret_cast<const bf16x8*>(&sm.A[P][128 + wr * 32 + mi * 16 + fr][32 * ks + fq * 8]);
        }
#pragma unroll
        for (int ni = 0; ni < 4; ++ni) {
          const int k0 = 32 * ks + 8 * fq + q4, col = (((wc * 4 + ni) ^ bswz(k0)) << 4) + 4 * p4;
          { const v4i16_t lo = lds_tr(&sm.B[P][0][k0][col]), hh = lds_tr(&sm.B[P][0][k0 + 4][col]); bh[ni] = bf16x8{lo[0], lo[1], lo[2], lo[3], hh[0], hh[1], hh[2], hh[3]}; }
          { const v4i16_t lo = lds_tr(&sm.B[P][1][k0][col]), hh = lds_tr(&sm.B[P][1][k0 + 4][col]); bl[ni] = bf16x8{lo[0], lo[1], lo[2], lo[3], hh[0], hh[1], hh[2], hh[3]}; }
        }
#pragma unroll
        for (int mi = 0; mi < 2; ++mi)
#pragma unroll
          for (int ni = 0; ni < 4; ++ni) {
            acc[mi][ni] = __builtin_amdgcn_mfma_f32_16x16x32_bf16(bh[ni], ah[mi], acc[mi][ni], 0, 0, 0);
            acc[mi][ni] = __builtin_amdgcn_mfma_f32_16x16x32_bf16(bh[ni], al[mi], acc[mi][ni], 0, 0, 0);
            acc[mi][ni] = __builtin_amdgcn_mfma_f32_16x16x32_bf16(bl[ni], ah[mi], acc[mi][ni], 0, 0, 0);
          }
        __builtin_amdgcn_sched_barrier(0);
      }
    };
    using C0 = std::integral_constant<int, 0>; using C1 = std::integral_constant<int, 1>;
    gload(C0{}, 0); sstore(C0{}); gload(C1{}, 1); __syncthreads();
    int kt = 0;
    for (; kt + 2 < 16; kt += 2) {
      gload(C0{}, kt + 2); compute(C0{}); sstore(C1{}); __syncthreads();
      gload(C1{}, kt + 3); compute(C1{}); sstore(C0{}); __syncthreads();
    }
    compute(C0{}); sstore(C1{}); __syncthreads();
    compute(C1{}); __syncthreads();
#pragma unroll
    for (int mi = 0; mi < 2; ++mi)
#pragma unroll
      for (int ni = 0; ni < 4; ++ni) {
        float4 o; o.x = acc[mi][ni][0]; o.y = acc[mi][ni][1]; o.z = acc[mi][ni][2]; o.w = acc[mi][ni][3];
        *reinterpret_cast<float4*>(p.logits + (size_t)(m0 + wr * 32 + mi * 16 + fr) * NE + n0 + wc * 64 + ni * 16 + fq * 4) = o;
      }
  }
}

DEV void ph_route(const Params& p, const float* rbias, int* cnt, int* etok) {
  const int lane = tidx() & 63, gw = blockIdx.x * NWAVE + (tidx() >> 6), nw = gridDim.x * NWAVE;
  const int half = lane >> 5;
  for (int tok = gw; tok < T_; tok += nw) {
    float aff[4], val[4];
#pragma unroll
    for (int j = 0; j < 4; ++j) {
      const float lg = p.logits[(size_t)tok * NE + lane + 64 * j];
      aff[j] = 1.f / (1.f + expf(-lg));
      val[j] = aff[j] + rbias[lane + 64 * j];
    }
    float gs[8];
#pragma unroll
    for (int j = 0; j < 4; ++j) {
      float m1 = val[j];
#pragma unroll
      for (int o = 16; o; o >>= 1) m1 = fmaxf(m1, __shfl_xor(m1, o));
      const unsigned long long eq = __ballot(val[j] == m1);
      const int ceq = __popc((unsigned)(half ? (eq >> 32) : (eq & 0xffffffffull)));
      float m2 = (val[j] == m1) ? -INFINITY : val[j];
#pragma unroll
      for (int o = 16; o; o >>= 1) m2 = fmaxf(m2, __shfl_xor(m2, o));
      if (ceq >= 2) m2 = m1;
      const float mine = m1 + m2, other = __shfl_xor(mine, 32);
      gs[2 * j] = half ? other : mine; gs[2 * j + 1] = half ? mine : other;
    }
    bool gok[8];
#pragma unroll
    for (int g = 0; g < 8; ++g) {
      int rk = 0;
#pragma unroll
      for (int g2 = 0; g2 < 8; ++g2) rk += (gs[g2] > gs[g] || (gs[g2] == gs[g] && g2 < g)) ? 1 : 0;
      gok[g] = rk < 4;
    }
#pragma unroll
    for (int j = 0; j < 4; ++j) { const bool ok = half ? gok[2 * j + 1] : gok[2 * j]; if (!ok) val[j] = -INFINITY; }
    int my_e = 0; float my_a = 0.f, asum = 0.f;
#pragma unroll
    for (int k = 0; k < TOPK; ++k) {
      float bv = val[0]; int bi = lane;
#pragma unroll
      for (int j = 1; j < 4; ++j) if (val[j] > bv) { bv = val[j]; bi = lane + 64 * j; }
#pragma unroll
      for (int o = 32; o; o >>= 1) {
        const float ov = __shfl_xor(bv, o); const int oi = __shfl_xor(bi, o);
        if (ov > bv || (ov == bv && oi < bi)) { bv = ov; bi = oi; }
      }
      float a_sel = 0.f;
#pragma unroll
      for (int j = 0; j < 4; ++j) { const bool hit = (bi == lane + 64 * j); a_sel = hit ? aff[j] : a_sel; val[j] = hit ? -INFINITY : val[j]; }
      a_sel = wave_sum(a_sel);
      asum += a_sel;
      if (lane == k) { my_e = bi; my_a = a_sel; }
    }
    if (lane < TOPK) {
      const int ps = atomicAdd(&cnt[my_e], 1);
      p.eidx[tok * TOPK + lane] = my_e; p.epos[tok * TOPK + lane] = ps; p.gatev[tok * TOPK + lane] = my_a / asum * 2.5f;
      etok[(size_t)my_e * T_ + ps] = tok;
    }
  }
}

constexpr int MOE_TM = 320;
struct MoeTab { int cn[260]; int of[260]; int tf[260]; unsigned ao[2][5][NTHR]; };
DEV void moe_prep(MoeTab& mt, const int* cnt) {
  const int tid = tidx();
  if (tid < NE) mt.cn[tid] = cnt[tid];
  __syncthreads();
  if (tid == 0) {
    int a = 0, tl = 0;
    for (int e = 0; e < NE; ++e) { mt.of[e] = a; mt.tf[e] = tl; a += mt.cn[e]; tl += (mt.cn[e] + MOE_TM - 1) / MOE_TM; }
    mt.cn[NE] = T_; mt.of[NE] = NASG; mt.tf[NE] = tl; mt.of[NE + 1] = NASG + T_; mt.tf[NE + 1] = tl + (T_ + MOE_TM - 1) / MOE_TM;
  }
  __syncthreads();
}
DEV int moe_rows_per_tile(int cn, int tiles) { return (cn + tiles - 1) / tiles; }
struct MoeItem { int e, nt, r0, r1, of; };
template <int NPT> DEV MoeItem moe_item(const MoeTab& mt, int u) {
  int lo = 0, hi = NE;
  while (lo < hi) { const int mid = (lo + hi + 1) >> 1; if (NPT * mt.tf[mid] <= u) lo = mid; else hi = mid - 1; }
  MoeItem it; it.e = lo;
  const int tiles = mt.tf[lo + 1] - mt.tf[lo], local = u - NPT * mt.tf[lo], mtl = local / NPT, cn = mt.cn[lo];
  it.nt = local - mtl * NPT; it.of = mt.of[lo];
  const int per = moe_rows_per_tile(cn, tiles);
  it.r0 = mtl * per; it.r1 = (it.r0 + per < cn) ? it.r0 + per : cn;
  return it;
}

template <int NK, class FA, class FB, class FAN, class FBN, class FM, class FE>
DEV void moe_gemm5(GemmSmem& sm, u32x4_t (&ra)[5], f32x4_t (&rb)[2][4], FA a_addr, FB b_addr, FAN a_next, FBN b_next, int ldb, FM mid, FE epi) {
  constexpr int MI = 5;
  const int tid = tidx(), lane = tid & 63, wid = tid >> 6;
  const int wr = wid >> 1, wc = wid & 1, fr = lane & 15, fq = lane >> 4;
  const int n4 = tid & 31, kq = tid >> 5, q4 = (lane & 15) >> 2, p4 = lane & 3;
  f32x4 acc[MI][4];
#pragma unroll
  for (int mi = 0; mi < MI; ++mi)
#pragma unroll
    for (int ni = 0; ni < 4; ++ni) acc[mi][ni] = f32x4{0.f, 0.f, 0.f, 0.f};
  auto gloadA = [&](auto& fa, int kt) {
#pragma unroll
    for (int i = 0; i < MI; ++i) ra[i] = *reinterpret_cast<const u32x4_t*>(fa(i, kt));
  };
  auto gloadB = [&](auto PC, auto& fb, int kt) {
    constexpr int P = decltype(PC)::value;
    const float* bp = fb(kt);
#pragma unroll
    for (int i = 0; i < 4; ++i) rb[P][i] = *reinterpret_cast<const f32x4_t*>(bp + (size_t)(16 * i) * ldb);
  };
  auto storeA = [&](auto PC, int i) {
    constexpr int P = decltype(PC)::value;
    *reinterpret_cast<u32x4_t*>(&sm.A[P][(tid >> 3) + 64 * i][(tid & 7) * 8]) = ra[i];
  };
  auto storeB = [&](auto PC, int i) {
    constexpr int P = decltype(PC)::value;
    const f32x4_t v = rb[P][i];
    u32x2_t w; w[0] = cvtpk(v[0], v[1]); w[1] = cvtpk(v[2], v[3]);
    const int k = kq + 16 * i;
    *reinterpret_cast<u32x2_t*>(&sm.B[P][k][(((n4 >> 2) ^ bswz(k)) << 4) + (n4 & 3) * 4]) = w;
  };
  auto compute = [&](auto BC, auto STC, auto& fa, int kta) {
    constexpr int P = decltype(BC)::value;
    constexpr bool ST = decltype(STC)::value;
    using CQ = std::integral_constant<int, 1 - P>;
#pragma unroll
    for (int ks = 0; ks < 2; ++ks) {
      bf16x8 bf[4];
#pragma unroll
      for (int ni = 0; ni < 4; ++ni) {
        const int k0 = 32 * ks + 8 * fq + q4, col = (((wc * 4 + ni) ^ bswz(k0)) << 4) + 4 * p4;
        const v4i16_t lo = lds_tr(&sm.B[P][k0][col]);
        const v4i16_t hh = lds_tr(&sm.B[P][k0 + 4][col]);
        bf[ni] = bf16x8{lo[0], lo[1], lo[2], lo[3], hh[0], hh[1], hh[2], hh[3]};
      }
      {
        bf16x8 af[3];
#pragma unroll
        for (int mi = 0; mi < 3; ++mi) af[mi] = *reinterpret_cast<const bf16x8*>(&sm.A[P][wr * 80 + mi * 16 + fr][32 * ks + fq * 8]);
#pragma unroll
        for (int mi = 0; mi < 3; ++mi)
#pragma unroll
          for (int ni = 0; ni < 4; ++ni) acc[mi][ni] = __builtin_amdgcn_mfma_f32_16x16x32_bf16(bf[ni], af[mi], acc[mi][ni], 0, 0, 0);
        if constexpr (ST) { if (ks == 0) { storeB(CQ{}, 0); storeB(CQ{}, 1); } else { storeA(CQ{}, 0); storeA(CQ{}, 1); } }
      }
      __builtin_amdgcn_sched_barrier(0);
      {
        bf16x8 af[2];
#pragma unroll
        for (int mi = 3; mi < 5; ++mi) af[mi - 3] = *reinterpret_cast<const bf16x8*>(&sm.A[P][wr * 80 + mi * 16 + fr][32 * ks + fq * 8]);
#pragma unroll
        for (int mi = 3; mi < 5; ++mi)
#pragma unroll
          for (int ni = 0; ni < 4; ++ni) acc[mi][ni] = __builtin_amdgcn_mfma_f32_16x16x32_bf16(bf[ni], af[mi - 3], acc[mi][ni], 0, 0, 0);
        if constexpr (ST) { if (ks == 0) { storeB(CQ{}, 2); storeB(CQ{}, 3); } else { storeA(CQ{}, 2); storeA(CQ{}, 3); storeA(CQ{}, 4); gloadA(fa, kta); } }
      }
      __builtin_amdgcn_sched_barrier(0);
    }
  };
  using C0 = std::integral_constant<int, 0>; using C1 = std::integral_constant<int, 1>;
  using YES = std::true_type; using NO = std::false_type;
#pragma unroll
  for (int i = 0; i < MI; ++i) storeA(C0{}, i);
#pragma unroll
  for (int i = 0; i < 4; ++i) storeB(C0{}, i);
  gloadA(a_addr, 1);
  __syncthreads();
#pragma unroll 1
  for (int kt = 0; kt + 2 < NK; kt += 2) {
    gloadB(C0{}, b_addr, kt + 2); if (kt == 0) mid(); compute(C0{}, YES{}, a_addr, kt + 2); __syncthreads();
    gloadB(C1{}, b_addr, kt + 3); compute(C1{}, YES{}, a_addr, kt + 3); __syncthreads();
  }
  gloadB(C0{}, b_next, 0); compute(C0{}, YES{}, a_next, 0); __syncthreads();
  gloadB(C1{}, b_next, 1);
  compute(C1{}, NO{}, a_next, 0);
  epi(acc);
}


constexpr int TS_LD = 136;
DEV void ts_put(u16* T, int row, int col, float a, float b, float c, float d) { uint2 w; w.x = cvtpk(a, b); w.y = cvtpk(c, d); *reinterpret_cast<uint2*>(T + row * TS_LD + col) = w; }
template <int NCH, class FD> DEV void ts_flush(const u16* T, int rows, FD dst) {
  __syncthreads();
  for (int c = tidx(); c < rows * NCH; c += NTHR) {
    const int row = c / NCH, ch = c - row * NCH;
    u16* d = dst(row);
    if (d) *reinterpret_cast<u32x4_t*>(d + ch * 8) = *reinterpret_cast<const u32x4_t*>(T + row * TS_LD + ch * 8);
  }
  __syncthreads();
}

DEV void ph_moe1(const Params& p, GemmSmem& sm, MoeTab& mt, int layer, const int* cnt) {
  const int tid = tidx(), lane = tid & 63, wid = tid >> 6, wr = wid >> 1, wc = wid & 1, fr = lane & 15, fq = lane >> 4;
  moe_prep(mt, cnt);
  ItemRange it = xcd_items(mt.tf[NE + 1] * 4);
  if (it.i >= it.hi) return;
  const int v0 = 4 * (tid & 31);
  auto set_rows = [&](const MoeItem& m, int slot) {
#pragma unroll
    for (int i = 0; i < 5; ++i) {
      int ri = m.r0 + (tid >> 3) + 64 * i; ri = ri < m.r1 ? ri : m.r1 - 1;
      const int tk = m.e < NE ? p.etok[(size_t)m.e * T_ + ri] : ri;
      mt.ao[slot][i][tid] = (unsigned)tk * D_ + (tid & 7) * 8;
    }
  };
  auto b_ptr = [&](const MoeItem& m, int kt) -> const float* {
    const float* wg = m.e < NE ? p.w_gate + ((size_t)layer * NE + m.e) * D_ * 256 : p.sh_gate + (size_t)layer * D_ * 256;
    const float* wu = m.e < NE ? p.w_up + ((size_t)layer * NE + m.e) * D_ * 256 : p.sh_up + (size_t)layer * D_ * 256;
    return ((v0 & 63) >= 32 ? wu : wg) + (size_t)(kt * 64 + (tid >> 5)) * 256 + m.nt * 64 + (v0 >> 6) * 32 + (v0 & 31);
  };
  u32x4_t ra[5]; f32x4_t rb[2][4];
  MoeItem cur = moe_item<4>(mt, it.i);
  int slot = 0;
  set_rows(cur, 0);
  {
#pragma unroll
    for (int i = 0; i < 5; ++i) ra[i] = *reinterpret_cast<const u32x4_t*>(p.x1b + mt.ao[0][i][tid]);
#pragma unroll
    for (int j = 0; j < 2; ++j)
#pragma unroll
      for (int i = 0; i < 4; ++i) rb[j][i] = *reinterpret_cast<const f32x4_t*>(b_ptr(cur, j) + (size_t)(16 * i) * 256);
  }
  for (;;) {
    const int un = it.i + it.step;
    const bool has_next = un < it.hi;
    const MoeItem nxt = has_next ? moe_item<4>(mt, un) : cur;
    const int nslot = has_next ? slot ^ 1 : slot;
    auto a_addr = [&](int i, int kt) { return p.x1b + mt.ao[slot][i][tid] + kt * 64; };
    auto b_addr = [&](int kt) { return b_ptr(cur, kt); };
    auto a_next = [&](int i, int kt) { return p.x1b + mt.ao[nslot][i][tid] + kt * 64; };
    auto b_next = [&](int kt) { return b_ptr(nxt, kt); };
    auto mid = [&]() { if (has_next) set_rows(nxt, nslot); };
    auto epi = [&](f32x4 (&acc)[5][4]) {
#pragma unroll
      for (int mi = 0; mi < 5; ++mi) {
        const int idx = cur.r0 + wr * 80 + mi * 16 + fr;
        if (idx < cur.r1) {
#pragma unroll
          for (int n2 = 0; n2 < 2; ++n2) {
            float hv[4];
#pragma unroll
            for (int j = 0; j < 4; ++j) { const float g = acc[mi][n2][j], uu = acc[mi][n2 + 2][j]; hv[j] = g * __builtin_amdgcn_rcpf(1.f + __expf(-g)) * uu; }
            st_bf4(p.hbuf + (size_t)(cur.of + idx) * 256 + cur.nt * 64 + wc * 32 + n2 * 16 + fq * 4, hv[0], hv[1], hv[2], hv[3]);
          }
        }
      }
    };
    moe_gemm5<16>(sm, ra, rb, a_addr, b_addr, a_next, b_next, 256, mid, epi);
    if (!has_next) break;
    cur = nxt; it.i = un; slot = nslot;
  }
}

DEV void ph_moe2(const Params& p, GemmSmem& sm, MoeTab& mt, int layer, const int* cnt) {
  const int tid = tidx(), lane = tid & 63, wid = tid >> 6, wr = wid >> 1, wc = wid & 1, fr = lane & 15, fq = lane >> 4;
  moe_prep(mt, cnt);
  ItemRange it = xcd_items(mt.tf[NE + 1] * 8);
  if (it.i >= it.hi) return;
  auto a_ptr = [&](const MoeItem& m, int i, int kt) -> const u16* {
    const int rmax = m.r1 - 1 - m.r0 - (tid >> 3);
    int d = 64 * i; d = d < rmax ? d : rmax;
    return p.hbuf + (size_t)(m.of + m.r0 + (tid >> 3) + d) * 256 + (tid & 7) * 8 + kt * 64;
  };
  auto b_ptr = [&](const MoeItem& m, int kt) -> const float* {
    const float* wd = m.e < NE ? p.w_down + ((size_t)layer * NE + m.e) * 256 * D_ : p.sh_down + (size_t)layer * 256 * D_;
    return wd + (size_t)(kt * 64 + (tid >> 5)) * D_ + m.nt * 128 + 4 * (tid & 31);
  };
  u32x4_t ra[5]; f32x4_t rb[2][4];
  MoeItem cur = moe_item<8>(mt, it.i);
  {
#pragma unroll
    for (int i = 0; i < 5; ++i) ra[i] = *reinterpret_cast<const u32x4_t*>(a_ptr(cur, i, 0));
#pragma unroll
    for (int j = 0; j < 2; ++j)
#pragma unroll
      for (int i = 0; i < 4; ++i) rb[j][i] = *reinterpret_cast<const f32x4_t*>(b_ptr(cur, j) + (size_t)(16 * i) * D_);
  }
  for (;;) {
    const int un = it.i + it.step;
    const bool has_next = un < it.hi;
    const MoeItem nxt = has_next ? moe_item<8>(mt, un) : cur;
    auto a_addr = [&](int i, int kt) { return a_ptr(cur, i, kt); };
    auto b_addr = [&](int kt) { return b_ptr(cur, kt); };
    auto a_next = [&](int i, int kt) { return a_ptr(nxt, i, kt); };
    auto b_next = [&](int kt) { return b_ptr(nxt, kt); };
    auto mid = [&]() {};
    auto epi = [&](f32x4 (&acc)[5][4]) {
      u16* T = reinterpret_cast<u16*>(&sm);
      __syncthreads();
#pragma unroll
      for (int mi = 0; mi < 5; ++mi)
#pragma unroll
        for (int ni = 0; ni < 4; ++ni) ts_put(T, wr * 80 + mi * 16 + fr, wc * 64 + ni * 16 + fq * 4, acc[mi][ni][0], acc[mi][ni][1], acc[mi][ni][2], acc[mi][ni][3]);
      ts_flush<16>(T, cur.r1 - cur.r0, [&](int row) -> u16* { return p.ybuf + (size_t)(cur.of + cur.r0 + row) * D_ + cur.nt * 128; });
    };
    moe_gemm5<4>(sm, ra, rb, a_addr, b_addr, a_next, b_next, D_, mid, epi);
    if (!has_next) break;
    cur = nxt; it.i = un;
  }
}

DEV void ph_combine_ln(const Params& p, MoeTab& mt, const int* cnt, const float* g, const float* bt, float* outf, u16* outb, bool with_ffn, bool write_b = true) {
  const int lane = tidx() & 63, gw = blockIdx.x * NWAVE + (tidx() >> 6), nw = gridDim.x * NWAVE;
  moe_prep(mt, cnt);
  for (int tok = gw; tok < T_; tok += nw) {
    int sl = 0; float gk = 0.f;
    if (lane < TOPK) { sl = mt.of[p.eidx[tok * TOPK + lane]] + p.epos[tok * TOPK + lane]; gk = p.gatev[tok * TOPK + lane]; }
    u32x4_t y[9][2], xh[2], xl[2];
#pragma unroll
    for (int i = 0; i < 2; ++i) {
      xh[i] = reinterpret_cast<const u32x4_t*>(p.x1b + (size_t)tok * D_)[i * 64 + lane];
      xl[i] = reinterpret_cast<const u32x4_t*>(p.x1lo + (size_t)tok * D_)[i * 64 + lane];
      y[8][i] = reinterpret_cast<const u32x4_t*>(p.ybuf + (size_t)(NASG + tok) * D_)[i * 64 + lane];
    }
    float gks[8];
#pragma unroll
    for (int k = 0; k < TOPK; ++k) {
      const int slk = __builtin_amdgcn_readlane(sl, k);
      gks[k] = __builtin_bit_cast(float, __builtin_amdgcn_readlane(__builtin_bit_cast(int, gk), k));
#pragma unroll
      for (int i = 0; i < 2; ++i) y[k][i] = reinterpret_cast<const u32x4_t*>(p.ybuf + (size_t)slk * D_)[i * 64 + lane];
    }
    float v[2][8];
#pragma unroll
    for (int i = 0; i < 2; ++i)
#pragma unroll
      for (int c = 0; c < 4; ++c) {
        float a0 = ALPHA * (bflo(xh[i][c]) + bflo(xl[i][c])), a1 = ALPHA * (bfhi(xh[i][c]) + bfhi(xl[i][c]));
        if (with_ffn) {
          a0 += bflo(y[8][i][c]); a1 += bfhi(y[8][i][c]);
#pragma unroll
          for (int k = 0; k < TOPK; ++k) { a0 += gks[k] * bflo(y[k][i][c]); a1 += gks[k] * bfhi(y[k][i][c]); }
        }
        v[i][2 * c] = a0; v[i][2 * c + 1] = a1;
      }
    float s = 0.f;
#pragma unroll
    for (int i = 0; i < 2; ++i)
#pragma unroll
      for (int c = 0; c < 8; ++c) s += v[i][c];
    const float mu = wave_sum(s) * (1.f / D_);
    float ss = 0.f;
#pragma unroll
    for (int i = 0; i < 2; ++i)
#pragma unroll
      for (int c = 0; c < 8; ++c) { v[i][c] -= mu; ss += v[i][c] * v[i][c]; }
    const float rstd = rsqrtf(wave_sum(ss) * (1.f / D_) + LN_EPS);
#pragma unroll
    for (int i = 0; i < 2; ++i) {
      const int c0 = (i * 64 + lane) * 8;
      float o[8];
#pragma unroll
      for (int h = 0; h < 2; ++h) {
        const float4 gg = ld4(g + c0 + 4 * h), bb = ld4(bt + c0 + 4 * h);
        o[4 * h] = v[i][4 * h] * rstd * gg.x + bb.x; o[4 * h + 1] = v[i][4 * h + 1] * rstd * gg.y + bb.y;
        o[4 * h + 2] = v[i][4 * h + 2] * rstd * gg.z + bb.z; o[4 * h + 3] = v[i][4 * h + 3] * rstd * gg.w + bb.w;
        float4 w; w.x = o[4 * h]; w.y = o[4 * h + 1]; w.z = o[4 * h + 2]; w.w = o[4 * h + 3];
        *reinterpret_cast<float4*>(outf + (size_t)tok * D_ + c0 + 4 * h) = w;
      }
      if (write_b) {
        u32x4_t w; w[0] = cvtpk(o[0], o[1]); w[1] = cvtpk(o[2], o[3]); w[2] = cvtpk(o[4], o[5]); w[3] = cvtpk(o[6], o[7]);
        *reinterpret_cast<u32x4_t*>(outb + (size_t)tok * D_ + c0) = w;
      }
    }
  }
}

DEV void ph_inproj1(const Params& p, GemmSmem& sm) {
  const int tid = tidx(), lane = tid & 63, wid = tid >> 6, wr = wid >> 1, wc = wid & 1, fr = lane & 15, fq = lane >> 4;
  constexpr int NT = 21;
  for (ItemRange it = xcd_items(64 * (NT + 1)); it.i < it.hi; it.i += it.step) {
    int mt, nt; dense_item<16, 2>(it.i, 64, mt, nt);
    if (nt >= NT) continue;
    const int m0 = mt * 256, n0 = nt * 128;
    const u16* ar0 = p.xb + (size_t)(m0 + (tid >> 3)) * D_ + (tid & 7) * 8;
    auto a_addr = [&](int i, int kt) { return ar0 + (size_t)i * 64 * D_ + kt * 64; };
    const u16* bb = p.w16_in1 + (size_t)(tid >> 4) * NIN1 + n0 + 8 * (tid & 15);
    const bool bok = n0 + 8 * (tid & 15) < NIN1;
    const u16* bbv = bok ? bb : p.w16_in1 + (size_t)(tid >> 4) * NIN1;
    auto b_addr = [&](int kt) -> const u16* { return bbv + (size_t)kt * 64 * NIN1; };
    auto b_lo = [&](int) { return false; };
    auto epi = [&](f32x4 (&acc)[4][4]) {
#pragma unroll
      for (int mi = 0; mi < 4; ++mi) {
        const int row = m0 + wr * 64 + mi * 16 + fr;
#pragma unroll
        for (int ni = 0; ni < 4; ++ni) {
          f32x4 v = acc[mi][ni];
          const int col = n0 + wc * 64 + ni * 16 + fq * 4;
          const bool rope = (ni == 0) && (col < 1280 || (col >= 1536 && col < 1792) || (col >= 2048 && col < 2304));
          if (rope) {
            const float4 c_ = ld4(p.cs + row * 16 + 4 * (fq & 1)), s_ = ld4(p.cs + row * 16 + 8 + 4 * (fq & 1));
            const float p0 = __shfl_xor(v[0], 32), p1 = __shfl_xor(v[1], 32), p2 = __shfl_xor(v[2], 32), p3 = __shfl_xor(v[3], 32);
            const float sg = fq < 2 ? -1.f : 1.f;
            v[0] = v[0] * c_.x + sg * p0 * s_.x; v[1] = v[1] * c_.y + sg * p1 * s_.y; v[2] = v[2] * c_.z + sg * p2 * s_.z; v[3] = v[3] * c_.w + sg * p3 * s_.w;
          }
          if (col < LD1) st_bf4(p.qkv + (size_t)row * LD1 + col, v[0], v[1], v[2], v[3]);
          else if (col < NIN1) {
            float4 o; o.x = 1.f / (1.f + __expf(-v[0])); o.y = 1.f / (1.f + __expf(-v[1])); o.z = 1.f / (1.f + __expf(-v[2])); o.w = 1.f / (1.f + __expf(-v[3]));
            *reinterpret_cast<float4*>(p.gates + (size_t)row * 48 + (col - LD1)) = o;
          }
        }
      }
    };
    gemm_core<4, false, true>(sm, 16, a_addr, b_addr, NIN1, b_lo, epi, bok);
  }
}

DEV float gelu_tanh(float x) { const float u = 0.7978845608028654f * (x + 0.044715f * x * x * x); return 0.5f * x * (1.f + tanhf(u)); }
DEV void ph_cmp1(const Params& p, GemmSmem& sm) {
  const int tid = tidx(), lane = tid & 63, wid = tid >> 6, wr = wid >> 1, wc = wid & 1, fr = lane & 15, fq = lane >> 4;
  for (int u = blockIdx.x; u < 64; u += gridDim.x) {
    const int ts = u >> 5, mt = u & 31, m0 = mt * 128;
    const u16* ar[2];
#pragma unroll
    for (int i = 0; i < 2; ++i) {
      const int m_ = m0 + (tid >> 3) + 64 * i, bg = m_ >> 8; int c = m_ & 255; c = c < 255 ? c : 254;
      ar[i] = p.qkv + (size_t)((bg >> 2) * S_ + 16 * c) * LD1 + (ts ? 1280 : 1024) + (bg & 3) * 64 + (tid & 7) * 8;
    }
    auto a_addr = [&](int i, int kt) { return ar[i] + (size_t)kt * LD1; };
    const float* bb = (ts ? p.cmpv_w1 : p.cmpk_w1) + (size_t)(tid >> 5) * 128 + 4 * (tid & 31);
    auto b_addr = [&](int kt) { return bb + (size_t)kt * 64 * 128; };
    auto b_lo = [&](int) { return false; };
    auto epi = [&](f32x4 (&acc)[2][4]) {
#pragma unroll
      for (int mi = 0; mi < 2; ++mi)
#pragma unroll
        for (int ni = 0; ni < 4; ++ni) {
          const int m = m0 + wr * 32 + mi * 16 + fr, col = wc * 64 + ni * 16 + fq * 4;
          const float4 pbv = ld4(p.pb + ts * 128 + col);
          st_bf4(p.hid + ((size_t)ts * 4096 + m) * 128 + col, gelu_tanh(acc[mi][ni][0] + pbv.x), gelu_tanh(acc[mi][ni][1] + pbv.y),
                 gelu_tanh(acc[mi][ni][2] + pbv.z), gelu_tanh(acc[mi][ni][3] + pbv.w));
        }
    };
    gemm_core<2, false>(sm, 32, a_addr, b_addr, 128, b_lo, epi);
  }
}
DEV void ph_cmp2(const Params& p, GemmSmem& sm) {
  const int tid = tidx(), lane = tid & 63, wid = tid >> 6, wr = wid >> 1, wc = wid & 1, fr = lane & 15, fq = lane >> 4;
  for (int u = blockIdx.x; u < 64; u += gridDim.x) {
    const int ts = u >> 5, mt = u & 31, m0 = mt * 128;
    const u16* ar0 = p.hid + ((size_t)ts * 4096 + m0 + (tid >> 3)) * 128 + (tid & 7) * 8;
    auto a_addr = [&](int i, int kt) { return ar0 + (size_t)i * 64 * 128 + kt * 64; };
    const float* bb = (ts ? p.cmpv_w2 : p.cmpk_w2) + (size_t)(tid >> 5) * 64 + 4 * (tid & 31);
    const bool bok = 4 * (tid & 31) < 64;
    const float* bbv = bok ? bb : (ts ? p.cmpv_w2 : p.cmpk_w2) + (size_t)(tid >> 5) * 64;
    auto b_addr = [&](int kt) -> const float* { return bbv + (size_t)kt * 64 * 64; };
    auto b_lo = [&](int) { return false; };
    auto epi = [&](f32x4 (&acc)[2][4]) {
      if (wc == 0) {
#pragma unroll
        for (int mi = 0; mi < 2; ++mi)
#pragma unroll
          for (int ni = 0; ni < 4; ++ni) {
            const int m = m0 + wr * 32 + mi * 16 + fr, col = ni * 16 + fq * 4;
            st_bf4(p.cmpkv + ((size_t)ts * 4096 + m) * 64 + col, acc[mi][ni][0], acc[mi][ni][1], acc[mi][ni][2], acc[mi][ni][3]);
          }
      }
    };
    gemm_core<2, false>(sm, 2, a_addr, b_addr, 64, b_lo, epi, bok);
  }
}

using f32x16 = __attribute__((ext_vector_type(16))) float;
DEV int crow(int r, int hi) { return (r & 3) + 8 * (r >> 2) + 4 * hi; }
constexpr float LOG2E = 1.4426950408889634f;
constexpr float SCL2 = 0.125f * LOG2E;

struct WaveTile { u16 K[32][72]; u16 V[2][32][32]; };
struct KVTile { u16 K[32][72]; u16 V[2][32][32]; };
struct AttnState { float m, l; f32x16 o[2]; };

DEV void stage_load(u32x4_t (&rk)[4], u32x4_t (&rv)[4], const u16* Kb, const u16* Vb, int ld, long rowbase, int rowstep, int kcmax, int k0, int lane) {
#pragma unroll
  for (int it = 0; it < 4; ++it) {
    int kc = k0 + (lane >> 3) + 8 * it; kc = kc > kcmax ? kcmax : kc;
    const long row = rowbase + (long)kc * rowstep;
    rk[it] = *reinterpret_cast<const u32x4_t*>(Kb + row * ld + (lane & 7) * 8);
    rv[it] = *reinterpret_cast<const u32x4_t*>(Vb + row * ld + (lane & 7) * 8);
  }
}
DEV void stage_store(WaveTile& wt, const u32x4_t (&rk)[4], const u32x4_t (&rv)[4], int lane) {
  const int ch = lane & 7;
#pragma unroll
  for (int it = 0; it < 4; ++it) {
    const int j = (lane >> 3) + 8 * it;
    *reinterpret_cast<u32x4_t*>(&wt.K[j][ch * 8]) = rk[it];
    *reinterpret_cast<u32x4_t*>(&wt.V[ch >> 2][j][(ch & 3) * 8]) = rv[it];
  }
}
template <class TT> DEV f32x16 qk_tile(const TT& wt, const bf16x8 (&qf)[4], int r32, int hi) {
  f32x16 acc;
#pragma unroll
  for (int r = 0; r < 16; ++r) acc[r] = 0.f;
#pragma unroll
  for (int s = 0; s < 4; ++s) {
    const bf16x8 kf = *reinterpret_cast<const bf16x8*>(&wt.K[r32][16 * s + 8 * hi]);
    acc = __builtin_amdgcn_mfma_f32_32x32x16_bf16(kf, qf[s], acc, 0, 0, 0);
  }
  return acc;
}
template <class TT> DEV void pv_tile(const TT& wt, const float (&pr)[16], f32x16 (&o)[2], int lane) {
  const int hi = lane >> 5, g = (lane >> 4) & 1, q4 = (lane & 15) >> 2, p4 = lane & 3;
  bf16x8 pf[2];
#pragma unroll
  for (int s2 = 0; s2 < 2; ++s2) {
    u32x4_t w;
    w[0] = cvtpk(pr[8 * s2 + 0], pr[8 * s2 + 1]); w[1] = cvtpk(pr[8 * s2 + 2], pr[8 * s2 + 3]);
    w[2] = cvtpk(pr[8 * s2 + 4], pr[8 * s2 + 5]); w[3] = cvtpk(pr[8 * s2 + 6], pr[8 * s2 + 7]);
    pf[s2] = __builtin_bit_cast(bf16x8, w);
  }
#pragma unroll
  for (int dt = 0; dt < 2; ++dt)
#pragma unroll
    for (int s2 = 0; s2 < 2; ++s2) {
      const v4i16_t lo = lds_tr(&wt.V[dt][16 * s2 + 4 * hi + q4][16 * g + 4 * p4]);
      const v4i16_t hh = lds_tr(&wt.V[dt][16 * s2 + 8 + 4 * hi + q4][16 * g + 4 * p4]);
      const bf16x8 vf = {lo[0], lo[1], lo[2], lo[3], hh[0], hh[1], hh[2], hh[3]};
      o[dt] = __builtin_amdgcn_mfma_f32_32x32x16_bf16(vf, pf[s2], o[dt], 0, 0, 0);
    }
}
DEV void attn_init(AttnState& st) {
  st.m = -INFINITY; st.l = 0.f;
#pragma unroll
  for (int r = 0; r < 16; ++r) { st.o[0][r] = 0.f; st.o[1][r] = 0.f; }
}
template <bool USE_SEL>
DEV void attn_span(AttnState& st, WaveTile& wt, const bf16x8 (&qf)[4], const u16* Kb, const u16* Vb, int ld,
                   long rowbase, int rowstep, int kcmax, int kc_lo, int kc_hi, int qc, int W,
                   unsigned long long sel, unsigned long long selu, int lane, int qc_min, int qc_max) {
  const int r32 = lane & 31, hi = lane >> 5;
  if (kc_lo < 0) kc_lo = 0;
  if (kc_hi > kcmax) kc_hi = kcmax;
  const int full_hi = qc_min < kcmax ? qc_min : kcmax;
  auto skip = [&](int k0) -> bool { return USE_SEL && !((selu >> (k0 >> 6)) & 1ull); };
  int kc0 = kc_lo & ~31;
  while (kc0 <= kc_hi && skip(kc0)) kc0 += 32;
  if (kc0 > kc_hi) return;
  u32x4_t rk[4], rv[4];
  stage_load(rk, rv, Kb, Vb, ld, rowbase, rowstep, kcmax, kc0, lane);
  for (;;) {
    stage_store(wt, rk, rv, lane);
    int kn = kc0 + 32;
    while (kn <= kc_hi && skip(kn)) kn += 32;
    if (kn <= kc_hi) stage_load(rk, rv, Kb, Vb, ld, rowbase, rowstep, kcmax, kn, lane);
    WAVE_SYNC();
    const f32x16 s = qk_tile(wt, qf, r32, hi);
    const bool selbit = USE_SEL ? (((sel >> (kc0 >> 6)) & 1ull) != 0ull) : true;
    const bool full = (qc_min <= qc_max) && (kc0 + 31 <= full_hi) && (kc0 >= qc_max - W);
    float sv[16]; float mt = -INFINITY;
    if (full) {
      float rm = s[0];
#pragma unroll
      for (int r = 1; r < 16; ++r) rm = fmaxf(rm, s[r]);
      mt = selbit ? rm * SCL2 : -INFINITY;
    } else {
#pragma unroll
      for (int r = 0; r < 16; ++r) {
        const int kc = kc0 + crow(r, hi), dist = qc - kc;
        const bool ok = selbit && kc <= kcmax && dist >= 0 && dist <= W;
        sv[r] = ok ? s[r] * SCL2 : -INFINITY;
        mt = fmaxf(mt, sv[r]);
      }
    }
    mt = fmaxf(mt, __shfl_xor(mt, 32));
    const float mnew = fmaxf(st.m, mt), muse = (mnew == -INFINITY) ? 0.f : mnew;
    const float alpha = __builtin_amdgcn_exp2f(st.m - muse);
    st.m = mnew;
    float ps = 0.f;
    if (full) {
      const float sub = selbit ? muse : INFINITY;
#pragma unroll
      for (int r = 0; r < 16; ++r) { sv[r] = __builtin_amdgcn_exp2f(__builtin_fmaf(s[r], SCL2, -sub)); ps += sv[r]; }
    } else {
#pragma unroll
      for (int r = 0; r < 16; ++r) { sv[r] = __builtin_amdgcn_exp2f(sv[r] - muse); ps += sv[r]; }
    }
    st.l = st.l * alpha + ps;
    if (__any(alpha != 1.f)) {
#pragma unroll
      for (int r = 0; r < 16; ++r) { st.o[0][r] *= alpha; st.o[1][r] *= alpha; }
    }
    pv_tile(wt, sv, st.o, lane);
    if (kn > kc_hi) break;
    kc0 = kn;
  }
}
DEV void attn_finish(AttnState& st, float sink2) {
  float l = st.l + __shfl_xor(st.l, 32);
  if (sink2 > -INFINITY) l += __builtin_amdgcn_exp2f(sink2 - st.m);
  const float inv = l > 0.f ? 1.f / l : 0.f;
#pragma unroll
  for (int r = 0; r < 16; ++r) { st.o[0][r] *= inv; st.o[1][r] *= inv; }
}
DEV void attn_store_bf16(const AttnState& st, u16* orow, int hi) {
#pragma unroll
  for (int dt = 0; dt < 2; ++dt)
#pragma unroll
    for (int k4 = 0; k4 < 4; ++k4) {
      uint2 w; w.x = cvtpk(st.o[dt][4 * k4], st.o[dt][4 * k4 + 1]); w.y = cvtpk(st.o[dt][4 * k4 + 2], st.o[dt][4 * k4 + 3]);
      *reinterpret_cast<uint2*>(orow + 32 * dt + 8 * k4 + 4 * hi) = w;
    }
}
DEV void load_qf(bf16x8 (&qf)[4], const u16* qrow, int hi) {
#pragma unroll
  for (int s = 0; s < 4; ++s) qf[s] = *reinterpret_cast<const bf16x8*>(qrow + 16 * s + 8 * hi);
}

DEV void ph_attn0_mfma(const Params& p, WaveTile* wts) {
  const int tid = tidx(), lane = tid & 63, wid = tid >> 6, r32 = lane & 31, hi = lane >> 5;
  WaveTile& wt = wts[wid];
  const int gw = blockIdx.x * NWAVE + wid, nw = gridDim.x * NWAVE;
  for (int u = gw; u < 8192; u += nw) {
    AttnState st; attn_init(st);
    bf16x8 qf[4];
    if (u < 4096) {
      const int it = u & 7, res = (u >> 3) & 15, h = (u >> 7) & 7, b = u >> 10;
      const int i0 = it * 32, t = 16 * (i0 + r32) + res;
      const long row = (long)b * S_ + t;
      load_qf(qf, p.qkv + row * LD0 + h * 64, hi);
      const u16* Kb = p.qkv + 512 + h * 64; const u16* Vb = p.qkv + 1024 + h * 64;
      attn_span<false>(st, wt, qf, Kb, Vb, LD0, (long)b * S_ + res, 16, 255, i0 - 128, i0 + 31, i0 + r32, 128, 0ull, 0ull, lane, 1, 0);
      const int c = res >> 2;
      attn_span<false>(st, wt, qf, Kb, Vb, LD0, (long)b * S_ + (res & 3), 4, 1023, 4 * i0 + c - 128, 4 * (i0 + 31) + c, 4 * (i0 + r32) + c, 128, 0ull, 0ull, lane, 1, 0);
      attn_span<false>(st, wt, qf, Kb, Vb, LD0, (long)b * S_, 1, 4095, 16 * i0 + res - 128, 16 * (i0 + 31) + res, t, 128, 0ull, 0ull, lane, 1, 0);
      attn_finish(st, -INFINITY);
      attn_store_bf16(st, p.ao + row * D_ + h * 64, hi);
    } else {
      const int v = u - 4096, qt = v & 127, hb = (v >> 7) & 7, b = v >> 10, g = hb >> 2;
      const int t = 32 * qt + r32;
      const long row = (long)b * S_ + t;
      load_qf(qf, p.qkv + row * LD0 + 1536 + hb * 64, hi);
      attn_span<false>(st, wt, qf, p.qkv + 2048 + g * 64, p.qkv + 2176 + g * 64, LD0, (long)b * S_, 1, 4095, 32 * qt - 127, 32 * qt + 31, t, 127, 0ull, 0ull, lane, 32 * qt, 32 * qt + 31);
      attn_finish(st, p.even_sinks[hb] * LOG2E);
      attn_store_bf16(st, p.ao + row * D_ + 512 + hb * 64, hi);
    }
  }
}

struct Att1aSmem { KVTile tiles[2][2]; float imp[NWAVE][32][65]; float sc[NWAVE][64]; };
DEV void ph_attn1a(const Params& p, char* smem) {
  Att1aSmem& sm = *reinterpret_cast<Att1aSmem*>(smem);
  const int tid = tidx(), lane = tid & 63, wid = tid >> 6, r32 = lane & 31, hi = lane >> 5, gl = wid >> 2;
  const int sg = tid >> 8, sj = (tid & 255) >> 3, sc = tid & 7;
  for (int u = blockIdx.x; u < 1024; u += gridDim.x) {
    const int k = u >> 8, base = u & 255, bg = base & 7, x = base >> 3;
    const int qt = (k == 0) ? 127 - x : (k == 1) ? 64 + x : (k == 2) ? 63 - x : x;
    const int b = bg >> 1, gp = bg & 1;
    const int h = gp * 8 + wid, g = h >> 2;
    const int q0 = 32 * qt, t = q0 + r32;
    const long row = (long)b * S_ + t;
    const int qc = (t - 31) >> 4;
    int kc_hi = q0 >> 4; kc_hi = kc_hi > 254 ? 254 : kc_hi;
    const int ntile = (kc_hi >> 5) + 1;
    const u16* kp = p.cmpkv + ((size_t)((b * 4 + 2 * gp + sg) * 256) + sj) * 64 + sc * 8;
    const u16* vp = kp + (size_t)4096 * 64;
    for (int i = tid; i < NWAVE * 32 * 65; i += NTHR) (&sm.imp[0][0][0])[i] = 0.f;
    bf16x8 qf[4];
    load_qf(qf, p.qkv + row * LD1 + h * 64, hi);
    auto for_tiles = [&](auto&& body) {
      u32x4_t rk = *reinterpret_cast<const u32x4_t*>(kp), rv = *reinterpret_cast<const u32x4_t*>(vp);
      int cur = 0;
      for (int tt = 0; tt < ntile; ++tt) {
        KVTile& dst = sm.tiles[cur][sg];
        *reinterpret_cast<u32x4_t*>(&dst.K[sj][sc * 8]) = rk;
        *reinterpret_cast<u32x4_t*>(&dst.V[sc >> 2][sj][(sc & 3) * 8]) = rv;
        const int tn = tt + 1 < ntile ? tt + 1 : tt;
        rk = *reinterpret_cast<const u32x4_t*>(kp + (size_t)tn * 32 * 64);
        rv = *reinterpret_cast<const u32x4_t*>(vp + (size_t)tn * 32 * 64);
        __syncthreads();
        body(sm.tiles[cur][gl], tt * 32);
        cur ^= 1;
      }
      __syncthreads();
    };
    float m = -INFINITY, l = 0.f;
    for_tiles([&](const KVTile& tl, int kc0) {
      const f32x16 s = qk_tile(tl, qf, r32, hi);
      float sv[16]; float mt = -INFINITY;
#pragma unroll
      for (int rr = 0; rr < 16; ++rr) { const int kc = kc0 + crow(rr, hi); const bool ok = kc <= 254 && kc <= qc; sv[rr] = ok ? s[rr] * SCL2 : -INFINITY; mt = fmaxf(mt, sv[rr]); }
      mt = fmaxf(mt, __shfl_xor(mt, 32));
      const float mnew = fmaxf(m, mt), muse = (mnew == -INFINITY) ? 0.f : mnew;
      float ps = 0.f;
#pragma unroll
      for (int rr = 0; rr < 16; ++rr) ps += __builtin_amdgcn_exp2f(sv[rr] - muse);
      l = l * __builtin_amdgcn_exp2f(m - muse) + ps; m = mnew;
    });
    l += __shfl_xor(l, 32);
    const float inv = l > 0.f ? 1.f / l : 0.f, muse = (m == -INFINITY) ? 0.f : m;
    f32x16 o[2];
#pragma unroll
    for (int rr = 0; rr < 16; ++rr) { o[0][rr] = 0.f; o[1][rr] = 0.f; }
    for_tiles([&](const KVTile& tl, int kc0) {
      const f32x16 s = qk_tile(tl, qf, r32, hi);
      float pr[16];
#pragma unroll
      for (int rr = 0; rr < 16; ++rr) { const int kc = kc0 + crow(rr, hi); const bool ok = kc <= 254 && kc <= qc; pr[rr] = ok ? __builtin_amdgcn_exp2f(s[rr] * SCL2 - muse) * inv : 0.f; }
#pragma unroll
      for (int k4 = 0; k4 < 4; ++k4) {
        const int j = (kc0 >> 2) + 2 * k4 + hi;
        sm.imp[wid][r32][j] += pr[4 * k4] + pr[4 * k4 + 1] + pr[4 * k4 + 2] + 0.5f * pr[4 * k4 + 3];
        WAVE_SYNC();
        if (j + 1 < 64) sm.imp[wid][r32][j + 1] += 0.5f * pr[4 * k4 + 3];
        WAVE_SYNC();
      }
      pv_tile(tl, pr, o, lane);
    });
    const float g0 = p.gates[(size_t)row * 48 + h * 3];
#pragma unroll
    for (int dt = 0; dt < 2; ++dt)
#pragma unroll
      for (int k4 = 0; k4 < 4; ++k4) {
        float4 w; w.x = g0 * o[dt][4 * k4]; w.y = g0 * o[dt][4 * k4 + 1]; w.z = g0 * o[dt][4 * k4 + 2]; w.w = g0 * o[dt][4 * k4 + 3];
        *reinterpret_cast<float4*>(p.hpre + (size_t)row * D_ + h * 64 + 32 * dt + 8 * k4 + 4 * hi) = w;
      }
    for (int i = 0; i < 8; ++i) {
      const int pi = wid * 8 + i, grp = pi >> 5, q = pi & 31;
      const int tq = q0 + q, cur = tq >> 6;
      const float impq = (sm.imp[4 * grp][q][lane] + sm.imp[4 * grp + 1][q][lane]) + (sm.imp[4 * grp + 2][q][lane] + sm.imp[4 * grp + 3][q][lane]);
      const float score = (lane > cur) ? -1.f : ((lane == 0 || lane == cur || lane == cur - 1) ? 1.0e4f : impq);
      sm.sc[wid][lane] = score;
      WAVE_SYNC();
      int rk_ = 0;
#pragma unroll
      for (int jj = 0; jj < 64; jj += 4) {
        const float4 v = *reinterpret_cast<const float4*>(&sm.sc[wid][jj]);
        rk_ += (v.x > score || (v.x == score && jj < lane)) ? 1 : 0;
        rk_ += (v.y > score || (v.y == score && jj + 1 < lane)) ? 1 : 0;
        rk_ += (v.z > score || (v.z == score && jj + 2 < lane)) ? 1 : 0;
        rk_ += (v.w > score || (v.w == score && jj + 3 < lane)) ? 1 : 0;
      }
      WAVE_SYNC();
      const unsigned long long mask = __ballot(rk_ < 16 && lane <= cur);
      if (lane == 0) p.selmask[((size_t)b * S_ + tq) * 4 + 2 * gp + grp] = mask;
    }
    __syncthreads();
  }
}

template <class TT>
DEV void attn_tile_update(AttnState& st, const TT& tl, const bf16x8 (&qf)[4], int kc0, int qc, int W, int kcmax, bool selbit, bool full, int lane) {
  const int r32 = lane & 31, hi = lane >> 5;
  const f32x16 s = qk_tile(tl, qf, r32, hi);
  float sv[16]; float mt = -INFINITY;
  if (full) {
    float rm = s[0];
#pragma unroll
    for (int r = 1; r < 16; ++r) rm = fmaxf(rm, s[r]);
    mt = selbit ? rm * SCL2 : -INFINITY;
  } else {
#pragma unroll
    for (int r = 0; r < 16; ++r) {
      const int kc = kc0 + crow(r, hi), dist = qc - kc;
      const bool ok = selbit && kc <= kcmax && dist >= 0 && dist <= W;
      sv[r] = ok ? s[r] * SCL2 : -INFINITY;
      mt = fmaxf(mt, sv[r]);
    }
  }
  mt = fmaxf(mt, __shfl_xor(mt, 32));
  const float mnew = fmaxf(st.m, mt), muse = (mnew == -INFINITY) ? 0.f : mnew;
  const float alpha = __builtin_amdgcn_exp2f(st.m - muse);
  st.m = mnew;
  float ps = 0.f;
  if (full) {
    const float sub = selbit ? muse : INFINITY;
#pragma unroll
    for (int r = 0; r < 16; ++r) { sv[r] = __builtin_amdgcn_exp2f(__builtin_fmaf(s[r], SCL2, -sub)); ps += sv[r]; }
  } else {
#pragma unroll
    for (int r = 0; r < 16; ++r) { sv[r] = __builtin_amdgcn_exp2f(sv[r] - muse); ps += sv[r]; }
  }
  st.l = st.l * alpha + ps;
  if (__any(alpha != 1.f)) {
#pragma unroll
    for (int r = 0; r < 16; ++r) { st.o[0][r] *= alpha; st.o[1][r] *= alpha; }
  }
  pv_tile(tl, sv, st.o, lane);
}

template <bool USE_SEL>
DEV void attn_span_shared(AttnState& st, KVTile (*tiles)[2][2], const Params& p, const bf16x8 (&qf)[4], int b, int gp, int kcol, int vcol,
                          int t_lo, int t_hi, int qc, int W, unsigned long long sel, int q0) {
  const int tid = tidx(), lane = tid & 63, wid = tid >> 6, gl = wid >> 2;
  const int sg = tid >> 8, sj = (tid & 255) >> 3, sc = tid & 7;
  const u16* kp = p.qkv + (size_t)b * S_ * LD1 + kcol + (2 * gp + sg) * 64 + (size_t)sj * LD1 + sc * 8;
  const u16* vp = p.qkv + (size_t)b * S_ * LD1 + vcol + (2 * gp + sg) * 64 + (size_t)sj * LD1 + sc * 8;
  const int s_lo = t_lo >> 1, s_hi = t_hi >> 1;
  u32x4_t rk[2], rv[2];
#pragma unroll
  for (int h = 0; h < 2; ++h) {
    rk[h] = *reinterpret_cast<const u32x4_t*>(kp + (size_t)(2 * s_lo + h) * 32 * LD1);
    rv[h] = *reinterpret_cast<const u32x4_t*>(vp + (size_t)(2 * s_lo + h) * 32 * LD1);
  }
  int cur = 0;
  for (int sidx = s_lo; sidx <= s_hi; ++sidx) {
#pragma unroll
    for (int h = 0; h < 2; ++h) {
      KVTile& dst = tiles[cur][sg][h];
      *reinterpret_cast<u32x4_t*>(&dst.K[sj][sc * 8]) = rk[h];
      *reinterpret_cast<u32x4_t*>(&dst.V[sc >> 2][sj][(sc & 3) * 8]) = rv[h];
    }
    const int sn = sidx < s_hi ? sidx + 1 : sidx;
#pragma unroll
    for (int h = 0; h < 2; ++h) {
      rk[h] = *reinterpret_cast<const u32x4_t*>(kp + (size_t)(2 * sn + h) * 32 * LD1);
      rv[h] = *reinterpret_cast<const u32x4_t*>(vp + (size_t)(2 * sn + h) * 32 * LD1);
    }
    __syncthreads();
#pragma unroll
    for (int h = 0; h < 2; ++h) {
      const int t = 2 * sidx + h;
      if (t >= t_lo && t <= t_hi) {
        const int kc0 = t * 32;
        const bool selbit = USE_SEL ? (((sel >> (kc0 >> 6)) & 1ull) != 0ull) : true;
        const bool full = (kc0 + 31 <= q0) && (kc0 >= q0 + 31 - W);
        attn_tile_update(st, tiles[cur][gl][h], qf, kc0, qc, W, 4095, selbit, full, lane);
      }
    }
    cur ^= 1;
  }
  __syncthreads();
}

DEV void ph_attn1b(const Params& p, char* smem) {
  KVTile (*tiles)[2][2] = reinterpret_cast<KVTile (*)[2][2]>(smem);
  const int tid = tidx(), lane = tid & 63, wid = tid >> 6, r32 = lane & 31, hi = lane >> 5;
  for (int u = blockIdx.x; u < 1024; u += gridDim.x) {
    const int k = u >> 8, base = u & 255, bg = base & 7, x = base >> 3;
    const int qt = (k == 0) ? 127 - x : (k == 1) ? 64 + x : (k == 2) ? 63 - x : x;
    const int b = bg >> 1, gp = bg & 1;
    const int h = gp * 8 + wid, g = h >> 2;
    const int q0 = 32 * qt, t = q0 + r32;
    const long row = (long)b * S_ + t;
    bf16x8 qf[4];
    load_qf(qf, p.qkv + row * LD1 + h * 64, hi);
    const unsigned long long sel = p.selmask[(size_t)row * 4 + g];
    const float g1 = p.gates[(size_t)row * 48 + h * 3 + 1], g2 = p.gates[(size_t)row * 48 + h * 3 + 2];
    AttnState st; attn_init(st);
    attn_span_shared<true>(st, tiles, p, qf, b, gp, 1536, 1792, 0, qt, t, 1 << 30, sel, q0);
    attn_finish(st, -INFINITY);
    f32x16 acc[2];
#pragma unroll
    for (int rr = 0; rr < 16; ++rr) { acc[0][rr] = g1 * st.o[0][rr]; acc[1][rr] = g1 * st.o[1][rr]; }
    attn_init(st);
    const int wlo = q0 - 511 > 0 ? (q0 - 511) >> 5 : 0;
    attn_span_shared<false>(st, tiles, p, qf, b, gp, 2048, 2304, wlo, qt, t, 511, 0ull, q0);
    attn_finish(st, -INFINITY);
#pragma unroll
    for (int dt = 0; dt < 2; ++dt)
#pragma unroll
      for (int k4 = 0; k4 < 4; ++k4) {
        const float4 c = *reinterpret_cast<const float4*>(p.hpre + (size_t)row * D_ + h * 64 + 32 * dt + 8 * k4 + 4 * hi);
        uint2 w;
        w.x = cvtpk(c.x + acc[dt][4 * k4] + g2 * st.o[dt][4 * k4], c.y + acc[dt][4 * k4 + 1] + g2 * st.o[dt][4 * k4 + 1]);
        w.y = cvtpk(c.z + acc[dt][4 * k4 + 2] + g2 * st.o[dt][4 * k4 + 2], c.w + acc[dt][4 * k4 + 3] + g2 * st.o[dt][4 * k4 + 3]);
        *reinterpret_cast<uint2*>(p.ao + (size_t)row * D_ + h * 64 + 32 * dt + 8 * k4 + 4 * hi) = w;
      }
  }
}

enum { PH_PRO = 0, PH_IN0, PH_ATT0, PH_OUT0, PH_LN0, PH_RG0, PH_RT0, PH_M10, PH_M20, PH_CB0,
       PH_IN1, PH_C1, PH_C2, PH_ATT1A, PH_ATT1B, PH_OUT1, PH_LN1, PH_RG1, PH_RT1, PH_M11, PH_M21, PH_CB1 };

template <int PH> DEV void run_phase(const Params& p, char* smem) {
  GemmSmem& gs = *reinterpret_cast<GemmSmem*>(smem);
  WaveTile* wts = reinterpret_cast<WaveTile*>(smem);
  MoeTab& mt = *reinterpret_cast<MoeTab*>(smem + sizeof(GemmSmem));
  if constexpr (PH == PH_PRO) ph_prologue(p);
  else if constexpr (PH == PH_IN0) ph_inproj0(p, gs);
  else if constexpr (PH == PH_ATT0) ph_attn0_mfma(p, wts);
  else if constexpr (PH == PH_OUT0) ph_outproj(p, gs, p.w16_out0, p.x);
  else if constexpr (PH == PH_LN0) ph_ln_mix(p, p.mix_g, p.mix_b);
  else if constexpr (PH == PH_RG0) ph_router_gemm(p, smem, p.rw16);
  else if constexpr (PH == PH_RT0) ph_route(p, p.router_b, p.cnt, p.etok);
  else if constexpr (PH == PH_M10) ph_moe1(p, gs, mt, 0, p.cnt);
  else if constexpr (PH == PH_M20) ph_moe2(p, gs, mt, 0, p.cnt);
  else if constexpr (PH == PH_CB0) ph_combine_ln(p, mt, p.cnt, p.ffn_g, p.ffn_b, p.x2f, p.xb, true);
  else if constexpr (PH == PH_IN1) ph_inproj1(p, gs);
  else if constexpr (PH == PH_C1) ph_cmp1(p, gs);
  else if constexpr (PH == PH_C2) ph_cmp2(p, gs);
  else if constexpr (PH == PH_ATT1A) ph_attn1a(p, smem);
  else if constexpr (PH == PH_ATT1B) ph_attn1b(p, smem);
  else if constexpr (PH == PH_OUT1) ph_outproj(p, gs, p.w16_out1, p.x2f);
  else if constexpr (PH == PH_LN1) ph_ln_mix(p, p.mix_g + D_, p.mix_b + D_);
  else if constexpr (PH == PH_RG1) ph_router_gemm(p, smem, p.rw16 + (size_t)2 * D_ * NE);
  else if constexpr (PH == PH_RT1) ph_route(p, p.router_b + NE, p.cnt + 512, p.etok);
  else if constexpr (PH == PH_M11) ph_moe1(p, gs, mt, 1, p.cnt + 512);
  else if constexpr (PH == PH_M21) ph_moe2(p, gs, mt, 1, p.cnt + 512);
  else if constexpr (PH == PH_CB1) ph_combine_ln(p, mt, p.cnt + 512, p.ffn_g + D_, p.ffn_b + D_, p.out, p.xb, true, false);
}

constexpr int SMEM_NEED0 = (NWAVE * (int)sizeof(WaveTile) > (int)(sizeof(GemmSmem) + sizeof(MoeTab))) ? NWAVE * (int)sizeof(WaveTile) : (int)(sizeof(GemmSmem) + sizeof(MoeTab));
constexpr int SMEM_NEED1 = SMEM_NEED0 > (int)sizeof(RouterSmem) ? SMEM_NEED0 : (int)sizeof(RouterSmem);
constexpr int SMEM_NEED2 = SMEM_NEED1 > (int)sizeof(Att1aSmem) ? SMEM_NEED1 : (int)sizeof(Att1aSmem);
constexpr int SMEM_NEED = SMEM_NEED2 > 8 * (int)sizeof(KVTile) ? SMEM_NEED2 : 8 * (int)sizeof(KVTile);
constexpr int SMEM_BAR_OFF = (SMEM_NEED + 15) & ~15, SMEM_BYTES = SMEM_BAR_OFF + 16;
template <int PH, bool LAST> DEV void phase_and_sync(const Params& p, char* smem, const XcdBarrier& bar) {
  run_phase<PH>(p, smem);
  if constexpr (!LAST) xcd_barrier(bar);
}
template <int... PHS> struct PhaseList {};
template <int P0> DEV void run_list(const Params& p, char* smem, const XcdBarrier& bar, PhaseList<P0>) { phase_and_sync<P0, true>(p, smem, bar); }
template <int P0, int P1, int... REST> DEV void run_list(const Params& p, char* smem, const XcdBarrier& bar, PhaseList<P0, P1, REST...>) {
  phase_and_sync<P0, false>(p, smem, bar);
  run_list(p, smem, bar, PhaseList<P1, REST...>{});
}
using Program = PhaseList<PH_PRO, PH_IN0, PH_ATT0, PH_OUT0, PH_LN0, PH_RG0, PH_RT0, PH_M10, PH_M20, PH_CB0,
                          PH_IN1, PH_C1, PH_C2, PH_ATT1A, PH_ATT1B, PH_OUT1, PH_LN1, PH_RG1, PH_RT1, PH_M11, PH_M21, PH_CB1>;
struct KArgs { const void* in[25]; float* out; char* ws; };
constexpr size_t al256(size_t b) { return (b + 255) & ~(size_t)255; }
constexpr size_t OFF_BAR = 0;
constexpr size_t OFF_CNT = OFF_BAR + al256(16384);
constexpr size_t OFF_PB = OFF_CNT + al256(4096);
constexpr size_t OFF_ZERO_END = OFF_PB + al256(1024);
constexpr size_t OFF_CS = OFF_ZERO_END;
constexpr size_t OFF_XB = OFF_CS + al256((size_t)T_ * 16 * 4);
constexpr size_t OFF_QKV = OFF_XB + al256((size_t)T_ * D_ * 2);
constexpr size_t OFF_GATES = OFF_QKV + al256((size_t)T_ * 2624 * 2);
constexpr size_t OFF_AO = OFF_GATES + al256((size_t)T_ * 48 * 4);
constexpr size_t OFF_HPRE = OFF_AO + al256((size_t)T_ * D_ * 2);
constexpr size_t OFF_X1B = OFF_HPRE + al256((size_t)T_ * D_ * 4);
constexpr size_t OFF_X1LO = OFF_X1B + al256((size_t)T_ * D_ * 2);
constexpr size_t OFF_LOGITS = OFF_X1LO + al256((size_t)T_ * D_ * 2);
constexpr size_t OFF_EIDX = OFF_LOGITS + al256((size_t)T_ * NE * 4);
constexpr size_t OFF_GATEV = OFF_EIDX + al256((size_t)NASG * 4);
constexpr size_t OFF_EPOS = OFF_GATEV + al256((size_t)NASG * 4);
constexpr size_t OFF_ETOK = OFF_EPOS + al256((size_t)NASG * 4);
constexpr size_t OFF_HBUF = OFF_ETOK + al256((size_t)NE * T_ * 4);
constexpr size_t OFF_YBUF = OFF_HBUF + al256((size_t)NROWS * 256 * 2);
constexpr size_t OFF_X2F = OFF_YBUF + al256((size_t)NROWS * D_ * 2);
constexpr size_t OFF_HID = OFF_X2F + al256((size_t)T_ * D_ * 4);
constexpr size_t OFF_CMPKV = OFF_HID + al256((size_t)2 * 4096 * 128 * 2);
constexpr size_t OFF_SELMASK = OFF_CMPKV + al256((size_t)2 * 4096 * 64 * 2);
constexpr size_t OFF_W16IN0 = OFF_SELMASK + al256((size_t)T_ * 4 * 8);
constexpr size_t OFF_W16OUT0 = OFF_W16IN0 + al256((size_t)D_ * LD0 * 2);
constexpr size_t OFF_W16IN1 = OFF_W16OUT0 + al256((size_t)D_ * D_ * 2);
constexpr size_t OFF_W16OUT1 = OFF_W16IN1 + al256((size_t)D_ * NIN1 * 2);
constexpr size_t OFF_RW16 = OFF_W16OUT1 + al256((size_t)D_ * D_ * 2);
constexpr size_t WS_NEEDED = OFF_RW16 + al256((size_t)4 * D_ * NE * 2);

DEV Params make_params(const KArgs& k) {
  Params p;
  p.x = (const float*)k.in[0]; p.pos = (const int*)k.in[1];
  p.even_w_in = (const float*)k.in[2]; p.even_sinks = (const float*)k.in[3]; p.even_w_out = (const float*)k.in[4]; p.odd_w_in = (const float*)k.in[5];
  p.cmpk_pos = (const float*)k.in[6]; p.cmpk_w1 = (const float*)k.in[7]; p.cmpk_w2 = (const float*)k.in[8];
  p.cmpv_pos = (const float*)k.in[9]; p.cmpv_w1 = (const float*)k.in[10]; p.cmpv_w2 = (const float*)k.in[11];
  p.odd_w_out = (const float*)k.in[12]; p.mix_g = (const float*)k.in[13]; p.mix_b = (const float*)k.in[14];
  p.router_w = (const float*)k.in[15]; p.router_b = (const float*)k.in[16];
  p.w_gate = (const float*)k.in[17]; p.w_up = (const float*)k.in[18]; p.w_down = (const float*)k.in[19];
  p.sh_gate = (const float*)k.in[20]; p.sh_up = (const float*)k.in[21]; p.sh_down = (const float*)k.in[22];
  p.ffn_g = (const float*)k.in[23]; p.ffn_b = (const float*)k.in[24];
  p.out = k.out;
  char* w = k.ws;
  p.bar = (unsigned*)(w + OFF_BAR); p.cnt = (int*)(w + OFF_CNT); p.pb = (float*)(w + OFF_PB);
  p.cs = (float*)(w + OFF_CS); p.xb = (u16*)(w + OFF_XB); p.qkv = (u16*)(w + OFF_QKV); p.gates = (float*)(w + OFF_GATES);
  p.ao = (u16*)(w + OFF_AO); p.hpre = (float*)(w + OFF_HPRE); p.x1b = (u16*)(w + OFF_X1B); p.x1lo = (u16*)(w + OFF_X1LO);
  p.logits = (float*)(w + OFF_LOGITS); p.eidx = (int*)(w + OFF_EIDX); p.gatev = (float*)(w + OFF_GATEV); p.epos = (int*)(w + OFF_EPOS); p.etok = (int*)(w + OFF_ETOK);
  p.hbuf = (u16*)(w + OFF_HBUF); p.ybuf = (u16*)(w + OFF_YBUF); p.x2f = (float*)(w + OFF_X2F); p.hid = (u16*)(w + OFF_HID); p.cmpkv = (u16*)(w + OFF_CMPKV);
  p.selmask = (unsigned long long*)(w + OFF_SELMASK);
  p.w16_in0 = (u16*)(w + OFF_W16IN0); p.w16_out0 = (u16*)(w + OFF_W16OUT0); p.w16_in1 = (u16*)(w + OFF_W16IN1); p.w16_out1 = (u16*)(w + OFF_W16OUT1); p.rw16 = (u16*)(w + OFF_RW16);
  return p;
}

__global__ void __launch_bounds__(NTHR, 2) k_fused(KArgs ka) {
  extern __shared__ __attribute__((aligned(16))) char smem[];
  const Params p = make_params(ka);
  if (tidx() == 0) *reinterpret_cast<uint4*>(smem + SMEM_BAR_OFF) = make_uint4(0u, 0u, 0u, 0u);
  __syncthreads();
  XcdBarrier bar = xcd_barrier_post(p.bar, (volatile LAS unsigned*)(smem + SMEM_BAR_OFF));
  run_list(p, smem, bar, Program{});
}

extern "C" void kernel_launch(void* const* d_in, const int* in_sizes, int n_in, void* d_out, int out_size, void* d_ws, size_t ws_size, hipStream_t stream) {
  (void)in_sizes; (void)n_in; (void)out_size;
  if (ws_size < WS_NEEDED) return;
  KArgs ka{};
  for (int i = 0; i < 25; ++i) ka.in[i] = d_in[i];
  ka.out = (float*)d_out; ka.ws = (char*)d_ws;
  hipMemsetAsync(d_ws, 0, OFF_ZERO_END, stream);
  static int grid = 0;
  if (!grid) {
    int dev = 0, cus = 0, per_cu = 0;
    hipGetDevice(&dev);
    hipDeviceGetAttribute(&cus, hipDeviceAttributeMultiprocessorCount, dev);
    hipFuncSetAttribute((const void*)k_fused, hipFuncAttributeMaxDynamicSharedMemorySize, SMEM_BYTES);
    hipOccupancyMaxActiveBlocksPerMultiprocessor(&per_cu, (const void*)k_fused, NTHR, SMEM_BYTES);
    if (per_cu > 1) per_cu = 1;
    if (per_cu < 1) per_cu = 1;
    grid = cus * per_cu;
  }
  hipLaunchKernelGGL(k_fused, dim3(grid), dim3(NTHR), SMEM_BYTES, stream, ka);
}
```

```cpp
#include <hip/hip_runtime.h>
#include <hip/hip_bf16.h>
#include <stdint.h>
#include <math.h>
#include <utility>

typedef unsigned short u16;
using bf16x8 = __attribute__((ext_vector_type(8))) short;
using f32x4  = __attribute__((ext_vector_type(4))) float;

#define DEV __device__ __forceinline__
__device__ __forceinline__ int tidx() { int t = (int)__builtin_amdgcn_workitem_id_x(); asm volatile("" : "+v"(t)); return t; }

constexpr int T_ = 16384, S_ = 4096, D_ = 1024;
constexpr int LD0 = 2304, LD1 = 2560, NIN1 = 2608;
constexpr int NE = 256, TOPK = 8, NASG = T_ * TOPK, NROWS = NASG + T_;
constexpr float ALPHA = 1.41421356237309515f;
constexpr float LN_EPS = 1e-5f;
constexpr int NTHR = 512, NWAVE = 8;


struct Params {
  const float* x; const int* pos;
  const float* even_w_in; const float* even_sinks; const float* even_w_out; const float* odd_w_in;
  const float* cmpk_pos; const float* cmpk_w1; const float* cmpk_w2; const float* cmpv_pos; const float* cmpv_w1; const float* cmpv_w2;
  const float* odd_w_out; const float* mix_g; const float* mix_b; const float* router_w; const float* router_b;
  const float* w_gate; const float* w_up; const float* w_down; const float* sh_gate; const float* sh_up; const float* sh_down;
  const float* ffn_g; const float* ffn_b;
  float* out;
  unsigned* bar; int* cnt; float* pb; float* cs; u16* xb; u16* qkv; float* gates; u16* ao; float* hpre;
  u16* x1b; u16* x1lo; float* logits; int* eidx; float* gatev; int* epos; int* etok;
  u16* hbuf; u16* ybuf; float* x2f; u16* hid; u16* cmpkv; unsigned long long* selmask;
  u16* w16_in0; u16* w16_out0; u16* w16_in1; u16* w16_out1; u16* rw16;
};

#define XB_TMO      128
#define XB_XCNT(j)  (256  + 64 * (j))
#define XB_XSUB(j)  (1280 + 64 * (j))
#define XB_XGEN(j)  (2304 + 64 * (j))
#define XB_TOP      3328
#define XB_TOPGEN   3392
#define XCD_BAR_WORDS 3456
#define XB_SPIN_CAP (1u << 18)
#define LAS __attribute__((address_space(3)))

__device__ __forceinline__ unsigned xb_ld(unsigned* p)              { return __hip_atomic_load(p, __ATOMIC_RELAXED, __HIP_MEMORY_SCOPE_AGENT); }
__device__ __forceinline__ unsigned xb_add(unsigned* p, unsigned v) { return __hip_atomic_fetch_add(p, v, __ATOMIC_RELAXED, __HIP_MEMORY_SCOPE_AGENT); }
__device__ __forceinline__ unsigned xb_xcc_id() { return (unsigned)__builtin_amdgcn_s_getreg((3 << 11) | 20) & 0xFu; }
#define XB_SPIN(cond, bar) do { unsigned _sp = 0; while (cond) { __builtin_amdgcn_s_sleep(1); \
    if ((++_sp & 255u) == 0u) { if (xb_ld(&(bar)[XB_TMO])) break; if (_sp > XB_SPIN_CAP) { atomicAdd(&(bar)[XB_TMO], 1u); break; } } } } while (0)

struct XcdBarrier {
    unsigned* bar; unsigned x;
    volatile LAS unsigned* st;
};

__device__ __forceinline__ XcdBarrier xcd_barrier_post(unsigned* bar, volatile LAS unsigned* st) {
    XcdBarrier b; b.bar = bar; b.x = xb_xcc_id(); b.st = st;
    if (tidx() == 0) (void)xb_add(&bar[XB_XCNT(b.x)], 1u);
    return b;
}
__device__ __forceinline__ void xcd_barrier_complete(unsigned* bar, unsigned x, unsigned& nloc, unsigned& nx) {
    const unsigned G = gridDim.x * gridDim.y * gridDim.z;
    unsigned sum, cnt, mine, sp = 0u;
    for (;;) {
        sum = 0u; cnt = 0u; mine = 0u;
#pragma unroll
        for (unsigned j = 0; j < 16; ++j) { const unsigned c = xb_ld(&bar[XB_XCNT(j)]); sum += c; cnt += (c > 0u) ? 1u : 0u; mine = (j == x) ? c : mine; }
        if (sum == G) break;
        __builtin_amdgcn_s_sleep(1);
        if ((++sp & 255u) == 0u) { if (xb_ld(&bar[XB_TMO])) break; if (sp > XB_SPIN_CAP) { atomicAdd(&bar[XB_TMO], 1u); break; } }
    }
    nloc = mine > 0u ? mine : 1u; nx = cnt > 0u ? cnt : 1u;
}

__device__ __forceinline__ void xcd_barrier(const XcdBarrier& b) {
    asm volatile("s_waitcnt vmcnt(0)" ::: "memory");
    __syncthreads();
    if (tidx() == 0) {
        unsigned* bar = b.bar;
        __builtin_amdgcn_s_waitcnt(0);
        unsigned nloc = b.st[0], nx = b.st[1];
        if (nloc == 0u) { xcd_barrier_complete(bar, b.x, nloc, nx); b.st[0] = nloc; b.st[1] = nx; }
        const unsigned old = xb_add(&bar[XB_XSUB(b.x)], 1u);
        const unsigned gen = old / nloc;
        if (old + 1u == (gen + 1u) * nloc) {
            __builtin_amdgcn_fence(__ATOMIC_RELEASE, "agent");
            asm volatile("s_waitcnt vmcnt(0)" ::: "memory");
            const unsigned og = xb_add(&bar[XB_TOP], 1u);
            const unsigned tg = og / nx;
            if (og + 1u == (tg + 1u) * nx) xb_add(&bar[XB_TOPGEN], 1u);
            else XB_SPIN(xb_ld(&bar[XB_TOPGEN]) == tg, bar);
            __builtin_amdgcn_fence(__ATOMIC_ACQUIRE, "agent");
            xb_add(&bar[XB_XGEN(b.x)], 1u);
            asm volatile("s_waitcnt vmcnt(0)" ::: "memory");
        } else {
            XB_SPIN(xb_ld(&bar[XB_XGEN(b.x)]) == gen, bar);
            __builtin_amdgcn_fence(__ATOMIC_ACQUIRE, "agent");
            asm volatile("s_waitcnt vmcnt(0)" ::: "memory");
        }
    }
    __syncthreads();
}


DEV float bf2f(u16 h) { return __uint_as_float(((unsigned)h) << 16); }
DEV float bflo(unsigned w) { return __uint_as_float(w << 16); }
DEV float bfhi(unsigned w) { return __uint_as_float(w & 0xffff0000u); }
DEV float wave_max(float v) { for (int o = 32; o; o >>= 1) v = fmaxf(v, __shfl_xor(v, o)); return v; }
DEV float wave_sum(float v) { for (int o = 32; o; o >>= 1) v += __shfl_xor(v, o); return v; }
#define WAVE_SYNC() asm volatile("s_waitcnt lgkmcnt(0)" ::: "memory")

typedef short v4i16_t __attribute__((ext_vector_type(4)));
typedef float f32x2_t __attribute__((ext_vector_type(2)));
typedef __bf16 bf16x2_t __attribute__((ext_vector_type(2)));
typedef unsigned u32x4_t __attribute__((ext_vector_type(4)));
typedef unsigned u32x2_t __attribute__((ext_vector_type(2)));
typedef float f32x4_t __attribute__((ext_vector_type(4)));
DEV unsigned cvtpk(float lo, float hi) { f32x2_t v = {lo, hi}; bf16x2_t b = __builtin_convertvector(v, bf16x2_t); return __builtin_bit_cast(unsigned, b); }
DEV v4i16_t lds_tr(const u16* ptr) { return __builtin_amdgcn_ds_read_tr16_b64_v4i16((LAS v4i16_t*)ptr); }

struct GemmSmem { u16 A[2][320][72]; u16 B[2][64][128]; };
DEV int bswz(int k) { return (k & 3) | (((k >> 3) & 1) << 2); }

template <int MI, bool SPLIT, bool B16 = false, class FA, class FB, class FL, class FE>
DEV void gemm_core(GemmSmem& sm, int nk, FA a_addr, FB b_addr, int ldb, FL b_lo, FE epi, bool b_ok = true) {
  const int tid = tidx(), lane = tid & 63, wid = tid >> 6;
  const int wr = wid >> 1, wc = wid & 1, fr = lane & 15, fq = lane >> 4;
  const int n4 = tid & 31, kq = tid >> 5, q4 = (lane & 15) >> 2, p4 = lane & 3;
  f32x4 acc[MI][4];
#pragma unroll
  for (int mi = 0; mi < MI; ++mi)
#pragma unroll
    for (int ni = 0; ni < 4; ++ni) acc[mi][ni] = f32x4{0.f, 0.f, 0.f, 0.f};
  static_assert(MI == 2 || MI == 4, "two register sets");
  u32x4_t ra[2][MI]; f32x4_t rb[2][4]; u32x4_t rh[2][2];
  auto gload = [&](auto PC, int kt) {
    constexpr int P = decltype(PC)::value;
#pragma unroll
    for (int i = 0; i < MI; ++i) ra[P][i] = *reinterpret_cast<const u32x4_t*>(a_addr(i, kt));
    if constexpr (B16) {
      const u16* bp = b_addr(kt);
      rh[P][0] = *reinterpret_cast<const u32x4_t*>(bp);
      rh[P][1] = *reinterpret_cast<const u32x4_t*>(bp + (size_t)32 * ldb);
    } else {
      const float* bp = b_addr(kt);
#pragma unroll
      for (int i = 0; i < 4; ++i) rb[P][i] = *reinterpret_cast<const f32x4_t*>(bp + (size_t)(16 * i) * ldb);
    }
  };
  constexpr int NB = B16 ? 2 : 4;
  auto storeA = [&](auto PC, int i) {
    constexpr int P = decltype(PC)::value;
    *reinterpret_cast<u32x4_t*>(&sm.A[P][(tid >> 3) + 64 * i][(tid & 7) * 8]) = ra[P][i];
  };
  auto storeB = [&](auto PC, int i, int kt) {
    constexpr int P = decltype(PC)::value;
    if constexpr (B16) {
      u32x4_t w = rh[P][i];
      if (!b_ok) w = u32x4_t{0u, 0u, 0u, 0u};
      const int k = (tid >> 4) + 32 * i, n8 = tid & 15;
      *reinterpret_cast<u32x4_t*>(&sm.B[P][k][(((n8 >> 1) ^ bswz(k)) << 4) + (n8 & 1) * 8]) = w;
    } else {
      const bool lo = SPLIT ? b_lo(kt) : false;
      f32x4_t v = rb[P][i];
      if (!b_ok) v = f32x4_t{0.f, 0.f, 0.f, 0.f};
      if (SPLIT && lo) {
        const unsigned h0 = cvtpk(v[0], v[1]), h1 = cvtpk(v[2], v[3]);
        v[0] -= __uint_as_float(h0 << 16); v[1] -= __uint_as_float(h0 & 0xffff0000u); v[2] -= __uint_as_float(h1 << 16); v[3] -= __uint_as_float(h1 & 0xffff0000u);
      }
      u32x2_t w; w[0] = cvtpk(v[0], v[1]); w[1] = cvtpk(v[2], v[3]);
      const int k = kq + 16 * i;
      *reinterpret_cast<u32x2_t*>(&sm.B[P][k][(((n4 >> 2) ^ bswz(k)) << 4) + (n4 & 3) * 4]) = w;
    }
  };
  auto sstore = [&](auto PC, int kt) {
#pragma unroll
    for (int i = 0; i < MI; ++i) storeA(PC, i);
#pragma unroll
    for (int i = 0; i < NB; ++i) storeB(PC, i, kt);
  };
  auto compute = [&](auto PC, auto STC, int kts) {
    constexpr int P = decltype(PC)::value;
    constexpr bool ST = decltype(STC)::value;
    using CQ = std::integral_constant<int, 1 - P>;
#pragma unroll
    for (int ks = 0; ks < 2; ++ks) {
      bf16x8 bf[4];
#pragma unroll
      for (int ni = 0; ni < 4; ++ni) {
        const int k0 = 32 * ks + 8 * fq + q4, col = (((wc * 4 + ni) ^ bswz(k0)) << 4) + 4 * p4;
        const v4i16_t lo = lds_tr(&sm.B[P][k0][col]);
        const v4i16_t hh = lds_tr(&sm.B[P][k0 + 4][col]);
        bf[ni] = bf16x8{lo[0], lo[1], lo[2], lo[3], hh[0], hh[1], hh[2], hh[3]};
      }
      bf16x8 af[MI];
#pragma unroll
      for (int mi = 0; mi < MI; ++mi) af[mi] = *reinterpret_cast<const bf16x8*>(&sm.A[P][wr * 16 * MI + mi * 16 + fr][32 * ks + fq * 8]);
#pragma unroll
      for (int mi = 0; mi < MI; ++mi)
#pragma unroll
        for (int ni = 0; ni < 4; ++ni) acc[mi][ni] = __builtin_amdgcn_mfma_f32_16x16x32_bf16(bf[ni], af[mi], acc[mi][ni], 0, 0, 0);
      if constexpr (ST) {
#pragma unroll
        for (int i = ks * (MI / 2); i < (ks + 1) * (MI / 2); ++i) storeA(CQ{}, i);
#pragma unroll
        for (int i = ks * (NB / 2); i < (ks + 1) * (NB / 2); ++i) storeB(CQ{}, i, kts);
      }
      __builtin_amdgcn_sched_barrier(0);
    }
  };
  using C0 = std::integral_constant<int, 0>; using C1 = std::integral_constant<int, 1>;
  using YES = std::true_type; using NO = std::false_type;
  int kt = 0;
  gload(C0{}, 0);
  sstore(C0{}, 0);
  gload(C1{}, 1);
  __syncthreads();
  for (; kt + 2 < nk; kt += 2) {
    gload(C0{}, kt + 2); compute(C0{}, YES{}, kt + 1); __syncthreads();
    gload(C1{}, kt + 3); compute(C1{}, YES{}, kt + 2); __syncthreads();
  }
  compute(C0{}, YES{}, kt + 1); __syncthreads();
  compute(C1{}, NO{}, 0); __syncthreads();
  epi(acc);
}

struct ItemRange { int i, hi, step; };
DEV ItemRange xcd_items(int I) {
  ItemRange r;
  if (gridDim.x & 7) { r.i = blockIdx.x; r.hi = I; r.step = gridDim.x; }
  else { const int x = blockIdx.x & 7; r.i = (int)((long)I * x / 8) + (blockIdx.x >> 3); r.hi = (int)((long)I * (x + 1) / 8); r.step = gridDim.x >> 3; }
  return r;
}
template <int GM, int GN> DEV void dense_item(int i, int MT, int& mt, int& nt) {
  const int g = i / (GM * GN), w = i % (GM * GN), gpm = MT / GM;
  mt = (g % gpm) * GM + w / GN; nt = (g / gpm) * GN + w % GN;
}
DEV float4 ld4(const float* ptr) { return *reinterpret_cast<const float4*>(ptr); }
DEV void st_bf4(u16* ptr, float a, float b, float c, float d) { uint2 w; w.x = cvtpk(a, b); w.y = cvtpk(c, d); *reinterpret_cast<uint2*>(ptr) = w; }

__constant__ float INVF[8] = {1.0f, 0.1939227432012558f, 0.03760603070259094f, 0.007292664609849453f, 0.0014142135623842478f,
                              0.00027424818836152554f, 5.3182957344688475e-05f, 1.0313385246263351e-05f};
DEV void ph_prologue(const Params& p) {
  const size_t gtid = (size_t)blockIdx.x * NTHR + tidx(), gsz = (size_t)gridDim.x * NTHR;
  for (size_t i = gtid; i < (size_t)T_ * D_ / 8; i += gsz) {
    const float4 a = reinterpret_cast<const float4*>(p.x)[2 * i], b = reinterpret_cast<const float4*>(p.x)[2 * i + 1];
    uint4 w; w.x = cvtpk(a.x, a.y); w.y = cvtpk(a.z, a.w); w.z = cvtpk(b.x, b.y); w.w = cvtpk(b.z, b.w);
    reinterpret_cast<uint4*>(p.xb)[i] = w;
  }
  for (size_t i = gtid; i < (size_t)T_ * 8; i += gsz) {
    const int t = (int)(i >> 3), f = (int)(i & 7);
    const float ang = (float)p.pos[t] * INVF[f];
    p.cs[t * 16 + f] = cosf(ang); p.cs[t * 16 + 8 + f] = sinf(ang);
  }
  auto cvt_w = [&](const float* src, u16* dst, size_t n4) {
    for (size_t i = gtid; i < n4; i += gsz) {
      const float4 a = reinterpret_cast<const float4*>(src)[i];
      uint2 w; w.x = cvtpk(a.x, a.y); w.y = cvtpk(a.z, a.w);
      reinterpret_cast<uint2*>(dst)[i] = w;
    }
  };
  cvt_w(p.even_w_in, p.w16_in0, (size_t)D_ * LD0 / 4);
  cvt_w(p.even_w_out, p.w16_out0, (size_t)D_ * D_ / 4);
  cvt_w(p.odd_w_in, p.w16_in1, (size_t)D_ * NIN1 / 4);
  cvt_w(p.odd_w_out, p.w16_out1, (size_t)D_ * D_ / 4);
  for (size_t i = gtid; i < (size_t)2 * D_ * NE / 4; i += gsz) {
    const size_t L = i / ((size_t)D_ * NE / 4), r = i - L * ((size_t)D_ * NE / 4);
    const float4 a = reinterpret_cast<const float4*>(p.router_w)[i];
    const unsigned h0 = cvtpk(a.x, a.y), h1 = cvtpk(a.z, a.w);
    uint2 hi; hi.x = h0; hi.y = h1;
    uint2 lo; lo.x = cvtpk(a.x - __uint_as_float(h0 << 16), a.y - __uint_as_float(h0 & 0xffff0000u)); lo.y = cvtpk(a.z - __uint_as_float(h1 << 16), a.w - __uint_as_float(h1 & 0xffff0000u));
    reinterpret_cast<uint2*>(p.rw16 + (L * 2 + 0) * (size_t)D_ * NE)[r] = hi;
    reinterpret_cast<uint2*>(p.rw16 + (L * 2 + 1) * (size_t)D_ * NE)[r] = lo;
  }
  for (size_t i = gtid; i < 2 * 128 * 16; i += gsz) {
    const int n = (int)(i & 127), kc = (int)((i >> 7) & 15), ts = (int)(i >> 11);
    const float* pe = ts ? p.cmpv_pos : p.cmpk_pos; const float* w1 = ts ? p.cmpv_w1 : p.cmpk_w1;
    float s = 0.f;
    for (int k = kc * 128; k < kc * 128 + 128; ++k) s += pe[k] * w1[(size_t)k * 128 + n];
    atomicAdd(&p.pb[ts * 128 + n], s);
  }
}

DEV void ph_inproj0(const Params& p, GemmSmem& sm) {
  const int tid = tidx(), lane = tid & 63, wid = tid >> 6, wr = wid >> 1, wc = wid & 1, fr = lane & 15, fq = lane >> 4;
  constexpr int NT = LD0 / 128;
  for (ItemRange it = xcd_items(64 * NT); it.i < it.hi; it.i += it.step) {
    int mt, nt; dense_item<16, 2>(it.i, 64, mt, nt);
    const int m0 = mt * 256, n0 = nt * 128;
    const u16* ar0 = p.xb + (size_t)(m0 + (tid >> 3)) * D_ + (tid & 7) * 8;
    auto a_addr = [&](int i, int kt) { return ar0 + (size_t)i * 64 * D_ + kt * 64; };
    const u16* bb = p.w16_in0 + (size_t)(tid >> 4) * LD0 + n0 + 8 * (tid & 15);
    auto b_addr = [&](int kt) { return bb + (size_t)kt * 64 * LD0; };
    auto b_lo = [&](int) { return false; };
    auto epi = [&](f32x4 (&acc)[4][4]) {
#pragma unroll
      for (int mi = 0; mi < 4; ++mi) {
        const int row = m0 + wr * 64 + mi * 16 + fr;
#pragma unroll
        for (int ni = 0; ni < 4; ++ni) {
          f32x4 v = acc[mi][ni];
          const int col = n0 + wc * 64 + ni * 16 + fq * 4;
          const bool rope = (ni == 0) && (col < 1024 || (col >= 1536 && col < 2176));
          if (rope) {
            const float4 c_ = ld4(p.cs + row * 16 + 4 * (fq & 1)), s_ = ld4(p.cs + row * 16 + 8 + 4 * (fq & 1));
            const float p0 = __shfl_xor(v[0], 32), p1 = __shfl_xor(v[1], 32), p2 = __shfl_xor(v[2], 32), p3 = __shfl_xor(v[3], 32);
            const float sg = fq < 2 ? -1.f : 1.f;
            v[0] = v[0] * c_.x + sg * p0 * s_.x; v[1] = v[1] * c_.y + sg * p1 * s_.y; v[2] = v[2] * c_.z + sg * p2 * s_.z; v[3] = v[3] * c_.w + sg * p3 * s_.w;
          }
          st_bf4(p.qkv + (size_t)row * LD0 + col, v[0], v[1], v[2], v[3]);
        }
      }
    };
    gemm_core<4, false, true>(sm, 16, a_addr, b_addr, LD0, b_lo, epi);
  }
}

DEV void ph_outproj(const Params& p, GemmSmem& sm, const u16* W16, const float* resid) {
  const int tid = tidx(), lane = tid & 63, wid = tid >> 6, wr = wid >> 1, wc = wid & 1, fr = lane & 15, fq = lane >> 4;
  for (ItemRange it = xcd_items(64 * 8); it.i < it.hi; it.i += it.step) {
    int mt, nt; dense_item<8, 4>(it.i, 64, mt, nt);
    const int m0 = mt * 256, n0 = nt * 128;
    const u16* ar0 = p.ao + (size_t)(m0 + (tid >> 3)) * D_ + (tid & 7) * 8;
    auto a_addr = [&](int i, int kt) { return ar0 + (size_t)i * 64 * D_ + kt * 64; };
    const u16* bb = W16 + (size_t)(tid >> 4) * D_ + n0 + 8 * (tid & 15);
    auto b_addr = [&](int kt) { return bb + (size_t)kt * 64 * D_; };
    auto b_lo = [&](int) { return false; };
    auto epi = [&](f32x4 (&acc)[4][4]) {
#pragma unroll
      for (int mi = 0; mi < 4; ++mi)
#pragma unroll
        for (int ni = 0; ni < 4; ++ni) {
          const size_t idx = (size_t)(m0 + wr * 64 + mi * 16 + fr) * D_ + n0 + wc * 64 + ni * 16 + fq * 4;
          const float4 r = ld4(resid + idx);
          float4 o; o.x = ALPHA * r.x + acc[mi][ni][0]; o.y = ALPHA * r.y + acc[mi][ni][1]; o.z = ALPHA * r.z + acc[mi][ni][2]; o.w = ALPHA * r.w + acc[mi][ni][3];
          *reinterpret_cast<float4*>(p.hpre + idx) = o;
        }
    };
    gemm_core<4, false, true>(sm, 16, a_addr, b_addr, D_, b_lo, epi);
  }
}

DEV void ph_ln_mix(const Params& p, const float* g, const float* bt) {
  const int lane = tidx() & 63, gw = blockIdx.x * NWAVE + (tidx() >> 6), nw = gridDim.x * NWAVE;
  for (int tok = gw; tok < T_; tok += nw) {
    float v[2][8]; float s = 0.f;
#pragma unroll
    for (int i = 0; i < 2; ++i)
#pragma unroll
      for (int h = 0; h < 2; ++h) {
        const float4 a = ld4(p.hpre + (size_t)tok * D_ + (i * 64 + lane) * 8 + 4 * h);
        v[i][4 * h] = a.x; v[i][4 * h + 1] = a.y; v[i][4 * h + 2] = a.z; v[i][4 * h + 3] = a.w;
        s += a.x + a.y + a.z + a.w;
      }
    const float mu = wave_sum(s) * (1.f / D_);
    float ss = 0.f;
#pragma unroll
    for (int i = 0; i < 2; ++i)
#pragma unroll
      for (int c = 0; c < 8; ++c) { v[i][c] -= mu; ss += v[i][c] * v[i][c]; }
    const float rstd = rsqrtf(wave_sum(ss) * (1.f / D_) + LN_EPS);
#pragma unroll
    for (int i = 0; i < 2; ++i) {
      const int c0 = (i * 64 + lane) * 8;
      float y[8];
#pragma unroll
      for (int h = 0; h < 2; ++h) {
        const float4 gg = ld4(g + c0 + 4 * h), bb = ld4(bt + c0 + 4 * h);
        y[4 * h] = v[i][4 * h] * rstd * gg.x + bb.x; y[4 * h + 1] = v[i][4 * h + 1] * rstd * gg.y + bb.y;
        y[4 * h + 2] = v[i][4 * h + 2] * rstd * gg.z + bb.z; y[4 * h + 3] = v[i][4 * h + 3] * rstd * gg.w + bb.w;
      }
      u32x4_t hi, lo;
#pragma unroll
      for (int c = 0; c < 4; ++c) {
        const unsigned hw = cvtpk(y[2 * c], y[2 * c + 1]);
        hi[c] = hw;
        lo[c] = cvtpk(y[2 * c] - __uint_as_float(hw << 16), y[2 * c + 1] - __uint_as_float(hw & 0xffff0000u));
      }
      *reinterpret_cast<u32x4_t*>(p.x1b + (size_t)tok * D_ + c0) = hi;
      *reinterpret_cast<u32x4_t*>(p.x1lo + (size_t)tok * D_ + c0) = lo;
    }
  }
}

struct RouterSmem { u16 A[2][256][72]; u16 B[2][2][64][128]; };
DEV void ph_router_gemm(const Params& p, char* smem, const u16* RW16) {
  RouterSmem& sm = *reinterpret_cast<RouterSmem*>(smem);
  const int tid = tidx(), lane = tid & 63, wid = tid >> 6, wr = wid >> 1, wc = wid & 1, fr = lane & 15, fq = lane >> 4;
  const int q4 = (lane & 15) >> 2, p4 = lane & 3;
  for (ItemRange it = xcd_items(128 * 2); it.i < it.hi; it.i += it.step) {
    const int nt = it.i & 1, mt = it.i >> 1, m0 = mt * 128, n0 = nt * 128;
    const size_t ao0 = (size_t)(m0 + (tid >> 3)) * D_ + (tid & 7) * 8;
    const u16* bb = RW16 + (size_t)(tid >> 4) * NE + n0 + 8 * (tid & 15);
    f32x4 acc[2][4];
#pragma unroll
    for (int mi = 0; mi < 2; ++mi)
#pragma unroll
      for (int ni = 0; ni < 4; ++ni) acc[mi][ni] = f32x4{0.f, 0.f, 0.f, 0.f};
    u32x4_t ra[2][4], rb[2][4];
    auto gload = [&](auto PC, int kt) {
      constexpr int P = decltype(PC)::value;
      ra[P][0] = *reinterpret_cast<const u32x4_t*>(p.x1b + ao0 + kt * 64);
      ra[P][1] = *reinterpret_cast<const u32x4_t*>(p.x1b + ao0 + (size_t)64 * D_ + kt * 64);
      ra[P][2] = *reinterpret_cast<const u32x4_t*>(p.x1lo + ao0 + kt * 64);
      ra[P][3] = *reinterpret_cast<const u32x4_t*>(p.x1lo + ao0 + (size_t)64 * D_ + kt * 64);
      const u16* bp = bb + (size_t)kt * 64 * NE;
      rb[P][0] = *reinterpret_cast<const u32x4_t*>(bp);
      rb[P][1] = *reinterpret_cast<const u32x4_t*>(bp + (size_t)32 * NE);
      rb[P][2] = *reinterpret_cast<const u32x4_t*>(bp + (size_t)D_ * NE);
      rb[P][3] = *reinterpret_cast<const u32x4_t*>(bp + (size_t)D_ * NE + (size_t)32 * NE);
    };
    auto sstore = [&](auto PC) {
      constexpr int P = decltype(PC)::value;
#pragma unroll
      for (int i = 0; i < 4; ++i) *reinterpret_cast<u32x4_t*>(&sm.A[P][(tid >> 3) + 64 * i][(tid & 7) * 8]) = ra[P][i];
#pragma unroll
      for (int i = 0; i < 4; ++i) {
        const int k = (tid >> 4) + 32 * (i & 1), n8 = tid & 15;
        *reinterpret_cast<u32x4_t*>(&sm.B[P][i >> 1][k][(((n8 >> 1) ^ bswz(k)) << 4) + (n8 & 1) * 8]) = rb[P][i];
      }
    };
    auto compute = [&](auto PC) {
      constexpr int P = decltype(PC)::value;
#pragma unroll
      for (int ks = 0; ks < 2; ++ks) {
        bf16x8 ah[2], al[2], bh[4], bl[4];
#pragma unroll
        for (int mi = 0; mi < 2; ++mi) {
          ah[mi] = *reinterpret_cast<const bf16x8*>(&sm.A[P][wr * 32 + mi * 16 + fr][32 * ks + fq * 8]);
          al[mi] = *reinterpret_cast<const bf16x8*>(&sm.A[P][128 + wr * 32 + mi * 16 + fr][32 * ks + fq * 8]);
        }
#pragma unroll
        for (int ni = 0; ni < 4; ++ni) {
          const int k0 = 32 * ks + 8 * fq + q4, col = (((wc * 4 + ni) ^ bswz(k0)) << 4) + 4 * p4;
          { const v4i16_t lo = lds_tr(&sm.B[P][0][k0][col]), hh = lds_tr(&sm.B[P][0][k0 + 4][col]); bh[ni] = bf16x8{lo[0], lo[1], lo[2], lo[3], hh[0], hh[1], hh[2], hh[3]}; }
          { const v4i16_t lo = lds_tr(&sm.B[P][1][k0][col]), hh = lds_tr(&sm.B[P][1][k0 + 4][col]); bl[ni] = bf16x8{lo[0], lo[1], lo[2], lo[3], hh[0], hh[1], hh[2], hh[3]}; }
        }
#pragma unroll
        for (int mi = 0; mi < 2; ++mi)
#pragma unroll
          for (int ni = 0; ni < 4; ++ni) {
            acc[mi][ni] = __builtin_amdgcn_mfma_f32_16x16x32_bf16(bh[ni], ah[mi], acc[mi][ni], 0, 0, 0);
            acc[mi][ni] = __builtin_amdgcn_mfma_f32_16x16x32_bf16(bh[ni], al[mi], acc[mi][ni], 0, 0, 0);
            acc[mi][ni] = __builtin_amdgcn_mfma_f32_16x16x32_bf16(bl[ni], ah[mi], acc[mi][ni], 0, 0, 0);
          }
        __builtin_amdgcn_sched_barrier(0);
      }
    };
    using C0 = std::integral_constant<int, 0>; using C1 = std::integral_constant<int, 1>;
    gload(C0{}, 0); sstore(C0{}); gload(C1{}, 1); __syncthreads();
    int kt = 0;
    for (; kt + 2 < 16; kt += 2) {
      gload(C0{}, kt + 2); compute(C0{}); sstore(C1{}); __syncthreads();
      gload(C1{}, kt + 3); compute(C1{}); sstore(C0{}); __syncthreads();
    }
    compute(C0{}); sstore(C1{}); __syncthreads();
    compute(C1{}); __syncthreads();
#pragma unroll
    for (int mi = 0; mi < 2; ++mi)
#pragma unroll
      for (int ni = 0; ni < 4; ++ni) {
        float4 o; o.x = acc[mi][ni][0]; o.y = acc[mi][ni][1]; o.z = acc[mi][ni][2]; o.w = acc[mi][ni][3];
        *reinterpret_cast<float4*>(p.logits + (size_t)(m0 + wr * 32 + mi * 16 + fr) * NE + n0 + wc * 64 + ni * 16 + fq * 4) = o;
      }
  }
}

DEV void ph_route(const Params& p, const float* rbias, int* cnt, int* etok) {
  const int lane = tidx() & 63, gw = blockIdx.x * NWAVE + (tidx() >> 6), nw = gridDim.x * NWAVE;
  const int half = lane >> 5;
  for (int tok = gw; tok < T_; tok += nw) {
    float aff[4], val[4];
#pragma unroll
    for (int j = 0; j < 4; ++j) {
      const float lg = p.logits[(size_t)tok * NE + lane + 64 * j];
      aff[j] = 1.f / (1.f + expf(-lg));
      val[j] = aff[j] + rbias[lane + 64 * j];
    }
    float gs[8];
#pragma unroll
    for (int j = 0; j < 4; ++j) {
      float m1 = val[j];
#pragma unroll
      for (int o = 16; o; o >>= 1) m1 = fmaxf(m1, __shfl_xor(m1, o));
      const unsigned long long eq = __ballot(val[j] == m1);
      const int ceq = __popc((unsigned)(half ? (eq >> 32) : (eq & 0xffffffffull)));
      float m2 = (val[j] == m1) ? -INFINITY : val[j];
#pragma unroll
      for (int o = 16; o; o >>= 1) m2 = fmaxf(m2, __shfl_xor(m2, o));
      if (ceq >= 2) m2 = m1;
      const float mine = m1 + m2, other = __shfl_xor(mine, 32);
      gs[2 * j] = half ? other : mine; gs[2 * j + 1] = half ? mine : other;
    }
    bool gok[8];
#pragma unroll
    for (int g = 0; g < 8; ++g) {
      int rk = 0;
#pragma unroll
      for (int g2 = 0; g2 < 8; ++g2) rk += (gs[g2] > gs[g] || (gs[g2] == gs[g] && g2 < g)) ? 1 : 0;
      gok[g] = rk < 4;
    }
#pragma unroll
    for (int j = 0; j < 4; ++j) { const bool ok = half ? gok[2 * j + 1] : gok[2 * j]; if (!ok) val[j] = -INFINITY; }
    int my_e = 0; float my_a = 0.f, asum = 0.f;
#pragma unroll
    for (int k = 0; k < TOPK; ++k) {
      float bv = val[0]; int bi = lane;
#pragma unroll
      for (int j = 1; j < 4; ++j) if (val[j] > bv) { bv = val[j]; bi = lane + 64 * j; }
#pragma unroll
      for (int o = 32; o; o >>= 1) {
        const float ov = __shfl_xor(bv, o); const int oi = __shfl_xor(bi, o);
        if (ov > bv || (ov == bv && oi < bi)) { bv = ov; bi = oi; }
      }
      float a_sel = 0.f;
#pragma unroll
      for (int j = 0; j < 4; ++j) { const bool hit = (bi == lane + 64 * j); a_sel = hit ? aff[j] : a_sel; val[j] = hit ? -INFINITY : val[j]; }
      a_sel = wave_sum(a_sel);
      asum += a_sel;
      if (lane == k) { my_e = bi; my_a = a_sel; }
    }
    if (lane < TOPK) {
      const int ps = atomicAdd(&cnt[my_e], 1);
      p.eidx[tok * TOPK + lane] = my_e; p.epos[tok * TOPK + lane] = ps; p.gatev[tok * TOPK + lane] = my_a / asum * 2.5f;
      etok[(size_t)my_e * T_ + ps] = tok;
    }
  }
}

constexpr int MOE_TM = 320;
struct MoeTab { int cn[260]; int of[260]; int tf[260]; unsigned ao[2][5][NTHR]; };
DEV void moe_prep(MoeTab& mt, const int* cnt) {
  const int tid = tidx();
  if (tid < NE) mt.cn[tid] = cnt[tid];
  __syncthreads();
  if (tid == 0) {
    int a = 0, tl = 0;
    for (int e = 0; e < NE; ++e) { mt.of[e] = a; mt.tf[e] = tl; a += mt.cn[e]; tl += (mt.cn[e] + MOE_TM - 1) / MOE_TM; }
    mt.cn[NE] = T_; mt.of[NE] = NASG; mt.tf[NE] = tl; mt.of[NE + 1] = NASG + T_; mt.tf[NE + 1] = tl + (T_ + MOE_TM - 1) / MOE_TM;
  }
  __syncthreads();
}
DEV int moe_rows_per_tile(int cn, int tiles) { return (cn + tiles - 1) / tiles; }
struct MoeItem { int e, nt, r0, r1, of; };
template <int NPT> DEV MoeItem moe_item(const MoeTab& mt, int u) {
  int lo = 0, hi = NE;
  while (lo < hi) { const int mid = (lo + hi + 1) >> 1; if (NPT * mt.tf[mid] <= u) lo = mid; else hi = mid - 1; }
  MoeItem it; it.e = lo;
  const int tiles = mt.tf[lo + 1] - mt.tf[lo], local = u - NPT * mt.tf[lo], mtl = local / NPT, cn = mt.cn[lo];
  it.nt = local - mtl * NPT; it.of = mt.of[lo];
  const int per = moe_rows_per_tile(cn, tiles);
  it.r0 = mtl * per; it.r1 = (it.r0 + per < cn) ? it.r0 + per : cn;
  return it;
}

template <int NK, class FA, class FB, class FAN, class FBN, class FM, class FE>
DEV void moe_gemm5(GemmSmem& sm, u32x4_t (&ra)[5], f32x4_t (&rb)[2][4], FA a_addr, FB b_addr, FAN a_next, FBN b_next, int ldb, FM mid, FE epi) {
  constexpr int MI = 5;
  const int tid = tidx(), lane = tid & 63, wid = tid >> 6;
  const int wr = wid >> 1, wc = wid & 1, fr = lane & 15, fq = lane >> 4;
  const int n4 = tid & 31, kq = tid >> 5, q4 = (lane & 15) >> 2, p4 = lane & 3;
  f32x4 acc[MI][4];
#pragma unroll
  for (int mi = 0; mi < MI; ++mi)
#pragma unroll
    for (int ni = 0; ni < 4; ++ni) acc[mi][ni] = f32x4{0.f, 0.f, 0.f, 0.f};
  auto gloadA = [&](auto& fa, int kt) {
#pragma unroll
    for (int i = 0; i < MI; ++i) ra[i] = *reinterpret_cast<const u32x4_t*>(fa(i, kt));
  };
  auto gloadB = [&](auto PC, auto& fb, int kt) {
    constexpr int P = decltype(PC)::value;
    const float* bp = fb(kt);
#pragma unroll
    for (int i = 0; i < 4; ++i) rb[P][i] = *reinterpret_cast<const f32x4_t*>(bp + (size_t)(16 * i) * ldb);
  };
  auto storeA = [&](auto PC, int i) {
    constexpr int P = decltype(PC)::value;
    *reinterpret_cast<u32x4_t*>(&sm.A[P][(tid >> 3) + 64 * i][(tid & 7) * 8]) = ra[i];
  };
  auto storeB = [&](auto PC, int i) {
    constexpr int P = decltype(PC)::value;
    const f32x4_t v = rb[P][i];
    u32x2_t w; w[0] = cvtpk(v[0], v[1]); w[1] = cvtpk(v[2], v[3]);
    const int k = kq + 16 * i;
    *reinterpret_cast<u32x2_t*>(&sm.B[P][k][(((n4 >> 2) ^ bswz(k)) << 4) + (n4 & 3) * 4]) = w;
  };
  auto compute = [&](auto BC, auto STC, auto& fa, int kta) {
    constexpr int P = decltype(BC)::value;
    constexpr bool ST = decltype(STC)::value;
    using CQ = std::integral_constant<int, 1 - P>;
    auto rdB = [&](int ks, bf16x8 (&bf)[4]) {
#pragma unroll
      for (int ni = 0; ni < 4; ++ni) {
        const int k0 = 32 * ks + 8 * fq + q4, col = (((wc * 4 + ni) ^ bswz(k0)) << 4) + 4 * p4;
        const v4i16_t lo = lds_tr(&sm.B[P][k0][col]);
        const v4i16_t hh = lds_tr(&sm.B[P][k0 + 4][col]);
        bf[ni] = bf16x8{lo[0], lo[1], lo[2], lo[3], hh[0], hh[1], hh[2], hh[3]};
      }
    };
    auto rdA = [&](int ks, int mi) { return *reinterpret_cast<const bf16x8*>(&sm.A[P][wr * 80 + mi * 16 + fr][32 * ks + fq * 8]); };
    bf16x8 b0[4], b1[4], a0[3], a1[2], a2[3], a3[2];
    rdB(0, b0);
#pragma unroll
    for (int mi = 0; mi < 3; ++mi) a0[mi] = rdA(0, mi);
#pragma unroll
    for (int mi = 0; mi < 2; ++mi) a1[mi] = rdA(0, 3 + mi);
#pragma unroll
    for (int mi = 0; mi < 3; ++mi)
#pragma unroll
      for (int ni = 0; ni < 4; ++ni) acc[mi][ni] = __builtin_amdgcn_mfma_f32_16x16x32_bf16(b0[ni], a0[mi], acc[mi][ni], 0, 0, 0);
    if constexpr (ST) { storeB(CQ{}, 0); storeB(CQ{}, 1); }
    __builtin_amdgcn_sched_barrier(0);
#pragma unroll
    for (int mi = 0; mi < 3; ++mi) a2[mi] = rdA(1, mi);
#pragma unroll
    for (int mi = 0; mi < 2; ++mi)
#pragma unroll
      for (int ni = 0; ni < 4; ++ni) acc[3 + mi][ni] = __builtin_amdgcn_mfma_f32_16x16x32_bf16(b0[ni], a1[mi], acc[3 + mi][ni], 0, 0, 0);
    if constexpr (ST) { storeB(CQ{}, 2); storeB(CQ{}, 3); }
    __builtin_amdgcn_sched_barrier(0);
    rdB(1, b1);
#pragma unroll
    for (int mi = 0; mi < 2; ++mi) a3[mi] = rdA(1, 3 + mi);
#pragma unroll
    for (int mi = 0; mi < 3; ++mi)
#pragma unroll
      for (int ni = 0; ni < 4; ++ni) acc[mi][ni] = __builtin_amdgcn_mfma_f32_16x16x32_bf16(b1[ni], a2[mi], acc[mi][ni], 0, 0, 0);
    if constexpr (ST) { storeA(CQ{}, 0); storeA(CQ{}, 1); }
    __builtin_amdgcn_sched_barrier(0);
#pragma unroll
    for (int mi = 0; mi < 2; ++mi)
#pragma unroll
      for (int ni = 0; ni < 4; ++ni) acc[3 + mi][ni] = __builtin_amdgcn_mfma_f32_16x16x32_bf16(b1[ni], a3[mi], acc[3 + mi][ni], 0, 0, 0);
    if constexpr (ST) { storeA(CQ{}, 2); storeA(CQ{}, 3); storeA(CQ{}, 4); gloadA(fa, kta); }
    __builtin_amdgcn_sched_barrier(0);
  };
  using C0 = std::integral_constant<int, 0>; using C1 = std::integral_constant<int, 1>;
  using YES = std::true_type; using NO = std::false_type;
#pragma unroll
  for (int i = 0; i < MI; ++i) storeA(C0{}, i);
#pragma unroll
  for (int i = 0; i < 4; ++i) storeB(C0{}, i);
  gloadA(a_addr, 1);
  __syncthreads();
#pragma unroll 1
  for (int kt = 0; kt + 2 < NK; kt += 2) {
    gloadB(C0{}, b_addr, kt + 2); if (kt == 0) mid(); compute(C0{}, YES{}, a_addr, kt + 2); __syncthreads();
    gloadB(C1{}, b_addr, kt + 3); compute(C1{}, YES{}, a_addr, kt + 3); __syncthreads();
  }
  gloadB(C0{}, b_next, 0); compute(C0{}, YES{}, a_next, 0); __syncthreads();
  gloadB(C1{}, b_next, 1);
  compute(C1{}, NO{}, a_next, 0);
  epi(acc);
}


constexpr int TS_LD = 136;
DEV void ts_put(u16* T, int row, int col, float a, float b, float c, float d) { uint2 w; w.x = cvtpk(a, b); w.y = cvtpk(c, d); *reinterpret_cast<uint2*>(T + row * TS_LD + col) = w; }
template <int NCH, class FD> DEV void ts_flush(const u16* T, int rows, FD dst) {
  __syncthreads();
  for (int c = tidx(); c < rows * NCH; c += NTHR) {
    const int row = c / NCH, ch = c - row * NCH;
    u16* d = dst(row);
    if (d) *reinterpret_cast<u32x4_t*>(d + ch * 8) = *reinterpret_cast<const u32x4_t*>(T + row * TS_LD + ch * 8);
  }
  __syncthreads();
}

DEV void ph_moe1(const Params& p, GemmSmem& sm, MoeTab& mt, int layer, const int* cnt) {
  const int tid = tidx(), lane = tid & 63, wid = tid >> 6, wr = wid >> 1, wc = wid & 1, fr = lane & 15, fq = lane >> 4;
  moe_prep(mt, cnt);
  ItemRange it = xcd_items(mt.tf[NE + 1] * 4);
  if (it.i >= it.hi) return;
  const int v0 = 4 * (tid & 31);
  auto set_rows = [&](const MoeItem& m, int slot) {
#pragma unroll
    for (int i = 0; i < 5; ++i) {
      int ri = m.r0 + (tid >> 3) + 64 * i; ri = ri < m.r1 ? ri : m.r1 - 1;
      const int tk = m.e < NE ? p.etok[(size_t)m.e * T_ + ri] : ri;
      mt.ao[slot][i][tid] = (unsigned)tk * D_ + (tid & 7) * 8;
    }
  };
  auto b_ptr = [&](const MoeItem& m, int kt) -> const float* {
    const float* wg = m.e < NE ? p.w_gate + ((size_t)layer * NE + m.e) * D_ * 256 : p.sh_gate + (size_t)layer * D_ * 256;
    const float* wu = m.e < NE ? p.w_up + ((size_t)layer * NE + m.e) * D_ * 256 : p.sh_up + (size_t)layer * D_ * 256;
    return ((v0 & 63) >= 32 ? wu : wg) + (size_t)(kt * 64 + (tid >> 5)) * 256 + m.nt * 64 + (v0 >> 6) * 32 + (v0 & 31);
  };
  u32x4_t ra[5]; f32x4_t rb[2][4];
  MoeItem cur = moe_item<4>(mt, it.i);
  int slot = 0;
  set_rows(cur, 0);
  {
#pragma unroll
    for (int i = 0; i < 5; ++i) ra[i] = *reinterpret_cast<const u32x4_t*>(p.x1b + mt.ao[0][i][tid]);
#pragma unroll
    for (int j = 0; j < 2; ++j)
#pragma unroll
      for (int i = 0; i < 4; ++i) rb[j][i] = *reinterpret_cast<const f32x4_t*>(b_ptr(cur, j) + (size_t)(16 * i) * 256);
  }
  for (;;) {
    const int un = it.i + it.step;
    const bool has_next = un < it.hi;
    const MoeItem nxt = has_next ? moe_item<4>(mt, un) : cur;
    const int nslot = has_next ? slot ^ 1 : slot;
    auto a_addr = [&](int i, int kt) { return p.x1b + mt.ao[slot][i][tid] + kt * 64; };
    auto b_addr = [&](int kt) { return b_ptr(cur, kt); };
    auto a_next = [&](int i, int kt) { return p.x1b + mt.ao[nslot][i][tid] + kt * 64; };
    auto b_next = [&](int kt) { return b_ptr(nxt, kt); };
    auto mid = [&]() { if (has_next) set_rows(nxt, nslot); };
    auto epi = [&](f32x4 (&acc)[5][4]) {
#pragma unroll
      for (int mi = 0; mi < 5; ++mi) {
        const int idx = cur.r0 + wr * 80 + mi * 16 + fr;
        if (idx < cur.r1) {
#pragma unroll
          for (int n2 = 0; n2 < 2; ++n2) {
            float hv[4];
#pragma unroll
            for (int j = 0; j < 4; ++j) { const float g = acc[mi][n2][j], uu = acc[mi][n2 + 2][j]; hv[j] = g * __builtin_amdgcn_rcpf(1.f + __expf(-g)) * uu; }
            st_bf4(p.hbuf + (size_t)(cur.of + idx) * 256 + cur.nt * 64 + wc * 32 + n2 * 16 + fq * 4, hv[0], hv[1], hv[2], hv[3]);
          }
        }
      }
    };
    moe_gemm5<16>(sm, ra, rb, a_addr, b_addr, a_next, b_next, 256, mid, epi);
    if (!has_next) break;
    cur = nxt; it.i = un; slot = nslot;
  }
}

DEV void ph_moe2(const Params& p, GemmSmem& sm, MoeTab& mt, int layer, const int* cnt) {
  const int tid = tidx(), lane = tid & 63, wid = tid >> 6, wr = wid >> 1, wc = wid & 1, fr = lane & 15, fq = lane >> 4;
  moe_prep(mt, cnt);
  ItemRange it = xcd_items(mt.tf[NE + 1] * 8);
  if (it.i >= it.hi) return;
  auto a_ptr = [&](const MoeItem& m, int i, int kt) -> const u16* {
    const int rmax = m.r1 - 1 - m.r0 - (tid >> 3);
    int d = 64 * i; d = d < rmax ? d : rmax;
    return p.hbuf + (size_t)(m.of + m.r0 + (tid >> 3) + d) * 256 + (tid & 7) * 8 + kt * 64;
  };
  auto b_ptr = [&](const MoeItem& m, int kt) -> const float* {
    const float* wd = m.e < NE ? p.w_down + ((size_t)layer * NE + m.e) * 256 * D_ : p.sh_down + (size_t)layer * 256 * D_;
    return wd + (size_t)(kt * 64 + (tid >> 5)) * D_ + m.nt * 128 + 4 * (tid & 31);
  };
  u32x4_t ra[5]; f32x4_t rb[2][4];
  MoeItem cur = moe_item<8>(mt, it.i);
  {
#pragma unroll
    for (int i = 0; i < 5; ++i) ra[i] = *reinterpret_cast<const u32x4_t*>(a_ptr(cur, i, 0));
#pragma unroll
    for (int j = 0; j < 2; ++j)
#pragma unroll
      for (int i = 0; i < 4; ++i) rb[j][i] = *reinterpret_cast<const f32x4_t*>(b_ptr(cur, j) + (size_t)(16 * i) * D_);
  }
  for (;;) {
    const int un = it.i + it.step;
    const bool has_next = un < it.hi;
    const MoeItem nxt = has_next ? moe_item<8>(mt, un) : cur;
    auto a_addr = [&](int i, int kt) { return a_ptr(cur, i, kt); };
    auto b_addr = [&](int kt) { return b_ptr(cur, kt); };
    auto a_next = [&](int i, int kt) { return a_ptr(nxt, i, kt); };
    auto b_next = [&](int kt) { return b_ptr(nxt, kt); };
    auto mid = [&]() {};
    auto epi = [&](f32x4 (&acc)[5][4]) {
      u16* T = reinterpret_cast<u16*>(&sm);
      __syncthreads();
#pragma unroll
      for (int mi = 0; mi < 5; ++mi)
#pragma unroll
        for (int ni = 0; ni < 4; ++ni) ts_put(T, wr * 80 + mi * 16 + fr, wc * 64 + ni * 16 + fq * 4, acc[mi][ni][0], acc[mi][ni][1], acc[mi][ni][2], acc[mi][ni][3]);
      ts_flush<16>(T, cur.r1 - cur.r0, [&](int row) -> u16* { return p.ybuf + (size_t)(cur.of + cur.r0 + row) * D_ + cur.nt * 128; });
    };
    moe_gemm5<4>(sm, ra, rb, a_addr, b_addr, a_next, b_next, D_, mid, epi);
    if (!has_next) break;
    cur = nxt; it.i = un;
  }
}

DEV void ph_combine_ln(const Params& p, MoeTab& mt, const int* cnt, const float* g, const float* bt, float* outf, u16* outb, bool with_ffn, bool write_b = true) {
  const int lane = tidx() & 63, gw = blockIdx.x * NWAVE + (tidx() >> 6), nw = gridDim.x * NWAVE;
  moe_prep(mt, cnt);
  for (int tok = gw; tok < T_; tok += nw) {
    int sl = 0; float gk = 0.f;
    if (lane < TOPK) { sl = mt.of[p.eidx[tok * TOPK + lane]] + p.epos[tok * TOPK + lane]; gk = p.gatev[tok * TOPK + lane]; }
    u32x4_t y[9][2], xh[2], xl[2];
#pragma unroll
    for (int i = 0; i < 2; ++i) {
      xh[i] = reinterpret_cast<const u32x4_t*>(p.x1b + (size_t)tok * D_)[i * 64 + lane];
      xl[i] = reinterpret_cast<const u32x4_t*>(p.x1lo + (size_t)tok * D_)[i * 64 + lane];
      y[8][i] = reinterpret_cast<const u32x4_t*>(p.ybuf + (size_t)(NASG + tok) * D_)[i * 64 + lane];
    }
    float gks[8];
#pragma unroll
    for (int k = 0; k < TOPK; ++k) {
      const int slk = __builtin_amdgcn_readlane(sl, k);
      gks[k] = __builtin_bit_cast(float, __builtin_amdgcn_readlane(__builtin_bit_cast(int, gk), k));
#pragma unroll
      for (int i = 0; i < 2; ++i) y[k][i] = reinterpret_cast<const u32x4_t*>(p.ybuf + (size_t)slk * D_)[i * 64 + lane];
    }
    float v[2][8];
#pragma unroll
    for (int i = 0; i < 2; ++i)
#pragma unroll
      for (int c = 0; c < 4; ++c) {
        float a0 = ALPHA * (bflo(xh[i][c]) + bflo(xl[i][c])), a1 = ALPHA * (bfhi(xh[i][c]) + bfhi(xl[i][c]));
        if (with_ffn) {
          a0 += bflo(y[8][i][c]); a1 += bfhi(y[8][i][c]);
#pragma unroll
          for (int k = 0; k < TOPK; ++k) { a0 += gks[k] * bflo(y[k][i][c]); a1 += gks[k] * bfhi(y[k][i][c]); }
        }
        v[i][2 * c] = a0; v[i][2 * c + 1] = a1;
      }
    float s = 0.f;
#pragma unroll
    for (int i = 0; i < 2; ++i)
#pragma unroll
      for (int c = 0; c < 8; ++c) s += v[i][c];
    const float mu = wave_sum(s) * (1.f / D_);
    float ss = 0.f;
#pragma unroll
    for (int i = 0; i < 2; ++i)
#pragma unroll
      for (int c = 0; c < 8; ++c) { v[i][c] -= mu; ss += v[i][c] * v[i][c]; }
    const float rstd = rsqrtf(wave_sum(ss) * (1.f / D_) + LN_EPS);
#pragma unroll
    for (int i = 0; i < 2; ++i) {
      const int c0 = (i * 64 + lane) * 8;
      float o[8];
#pragma unroll
      for (int h = 0; h < 2; ++h) {
        const float4 gg = ld4(g + c0 + 4 * h), bb = ld4(bt + c0 + 4 * h);
        o[4 * h] = v[i][4 * h] * rstd * gg.x + bb.x; o[4 * h + 1] = v[i][4 * h + 1] * rstd * gg.y + bb.y;
        o[4 * h + 2] = v[i][4 * h + 2] * rstd * gg.z + bb.z; o[4 * h + 3] = v[i][4 * h + 3] * rstd * gg.w + bb.w;
        float4 w; w.x = o[4 * h]; w.y = o[4 * h + 1]; w.z = o[4 * h + 2]; w.w = o[4 * h + 3];
        *reinterpret_cast<float4*>(outf + (size_t)tok * D_ + c0 + 4 * h) = w;
      }
      if (write_b) {
        u32x4_t w; w[0] = cvtpk(o[0], o[1]); w[1] = cvtpk(o[2], o[3]); w[2] = cvtpk(o[4], o[5]); w[3] = cvtpk(o[6], o[7]);
        *reinterpret_cast<u32x4_t*>(outb + (size_t)tok * D_ + c0) = w;
      }
    }
  }
}

DEV void ph_inproj1(const Params& p, GemmSmem& sm) {
  const int tid = tidx(), lane = tid & 63, wid = tid >> 6, wr = wid >> 1, wc = wid & 1, fr = lane & 15, fq = lane >> 4;
  constexpr int NT = 21;
  for (ItemRange it = xcd_items(64 * (NT + 1)); it.i < it.hi; it.i += it.step) {
    int mt, nt; dense_item<16, 2>(it.i, 64, mt, nt);
    if (nt >= NT) continue;
    const int m0 = mt * 256, n0 = nt * 128;
    const u16* ar0 = p.xb + (size_t)(m0 + (tid >> 3)) * D_ + (tid & 7) * 8;
    auto a_addr = [&](int i, int kt) { return ar0 + (size_t)i * 64 * D_ + kt * 64; };
    const u16* bb = p.w16_in1 + (size_t)(tid >> 4) * NIN1 + n0 + 8 * (tid & 15);
    const bool bok = n0 + 8 * (tid & 15) < NIN1;
    const u16* bbv = bok ? bb : p.w16_in1 + (size_t)(tid >> 4) * NIN1;
    auto b_addr = [&](int kt) -> const u16* { return bbv + (size_t)kt * 64 * NIN1; };
    auto b_lo = [&](int) { return false; };
    auto epi = [&](f32x4 (&acc)[4][4]) {
#pragma unroll
      for (int mi = 0; mi < 4; ++mi) {
        const int row = m0 + wr * 64 + mi * 16 + fr;
#pragma unroll
        for (int ni = 0; ni < 4; ++ni) {
          f32x4 v = acc[mi][ni];
          const int col = n0 + wc * 64 + ni * 16 + fq * 4;
          const bool rope = (ni == 0) && (col < 1280 || (col >= 1536 && col < 1792) || (col >= 2048 && col < 2304));
          if (rope) {
            const float4 c_ = ld4(p.cs + row * 16 + 4 * (fq & 1)), s_ = ld4(p.cs + row * 16 + 8 + 4 * (fq & 1));
            const float p0 = __shfl_xor(v[0], 32), p1 = __shfl_xor(v[1], 32), p2 = __shfl_xor(v[2], 32), p3 = __shfl_xor(v[3], 32);
            const float sg = fq < 2 ? -1.f : 1.f;
            v[0] = v[0] * c_.x + sg * p0 * s_.x; v[1] = v[1] * c_.y + sg * p1 * s_.y; v[2] = v[2] * c_.z + sg * p2 * s_.z; v[3] = v[3] * c_.w + sg * p3 * s_.w;
          }
          if (col < LD1) st_bf4(p.qkv + (size_t)row * LD1 + col, v[0], v[1], v[2], v[3]);
          else if (col < NIN1) {
            float4 o; o.x = 1.f / (1.f + __expf(-v[0])); o.y = 1.f / (1.f + __expf(-v[1])); o.z = 1.f / (1.f + __expf(-v[2])); o.w = 1.f / (1.f + __expf(-v[3]));
            *reinterpret_cast<float4*>(p.gates + (size_t)row * 48 + (col - LD1)) = o;
          }
        }
      }
    };
    gemm_core<4, false, true>(sm, 16, a_addr, b_addr, NIN1, b_lo, epi, bok);
  }
}

DEV float gelu_tanh(float x) { const float u = 0.7978845608028654f * (x + 0.044715f * x * x * x); return 0.5f * x * (1.f + tanhf(u)); }
DEV void ph_cmp1(const Params& p, GemmSmem& sm) {
  const int tid = tidx(), lane = tid & 63, wid = tid >> 6, wr = wid >> 1, wc = wid & 1, fr = lane & 15, fq = lane >> 4;
  for (int u = blockIdx.x; u < 64; u += gridDim.x) {
    const int ts = u >> 5, mt = u & 31, m0 = mt * 128;
    const u16* ar[2];
#pragma unroll
    for (int i = 0; i < 2; ++i) {
      const int m_ = m0 + (tid >> 3) + 64 * i, bg = m_ >> 8; int c = m_ & 255; c = c < 255 ? c : 254;
      ar[i] = p.qkv + (size_t)((bg >> 2) * S_ + 16 * c) * LD1 + (ts ? 1280 : 1024) + (bg & 3) * 64 + (tid & 7) * 8;
    }
    auto a_addr = [&](int i, int kt) { return ar[i] + (size_t)kt * LD1; };
    const float* bb = (ts ? p.cmpv_w1 : p.cmpk_w1) + (size_t)(tid >> 5) * 128 + 4 * (tid & 31);
    auto b_addr = [&](int kt) { return bb + (size_t)kt * 64 * 128; };
    auto b_lo = [&](int) { return false; };
    auto epi = [&](f32x4 (&acc)[2][4]) {
#pragma unroll
      for (int mi = 0; mi < 2; ++mi)
#pragma unroll
        for (int ni = 0; ni < 4; ++ni) {
          const int m = m0 + wr * 32 + mi * 16 + fr, col = wc * 64 + ni * 16 + fq * 4;
          const float4 pbv = ld4(p.pb + ts * 128 + col);
          st_bf4(p.hid + ((size_t)ts * 4096 + m) * 128 + col, gelu_tanh(acc[mi][ni][0] + pbv.x), gelu_tanh(acc[mi][ni][1] + pbv.y),
                 gelu_tanh(acc[mi][ni][2] + pbv.z), gelu_tanh(acc[mi][ni][3] + pbv.w));
        }
    };
    gemm_core<2, false>(sm, 32, a_addr, b_addr, 128, b_lo, epi);
  }
}
DEV void ph_cmp2(const Params& p, GemmSmem& sm) {
  const int tid = tidx(), lane = tid & 63, wid = tid >> 6, wr = wid >> 1, wc = wid & 1, fr = lane & 15, fq = lane >> 4;
  for (int u = blockIdx.x; u < 64; u += gridDim.x) {
    const int ts = u >> 5, mt = u & 31, m0 = mt * 128;
    const u16* ar0 = p.hid + ((size_t)ts * 4096 + m0 + (tid >> 3)) * 128 + (tid & 7) * 8;
    auto a_addr = [&](int i, int kt) { return ar0 + (size_t)i * 64 * 128 + kt * 64; };
    const float* bb = (ts ? p.cmpv_w2 : p.cmpk_w2) + (size_t)(tid >> 5) * 64 + 4 * (tid & 31);
    const bool bok = 4 * (tid & 31) < 64;
    const float* bbv = bok ? bb : (ts ? p.cmpv_w2 : p.cmpk_w2) + (size_t)(tid >> 5) * 64;
    auto b_addr = [&](int kt) -> const float* { return bbv + (size_t)kt * 64 * 64; };
    auto b_lo = [&](int) { return false; };
    auto epi = [&](f32x4 (&acc)[2][4]) {
      if (wc == 0) {
#pragma unroll
        for (int mi = 0; mi < 2; ++mi)
#pragma unroll
          for (int ni = 0; ni < 4; ++ni) {
            const int m = m0 + wr * 32 + mi * 16 + fr, col = ni * 16 + fq * 4;
            st_bf4(p.cmpkv + ((size_t)ts * 4096 + m) * 64 + col, acc[mi][ni][0], acc[mi][ni][1], acc[mi][ni][2], acc[mi][ni][3]);
          }
      }
    };
    gemm_core<2, false>(sm, 2, a_addr, b_addr, 64, b_lo, epi, bok);
  }
}

using f32x16 = __attribute__((ext_vector_type(16))) float;
DEV int crow(int r, int hi) { return (r & 3) + 8 * (r >> 2) + 4 * hi; }
constexpr float LOG2E = 1.4426950408889634f;
constexpr float SCL2 = 0.125f * LOG2E;

struct WaveTile { u16 K[32][72]; u16 V[2][32][32]; };
struct KVTile { u16 K[32][72]; u16 V[2][32][32]; };
struct AttnState { float m, l; f32x16 o[2]; };

DEV void stage_load(u32x4_t (&rk)[4], u32x4_t (&rv)[4], const u16* Kb, const u16* Vb, int ld, long rowbase, int rowstep, int kcmax, int k0, int lane) {
#pragma unroll
  for (int it = 0; it < 4; ++it) {
    int kc = k0 + (lane >> 3) + 8 * it; kc = kc > kcmax ? kcmax : kc;
    const long row = rowbase + (long)kc * rowstep;
    rk[it] = *reinterpret_cast<const u32x4_t*>(Kb + row * ld + (lane & 7) * 8);
    rv[it] = *reinterpret_cast<const u32x4_t*>(Vb + row * ld + (lane & 7) * 8);
  }
}
DEV void stage_store(WaveTile& wt, const u32x4_t (&rk)[4], const u32x4_t (&rv)[4], int lane) {
  const int ch = lane & 7;
#pragma unroll
  for (int it = 0; it < 4; ++it) {
    const int j = (lane >> 3) + 8 * it;
    *reinterpret_cast<u32x4_t*>(&wt.K[j][ch * 8]) = rk[it];
    *reinterpret_cast<u32x4_t*>(&wt.V[ch >> 2][j][(ch & 3) * 8]) = rv[it];
  }
}
template <class TT> DEV f32x16 qk_tile(const TT& wt, const bf16x8 (&qf)[4], int r32, int hi) {
  f32x16 acc;
#pragma unroll
  for (int r = 0; r < 16; ++r) acc[r] = 0.f;
#pragma unroll
  for (int s = 0; s < 4; ++s) {
    const bf16x8 kf = *reinterpret_cast<const bf16x8*>(&wt.K[r32][16 * s + 8 * hi]);
    acc = __builtin_amdgcn_mfma_f32_32x32x16_bf16(kf, qf[s], acc, 0, 0, 0);
  }
  return acc;
}
template <class TT> DEV void pv_tile(const TT& wt, const float (&pr)[16], f32x16 (&o)[2], int lane) {
  const int hi = lane >> 5, g = (lane >> 4) & 1, q4 = (lane & 15) >> 2, p4 = lane & 3;
  bf16x8 pf[2];
#pragma unroll
  for (int s2 = 0; s2 < 2; ++s2) {
    u32x4_t w;
    w[0] = cvtpk(pr[8 * s2 + 0], pr[8 * s2 + 1]); w[1] = cvtpk(pr[8 * s2 + 2], pr[8 * s2 + 3]);
    w[2] = cvtpk(pr[8 * s2 + 4], pr[8 * s2 + 5]); w[3] = cvtpk(pr[8 * s2 + 6], pr[8 * s2 + 7]);
    pf[s2] = __builtin_bit_cast(bf16x8, w);
  }
#pragma unroll
  for (int dt = 0; dt < 2; ++dt)
#pragma unroll
    for (int s2 = 0; s2 < 2; ++s2) {
      const v4i16_t lo = lds_tr(&wt.V[dt][16 * s2 + 4 * hi + q4][16 * g + 4 * p4]);
      const v4i16_t hh = lds_tr(&wt.V[dt][16 * s2 + 8 + 4 * hi + q4][16 * g + 4 * p4]);
      const bf16x8 vf = {lo[0], lo[1], lo[2], lo[3], hh[0], hh[1], hh[2], hh[3]};
      o[dt] = __builtin_amdgcn_mfma_f32_32x32x16_bf16(vf, pf[s2], o[dt], 0, 0, 0);
    }
}
DEV void attn_init(AttnState& st) {
  st.m = -INFINITY; st.l = 0.f;
#pragma unroll
  for (int r = 0; r < 16; ++r) { st.o[0][r] = 0.f; st.o[1][r] = 0.f; }
}
template <bool USE_SEL>
DEV void attn_span(AttnState& st, WaveTile& wt, const bf16x8 (&qf)[4], const u16* Kb, const u16* Vb, int ld,
                   long rowbase, int rowstep, int kcmax, int kc_lo, int kc_hi, int qc, int W,
                   unsigned long long sel, unsigned long long selu, int lane, int qc_min, int qc_max) {
  const int r32 = lane & 31, hi = lane >> 5;
  if (kc_lo < 0) kc_lo = 0;
  if (kc_hi > kcmax) kc_hi = kcmax;
  const int full_hi = qc_min < kcmax ? qc_min : kcmax;
  auto skip = [&](int k0) -> bool { return USE_SEL && !((selu >> (k0 >> 6)) & 1ull); };
  int kc0 = kc_lo & ~31;
  while (kc0 <= kc_hi && skip(kc0)) kc0 += 32;
  if (kc0 > kc_hi) return;
  u32x4_t rk[4], rv[4];
  stage_load(rk, rv, Kb, Vb, ld, rowbase, rowstep, kcmax, kc0, lane);
  for (;;) {
    stage_store(wt, rk, rv, lane);
    int kn = kc0 + 32;
    while (kn <= kc_hi && skip(kn)) kn += 32;
    if (kn <= kc_hi) stage_load(rk, rv, Kb, Vb, ld, rowbase, rowstep, kcmax, kn, lane);
    WAVE_SYNC();
    const f32x16 s = qk_tile(wt, qf, r32, hi);
    const bool selbit = USE_SEL ? (((sel >> (kc0 >> 6)) & 1ull) != 0ull) : true;
    const bool full = (qc_min <= qc_max) && (kc0 + 31 <= full_hi) && (kc0 >= qc_max - W);
    float sv[16]; float mt = -INFINITY;
    if (full) {
      float rm = s[0];
#pragma unroll
      for (int r = 1; r < 16; ++r) rm = fmaxf(rm, s[r]);
      mt = selbit ? rm * SCL2 : -INFINITY;
    } else {
#pragma unroll
      for (int r = 0; r < 16; ++r) {
        const int kc = kc0 + crow(r, hi), dist = qc - kc;
        const bool ok = selbit && kc <= kcmax && dist >= 0 && dist <= W;
        sv[r] = ok ? s[r] * SCL2 : -INFINITY;
        mt = fmaxf(mt, sv[r]);
      }
    }
    mt = fmaxf(mt, __shfl_xor(mt, 32));
    const float mnew = fmaxf(st.m, mt), muse = (mnew == -INFINITY) ? 0.f : mnew;
    const float alpha = __builtin_amdgcn_exp2f(st.m - muse);
    st.m = mnew;
    float ps = 0.f;
    if (full) {
      const float sub = selbit ? muse : INFINITY;
#pragma unroll
      for (int r = 0; r < 16; ++r) { sv[r] = __builtin_amdgcn_exp2f(__builtin_fmaf(s[r], SCL2, -sub)); ps += sv[r]; }
    } else {
#pragma unroll
      for (int r = 0; r < 16; ++r) { sv[r] = __builtin_amdgcn_exp2f(sv[r] - muse); ps += sv[r]; }
    }
    st.l = st.l * alpha + ps;
    if (__any(alpha != 1.f)) {
#pragma unroll
      for (int r = 0; r < 16; ++r) { st.o[0][r] *= alpha; st.o[1][r] *= alpha; }
    }
    pv_tile(wt, sv, st.o, lane);
    if (kn > kc_hi) break;
    kc0 = kn;
  }
}
DEV void attn_finish(AttnState& st, float sink2) {
  float l = st.l + __shfl_xor(st.l, 32);
  if (sink2 > -INFINITY) l += __builtin_amdgcn_exp2f(sink2 - st.m);
  const float inv = l > 0.f ? 1.f / l : 0.f;
#pragma unroll
  for (int r = 0; r < 16; ++r) { st.o[0][r] *= inv; st.o[1][r] *= inv; }
}
DEV void attn_store_bf16(const AttnState& st, u16* orow, int hi) {
#pragma unroll
  for (int dt = 0; dt < 2; ++dt)
#pragma unroll
    for (int k4 = 0; k4 < 4; ++k4) {
      uint2 w; w.x = cvtpk(st.o[dt][4 * k4], st.o[dt][4 * k4 + 1]); w.y = cvtpk(st.o[dt][4 * k4 + 2], st.o[dt][4 * k4 + 3]);
      *reinterpret_cast<uint2*>(orow + 32 * dt + 8 * k4 + 4 * hi) = w;
    }
}
DEV void load_qf(bf16x8 (&qf)[4], const u16* qrow, int hi) {
#pragma unroll
  for (int s = 0; s < 4; ++s) qf[s] = *reinterpret_cast<const bf16x8*>(qrow + 16 * s + 8 * hi);
}

DEV void ph_attn0_mfma(const Params& p, WaveTile* wts) {
  const int tid = tidx(), lane = tid & 63, wid = tid >> 6, r32 = lane & 31, hi = lane >> 5;
  WaveTile& wt = wts[wid];
  const int gw = blockIdx.x * NWAVE + wid, nw = gridDim.x * NWAVE;
  for (int u = gw; u < 8192; u += nw) {
    AttnState st; attn_init(st);
    bf16x8 qf[4];
    if (u < 4096) {
      const int it = u & 7, res = (u >> 3) & 15, h = (u >> 7) & 7, b = u >> 10;
      const int i0 = it * 32, t = 16 * (i0 + r32) + res;
      const long row = (long)b * S_ + t;
      load_qf(qf, p.qkv + row * LD0 + h * 64, hi);
      const u16* Kb = p.qkv + 512 + h * 64; const u16* Vb = p.qkv + 1024 + h * 64;
      attn_span<false>(st, wt, qf, Kb, Vb, LD0, (long)b * S_ + res, 16, 255, i0 - 128, i0 + 31, i0 + r32, 128, 0ull, 0ull, lane, 1, 0);
      const int c = res >> 2;
      attn_span<false>(st, wt, qf, Kb, Vb, LD0, (long)b * S_ + (res & 3), 4, 1023, 4 * i0 + c - 128, 4 * (i0 + 31) + c, 4 * (i0 + r32) + c, 128, 0ull, 0ull, lane, 1, 0);
      attn_span<false>(st, wt, qf, Kb, Vb, LD0, (long)b * S_, 1, 4095, 16 * i0 + res - 128, 16 * (i0 + 31) + res, t, 128, 0ull, 0ull, lane, 1, 0);
      attn_finish(st, -INFINITY);
      attn_store_bf16(st, p.ao + row * D_ + h * 64, hi);
    } else {
      const int v = u - 4096, qt = v & 127, hb = (v >> 7) & 7, b = v >> 10, g = hb >> 2;
      const int t = 32 * qt + r32;
      const long row = (long)b * S_ + t;
      load_qf(qf, p.qkv + row * LD0 + 1536 + hb * 64, hi);
      attn_span<false>(st, wt, qf, p.qkv + 2048 + g * 64, p.qkv + 2176 + g * 64, LD0, (long)b * S_, 1, 4095, 32 * qt - 127, 32 * qt + 31, t, 127, 0ull, 0ull, lane, 32 * qt, 32 * qt + 31);
      attn_finish(st, p.even_sinks[hb] * LOG2E);
      attn_store_bf16(st, p.ao + row * D_ + 512 + hb * 64, hi);
    }
  }
}

struct Att1aSmem { KVTile tiles[2][2]; float imp[NWAVE][32][65]; float sc[NWAVE][64]; };
DEV void ph_attn1a(const Params& p, char* smem) {
  Att1aSmem& sm = *reinterpret_cast<Att1aSmem*>(smem);
  const int tid = tidx(), lane = tid & 63, wid = tid >> 6, r32 = lane & 31, hi = lane >> 5, gl = wid >> 2;
  const int sg = tid >> 8, sj = (tid & 255) >> 3, sc = tid & 7;
  for (int u = blockIdx.x; u < 1024; u += gridDim.x) {
    const int k = u >> 8, base = u & 255, bg = base & 7, x = base >> 3;
    const int qt = (k == 0) ? 127 - x : (k == 1) ? 64 + x : (k == 2) ? 63 - x : x;
    const int b = bg >> 1, gp = bg & 1;
    const int h = gp * 8 + wid, g = h >> 2;
    const int q0 = 32 * qt, t = q0 + r32;
    const long row = (long)b * S_ + t;
    const int qc = (t - 31) >> 4;
    int kc_hi = q0 >> 4; kc_hi = kc_hi > 254 ? 254 : kc_hi;
    const int ntile = (kc_hi >> 5) + 1;
    const u16* kp = p.cmpkv + ((size_t)((b * 4 + 2 * gp + sg) * 256) + sj) * 64 + sc * 8;
    const u16* vp = kp + (size_t)4096 * 64;
    for (int i = tid; i < NWAVE * 32 * 65; i += NTHR) (&sm.imp[0][0][0])[i] = 0.f;
    bf16x8 qf[4];
    load_qf(qf, p.qkv + row * LD1 + h * 64, hi);
    auto for_tiles = [&](auto&& body) {
      u32x4_t rk = *reinterpret_cast<const u32x4_t*>(kp), rv = *reinterpret_cast<const u32x4_t*>(vp);
      int cur = 0;
      for (int tt = 0; tt < ntile; ++tt) {
        KVTile& dst = sm.tiles[cur][sg];
        *reinterpret_cast<u32x4_t*>(&dst.K[sj][sc * 8]) = rk;
        *reinterpret_cast<u32x4_t*>(&dst.V[sc >> 2][sj][(sc & 3) * 8]) = rv;
        const int tn = tt + 1 < ntile ? tt + 1 : tt;
        rk = *reinterpret_cast<const u32x4_t*>(kp + (size_t)tn * 32 * 64);
        rv = *reinterpret_cast<const u32x4_t*>(vp + (size_t)tn * 32 * 64);
        __syncthreads();
        body(sm.tiles[cur][gl], tt * 32);
        cur ^= 1;
      }
      __syncthreads();
    };
    float m = -INFINITY, l = 0.f;
    for_tiles([&](const KVTile& tl, int kc0) {
      const f32x16 s = qk_tile(tl, qf, r32, hi);
      float sv[16]; float mt = -INFINITY;
#pragma unroll
      for (int rr = 0; rr < 16; ++rr) { const int kc = kc0 + crow(rr, hi); const bool ok = kc <= 254 && kc <= qc; sv[rr] = ok ? s[rr] * SCL2 : -INFINITY; mt = fmaxf(mt, sv[rr]); }
      mt = fmaxf(mt, __shfl_xor(mt, 32));
      const float mnew = fmaxf(m, mt), muse = (mnew == -INFINITY) ? 0.f : mnew;
      float ps = 0.f;
#pragma unroll
      for (int rr = 0; rr < 16; ++rr) ps += __builtin_amdgcn_exp2f(sv[rr] - muse);
      l = l * __builtin_amdgcn_exp2f(m - muse) + ps; m = mnew;
    });
    l += __shfl_xor(l, 32);
    const float inv = l > 0.f ? 1.f / l : 0.f, muse = (m == -INFINITY) ? 0.f : m;
    f32x16 o[2];
#pragma unroll
    for (int rr = 0; rr < 16; ++rr) { o[0][rr] = 0.f; o[1][rr] = 0.f; }
    for_tiles([&](const KVTile& tl, int kc0) {
      const f32x16 s = qk_tile(tl, qf, r32, hi);
      float pr[16];
#pragma unroll
      for (int rr = 0; rr < 16; ++rr) { const int kc = kc0 + crow(rr, hi); const bool ok = kc <= 254 && kc <= qc; pr[rr] = ok ? __builtin_amdgcn_exp2f(s[rr] * SCL2 - muse) * inv : 0.f; }
#pragma unroll
      for (int k4 = 0; k4 < 4; ++k4) {
        const int j = (kc0 >> 2) + 2 * k4 + hi;
        sm.imp[wid][r32][j] += pr[4 * k4] + pr[4 * k4 + 1] + pr[4 * k4 + 2] + 0.5f * pr[4 * k4 + 3];
        WAVE_SYNC();
        if (j + 1 < 64) sm.imp[wid][r32][j + 1] += 0.5f * pr[4 * k4 + 3];
        WAVE_SYNC();
      }
      pv_tile(tl, pr, o, lane);
    });
    const float g0 = p.gates[(size_t)row * 48 + h * 3];
#pragma unroll
    for (int dt = 0; dt < 2; ++dt)
#pragma unroll
      for (int k4 = 0; k4 < 4; ++k4) {
        float4 w; w.x = g0 * o[dt][4 * k4]; w.y = g0 * o[dt][4 * k4 + 1]; w.z = g0 * o[dt][4 * k4 + 2]; w.w = g0 * o[dt][4 * k4 + 3];
        *reinterpret_cast<float4*>(p.hpre + (size_t)row * D_ + h * 64 + 32 * dt + 8 * k4 + 4 * hi) = w;
      }
    for (int i = 0; i < 8; ++i) {
      const int pi = wid * 8 + i, grp = pi >> 5, q = pi & 31;
      const int tq = q0 + q, cur = tq >> 6;
      const float impq = (sm.imp[4 * grp][q][lane] + sm.imp[4 * grp + 1][q][lane]) + (sm.imp[4 * grp + 2][q][lane] + sm.imp[4 * grp + 3][q][lane]);
      const float score = (lane > cur) ? -1.f : ((lane == 0 || lane == cur || lane == cur - 1) ? 1.0e4f : impq);
      sm.sc[wid][lane] = score;
      WAVE_SYNC();
      int rk_ = 0;
#pragma unroll
      for (int jj = 0; jj < 64; jj += 4) {
        const float4 v = *reinterpret_cast<const float4*>(&sm.sc[wid][jj]);
        rk_ += (v.x > score || (v.x == score && jj < lane)) ? 1 : 0;
        rk_ += (v.y > score || (v.y == score && jj + 1 < lane)) ? 1 : 0;
        rk_ += (v.z > score || (v.z == score && jj + 2 < lane)) ? 1 : 0;
        rk_ += (v.w > score || (v.w == score && jj + 3 < lane)) ? 1 : 0;
      }
      WAVE_SYNC();
      const unsigned long long mask = __ballot(rk_ < 16 && lane <= cur);
      if (lane == 0) p.selmask[((size_t)b * S_ + tq) * 4 + 2 * gp + grp] = mask;
    }
    __syncthreads();
  }
}

template <class TT>
DEV void attn_tile_update(AttnState& st, const TT& tl, const bf16x8 (&qf)[4], int kc0, int qc, int W, int kcmax, bool selbit, bool full, int lane) {
  const int r32 = lane & 31, hi = lane >> 5;
  const f32x16 s = qk_tile(tl, qf, r32, hi);
  float sv[16]; float mt = -INFINITY;
  if (full) {
    float rm = s[0];
#pragma unroll
    for (int r = 1; r < 16; ++r) rm = fmaxf(rm, s[r]);
    mt = selbit ? rm * SCL2 : -INFINITY;
  } else {
#pragma unroll
    for (int r = 0; r < 16; ++r) {
      const int kc = kc0 + crow(r, hi), dist = qc - kc;
      const bool ok = selbit && kc <= kcmax && dist >= 0 && dist <= W;
      sv[r] = ok ? s[r] * SCL2 : -INFINITY;
      mt = fmaxf(mt, sv[r]);
    }
  }
  mt = fmaxf(mt, __shfl_xor(mt, 32));
  const float mnew = fmaxf(st.m, mt), muse = (mnew == -INFINITY) ? 0.f : mnew;
  const float alpha = __builtin_amdgcn_exp2f(st.m - muse);
  st.m = mnew;
  float ps = 0.f;
  if (full) {
    const float sub = selbit ? muse : INFINITY;
#pragma unroll
    for (int r = 0; r < 16; ++r) { sv[r] = __builtin_amdgcn_exp2f(__builtin_fmaf(s[r], SCL2, -sub)); ps += sv[r]; }
  } else {
#pragma unroll
    for (int r = 0; r < 16; ++r) { sv[r] = __builtin_amdgcn_exp2f(sv[r] - muse); ps += sv[r]; }
  }
  st.l = st.l * alpha + ps;
  if (__any(alpha != 1.f)) {
#pragma unroll
    for (int r = 0; r < 16; ++r) { st.o[0][r] *= alpha; st.o[1][r] *= alpha; }
  }
  pv_tile(tl, sv, st.o, lane);
}

template <bool USE_SEL>
DEV void attn_span_shared(AttnState& st, KVTile (*tiles)[2][2], const Params& p, const bf16x8 (&qf)[4], int b, int gp, int kcol, int vcol,
                          int t_lo, int t_hi, int qc, int W, unsigned long long sel, int q0) {
  const int tid = tidx(), lane = tid & 63, wid = tid >> 6, gl = wid >> 2;
  const int sg = tid >> 8, sj = (tid & 255) >> 3, sc = tid & 7;
  const u16* kp = p.qkv + (size_t)b * S_ * LD1 + kcol + (2 * gp + sg) * 64 + (size_t)sj * LD1 + sc * 8;
  const u16* vp = p.qkv + (size_t)b * S_ * LD1 + vcol + (2 * gp + sg) * 64 + (size_t)sj * LD1 + sc * 8;
  const int s_lo = t_lo >> 1, s_hi = t_hi >> 1;
  u32x4_t rk[2], rv[2];
#pragma unroll
  for (int h = 0; h < 2; ++h) {
    rk[h] = *reinterpret_cast<const u32x4_t*>(kp + (size_t)(2 * s_lo + h) * 32 * LD1);
    rv[h] = *reinterpret_cast<const u32x4_t*>(vp + (size_t)(2 * s_lo + h) * 32 * LD1);
  }
  int cur = 0;
  for (int sidx = s_lo; sidx <= s_hi; ++sidx) {
#pragma unroll
    for (int h = 0; h < 2; ++h) {
      KVTile& dst = tiles[cur][sg][h];
      *reinterpret_cast<u32x4_t*>(&dst.K[sj][sc * 8]) = rk[h];
      *reinterpret_cast<u32x4_t*>(&dst.V[sc >> 2][sj][(sc & 3) * 8]) = rv[h];
    }
    const int sn = sidx < s_hi ? sidx + 1 : sidx;
#pragma unroll
    for (int h = 0; h < 2; ++h) {
      rk[h] = *reinterpret_cast<const u32x4_t*>(kp + (size_t)(2 * sn + h) * 32 * LD1);
      rv[h] = *reinterpret_cast<const u32x4_t*>(vp + (size_t)(2 * sn + h) * 32 * LD1);
    }
    __syncthreads();
#pragma unroll
    for (int h = 0; h < 2; ++h) {
      const int t = 2 * sidx + h;
      if (t >= t_lo && t <= t_hi) {
        const int kc0 = t * 32;
        const bool selbit = USE_SEL ? (((sel >> (kc0 >> 6)) & 1ull) != 0ull) : true;
        const bool full = (kc0 + 31 <= q0) && (kc0 >= q0 + 31 - W);
        attn_tile_update(st, tiles[cur][gl][h], qf, kc0, qc, W, 4095, selbit, full, lane);
      }
    }
    cur ^= 1;
  }
  __syncthreads();
}

DEV void ph_attn1b(const Params& p, char* smem) {
  KVTile (*tiles)[2][2] = reinterpret_cast<KVTile (*)[2][2]>(smem);
  const int tid = tidx(), lane = tid & 63, wid = tid >> 6, r32 = lane & 31, hi = lane >> 5;
  for (int u = blockIdx.x; u < 1024; u += gridDim.x) {
    const int k = u >> 8, base = u & 255, bg = base & 7, x = base >> 3;
    const int qt = (k == 0) ? 127 - x : (k == 1) ? 64 + x : (k == 2) ? 63 - x : x;
    const int b = bg >> 1, gp = bg & 1;
    const int h = gp * 8 + wid, g = h >> 2;
    const int q0 = 32 * qt, t = q0 + r32;
    const long row = (long)b * S_ + t;
    bf16x8 qf[4];
    load_qf(qf, p.qkv + row * LD1 + h * 64, hi);
    const unsigned long long sel = p.selmask[(size_t)row * 4 + g];
    const float g1 = p.gates[(size_t)row * 48 + h * 3 + 1], g2 = p.gates[(size_t)row * 48 + h * 3 + 2];
    AttnState st; attn_init(st);
    attn_span_shared<true>(st, tiles, p, qf, b, gp, 1536, 1792, 0, qt, t, 1 << 30, sel, q0);
    attn_finish(st, -INFINITY);
    f32x16 acc[2];
#pragma unroll
    for (int rr = 0; rr < 16; ++rr) { acc[0][rr] = g1 * st.o[0][rr]; acc[1][rr] = g1 * st.o[1][rr]; }
    attn_init(st);
    const int wlo = q0 - 511 > 0 ? (q0 - 511) >> 5 : 0;
    attn_span_shared<false>(st, tiles, p, qf, b, gp, 2048, 2304, wlo, qt, t, 511, 0ull, q0);
    attn_finish(st, -INFINITY);
#pragma unroll
    for (int dt = 0; dt < 2; ++dt)
#pragma unroll
      for (int k4 = 0; k4 < 4; ++k4) {
        const float4 c = *reinterpret_cast<const float4*>(p.hpre + (size_t)row * D_ + h * 64 + 32 * dt + 8 * k4 + 4 * hi);
        uint2 w;
        w.x = cvtpk(c.x + acc[dt][4 * k4] + g2 * st.o[dt][4 * k4], c.y + acc[dt][4 * k4 + 1] + g2 * st.o[dt][4 * k4 + 1]);
        w.y = cvtpk(c.z + acc[dt][4 * k4 + 2] + g2 * st.o[dt][4 * k4 + 2], c.w + acc[dt][4 * k4 + 3] + g2 * st.o[dt][4 * k4 + 3]);
        *reinterpret_cast<uint2*>(p.ao + (size_t)row * D_ + h * 64 + 32 * dt + 8 * k4 + 4 * hi) = w;
      }
  }
}

enum { PH_PRO = 0, PH_IN0, PH_ATT0, PH_OUT0, PH_LN0, PH_RG0, PH_RT0, PH_M10, PH_M20, PH_CB0,
       PH_IN1, PH_C1, PH_C2, PH_ATT1A, PH_ATT1B, PH_OUT1, PH_LN1, PH_RG1, PH_RT1, PH_M11, PH_M21, PH_CB1 };

template <int PH> DEV void run_phase(const Params& p, char* smem) {
  GemmSmem& gs = *reinterpret_cast<GemmSmem*>(smem);
  WaveTile* wts = reinterpret_cast<WaveTile*>(smem);
  MoeTab& mt = *reinterpret_cast<MoeTab*>(smem + sizeof(GemmSmem));
  if constexpr (PH == PH_PRO) ph_prologue(p);
  else if constexpr (PH == PH_IN0) ph_inproj0(p, gs);
  else if constexpr (PH == PH_ATT0) ph_attn0_mfma(p, wts);
  else if constexpr (PH == PH_OUT0) ph_outproj(p, gs, p.w16_out0, p.x);
  else if constexpr (PH == PH_LN0) ph_ln_mix(p, p.mix_g, p.mix_b);
  else if constexpr (PH == PH_RG0) ph_router_gemm(p, smem, p.rw16);
  else if constexpr (PH == PH_RT0) ph_route(p, p.router_b, p.cnt, p.etok);
  else if constexpr (PH == PH_M10) ph_moe1(p, gs, mt, 0, p.cnt);
  else if constexpr (PH == PH_M20) ph_moe2(p, gs, mt, 0, p.cnt);
  else if constexpr (PH == PH_CB0) ph_combine_ln(p, mt, p.cnt, p.ffn_g, p.ffn_b, p.x2f, p.xb, true);
  else if constexpr (PH == PH_IN1) ph_inproj1(p, gs);
  else if constexpr (PH == PH_C1) ph_cmp1(p, gs);
  else if constexpr (PH == PH_C2) ph_cmp2(p, gs);
  else if constexpr (PH == PH_ATT1A) ph_attn1a(p, smem);
  else if constexpr (PH == PH_ATT1B) ph_attn1b(p, smem);
  else if constexpr (PH == PH_OUT1) ph_outproj(p, gs, p.w16_out1, p.x2f);
  else if constexpr (PH == PH_LN1) ph_ln_mix(p, p.mix_g + D_, p.mix_b + D_);
  else if constexpr (PH == PH_RG1) ph_router_gemm(p, smem, p.rw16 + (size_t)2 * D_ * NE);
  else if constexpr (PH == PH_RT1) ph_route(p, p.router_b + NE, p.cnt + 512, p.etok);
  else if constexpr (PH == PH_M11) ph_moe1(p, gs, mt, 1, p.cnt + 512);
  else if constexpr (PH == PH_M21) ph_moe2(p, gs, mt, 1, p.cnt + 512);
  else if constexpr (PH == PH_CB1) ph_combine_ln(p, mt, p.cnt + 512, p.ffn_g + D_, p.ffn_b + D_, p.out, p.xb, true, false);
}

constexpr int SMEM_NEED0 = (NWAVE * (int)sizeof(WaveTile) > (int)(sizeof(GemmSmem) + sizeof(MoeTab))) ? NWAVE * (int)sizeof(WaveTile) : (int)(sizeof(GemmSmem) + sizeof(MoeTab));
constexpr int SMEM_NEED1 = SMEM_NEED0 > (int)sizeof(RouterSmem) ? SMEM_NEED0 : (int)sizeof(RouterSmem);
constexpr int SMEM_NEED2 = SMEM_NEED1 > (int)sizeof(Att1aSmem) ? SMEM_NEED1 : (int)sizeof(Att1aSmem);
constexpr int SMEM_NEED = SMEM_NEED2 > 8 * (int)sizeof(KVTile) ? SMEM_NEED2 : 8 * (int)sizeof(KVTile);
constexpr int SMEM_BAR_OFF = (SMEM_NEED + 15) & ~15, SMEM_BYTES = SMEM_BAR_OFF + 16;
template <int PH, bool LAST> DEV void phase_and_sync(const Params& p, char* smem, const XcdBarrier& bar) {
  run_phase<PH>(p, smem);
  if constexpr (!LAST) xcd_barrier(bar);
}
template <int... PHS> struct PhaseList {};
template <int P0> DEV void run_list(const Params& p, char* smem, const XcdBarrier& bar, PhaseList<P0>) { phase_and_sync<P0, true>(p, smem, bar); }
template <int P0, int P1, int... REST> DEV void run_list(const Params& p, char* smem, const XcdBarrier& bar, PhaseList<P0, P1, REST...>) {
  phase_and_sync<P0, false>(p, smem, bar);
  run_list(p, smem, bar, PhaseList<P1, REST...>{});
}
using Program = PhaseList<PH_PRO, PH_IN0, PH_ATT0, PH_OUT0, PH_LN0, PH_RG0, PH_RT0, PH_M10, PH_M20, PH_CB0,
                          PH_IN1, PH_C1, PH_C2, PH_ATT1A, PH_ATT1B, PH_OUT1, PH_LN1, PH_RG1, PH_RT1, PH_M11, PH_M21, PH_CB1>;
struct KArgs { const void* in[25]; float* out; char* ws; };
constexpr size_t al256(size_t b) { return (b + 255) & ~(size_t)255; }
constexpr size_t OFF_BAR = 0;
constexpr size_t OFF_CNT = OFF_BAR + al256(16384);
constexpr size_t OFF_PB = OFF_CNT + al256(4096);
constexpr size_t OFF_ZERO_END = OFF_PB + al256(1024);
constexpr size_t OFF_CS = OFF_ZERO_END;
constexpr size_t OFF_XB = OFF_CS + al256((size_t)T_ * 16 * 4);
constexpr size_t OFF_QKV = OFF_XB + al256((size_t)T_ * D_ * 2);
constexpr size_t OFF_GATES = OFF_QKV + al256((size_t)T_ * 2624 * 2);
constexpr size_t OFF_AO = OFF_GATES + al256((size_t)T_ * 48 * 4);
constexpr size_t OFF_HPRE = OFF_AO + al256((size_t)T_ * D_ * 2);
constexpr size_t OFF_X1B = OFF_HPRE + al256((size_t)T_ * D_ * 4);
constexpr size_t OFF_X1LO = OFF_X1B + al256((size_t)T_ * D_ * 2);
constexpr size_t OFF_LOGITS = OFF_X1LO + al256((size_t)T_ * D_ * 2);
constexpr size_t OFF_EIDX = OFF_LOGITS + al256((size_t)T_ * NE * 4);
constexpr size_t OFF_GATEV = OFF_EIDX + al256((size_t)NASG * 4);
constexpr size_t OFF_EPOS = OFF_GATEV + al256((size_t)NASG * 4);
constexpr size_t OFF_ETOK = OFF_EPOS + al256((size_t)NASG * 4);
constexpr size_t OFF_HBUF = OFF_ETOK + al256((size_t)NE * T_ * 4);
constexpr size_t OFF_YBUF = OFF_HBUF + al256((size_t)NROWS * 256 * 2);
constexpr size_t OFF_X2F = OFF_YBUF + al256((size_t)NROWS * D_ * 2);
constexpr size_t OFF_HID = OFF_X2F + al256((size_t)T_ * D_ * 4);
constexpr size_t OFF_CMPKV = OFF_HID + al256((size_t)2 * 4096 * 128 * 2);
constexpr size_t OFF_SELMASK = OFF_CMPKV + al256((size_t)2 * 4096 * 64 * 2);
constexpr size_t OFF_W16IN0 = OFF_SELMASK + al256((size_t)T_ * 4 * 8);
constexpr size_t OFF_W16OUT0 = OFF_W16IN0 + al256((size_t)D_ * LD0 * 2);
constexpr size_t OFF_W16IN1 = OFF_W16OUT0 + al256((size_t)D_ * D_ * 2);
constexpr size_t OFF_W16OUT1 = OFF_W16IN1 + al256((size_t)D_ * NIN1 * 2);
constexpr size_t OFF_RW16 = OFF_W16OUT1 + al256((size_t)D_ * D_ * 2);
constexpr size_t WS_NEEDED = OFF_RW16 + al256((size_t)4 * D_ * NE * 2);

DEV Params make_params(const KArgs& k) {
  Params p;
  p.x = (const float*)k.in[0]; p.pos = (const int*)k.in[1];
  p.even_w_in = (const float*)k.in[2]; p.even_sinks = (const float*)k.in[3]; p.even_w_out = (const float*)k.in[4]; p.odd_w_in = (const float*)k.in[5];
  p.cmpk_pos = (const float*)k.in[6]; p.cmpk_w1 = (const float*)k.in[7]; p.cmpk_w2 = (const float*)k.in[8];
  p.cmpv_pos = (const float*)k.in[9]; p.cmpv_w1 = (const float*)k.in[10]; p.cmpv_w2 = (const float*)k.in[11];
  p.odd_w_out = (const float*)k.in[12]; p.mix_g = (const float*)k.in[13]; p.mix_b = (const float*)k.in[14];
  p.router_w = (const float*)k.in[15]; p.router_b = (const float*)k.in[16];
  p.w_gate = (const float*)k.in[17]; p.w_up = (const float*)k.in[18]; p.w_down = (const float*)k.in[19];
  p.sh_gate = (const float*)k.in[20]; p.sh_up = (const float*)k.in[21]; p.sh_down = (const float*)k.in[22];
  p.ffn_g = (const float*)k.in[23]; p.ffn_b = (const float*)k.in[24];
  p.out = k.out;
  char* w = k.ws;
  p.bar = (unsigned*)(w + OFF_BAR); p.cnt = (int*)(w + OFF_CNT); p.pb = (float*)(w + OFF_PB);
  p.cs = (float*)(w + OFF_CS); p.xb = (u16*)(w + OFF_XB); p.qkv = (u16*)(w + OFF_QKV); p.gates = (float*)(w + OFF_GATES);
  p.ao = (u16*)(w + OFF_AO); p.hpre = (float*)(w + OFF_HPRE); p.x1b = (u16*)(w + OFF_X1B); p.x1lo = (u16*)(w + OFF_X1LO);
  p.logits = (float*)(w + OFF_LOGITS); p.eidx = (int*)(w + OFF_EIDX); p.gatev = (float*)(w + OFF_GATEV); p.epos = (int*)(w + OFF_EPOS); p.etok = (int*)(w + OFF_ETOK);
  p.hbuf = (u16*)(w + OFF_HBUF); p.ybuf = (u16*)(w + OFF_YBUF); p.x2f = (float*)(w + OFF_X2F); p.hid = (u16*)(w + OFF_HID); p.cmpkv = (u16*)(w + OFF_CMPKV);
  p.selmask = (unsigned long long*)(w + OFF_SELMASK);
  p.w16_in0 = (u16*)(w + OFF_W16IN0); p.w16_out0 = (u16*)(w + OFF_W16OUT0); p.w16_in1 = (u16*)(w + OFF_W16IN1); p.w16_out1 = (u16*)(w + OFF_W16OUT1); p.rw16 = (u16*)(w + OFF_RW16);
  return p;
}

__global__ void __launch_bounds__(NTHR, 2) k_fused(KArgs ka) {
  extern __shared__ __attribute__((aligned(16))) char smem[];
  const Params p = make_params(ka);
  if (tidx() == 0) *reinterpret_cast<uint4*>(smem + SMEM_BAR_OFF) = make_uint4(0u, 0u, 0u, 0u);
  __syncthreads();
  XcdBarrier bar = xcd_barrier_post(p.bar, (volatile LAS unsigned*)(smem + SMEM_BAR_OFF));
  run_list(p, smem, bar, Program{});
}

extern "C" void kernel_launch(void* const* d_in, const int* in_sizes, int n_in, void* d_out, int out_size, void* d_ws, size_t ws_size, hipStream_t stream) {
  (void)in_sizes; (void)n_in; (void)out_size;
  if (ws_size < WS_NEEDED) return;
  KArgs ka{};
  for (int i = 0; i < 25; ++i) ka.in[i] = d_in[i];
  ka.out = (float*)d_out; ka.ws = (char*)d_ws;
  hipMemsetAsync(d_ws, 0, OFF_ZERO_END, stream);
  static int grid = 0;
  if (!grid) {
    int dev = 0, cus = 0, per_cu = 0;
    hipGetDevice(&dev);
    hipDeviceGetAttribute(&cus, hipDeviceAttributeMultiprocessorCount, dev);
    hipFuncSetAttribute((const void*)k_fused, hipFuncAttributeMaxDynamicSharedMemorySize, SMEM_BYTES);
    hipOccupancyMaxActiveBlocksPerMultiprocessor(&per_cu, (const void*)k_fused, NTHR, SMEM_BYTES);
    if (per_cu > 1) per_cu = 1;
    if (per_cu < 1) per_cu = 1;
    grid = cus * per_cu;
  }
  hipLaunchKernelGGL(k_fused, dim3(grid), dim3(NTHR), SMEM_BYTES, stream, ka);
}
```

```cpp
#include <hip/hip_runtime.h>
#include <hip/hip_bf16.h>
#include <stdint.h>
#include <math.h>
#include <utility>

typedef unsigned short u16;
using bf16x8 = __attribute__((ext_vector_type(8))) short;
using f32x4  = __attribute__((ext_vector_type(4))) float;

#define DEV __device__ __forceinline__
constexpr int TID_TAB_OFF = 156 * 1024;
__device__ __forceinline__ unsigned hw_wave_slot() { return (unsigned)__builtin_amdgcn_s_getreg((5 << 11) | 4); }
__device__ __forceinline__ int tidx() {
  const int wv = *reinterpret_cast<const __attribute__((address_space(3))) int*>((unsigned)(TID_TAB_OFF + 4 * hw_wave_slot()));
  int t = (__builtin_amdgcn_readfirstlane(wv) << 6) | (int)__builtin_amdgcn_mbcnt_hi(~0u, __builtin_amdgcn_mbcnt_lo(~0u, 0u));
  asm volatile("" : "+v"(t));
  return t;
}

constexpr int T_ = 16384, S_ = 4096, D_ = 1024;
constexpr int LD0 = 2304, LD1 = 2560, NIN1 = 2608;
constexpr int NE = 256, TOPK = 8, NASG = T_ * TOPK, NROWS = NASG + T_;
constexpr float ALPHA = 1.41421356237309515f;
constexpr float LN_EPS = 1e-5f;
constexpr int NTHR = 512, NWAVE = 8;


struct Params {
  const float* x; const int* pos;
  const float* even_w_in; const float* even_sinks; const float* even_w_out; const float* odd_w_in;
  const float* cmpk_pos; const float* cmpk_w1; const float* cmpk_w2; const float* cmpv_pos; const float* cmpv_w1; const float* cmpv_w2;
  const float* odd_w_out; const float* mix_g; const float* mix_b; const float* router_w; const float* router_b;
  const float* w_gate; const float* w_up; const float* w_down; const float* sh_gate; const float* sh_up; const float* sh_down;
  const float* ffn_g; const float* ffn_b;
  float* out;
  unsigned* bar; int* cnt; float* pb; float* cs; u16* xb; u16* qkv; float* gates; u16* ao; float* hpre;
  u16* x1b; u16* x1lo; float* logits; int* eidx; float* gatev; int* epos; int* etok;
  u16* hbuf; u16* ybuf; float* x2f; u16* hid; u16* cmpkv; unsigned long long* selmask;
  u16* w16_in0; u16* w16_out0; u16* w16_in1; u16* w16_out1; u16* rw16;
};

#define XB_TMO      128
#define XB_XCNT(j)  (256  + 64 * (j))
#define XB_XSUB(j)  (1280 + 64 * (j))
#define XB_XGEN(j)  (2304 + 64 * (j))
#define XB_TOP      3328
#define XB_TOPGEN   3392
#define XCD_BAR_WORDS 3456
#define XB_SPIN_CAP (1u << 18)
#define LAS __attribute__((address_space(3)))

__device__ __forceinline__ unsigned xb_ld(unsigned* p)              { return __hip_atomic_load(p, __ATOMIC_RELAXED, __HIP_MEMORY_SCOPE_AGENT); }
__device__ __forceinline__ unsigned xb_add(unsigned* p, unsigned v) { return __hip_atomic_fetch_add(p, v, __ATOMIC_RELAXED, __HIP_MEMORY_SCOPE_AGENT); }
__device__ __forceinline__ unsigned xb_xcc_id() { return (unsigned)__builtin_amdgcn_s_getreg((3 << 11) | 20) & 0xFu; }
#define XB_SPIN(cond, bar) do { unsigned _sp = 0; while (cond) { __builtin_amdgcn_s_sleep(1); \
    if ((++_sp & 255u) == 0u) { if (xb_ld(&(bar)[XB_TMO])) break; if (_sp > XB_SPIN_CAP) { atomicAdd(&(bar)[XB_TMO], 1u); break; } } } } while (0)

struct XcdBarrier {
    unsigned* bar; unsigned x;
    volatile LAS unsigned* st;
};

__device__ __forceinline__ XcdBarrier xcd_barrier_post(unsigned* bar, volatile LAS unsigned* st) {
    XcdBarrier b; b.bar = bar; b.x = xb_xcc_id(); b.st = st;
    if (tidx() == 0) (void)xb_add(&bar[XB_XCNT(b.x)], 1u);
    return b;
}
__device__ __forceinline__ void xcd_barrier_complete(unsigned* bar, unsigned x, unsigned& nloc, unsigned& nx) {
    const unsigned G = gridDim.x * gridDim.y * gridDim.z;
    unsigned sum, cnt, mine, sp = 0u;
    for (;;) {
        sum = 0u; cnt = 0u; mine = 0u;
#pragma unroll
        for (unsigned j = 0; j < 16; ++j) { const unsigned c = xb_ld(&bar[XB_XCNT(j)]); sum += c; cnt += (c > 0u) ? 1u : 0u; mine = (j == x) ? c : mine; }
        if (sum == G) break;
        __builtin_amdgcn_s_sleep(1);
        if ((++sp & 255u) == 0u) { if (xb_ld(&bar[XB_TMO])) break; if (sp > XB_SPIN_CAP) { atomicAdd(&bar[XB_TMO], 1u); break; } }
    }
    nloc = mine > 0u ? mine : 1u; nx = cnt > 0u ? cnt : 1u;
}

__device__ __forceinline__ void xcd_barrier(const XcdBarrier& b) {
    asm volatile("s_waitcnt vmcnt(0)" ::: "memory");
    __syncthreads();
    if (tidx() == 0) {
        unsigned* bar = b.bar;
        __builtin_amdgcn_s_waitcnt(0);
        unsigned nloc = b.st[0], nx = b.st[1];
        if (nloc == 0u) { xcd_barrier_complete(bar, b.x, nloc, nx); b.st[0] = nloc; b.st[1] = nx; }
        const unsigned old = xb_add(&bar[XB_XSUB(b.x)], 1u);
        const unsigned gen = old / nloc;
        if (old + 1u == (gen + 1u) * nloc) {
            __builtin_amdgcn_fence(__ATOMIC_RELEASE, "agent");
            asm volatile("s_waitcnt vmcnt(0)" ::: "memory");
            const unsigned og = xb_add(&bar[XB_TOP], 1u);
            const unsigned tg = og / nx;
            if (og + 1u == (tg + 1u) * nx) xb_add(&bar[XB_TOPGEN], 1u);
            else XB_SPIN(xb_ld(&bar[XB_TOPGEN]) == tg, bar);
            __builtin_amdgcn_fence(__ATOMIC_ACQUIRE, "agent");
            xb_add(&bar[XB_XGEN(b.x)], 1u);
            asm volatile("s_waitcnt vmcnt(0)" ::: "memory");
        } else {
            XB_SPIN(xb_ld(&bar[XB_XGEN(b.x)]) == gen, bar);
            __builtin_amdgcn_fence(__ATOMIC_ACQUIRE, "agent");
            asm volatile("s_waitcnt vmcnt(0)" ::: "memory");
        }
    }
    __syncthreads();
}


DEV float bf2f(u16 h) { return __uint_as_float(((unsigned)h) << 16); }
DEV float bflo(unsigned w) { return __uint_as_float(w << 16); }
DEV float bfhi(unsigned w) { return __uint_as_float(w & 0xffff0000u); }
DEV float wave_max(float v) { for (int o = 32; o; o >>= 1) v = fmaxf(v, __shfl_xor(v, o)); return v; }
DEV float wave_sum(float v) { for (int o = 32; o; o >>= 1) v += __shfl_xor(v, o); return v; }
#define WAVE_SYNC() asm volatile("s_waitcnt lgkmcnt(0)" ::: "memory")

typedef short v4i16_t __attribute__((ext_vector_type(4)));
typedef float f32x2_t __attribute__((ext_vector_type(2)));
typedef __bf16 bf16x2_t __attribute__((ext_vector_type(2)));
typedef unsigned u32x4_t __attribute__((ext_vector_type(4)));
typedef unsigned u32x2_t __attribute__((ext_vector_type(2)));
typedef float f32x4_t __attribute__((ext_vector_type(4)));
DEV unsigned cvtpk(float lo, float hi) { f32x2_t v = {lo, hi}; bf16x2_t b = __builtin_convertvector(v, bf16x2_t); return __builtin_bit_cast(unsigned, b); }
DEV v4i16_t lds_tr(const u16* ptr) { return __builtin_amdgcn_ds_read_tr16_b64_v4i16((LAS v4i16_t*)ptr); }

struct GemmSmem { u16 A[2][320][72]; u16 B[2][64][128]; };
DEV int bswz(int k) { return (k & 3) | (((k >> 3) & 1) << 2); }

template <int MI, bool SPLIT, bool B16 = false, class FA, class FB, class FL, class FE>
DEV void gemm_core(GemmSmem& sm, int nk, FA a_addr, FB b_addr, int ldb, FL b_lo, FE epi, bool b_ok = true) {
  const int tid = tidx(), lane = tid & 63, wid = tid >> 6;
  const int wr = wid >> 1, wc = wid & 1, fr = lane & 15, fq = lane >> 4;
  const int n4 = tid & 31, kq = tid >> 5, q4 = (lane & 15) >> 2, p4 = lane & 3;
  f32x4 acc[MI][4];
#pragma unroll
  for (int mi = 0; mi < MI; ++mi)
#pragma unroll
    for (int ni = 0; ni < 4; ++ni) acc[mi][ni] = f32x4{0.f, 0.f, 0.f, 0.f};
  static_assert(MI == 2 || MI == 4, "two register sets");
  u32x4_t ra[2][MI]; f32x4_t rb[2][4]; u32x4_t rh[2][2];
  auto gload = [&](auto PC, int kt) {
    constexpr int P = decltype(PC)::value;
#pragma unroll
    for (int i = 0; i < MI; ++i) ra[P][i] = *reinterpret_cast<const u32x4_t*>(a_addr(i, kt));
    if constexpr (B16) {
      const u16* bp = b_addr(kt);
      rh[P][0] = *reinterpret_cast<const u32x4_t*>(bp);
      rh[P][1] = *reinterpret_cast<const u32x4_t*>(bp + (size_t)32 * ldb);
    } else {
      const float* bp = b_addr(kt);
#pragma unroll
      for (int i = 0; i < 4; ++i) rb[P][i] = *reinterpret_cast<const f32x4_t*>(bp + (size_t)(16 * i) * ldb);
    }
  };
  constexpr int NB = B16 ? 2 : 4;
  auto storeA = [&](auto PC, int i) {
    constexpr int P = decltype(PC)::value;
    *reinterpret_cast<u32x4_t*>(&sm.A[P][(tid >> 3) + 64 * i][(tid & 7) * 8]) = ra[P][i];
  };
  auto storeB = [&](auto PC, int i, int kt) {
    constexpr int P = decltype(PC)::value;
    if constexpr (B16) {
      u32x4_t w = rh[P][i];
      if (!b_ok) w = u32x4_t{0u, 0u, 0u, 0u};
      const int k = (tid >> 4) + 32 * i, n8 = tid & 15;
      *reinterpret_cast<u32x4_t*>(&sm.B[P][k][(((n8 >> 1) ^ bswz(k)) << 4) + (n8 & 1) * 8]) = w;
    } else {
      const bool lo = SPLIT ? b_lo(kt) : false;
      f32x4_t v = rb[P][i];
      if (!b_ok) v = f32x4_t{0.f, 0.f, 0.f, 0.f};
      if (SPLIT && lo) {
        const unsigned h0 = cvtpk(v[0], v[1]), h1 = cvtpk(v[2], v[3]);
        v[0] -= __uint_as_float(h0 << 16); v[1] -= __uint_as_float(h0 & 0xffff0000u); v[2] -= __uint_as_float(h1 << 16); v[3] -= __uint_as_float(h1 & 0xffff0000u);
      }
      u32x2_t w; w[0] = cvtpk(v[0], v[1]); w[1] = cvtpk(v[2], v[3]);
      const int k = kq + 16 * i;
      *reinterpret_cast<u32x2_t*>(&sm.B[P][k][(((n4 >> 2) ^ bswz(k)) << 4) + (n4 & 3) * 4]) = w;
    }
  };
  auto sstore = [&](auto PC, int kt) {
#pragma unroll
    for (int i = 0; i < MI; ++i) storeA(PC, i);
#pragma unroll
    for (int i = 0; i < NB; ++i) storeB(PC, i, kt);
  };
  auto compute = [&](auto PC, auto STC, int kts) {
    constexpr int P = decltype(PC)::value;
    constexpr bool ST = decltype(STC)::value;
    using CQ = std::integral_constant<int, 1 - P>;
#pragma unroll
    for (int ks = 0; ks < 2; ++ks) {
      bf16x8 bf[4];
#pragma unroll
      for (int ni = 0; ni < 4; ++ni) {
        const int k0 = 32 * ks + 8 * fq + q4, col = (((wc * 4 + ni) ^ bswz(k0)) << 4) + 4 * p4;
        const v4i16_t lo = lds_tr(&sm.B[P][k0][col]);
        const v4i16_t hh = lds_tr(&sm.B[P][k0 + 4][col]);
        bf[ni] = bf16x8{lo[0], lo[1], lo[2], lo[3], hh[0], hh[1], hh[2], hh[3]};
      }
      bf16x8 af[MI];
#pragma unroll
      for (int mi = 0; mi < MI; ++mi) af[mi] = *reinterpret_cast<const bf16x8*>(&sm.A[P][wr * 16 * MI + mi * 16 + fr][32 * ks + fq * 8]);
#pragma unroll
      for (int mi = 0; mi < MI; ++mi)
#pragma unroll
        for (int ni = 0; ni < 4; ++ni) acc[mi][ni] = __builtin_amdgcn_mfma_f32_16x16x32_bf16(bf[ni], af[mi], acc[mi][ni], 0, 0, 0);
      if constexpr (ST) {
#pragma unroll
        for (int i = ks * (MI / 2); i < (ks + 1) * (MI / 2); ++i) storeA(CQ{}, i);
#pragma unroll
        for (int i = ks * (NB / 2); i < (ks + 1) * (NB / 2); ++i) storeB(CQ{}, i, kts);
      }
      __builtin_amdgcn_sched_barrier(0);
    }
  };
  using C0 = std::integral_constant<int, 0>; using C1 = std::integral_constant<int, 1>;
  using YES = std::true_type; using NO = std::false_type;
  int kt = 0;
  gload(C0{}, 0);
  sstore(C0{}, 0);
  gload(C1{}, 1);
  __syncthreads();
  for (; kt + 2 < nk; kt += 2) {
    gload(C0{}, kt + 2); compute(C0{}, YES{}, kt + 1); __syncthreads();
    gload(C1{}, kt + 3); compute(C1{}, YES{}, kt + 2); __syncthreads();
  }
  compute(C0{}, YES{}, kt + 1); __syncthreads();
  compute(C1{}, NO{}, 0); __syncthreads();
  epi(acc);
}

struct ItemRange { int i, hi, step; };
DEV ItemRange xcd_items(int I) {
  ItemRange r;
  if (gridDim.x & 7) { r.i = blockIdx.x; r.hi = I; r.step = gridDim.x; }
  else { const int x = blockIdx.x & 7; r.i = (int)((long)I * x / 8) + (blockIdx.x >> 3); r.hi = (int)((long)I * (x + 1) / 8); r.step = gridDim.x >> 3; }
  return r;
}
template <int GM, int GN> DEV void dense_item(int i, int MT, int& mt, int& nt) {
  const int g = i / (GM * GN), w = i % (GM * GN), gpm = MT / GM;
  mt = (g % gpm) * GM + w / GN; nt = (g / gpm) * GN + w % GN;
}
DEV float4 ld4(const float* ptr) { return *reinterpret_cast<const float4*>(ptr); }
DEV void st_bf4(u16* ptr, float a, float b, float c, float d) { uint2 w; w.x = cvtpk(a, b); w.y = cvtpk(c, d); *reinterpret_cast<uint2*>(ptr) = w; }

__constant__ float INVF[8] = {1.0f, 0.1939227432012558f, 0.03760603070259094f, 0.007292664609849453f, 0.0014142135623842478f,
                              0.00027424818836152554f, 5.3182957344688475e-05f, 1.0313385246263351e-05f};
DEV void ph_prologue(const Params& p) {
  const size_t gtid = (size_t)blockIdx.x * NTHR + tidx(), gsz = (size_t)gridDim.x * NTHR;
  for (size_t i = gtid; i < (size_t)T_ * D_ / 8; i += gsz) {
    const float4 a = reinterpret_cast<const float4*>(p.x)[2 * i], b = reinterpret_cast<const float4*>(p.x)[2 * i + 1];
    uint4 w; w.x = cvtpk(a.x, a.y); w.y = cvtpk(a.z, a.w); w.z = cvtpk(b.x, b.y); w.w = cvtpk(b.z, b.w);
    reinterpret_cast<uint4*>(p.xb)[i] = w;
  }
  for (size_t i = gtid; i < (size_t)T_ * 8; i += gsz) {
    const int t = (int)(i >> 3), f = (int)(i & 7);
    const float ang = (float)p.pos[t] * INVF[f];
    p.cs[t * 16 + f] = cosf(ang); p.cs[t * 16 + 8 + f] = sinf(ang);
  }
  auto cvt_w = [&](const float* src, u16* dst, size_t n4) {
    for (size_t i = gtid; i < n4; i += gsz) {
      const float4 a = reinterpret_cast<const float4*>(src)[i];
      uint2 w; w.x = cvtpk(a.x, a.y); w.y = cvtpk(a.z, a.w);
      reinterpret_cast<uint2*>(dst)[i] = w;
    }
  };
  auto cvt_wt = [&](const float* src, u16* dst, int N, int NP) {
    for (size_t i = gtid; i < (size_t)NP * (D_ / 8); i += gsz) {
      const int n = (int)(i % NP), k8 = (int)(i / NP);
      u32x4_t w = u32x4_t{0u, 0u, 0u, 0u};
      if (n < N) {
        float v[8];
#pragma unroll
        for (int j = 0; j < 8; ++j) v[j] = src[(size_t)(k8 * 8 + j) * N + n];
        w[0] = cvtpk(v[0], v[1]); w[1] = cvtpk(v[2], v[3]); w[2] = cvtpk(v[4], v[5]); w[3] = cvtpk(v[6], v[7]);
      }
      *reinterpret_cast<u32x4_t*>(dst + (size_t)n * D_ + k8 * 8) = w;
    }
  };
  cvt_wt(p.even_w_in, p.w16_in0, LD0, LD0);
  cvt_wt(p.even_w_out, p.w16_out0, D_, D_);
  cvt_wt(p.odd_w_in, p.w16_in1, NIN1, 2816);
  cvt_wt(p.odd_w_out, p.w16_out1, D_, D_);
  for (size_t i = gtid; i < (size_t)2 * D_ * NE / 4; i += gsz) {
    const size_t L = i / ((size_t)D_ * NE / 4), r = i - L * ((size_t)D_ * NE / 4);
    const float4 a = reinterpret_cast<const float4*>(p.router_w)[i];
    const unsigned h0 = cvtpk(a.x, a.y), h1 = cvtpk(a.z, a.w);
    uint2 hi; hi.x = h0; hi.y = h1;
    uint2 lo; lo.x = cvtpk(a.x - __uint_as_float(h0 << 16), a.y - __uint_as_float(h0 & 0xffff0000u)); lo.y = cvtpk(a.z - __uint_as_float(h1 << 16), a.w - __uint_as_float(h1 & 0xffff0000u));
    reinterpret_cast<uint2*>(p.rw16 + (L * 2 + 0) * (size_t)D_ * NE)[r] = hi;
    reinterpret_cast<uint2*>(p.rw16 + (L * 2 + 1) * (size_t)D_ * NE)[r] = lo;
  }
  for (size_t i = gtid; i < 2 * 128 * 16; i += gsz) {
    const int n = (int)(i & 127), kc = (int)((i >> 7) & 15), ts = (int)(i >> 11);
    const float* pe = ts ? p.cmpv_pos : p.cmpk_pos; const float* w1 = ts ? p.cmpv_w1 : p.cmpk_w1;
    float s = 0.f;
    for (int k = kc * 128; k < kc * 128 + 128; ++k) s += pe[k] * w1[(size_t)k * 128 + n];
    atomicAdd(&p.pb[ts * 128 + n], s);
  }
}

namespace pg8 {
#define PG8_LAS __attribute__((address_space(3)))
typedef unsigned short bf16_t;
typedef short bf16x8 __attribute__((ext_vector_type(8)));
typedef float f32x4 __attribute__((ext_vector_type(4)));
typedef unsigned u32x4 __attribute__((ext_vector_type(4)));
constexpr int BM = 256, BK = 64, HALF = 128, HTB = HALF * BK * 2  , STAGE_BYTES = 8 * HTB, NXCD = 8, WGM = 8;

__host__ __device__ __forceinline__ int lds_byte(int r, int c) { const int st = (r >> 4) * 2 + (c >> 5), rr = r & 15, cc = c & 31, ob = rr * 64 + cc * 2; return st * 1024 + (ob ^ (((ob >> 9) & 1) << 5)); }
__host__ __device__ __forceinline__ void stage_rc(int b, int& R, int& C) { const int st = b / 1024, sb = b % 1024, swz = sb ^ (((sb >> 9) & 1) << 5); R = (st >> 1) * 16 + swz / 64; C = (st & 1) * 32 + (swz % 64) / 2; }
__host__ __device__ __forceinline__ int perm32(int rho) { const int n = rho >> 4, i = rho & 15; return 8 * (i >> 2) + 4 * n + (i & 3); }

struct Unit { int pm, pn; };
struct Gemm { const bf16_t* A; const bf16_t* Bt; int M, N, K; };

struct StaticOrder {
    int nM, nN, nwg, G, c;
    __host__ __device__ void init(int M, int N, int G_, int c_) { nM = M / BM; nN = N / BM; nwg = nM * nN; G = G_; c = c_; }
    __host__ __device__ bool next(int i, Unit& u) const {
        const long L = (long)i * G + c; if (L >= nwg) return false;
        int wgid = (int)L; { const int q = nwg / NXCD, r = nwg % NXCD, xcd = wgid % NXCD, off = wgid / NXCD; wgid = (xcd < r ? xcd * (q + 1) : r * (q + 1) + (xcd - r) * q) + off; }
        const int nig = WGM * nN, gid = wgid / nig, fm = gid * WGM, gsz = (nM - fm) < WGM ? (nM - fm) : WGM;
        u.pm = fm + ((wgid % nig) % gsz); u.pn = (wgid % nig) / gsz; return true;
    }
    __device__ __forceinline__ void a_ready(const Unit&) const {}
    __device__ __forceinline__ void done(const Unit&) const {}
};
template <class Epi, class Sched, bool STAMP = false>
__device__ __forceinline__ void gemm_phase(PG8_LAS unsigned char* lds, const Gemm g, const Sched& S, const Epi& E, unsigned long long* stamps) {
    const int tid = tidx(), wid = __builtin_amdgcn_readfirstlane(tid >> 6), lane = tid & 63, wr = wid >> 2, wc = wid & 3, fr = lane & 15, fq = lane >> 4;
    const int K = g.K, nt = K / BK;
    int ts_lo = 0, ts_hi = 0, nts = 0; const unsigned long long rt_entry = STAMP ? (unsigned long long)wall_clock64() : 0ull;
#define PG8_STAMP() do { if (STAMP && wid == 0 && nts < 64) { const unsigned long long _c = (unsigned long long)clock64(); \
        ts_lo = (lane == nts) ? (int)(unsigned)_c : ts_lo; ts_hi = (lane == nts) ? (int)(unsigned)(_c >> 32) : ts_hi; ++nts; } } while (0)
    PG8_STAMP();
    unsigned voffA[2], voffB[2];
#pragma unroll
    for (int i = 0; i < 2; ++i) { int R, C; stage_rc(tid * 16 + i * 8192, R, C); const int Rb = Epi::PERM ? ((R & ~31) + perm32(R & 31)) : R;
        voffA[i] = (unsigned)(R * K + C) * 2u; voffB[i] = (unsigned)(Rb * K + C) * 2u; }
    const size_t kstep = (size_t)(BK * 2);
    const size_t hstep = (size_t)HALF * K * 2;
    const size_t tstep = 2 * hstep;
    const unsigned ldsw = (unsigned)wid * 1024u;
    const int aoff = lds_byte(wr * 64 + fr, fq * 8), boff = lds_byte(wc * 32 + fr, fq * 8);
#define PG8_SA(b, h) (((b) * 2 + (h)) * HTB)
#define PG8_SB(b, h) ((4 + (b) * 2 + (h)) * HTB)
#define PG8_STAGE(bufoff, gbase, voff) do { _Pragma("unroll") for (int _i = 0; _i < 2; ++_i) \
        __builtin_amdgcn_global_load_lds((const unsigned*)((const char*)(gbase) + (voff)[_i]), (PG8_LAS unsigned*)(lds + (bufoff) + ldsw + _i * 8192), 16, 0, 0); } while (0)
#define PG8_LDA(dst, b, h) do { _Pragma("unroll") for (int m = 0; m < 4; ++m) _Pragma("unroll") for (int k = 0; k < 2; ++k) dst[m][k] = *(const PG8_LAS bf16x8*)(lds + PG8_SA(b, h) + aoff + m * 2048 + k * 1024); } while (0)
#define PG8_LDB(dst, b, h) do { _Pragma("unroll") for (int n = 0; n < 2; ++n) _Pragma("unroll") for (int k = 0; k < 2; ++k) dst[n][k] = *(const PG8_LAS bf16x8*)(lds + PG8_SB(b, h) + boff + n * 2048 + k * 1024); } while (0)
#define PG8_MMA(ai, bj, At, Bt) do { __builtin_amdgcn_s_setprio(1); _Pragma("unroll") for (int m = 0; m < 4; ++m) _Pragma("unroll") for (int n = 0; n < 2; ++n) _Pragma("unroll") for (int k = 0; k < 2; ++k) \
        acc[ai][bj][m][n] = __builtin_amdgcn_mfma_f32_16x16x32_bf16(Bt[n][k], At[m][k], acc[ai][bj][m][n], 0, 0, 0); __builtin_amdgcn_s_setprio(0); } while (0)
#define PG8_WAIT_V(n) asm volatile("s_waitcnt vmcnt(" #n ")" ::: "memory")
#define PG8_WAIT_L(n) asm volatile("s_waitcnt lgkmcnt(" #n ")" ::: "memory")
#define PG8_BAR __builtin_amdgcn_s_barrier()
#define PG8_SCHED __builtin_amdgcn_sched_barrier(0)
    Unit cur, nxt; int ui = 0;
    if (!S.next(0, cur)) return;
    f32x4 acc[2][2][4][2];
#pragma unroll
    for (int a = 0; a < 2; ++a)
#pragma unroll
        for (int b = 0; b < 2; ++b)
#pragma unroll
            for (int m = 0; m < 4; ++m)
#pragma unroll
                for (int n = 0; n < 2; ++n) acc[a][b][m][n] = (f32x4){0.f, 0.f, 0.f, 0.f};
    bf16x8 At[4][2], B0[2][2], B1[2][2];
    const char* cA = (const char*)g.A + (size_t)cur.pm * tstep; const char* cB = (const char*)g.Bt + (size_t)cur.pn * tstep;
    S.a_ready(cur);
    PG8_STAGE(PG8_SB(0, 0), cB, voffB); PG8_STAGE(PG8_SA(0, 0), cA, voffA); PG8_STAGE(PG8_SB(0, 1), cB + hstep, voffB); PG8_STAGE(PG8_SA(0, 1), cA + hstep, voffA);
    if (wr == 1) PG8_BAR;
    PG8_WAIT_V(4); PG8_BAR;
    PG8_STAGE(PG8_SB(1, 0), cB + kstep, voffB); PG8_STAGE(PG8_SA(1, 0), cA + kstep, voffA); PG8_STAGE(PG8_SB(1, 1), cB + hstep + kstep, voffB);
    PG8_WAIT_V(6); PG8_BAR;
    PG8_STAMP();
    for (;;) {
        const bool has_next = S.next(ui + 1, nxt);
        const char* nA = has_next ? (const char*)g.A + (size_t)nxt.pm * tstep : cA; const char* nB = has_next ? (const char*)g.Bt + (size_t)nxt.pn * tstep : cB;
        for (int t = 0; t < nt; t += 2) {
            const bool last = (t == nt - 2);
            const char* a1 = cA + (size_t)(t + 1) * kstep;
            const char* a2 = last ? nA : cA + (size_t)(t + 2) * kstep; const char* b2 = last ? nB : cB + (size_t)(t + 2) * kstep;
            const char* a3 = a2 + kstep; const char* b3 = b2 + kstep;
            if (last && has_next) S.a_ready(nxt);
            PG8_LDB(B0, 0, 0); PG8_SCHED; PG8_LDA(At, 0, 0); PG8_STAGE(PG8_SA(1, 1), a1 + hstep, voffA);
            PG8_WAIT_L(8); PG8_BAR; PG8_WAIT_L(0); PG8_MMA(0, 0, At, B0); PG8_BAR; PG8_SCHED;
            PG8_LDB(B1, 0, 1); PG8_STAGE(PG8_SB(0, 0), b2, voffB);
            PG8_BAR; PG8_WAIT_L(0); PG8_MMA(0, 1, At, B1); PG8_BAR;
            PG8_LDA(At, 0, 1); PG8_STAGE(PG8_SA(0, 0), a2, voffA);
            PG8_BAR; PG8_WAIT_L(0); PG8_MMA(1, 0, At, B0); PG8_BAR; PG8_SCHED;
            PG8_STAGE(PG8_SB(0, 1), b2 + hstep, voffB);
            PG8_WAIT_V(6); PG8_BAR; PG8_MMA(1, 1, At, B1); PG8_BAR;
            PG8_LDB(B0, 1, 0); PG8_SCHED; PG8_LDA(At, 1, 0); PG8_STAGE(PG8_SA(0, 1), a2 + hstep, voffA);
            PG8_WAIT_L(8); PG8_BAR; PG8_WAIT_L(0); PG8_MMA(0, 0, At, B0); PG8_BAR; PG8_SCHED;
            PG8_LDB(B1, 1, 1); PG8_STAGE(PG8_SB(1, 0), b3, voffB);
            PG8_BAR; PG8_WAIT_L(0); PG8_MMA(0, 1, At, B1); PG8_BAR;
            PG8_LDA(At, 1, 1); PG8_STAGE(PG8_SA(1, 0), a3, voffA);
            PG8_BAR; PG8_WAIT_L(0); PG8_MMA(1, 0, At, B0); PG8_BAR; PG8_SCHED;
            PG8_STAGE(PG8_SB(1, 1), b3 + hstep, voffB);
            PG8_WAIT_V(6); PG8_BAR; PG8_MMA(1, 1, At, B1); PG8_BAR;
        }
        PG8_STAMP();
        if constexpr (!Epi::AFTER_DRAIN) { E(acc, cur, wr, wc, fr, fq); S.done(cur); }
        PG8_STAMP();
        if (!has_next) break;
#pragma unroll
        for (int a = 0; a < 2; ++a)
#pragma unroll
            for (int b = 0; b < 2; ++b)
#pragma unroll
                for (int m = 0; m < 4; ++m)
#pragma unroll
                    for (int n = 0; n < 2; ++n) acc[a][b][m][n] = (f32x4){0.f, 0.f, 0.f, 0.f};
        cur = nxt; cA = nA; cB = nB; ++ui;
    }
    PG8_WAIT_V(0);
    if (wr == 0) PG8_BAR;
    PG8_BAR;
    if constexpr (Epi::AFTER_DRAIN) { E.fused(acc, cur, wr, wc, fr, fq, lds, wid, lane); S.done(cur); }
    PG8_STAMP();
    if (STAMP && wid == 0) { stamps[lane] = lane < nts ? (((unsigned long long)(unsigned)ts_hi << 32) | (unsigned)ts_lo) : 0ull;
        if (lane == 62) stamps[62] = rt_entry; if (lane == 63) stamps[63] = (unsigned long long)wall_clock64(); }
#undef PG8_STAMP
#undef PG8_SA
#undef PG8_SB
#undef PG8_STAGE
#undef PG8_LDA
#undef PG8_LDB
#undef PG8_MMA
#undef PG8_WAIT_V
#undef PG8_WAIT_L
#undef PG8_BAR
#undef PG8_SCHED
}
}

DEV f32x4 rope4(const float* cs, int row, int fq, f32x4 v) {
  const float4 c_ = ld4(cs + row * 16 + 4 * (fq & 1)), s_ = ld4(cs + row * 16 + 8 + 4 * (fq & 1));
  const float p0 = __shfl_xor(v[0], 32), p1 = __shfl_xor(v[1], 32), p2 = __shfl_xor(v[2], 32), p3 = __shfl_xor(v[3], 32);
  const float sg = fq < 2 ? -1.f : 1.f;
  v[0] = v[0] * c_.x + sg * p0 * s_.x; v[1] = v[1] * c_.y + sg * p1 * s_.y; v[2] = v[2] * c_.z + sg * p2 * s_.z; v[3] = v[3] * c_.w + sg * p3 * s_.w;
  return v;
}
struct EpiIn0 {
  static constexpr bool PERM = false, AFTER_DRAIN = false;
  u16* qkv; const float* cs;
  DEV void operator()(const pg8::f32x4 (&acc)[2][2][4][2], const pg8::Unit& u, int wr, int wc, int fr, int fq) const {
#pragma unroll
    for (int ai = 0; ai < 2; ++ai)
#pragma unroll
      for (int m = 0; m < 4; ++m) {
        const int row = u.pm * 256 + ai * 128 + wr * 64 + m * 16 + fr;
#pragma unroll
        for (int bj = 0; bj < 2; ++bj)
#pragma unroll
          for (int n = 0; n < 2; ++n) {
            const int col = u.pn * 256 + bj * 128 + wc * 32 + n * 16 + 4 * fq;
            f32x4 v = acc[ai][bj][m][n];
            if (n == 0 && (wc & 1) == 0 && (col < 1024 || (col >= 1536 && col < 2176))) v = rope4(cs, row, fq, v);
            st_bf4(qkv + (size_t)row * LD0 + col, v[0], v[1], v[2], v[3]);
          }
      }
  }
};
struct EpiIn1 {
  static constexpr bool PERM = false, AFTER_DRAIN = false;
  u16* qkv; float* gates; const float* cs;
  DEV void operator()(const pg8::f32x4 (&acc)[2][2][4][2], const pg8::Unit& u, int wr, int wc, int fr, int fq) const {
#pragma unroll
    for (int ai = 0; ai < 2; ++ai)
#pragma unroll
      for (int m = 0; m < 4; ++m) {
        const int row = u.pm * 256 + ai * 128 + wr * 64 + m * 16 + fr;
#pragma unroll
        for (int bj = 0; bj < 2; ++bj)
#pragma unroll
          for (int n = 0; n < 2; ++n) {
            const int col = u.pn * 256 + bj * 128 + wc * 32 + n * 16 + 4 * fq;
            f32x4 v = acc[ai][bj][m][n];
            if (n == 0 && (wc & 1) == 0 && (col < 1280 || (col >= 1536 && col < 1792) || (col >= 2048 && col < 2304))) v = rope4(cs, row, fq, v);
            if (col < LD1) st_bf4(qkv + (size_t)row * LD1 + col, v[0], v[1], v[2], v[3]);
            else if (col < NIN1) {
              float4 o; o.x = 1.f / (1.f + __expf(-v[0])); o.y = 1.f / (1.f + __expf(-v[1])); o.z = 1.f / (1.f + __expf(-v[2])); o.w = 1.f / (1.f + __expf(-v[3]));
              *reinterpret_cast<float4*>(gates + (size_t)row * 48 + (col - LD1)) = o;
            }
          }
      }
  }
};
struct EpiOut {
  static constexpr bool PERM = false, AFTER_DRAIN = false;
  float* hpre; const float* resid;
  DEV void operator()(const pg8::f32x4 (&acc)[2][2][4][2], const pg8::Unit& u, int wr, int wc, int fr, int fq) const {
#pragma unroll
    for (int ai = 0; ai < 2; ++ai)
#pragma unroll
      for (int m = 0; m < 4; ++m) {
        const int row = u.pm * 256 + ai * 128 + wr * 64 + m * 16 + fr;
#pragma unroll
        for (int bj = 0; bj < 2; ++bj)
#pragma unroll
          for (int n = 0; n < 2; ++n) {
            const size_t idx = (size_t)row * D_ + u.pn * 256 + bj * 128 + wc * 32 + n * 16 + 4 * fq;
            const float4 r = ld4(resid + idx);
            float4 o; o.x = ALPHA * r.x + acc[ai][bj][m][n][0]; o.y = ALPHA * r.y + acc[ai][bj][m][n][1]; o.z = ALPHA * r.z + acc[ai][bj][m][n][2]; o.w = ALPHA * r.w + acc[ai][bj][m][n][3];
            *reinterpret_cast<float4*>(hpre + idx) = o;
          }
      }
  }
};
template <class Epi> DEV void dense_phase(char* smem, const u16* A, const u16* Bt, int N, const Epi& E) {
  pg8::Gemm g; g.A = A; g.Bt = Bt; g.M = T_; g.N = N; g.K = D_;
  pg8::StaticOrder S; S.init(T_, N, (int)gridDim.x, (int)blockIdx.x);
  pg8::gemm_phase<Epi, pg8::StaticOrder, false>((PG8_LAS unsigned char*)smem, g, S, E, nullptr);
  __syncthreads();
}
constexpr int NIN1P = 2816;
DEV void ph_inproj0(const Params& p, char* smem) { EpiIn0 E; E.qkv = p.qkv; E.cs = p.cs; dense_phase(smem, p.xb, p.w16_in0, LD0, E); }
DEV void ph_outproj(const Params& p, char* smem, const u16* W16, const float* resid) { EpiOut E; E.hpre = p.hpre; E.resid = resid; dense_phase(smem, p.ao, W16, D_, E); }
DEV void ph_inproj1(const Params& p, char* smem) { EpiIn1 E; E.qkv = p.qkv; E.gates = p.gates; E.cs = p.cs; dense_phase(smem, p.xb, p.w16_in1, NIN1P, E); }

DEV void ph_ln_mix(const Params& p, const float* g, const float* bt) {
  const int lane = tidx() & 63, gw = blockIdx.x * NWAVE + (tidx() >> 6), nw = gridDim.x * NWAVE;
  float4 gg[2][2], bb[2][2];
#pragma unroll
  for (int i = 0; i < 2; ++i)
#pragma unroll
    for (int h = 0; h < 2; ++h) { gg[i][h] = ld4(g + (i * 64 + lane) * 8 + 4 * h); bb[i][h] = ld4(bt + (i * 64 + lane) * 8 + 4 * h); }
  for (int tok0 = gw; tok0 < T_; tok0 += 4 * nw) {
    float4 a[4][2][2];
#pragma unroll
    for (int q = 0; q < 4; ++q) {
      int tk = tok0 + q * nw; tk = tk < T_ ? tk : tok0;
#pragma unroll
      for (int i = 0; i < 2; ++i)
#pragma unroll
        for (int h = 0; h < 2; ++h) a[q][i][h] = ld4(p.hpre + (size_t)tk * D_ + (i * 64 + lane) * 8 + 4 * h);
    }
#pragma unroll
    for (int q = 0; q < 4; ++q) {
      const int tok = tok0 + q * nw;
      if (tok >= T_) break;
      float v[2][8]; float s = 0.f;
#pragma unroll
      for (int i = 0; i < 2; ++i)
#pragma unroll
        for (int h = 0; h < 2; ++h) {
          const float4 x = a[q][i][h];
          v[i][4 * h] = x.x; v[i][4 * h + 1] = x.y; v[i][4 * h + 2] = x.z; v[i][4 * h + 3] = x.w;
          s += x.x + x.y + x.z + x.w;
        }
      const float mu = wave_sum(s) * (1.f / D_);
      float ss = 0.f;
#pragma unroll
      for (int i = 0; i < 2; ++i)
#pragma unroll
        for (int c = 0; c < 8; ++c) { v[i][c] -= mu; ss += v[i][c] * v[i][c]; }
      const float rstd = rsqrtf(wave_sum(ss) * (1.f / D_) + LN_EPS);
#pragma unroll
      for (int i = 0; i < 2; ++i) {
        const int c0 = (i * 64 + lane) * 8;
        float y[8];
#pragma unroll
        for (int h = 0; h < 2; ++h) {
          y[4 * h] = v[i][4 * h] * rstd * gg[i][h].x + bb[i][h].x; y[4 * h + 1] = v[i][4 * h + 1] * rstd * gg[i][h].y + bb[i][h].y;
          y[4 * h + 2] = v[i][4 * h + 2] * rstd * gg[i][h].z + bb[i][h].z; y[4 * h + 3] = v[i][4 * h + 3] * rstd * gg[i][h].w + bb[i][h].w;
        }
        u32x4_t hi, lo;
#pragma unroll
        for (int c = 0; c < 4; ++c) {
          const unsigned hw = cvtpk(y[2 * c], y[2 * c + 1]);
          hi[c] = hw;
          lo[c] = cvtpk(y[2 * c] - __uint_as_float(hw << 16), y[2 * c + 1] - __uint_as_float(hw & 0xffff0000u));
        }
        *reinterpret_cast<u32x4_t*>(p.x1b + (size_t)tok * D_ + c0) = hi;
        *reinterpret_cast<u32x4_t*>(p.x1lo + (size_t)tok * D_ + c0) = lo;
      }
    }
  }
}

struct RouterSmem { u16 A[2][256][72]; u16 B[2][2][64][128]; };
DEV void ph_router_gemm(const Params& p, char* smem, const u16* RW16) {
  RouterSmem& sm = *reinterpret_cast<RouterSmem*>(smem);
  const int tid = tidx(), lane = tid & 63, wid = tid >> 6, wr = wid >> 1, wc = wid & 1, fr = lane & 15, fq = lane >> 4;
  const int q4 = (lane & 15) >> 2, p4 = lane & 3;
  for (ItemRange it = xcd_items(128 * 2); it.i < it.hi; it.i += it.step) {
    const int nt = it.i & 1, mt = it.i >> 1, m0 = mt * 128, n0 = nt * 128;
    const size_t ao0 = (size_t)(m0 + (tid >> 3)) * D_ + (tid & 7) * 8;
    const u16* bb = RW16 + (size_t)(tid >> 4) * NE + n0 + 8 * (tid & 15);
    f32x4 acc[2][4];
#pragma unroll
    for (int mi = 0; mi < 2; ++mi)
#pragma unroll
      for (int ni = 0; ni < 4; ++ni) acc[mi][ni] = f32x4{0.f, 0.f, 0.f, 0.f};
    u32x4_t ra[2][4], rb[2][4];
    auto gload = [&](auto PC, int kt) {
      constexpr int P = decltype(PC)::value;
      ra[P][0] = *reinterpret_cast<const u32x4_t*>(p.x1b + ao0 + kt * 64);
      ra[P][1] = *reinterpret_cast<const u32x4_t*>(p.x1b + ao0 + (size_t)64 * D_ + kt * 64);
      ra[P][2] = *reinterpret_cast<const u32x4_t*>(p.x1lo + ao0 + kt * 64);
      ra[P][3] = *reinterpret_cast<const u32x4_t*>(p.x1lo + ao0 + (size_t)64 * D_ + kt * 64);
      const u16* bp = bb + (size_t)kt * 64 * NE;
      rb[P][0] = *reinterpret_cast<const u32x4_t*>(bp);
      rb[P][1] = *reinterpret_cast<const u32x4_t*>(bp + (size_t)32 * NE);
      rb[P][2] = *reinterpret_cast<const u32x4_t*>(bp + (size_t)D_ * NE);
      rb[P][3] = *reinterpret_cast<const u32x4_t*>(bp + (size_t)D_ * NE + (size_t)32 * NE);
    };
    auto sstore = [&](auto PC) {
      constexpr int P = decltype(PC)::value;
#pragma unroll
      for (int i = 0; i < 4; ++i) *reinterpret_cast<u32x4_t*>(&sm.A[P][(tid >> 3) + 64 * i][(tid & 7) * 8]) = ra[P][i];
#pragma unroll
      for (int i = 0; i < 4; ++i) {
        const int k = (tid >> 4) + 32 * (i & 1), n8 = tid & 15;
        *reinterpret_cast<u32x4_t*>(&sm.B[P][i >> 1][k][(((n8 >> 1) ^ bswz(k)) << 4) + (n8 & 1) * 8]) = rb[P][i];
      }
    };
    auto compute = [&](auto PC) {
      constexpr int P = decltype(PC)::value;
#pragma unroll
      for (int ks = 0; ks < 2; ++ks) {
        bf16x8 ah[2], al[2], bh[4], bl[4];
#pragma unroll
        for (int mi = 0; mi < 2; ++mi) {
          ah[mi] = *reinterpret_cast<const bf16x8*>(&sm.A[P][wr * 32 + mi * 16 + fr][32 * ks + fq * 8]);
          al[mi] = *reinterpret_cast<const bf16x8*>(&sm.A[P][128 + wr * 32 + mi * 16 + fr][32 * ks + fq * 8]);
        }
#pragma unroll
        for (int ni = 0; ni < 4; ++ni) {
          const int k0 = 32 * ks + 8 * fq + q4, col = (((wc * 4 + ni) ^ bswz(k0)) << 4) + 4 * p4;
          { const v4i16_t lo = lds_tr(&sm.B[P][0][k0][col]), hh = lds_tr(&sm.B[P][0][k0 + 4][col]); bh[ni] = bf16x8{lo[0], lo[1], lo[2], lo[3], hh[0], hh[1], hh[2], hh[3]}; }
          { const v4i16_t lo = lds_tr(&sm.B[P][1][k0][col]), hh = lds_tr(&sm.B[P][1][k0 + 4][col]); bl[ni] = bf16x8{lo[0], lo[1], lo[2], lo[3], hh[0], hh[1], hh[2], hh[3]}; }
        }
#pragma unroll
        for (int mi = 0; mi < 2; ++mi)
#pragma unroll
          for (int ni = 0; ni < 4; ++ni) {
            acc[mi][ni] = __builtin_amdgcn_mfma_f32_16x16x32_bf16(bh[ni], ah[mi], acc[mi][ni], 0, 0, 0);
            acc[mi][ni] = __builtin_amdgcn_mfma_f32_16x16x32_bf16(bh[ni], al[mi], acc[mi][ni], 0, 0, 0);
            acc[mi][ni] = __builtin_amdgcn_mfma_f32_16x16x32_bf16(bl[ni], ah[mi], acc[mi][ni], 0, 0, 0);
          }
        __builtin_amdgcn_sched_barrier(0);
      }
    };
    using C0 = std::integral_constant<int, 0>; using C1 = std::integral_constant<int, 1>;
    gload(C0{}, 0); sstore(C0{}); gload(C1{}, 1); __syncthreads();
    int kt = 0;
    for (; kt + 2 < 16; kt += 2) {
      gload(C0{}, kt + 2); compute(C0{}); sstore(C1{}); __syncthreads();
      gload(C1{}, kt + 3); compute(C1{}); sstore(C0{}); __syncthreads();
    }
    compute(C0{}); sstore(C1{}); __syncthreads();
    compute(C1{}); __syncthreads();
#pragma unroll
    for (int mi = 0; mi < 2; ++mi)
#pragma unroll
      for (int ni = 0; ni < 4; ++ni) {
        float4 o; o.x = acc[mi][ni][0]; o.y = acc[mi][ni][1]; o.z = acc[mi][ni][2]; o.w = acc[mi][ni][3];
        *reinterpret_cast<float4*>(p.logits + (size_t)(m0 + wr * 32 + mi * 16 + fr) * NE + n0 + wc * 64 + ni * 16 + fq * 4) = o;
      }
  }
}

DEV void ph_route(const Params& p, const float* rbias, int* cnt, int* etok) {
  const int lane = tidx() & 63, gw = blockIdx.x * NWAVE + (tidx() >> 6), nw = gridDim.x * NWAVE;
  const int half = lane >> 5;
  for (int tok = gw; tok < T_; tok += nw) {
    float aff[4], val[4];
#pragma unroll
    for (int j = 0; j < 4; ++j) {
      const float lg = p.logits[(size_t)tok * NE + lane + 64 * j];
      aff[j] = 1.f / (1.f + expf(-lg));
      val[j] = aff[j] + rbias[lane + 64 * j];
    }
    float gs[8];
#pragma unroll
    for (int j = 0; j < 4; ++j) {
      float m1 = val[j];
#pragma unroll
      for (int o = 16; o; o >>= 1) m1 = fmaxf(m1, __shfl_xor(m1, o));
      const unsigned long long eq = __ballot(val[j] == m1);
      const int ceq = __popc((unsigned)(half ? (eq >> 32) : (eq & 0xffffffffull)));
      float m2 = (val[j] == m1) ? -INFINITY : val[j];
#pragma unroll
      for (int o = 16; o; o >>= 1) m2 = fmaxf(m2, __shfl_xor(m2, o));
      if (ceq >= 2) m2 = m1;
      const float mine = m1 + m2, other = __shfl_xor(mine, 32);
      gs[2 * j] = half ? other : mine; gs[2 * j + 1] = half ? mine : other;
    }
    bool gok[8];
#pragma unroll
    for (int g = 0; g < 8; ++g) {
      int rk = 0;
#pragma unroll
      for (int g2 = 0; g2 < 8; ++g2) rk += (gs[g2] > gs[g] || (gs[g2] == gs[g] && g2 < g)) ? 1 : 0;
      gok[g] = rk < 4;
    }
#pragma unroll
    for (int j = 0; j < 4; ++j) { const bool ok = half ? gok[2 * j + 1] : gok[2 * j]; if (!ok) val[j] = -INFINITY; }
    int my_e = 0; float my_a = 0.f, asum = 0.f;
#pragma unroll
    for (int k = 0; k < TOPK; ++k) {
      float bv = val[0]; int bi = lane;
#pragma unroll
      for (int j = 1; j < 4; ++j) if (val[j] > bv) { bv = val[j]; bi = lane + 64 * j; }
#pragma unroll
      for (int o = 32; o; o >>= 1) {
        const float ov = __shfl_xor(bv, o); const int oi = __shfl_xor(bi, o);
        if (ov > bv || (ov == bv && oi < bi)) { bv = ov; bi = oi; }
      }
      float a_sel = 0.f;
#pragma unroll
      for (int j = 0; j < 4; ++j) { const bool hit = (bi == lane + 64 * j); a_sel = hit ? aff[j] : a_sel; val[j] = hit ? -INFINITY : val[j]; }
      a_sel = wave_sum(a_sel);
      asum += a_sel;
      if (lane == k) { my_e = bi; my_a = a_sel; }
    }
    if (lane < TOPK) {
      const int ps = atomicAdd(&cnt[my_e], 1);
      p.eidx[tok * TOPK + lane] = my_e; p.epos[tok * TOPK + lane] = ps; p.gatev[tok * TOPK + lane] = my_a / asum * 2.5f;
      etok[(size_t)my_e * T_ + ps] = tok;
    }
  }
}

constexpr int MOE_TM = 320;
struct MoeTab { int cn[260]; int of[260]; int tf[260]; unsigned ao[2][5][NTHR]; };
DEV void moe_prep(MoeTab& mt, const int* cnt) {
  const int tid = tidx();
  if (tid < NE) mt.cn[tid] = cnt[tid];
  __syncthreads();
  if (tid == 0) {
    int a = 0, tl = 0;
    for (int e = 0; e < NE; ++e) { mt.of[e] = a; mt.tf[e] = tl; a += mt.cn[e]; tl += (mt.cn[e] + MOE_TM - 1) / MOE_TM; }
    mt.cn[NE] = T_; mt.of[NE] = NASG; mt.tf[NE] = tl; mt.of[NE + 1] = NASG + T_; mt.tf[NE + 1] = tl + (T_ + MOE_TM - 1) / MOE_TM;
  }
  __syncthreads();
}
DEV int moe_rows_per_tile(int cn, int tiles) { return (cn + tiles - 1) / tiles; }
struct MoeItem { int e, nt, r0, r1, of; };
template <int NPT> DEV MoeItem moe_item(const MoeTab& mt, int u) {
  int lo = 0, hi = NE;
  while (lo < hi) { const int mid = (lo + hi + 1) >> 1; if (NPT * mt.tf[mid] <= u) lo = mid; else hi = mid - 1; }
  MoeItem it; it.e = lo;
  const int tiles = mt.tf[lo + 1] - mt.tf[lo], local = u - NPT * mt.tf[lo], mtl = local / NPT, cn = mt.cn[lo];
  it.nt = local - mtl * NPT; it.of = mt.of[lo];
  const int per = moe_rows_per_tile(cn, tiles);
  it.r0 = mtl * per; it.r1 = (it.r0 + per < cn) ? it.r0 + per : cn;
  return it;
}

template <int NK, class FA, class FB, class FAN, class FBN, class FM, class FE>
DEV void moe_gemm5(GemmSmem& sm, u32x4_t (&ra)[5], f32x4_t (&rb)[2][4], FA a_addr, FB b_addr, FAN a_next, FBN b_next, int ldb, FM mid, FE epi) {
  constexpr int MI = 5;
  const int tid = tidx(), lane = tid & 63, wid = tid >> 6;
  const int wr = wid >> 1, wc = wid & 1, fr = lane & 15, fq = lane >> 4;
  const int n4 = tid & 31, kq = tid >> 5, q4 = (lane & 15) >> 2, p4 = lane & 3;
  f32x4 acc[MI][4];
#pragma unroll
  for (int mi = 0; mi < MI; ++mi)
#pragma unroll
    for (int ni = 0; ni < 4; ++ni) acc[mi][ni] = f32x4{0.f, 0.f, 0.f, 0.f};
  auto gloadA = [&](auto& fa, int kt) {
#pragma unroll
    for (int i = 0; i < MI; ++i) ra[i] = *reinterpret_cast<const u32x4_t*>(fa(i, kt));
  };
  auto gloadB = [&](auto PC, auto& fb, int kt) {
    constexpr int P = decltype(PC)::value;
    const float* bp = fb(kt);
#pragma unroll
    for (int i = 0; i < 4; ++i) rb[P][i] = *reinterpret_cast<const f32x4_t*>(bp + (size_t)(16 * i) * ldb);
  };
  auto storeA = [&](auto PC, int i) {
    constexpr int P = decltype(PC)::value;
    *reinterpret_cast<u32x4_t*>(&sm.A[P][(tid >> 3) + 64 * i][(tid & 7) * 8]) = ra[i];
  };
  auto storeB = [&](auto PC, int i) {
    constexpr int P = decltype(PC)::value;
    const f32x4_t v = rb[P][i];
    u32x2_t w; w[0] = cvtpk(v[0], v[1]); w[1] = cvtpk(v[2], v[3]);
    const int k = kq + 16 * i;
    *reinterpret_cast<u32x2_t*>(&sm.B[P][k][(((n4 >> 2) ^ bswz(k)) << 4) + (n4 & 3) * 4]) = w;
  };
  auto compute = [&](auto BC, auto STC, auto& fa, int kta) {
    constexpr int P = decltype(BC)::value;
    constexpr bool ST = decltype(STC)::value;
    using CQ = std::integral_constant<int, 1 - P>;
    auto rdB = [&](int ks, bf16x8 (&bf)[4]) {
#pragma unroll
      for (int ni = 0; ni < 4; ++ni) {
        const int k0 = 32 * ks + 8 * fq + q4, col = (((wc * 4 + ni) ^ bswz(k0)) << 4) + 4 * p4;
        const v4i16_t lo = lds_tr(&sm.B[P][k0][col]);
        const v4i16_t hh = lds_tr(&sm.B[P][k0 + 4][col]);
        bf[ni] = bf16x8{lo[0], lo[1], lo[2], lo[3], hh[0], hh[1], hh[2], hh[3]};
      }
    };
    auto rdA = [&](int ks, int mi) { return *reinterpret_cast<const bf16x8*>(&sm.A[P][wr * 80 + mi * 16 + fr][32 * ks + fq * 8]); };
    bf16x8 b0[4], b1[4], a0[3], a1[2], a2[3], a3[2];
    rdB(0, b0);
#pragma unroll
    for (int mi = 0; mi < 3; ++mi) a0[mi] = rdA(0, mi);
#pragma unroll
    for (int mi = 0; mi < 2; ++mi) a1[mi] = rdA(0, 3 + mi);
#pragma unroll
    for (int mi = 0; mi < 3; ++mi)
#pragma unroll
      for (int ni = 0; ni < 4; ++ni) acc[mi][ni] = __builtin_amdgcn_mfma_f32_16x16x32_bf16(b0[ni], a0[mi], acc[mi][ni], 0, 0, 0);
    if constexpr (ST) { storeB(CQ{}, 0); storeB(CQ{}, 1); }
    __builtin_amdgcn_sched_barrier(0);
#pragma unroll
    for (int mi = 0; mi < 3; ++mi) a2[mi] = rdA(1, mi);
#pragma unroll
    for (int mi = 0; mi < 2; ++mi)
#pragma unroll
      for (int ni = 0; ni < 4; ++ni) acc[3 + mi][ni] = __builtin_amdgcn_mfma_f32_16x16x32_bf16(b0[ni], a1[mi], acc[3 + mi][ni], 0, 0, 0);
    if constexpr (ST) { storeB(CQ{}, 2); storeB(CQ{}, 3); }
    __builtin_amdgcn_sched_barrier(0);
    rdB(1, b1);
#pragma unroll
    for (int mi = 0; mi < 2; ++mi) a3[mi] = rdA(1, 3 + mi);
#pragma unroll
    for (int mi = 0; mi < 3; ++mi)
#pragma unroll
      for (int ni = 0; ni < 4; ++ni) acc[mi][ni] = __builtin_amdgcn_mfma_f32_16x16x32_bf16(b1[ni], a2[mi], acc[mi][ni], 0, 0, 0);
    if constexpr (ST) { storeA(CQ{}, 0); storeA(CQ{}, 1); }
    __builtin_amdgcn_sched_barrier(0);
#pragma unroll
    for (int mi = 0; mi < 2; ++mi)
#pragma unroll
      for (int ni = 0; ni < 4; ++ni) acc[3 + mi][ni] = __builtin_amdgcn_mfma_f32_16x16x32_bf16(b1[ni], a3[mi], acc[3 + mi][ni], 0, 0, 0);
    if constexpr (ST) { storeA(CQ{}, 2); storeA(CQ{}, 3); storeA(CQ{}, 4); gloadA(fa, kta); }
    __builtin_amdgcn_sched_barrier(0);
  };
  using C0 = std::integral_constant<int, 0>; using C1 = std::integral_constant<int, 1>;
  using YES = std::true_type; using NO = std::false_type;
#pragma unroll
  for (int i = 0; i < MI; ++i) storeA(C0{}, i);
#pragma unroll
  for (int i = 0; i < 4; ++i) storeB(C0{}, i);
  gloadA(a_addr, 1);
  __syncthreads();
#pragma unroll 1
  for (int kt = 0; kt + 2 < NK; kt += 2) {
    gloadB(C0{}, b_addr, kt + 2); if (kt == 0) mid(); compute(C0{}, YES{}, a_addr, kt + 2); __syncthreads();
    gloadB(C1{}, b_addr, kt + 3); compute(C1{}, YES{}, a_addr, kt + 3); __syncthreads();
  }
  gloadB(C0{}, b_next, 0); compute(C0{}, YES{}, a_next, 0); __syncthreads();
  gloadB(C1{}, b_next, 1);
  compute(C1{}, NO{}, a_next, 0);
  epi(acc);
}


constexpr int TS_LD = 136;
DEV void ts_put(u16* T, int row, int col, float a, float b, float c, float d) { uint2 w; w.x = cvtpk(a, b); w.y = cvtpk(c, d); *reinterpret_cast<uint2*>(T + row * TS_LD + col) = w; }
template <int NCH, class FD> DEV void ts_flush(const u16* T, int rows, FD dst) {
  __syncthreads();
  for (int c = tidx(); c < rows * NCH; c += NTHR) {
    const int row = c / NCH, ch = c - row * NCH;
    u16* d = dst(row);
    if (d) *reinterpret_cast<u32x4_t*>(d + ch * 8) = *reinterpret_cast<const u32x4_t*>(T + row * TS_LD + ch * 8);
  }
  __syncthreads();
}

DEV void ph_moe1(const Params& p, GemmSmem& sm, MoeTab& mt, int layer, const int* cnt) {
  const int tid = tidx(), lane = tid & 63, wid = tid >> 6, wr = wid >> 1, wc = wid & 1, fr = lane & 15, fq = lane >> 4;
  moe_prep(mt, cnt);
  ItemRange it = xcd_items(mt.tf[NE + 1] * 4);
  if (it.i >= it.hi) return;
  const int v0 = 4 * (tid & 31);
  auto set_rows = [&](const MoeItem& m, int slot) {
#pragma unroll
    for (int i = 0; i < 5; ++i) {
      int ri = m.r0 + (tid >> 3) + 64 * i; ri = ri < m.r1 ? ri : m.r1 - 1;
      const int tk = m.e < NE ? p.etok[(size_t)m.e * T_ + ri] : ri;
      mt.ao[slot][i][tid] = (unsigned)tk * D_ + (tid & 7) * 8;
    }
  };
  auto b_ptr = [&](const MoeItem& m, int kt) -> const float* {
    const float* wg = m.e < NE ? p.w_gate + ((size_t)layer * NE + m.e) * D_ * 256 : p.sh_gate + (size_t)layer * D_ * 256;
    const float* wu = m.e < NE ? p.w_up + ((size_t)layer * NE + m.e) * D_ * 256 : p.sh_up + (size_t)layer * D_ * 256;
    return ((v0 & 63) >= 32 ? wu : wg) + (size_t)(kt * 64 + (tid >> 5)) * 256 + m.nt * 64 + (v0 >> 6) * 32 + (v0 & 31);
  };
  u32x4_t ra[5]; f32x4_t rb[2][4];
  MoeItem cur = moe_item<4>(mt, it.i);
  int slot = 0;
  set_rows(cur, 0);
  {
#pragma unroll
    for (int i = 0; i < 5; ++i) ra[i] = *reinterpret_cast<const u32x4_t*>(p.x1b + mt.ao[0][i][tid]);
#pragma unroll
    for (int j = 0; j < 2; ++j)
#pragma unroll
      for (int i = 0; i < 4; ++i) rb[j][i] = *reinterpret_cast<const f32x4_t*>(b_ptr(cur, j) + (size_t)(16 * i) * 256);
  }
  for (;;) {
    const int un = it.i + it.step;
    const bool has_next = un < it.hi;
    const MoeItem nxt = has_next ? moe_item<4>(mt, un) : cur;
    const int nslot = has_next ? slot ^ 1 : slot;
    auto a_addr = [&](int i, int kt) { return p.x1b + mt.ao[slot][i][tid] + kt * 64; };
    auto b_addr = [&](int kt) { return b_ptr(cur, kt); };
    auto a_next = [&](int i, int kt) { return p.x1b + mt.ao[nslot][i][tid] + kt * 64; };
    auto b_next = [&](int kt) { return b_ptr(nxt, kt); };
    auto mid = [&]() { if (has_next) set_rows(nxt, nslot); };
    auto epi = [&](f32x4 (&acc)[5][4]) {
#pragma unroll
      for (int mi = 0; mi < 5; ++mi) {
        const int idx = cur.r0 + wr * 80 + mi * 16 + fr;
        if (idx < cur.r1) {
#pragma unroll
          for (int n2 = 0; n2 < 2; ++n2) {
            float hv[4];
#pragma unroll
            for (int j = 0; j < 4; ++j) { const float g = acc[mi][n2][j], uu = acc[mi][n2 + 2][j]; hv[j] = g * __builtin_amdgcn_rcpf(1.f + __expf(-g)) * uu; }
            st_bf4(p.hbuf + (size_t)(cur.of + idx) * 256 + cur.nt * 64 + wc * 32 + n2 * 16 + fq * 4, hv[0], hv[1], hv[2], hv[3]);
          }
        }
      }
    };
    moe_gemm5<16>(sm, ra, rb, a_addr, b_addr, a_next, b_next, 256, mid, epi);
    if (!has_next) break;
    cur = nxt; it.i = un; slot = nslot;
  }
}

DEV void ph_moe2(const Params& p, GemmSmem& sm, MoeTab& mt, int layer, const int* cnt) {
  const int tid = tidx(), lane = tid & 63, wid = tid >> 6, wr = wid >> 1, wc = wid & 1, fr = lane & 15, fq = lane >> 4;
  moe_prep(mt, cnt);
  ItemRange it = xcd_items(mt.tf[NE + 1] * 8);
  if (it.i >= it.hi) return;
  auto a_ptr = [&](const MoeItem& m, int i, int kt) -> const u16* {
    const int rmax = m.r1 - 1 - m.r0 - (tid >> 3);
    int d = 64 * i; d = d < rmax ? d : rmax;
    return p.hbuf + (size_t)(m.of + m.r0 + (tid >> 3) + d) * 256 + (tid & 7) * 8 + kt * 64;
  };
  auto b_ptr = [&](const MoeItem& m, int kt) -> const float* {
    const float* wd = m.e < NE ? p.w_down + ((size_t)layer * NE + m.e) * 256 * D_ : p.sh_down + (size_t)layer * 256 * D_;
    return wd + (size_t)(kt * 64 + (tid >> 5)) * D_ + m.nt * 128 + 4 * (tid & 31);
  };
  u32x4_t ra[5]; f32x4_t rb[2][4];
  MoeItem cur = moe_item<8>(mt, it.i);
  {
#pragma unroll
    for (int i = 0; i < 5; ++i) ra[i] = *reinterpret_cast<const u32x4_t*>(a_ptr(cur, i, 0));
#pragma unroll
    for (int j = 0; j < 2; ++j)
#pragma unroll
      for (int i = 0; i < 4; ++i) rb[j][i] = *reinterpret_cast<const f32x4_t*>(b_ptr(cur, j) + (size_t)(16 * i) * D_);
  }
  for (;;) {
    const int un = it.i + it.step;
    const bool has_next = un < it.hi;
    const MoeItem nxt = has_next ? moe_item<8>(mt, un) : cur;
    auto a_addr = [&](int i, int kt) { return a_ptr(cur, i, kt); };
    auto b_addr = [&](int kt) { return b_ptr(cur, kt); };
    auto a_next = [&](int i, int kt) { return a_ptr(nxt, i, kt); };
    auto b_next = [&](int kt) { return b_ptr(nxt, kt); };
    auto mid = [&]() {};
    auto epi = [&](f32x4 (&acc)[5][4]) {
      u16* T = reinterpret_cast<u16*>(&sm);
      __syncthreads();
#pragma unroll
      for (int mi = 0; mi < 5; ++mi)
#pragma unroll
        for (int ni = 0; ni < 4; ++ni) ts_put(T, wr * 80 + mi * 16 + fr, wc * 64 + ni * 16 + fq * 4, acc[mi][ni][0], acc[mi][ni][1], acc[mi][ni][2], acc[mi][ni][3]);
      ts_flush<16>(T, cur.r1 - cur.r0, [&](int row) -> u16* { return p.ybuf + (size_t)(cur.of + cur.r0 + row) * D_ + cur.nt * 128; });
    };
    moe_gemm5<4>(sm, ra, rb, a_addr, b_addr, a_next, b_next, D_, mid, epi);
    if (!has_next) break;
    cur = nxt; it.i = un;
  }
}

DEV void ph_combine_ln(const Params& p, MoeTab& mt, const int* cnt, const float* g, const float* bt, float* outf, u16* outb, bool with_ffn, bool write_b = true) {
  const int lane = tidx() & 63, gw = blockIdx.x * NWAVE + (tidx() >> 6), nw = gridDim.x * NWAVE;
  moe_prep(mt, cnt);
  for (int tok = gw; tok < T_; tok += nw) {
    int sl = 0; float gk = 0.f;
    if (lane < TOPK) { sl = mt.of[p.eidx[tok * TOPK + lane]] + p.epos[tok * TOPK + lane]; gk = p.gatev[tok * TOPK + lane]; }
    u32x4_t y[9][2], xh[2], xl[2];
#pragma unroll
    for (int i = 0; i < 2; ++i) {
      xh[i] = reinterpret_cast<const u32x4_t*>(p.x1b + (size_t)tok * D_)[i * 64 + lane];
      xl[i] = reinterpret_cast<const u32x4_t*>(p.x1lo + (size_t)tok * D_)[i * 64 + lane];
      y[8][i] = reinterpret_cast<const u32x4_t*>(p.ybuf + (size_t)(NASG + tok) * D_)[i * 64 + lane];
    }
    float gks[8];
#pragma unroll
    for (int k = 0; k < TOPK; ++k) {
      const int slk = __builtin_amdgcn_readlane(sl, k);
      gks[k] = __builtin_bit_cast(float, __builtin_amdgcn_readlane(__builtin_bit_cast(int, gk), k));
#pragma unroll
      for (int i = 0; i < 2; ++i) y[k][i] = reinterpret_cast<const u32x4_t*>(p.ybuf + (size_t)slk * D_)[i * 64 + lane];
    }
    float v[2][8];
#pragma unroll
    for (int i = 0; i < 2; ++i)
#pragma unroll
      for (int c = 0; c < 4; ++c) {
        float a0 = ALPHA * (bflo(xh[i][c]) + bflo(xl[i][c])), a1 = ALPHA * (bfhi(xh[i][c]) + bfhi(xl[i][c]));
        if (with_ffn) {
          a0 += bflo(y[8][i][c]); a1 += bfhi(y[8][i][c]);
#pragma unroll
          for (int k = 0; k < TOPK; ++k) { a0 += gks[k] * bflo(y[k][i][c]); a1 += gks[k] * bfhi(y[k][i][c]); }
        }
        v[i][2 * c] = a0; v[i][2 * c + 1] = a1;
      }
    float s = 0.f;
#pragma unroll
    for (int i = 0; i < 2; ++i)
#pragma unroll
      for (int c = 0; c < 8; ++c) s += v[i][c];
    const float mu = wave_sum(s) * (1.f / D_);
    float ss = 0.f;
#pragma unroll
    for (int i = 0; i < 2; ++i)
#pragma unroll
      for (int c = 0; c < 8; ++c) { v[i][c] -= mu; ss += v[i][c] * v[i][c]; }
    const float rstd = rsqrtf(wave_sum(ss) * (1.f / D_) + LN_EPS);
#pragma unroll
    for (int i = 0; i < 2; ++i) {
      const int c0 = (i * 64 + lane) * 8;
      float o[8];
#pragma unroll
      for (int h = 0; h < 2; ++h) {
        const float4 gg = ld4(g + c0 + 4 * h), bb = ld4(bt + c0 + 4 * h);
        o[4 * h] = v[i][4 * h] * rstd * gg.x + bb.x; o[4 * h + 1] = v[i][4 * h + 1] * rstd * gg.y + bb.y;
        o[4 * h + 2] = v[i][4 * h + 2] * rstd * gg.z + bb.z; o[4 * h + 3] = v[i][4 * h + 3] * rstd * gg.w + bb.w;
        float4 w; w.x = o[4 * h]; w.y = o[4 * h + 1]; w.z = o[4 * h + 2]; w.w = o[4 * h + 3];
        *reinterpret_cast<float4*>(outf + (size_t)tok * D_ + c0 + 4 * h) = w;
      }
      if (write_b) {
        u32x4_t w; w[0] = cvtpk(o[0], o[1]); w[1] = cvtpk(o[2], o[3]); w[2] = cvtpk(o[4], o[5]); w[3] = cvtpk(o[6], o[7]);
        *reinterpret_cast<u32x4_t*>(outb + (size_t)tok * D_ + c0) = w;
      }
    }
  }
}

DEV float gelu_tanh(float x) { const float u = 0.7978845608028654f * (x + 0.044715f * x * x * x); return 0.5f * x * (1.f + tanhf(u)); }
DEV void ph_cmp1(const Params& p, GemmSmem& sm) {
  const int tid = tidx(), lane = tid & 63, wid = tid >> 6, wr = wid >> 1, wc = wid & 1, fr = lane & 15, fq = lane >> 4;
  for (int u = blockIdx.x; u < 64; u += gridDim.x) {
    const int ts = u >> 5, mt = u & 31, m0 = mt * 128;
    const u16* ar[2];
#pragma unroll
    for (int i = 0; i < 2; ++i) {
      const int m_ = m0 + (tid >> 3) + 64 * i, bg = m_ >> 8; int c = m_ & 255; c = c < 255 ? c : 254;
      ar[i] = p.qkv + (size_t)((bg >> 2) * S_ + 16 * c) * LD1 + (ts ? 1280 : 1024) + (bg & 3) * 64 + (tid & 7) * 8;
    }
    auto a_addr = [&](int i, int kt) { return ar[i] + (size_t)kt * LD1; };
    const float* bb = (ts ? p.cmpv_w1 : p.cmpk_w1) + (size_t)(tid >> 5) * 128 + 4 * (tid & 31);
    auto b_addr = [&](int kt) { return bb + (size_t)kt * 64 * 128; };
    auto b_lo = [&](int) { return false; };
    auto epi = [&](f32x4 (&acc)[2][4]) {
#pragma unroll
      for (int mi = 0; mi < 2; ++mi)
#pragma unroll
        for (int ni = 0; ni < 4; ++ni) {
          const int m = m0 + wr * 32 + mi * 16 + fr, col = wc * 64 + ni * 16 + fq * 4;
          const float4 pbv = ld4(p.pb + ts * 128 + col);
          st_bf4(p.hid + ((size_t)ts * 4096 + m) * 128 + col, gelu_tanh(acc[mi][ni][0] + pbv.x), gelu_tanh(acc[mi][ni][1] + pbv.y),
                 gelu_tanh(acc[mi][ni][2] + pbv.z), gelu_tanh(acc[mi][ni][3] + pbv.w));
        }
    };
    gemm_core<2, false>(sm, 32, a_addr, b_addr, 128, b_lo, epi);
  }
}
DEV void ph_cmp2(const Params& p, GemmSmem& sm) {
  const int tid = tidx(), lane = tid & 63, wid = tid >> 6, wr = wid >> 1, wc = wid & 1, fr = lane & 15, fq = lane >> 4;
  for (int u = blockIdx.x; u < 64; u += gridDim.x) {
    const int ts = u >> 5, mt = u & 31, m0 = mt * 128;
    const u16* ar0 = p.hid + ((size_t)ts * 4096 + m0 + (tid >> 3)) * 128 + (tid & 7) * 8;
    auto a_addr = [&](int i, int kt) { return ar0 + (size_t)i * 64 * 128 + kt * 64; };
    const float* bb = (ts ? p.cmpv_w2 : p.cmpk_w2) + (size_t)(tid >> 5) * 64 + 4 * (tid & 31);
    const bool bok = 4 * (tid & 31) < 64;
    const float* bbv = bok ? bb : (ts ? p.cmpv_w2 : p.cmpk_w2) + (size_t)(tid >> 5) * 64;
    auto b_addr = [&](int kt) -> const float* { return bbv + (size_t)kt * 64 * 64; };
    auto b_lo = [&](int) { return false; };
    auto epi = [&](f32x4 (&acc)[2][4]) {
      if (wc == 0) {
#pragma unroll
        for (int mi = 0; mi < 2; ++mi)
#pragma unroll
          for (int ni = 0; ni < 4; ++ni) {
            const int m = m0 + wr * 32 + mi * 16 + fr, col = ni * 16 + fq * 4;
            st_bf4(p.cmpkv + ((size_t)ts * 4096 + m) * 64 + col, acc[mi][ni][0], acc[mi][ni][1], acc[mi][ni][2], acc[mi][ni][3]);
          }
      }
    };
    gemm_core<2, false>(sm, 2, a_addr, b_addr, 64, b_lo, epi, bok);
  }
}

using f32x16 = __attribute__((ext_vector_type(16))) float;
DEV int crow(int r, int hi) { return (r & 3) + 8 * (r >> 2) + 4 * hi; }
constexpr float LOG2E = 1.4426950408889634f;
constexpr float SCL2 = 0.125f * LOG2E;

struct WaveTile { u16 K[32][72]; u16 V[2][32][32]; };
struct KVTile { u16 K[32][72]; u16 V[2][32][32]; };
struct AttnState { float m, l; f32x16 o[2]; };

DEV void stage_load(u32x4_t (&rk)[4], u32x4_t (&rv)[4], const u16* Kb, const u16* Vb, int ld, long rowbase, int rowstep, int kcmax, int k0, int lane) {
#pragma unroll
  for (int it = 0; it < 4; ++it) {
    int kc = k0 + (lane >> 3) + 8 * it; kc = kc > kcmax ? kcmax : kc;
    const long row = rowbase + (long)kc * rowstep;
    rk[it] = *reinterpret_cast<const u32x4_t*>(Kb + row * ld + (lane & 7) * 8);
    rv[it] = *reinterpret_cast<const u32x4_t*>(Vb + row * ld + (lane & 7) * 8);
  }
}
DEV void stage_store(WaveTile& wt, const u32x4_t (&rk)[4], const u32x4_t (&rv)[4], int lane) {
  const int ch = lane & 7;
#pragma unroll
  for (int it = 0; it < 4; ++it) {
    const int j = (lane >> 3) + 8 * it;
    *reinterpret_cast<u32x4_t*>(&wt.K[j][ch * 8]) = rk[it];
    *reinterpret_cast<u32x4_t*>(&wt.V[ch >> 2][j][(ch & 3) * 8]) = rv[it];
  }
}
template <class TT> DEV f32x16 qk_tile(const TT& wt, const bf16x8 (&qf)[4], int r32, int hi) {
  f32x16 acc;
#pragma unroll
  for (int r = 0; r < 16; ++r) acc[r] = 0.f;
#pragma unroll
  for (int s = 0; s < 4; ++s) {
    const bf16x8 kf = *reinterpret_cast<const bf16x8*>(&wt.K[r32][16 * s + 8 * hi]);
    acc = __builtin_amdgcn_mfma_f32_32x32x16_bf16(kf, qf[s], acc, 0, 0, 0);
  }
  return acc;
}
template <class TT> DEV void pv_tile(const TT& wt, const float (&pr)[16], f32x16 (&o)[2], int lane) {
  const int hi = lane >> 5, g = (lane >> 4) & 1, q4 = (lane & 15) >> 2, p4 = lane & 3;
  bf16x8 pf[2];
#pragma unroll
  for (int s2 = 0; s2 < 2; ++s2) {
    u32x4_t w;
    w[0] = cvtpk(pr[8 * s2 + 0], pr[8 * s2 + 1]); w[1] = cvtpk(pr[8 * s2 + 2], pr[8 * s2 + 3]);
    w[2] = cvtpk(pr[8 * s2 + 4], pr[8 * s2 + 5]); w[3] = cvtpk(pr[8 * s2 + 6], pr[8 * s2 + 7]);
    pf[s2] = __builtin_bit_cast(bf16x8, w);
  }
#pragma unroll
  for (int dt = 0; dt < 2; ++dt)
#pragma unroll
    for (int s2 = 0; s2 < 2; ++s2) {
      const v4i16_t lo = lds_tr(&wt.V[dt][16 * s2 + 4 * hi + q4][16 * g + 4 * p4]);
      const v4i16_t hh = lds_tr(&wt.V[dt][16 * s2 + 8 + 4 * hi + q4][16 * g + 4 * p4]);
      const bf16x8 vf = {lo[0], lo[1], lo[2], lo[3], hh[0], hh[1], hh[2], hh[3]};
      o[dt] = __builtin_amdgcn_mfma_f32_32x32x16_bf16(vf, pf[s2], o[dt], 0, 0, 0);
    }
}
DEV void attn_init(AttnState& st) {
  st.m = -INFINITY; st.l = 0.f;
#pragma unroll
  for (int r = 0; r < 16; ++r) { st.o[0][r] = 0.f; st.o[1][r] = 0.f; }
}
template <bool USE_SEL>
DEV void attn_span(AttnState& st, WaveTile& wt, const bf16x8 (&qf)[4], const u16* Kb, const u16* Vb, int ld,
                   long rowbase, int rowstep, int kcmax, int kc_lo, int kc_hi, int qc, int W,
                   unsigned long long sel, unsigned long long selu, int lane, int qc_min, int qc_max) {
  const int r32 = lane & 31, hi = lane >> 5;
  if (kc_lo < 0) kc_lo = 0;
  if (kc_hi > kcmax) kc_hi = kcmax;
  const int full_hi = qc_min < kcmax ? qc_min : kcmax;
  auto skip = [&](int k0) -> bool { return USE_SEL && !((selu >> (k0 >> 6)) & 1ull); };
  int kc0 = kc_lo & ~31;
  while (kc0 <= kc_hi && skip(kc0)) kc0 += 32;
  if (kc0 > kc_hi) return;
  u32x4_t rk[4], rv[4];
  stage_load(rk, rv, Kb, Vb, ld, rowbase, rowstep, kcmax, kc0, lane);
  for (;;) {
    stage_store(wt, rk, rv, lane);
    int kn = kc0 + 32;
    while (kn <= kc_hi && skip(kn)) kn += 32;
    if (kn <= kc_hi) stage_load(rk, rv, Kb, Vb, ld, rowbase, rowstep, kcmax, kn, lane);
    WAVE_SYNC();
    const f32x16 s = qk_tile(wt, qf, r32, hi);
    const bool selbit = USE_SEL ? (((sel >> (kc0 >> 6)) & 1ull) != 0ull) : true;
    const bool full = (qc_min <= qc_max) && (kc0 + 31 <= full_hi) && (kc0 >= qc_max - W);
    float sv[16]; float mt = -INFINITY;
    if (full) {
      float rm = s[0];
#pragma unroll
      for (int r = 1; r < 16; ++r) rm = fmaxf(rm, s[r]);
      mt = selbit ? rm * SCL2 : -INFINITY;
    } else {
#pragma unroll
      for (int r = 0; r < 16; ++r) {
        const int kc = kc0 + crow(r, hi), dist = qc - kc;
        const bool ok = selbit && kc <= kcmax && dist >= 0 && dist <= W;
        sv[r] = ok ? s[r] * SCL2 : -INFINITY;
        mt = fmaxf(mt, sv[r]);
      }
    }
    mt = fmaxf(mt, __shfl_xor(mt, 32));
    const float mnew = fmaxf(st.m, mt), muse = (mnew == -INFINITY) ? 0.f : mnew;
    const float alpha = __builtin_amdgcn_exp2f(st.m - muse);
    st.m = mnew;
    float ps = 0.f;
    if (full) {
      const float sub = selbit ? muse : INFINITY;
#pragma unroll
      for (int r = 0; r < 16; ++r) { sv[r] = __builtin_amdgcn_exp2f(__builtin_fmaf(s[r], SCL2, -sub)); ps += sv[r]; }
    } else {
#pragma unroll
      for (int r = 0; r < 16; ++r) { sv[r] = __builtin_amdgcn_exp2f(sv[r] - muse); ps += sv[r]; }
    }
    st.l = st.l * alpha + ps;
    if (__any(alpha != 1.f)) {
#pragma unroll
      for (int r = 0; r < 16; ++r) { st.o[0][r] *= alpha; st.o[1][r] *= alpha; }
    }
    pv_tile(wt, sv, st.o, lane);
    if (kn > kc_hi) break;
    kc0 = kn;
  }
}
DEV void attn_finish(AttnState& st, float sink2) {
  float l = st.l + __shfl_xor(st.l, 32);
  if (sink2 > -INFINITY) l += __builtin_amdgcn_exp2f(sink2 - st.m);
  const float inv = l > 0.f ? 1.f / l : 0.f;
#pragma unroll
  for (int r = 0; r < 16; ++r) { st.o[0][r] *= inv; st.o[1][r] *= inv; }
}
DEV void attn_store_bf16(const AttnState& st, u16* orow, int hi) {
#pragma unroll
  for (int dt = 0; dt < 2; ++dt)
#pragma unroll
    for (int k4 = 0; k4 < 4; ++k4) {
      uint2 w; w.x = cvtpk(st.o[dt][4 * k4], st.o[dt][4 * k4 + 1]); w.y = cvtpk(st.o[dt][4 * k4 + 2], st.o[dt][4 * k4 + 3]);
      *reinterpret_cast<uint2*>(orow + 32 * dt + 8 * k4 + 4 * hi) = w;
    }
}
DEV void load_qf(bf16x8 (&qf)[4], const u16* qrow, int hi) {
#pragma unroll
  for (int s = 0; s < 4; ++s) qf[s] = *reinterpret_cast<const bf16x8*>(qrow + 16 * s + 8 * hi);
}

DEV void ph_attn0_mfma(const Params& p, WaveTile* wts) {
  const int tid = tidx(), lane = tid & 63, wid = tid >> 6, r32 = lane & 31, hi = lane >> 5;
  WaveTile& wt = wts[wid];
  const int gw = blockIdx.x * NWAVE + wid, nw = gridDim.x * NWAVE;
  for (int u = gw; u < 8192; u += nw) {
    AttnState st; attn_init(st);
    bf16x8 qf[4];
    if (u < 4096) {
      const int it = u & 7, res = (u >> 3) & 15, h = (u >> 7) & 7, b = u >> 10;
      const int i0 = it * 32, t = 16 * (i0 + r32) + res;
      const long row = (long)b * S_ + t;
      load_qf(qf, p.qkv + row * LD0 + h * 64, hi);
      const u16* Kb = p.qkv + 512 + h * 64; const u16* Vb = p.qkv + 1024 + h * 64;
      attn_span<false>(st, wt, qf, Kb, Vb, LD0, (long)b * S_ + res, 16, 255, i0 - 128, i0 + 31, i0 + r32, 128, 0ull, 0ull, lane, 1, 0);
      const int c = res >> 2;
      attn_span<false>(st, wt, qf, Kb, Vb, LD0, (long)b * S_ + (res & 3), 4, 1023, 4 * i0 + c - 128, 4 * (i0 + 31) + c, 4 * (i0 + r32) + c, 128, 0ull, 0ull, lane, 1, 0);
      attn_span<false>(st, wt, qf, Kb, Vb, LD0, (long)b * S_, 1, 4095, 16 * i0 + res - 128, 16 * (i0 + 31) + res, t, 128, 0ull, 0ull, lane, 1, 0);
      attn_finish(st, -INFINITY);
      attn_store_bf16(st, p.ao + row * D_ + h * 64, hi);
    } else {
      const int v = u - 4096, qt = v & 127, hb = (v >> 7) & 7, b = v >> 10, g = hb >> 2;
      const int t = 32 * qt + r32;
      const long row = (long)b * S_ + t;
      load_qf(qf, p.qkv + row * LD0 + 1536 + hb * 64, hi);
      attn_span<false>(st, wt, qf, p.qkv + 2048 + g * 64, p.qkv + 2176 + g * 64, LD0, (long)b * S_, 1, 4095, 32 * qt - 127, 32 * qt + 31, t, 127, 0ull, 0ull, lane, 32 * qt, 32 * qt + 31);
      attn_finish(st, p.even_sinks[hb] * LOG2E);
      attn_store_bf16(st, p.ao + row * D_ + 512 + hb * 64, hi);
    }
  }
}

struct Att1aSmem { KVTile tiles[2][2]; float imp[NWAVE][32][65]; float sc[NWAVE][64]; };
DEV void ph_attn1a(const Params& p, char* smem) {
  Att1aSmem& sm = *reinterpret_cast<Att1aSmem*>(smem);
  const int tid = tidx(), lane = tid & 63, wid = tid >> 6, r32 = lane & 31, hi = lane >> 5, gl = wid >> 2;
  const int sg = tid >> 8, sj = (tid & 255) >> 3, sc = tid & 7;
  for (int u = blockIdx.x; u < 1024; u += gridDim.x) {
    const int k = u >> 8, base = u & 255, bg = base & 7, x = base >> 3;
    const int qt = (k == 0) ? 127 - x : (k == 1) ? 64 + x : (k == 2) ? 63 - x : x;
    const int b = bg >> 1, gp = bg & 1;
    const int h = gp * 8 + wid, g = h >> 2;
    const int q0 = 32 * qt, t = q0 + r32;
    const long row = (long)b * S_ + t;
    const int qc = (t - 31) >> 4;
    int kc_hi = q0 >> 4; kc_hi = kc_hi > 254 ? 254 : kc_hi;
    const int ntile = (kc_hi >> 5) + 1;
    const u16* kp = p.cmpkv + ((size_t)((b * 4 + 2 * gp + sg) * 256) + sj) * 64 + sc * 8;
    const u16* vp = kp + (size_t)4096 * 64;
    for (int i = tid; i < NWAVE * 32 * 65; i += NTHR) (&sm.imp[0][0][0])[i] = 0.f;
    bf16x8 qf[4];
    load_qf(qf, p.qkv + row * LD1 + h * 64, hi);
    auto for_tiles = [&](auto&& body) {
      u32x4_t rk = *reinterpret_cast<const u32x4_t*>(kp), rv = *reinterpret_cast<const u32x4_t*>(vp);
      int cur = 0;
      for (int tt = 0; tt < ntile; ++tt) {
        KVTile& dst = sm.tiles[cur][sg];
        *reinterpret_cast<u32x4_t*>(&dst.K[sj][sc * 8]) = rk;
        *reinterpret_cast<u32x4_t*>(&dst.V[sc >> 2][sj][(sc & 3) * 8]) = rv;
        const int tn = tt + 1 < ntile ? tt + 1 : tt;
        rk = *reinterpret_cast<const u32x4_t*>(kp + (size_t)tn * 32 * 64);
        rv = *reinterpret_cast<const u32x4_t*>(vp + (size_t)tn * 32 * 64);
        __syncthreads();
        body(sm.tiles[cur][gl], tt * 32);
        cur ^= 1;
      }
      __syncthreads();
    };
    float m = -INFINITY, l = 0.f;
    for_tiles([&](const KVTile& tl, int kc0) {
      const f32x16 s = qk_tile(tl, qf, r32, hi);
      float sv[16]; float mt = -INFINITY;
#pragma unroll
      for (int rr = 0; rr < 16; ++rr) { const int kc = kc0 + crow(rr, hi); const bool ok = kc <= 254 && kc <= qc; sv[rr] = ok ? s[rr] * SCL2 : -INFINITY; mt = fmaxf(mt, sv[rr]); }
      mt = fmaxf(mt, __shfl_xor(mt, 32));
      const float mnew = fmaxf(m, mt), muse = (mnew == -INFINITY) ? 0.f : mnew;
      float ps = 0.f;
#pragma unroll
      for (int rr = 0; rr < 16; ++rr) ps += __builtin_amdgcn_exp2f(sv[rr] - muse);
      l = l * __builtin_amdgcn_exp2f(m - muse) + ps; m = mnew;
    });
    l += __shfl_xor(l, 32);
    const float inv = l > 0.f ? 1.f / l : 0.f, muse = (m == -INFINITY) ? 0.f : m;
    f32x16 o[2];
#pragma unroll
    for (int rr = 0; rr < 16; ++rr) { o[0][rr] = 0.f; o[1][rr] = 0.f; }
    for_tiles([&](const KVTile& tl, int kc0) {
      const f32x16 s = qk_tile(tl, qf, r32, hi);
      float pr[16];
#pragma unroll
      for (int rr = 0; rr < 16; ++rr) { const int kc = kc0 + crow(rr, hi); const bool ok = kc <= 254 && kc <= qc; pr[rr] = ok ? __builtin_amdgcn_exp2f(s[rr] * SCL2 - muse) * inv : 0.f; }
#pragma unroll
      for (int k4 = 0; k4 < 4; ++k4) {
        const int j = (kc0 >> 2) + 2 * k4 + hi;
        sm.imp[wid][r32][j] += pr[4 * k4] + pr[4 * k4 + 1] + pr[4 * k4 + 2] + 0.5f * pr[4 * k4 + 3];
        WAVE_SYNC();
        if (j + 1 < 64) sm.imp[wid][r32][j + 1] += 0.5f * pr[4 * k4 + 3];
        WAVE_SYNC();
      }
      pv_tile(tl, pr, o, lane);
    });
    const float g0 = p.gates[(size_t)row * 48 + h * 3];
#pragma unroll
    for (int dt = 0; dt < 2; ++dt)
#pragma unroll
      for (int k4 = 0; k4 < 4; ++k4) {
        float4 w; w.x = g0 * o[dt][4 * k4]; w.y = g0 * o[dt][4 * k4 + 1]; w.z = g0 * o[dt][4 * k4 + 2]; w.w = g0 * o[dt][4 * k4 + 3];
        *reinterpret_cast<float4*>(p.hpre + (size_t)row * D_ + h * 64 + 32 * dt + 8 * k4 + 4 * hi) = w;
      }
    for (int i = 0; i < 8; ++i) {
      const int pi = wid * 8 + i, grp = pi >> 5, q = pi & 31;
      const int tq = q0 + q, cur = tq >> 6;
      const float impq = (sm.imp[4 * grp][q][lane] + sm.imp[4 * grp + 1][q][lane]) + (sm.imp[4 * grp + 2][q][lane] + sm.imp[4 * grp + 3][q][lane]);
      const float score = (lane > cur) ? -1.f : ((lane == 0 || lane == cur || lane == cur - 1) ? 1.0e4f : impq);
      sm.sc[wid][lane] = score;
      WAVE_SYNC();
      int rk_ = 0;
#pragma unroll
      for (int jj = 0; jj < 64; jj += 4) {
        const float4 v = *reinterpret_cast<const float4*>(&sm.sc[wid][jj]);
        rk_ += (v.x > score || (v.x == score && jj < lane)) ? 1 : 0;
        rk_ += (v.y > score || (v.y == score && jj + 1 < lane)) ? 1 : 0;
        rk_ += (v.z > score || (v.z == score && jj + 2 < lane)) ? 1 : 0;
        rk_ += (v.w > score || (v.w == score && jj + 3 < lane)) ? 1 : 0;
      }
      WAVE_SYNC();
      const unsigned long long mask = __ballot(rk_ < 16 && lane <= cur);
      if (lane == 0) p.selmask[((size_t)b * S_ + tq) * 4 + 2 * gp + grp] = mask;
    }
    __syncthreads();
  }
}

template <class TT>
DEV void attn_tile_update(AttnState& st, const TT& tl, const bf16x8 (&qf)[4], int kc0, int qc, int W, int kcmax, bool selbit, bool full, int lane) {
  const int r32 = lane & 31, hi = lane >> 5;
  const f32x16 s = qk_tile(tl, qf, r32, hi);
  float sv[16]; float mt = -INFINITY;
  if (full) {
    float rm = s[0];
#pragma unroll
    for (int r = 1; r < 16; ++r) rm = fmaxf(rm, s[r]);
    mt = selbit ? rm * SCL2 : -INFINITY;
  } else {
#pragma unroll
    for (int r = 0; r < 16; ++r) {
      const int kc = kc0 + crow(r, hi), dist = qc - kc;
      const bool ok = selbit && kc <= kcmax && dist >= 0 && dist <= W;
      sv[r] = ok ? s[r] * SCL2 : -INFINITY;
      mt = fmaxf(mt, sv[r]);
    }
  }
  mt = fmaxf(mt, __shfl_xor(mt, 32));
  const float mnew = fmaxf(st.m, mt), muse = (mnew == -INFINITY) ? 0.f : mnew;
  const float alpha = __builtin_amdgcn_exp2f(st.m - muse);
  st.m = mnew;
  float ps = 0.f;
  if (full) {
    const float sub = selbit ? muse : INFINITY;
#pragma unroll
    for (int r = 0; r < 16; ++r) { sv[r] = __builtin_amdgcn_exp2f(__builtin_fmaf(s[r], SCL2, -sub)); ps += sv[r]; }
  } else {
#pragma unroll
    for (int r = 0; r < 16; ++r) { sv[r] = __builtin_amdgcn_exp2f(sv[r] - muse); ps += sv[r]; }
  }
  st.l = st.l * alpha + ps;
  if (__any(alpha != 1.f)) {
#pragma unroll
    for (int r = 0; r < 16; ++r) { st.o[0][r] *= alpha; st.o[1][r] *= alpha; }
  }
  pv_tile(tl, sv, st.o, lane);
}

template <bool USE_SEL>
DEV void attn_span_shared(AttnState& st, KVTile (*tiles)[2][2], const Params& p, const bf16x8 (&qf)[4], int b, int gp, int kcol, int vcol,
                          int t_lo, int t_hi, int qc, int W, unsigned long long sel, int q0) {
  const int tid = tidx(), lane = tid & 63, wid = tid >> 6, gl = wid >> 2;
  const int sg = tid >> 8, sj = (tid & 255) >> 3, sc = tid & 7;
  const u16* kp = p.qkv + (size_t)b * S_ * LD1 + kcol + (2 * gp + sg) * 64 + (size_t)sj * LD1 + sc * 8;
  const u16* vp = p.qkv + (size_t)b * S_ * LD1 + vcol + (2 * gp + sg) * 64 + (size_t)sj * LD1 + sc * 8;
  const int s_lo = t_lo >> 1, s_hi = t_hi >> 1;
  u32x4_t rk[2], rv[2];
#pragma unroll
  for (int h = 0; h < 2; ++h) {
    rk[h] = *reinterpret_cast<const u32x4_t*>(kp + (size_t)(2 * s_lo + h) * 32 * LD1);
    rv[h] = *reinterpret_cast<const u32x4_t*>(vp + (size_t)(2 * s_lo + h) * 32 * LD1);
  }
  int cur = 0;
  for (int sidx = s_lo; sidx <= s_hi; ++sidx) {
#pragma unroll
    for (int h = 0; h < 2; ++h) {
      KVTile& dst = tiles[cur][sg][h];
      *reinterpret_cast<u32x4_t*>(&dst.K[sj][sc * 8]) = rk[h];
      *reinterpret_cast<u32x4_t*>(&dst.V[sc >> 2][sj][(sc & 3) * 8]) = rv[h];
    }
    const int sn = sidx < s_hi ? sidx + 1 : sidx;
#pragma unroll
    for (int h = 0; h < 2; ++h) {
      rk[h] = *reinterpret_cast<const u32x4_t*>(kp + (size_t)(2 * sn + h) * 32 * LD1);
      rv[h] = *reinterpret_cast<const u32x4_t*>(vp + (size_t)(2 * sn + h) * 32 * LD1);
    }
    __syncthreads();
#pragma unroll
    for (int h = 0; h < 2; ++h) {
      const int t = 2 * sidx + h;
      if (t >= t_lo && t <= t_hi) {
        const int kc0 = t * 32;
        const bool selbit = USE_SEL ? (((sel >> (kc0 >> 6)) & 1ull) != 0ull) : true;
        const bool full = (kc0 + 31 <= q0) && (kc0 >= q0 + 31 - W);
        attn_tile_update(st, tiles[cur][gl][h], qf, kc0, qc, W, 4095, selbit, full, lane);
      }
    }
    cur ^= 1;
  }
  __syncthreads();
}

DEV void ph_attn1b(const Params& p, char* smem) {
  KVTile (*tiles)[2][2] = reinterpret_cast<KVTile (*)[2][2]>(smem);
  const int tid = tidx(), lane = tid & 63, wid = tid >> 6, r32 = lane & 31, hi = lane >> 5;
  for (int u = blockIdx.x; u < 1024; u += gridDim.x) {
    const int k = u >> 8, base = u & 255, bg = base & 7, x = base >> 3;
    const int qt = (k == 0) ? 127 - x : (k == 1) ? 64 + x : (k == 2) ? 63 - x : x;
    const int b = bg >> 1, gp = bg & 1;
    const int h = gp * 8 + wid, g = h >> 2;
    const int q0 = 32 * qt, t = q0 + r32;
    const long row = (long)b * S_ + t;
    bf16x8 qf[4];
    load_qf(qf, p.qkv + row * LD1 + h * 64, hi);
    const unsigned long long sel = p.selmask[(size_t)row * 4 + g];
    const float g1 = p.gates[(size_t)row * 48 + h * 3 + 1], g2 = p.gates[(size_t)row * 48 + h * 3 + 2];
    AttnState st; attn_init(st);
    attn_span_shared<true>(st, tiles, p, qf, b, gp, 1536, 1792, 0, qt, t, 1 << 30, sel, q0);
    attn_finish(st, -INFINITY);
    f32x16 acc[2];
#pragma unroll
    for (int rr = 0; rr < 16; ++rr) { acc[0][rr] = g1 * st.o[0][rr]; acc[1][rr] = g1 * st.o[1][rr]; }
    attn_init(st);
    const int wlo = q0 - 511 > 0 ? (q0 - 511) >> 5 : 0;
    attn_span_shared<false>(st, tiles, p, qf, b, gp, 2048, 2304, wlo, qt, t, 511, 0ull, q0);
    attn_finish(st, -INFINITY);
#pragma unroll
    for (int dt = 0; dt < 2; ++dt)
#pragma unroll
      for (int k4 = 0; k4 < 4; ++k4) {
        const float4 c = *reinterpret_cast<const float4*>(p.hpre + (size_t)row * D_ + h * 64 + 32 * dt + 8 * k4 + 4 * hi);
        uint2 w;
        w.x = cvtpk(c.x + acc[dt][4 * k4] + g2 * st.o[dt][4 * k4], c.y + acc[dt][4 * k4 + 1] + g2 * st.o[dt][4 * k4 + 1]);
        w.y = cvtpk(c.z + acc[dt][4 * k4 + 2] + g2 * st.o[dt][4 * k4 + 2], c.w + acc[dt][4 * k4 + 3] + g2 * st.o[dt][4 * k4 + 3]);
        *reinterpret_cast<uint2*>(p.ao + (size_t)row * D_ + h * 64 + 32 * dt + 8 * k4 + 4 * hi) = w;
      }
  }
}

enum { PH_PRO = 0, PH_IN0, PH_ATT0, PH_OUT0, PH_LN0, PH_RG0, PH_RT0, PH_M10, PH_M20, PH_CB0,
       PH_IN1, PH_C1, PH_C2, PH_ATT1A, PH_ATT1B, PH_OUT1, PH_LN1, PH_RG1, PH_RT1, PH_M11, PH_M21, PH_CB1 };

template <int PH> DEV void run_phase(const Params& p, char* smem) {
  GemmSmem& gs = *reinterpret_cast<GemmSmem*>(smem);
  WaveTile* wts = reinterpret_cast<WaveTile*>(smem);
  MoeTab& mt = *reinterpret_cast<MoeTab*>(smem + sizeof(GemmSmem));
  if constexpr (PH == PH_PRO) ph_prologue(p);
  else if constexpr (PH == PH_IN0) ph_inproj0(p, smem);
  else if constexpr (PH == PH_ATT0) ph_attn0_mfma(p, wts);
  else if constexpr (PH == PH_OUT0) ph_outproj(p, smem, p.w16_out0, p.x);
  else if constexpr (PH == PH_LN0) ph_ln_mix(p, p.mix_g, p.mix_b);
  else if constexpr (PH == PH_RG0) ph_router_gemm(p, smem, p.rw16);
  else if constexpr (PH == PH_RT0) ph_route(p, p.router_b, p.cnt, p.etok);
  else if constexpr (PH == PH_M10) ph_moe1(p, gs, mt, 0, p.cnt);
  else if constexpr (PH == PH_M20) ph_moe2(p, gs, mt, 0, p.cnt);
  else if constexpr (PH == PH_CB0) ph_combine_ln(p, mt, p.cnt, p.ffn_g, p.ffn_b, p.x2f, p.xb, true);
  else if constexpr (PH == PH_IN1) ph_inproj1(p, smem);
  else if constexpr (PH == PH_C1) ph_cmp1(p, gs);
  else if constexpr (PH == PH_C2) ph_cmp2(p, gs);
  else if constexpr (PH == PH_ATT1A) ph_attn1a(p, smem);
  else if constexpr (PH == PH_ATT1B) ph_attn1b(p, smem);
  else if constexpr (PH == PH_OUT1) ph_outproj(p, smem, p.w16_out1, p.x2f);
  else if constexpr (PH == PH_LN1) ph_ln_mix(p, p.mix_g + D_, p.mix_b + D_);
  else if constexpr (PH == PH_RG1) ph_router_gemm(p, smem, p.rw16 + (size_t)2 * D_ * NE);
  else if constexpr (PH == PH_RT1) ph_route(p, p.router_b + NE, p.cnt + 512, p.etok);
  else if constexpr (PH == PH_M11) ph_moe1(p, gs, mt, 1, p.cnt + 512);
  else if constexpr (PH == PH_M21) ph_moe2(p, gs, mt, 1, p.cnt + 512);
  else if constexpr (PH == PH_CB1) ph_combine_ln(p, mt, p.cnt + 512, p.ffn_g + D_, p.ffn_b + D_, p.out, p.xb, true, false);
}

constexpr int SMEM_NEED0 = (NWAVE * (int)sizeof(WaveTile) > (int)(sizeof(GemmSmem) + sizeof(MoeTab))) ? NWAVE * (int)sizeof(WaveTile) : (int)(sizeof(GemmSmem) + sizeof(MoeTab));
constexpr int SMEM_NEED1 = SMEM_NEED0 > (int)sizeof(RouterSmem) ? SMEM_NEED0 : (int)sizeof(RouterSmem);
constexpr int SMEM_NEED2 = SMEM_NEED1 > (int)sizeof(Att1aSmem) ? SMEM_NEED1 : (int)sizeof(Att1aSmem);
constexpr int SMEM_NEED = SMEM_NEED2 > 8 * (int)sizeof(KVTile) ? SMEM_NEED2 : 8 * (int)sizeof(KVTile);
constexpr int SMEM_BAR_OFF = (SMEM_NEED + 15) & ~15, SMEM_BYTES = TID_TAB_OFF + 256;
static_assert(SMEM_BAR_OFF + 16 <= TID_TAB_OFF && SMEM_BYTES <= 160 * 1024, "LDS layout");
template <int PH, bool LAST> DEV void phase_and_sync(const Params& p, char* smem, const XcdBarrier& bar) {
  run_phase<PH>(p, smem);
  if constexpr (!LAST) xcd_barrier(bar);
}
template <int... PHS> struct PhaseList {};
template <int P0> DEV void run_list(const Params& p, char* smem, const XcdBarrier& bar, PhaseList<P0>) { phase_and_sync<P0, true>(p, smem, bar); }
template <int P0, int P1, int... REST> DEV void run_list(const Params& p, char* smem, const XcdBarrier& bar, PhaseList<P0, P1, REST...>) {
  phase_and_sync<P0, false>(p, smem, bar);
  run_list(p, smem, bar, PhaseList<P1, REST...>{});
}
using Program = PhaseList<PH_PRO, PH_IN0, PH_ATT0, PH_OUT0, PH_LN0, PH_RG0, PH_RT0, PH_M10, PH_M20, PH_CB0,
                          PH_IN1, PH_C1, PH_C2, PH_ATT1A, PH_ATT1B, PH_OUT1, PH_LN1, PH_RG1, PH_RT1, PH_M11, PH_M21, PH_CB1>;
struct KArgs { const void* in[25]; float* out; char* ws; };
constexpr size_t al256(size_t b) { return (b + 255) & ~(size_t)255; }
constexpr size_t OFF_BAR = 0;
constexpr size_t OFF_CNT = OFF_BAR + al256(16384);
constexpr size_t OFF_PB = OFF_CNT + al256(4096);
constexpr size_t OFF_ZERO_END = OFF_PB + al256(1024);
constexpr size_t OFF_CS = OFF_ZERO_END;
constexpr size_t OFF_XB = OFF_CS + al256((size_t)T_ * 16 * 4);
constexpr size_t OFF_QKV = OFF_XB + al256((size_t)T_ * D_ * 2);
constexpr size_t OFF_GATES = OFF_QKV + al256((size_t)T_ * 2624 * 2);
constexpr size_t OFF_AO = OFF_GATES + al256((size_t)T_ * 48 * 4);
constexpr size_t OFF_HPRE = OFF_AO + al256((size_t)T_ * D_ * 2);
constexpr size_t OFF_X1B = OFF_HPRE + al256((size_t)T_ * D_ * 4);
constexpr size_t OFF_X1LO = OFF_X1B + al256((size_t)T_ * D_ * 2);
constexpr size_t OFF_LOGITS = OFF_X1LO + al256((size_t)T_ * D_ * 2);
constexpr size_t OFF_EIDX = OFF_LOGITS + al256((size_t)T_ * NE * 4);
constexpr size_t OFF_GATEV = OFF_EIDX + al256((size_t)NASG * 4);
constexpr size_t OFF_EPOS = OFF_GATEV + al256((size_t)NASG * 4);
constexpr size_t OFF_ETOK = OFF_EPOS + al256((size_t)NASG * 4);
constexpr size_t OFF_HBUF = OFF_ETOK + al256((size_t)NE * T_ * 4);
constexpr size_t OFF_YBUF = OFF_HBUF + al256((size_t)NROWS * 256 * 2);
constexpr size_t OFF_X2F = OFF_YBUF + al256((size_t)NROWS * D_ * 2);
constexpr size_t OFF_HID = OFF_X2F + al256((size_t)T_ * D_ * 4);
constexpr size_t OFF_CMPKV = OFF_HID + al256((size_t)2 * 4096 * 128 * 2);
constexpr size_t OFF_SELMASK = OFF_CMPKV + al256((size_t)2 * 4096 * 64 * 2);
constexpr size_t OFF_W16IN0 = OFF_SELMASK + al256((size_t)T_ * 4 * 8);
constexpr size_t OFF_W16OUT0 = OFF_W16IN0 + al256((size_t)D_ * LD0 * 2);
constexpr size_t OFF_W16IN1 = OFF_W16OUT0 + al256((size_t)D_ * D_ * 2);
constexpr size_t OFF_W16OUT1 = OFF_W16IN1 + al256((size_t)D_ * 2816 * 2);
constexpr size_t OFF_RW16 = OFF_W16OUT1 + al256((size_t)D_ * D_ * 2);
constexpr size_t WS_NEEDED = OFF_RW16 + al256((size_t)4 * D_ * NE * 2);

DEV Params make_params(const KArgs& k) {
  Params p;
  p.x = (const float*)k.in[0]; p.pos = (const int*)k.in[1];
  p.even_w_in = (const float*)k.in[2]; p.even_sinks = (const float*)k.in[3]; p.even_w_out = (const float*)k.in[4]; p.odd_w_in = (const float*)k.in[5];
  p.cmpk_pos = (const float*)k.in[6]; p.cmpk_w1 = (const float*)k.in[7]; p.cmpk_w2 = (const float*)k.in[8];
  p.cmpv_pos = (const float*)k.in[9]; p.cmpv_w1 = (const float*)k.in[10]; p.cmpv_w2 = (const float*)k.in[11];
  p.odd_w_out = (const float*)k.in[12]; p.mix_g = (const float*)k.in[13]; p.mix_b = (const float*)k.in[14];
  p.router_w = (const float*)k.in[15]; p.router_b = (const float*)k.in[16];
  p.w_gate = (const float*)k.in[17]; p.w_up = (const float*)k.in[18]; p.w_down = (const float*)k.in[19];
  p.sh_gate = (const float*)k.in[20]; p.sh_up = (const float*)k.in[21]; p.sh_down = (const float*)k.in[22];
  p.ffn_g = (const float*)k.in[23]; p.ffn_b = (const float*)k.in[24];
  p.out = k.out;
  char* w = k.ws;
  p.bar = (unsigned*)(w + OFF_BAR); p.cnt = (int*)(w + OFF_CNT); p.pb = (float*)(w + OFF_PB);
  p.cs = (float*)(w + OFF_CS); p.xb = (u16*)(w + OFF_XB); p.qkv = (u16*)(w + OFF_QKV); p.gates = (float*)(w + OFF_GATES);
  p.ao = (u16*)(w + OFF_AO); p.hpre = (float*)(w + OFF_HPRE); p.x1b = (u16*)(w + OFF_X1B); p.x1lo = (u16*)(w + OFF_X1LO);
  p.logits = (float*)(w + OFF_LOGITS); p.eidx = (int*)(w + OFF_EIDX); p.gatev = (float*)(w + OFF_GATEV); p.epos = (int*)(w + OFF_EPOS); p.etok = (int*)(w + OFF_ETOK);
  p.hbuf = (u16*)(w + OFF_HBUF); p.ybuf = (u16*)(w + OFF_YBUF); p.x2f = (float*)(w + OFF_X2F); p.hid = (u16*)(w + OFF_HID); p.cmpkv = (u16*)(w + OFF_CMPKV);
  p.selmask = (unsigned long long*)(w + OFF_SELMASK);
  p.w16_in0 = (u16*)(w + OFF_W16IN0); p.w16_out0 = (u16*)(w + OFF_W16OUT0); p.w16_in1 = (u16*)(w + OFF_W16IN1); p.w16_out1 = (u16*)(w + OFF_W16OUT1); p.rw16 = (u16*)(w + OFF_RW16);
  return p;
}

__global__ void __launch_bounds__(NTHR, 2) k_fused(KArgs ka) {
  extern __shared__ __attribute__((aligned(16))) char smem[];
  const Params p = make_params(ka);
  {
    const int t0 = (int)__builtin_amdgcn_workitem_id_x();
    if ((t0 & 63) == 0) *reinterpret_cast<__attribute__((address_space(3))) int*>((unsigned)(TID_TAB_OFF + 4 * hw_wave_slot())) = t0 >> 6;
    if (t0 == 0) *reinterpret_cast<uint4*>(smem + SMEM_BAR_OFF) = make_uint4(0u, 0u, 0u, 0u);
  }
  __syncthreads();
  XcdBarrier bar = xcd_barrier_post(p.bar, (volatile LAS unsigned*)(smem + SMEM_BAR_OFF));
  run_list(p, smem, bar, Program{});
}

extern "C" void kernel_launch(void* const* d_in, const int* in_sizes, int n_in, void* d_out, int out_size, void* d_ws, size_t ws_size, hipStream_t stream) {
  (void)in_sizes; (void)n_in; (void)out_size;
  if (ws_size < WS_NEEDED) return;
  KArgs ka{};
  for (int i = 0; i < 25; ++i) ka.in[i] = d_in[i];
  ka.out = (float*)d_out; ka.ws = (char*)d_ws;
  hipMemsetAsync(d_ws, 0, OFF_ZERO_END, stream);
  static int grid = 0;
  if (!grid) {
    int dev = 0, cus = 0, per_cu = 0;
    hipGetDevice(&dev);
    hipDeviceGetAttribute(&cus, hipDeviceAttributeMultiprocessorCount, dev);
    hipFuncSetAttribute((const void*)k_fused, hipFuncAttributeMaxDynamicSharedMemorySize, SMEM_BYTES);
    hipOccupancyMaxActiveBlocksPerMultiprocessor(&per_cu, (const void*)k_fused, NTHR, SMEM_BYTES);
    if (per_cu > 1) per_cu = 1;
    if (per_cu < 1) per_cu = 1;
    grid = cus * per_cu;
  }
  hipLaunchKernelGGL(k_fused, dim3(grid), dim3(NTHR), SMEM_BYTES, stream, ka);
}
```
